# Optimizing an MI355X kernel written in HIP

```python
import math
import jax, jax.numpy as jnp
from jax import lax
import numpy as np

D_MODEL = 1024
BATCH = 4
SEQ = 8192
DEPTH = 1
DEC_BATCH = 8
DEC_SEQ = 32
PAST_LEN = 4096

CHUNK = 64
GDN_HEADS = 4
GDN_DK = 128
GDN_DV = 128
GDN_CONV = 4
DIFF_HEADS = 4
DIFF_DH = 64
DIFF_DV = 2 * DIFF_DH
ROPE_THETA = 10000.0
Q_BLOCK = 128
D_FF = 2816
FFN_CONV = 3
LN_EPS = 1e-5
RMS_EPS = 1e-6
NEG_INF = -1e30

GDN_QK = GDN_HEADS * GDN_DK
GDN_V = GDN_HEADS * GDN_DV
GDN_QKV = 2 * GDN_QK + GDN_V
DIFF_QK = DIFF_HEADS * 2 * DIFF_DH
DIFF_V = DIFF_HEADS * DIFF_DV
D_IN = GDN_QKV + GDN_V + 2 * GDN_HEADS + 2 * DIFF_QK + DIFF_V
D_MIX = GDN_V + DIFF_V
DEEPNORM_ALPHA = (2 * DEPTH) ** 0.25
DEEPNORM_BETA = (8 * DEPTH) ** -0.25

kernel_name = "hybrid_gdn_diffattn_convffn_stream_step"


def layer_norm(x, g, b):
    xf = x.astype(jnp.float32)
    mu = jnp.mean(xf, -1, keepdims=True)
    var = jnp.mean(jnp.square(xf - mu), -1, keepdims=True)
    return ((xf - mu) * lax.rsqrt(var + LN_EPS) * g + b).astype(x.dtype)


def rms_norm(x, w):
    xf = x.astype(jnp.float32)
    return (xf * lax.rsqrt(jnp.mean(xf * xf, -1, keepdims=True) + RMS_EPS) * w).astype(x.dtype)


def l2norm(x):
    xf = x.astype(jnp.float32)
    return (xf * lax.rsqrt(jnp.sum(xf * xf, -1, keepdims=True) + 1e-6)).astype(x.dtype)


def causal_dwconv(x, buf, w):
    width = w.shape[0]
    T = x.shape[1]
    xp = jnp.concatenate([buf.astype(x.dtype), x], axis=1)
    y = sum(xp[:, j:j + T] * w[j] for j in range(width))
    return y, xp[:, T:]


def rope(x, pos):
    half = DIFF_DH // 2
    inv = ROPE_THETA ** (-jnp.arange(half, dtype=jnp.float32) * (2.0 / DIFF_DH))
    ang = pos.astype(jnp.float32)[:, None] * inv[None, :]
    cos = jnp.cos(ang)[:, None, None, :]
    sin = jnp.sin(ang)[:, None, None, :]
    xf = x.astype(jnp.float32)
    x1, x2 = xf[..., :half], xf[..., half:]
    return jnp.concatenate([x1 * cos - x2 * sin, x2 * cos + x1 * sin], -1).astype(x.dtype)


def gdn_chunked(q, k, v, g, beta, s0, chunk):
    f32 = jnp.float32
    B, T, H, Dk = q.shape
    Dv = v.shape[-1]
    N = T // chunk

    def split(t):
        t = t.astype(f32).reshape(B, N, chunk, H, *t.shape[3:])
        return jnp.moveaxis(t, (1, 3), (0, 2))

    qc = split(q) * (Dk ** -0.5)
    kc = split(k)
    vc = split(v)
    bc = split(beta)
    gc = jnp.cumsum(split(g), axis=-1)
    idx = jnp.arange(chunk)
    incl = idx[:, None] >= idx[None, :]
    decay = jnp.exp(jnp.where(incl, gc[..., :, None] - gc[..., None, :], -jnp.inf))
    kb = kc * bc[..., None]
    a_low = jnp.where(idx[:, None] > idx[None, :],
                      jnp.einsum('nbhid,nbhjd->nbhij', kb, kc) * decay, 0.0)
    eye = jnp.eye(chunk, dtype=f32)
    t_inv = lax.linalg.triangular_solve(eye + a_low, jnp.broadcast_to(eye, a_low.shape),
                                        left_side=True, lower=True, unit_diagonal=True)
    u = t_inv @ (vc * bc[..., None])
    w = t_inv @ (kb * jnp.exp(gc)[..., None])
    qk = jnp.einsum('nbhid,nbhjd->nbhij', qc, kc) * decay

    def step(S, xs):
        q_i, k_i, u_i, w_i, g_i, qk_i = xs
        v_new = u_i - w_i @ S
        o_i = (q_i * jnp.exp(g_i)[..., None]) @ S + qk_i @ v_new
        g_last = g_i[..., -1:]
        S = S * jnp.exp(g_last)[..., None] + jnp.einsum(
            'bhcd,bhce->bhde', k_i * jnp.exp(g_last - g_i)[..., None], v_new)
        return S, o_i

    S, o = lax.scan(step, s0.astype(f32), (qc, kc, u, w, gc, qk))
    o = jnp.moveaxis(o, (0, 2), (1, 3)).reshape(B, T, H, Dv)
    return o.astype(v.dtype), S.astype(s0.dtype)


def diff_attention(q, k, v, q_pos, k_pos, lam):
    B, Tq = q.shape[:2]
    nqb = max(Tq // Q_BLOCK, 1)
    bq = Tq // nqb
    qb = jnp.moveaxis(q.reshape(B, nqb, bq, *q.shape[2:]), 1, 0)
    pb = q_pos.reshape(nqb, bq)
    k_chunk = k_pos // CHUNK
    scale = DIFF_DH ** -0.5

    def block(args):
        qi, pi = args
        mask = k_chunk[None, :] <= (pi // CHUNK)[:, None]
        s = jnp.einsum('bqhmd,bkhmd->bhmqk', qi, k).astype(jnp.float32) * scale
        p = jax.nn.softmax(jnp.where(mask, s, NEG_INF), axis=-1)
        a = p[:, :, 0] - lam * p[:, :, 1]
        return jnp.einsum('bhqk,bkhd->bqhd', a.astype(v.dtype), v)

    o = lax.map(block, (qb, pb))
    return jnp.moveaxis(o, 0, 1).reshape(B, Tq, *o.shape[3:])


def trunk_layer(x, pos, k_past, v_past, s0, conv_qkv_buf, conv_ffn_buf, p, lam_init):
    f32 = jnp.float32
    B, T, _ = x.shape
    h = x @ p["w_in"]
    o1 = GDN_QKV
    o2 = o1 + GDN_V
    o3 = o2 + GDN_HEADS
    o4 = o3 + GDN_HEADS
    o5 = o4 + DIFF_QK
    o6 = o5 + DIFF_QK
    qkv_a, gate_a, a_a, b_a = h[..., :o1], h[..., o1:o2], h[..., o2:o3], h[..., o3:o4]
    q_b, k_b, v_b = h[..., o4:o5], h[..., o5:o6], h[..., o6:]

    qkv_c, new_conv_qkv = causal_dwconv(qkv_a, conv_qkv_buf, p["gdn_conv_w"])
    qkv_c = jax.nn.silu(qkv_c)
    qa = l2norm(qkv_c[..., :GDN_QK].reshape(B, T, GDN_HEADS, GDN_DK))
    ka = l2norm(qkv_c[..., GDN_QK:2 * GDN_QK].reshape(B, T, GDN_HEADS, GDN_DK))
    va = qkv_c[..., 2 * GDN_QK:].reshape(B, T, GDN_HEADS, GDN_DV)
    g = -jnp.exp(p["gdn_a_log"].astype(f32)) * jax.nn.softplus(
        a_a.astype(f32) + p["gdn_dt_bias"].astype(f32))
    beta = jax.nn.sigmoid(b_a.astype(f32))
    chunk = CHUNK if T % CHUNK == 0 else T
    oa, s_new = gdn_chunked(qa, ka, va, g, beta, s0, chunk)
    oa = rms_norm(oa, p["gdn_norm_w"]) * jax.nn.silu(gate_a.reshape(B, T, GDN_HEADS, GDN_DV))

    qd = rope(q_b.reshape(B, T, DIFF_HEADS, 2, DIFF_DH), pos)
    kd = rope(k_b.reshape(B, T, DIFF_HEADS, 2, DIFF_DH), pos)
    vd = v_b.reshape(B, T, DIFF_HEADS, DIFF_DV)
    new_k = kd.reshape(B, T, DIFF_HEADS, 2 * DIFF_DH)
    if k_past is None:
        k_all, v_all, k_pos = kd, vd, pos
    else:
        past = k_past.shape[1]
        k_all = jnp.concatenate(
            [k_past.reshape(B, past, DIFF_HEADS, 2, DIFF_DH).astype(kd.dtype), kd], axis=1)
        v_all = jnp.concatenate([v_past.astype(vd.dtype), vd], axis=1)
        k_pos = jnp.concatenate([jnp.arange(past, dtype=pos.dtype), pos])
    lv = p["diff_lambda"].astype(f32)
    lam = jnp.exp(jnp.sum(lv[0] * lv[1])) - jnp.exp(jnp.sum(lv[2] * lv[3])) + lam_init
    ob = diff_attention(qd, k_all, v_all, pos, k_pos, lam)
    ob = rms_norm(ob, p["diff_subln_w"]) * (1.0 - lam_init)

    mix = jnp.concatenate([oa.reshape(B, T, GDN_V), ob.reshape(B, T, DIFF_V).astype(oa.dtype)],
                          axis=-1) @ p["w_o"]
    x = layer_norm(DEEPNORM_ALPHA * x + mix, p["ln1_g"], p["ln1_b"])

    u, new_conv_ffn = causal_dwconv(x @ p["w_up"], conv_ffn_buf, p["ffn_conv_w"])
    u = u + p["ffn_conv_b"]
    y = (jax.nn.silu(u[..., :D_FF]) * u[..., D_FF:]) @ p["w_down"]
    x = layer_norm(DEEPNORM_ALPHA * x + y, p["ln2_g"], p["ln2_b"])
    return x, new_k, vd, s_new, new_conv_qkv, new_conv_ffn


def setup_inputs(seed: int = 0) -> dict:
    key = jax.random.key(seed)
    ks = jax.random.split(key, 26)
    f32 = jnp.float32

    def nrm(k, shape, s):
        return jax.random.normal(k, shape, f32) * s

    L = DEPTH
    dt = jnp.exp(jax.random.uniform(ks[10], (L, GDN_HEADS), f32, math.log(1e-3), math.log(1e-1)))
    return {
        "x_prompt": nrm(ks[0], (BATCH, SEQ, D_MODEL), 1.0),
        "x_sample": nrm(ks[1], (DEC_BATCH, DEC_SEQ, D_MODEL), 1.0),
        "cache_k": nrm(ks[2], (L, DEC_BATCH, PAST_LEN, DIFF_HEADS, 2 * DIFF_DH), 1.0),
        "cache_v": nrm(ks[3], (L, DEC_BATCH, PAST_LEN, DIFF_HEADS, DIFF_DV), 1.0),
        "state_gdn": nrm(ks[4], (L, DEC_BATCH, GDN_HEADS, GDN_DK, GDN_DV), 0.5),
        "state_conv_qkv": nrm(ks[5], (L, DEC_BATCH, GDN_CONV - 1, GDN_QKV), 1.0),
        "state_conv_ffn": nrm(ks[6], (L, DEC_BATCH, FFN_CONV - 1, 2 * D_FF), 1.0),
        "w_in": nrm(ks[7], (L, D_MODEL, D_IN), D_MODEL ** -0.5),
        "gdn_conv_w": nrm(ks[8], (L, GDN_CONV, GDN_QKV), GDN_CONV ** -0.5),
        "gdn_a_log": jnp.log(jax.random.uniform(ks[9], (L, GDN_HEADS), f32, 1.0, 16.0)),
        "gdn_dt_bias": dt + jnp.log(-jnp.expm1(-dt)),
        "gdn_norm_w": 1.0 + nrm(ks[11], (L, GDN_DV), 0.02),
        "diff_lambda": nrm(ks[12], (L, 4, DIFF_DH), 0.1),
        "diff_subln_w": 1.0 + nrm(ks[13], (L, DIFF_DV), 0.02),
        "w_o": nrm(ks[14], (L, D_MIX, D_MODEL), D_MIX ** -0.5 * DEEPNORM_BETA),
        "ln1_g": 1.0 + nrm(ks[15], (L, D_MODEL), 0.02),
        "ln1_b": nrm(ks[16], (L, D_MODEL), 0.02),
        "w_up": nrm(ks[17], (L, D_MODEL, 2 * D_FF), D_MODEL ** -0.5),
        "ffn_conv_w": nrm(ks[18], (L, FFN_CONV, 2 * D_FF), FFN_CONV ** -0.5),
        "ffn_conv_b": nrm(ks[19], (L, 2 * D_FF), 0.02),
        "w_down": nrm(ks[20], (L, D_FF, D_MODEL), D_FF ** -0.5 * DEEPNORM_BETA),
        "ln2_g": 1.0 + nrm(ks[21], (L, D_MODEL), 0.02),
        "ln2_b": nrm(ks[22], (L, D_MODEL), 0.02),
    }


def reference(x_prompt, x_sample, cache_k, cache_v, state_gdn, state_conv_qkv, state_conv_ffn,
              w_in, gdn_conv_w, gdn_a_log, gdn_dt_bias, gdn_norm_w, diff_lambda, diff_subln_w,
              w_o, ln1_g, ln1_b, w_up, ffn_conv_w, ffn_conv_b, w_down, ln2_g, ln2_b):
    Bp, Tp, _ = x_prompt.shape
    Ts = x_sample.shape[1]
    past = cache_k.shape[2]
    pos_p = jnp.arange(Tp, dtype=jnp.int32)
    pos_s = past + jnp.arange(Ts, dtype=jnp.int32)
    xp, xs = x_prompt, x_sample
    outs_p, outs_s = [], []
    for l in range(DEPTH):
        p = {"w_in": w_in[l], "gdn_conv_w": gdn_conv_w[l], "gdn_a_log": gdn_a_log[l],
             "gdn_dt_bias": gdn_dt_bias[l], "gdn_norm_w": gdn_norm_w[l],
             "diff_lambda": diff_lambda[l], "diff_subln_w": diff_subln_w[l], "w_o": w_o[l],
             "ln1_g": ln1_g[l], "ln1_b": ln1_b[l], "w_up": w_up[l], "ffn_conv_w": ffn_conv_w[l],
             "ffn_conv_b": ffn_conv_b[l], "w_down": w_down[l], "ln2_g": ln2_g[l], "ln2_b": ln2_b[l]}
        lam_init = 0.8 - 0.6 * math.exp(-0.3 * l)
        s0_p = jnp.zeros((Bp, GDN_HEADS, GDN_DK, GDN_DV), jnp.float32)
        cq0_p = jnp.zeros((Bp, GDN_CONV - 1, GDN_QKV), xp.dtype)
        cf0_p = jnp.zeros((Bp, FFN_CONV - 1, 2 * D_FF), xp.dtype)
        xp, kp, vp, sp, cqp, cfp = trunk_layer(xp, pos_p, None, None, s0_p, cq0_p, cf0_p, p, lam_init)
        xs, ksn, vsn, ssn, cqs, cfs = trunk_layer(xs, pos_s, cache_k[l], cache_v[l], state_gdn[l],
                                                  state_conv_qkv[l], state_conv_ffn[l], p, lam_init)
        outs_p.append((kp, vp, sp, cqp, cfp))
        outs_s.append((ksn, vsn, ssn, cqs, cfs))

    def stk(outs, i):
        return jnp.stack([o[i] for o in outs])

    return (xp, xs,
            stk(outs_p, 0), stk(outs_p, 1), stk(outs_p, 2), stk(outs_p, 3), stk(outs_p, 4),
            stk(outs_s, 0), stk(outs_s, 1), stk(outs_s, 2), stk(outs_s, 3), stk(outs_s, 4))
```

```cpp
#include <hip/hip_runtime.h>
#include <hip/hip_cooperative_groups.h>
#include <cstdio>
namespace cg = cooperative_groups;

typedef unsigned short bf16_t;
typedef short bf16x8 __attribute__((ext_vector_type(8)));
typedef short s16x4 __attribute__((ext_vector_type(4)));
typedef float f32x4 __attribute__((ext_vector_type(4)));
typedef float f32x16 __attribute__((ext_vector_type(16)));
typedef unsigned u32x4 __attribute__((ext_vector_type(4)));
typedef unsigned u32x2 __attribute__((ext_vector_type(2)));
#define DI __device__ __forceinline__

constexpr int D = 1024, TP = 8192, BP = 4, MP = BP * TP, BS = 8, TS = 32, MS = BS * TS, M = MP + MS, PAST = 4096;
constexpr int DIN = 3592, NH1 = 3584, DFF = 2816, NUP = 2 * DFF;
constexpr int TKS = 4160;
constexpr int NITEM = BP * 128 * 4 + BS * 4;
constexpr int ITEM_B = 90112;
constexpr int LDS_BYTES = 160 * 1024;
constexpr float ALPHA = 1.189207115002721f;
constexpr float LAM_INIT = 0.2f;

constexpr size_t O_Y = 0, O_KP = 33816576, O_VP = 50593792, O_GP = 67371008, O_CQP = 67633152, O_CFP = 67651584,
                 O_KS = 67696640, O_VS = 67827712, O_GS = 67958784, O_CQS = 68483072, O_CFS = 68519936, O_END = 68610048;

constexpr size_t al256(size_t x) { return (x + 255) & ~(size_t)255; }
constexpr size_t WS_CTL = 0;
constexpr size_t WS_ROPE = 4096;
constexpr size_t WS_AB = WS_ROPE + (size_t)8192 * 32 * 8;
constexpr size_t WS_DL = WS_AB + (size_t)M * 8 * 4;
constexpr size_t WS_WIN = al256(WS_DL + NITEM * 4);
constexpr size_t WS_WO = WS_WIN + (size_t)NH1 * D * 2;
constexpr size_t WS_WUP = WS_WO + (size_t)D * D * 2;
constexpr size_t WS_WDN = WS_WUP + (size_t)NUP * D * 2;
constexpr size_t WS_R1 = al256(WS_WDN + (size_t)D * DFF * 2);
constexpr size_t R1_SIZE = (size_t)NITEM * ITEM_B;
constexpr size_t WS_R2 = al256(WS_R1 + R1_SIZE);
constexpr size_t WS_R3 = al256(WS_R2 + (size_t)M * 1536 * 2);
constexpr size_t WS_R4 = WS_R3 + (size_t)M * 512 * 2;
constexpr size_t WS_R5 = al256(WS_R4 + (size_t)M * 512 * 2);
constexpr size_t KROWS = (size_t)MP + (size_t)BS * TKS;
constexpr size_t WS_R6 = al256(WS_R5 + KROWS * 512 * 2);
constexpr size_t VT_S_OFF = (size_t)BP * 4 * 128 * TP;
constexpr size_t WS_END = al256(WS_R6 + (VT_S_OFF + (size_t)BS * 4 * 128 * TKS) * 2);
static_assert((size_t)M * DFF * 2 <= R1_SIZE, "GT must fit R1");
static_assert(WS_END <= (size_t)536870912, "workspace too large");

struct Params {
    const float *x_p, *x_s, *cache_k, *cache_v, *state_gdn, *state_cq, *state_cf;
    const float *w_in, *gdn_conv_w, *a_log, *dt_bias, *gdn_norm_w, *diff_lambda, *subln_w, *w_o, *ln1_g, *ln1_b, *w_up,
        *ffn_conv_w, *ffn_conv_b, *w_down, *ln2_g, *ln2_b;
    float* out; unsigned char* ws;
    int phase_lo, phase_hi;
};

extern __shared__ __attribute__((aligned(16))) unsigned char dyn_smem[];

typedef __bf16 bf16x2_t __attribute__((ext_vector_type(2)));
typedef float f32x2 __attribute__((ext_vector_type(2)));
DI unsigned pk2(float lo, float hi) { f32x2 v = {lo, hi}; bf16x2_t b = __builtin_convertvector(v, bf16x2_t); return __builtin_bit_cast(unsigned, b); }
DI bf16_t f2bf(float x) { return (bf16_t)(pk2(x, 0.f) & 0xffffu); }
DI float bf2f(bf16_t b) { return __uint_as_float(((unsigned)b) << 16); }
DI float bflo(unsigned u) { return __uint_as_float(u << 16); }
DI float bfhi(unsigned u) { return __uint_as_float(u & 0xffff0000u); }
DI float silu(float x) { return x / (1.f + __expf(-x)); }
DI int opaque_tid() { int t = threadIdx.x; asm volatile("" : "+v"(t)); return t; }
DI float wave_sum(float v) {
#pragma unroll
    for (int o = 1; o < 64; o <<= 1) v += __shfl_xor(v, o);
    return v;
}
DI const float* xrow_ptr(const Params& p, int row) { return row < MP ? p.x_p + (size_t)row * D : p.x_s + (size_t)(row - MP) * D; }

template <int MODE> DI int srccol(int n) {
    if (MODE == 1) {
        if (n < 2048) return n;
        return n + 8;
    }
    if (MODE == 2) { const int pn = n >> 8, j = n & 255; return j < 128 ? 128 * pn + j : DFF + 128 * pn + (j - 128); }
    return n;
}
template <int MODE> DI void transpose_tile(const float* W, int K, int N, bf16_t* WT, int k0, int n0) {
    float* lds = (float*)dyn_smem;
    const int tid = threadIdx.x;
#pragma unroll
    for (int i = 0; i < 8; ++i) { const int kk = (tid >> 6) + 8 * i, nn = tid & 63; lds[kk * 65 + nn] = W[(size_t)(k0 + kk) * N + srccol<MODE>(n0 + nn)]; }
    __syncthreads();
#pragma unroll
    for (int i = 0; i < 8; ++i) { const int nn = (tid >> 6) + 8 * i, kk = tid & 63; WT[(size_t)(n0 + nn) * K + k0 + kk] = f2bf(lds[kk * 65 + nn]); }
    __syncthreads();
}

DI void phase_prep(const Params& p) {
    const int tid = threadIdx.x, lane = tid & 63, wave = tid >> 6, nb = gridDim.x, bid = blockIdx.x;
    unsigned char* ws = p.ws;
    if (bid == 0 && tid < 64) {
        unsigned* ctl = (unsigned*)(ws + WS_CTL);
        float a = p.diff_lambda[lane] * p.diff_lambda[64 + lane], b = p.diff_lambda[128 + lane] * p.diff_lambda[192 + lane];
        a = wave_sum(a); b = wave_sum(b);
        if (lane == 0) { ctl[0] = 0u; ((float*)ctl)[1] = expf(a) - expf(b) + LAM_INIT; }
    }
    {
        constexpr int I_IN = 16 * 56, I_O = 16 * 16, I_UP = 16 * 88, I_DN = 44 * 16;
        for (int it = bid; it < I_IN + I_O + I_UP + I_DN; it += nb) {
            int r = it;
            if (r < I_IN) { transpose_tile<1>(p.w_in, D, DIN, (bf16_t*)(ws + WS_WIN), (r / 56) * 64, (r % 56) * 64); continue; } r -= I_IN;
            if (r < I_O) { transpose_tile<0>(p.w_o, D, D, (bf16_t*)(ws + WS_WO), (r / 16) * 64, (r % 16) * 64); continue; } r -= I_O;
            if (r < I_UP) { transpose_tile<2>(p.w_up, D, NUP, (bf16_t*)(ws + WS_WUP), (r / 88) * 64, (r % 88) * 64); continue; } r -= I_UP;
            transpose_tile<0>(p.w_down, DFF, D, (bf16_t*)(ws + WS_WDN), (r / 16) * 64, (r % 16) * 64);
        }
    }
    {
        float2* rope = (float2*)(ws + WS_ROPE);
        for (int idx = bid * 512 + tid; idx < 8192 * 32; idx += nb * 512) {
            const int pos = idx >> 5, d = idx & 31;
            const double inv = exp(-(double)d * (9.210340371976184 / 32.0));
            double a = (double)pos * inv;
            a -= 6.283185307179586 * rint(a * 0.15915494309189535);
            const float af = (float)a;
            rope[idx] = make_float2(__cosf(af), __sinf(af));
        }
    }
    {
        float* w8 = (float*)dyn_smem;
        __syncthreads();
        for (int i = tid; i < 1024 * 8; i += 512) w8[i] = p.w_in[(size_t)(i >> 3) * DIN + 2048 + (i & 7)];
        __syncthreads();
        bf16_t* XB = (bf16_t*)(ws + WS_R1);
        float* AB = (float*)(ws + WS_AB);
        for (int row = bid * 8 + wave; row < M; row += nb * 8) {
            const float* xr = xrow_ptr(p, row);
            float acc[8];
#pragma unroll
            for (int c = 0; c < 8; ++c) acc[c] = 0.f;
#pragma unroll
            for (int j = 0; j < 4; ++j) {
                const int k0 = lane * 4 + 256 * j;
                const f32x4 v = *(const f32x4*)(xr + k0);
                u32x2 o; o.x = pk2(v.x, v.y); o.y = pk2(v.z, v.w);
                *(u32x2*)(XB + (size_t)row * D + k0) = o;
#pragma unroll
                for (int e = 0; e < 4; ++e) {
                    const f32x4 wa = *(const f32x4*)(w8 + (k0 + e) * 8), wb = *(const f32x4*)(w8 + (k0 + e) * 8 + 4);
                    const float xv = v[e];
                    acc[0] += xv * wa.x; acc[1] += xv * wa.y; acc[2] += xv * wa.z; acc[3] += xv * wa.w;
                    acc[4] += xv * wb.x; acc[5] += xv * wb.y; acc[6] += xv * wb.z; acc[7] += xv * wb.w;
                }
            }
#pragma unroll
            for (int c = 0; c < 8; ++c) acc[c] = wave_sum(acc[c]);
            if (lane == 0) { *(f32x4*)(AB + (size_t)row * 8) = (f32x4){acc[0], acc[1], acc[2], acc[3]}; *(f32x4*)(AB + (size_t)row * 8 + 4) = (f32x4){acc[4], acc[5], acc[6], acc[7]}; }
        }
        __syncthreads();
    }
    {
        bf16_t* KALL = (bf16_t*)(ws + WS_R5);
        const int nchunk = BS * TKS * 64;
        for (int c = bid * 512 + tid; c < nchunk; c += nb * 512) {
            const int col8 = c & 63, r = c >> 6, b = r / TKS, pp = r % TKS;
            if (pp >= PAST && pp < PAST + TS) continue;
            u32x4 o = (u32x4){0u, 0u, 0u, 0u};
            if (pp < PAST) {
                const float* s = p.cache_k + ((size_t)(b * PAST + pp) * 512 + col8 * 8);
                const f32x4 v0 = *(const f32x4*)s, v1 = *(const f32x4*)(s + 4);
                o.x = pk2(v0.x, v0.y); o.y = pk2(v0.z, v0.w); o.z = pk2(v1.x, v1.y); o.w = pk2(v1.z, v1.w);
            }
            *(u32x4*)(KALL + ((size_t)MP + (size_t)b * TKS + pp) * 512 + col8 * 8) = o;
        }
    }
    {
        bf16_t* VTS = (bf16_t*)(ws + WS_R6) + VT_S_OFF;
        bf16_t* t = (bf16_t*)dyn_smem;
        for (int it = bid; it < BS * 4 * 65; it += nb) {
            const int blk = it % 65, bh = it / 65, b = bh >> 2, h = bh & 3;
            if (blk < 64) {
                __syncthreads();
#pragma unroll
                for (int i = 0; i < 4; ++i) {
                    const int id = tid + 512 * i, key = id >> 5, c4 = id & 31;
                    const f32x4 v = *(const f32x4*)(p.cache_v + ((size_t)(b * PAST + blk * 64 + key) * 512 + h * 128 + c4 * 4));
                    bf16_t* d = t + key * 130 + c4 * 4;
                    *(unsigned*)d = pk2(v.x, v.y); *(unsigned*)(d + 2) = pk2(v.z, v.w);
                }
                __syncthreads();
                const int dv = tid >> 2, part = tid & 3;
                unsigned o[8];
#pragma unroll
                for (int i = 0; i < 8; ++i) { const int k0 = part * 16 + 2 * i; o[i] = (unsigned)t[k0 * 130 + dv] | ((unsigned)t[(k0 + 1) * 130 + dv] << 16); }
                bf16_t* dst = VTS + ((size_t)(bh * 128 + dv) * TKS + blk * 64 + part * 16);
                *(u32x4*)dst = (u32x4){o[0], o[1], o[2], o[3]}; *(u32x4*)(dst + 8) = (u32x4){o[4], o[5], o[6], o[7]};
            } else {
                if (tid < 128) { bf16_t* dst = VTS + ((size_t)(bh * 128 + tid) * TKS + PAST + TS);
#pragma unroll
                    for (int i = 0; i < 4; ++i) *(u32x4*)(dst + 8 * i) = (u32x4){0u, 0u, 0u, 0u}; }
            }
        }
        __syncthreads();
    }
}

constexpr int BM = 256, BK = 64, HALF = 128, NXCD = 8, WGM = 8, HT = HALF * BK;
DI void stage_rc(int b, int& R, int& C) {
    const int st = b / 1024, sb = b % 1024, swz = sb ^ (((sb >> 9) & 1) << 5);
    R = (st >> 1) * 16 + swz / 64; C = (st & 1) * 32 + (swz % 64) / 2;
}
DI int lds_byte(int r, int c) {
    const int st = (r >> 4) * 2 + (c >> 5), rr = r & 15, cc = c & 31, ob = rr * 64 + cc * 2;
    return st * 1024 + (ob ^ (((ob >> 9) & 1) << 5));
}

#define SHM ((bf16_t*)dyn_smem)
#define SA(b, h) (SHM + ((b) * 2 + (h)) * HT)
#define SB(b, h) (SHM + (4 + (b) * 2 + (h)) * HT)
#define STAGE(P, BASE, br, kt) do { const bf16_t* _gb = (BASE) + ((long)(br) * K + (long)(kt) * BK); \
      __builtin_amdgcn_global_load_lds((const unsigned*)(_gb + so0), (unsigned*)((char*)(P) + threadIdx.x * 16), 16, 0, 0); \
      __builtin_amdgcn_global_load_lds((const unsigned*)(_gb + 64 * K + so0), (unsigned*)((char*)(P) + threadIdx.x * 16 + 8192), 16, 0, 0); } while (0)
#define LDA(dst, b, h) for (int m = 0; m < 4; ++m) for (int k = 0; k < 2; ++k) \
    dst[m][k] = *reinterpret_cast<const bf16x8*>((char*)SA(b, h) + lds_byte(wr * 64 + m * 16 + fr, k * 32 + fq * 8))
#define LDB(dst, b, h) for (int n = 0; n < 2; ++n) for (int k = 0; k < 2; ++k) \
    dst[n][k] = *reinterpret_cast<const bf16x8*>((char*)SB(b, h) + lds_byte(wc * 32 + n * 16 + fr, k * 32 + fq * 8))
#define MMA(ai, bj, At, Bt_) do { __builtin_amdgcn_s_setprio(1); \
    for (int m = 0; m < 4; ++m) for (int n = 0; n < 2; ++n) for (int k = 0; k < 2; ++k) \
      acc[ai][bj][m][n] = __builtin_amdgcn_mfma_f32_16x16x32_bf16(At[m][k], Bt_[n][k], acc[ai][bj][m][n], 0, 0, 0); \
    __builtin_amdgcn_s_setprio(0); } while (0)
#define WAIT_V(n) asm volatile("s_waitcnt vmcnt(" #n ")" ::: "memory")
#define WAIT_L(n) asm volatile("s_waitcnt lgkmcnt(" #n ")" ::: "memory")
#define BAR __builtin_amdgcn_s_barrier()
#define SCHED __builtin_amdgcn_sched_barrier(0)

template <int K> DI void gemm_tile(const bf16_t* __restrict__ A, const bf16_t* __restrict__ Bt, const int brow, const int bcol, f32x4 (&acc)[2][2][4][2]) {
    const int wid = threadIdx.x >> 6, lane = threadIdx.x & 63, wr = wid >> 2, wc = wid & 3, fr = lane & 15, fq = lane >> 4;
    unsigned so0;
    { int _r, _c; stage_rc(threadIdx.x * 16, _r, _c); so0 = (unsigned)(_r * K + _c); }
#pragma unroll
    for (int a = 0; a < 2; ++a)
#pragma unroll
        for (int b = 0; b < 2; ++b)
#pragma unroll
            for (int m = 0; m < 4; ++m)
#pragma unroll
                for (int n = 0; n < 2; ++n) acc[a][b][m][n] = (f32x4){0.f, 0.f, 0.f, 0.f};
    bf16x8 At[4][2], B0[2][2], B1[2][2];
    constexpr int nt = K / BK;
    STAGE(SB(0, 0), Bt, bcol, 0); STAGE(SA(0, 0), A, brow, 0);
    STAGE(SB(0, 1), Bt, bcol + HALF, 0); STAGE(SA(0, 1), A, brow + HALF, 0);
    if (wr == 1) BAR;
    WAIT_V(4); BAR;
    STAGE(SB(1, 0), Bt, bcol, 1); STAGE(SA(1, 0), A, brow, 1); STAGE(SB(1, 1), Bt, bcol + HALF, 1);
    WAIT_V(6); BAR;
    for (int t = 0; t < nt - 2; t += 2) {
        LDB(B0, 0, 0); SCHED; LDA(At, 0, 0); STAGE(SA(1, 1), A, brow + HALF, t + 1);
        WAIT_L(8); BAR; WAIT_L(0); MMA(0, 0, At, B0); BAR; SCHED;
        LDB(B1, 0, 1); STAGE(SB(0, 0), Bt, bcol, t + 2);
        BAR; WAIT_L(0); MMA(0, 1, At, B1); BAR;
        LDA(At, 0, 1); STAGE(SA(0, 0), A, brow, t + 2);
        BAR; WAIT_L(0); MMA(1, 0, At, B0); BAR; SCHED;
        STAGE(SB(0, 1), Bt, bcol + HALF, t + 2);
        WAIT_V(6); BAR; MMA(1, 1, At, B1); BAR;
        LDB(B0, 1, 0); SCHED; LDA(At, 1, 0); STAGE(SA(0, 1), A, brow + HALF, t + 2);
        WAIT_L(8); BAR; WAIT_L(0); MMA(0, 0, At, B0); BAR; SCHED;
        LDB(B1, 1, 1); STAGE(SB(1, 0), Bt, bcol, t + 3);
        BAR; WAIT_L(0); MMA(0, 1, At, B1); BAR;
        LDA(At, 1, 1); STAGE(SA(1, 0), A, brow, t + 3);
        BAR; WAIT_L(0); MMA(1, 0, At, B0); BAR; SCHED;
        STAGE(SB(1, 1), Bt, bcol + HALF, t + 3);
        WAIT_V(6); BAR; MMA(1, 1, At, B1); BAR;
    }
    { LDB(B0, 0, 0); LDA(At, 0, 0); STAGE(SA(1, 1), A, brow + HALF, nt - 1);
      BAR; WAIT_L(0); MMA(0, 0, At, B0); BAR;
      LDB(B1, 0, 1); BAR; WAIT_L(0); MMA(0, 1, At, B1); BAR;
      LDA(At, 0, 1); WAIT_V(4); BAR; WAIT_L(0); MMA(1, 0, At, B0); MMA(1, 1, At, B1); BAR; }
    { LDB(B0, 1, 0); LDA(At, 1, 0); WAIT_V(2); BAR; WAIT_L(0); MMA(0, 0, At, B0); BAR;
      LDB(B1, 1, 1); WAIT_V(0); BAR; WAIT_L(0); MMA(0, 1, At, B1); BAR;
      LDA(At, 1, 1); BAR; WAIT_L(0); MMA(1, 0, At, B0); MMA(1, 1, At, B1); BAR; }
    if (wr == 0) BAR;
}

DI void tile_of(int L, int nM, int nN, int& pm, int& pn) {
    const int nwg = nM * nN; int wgid = L;
    { const int q = nwg / NXCD, r = nwg % NXCD, xcd = wgid % NXCD, off = wgid / NXCD; wgid = (xcd < r ? xcd * (q + 1) : r * (q + 1) + (xcd - r) * q) + off; }
    const int nig = WGM * nN, gid = wgid / nig, fm = gid * WGM, gsz = min(nM - fm, WGM);
    pm = fm + ((wgid % nig) % gsz); pn = (wgid % nig) / gsz;
}

constexpr int CST = 260;
DI void stage_half(const f32x4 (&acc)[2][2][4][2], const int ai) {
    const int tid_ = opaque_tid(), wid = tid_ >> 6, lane = tid_ & 63, wr = wid >> 2, wc = wid & 3, fr = lane & 15, fq = lane >> 4;
    float* base = (float*)dyn_smem + (wr * 64 + fq * 4) * CST + wc * 32 + fr;
#pragma unroll
    for (int m = 0; m < 4; ++m)
#pragma unroll
        for (int j = 0; j < 4; ++j)
#pragma unroll
            for (int bj = 0; bj < 2; ++bj)
#pragma unroll
                for (int n = 0; n < 2; ++n) base[(m * 16 + j) * CST + bj * 128 + n * 16] = ai == 0 ? acc[0][bj][m][n][j] : acc[1][bj][m][n][j];
}
#define CT ((const float*)dyn_smem)

DI void epi_in_half(const Params& p, int pm, int pn, int ai) {
    unsigned char* ws = p.ws;
    const int tid = opaque_tid(), brow = pm * BM + ai * 128, bcol = pn * BM;
    const bool samp = pm == 128;
    if (pn < 8) {
        bf16_t* dst = pn < 6 ? (bf16_t*)(ws + WS_R2) : (bf16_t*)(ws + WS_R3);
        const int ld = pn < 6 ? 1536 : 512, c0 = pn < 6 ? bcol : bcol - 1536;
#pragma unroll 4
        for (int i = 0; i < 16; ++i) {
            const int id = tid + 512 * i, r = id >> 6, c4 = (id & 63) * 4, row = brow + r;
            const f32x4 v = *(const f32x4*)(CT + r * CST + c4);
            u32x2 o; o.x = pk2(v.x, v.y); o.y = pk2(v.z, v.w);
            *(u32x2*)(dst + (size_t)row * ld + c0 + c4) = o;
            if (pn < 6) {
                if (!samp) { const int t = row & (TP - 1); if (t >= TP - 3) *(f32x4*)(p.out + O_CQP + (size_t)((row >> 13) * 3 + t - (TP - 3)) * 1536 + c0 + c4) = v; }
                else { const int rr = row - MP, t = rr & 31; if (t >= TS - 3) *(f32x4*)(p.out + O_CQS + (size_t)((rr >> 5) * 3 + t - (TS - 3)) * 1536 + c0 + c4) = v; }
            }
        }
        return;
    }
    if (pn < 12) {
        const bool isq = pn < 10;
        const float* rope = (const float*)(ws + WS_ROPE);
        bf16_t* QB = (bf16_t*)(ws + WS_R4); bf16_t* KALL = (bf16_t*)(ws + WS_R5);
        const float qs = 0.125f * 1.4426950408889634f;
#pragma unroll 2
        for (int i = 0; i < 8; ++i) {
            const int id = tid + 512 * i, r = id >> 5, q = id & 31, hl = q >> 4, map = (q >> 3) & 1, d4 = (q & 7) * 4, row = brow + r;
            const int cl = hl * 128 + map * 64 + d4, col = ((pn & 1) * 2 + hl) * 128 + map * 64 + d4;
            const f32x4 x1 = *(const f32x4*)(CT + r * CST + cl), x2 = *(const f32x4*)(CT + r * CST + cl + 32);
            int pos; size_t krow; float* kout;
            if (!samp) { pos = row & (TP - 1); krow = row; kout = p.out + O_KP + (size_t)row * 512; }
            else { const int rr = row - MP; pos = PAST + (rr & 31); krow = (size_t)MP + (size_t)(rr >> 5) * TKS + pos; kout = p.out + O_KS + (size_t)rr * 512; }
            const f32x4 t0 = *(const f32x4*)(rope + (size_t)(pos * 32 + d4) * 2), t1 = *(const f32x4*)(rope + (size_t)(pos * 32 + d4) * 2 + 4);
            const f32x4 cs = (f32x4){t0.x, t0.z, t1.x, t1.z}, sn = (f32x4){t0.y, t0.w, t1.y, t1.w};
            const f32x4 y1 = x1 * cs - x2 * sn, y2 = x2 * cs + x1 * sn;
            if (isq) {
                u32x2 o1, o2; o1.x = pk2(y1.x * qs, y1.y * qs); o1.y = pk2(y1.z * qs, y1.w * qs); o2.x = pk2(y2.x * qs, y2.y * qs); o2.y = pk2(y2.z * qs, y2.w * qs);
                *(u32x2*)(QB + (size_t)row * 512 + col) = o1; *(u32x2*)(QB + (size_t)row * 512 + col + 32) = o2;
            } else {
                *(f32x4*)(kout + col) = y1; *(f32x4*)(kout + col + 32) = y2;
                u32x2 o1, o2; o1.x = pk2(y1.x, y1.y); o1.y = pk2(y1.z, y1.w); o2.x = pk2(y2.x, y2.y); o2.y = pk2(y2.z, y2.w);
                *(u32x2*)(KALL + krow * 512 + col) = o1; *(u32x2*)(KALL + krow * 512 + col + 32) = o2;
            }
        }
        return;
    }
    {
        bf16_t* VT = (bf16_t*)(ws + WS_R6);
#pragma unroll 4
        for (int i = 0; i < 16; ++i) {
            const int id = tid + 512 * i, r = id >> 6, c4 = (id & 63) * 4, row = brow + r, col = (pn & 1) * 256 + c4;
            const f32x4 v = *(const f32x4*)(CT + r * CST + c4);
            float* vout = samp ? p.out + O_VS + (size_t)(row - MP) * 512 + col : p.out + O_VP + (size_t)row * 512 + col;
            *(f32x4*)vout = v;
        }
#pragma unroll 1
        for (int i = 0; i < 2; ++i) {
            const int id = tid + 512 * i, rg = id >> 6, c4 = (id & 63) * 4, row0 = brow + rg * 8;
            f32x4 v[8];
#pragma unroll
            for (int e = 0; e < 8; ++e) v[e] = *(const f32x4*)(CT + (rg * 8 + e) * CST + c4);
#pragma unroll
            for (int e = 0; e < 4; ++e) {
                const int colg = (pn & 1) * 256 + c4 + e, head = colg >> 7, dv = colg & 127;
                u32x4 o; o.x = pk2(v[0][e], v[1][e]); o.y = pk2(v[2][e], v[3][e]); o.z = pk2(v[4][e], v[5][e]); o.w = pk2(v[6][e], v[7][e]);
                bf16_t* d;
                if (samp) { const int rr = row0 - MP; d = VT + VT_S_OFF + ((size_t)(((rr >> 5) * 4 + head) * 128 + dv) * TKS + PAST + (rr & 31)); }
                else d = VT + ((size_t)(((row0 >> 13) * 4 + head) * 128 + dv) * TP + (row0 & (TP - 1)));
                *(u32x4*)d = o;
            }
        }
    }
}

template <int WHICH> DI void epi_res_half(const Params& p, int pm, int pn, int ai) {
    const int tid = opaque_tid(), brow = pm * BM + ai * 128, bcol = pn * BM;
#pragma unroll 4
    for (int i = 0; i < 16; ++i) {
        const int id = tid + 512 * i, r = id >> 6, c4 = (id & 63) * 4, row = brow + r;
        const f32x4 v = *(const f32x4*)(CT + r * CST + c4);
        float* o = p.out + O_Y + (size_t)row * D + bcol + c4;
        const float* rs = WHICH == 0 ? xrow_ptr(p, row) + bcol + c4 : o;
        const f32x4 x = *(const f32x4*)rs;
        *(f32x4*)o = x * ALPHA + v;
    }
}

constexpr int UST = 264;
DI void epi_up(const Params& p, const f32x4 (&acc)[2][2][4][2], int pm, int pn) {
    unsigned char* ws = p.ws;
    bf16_t* U = (bf16_t*)dyn_smem;
    float* BND = (float*)(ws + WS_R5);
    const bool samp = pm == 128;
    const int brow = pm * BM, tid = opaque_tid();
    {
        const int wid = tid >> 6, lane = tid & 63, wr = wid >> 2, wc = wid & 3, fr = lane & 15, fq = lane >> 4;
        bf16_t* base = U + (wr * 64 + fq * 4) * UST + wc * 32 + fr;
#pragma unroll
        for (int ai = 0; ai < 2; ++ai)
#pragma unroll
            for (int m = 0; m < 4; ++m)
#pragma unroll
                for (int j = 0; j < 4; ++j)
#pragma unroll
                    for (int bj = 0; bj < 2; ++bj)
#pragma unroll
                        for (int n = 0; n < 2; ++n) base[(ai * 128 + m * 16 + j) * UST + bj * 128 + n * 16] = f2bf(acc[ai][bj][m][n][j]);
    }
    __syncthreads();
    {
        const int nb = samp ? 32 * 256 : 4 * 256;
        for (int id = tid; id < nb; id += 512) {
            const int cl = id & 255, q = id >> 8;
            const int oc = (cl >> 7) * DFF + 128 * pn + (cl & 127);
            int rr, bslot, u;
            if (!samp) { bslot = q; rr = q < 2 ? q : 252 + q; u = pm; }
            else { bslot = q & 3; rr = (q >> 2) * 32 + (bslot < 2 ? bslot : 28 + bslot); u = 128 + (q >> 2); }
            const float v = bf2f(U[rr * UST + cl]);
            BND[((size_t)u * 4 + bslot) * NUP + oc] = v;
            if (bslot >= 2) {
                if (samp) p.out[O_CFS + (size_t)((q >> 2) * 2 + bslot - 2) * NUP + oc] = v;
                else if ((pm & 31) == 31) p.out[O_CFP + (size_t)((pm >> 5) * 2 + bslot - 2) * NUP + oc] = v;
            }
        }
    }
    {
        const int c = tid & 127, rs = tid >> 7, cg_ = 128 * pn + c, cv_ = DFF + 128 * pn + c;
        const float wg0 = p.ffn_conv_w[cg_], wg1 = p.ffn_conv_w[NUP + cg_], wg2 = p.ffn_conv_w[2 * NUP + cg_], bg = p.ffn_conv_b[cg_];
        const float wv0 = p.ffn_conv_w[cv_], wv1 = p.ffn_conv_w[NUP + cv_], wv2 = p.ffn_conv_w[2 * NUP + cv_], bv = p.ffn_conv_b[cv_];
        bf16_t* GT = (bf16_t*)(ws + WS_R1);
        const int r0 = rs * 64;
        float g1 = 0.f, g2 = 0.f, v1 = 0.f, v2 = 0.f;
        if (r0 >= 2) { g1 = bf2f(U[(r0 - 2) * UST + c]); g2 = bf2f(U[(r0 - 1) * UST + c]); v1 = bf2f(U[(r0 - 2) * UST + 128 + c]); v2 = bf2f(U[(r0 - 1) * UST + 128 + c]); }
#pragma unroll 4
        for (int r = r0; r < r0 + 64; ++r) {
            const float g3 = bf2f(U[r * UST + c]), v3 = bf2f(U[r * UST + 128 + c]);
            const bool skip = samp ? ((r & 31) < 2) : (r < 2);
            if (!skip) {
                const float cg2 = wg0 * g1 + wg1 * g2 + wg2 * g3 + bg, cv2 = wv0 * v1 + wv1 * v2 + wv2 * v3 + bv;
                GT[(size_t)(brow + r) * DFF + 128 * pn + c] = f2bf(silu(cg2) * cv2);
            }
            g1 = g2; g2 = g3; v1 = v2; v2 = v3;
        }
    }
}

template <int WHICH> DI void gemm_phase(const Params& p) {
    unsigned char* ws = p.ws;
    const bf16_t* A; const bf16_t* Bt; int N; constexpr int K = WHICH == 4 ? DFF : D;
    if (WHICH == 1) { A = (const bf16_t*)(ws + WS_R1); Bt = (const bf16_t*)(ws + WS_WIN); N = NH1; }
    else if (WHICH == 2) { A = (const bf16_t*)(ws + WS_R2); Bt = (const bf16_t*)(ws + WS_WO); N = D; }
    else if (WHICH == 3) { A = (const bf16_t*)(ws + WS_R3); Bt = (const bf16_t*)(ws + WS_WUP); N = NUP; }
    else { A = (const bf16_t*)(ws + WS_R1); Bt = (const bf16_t*)(ws + WS_WDN); N = D; }
    const int nM = M / BM, nN = N / BM, ntile = nM * nN;
    for (int L = blockIdx.x; L < ntile; L += gridDim.x) {
        int pm, pn; tile_of(L, nM, nN, pm, pn);
        f32x4 acc[2][2][4][2];
        gemm_tile<K>(A, Bt, pm * BM, pn * BM, acc);
        if (WHICH == 3) epi_up(p, acc, pm, pn);
        else {
#pragma unroll
            for (int ai = 0; ai < 2; ++ai) {
                stage_half(acc, ai);
                __syncthreads();
                if (WHICH == 1) epi_in_half(p, pm, pn, ai);
                else if (WHICH == 2) epi_res_half<0>(p, pm, pn, ai);
                else epi_res_half<1>(p, pm, pn, ai);
                __syncthreads();
            }
        }
        __syncthreads();
    }
}

template <int WHICH> DI void ln_phase(const Params& p) {
    const int lane = threadIdx.x & 63, wave = threadIdx.x >> 6;
    const float* g = WHICH == 0 ? p.ln1_g : p.ln2_g; const float* b = WHICH == 0 ? p.ln1_b : p.ln2_b;
    bf16_t* X1B = (bf16_t*)(p.ws + WS_R3);
    f32x4 gv[4], bv[4];
#pragma unroll
    for (int j = 0; j < 4; ++j) { gv[j] = *(const f32x4*)(g + lane * 4 + 256 * j); bv[j] = *(const f32x4*)(b + lane * 4 + 256 * j); }
    for (int row = blockIdx.x * 8 + wave; row < M; row += gridDim.x * 8) {
        float* xr = p.out + O_Y + (size_t)row * D;
        f32x4 v[4]; float s = 0.f;
#pragma unroll
        for (int j = 0; j < 4; ++j) { v[j] = *(const f32x4*)(xr + lane * 4 + 256 * j); s += (v[j].x + v[j].y) + (v[j].z + v[j].w); }
        const float mean = wave_sum(s) * (1.f / D); float s2 = 0.f;
#pragma unroll
        for (int j = 0; j < 4; ++j) { v[j] = v[j] - mean; s2 += (v[j].x * v[j].x + v[j].y * v[j].y) + (v[j].z * v[j].z + v[j].w * v[j].w); }
        const float rstd = rsqrtf(wave_sum(s2) * (1.f / D) + 1e-5f);
#pragma unroll
        for (int j = 0; j < 4; ++j) {
            const f32x4 o = v[j] * rstd * gv[j] + bv[j];
            *(f32x4*)(xr + lane * 4 + 256 * j) = o;
            if (WHICH == 0) { u32x2 q; q.x = pk2(o.x, o.y); q.y = pk2(o.z, o.w); *(u32x2*)(X1B + (size_t)row * D + lane * 4 + 256 * j) = q; }
        }
    }
}

DI void fixup_phase(const Params& p) {
    const float* BND = (const float*)(p.ws + WS_R5);
    bf16_t* GT = (bf16_t*)(p.ws + WS_R1);
    const int total = (128 + 8) * 2 * DFF;
    for (int idx = blockIdx.x * 512 + threadIdx.x; idx < total; idx += gridDim.x * 512) {
        const int c = idx % DFF, q = idx / DFF, r = q & 1, u = q >> 1;
        const float* cur = BND + (size_t)u * 4 * NUP;
        float pg[2], pv[2];
        if (u < 128) {
            if ((u & 31) == 0) { pg[0] = pg[1] = pv[0] = pv[1] = 0.f; }
            else { const float* pr = BND + (size_t)(u - 1) * 4 * NUP; pg[0] = pr[2 * NUP + c]; pg[1] = pr[3 * NUP + c]; pv[0] = pr[2 * NUP + DFF + c]; pv[1] = pr[3 * NUP + DFF + c]; }
        } else { const float* st = p.state_cf + (size_t)(u - 128) * 2 * NUP; pg[0] = st[c]; pg[1] = st[NUP + c]; pv[0] = st[DFF + c]; pv[1] = st[NUP + DFF + c]; }
        const float cg0 = cur[c], cg1 = cur[NUP + c], cv0 = cur[DFF + c], cv1 = cur[NUP + DFF + c];
        const float wg0 = p.ffn_conv_w[c], wg1 = p.ffn_conv_w[NUP + c], wg2 = p.ffn_conv_w[2 * NUP + c], bg = p.ffn_conv_b[c];
        const float wv0 = p.ffn_conv_w[DFF + c], wv1 = p.ffn_conv_w[NUP + DFF + c], wv2 = p.ffn_conv_w[2 * NUP + DFF + c], bv = p.ffn_conv_b[DFF + c];
        float g, v;
        if (r == 0) { g = wg0 * pg[0] + wg1 * pg[1] + wg2 * cg0 + bg; v = wv0 * pv[0] + wv1 * pv[1] + wv2 * cv0 + bv; }
        else { g = wg0 * pg[1] + wg1 * cg0 + wg2 * cg1 + bg; v = wv0 * pv[1] + wv1 * cv0 + wv2 * cv1 + bv; }
        const size_t row = u < 128 ? (size_t)u * 256 + r : (size_t)MP + (size_t)(u - 128) * 32 + r;
        GT[row * DFF + c] = f2bf(silu(g) * v);
    }
}

#define MFMA16(a, b, c) __builtin_amdgcn_mfma_f32_16x16x32_bf16((a), (b), (c), 0, 0, 0)
#define MFMA32(a, b, c) __builtin_amdgcn_mfma_f32_32x32x16_bf16((a), (b), (c), 0, 0, 0)
DI bf16x8 pack8(const f32x4 a, const f32x4 b) { u32x4 o; o.x = pk2(a.x, a.y); o.y = pk2(a.z, a.w); o.z = pk2(b.x, b.y); o.w = pk2(b.z, b.w); return __builtin_bit_cast(bf16x8, o); }
constexpr float GSCALE = 0.08838834764831845f;
constexpr int QST = 132, AST = 68, NST = 136, QKST = 72;
constexpr int L_QKV = 0, L_AM = 3 * 64 * QST * 4, L_KN = L_AM + 64 * AST * 4, L_QN = L_KN + 64 * NST * 2, L_GC = L_QN + 64 * NST * 2;
constexpr int L_QKS = 0, L_WS = 2 * 64 * QST * 4;
static_assert(L_GC + 1024 <= LDS_BYTES, "gdn prep LDS");

DI void gdn_prep_phase(const Params& p) {
    unsigned char* ws = p.ws;
    float* QKVf = (float*)(dyn_smem + L_QKV); float* AM = (float*)(dyn_smem + L_AM);
    bf16_t* KN = (bf16_t*)(dyn_smem + L_KN); bf16_t* QN = (bf16_t*)(dyn_smem + L_QN);
    float* GC = (float*)(dyn_smem + L_GC); float* BETA = GC + 64; float* EG = GC + 128; float* ED = GC + 192;
    bf16_t* QKS = (bf16_t*)(dyn_smem + L_QKS); bf16_t* WSI = (bf16_t*)(dyn_smem + L_WS);
    const bf16_t* HQKV = (const bf16_t*)(ws + WS_R2);
    const float* AB = (const float*)(ws + WS_AB);
    float* DL = (float*)(ws + WS_DL);
    for (int item = blockIdx.x; item < NITEM; item += gridDim.x) {
        const int tid = opaque_tid(), lane = tid & 63, wave = __builtin_amdgcn_readfirstlane(tid >> 6), fr = lane & 15, fq = lane >> 4;
        int h, b, c, row0, valid; bool samp;
        if (item < 2048) { h = item & 3; c = (item >> 2) & 127; b = item >> 9; row0 = b * TP + c * 64; valid = 64; samp = false; }
        else { const int j = item - 2048; h = j & 3; b = j >> 2; c = 0; row0 = MP + b * TS; valid = TS; samp = true; }
        unsigned char* ip = ws + WS_R1 + (size_t)item * ITEM_B;
        __syncthreads();
#pragma unroll 1
        for (int task = tid; task < 1536; task += 512) {
            const int col = task % 384, seg = task / 384, part = col >> 7, cc = col & 127, gcol = part * 512 + h * 128 + cc, t0 = seg * 16;
            const float w0 = p.gdn_conv_w[gcol], w1 = p.gdn_conv_w[1536 + gcol], w2 = p.gdn_conv_w[2 * 1536 + gcol], w3 = p.gdn_conv_w[3 * 1536 + gcol];
            float xm[3];
#pragma unroll
            for (int k = 0; k < 3; ++k) {
                const int t = t0 - 3 + k; float v;
                if (t >= 0) v = t < valid ? bf2f(HQKV[(size_t)(row0 + t) * 1536 + gcol]) : 0.f;
                else if (samp) v = p.state_cq[(size_t)(b * 3 + 3 + t) * 1536 + gcol];
                else v = c == 0 ? 0.f : bf2f(HQKV[(size_t)(row0 + t) * 1536 + gcol]);
                xm[k] = v;
            }
#pragma unroll 4
            for (int t = t0; t < t0 + 16; ++t) {
                const float xv = t < valid ? bf2f(HQKV[(size_t)(row0 + t) * 1536 + gcol]) : 0.f;
                const float y = w0 * xm[0] + w1 * xm[1] + w2 * xm[2] + w3 * xv;
                QKVf[(part * 64 + t) * QST + cc] = t < valid ? silu(y) : 0.f;
                xm[0] = xm[1]; xm[1] = xm[2]; xm[2] = xv;
            }
        }
        if (tid < 64) {
            float g = 0.f, be = 0.f;
            if (tid < valid) {
                const float a = AB[(size_t)(row0 + tid) * 8 + h] + p.dt_bias[h], bb = AB[(size_t)(row0 + tid) * 8 + 4 + h];
                const float sp = a > 20.f ? a : log1pf(expf(a));
                g = -expf(p.a_log[h]) * sp; be = 1.f / (1.f + expf(-bb));
            }
            float gc = g;
#pragma unroll
            for (int o = 1; o < 64; o <<= 1) { const float n = __shfl_up(gc, o); if (lane >= o) gc += n; }
            const float gl = __shfl(gc, 63);
            GC[tid] = gc; BETA[tid] = be; EG[tid] = expf(gc); ED[tid] = expf(gl - gc);
            if (tid == 0) DL[item] = expf(gl);
        }
        __syncthreads();
        {
            const int row = tid >> 3, pt = tid & 7;
            float q[16], k[16]; float sq = 0.f, sk = 0.f;
#pragma unroll
            for (int e4 = 0; e4 < 4; ++e4) {
                const f32x4 a = *(const f32x4*)(QKVf + row * QST + 16 * pt + 4 * e4), bq = *(const f32x4*)(QKVf + (64 + row) * QST + 16 * pt + 4 * e4);
#pragma unroll
                for (int e = 0; e < 4; ++e) { q[4 * e4 + e] = a[e]; k[4 * e4 + e] = bq[e]; sq += a[e] * a[e]; sk += bq[e] * bq[e]; }
            }
#pragma unroll
            for (int o = 1; o < 8; o <<= 1) { sq += __shfl_xor(sq, o); sk += __shfl_xor(sk, o); }
            const float rq = rsqrtf(sq + 1e-6f), rk = rsqrtf(sk + 1e-6f), qg = rq * GSCALE * EG[row];
            u32x4 o0, o1;
            o0.x = pk2(q[0] * rq, q[1] * rq); o0.y = pk2(q[2] * rq, q[3] * rq); o0.z = pk2(q[4] * rq, q[5] * rq); o0.w = pk2(q[6] * rq, q[7] * rq);
            o1.x = pk2(q[8] * rq, q[9] * rq); o1.y = pk2(q[10] * rq, q[11] * rq); o1.z = pk2(q[12] * rq, q[13] * rq); o1.w = pk2(q[14] * rq, q[15] * rq);
            *(u32x4*)(QN + row * NST + 16 * pt) = o0; *(u32x4*)(QN + row * NST + 16 * pt + 8) = o1;
            o0.x = pk2(k[0] * rk, k[1] * rk); o0.y = pk2(k[2] * rk, k[3] * rk); o0.z = pk2(k[4] * rk, k[5] * rk); o0.w = pk2(k[6] * rk, k[7] * rk);
            o1.x = pk2(k[8] * rk, k[9] * rk); o1.y = pk2(k[10] * rk, k[11] * rk); o1.z = pk2(k[12] * rk, k[13] * rk); o1.w = pk2(k[14] * rk, k[15] * rk);
            *(u32x4*)(KN + row * NST + 16 * pt) = o0; *(u32x4*)(KN + row * NST + 16 * pt + 8) = o1;
#pragma unroll
            for (int e4 = 0; e4 < 4; ++e4) *(f32x4*)(QKVf + (64 + row) * QST + 16 * pt + 4 * e4) = (f32x4){k[4 * e4] * rk, k[4 * e4 + 1] * rk, k[4 * e4 + 2] * rk, k[4 * e4 + 3] * rk};
            bf16_t* QGf = (bf16_t*)(ip + 16384);
            const int rt = row >> 4, frr = row & 15, ks = pt >> 1;
#pragma unroll
            for (int f = 0; f < 4; ++f) {
                u32x2 o; o.x = pk2(q[4 * f] * qg, q[4 * f + 1] * qg); o.y = pk2(q[4 * f + 2] * qg, q[4 * f + 3] * qg);
                *(u32x2*)(QGf + (size_t)(((rt * 4 + ks) * 64 + f * 16 + frr) * 8 + 4 * (pt & 1))) = o;
            }
        }
        __syncthreads();
        {
            const bool isq = wave >= 4; const int ti = wave & 3;
            const bf16_t* As = isq ? QN : KN;
#pragma unroll
            for (int tj = 0; tj < 4; ++tj) {
                f32x4 acc = (f32x4){0.f, 0.f, 0.f, 0.f};
#pragma unroll
                for (int ks = 0; ks < 4; ++ks) {
                    const bf16x8 a = *(const bf16x8*)(As + (16 * ti + fr) * NST + 32 * ks + 8 * fq), bb = *(const bf16x8*)(KN + (16 * tj + fr) * NST + 32 * ks + 8 * fq);
                    acc = MFMA16(a, bb, acc);
                }
                const int jj = 16 * tj + fr; const float gj = GC[jj];
#pragma unroll
                for (int j = 0; j < 4; ++j) {
                    const int i = 16 * ti + 4 * fq + j;
                    const float dec = i >= jj ? expf(GC[i] - gj) : 0.f;
                    if (!isq) AM[i * AST + jj] = i > jj ? BETA[i] * acc[j] * dec : 0.f;
                    else QKS[i * QKST + jj] = f2bf(GSCALE * acc[j] * dec);
                }
            }
            bf16_t* KDTf = (bf16_t*)(ip + 32768);
#pragma unroll
            for (int i2 = 0; i2 < 2; ++i2) {
                const int f = tid + 512 * i2, ln = f & 63, ks2 = (f >> 6) & 1, dt = f >> 7, fq_ = ln >> 4, dk = 16 * dt + (ln & 15);
                float v[8];
#pragma unroll
                for (int e = 0; e < 8; ++e) { const int i = 32 * ks2 + 16 * (e >> 2) + 4 * fq_ + (e & 3); v[e] = bf2f(KN[i * NST + dk]) * ED[i]; }
                u32x4 o; o.x = pk2(v[0], v[1]); o.y = pk2(v[2], v[3]); o.z = pk2(v[4], v[5]); o.w = pk2(v[6], v[7]);
                *(u32x4*)(KDTf + (size_t)f * 8) = o;
            }
        }
        __syncthreads();
        float x[64];
        if (tid < 256) {
            const bool isw = tid >= 128; const int cc = tid & 127;
            int zo = 0; asm volatile("" : "+v"(zo));
            const float* Bz = BETA + zo; const float* Ez = EG + zo;
#pragma unroll
            for (int i = 0; i < 64; ++i) x[i] = isw ? QKVf[(64 + i) * QST + cc] * (Bz[i] * Ez[i]) : QKVf[(128 + i) * QST + cc] * Bz[i];
        }
        __syncthreads();
        if (tid < 256) {
            const bool isw = tid >= 128; const int cc = tid & 127;
            int zo = 0; asm volatile("" : "+v"(zo));
            const float* AMz = AM + zo;
#pragma unroll
            for (int i = 1; i < 64; ++i) {
                __builtin_amdgcn_sched_barrier(0);
                float s = x[i];
#pragma unroll
                for (int j4 = 0; j4 < (i + 3) / 4; ++j4) {
                    const f32x4 a = *(const f32x4*)(AMz + i * AST + 4 * j4);
#pragma unroll
                    for (int e = 0; e < 4; ++e) if (4 * j4 + e < i) s -= a[e] * x[4 * j4 + e];
                }
                x[i] = s;
            }
            if (!isw) {
                float* Uc = (float*)(ip + 57344);
                const int strip = cc >> 4, frr = cc & 15;
#pragma unroll
                for (int rt = 0; rt < 4; ++rt)
#pragma unroll
                    for (int f = 0; f < 4; ++f)
                        *(f32x4*)(Uc + (size_t)(((strip * 4 + rt) * 64 + f * 16 + frr) * 4)) = (f32x4){x[16 * rt + 4 * f], x[16 * rt + 4 * f + 1], x[16 * rt + 4 * f + 2], x[16 * rt + 4 * f + 3]};
            } else {
#pragma unroll
                for (int i = 0; i < 64; ++i) WSI[i * NST + cc] = f2bf(x[i]);
            }
        }
        __syncthreads();
        {
            bf16_t* Wf = (bf16_t*)ip; bf16_t* QKf = (bf16_t*)(ip + 49152);
#pragma unroll
            for (int i2 = 0; i2 < 2; ++i2) {
                const int f = tid + 512 * i2, ln = f & 63, ks = (f >> 6) & 3, rt = f >> 8, i = 16 * rt + (ln & 15), fq_ = ln >> 4;
                const u32x2 lo = *(const u32x2*)(WSI + i * NST + 32 * ks + 4 * fq_), hi = *(const u32x2*)(WSI + i * NST + 32 * ks + 16 + 4 * fq_);
                *(u32x4*)(Wf + (size_t)f * 8) = (u32x4){lo.x, lo.y, hi.x, hi.y};
            }
            {
                const int f = tid, ln = f & 63, ks2 = (f >> 6) & 1, rt = f >> 7, i = 16 * rt + (ln & 15), fq_ = ln >> 4;
                const u32x2 lo = *(const u32x2*)(QKS + i * QKST + 32 * ks2 + 4 * fq_), hi = *(const u32x2*)(QKS + i * QKST + 32 * ks2 + 16 + 4 * fq_);
                *(u32x4*)(QKf + (size_t)f * 8) = (u32x4){lo.x, lo.y, hi.x, hi.y};
            }
        }
    }
}

constexpr int OPB_B = 57344, L_OBUF = 2 * OPB_B, OST = 132;
static_assert(L_OBUF + 64 * OST * 4 <= LDS_BYTES, "scan LDS");
DI void gdn_scan(const Params& p, const bool samp, const int b, const int h) {
    unsigned char* ws = p.ws;
    const int tid = threadIdx.x, lane = tid & 63, w = __builtin_amdgcn_readfirstlane(tid >> 6), fr = lane & 15, fq = lane >> 4;
    const int nsteps = samp ? 1 : 128, valid = samp ? TS : 64;
    float* OBUF = (float*)(dyn_smem + L_OBUF);
    const bf16_t* HG = (const bf16_t*)(ws + WS_R3);
    bf16_t* OMIX = (bf16_t*)(ws + WS_R2);
    const float* DL = (const float*)(ws + WS_DL);
    f32x4 S[8];
#pragma unroll
    for (int dt = 0; dt < 8; ++dt) {
        if (samp) {
#pragma unroll
            for (int j = 0; j < 4; ++j) S[dt][j] = p.state_gdn[((size_t)(b * 4 + h) * 128 + 16 * dt + 4 * fq + j) * 128 + 16 * w + fr];
        } else S[dt] = (f32x4){0.f, 0.f, 0.f, 0.f};
    }
    const int item0 = samp ? 2048 + b * 4 + h : b * 512 + h;
    __syncthreads();
    {
        const unsigned char* ip = ws + WS_R1 + (size_t)item0 * ITEM_B;
#pragma unroll
        for (int i = 0; i < 7; ++i) *(u32x4*)(dyn_smem + (tid + 512 * i) * 16) = *(const u32x4*)(ip + (tid + 512 * i) * 16);
    }
    __syncthreads();
#pragma unroll 1
    for (int c = 0; c < nsteps; ++c) {
        const int item = item0 + 4 * c;
        const unsigned char* ip = ws + WS_R1 + (size_t)item * ITEM_B;
        const bool nxt = c + 1 < nsteps;
        u32x4 pf[7];
        if (nxt) {
#pragma unroll
            for (int i = 0; i < 7; ++i) pf[i] = *(const u32x4*)(ip + 4 * (size_t)ITEM_B + (tid + 512 * i) * 16);
        }
        const float* Uc = (const float*)(ip + 57344);
        f32x4 U[4];
#pragma unroll
        for (int rt = 0; rt < 4; ++rt) U[rt] = *(const f32x4*)(Uc + ((w * 4 + rt) * 64 + lane) * 4);
        const float dl = DL[item];
        const unsigned char* buf = dyn_smem + (c & 1) * OPB_B;
        bf16x8 Sb[4];
#pragma unroll
        for (int ks = 0; ks < 4; ++ks) Sb[ks] = pack8(S[2 * ks], S[2 * ks + 1]);
        f32x4 vn[4];
#pragma unroll
        for (int rt = 0; rt < 4; ++rt) {
            f32x4 acc = (f32x4){0.f, 0.f, 0.f, 0.f};
#pragma unroll
            for (int ks = 0; ks < 4; ++ks) acc = MFMA16(*(const bf16x8*)(buf + ((rt * 4 + ks) * 64 + lane) * 16), Sb[ks], acc);
            vn[rt] = U[rt] - acc;
        }
        bf16x8 Vb[2];
        Vb[0] = pack8(vn[0], vn[1]); Vb[1] = pack8(vn[2], vn[3]);
#pragma unroll
        for (int rt = 0; rt < 4; ++rt) {
            f32x4 acc = (f32x4){0.f, 0.f, 0.f, 0.f};
#pragma unroll
            for (int ks = 0; ks < 4; ++ks) acc = MFMA16(*(const bf16x8*)(buf + 16384 + ((rt * 4 + ks) * 64 + lane) * 16), Sb[ks], acc);
#pragma unroll
            for (int ks2 = 0; ks2 < 2; ++ks2) acc = MFMA16(*(const bf16x8*)(buf + 49152 + ((rt * 2 + ks2) * 64 + lane) * 16), Vb[ks2], acc);
#pragma unroll
            for (int j = 0; j < 4; ++j) OBUF[(16 * rt + 4 * fq + j) * OST + 16 * w + fr] = acc[j];
        }
#pragma unroll
        for (int dt = 0; dt < 8; ++dt) {
            f32x4 acc = S[dt] * dl;
#pragma unroll
            for (int ks2 = 0; ks2 < 2; ++ks2) acc = MFMA16(*(const bf16x8*)(buf + 32768 + ((dt * 2 + ks2) * 64 + lane) * 16), Vb[ks2], acc);
            S[dt] = acc;
        }
        if (nxt) {
#pragma unroll
            for (int i = 0; i < 7; ++i) *(u32x4*)(dyn_smem + ((c + 1) & 1) * OPB_B + (tid + 512 * i) * 16) = pf[i];
        }
        __syncthreads();
        {
            const int row = tid >> 3, pt = tid & 7;
            float o[16]; float ss = 0.f;
#pragma unroll
            for (int e4 = 0; e4 < 4; ++e4) { const f32x4 a = *(const f32x4*)(OBUF + row * OST + 16 * pt + 4 * e4);
#pragma unroll
                for (int e = 0; e < 4; ++e) { o[4 * e4 + e] = a[e]; ss += a[e] * a[e]; } }
#pragma unroll
            for (int of = 1; of < 8; of <<= 1) ss += __shfl_xor(ss, of);
            if (row < valid) {
                const float r = rsqrtf(ss * (1.f / 128.f) + 1e-6f);
                const size_t grow = (samp ? (size_t)MP + b * TS : (size_t)b * TP + (size_t)c * 64) + row;
                const u32x4 g0 = *(const u32x4*)(HG + grow * 512 + h * 128 + 16 * pt), g1 = *(const u32x4*)(HG + grow * 512 + h * 128 + 16 * pt + 8);
                const unsigned gw[8] = {g0.x, g0.y, g0.z, g0.w, g1.x, g1.y, g1.z, g1.w};
                unsigned ow[8];
#pragma unroll
                for (int e = 0; e < 8; ++e) {
                    const float ga = bflo(gw[e]), gb = bfhi(gw[e]);
                    const float n0 = p.gdn_norm_w[16 * pt + 2 * e], n1 = p.gdn_norm_w[16 * pt + 2 * e + 1];
                    ow[e] = pk2(o[2 * e] * r * n0 * silu(ga), o[2 * e + 1] * r * n1 * silu(gb));
                }
                *(u32x4*)(OMIX + grow * 1024 + h * 128 + 16 * pt) = (u32x4){ow[0], ow[1], ow[2], ow[3]};
                *(u32x4*)(OMIX + grow * 1024 + h * 128 + 16 * pt + 8) = (u32x4){ow[4], ow[5], ow[6], ow[7]};
            }
        }
        __syncthreads();
    }
    float* So = p.out + (samp ? O_GS : O_GP) + (size_t)(b * 4 + h) * 128 * 128;
#pragma unroll
    for (int dt = 0; dt < 8; ++dt)
#pragma unroll
        for (int j = 0; j < 4; ++j) So[(size_t)(16 * dt + 4 * fq + j) * 128 + 16 * w + fr] = S[dt][j];
}

constexpr int KST = 136, VST = 72, L_KT = 0, L_VT = 2 * 64 * KST * 2, L_ALX = L_VT + 2 * 128 * VST * 2, L_IDX = L_ALX + 8 * 2 * 32 * 4, L_QF = L_IDX + 256;
static_assert(L_QF + 8 * 8 * 1024 <= LDS_BYTES, "attn LDS");
DI int crow32(int i, int hh) { return (i & 3) + 8 * (i >> 2) + 4 * hh; }

DI void attn_item(const Params& p, const int idx, const float* lamp) {
    unsigned char* ws = p.ws;
    const int tid = threadIdx.x, lane = tid & 63, w = __builtin_amdgcn_readfirstlane(tid >> 6), r = lane & 31, hh = lane >> 5;
    bool samp; int b, h, qb = 0, ntiles, lastw; size_t qbase, kbase; const bf16_t* vtb; int vstride; bool active;
    if (idx < 32) { samp = true; b = idx >> 2; h = idx & 3; qbase = (size_t)MP + b * TS; kbase = (size_t)MP + (size_t)b * TKS; ntiles = 65; lastw = 64; active = w == 0;
                    vtb = (const bf16_t*)(ws + WS_R6) + VT_S_OFF + (size_t)((b * 4 + h) * 128) * TKS; vstride = TKS; }
    else { const int j = idx - 32; samp = false; qb = 31 - (j >> 4); b = (j & 15) >> 2; h = j & 3; qbase = (size_t)b * TP + qb * 256; kbase = (size_t)b * TP; ntiles = 4 * qb + 4; lastw = 4 * qb + (w >> 1); active = true;
           vtb = (const bf16_t*)(ws + WS_R6) + (size_t)((b * 4 + h) * 128) * TP; vstride = TP; }
    const bf16_t* KALL = (const bf16_t*)(ws + WS_R5) + kbase * 512 + h * 128;
    bf16_t* KT = (bf16_t*)(dyn_smem + L_KT); bf16_t* VTL = (bf16_t*)(dyn_smem + L_VT);
    float* ALX = (float*)(dyn_smem + L_ALX) + w * 64;
    bf16_t* QF = (bf16_t*)(dyn_smem + L_QF) + w * 8 * 64 * 8;
    {
        const bf16_t* qp = (const bf16_t*)(ws + WS_R4) + (qbase + 32 * w + r) * 512 + h * 128 + 8 * hh;
        if (active) {
#pragma unroll
            for (int f = 0; f < 8; ++f) *(u32x4*)(QF + (f * 64 + lane) * 8) = *(const u32x4*)(qp + (f >> 2) * 64 + 16 * (f & 3));
        }
    }
    f32x16 O1[4], O2[4];
#pragma unroll
    for (int t = 0; t < 4; ++t)
#pragma unroll
        for (int i = 0; i < 16; ++i) { O1[t][i] = 0.f; O2[t][i] = 0.f; }
    float m1 = -1e30f, m2 = -1e30f, l1 = 0.f, l2 = 0.f;
    const int krow0 = tid >> 4, kc16 = tid & 15;
    const int vdv0 = tid >> 3, vm = tid & 7;
    const int vpos = (vm >> 2) * 32 + ((vm >> 1) & 1) * 16 + (vm & 1) * 4;
    const unsigned koff = krow0 * 512 + kc16 * 8, voff = vdv0 * vstride + 8 * vm;
    const unsigned klds = (krow0 * KST + kc16 * 8) * 2, vlds = (vdv0 * VST + vpos) * 2;
    u32x4 pa, pb;
    __syncthreads();
    {
        pa = *(const u32x4*)(KALL + koff); pb = *(const u32x4*)(KALL + 32 * 512 + koff);
        *(u32x4*)(dyn_smem + L_KT + klds) = pa; *(u32x4*)(dyn_smem + L_KT + 32 * KST * 2 + klds) = pb;
        pa = *(const u32x4*)(vtb + voff); pb = *(const u32x4*)(vtb + (size_t)64 * vstride + voff);
        *(u32x2*)(dyn_smem + L_VT + vlds) = (u32x2){pa.x, pa.y}; *(u32x2*)(dyn_smem + L_VT + vlds + 16) = (u32x2){pa.z, pa.w};
        *(u32x2*)(dyn_smem + L_VT + 64 * VST * 2 + vlds) = (u32x2){pb.x, pb.y}; *(u32x2*)(dyn_smem + L_VT + 64 * VST * 2 + vlds + 16) = (u32x2){pb.z, pb.w};
    }
    __syncthreads();
#pragma unroll 1
    for (int kt = 0; kt < ntiles; ++kt) {
        const bool nxt = kt + 1 < ntiles;
        const bf16_t* kn_ = KALL + (size_t)(kt + 1) * 64 * 512; const bf16_t* vn_ = vtb + (size_t)(kt + 1) * 64;
        unsigned char* ldn = dyn_smem + ((kt + 1) & 1) * 64 * KST * 2; unsigned char* ldv = dyn_smem + L_VT + ((kt + 1) & 1) * 128 * VST * 2;
        if (nxt) { pa = *(const u32x4*)(kn_ + koff); pb = *(const u32x4*)(kn_ + 32 * 512 + koff); }
        if (active && kt <= lastw) {
            const bf16_t* Kb = KT + (kt & 1) * 64 * KST; const bf16_t* Vb = VTL + (kt & 1) * 128 * VST;
            const bool domask = samp && kt == 64;
#pragma unroll 1
            for (int sub = 0; sub < 2; ++sub) {
                bf16x8 P[2][2];
#pragma unroll
                for (int mp = 0; mp < 2; ++mp) {
                    f32x16 sc;
#pragma unroll
                    for (int i = 0; i < 16; ++i) sc[i] = 0.f;
#pragma unroll
                    for (int s = 0; s < 4; ++s) {
                        const bf16x8 ka = *(const bf16x8*)(Kb + (sub * 32 + r) * KST + mp * 64 + 16 * s + 8 * hh);
                        const bf16x8 qf = *(const bf16x8*)(QF + ((mp * 4 + s) * 64 + lane) * 8);
                        sc = MFMA32(ka, qf, sc);
                    }
                    __builtin_amdgcn_sched_barrier(0);
                    if (domask) {
#pragma unroll
                        for (int i = 0; i < 16; ++i) if (sub * 32 + crow32(i, hh) >= TS) sc[i] = -1e30f;
                    }
                    float mx = sc[0];
#pragma unroll
                    for (int i = 1; i < 16; ++i) mx = fmaxf(mx, sc[i]);
                    mx = fmaxf(mx, __shfl_xor(mx, 32));
                    const float mo = mp == 0 ? m1 : m2, mn = fmaxf(mo, mx), al = __builtin_amdgcn_exp2f(mo - mn);
                    float ps = 0.f;
#pragma unroll
                    for (int i = 0; i < 16; ++i) { sc[i] = __builtin_amdgcn_exp2f(sc[i] - mn); ps += sc[i]; }
                    if (mp == 0) { m1 = mn; l1 = l1 * al + ps; } else { m2 = mn; l2 = l2 * al + ps; }
                    if (__any(al < 1.f)) {
                        if (hh == 0) ALX[r] = al;
                        asm volatile("s_waitcnt lgkmcnt(0)" ::: "memory");
#pragma unroll
                        for (int g = 0; g < 4; ++g) {
                            const f32x4 a1 = *(const f32x4*)(ALX + 8 * g + 4 * hh);
#pragma unroll
                            for (int t = 0; t < 4; ++t)
#pragma unroll
                                for (int j = 0; j < 4; ++j) { if (mp == 0) O1[t][4 * g + j] *= a1[j]; else O2[t][4 * g + j] *= a1[j]; }
                        }
                        asm volatile("s_waitcnt lgkmcnt(0)" ::: "memory");
                    }
#pragma unroll
                    for (int sp = 0; sp < 2; ++sp) {
                        u32x4 a;
                        a.x = pk2(sc[8 * sp], sc[8 * sp + 1]); a.y = pk2(sc[8 * sp + 2], sc[8 * sp + 3]); a.z = pk2(sc[8 * sp + 4], sc[8 * sp + 5]); a.w = pk2(sc[8 * sp + 6], sc[8 * sp + 7]);
                        P[mp][sp] = __builtin_bit_cast(bf16x8, a);
                    }
                    __builtin_amdgcn_sched_barrier(0);
                }
#pragma unroll
                for (int sp = 0; sp < 2; ++sp)
#pragma unroll
                    for (int t = 0; t < 4; ++t) {
                        if ((t & 1) == 0) __builtin_amdgcn_sched_barrier(0);
                        const bf16x8 vb = *(const bf16x8*)(Vb + (32 * t + r) * VST + sub * 32 + (sp * 2 + hh) * 8);
                        O1[t] = MFMA32(P[0][sp], vb, O1[t]); O2[t] = MFMA32(P[1][sp], vb, O2[t]);
                    }
                if (sub == 0 && nxt) {
                    *(u32x4*)(ldn + klds) = pa; *(u32x4*)(ldn + 32 * KST * 2 + klds) = pb;
                    pa = *(const u32x4*)(vn_ + voff); pb = *(const u32x4*)(vn_ + (size_t)64 * vstride + voff);
                }
            }
        } else if (nxt) {
            *(u32x4*)(ldn + klds) = pa; *(u32x4*)(ldn + 32 * KST * 2 + klds) = pb;
            pa = *(const u32x4*)(vn_ + voff); pb = *(const u32x4*)(vn_ + (size_t)64 * vstride + voff);
        }
        if (nxt) {
            *(u32x2*)(ldv + vlds) = (u32x2){pa.x, pa.y}; *(u32x2*)(ldv + vlds + 16) = (u32x2){pa.z, pa.w};
            *(u32x2*)(ldv + 64 * VST * 2 + vlds) = (u32x2){pb.x, pb.y}; *(u32x2*)(ldv + 64 * VST * 2 + vlds + 16) = (u32x2){pb.z, pb.w};
        }
        __syncthreads();
    }
    if (active) {
        l1 += __shfl_xor(l1, 32); l2 += __shfl_xor(l2, 32);
        if (hh == 0) { ALX[r] = __builtin_amdgcn_rcpf(l1); ALX[32 + r] = *lamp * __builtin_amdgcn_rcpf(l2); }
        asm volatile("s_waitcnt lgkmcnt(0)" ::: "memory");
        float ss[16], a1[16], a2[16];
#pragma unroll
        for (int g = 0; g < 4; ++g) {
            const f32x4 x1 = *(const f32x4*)(ALX + 8 * g + 4 * hh), x2 = *(const f32x4*)(ALX + 32 + 8 * g + 4 * hh);
#pragma unroll
            for (int j = 0; j < 4; ++j) { a1[4 * g + j] = x1[j]; a2[4 * g + j] = x2[j]; ss[4 * g + j] = 0.f; }
        }
#pragma unroll
        for (int t = 0; t < 4; ++t) {
            __builtin_amdgcn_sched_barrier(0);
#pragma unroll
            for (int i = 0; i < 16; ++i) { const float o = O1[t][i] * a1[i] - O2[t][i] * a2[i]; O1[t][i] = o; ss[i] += o * o; }
        }
        __builtin_amdgcn_sched_barrier(0);
#pragma unroll
        for (int i = 0; i < 16; ++i) {
#pragma unroll
            for (int of = 1; of < 32; of <<= 1) ss[i] += __shfl_xor(ss[i], of);
            ss[i] = __builtin_amdgcn_rsqf(ss[i] * (1.f / 128.f) + 1e-6f) * (1.f - LAM_INIT);
        }
        int zo = 0; asm volatile("" : "+v"(zo));
        bf16_t* obase = (bf16_t*)(ws + WS_R2) + (qbase + 32 * w) * 1024 + 512 + h * 128;
        const unsigned ooff = (unsigned)((4 * hh + zo) * 1024 + r);
        const float* sw = p.subln_w + r + zo;
#pragma unroll
        for (int t = 0; t < 4; ++t) {
            const float wv = sw[32 * t];
#pragma unroll
            for (int i = 0; i < 16; ++i) obase[ooff + ((i & 3) + 8 * (i >> 2)) * 1024 + 32 * t] = f2bf(O1[t][i] * ss[i] * wv);
        }
    }
}

DI void mixer_phase(const Params& p) {
    const int bid = blockIdx.x;
#ifndef NO_SCAN
    if (bid < 48) { const bool sm = bid >= 16; const int j = sm ? bid - 16 : bid; gdn_scan(p, sm, j >> 2, j & 3); }
#endif
    unsigned* ctl = (unsigned*)(p.ws + WS_CTL);
    int* sidx = (int*)(dyn_smem + L_IDX);
    for (;;) {
        __syncthreads();
        if (threadIdx.x == 0) *sidx = (int)atomicAdd(ctl, 1u);
        __syncthreads();
        const int idx = __builtin_amdgcn_readfirstlane(*sidx);
        if (idx >= 32 + 512) break;
#ifndef NO_ATTN
        attn_item(p, idx, (const float*)ctl + 1);
#endif
    }
}


__global__ void __launch_bounds__(512, 2) fwd_kernel(Params p) {
    cg::grid_group grid = cg::this_grid();
    const bool all = p.phase_hi - p.phase_lo > 1;
#define PHASE(i, body) if (p.phase_lo <= (i) && (i) < p.phase_hi) { body; if (all && (i) + 1 < p.phase_hi) grid.sync(); }
    PHASE(0, phase_prep(p))
    PHASE(1, gemm_phase<1>(p))
    PHASE(2, gdn_prep_phase(p))
    PHASE(3, mixer_phase(p))
    PHASE(4, gemm_phase<2>(p))
    PHASE(5, ln_phase<0>(p))
    PHASE(6, gemm_phase<3>(p))
    PHASE(7, fixup_phase(p))
    PHASE(8, gemm_phase<4>(p))
    PHASE(9, ln_phase<1>(p))
}

extern "C" void kernel_launch(void* const* d_in, const int* in_sizes, int n_in, void* d_out, int out_size, void* d_ws, size_t ws_size, hipStream_t stream) {
    static int grid = 0;
    if (grid == 0) {
        if (n_in != 23 || (size_t)out_size != O_END || ws_size < WS_END) { fprintf(stderr, "kernel_launch: unexpected sizes n_in %d out %d ws %zu (need %zu)\n", n_in, out_size, ws_size, (size_t)WS_END); grid = -1; return; }
        int dev = 0, cus = 0, per_cu = 0;
        hipGetDevice(&dev);
        hipDeviceGetAttribute(&cus, hipDeviceAttributeMultiprocessorCount, dev);
        if (hipFuncSetAttribute((const void*)fwd_kernel, hipFuncAttributeMaxDynamicSharedMemorySize, LDS_BYTES) != hipSuccess) { fprintf(stderr, "kernel_launch: hipFuncSetAttribute failed\n"); grid = -1; return; }
        hipOccupancyMaxActiveBlocksPerMultiprocessor(&per_cu, (const void*)fwd_kernel, 512, LDS_BYTES);
        if (per_cu < 1) { fprintf(stderr, "kernel_launch: occupancy query says %d\n", per_cu); per_cu = 1; }
        (void)hipGetLastError();
        grid = cus * 1;
    }
    if (grid < 0) return;
    Params p{};
    const float** f = (const float**)&p;
    for (int i = 0; i < 23; ++i) f[i] = (const float*)d_in[i];
    p.out = (float*)d_out; p.ws = (unsigned char*)d_ws; p.phase_lo = 0; p.phase_hi = 10;
    void* args[] = {&p};
    hipError_t e = hipLaunchCooperativeKernel((const void*)fwd_kernel, dim3(grid), dim3(512), args, LDS_BYTES, stream);
    if (e != hipSuccess) fprintf(stderr, "cooperative launch failed: %s (grid %d)\n", hipGetErrorString(e), grid);
}
```

```cpp
#include <hip/hip_runtime.h>
#include <hip/hip_cooperative_groups.h>
#include <cstdio>
namespace cg = cooperative_groups;

typedef unsigned short bf16_t;
typedef short bf16x8 __attribute__((ext_vector_type(8)));
typedef short s16x4 __attribute__((ext_vector_type(4)));
typedef float f32x4 __attribute__((ext_vector_type(4)));
typedef float f32x16 __attribute__((ext_vector_type(16)));
typedef unsigned u32x4 __attribute__((ext_vector_type(4)));
typedef unsigned u32x2 __attribute__((ext_vector_type(2)));
#define DI __device__ __forceinline__

constexpr int D = 1024, TP = 8192, BP = 4, MP = BP * TP, BS = 8, TS = 32, MS = BS * TS, M = MP + MS, PAST = 4096;
constexpr int DIN = 3592, NH1 = 3584, DFF = 2816, NUP = 2 * DFF;
constexpr int TKS = 4160;
constexpr int NITEM = BP * 128 * 4 + BS * 4;
constexpr int ITEM_B = 90112;
constexpr int LDS_BYTES = 160 * 1024;
constexpr float ALPHA = 1.189207115002721f;
constexpr float LAM_INIT = 0.2f;

constexpr size_t O_Y = 0, O_KP = 33816576, O_VP = 50593792, O_GP = 67371008, O_CQP = 67633152, O_CFP = 67651584,
                 O_KS = 67696640, O_VS = 67827712, O_GS = 67958784, O_CQS = 68483072, O_CFS = 68519936, O_END = 68610048;

constexpr size_t al256(size_t x) { return (x + 255) & ~(size_t)255; }
constexpr size_t WS_CTL = 0;
constexpr size_t WS_ROPE = 4096;
constexpr size_t WS_AB = WS_ROPE + (size_t)8192 * 32 * 8;
constexpr size_t WS_DL = WS_AB + (size_t)M * 8 * 4;
constexpr size_t WS_WIN = al256(WS_DL + NITEM * 4);
constexpr size_t WS_WO = WS_WIN + (size_t)NH1 * D * 2;
constexpr size_t WS_WUP = WS_WO + (size_t)D * D * 2;
constexpr size_t WS_WDN = WS_WUP + (size_t)NUP * D * 2;
constexpr size_t WS_R1 = al256(WS_WDN + (size_t)D * DFF * 2);
constexpr size_t R1_SIZE = (size_t)NITEM * ITEM_B;
constexpr size_t WS_R2 = al256(WS_R1 + R1_SIZE);
constexpr size_t WS_R3 = al256(WS_R2 + (size_t)M * 1536 * 2);
constexpr size_t WS_R4 = WS_R3 + (size_t)M * 512 * 2;
constexpr size_t WS_R5 = al256(WS_R4 + (size_t)M * 512 * 2);
constexpr size_t KROWS = (size_t)MP + (size_t)BS * TKS;
constexpr size_t WS_R6 = al256(WS_R5 + KROWS * 512 * 2);
constexpr size_t VT_S_OFF = (size_t)BP * 4 * 128 * TP;
constexpr size_t WS_END = al256(WS_R6 + (VT_S_OFF + (size_t)BS * 4 * 128 * TKS) * 2);
static_assert((size_t)M * DFF * 2 <= R1_SIZE, "GT must fit R1");
static_assert(WS_END <= (size_t)536870912, "workspace too large");

struct Params {
    const float *x_p, *x_s, *cache_k, *cache_v, *state_gdn, *state_cq, *state_cf;
    const float *w_in, *gdn_conv_w, *a_log, *dt_bias, *gdn_norm_w, *diff_lambda, *subln_w, *w_o, *ln1_g, *ln1_b, *w_up,
        *ffn_conv_w, *ffn_conv_b, *w_down, *ln2_g, *ln2_b;
    float* out; unsigned char* ws;
    int phase_lo, phase_hi;
};

extern __shared__ __attribute__((aligned(16))) unsigned char dyn_smem[];

typedef __bf16 bf16x2_t __attribute__((ext_vector_type(2)));
typedef float f32x2 __attribute__((ext_vector_type(2)));
DI unsigned pk2(float lo, float hi) { f32x2 v = {lo, hi}; bf16x2_t b = __builtin_convertvector(v, bf16x2_t); return __builtin_bit_cast(unsigned, b); }
DI bf16_t f2bf(float x) { return (bf16_t)(pk2(x, 0.f) & 0xffffu); }
DI float bf2f(bf16_t b) { return __uint_as_float(((unsigned)b) << 16); }
DI float bflo(unsigned u) { return __uint_as_float(u << 16); }
DI float bfhi(unsigned u) { return __uint_as_float(u & 0xffff0000u); }
DI float silu(float x) { return x / (1.f + __expf(-x)); }
DI int opaque_tid() { int t = threadIdx.x; asm volatile("" : "+v"(t)); return t; }
DI float wave_sum(float v) {
#pragma unroll
    for (int o = 1; o < 64; o <<= 1) v += __shfl_xor(v, o);
    return v;
}
DI const float* xrow_ptr(const Params& p, int row) { return row < MP ? p.x_p + (size_t)row * D : p.x_s + (size_t)(row - MP) * D; }

template <int MODE> DI int srccol(int n) {
    if (MODE == 1) {
        if (n < 2048) return n;
        return n + 8;
    }
    if (MODE == 2) { const int pn = n >> 8, j = n & 255; return j < 128 ? 128 * pn + j : DFF + 128 * pn + (j - 128); }
    return n;
}
struct TrItem { const float* W; bf16_t* WT; int K, N, k0, n0, mode; };
DI TrItem tr_decode(const Params& p, int it) {
    constexpr int I_IN = 16 * 56, I_O = 16 * 16, I_UP = 16 * 88;
    unsigned char* ws = p.ws; TrItem t; int r = it;
    if (r < I_IN) { t.W = p.w_in; t.WT = (bf16_t*)(ws + WS_WIN); t.K = D; t.N = DIN; t.k0 = (r / 56) * 64; t.n0 = (r % 56) * 64; t.mode = 1; return t; } r -= I_IN;
    if (r < I_O) { t.W = p.w_o; t.WT = (bf16_t*)(ws + WS_WO); t.K = D; t.N = D; t.k0 = (r / 16) * 64; t.n0 = (r % 16) * 64; t.mode = 0; return t; } r -= I_O;
    if (r < I_UP) { t.W = p.w_up; t.WT = (bf16_t*)(ws + WS_WUP); t.K = D; t.N = NUP; t.k0 = (r / 88) * 64; t.n0 = (r % 88) * 64; t.mode = 2; return t; } r -= I_UP;
    t.W = p.w_down; t.WT = (bf16_t*)(ws + WS_WDN); t.K = DFF; t.N = D; t.k0 = (r / 16) * 64; t.n0 = (r % 16) * 64; t.mode = 0; return t;
}
DI void tr_load(const TrItem& t, float (&v)[8]) {
    const int tid = threadIdx.x, n = t.n0 + (tid & 63);
    const int sc = t.mode == 1 ? (n < 2048 ? n : n + 8) : (t.mode == 2 ? srccol<2>(n) : n);
#pragma unroll
    for (int i = 0; i < 8; ++i) v[i] = t.W[(size_t)(t.k0 + (tid >> 6) + 8 * i) * t.N + sc];
}
DI void phase_prep(const Params& p) {
    const int tid = threadIdx.x, lane = tid & 63, wave = tid >> 6, nb = gridDim.x, bid = blockIdx.x;
    unsigned char* ws = p.ws;
    if (bid == 0 && tid < 64) {
        unsigned* ctl = (unsigned*)(ws + WS_CTL);
        float a = p.diff_lambda[lane] * p.diff_lambda[64 + lane], b = p.diff_lambda[128 + lane] * p.diff_lambda[192 + lane];
        a = wave_sum(a); b = wave_sum(b);
        if (lane == 0) { ctl[0] = 0u; ((float*)ctl)[1] = expf(a) - expf(b) + LAM_INIT; }
    }
    {
        constexpr int NT = 16 * 56 + 16 * 16 + 16 * 88 + 44 * 16;
        float* lds = (float*)dyn_smem;
        float v[8];
        TrItem cur = tr_decode(p, bid < NT ? bid : 0);
        if (bid < NT) tr_load(cur, v);
        for (int it = bid; it < NT; it += nb) {
            float nv[8]; TrItem nx = cur;
            if (it + nb < NT) { nx = tr_decode(p, it + nb); tr_load(nx, nv); }
#pragma unroll
            for (int i = 0; i < 8; ++i) lds[((tid >> 6) + 8 * i) * 65 + (tid & 63)] = v[i];
            __syncthreads();
#pragma unroll
            for (int i = 0; i < 8; ++i) { const int nn = (tid >> 6) + 8 * i, kk = tid & 63; cur.WT[(size_t)(cur.n0 + nn) * cur.K + cur.k0 + kk] = f2bf(lds[kk * 65 + nn]); }
            __syncthreads();
#pragma unroll
            for (int i = 0; i < 8; ++i) v[i] = nv[i];
            cur = nx;
        }
    }
    {
        float2* rope = (float2*)(ws + WS_ROPE);
        for (int idx = bid * 512 + tid; idx < 8192 * 32; idx += nb * 512) {
            const int pos = idx >> 5, d = idx & 31;
            const double inv = exp(-(double)d * (9.210340371976184 / 32.0));
            double a = (double)pos * inv;
            a -= 6.283185307179586 * rint(a * 0.15915494309189535);
            const float af = (float)a;
            rope[idx] = make_float2(__cosf(af), __sinf(af));
        }
    }
    {
        float* w8 = (float*)dyn_smem;
        __syncthreads();
        for (int i = tid; i < 1024 * 8; i += 512) w8[i] = p.w_in[(size_t)(i >> 3) * DIN + 2048 + (i & 7)];
        __syncthreads();
        bf16_t* XB = (bf16_t*)(ws + WS_R1);
        float* AB = (float*)(ws + WS_AB);
        f32x4 cv[4];
        {
            const int row = bid * 8 + wave;
            if (row < M) { const float* xr = xrow_ptr(p, row);
#pragma unroll
                for (int j = 0; j < 4; ++j) cv[j] = *(const f32x4*)(xr + lane * 4 + 256 * j); }
        }
        for (int row = bid * 8 + wave; row < M; row += nb * 8) {
            f32x4 nvx[4];
            if (row + nb * 8 < M) { const float* xn = xrow_ptr(p, row + nb * 8);
#pragma unroll
                for (int j = 0; j < 4; ++j) nvx[j] = *(const f32x4*)(xn + lane * 4 + 256 * j); }
            float acc[8];
#pragma unroll
            for (int c = 0; c < 8; ++c) acc[c] = 0.f;
#pragma unroll
            for (int j = 0; j < 4; ++j) {
                const int k0 = lane * 4 + 256 * j;
                const f32x4 v = cv[j];
                u32x2 o; o.x = pk2(v.x, v.y); o.y = pk2(v.z, v.w);
                *(u32x2*)(XB + (size_t)row * D + k0) = o;
#pragma unroll
                for (int e = 0; e < 4; ++e) {
                    const f32x4 wa = *(const f32x4*)(w8 + (k0 + e) * 8), wb = *(const f32x4*)(w8 + (k0 + e) * 8 + 4);
                    const float xv = v[e];
                    acc[0] += xv * wa.x; acc[1] += xv * wa.y; acc[2] += xv * wa.z; acc[3] += xv * wa.w;
                    acc[4] += xv * wb.x; acc[5] += xv * wb.y; acc[6] += xv * wb.z; acc[7] += xv * wb.w;
                }
            }
#pragma unroll
            for (int c = 0; c < 8; ++c) acc[c] = wave_sum(acc[c]);
            if (lane == 0) { *(f32x4*)(AB + (size_t)row * 8) = (f32x4){acc[0], acc[1], acc[2], acc[3]}; *(f32x4*)(AB + (size_t)row * 8 + 4) = (f32x4){acc[4], acc[5], acc[6], acc[7]}; }
#pragma unroll
            for (int j = 0; j < 4; ++j) cv[j] = nvx[j];
        }
        __syncthreads();
    }
    {
        bf16_t* KALL = (bf16_t*)(ws + WS_R5);
        const int nchunk = BS * TKS * 64;
        for (int c0 = bid * 512 + tid; c0 < nchunk; c0 += nb * 512 * 4) {
            f32x4 v0[4], v1[4]; int st[4]; size_t dsto[4];
#pragma unroll
            for (int u = 0; u < 4; ++u) {
                const int c = c0 + u * nb * 512;
                st[u] = 0;
                if (c < nchunk) {
                    const int col8 = c & 63, r = c >> 6, b = r / TKS, pp = r % TKS;
                    dsto[u] = ((size_t)MP + (size_t)b * TKS + pp) * 512 + col8 * 8;
                    if (pp < PAST) { const float* sp = p.cache_k + ((size_t)(b * PAST + pp) * 512 + col8 * 8); v0[u] = *(const f32x4*)sp; v1[u] = *(const f32x4*)(sp + 4); st[u] = 1; }
                    else if (pp >= PAST + TS) st[u] = 2;
                }
            }
#pragma unroll
            for (int u = 0; u < 4; ++u) {
                if (st[u] == 1) { u32x4 o; o.x = pk2(v0[u].x, v0[u].y); o.y = pk2(v0[u].z, v0[u].w); o.z = pk2(v1[u].x, v1[u].y); o.w = pk2(v1[u].z, v1[u].w); *(u32x4*)(KALL + dsto[u]) = o; }
                else if (st[u] == 2) *(u32x4*)(KALL + dsto[u]) = (u32x4){0u, 0u, 0u, 0u};
            }
        }
    }
    {
        bf16_t* VTS = (bf16_t*)(ws + WS_R6) + VT_S_OFF;
        bf16_t* t = (bf16_t*)dyn_smem;
        f32x4 cvv[4];
        auto ldv = [&](int it, f32x4 (&v)[4]) {
            const int blk = it % 65, bh = it / 65, b = bh >> 2, h = bh & 3;
            if (blk < 64) {
#pragma unroll
                for (int i = 0; i < 4; ++i) { const int id = tid + 512 * i, key = id >> 5, c4 = id & 31;
                    v[i] = *(const f32x4*)(p.cache_v + ((size_t)(b * PAST + blk * 64 + key) * 512 + h * 128 + c4 * 4)); }
            }
        };
        if (bid < BS * 4 * 65) ldv(bid, cvv);
        for (int it = bid; it < BS * 4 * 65; it += nb) {
            const int blk = it % 65, bh = it / 65;
            f32x4 nvv[4];
            if (it + nb < BS * 4 * 65) ldv(it + nb, nvv);
            if (blk < 64) {
                __syncthreads();
#pragma unroll
                for (int i = 0; i < 4; ++i) {
                    const int id = tid + 512 * i, key = id >> 5, c4 = id & 31;
                    const f32x4 v = cvv[i];
                    bf16_t* d = t + key * 130 + c4 * 4;
                    *(unsigned*)d = pk2(v.x, v.y); *(unsigned*)(d + 2) = pk2(v.z, v.w);
                }
                __syncthreads();
                const int dv = tid >> 2, part = tid & 3;
                unsigned o[8];
#pragma unroll
                for (int i = 0; i < 8; ++i) { const int k0 = part * 16 + 2 * i; o[i] = (unsigned)t[k0 * 130 + dv] | ((unsigned)t[(k0 + 1) * 130 + dv] << 16); }
                bf16_t* dst = VTS + ((size_t)(bh * 128 + dv) * TKS + blk * 64 + part * 16);
                *(u32x4*)dst = (u32x4){o[0], o[1], o[2], o[3]}; *(u32x4*)(dst + 8) = (u32x4){o[4], o[5], o[6], o[7]};
            } else {
                if (tid < 128) { bf16_t* dst = VTS + ((size_t)(bh * 128 + tid) * TKS + PAST + TS);
#pragma unroll
                    for (int i = 0; i < 4; ++i) *(u32x4*)(dst + 8 * i) = (u32x4){0u, 0u, 0u, 0u}; }
            }
#pragma unroll
            for (int i = 0; i < 4; ++i) cvv[i] = nvv[i];
        }
        __syncthreads();
    }
}

constexpr int BM = 256, BK = 64, HALF = 128, NXCD = 8, WGM = 8, HT = HALF * BK;
DI void stage_rc(int b, int& R, int& C) {
    const int st = b / 1024, sb = b % 1024, swz = sb ^ (((sb >> 9) & 1) << 5);
    R = (st >> 1) * 16 + swz / 64; C = (st & 1) * 32 + (swz % 64) / 2;
}
DI int lds_byte(int r, int c) {
    const int st = (r >> 4) * 2 + (c >> 5), rr = r & 15, cc = c & 31, ob = rr * 64 + cc * 2;
    return st * 1024 + (ob ^ (((ob >> 9) & 1) << 5));
}

#define SHM ((bf16_t*)dyn_smem)
#define SA(b, h) (SHM + ((b) * 2 + (h)) * HT)
#define SB(b, h) (SHM + (4 + (b) * 2 + (h)) * HT)
#define STAGE(P, BASE, br, kt) do { const bf16_t* _gb = (BASE) + ((long)(br) * K + (long)(kt) * BK); \
      __builtin_amdgcn_global_load_lds((const unsigned*)(_gb + so0), (unsigned*)((char*)(P) + threadIdx.x * 16), 16, 0, 0); \
      __builtin_amdgcn_global_load_lds((const unsigned*)(_gb + 64 * K + so0), (unsigned*)((char*)(P) + threadIdx.x * 16 + 8192), 16, 0, 0); } while (0)
#define LDA(dst, b, h) for (int m = 0; m < 4; ++m) for (int k = 0; k < 2; ++k) \
    dst[m][k] = *reinterpret_cast<const bf16x8*>((char*)SA(b, h) + lds_byte(wr * 64 + m * 16 + fr, k * 32 + fq * 8))
#define LDB(dst, b, h) for (int n = 0; n < 2; ++n) for (int k = 0; k < 2; ++k) \
    dst[n][k] = *reinterpret_cast<const bf16x8*>((char*)SB(b, h) + lds_byte(wc * 32 + n * 16 + fr, k * 32 + fq * 8))
#define MMA(ai, bj, At, Bt_) do { __builtin_amdgcn_s_setprio(1); \
    for (int m = 0; m < 4; ++m) for (int n = 0; n < 2; ++n) for (int k = 0; k < 2; ++k) \
      acc[ai][bj][m][n] = __builtin_amdgcn_mfma_f32_16x16x32_bf16(At[m][k], Bt_[n][k], acc[ai][bj][m][n], 0, 0, 0); \
    __builtin_amdgcn_s_setprio(0); } while (0)
#define WAIT_V(n) asm volatile("s_waitcnt vmcnt(" #n ")" ::: "memory")
#define WAIT_L(n) asm volatile("s_waitcnt lgkmcnt(" #n ")" ::: "memory")
#define BAR __builtin_amdgcn_s_barrier()
#define SCHED __builtin_amdgcn_sched_barrier(0)

template <int K> DI void gemm_tile(const bf16_t* __restrict__ A, const bf16_t* __restrict__ Bt, const int brow, const int bcol, f32x4 (&acc)[2][2][4][2]) {
    const int wid = threadIdx.x >> 6, lane = threadIdx.x & 63, wr = wid >> 2, wc = wid & 3, fr = lane & 15, fq = lane >> 4;
    unsigned so0;
    { int _r, _c; stage_rc(threadIdx.x * 16, _r, _c); so0 = (unsigned)(_r * K + _c); }
#pragma unroll
    for (int a = 0; a < 2; ++a)
#pragma unroll
        for (int b = 0; b < 2; ++b)
#pragma unroll
            for (int m = 0; m < 4; ++m)
#pragma unroll
                for (int n = 0; n < 2; ++n) acc[a][b][m][n] = (f32x4){0.f, 0.f, 0.f, 0.f};
    bf16x8 At[4][2], B0[2][2], B1[2][2];
    constexpr int nt = K / BK;
    STAGE(SB(0, 0), Bt, bcol, 0); STAGE(SA(0, 0), A, brow, 0);
    STAGE(SB(0, 1), Bt, bcol + HALF, 0); STAGE(SA(0, 1), A, brow + HALF, 0);
    if (wr == 1) BAR;
    WAIT_V(4); BAR;
    STAGE(SB(1, 0), Bt, bcol, 1); STAGE(SA(1, 0), A, brow, 1); STAGE(SB(1, 1), Bt, bcol + HALF, 1);
    WAIT_V(6); BAR;
    for (int t = 0; t < nt - 2; t += 2) {
        LDB(B0, 0, 0); SCHED; LDA(At, 0, 0); STAGE(SA(1, 1), A, brow + HALF, t + 1);
        WAIT_L(8); BAR; WAIT_L(0); MMA(0, 0, At, B0); BAR; SCHED;
        LDB(B1, 0, 1); STAGE(SB(0, 0), Bt, bcol, t + 2);
        BAR; WAIT_L(0); MMA(0, 1, At, B1); BAR;
        LDA(At, 0, 1); STAGE(SA(0, 0), A, brow, t + 2);
        BAR; WAIT_L(0); MMA(1, 0, At, B0); BAR; SCHED;
        STAGE(SB(0, 1), Bt, bcol + HALF, t + 2);
        WAIT_V(6); BAR; MMA(1, 1, At, B1); BAR;
        LDB(B0, 1, 0); SCHED; LDA(At, 1, 0); STAGE(SA(0, 1), A, brow + HALF, t + 2);
        WAIT_L(8); BAR; WAIT_L(0); MMA(0, 0, At, B0); BAR; SCHED;
        LDB(B1, 1, 1); STAGE(SB(1, 0), Bt, bcol, t + 3);
        BAR; WAIT_L(0); MMA(0, 1, At, B1); BAR;
        LDA(At, 1, 1); STAGE(SA(1, 0), A, brow, t + 3);
        BAR; WAIT_L(0); MMA(1, 0, At, B0); BAR; SCHED;
        STAGE(SB(1, 1), Bt, bcol + HALF, t + 3);
        WAIT_V(6); BAR; MMA(1, 1, At, B1); BAR;
    }
    { LDB(B0, 0, 0); LDA(At, 0, 0); STAGE(SA(1, 1), A, brow + HALF, nt - 1);
      BAR; WAIT_L(0); MMA(0, 0, At, B0); BAR;
      LDB(B1, 0, 1); BAR; WAIT_L(0); MMA(0, 1, At, B1); BAR;
      LDA(At, 0, 1); WAIT_V(4); BAR; WAIT_L(0); MMA(1, 0, At, B0); MMA(1, 1, At, B1); BAR; }
    { LDB(B0, 1, 0); LDA(At, 1, 0); WAIT_V(2); BAR; WAIT_L(0); MMA(0, 0, At, B0); BAR;
      LDB(B1, 1, 1); WAIT_V(0); BAR; WAIT_L(0); MMA(0, 1, At, B1); BAR;
      LDA(At, 1, 1); BAR; WAIT_L(0); MMA(1, 0, At, B0); MMA(1, 1, At, B1); BAR; }
    if (wr == 0) BAR;
}

DI void tile_of(int L, int nM, int nN, int& pm, int& pn) {
    const int nwg = nM * nN; int wgid = L;
    { const int q = nwg / NXCD, r = nwg % NXCD, xcd = wgid % NXCD, off = wgid / NXCD; wgid = (xcd < r ? xcd * (q + 1) : r * (q + 1) + (xcd - r) * q) + off; }
    const int nig = WGM * nN, gid = wgid / nig, fm = gid * WGM, gsz = min(nM - fm, WGM);
    pm = fm + ((wgid % nig) % gsz); pn = (wgid % nig) / gsz;
}

constexpr int CST = 260;
DI void stage_half(const f32x4 (&acc)[2][2][4][2], const int ai) {
    const int tid_ = opaque_tid(), wid = tid_ >> 6, lane = tid_ & 63, wr = wid >> 2, wc = wid & 3, fr = lane & 15, fq = lane >> 4;
    float* base = (float*)dyn_smem + (wr * 64 + fq * 4) * CST + wc * 32 + fr;
#pragma unroll
    for (int m = 0; m < 4; ++m)
#pragma unroll
        for (int j = 0; j < 4; ++j)
#pragma unroll
            for (int bj = 0; bj < 2; ++bj)
#pragma unroll
                for (int n = 0; n < 2; ++n) base[(m * 16 + j) * CST + bj * 128 + n * 16] = ai == 0 ? acc[0][bj][m][n][j] : acc[1][bj][m][n][j];
}
#define CT ((const float*)dyn_smem)

DI void epi_in_half(const Params& p, int pm, int pn, int ai) {
    unsigned char* ws = p.ws;
    const int tid = opaque_tid(), brow = pm * BM + ai * 128, bcol = pn * BM;
    const bool samp = pm == 128;
    if (pn < 8) {
        bf16_t* dst = pn < 6 ? (bf16_t*)(ws + WS_R2) : (bf16_t*)(ws + WS_R3);
        const int ld = pn < 6 ? 1536 : 512, c0 = pn < 6 ? bcol : bcol - 1536;
#pragma unroll 4
        for (int i = 0; i < 16; ++i) {
            const int id = tid + 512 * i, r = id >> 6, c4 = (id & 63) * 4, row = brow + r;
            const f32x4 v = *(const f32x4*)(CT + r * CST + c4);
            u32x2 o; o.x = pk2(v.x, v.y); o.y = pk2(v.z, v.w);
            *(u32x2*)(dst + (size_t)row * ld + c0 + c4) = o;
            if (pn < 6) {
                if (!samp) { const int t = row & (TP - 1); if (t >= TP - 3) *(f32x4*)(p.out + O_CQP + (size_t)((row >> 13) * 3 + t - (TP - 3)) * 1536 + c0 + c4) = v; }
                else { const int rr = row - MP, t = rr & 31; if (t >= TS - 3) *(f32x4*)(p.out + O_CQS + (size_t)((rr >> 5) * 3 + t - (TS - 3)) * 1536 + c0 + c4) = v; }
            }
        }
        return;
    }
    if (pn < 12) {
        const bool isq = pn < 10;
        const float* rope = (const float*)(ws + WS_ROPE);
        bf16_t* QB = (bf16_t*)(ws + WS_R4); bf16_t* KALL = (bf16_t*)(ws + WS_R5);
        const float qs = 0.125f * 1.4426950408889634f;
#pragma unroll 2
        for (int i = 0; i < 8; ++i) {
            const int id = tid + 512 * i, r = id >> 5, q = id & 31, hl = q >> 4, map = (q >> 3) & 1, d4 = (q & 7) * 4, row = brow + r;
            const int cl = hl * 128 + map * 64 + d4, col = ((pn & 1) * 2 + hl) * 128 + map * 64 + d4;
            const f32x4 x1 = *(const f32x4*)(CT + r * CST + cl), x2 = *(const f32x4*)(CT + r * CST + cl + 32);
            int pos; size_t krow; float* kout;
            if (!samp) { pos = row & (TP - 1); krow = row; kout = p.out + O_KP + (size_t)row * 512; }
            else { const int rr = row - MP; pos = PAST + (rr & 31); krow = (size_t)MP + (size_t)(rr >> 5) * TKS + pos; kout = p.out + O_KS + (size_t)rr * 512; }
            const f32x4 t0 = *(const f32x4*)(rope + (size_t)(pos * 32 + d4) * 2), t1 = *(const f32x4*)(rope + (size_t)(pos * 32 + d4) * 2 + 4);
            const f32x4 cs = (f32x4){t0.x, t0.z, t1.x, t1.z}, sn = (f32x4){t0.y, t0.w, t1.y, t1.w};
            const f32x4 y1 = x1 * cs - x2 * sn, y2 = x2 * cs + x1 * sn;
            if (isq) {
                u32x2 o1, o2; o1.x = pk2(y1.x * qs, y1.y * qs); o1.y = pk2(y1.z * qs, y1.w * qs); o2.x = pk2(y2.x * qs, y2.y * qs); o2.y = pk2(y2.z * qs, y2.w * qs);
                *(u32x2*)(QB + (size_t)row * 512 + col) = o1; *(u32x2*)(QB + (size_t)row * 512 + col + 32) = o2;
            } else {
                *(f32x4*)(kout + col) = y1; *(f32x4*)(kout + col + 32) = y2;
                u32x2 o1, o2; o1.x = pk2(y1.x, y1.y); o1.y = pk2(y1.z, y1.w); o2.x = pk2(y2.x, y2.y); o2.y = pk2(y2.z, y2.w);
                *(u32x2*)(KALL + krow * 512 + col) = o1; *(u32x2*)(KALL + krow * 512 + col + 32) = o2;
            }
        }
        return;
    }
    {
        bf16_t* VT = (bf16_t*)(ws + WS_R6);
#pragma unroll 4
        for (int i = 0; i < 16; ++i) {
            const int id = tid + 512 * i, r = id >> 6, c4 = (id & 63) * 4, row = brow + r, col = (pn & 1) * 256 + c4;
            const f32x4 v = *(const f32x4*)(CT + r * CST + c4);
            float* vout = samp ? p.out + O_VS + (size_t)(row - MP) * 512 + col : p.out + O_VP + (size_t)row * 512 + col;
            *(f32x4*)vout = v;
        }
#pragma unroll 1
        for (int i = 0; i < 2; ++i) {
            const int id = tid + 512 * i, rg = id >> 6, c4 = (id & 63) * 4, row0 = brow + rg * 8;
            f32x4 v[8];
#pragma unroll
            for (int e = 0; e < 8; ++e) v[e] = *(const f32x4*)(CT + (rg * 8 + e) * CST + c4);
#pragma unroll
            for (int e = 0; e < 4; ++e) {
                const int colg = (pn & 1) * 256 + c4 + e, head = colg >> 7, dv = colg & 127;
                u32x4 o; o.x = pk2(v[0][e], v[1][e]); o.y = pk2(v[2][e], v[3][e]); o.z = pk2(v[4][e], v[5][e]); o.w = pk2(v[6][e], v[7][e]);
                bf16_t* d;
                if (samp) { const int rr = row0 - MP; d = VT + VT_S_OFF + ((size_t)(((rr >> 5) * 4 + head) * 128 + dv) * TKS + PAST + (rr & 31)); }
                else d = VT + ((size_t)(((row0 >> 13) * 4 + head) * 128 + dv) * TP + (row0 & (TP - 1)));
                *(u32x4*)d = o;
            }
        }
    }
}

template <int WHICH> DI void epi_res_half(const Params& p, int pm, int pn, int ai) {
    const int tid = opaque_tid(), brow = pm * BM + ai * 128, bcol = pn * BM;
#pragma unroll 4
    for (int i = 0; i < 16; ++i) {
        const int id = tid + 512 * i, r = id >> 6, c4 = (id & 63) * 4, row = brow + r;
        const f32x4 v = *(const f32x4*)(CT + r * CST + c4);
        float* o = p.out + O_Y + (size_t)row * D + bcol + c4;
        const float* rs = WHICH == 0 ? xrow_ptr(p, row) + bcol + c4 : o;
        const f32x4 x = *(const f32x4*)rs;
        *(f32x4*)o = x * ALPHA + v;
    }
}

constexpr int UST = 264;
DI void epi_up(const Params& p, const f32x4 (&acc)[2][2][4][2], int pm, int pn) {
    unsigned char* ws = p.ws;
    bf16_t* U = (bf16_t*)dyn_smem;
    float* BND = (float*)(ws + WS_R5);
    const bool samp = pm == 128;
    const int brow = pm * BM, tid = opaque_tid();
    {
        const int wid = tid >> 6, lane = tid & 63, wr = wid >> 2, wc = wid & 3, fr = lane & 15, fq = lane >> 4;
        bf16_t* base = U + (wr * 64 + fq * 4) * UST + wc * 32 + fr;
#pragma unroll
        for (int ai = 0; ai < 2; ++ai)
#pragma unroll
            for (int m = 0; m < 4; ++m)
#pragma unroll
                for (int j = 0; j < 4; ++j)
#pragma unroll
                    for (int bj = 0; bj < 2; ++bj)
#pragma unroll
                        for (int n = 0; n < 2; ++n) base[(ai * 128 + m * 16 + j) * UST + bj * 128 + n * 16] = f2bf(acc[ai][bj][m][n][j]);
    }
    __syncthreads();
    {
        const int nb = samp ? 32 * 256 : 4 * 256;
        for (int id = tid; id < nb; id += 512) {
            const int cl = id & 255, q = id >> 8;
            const int oc = (cl >> 7) * DFF + 128 * pn + (cl & 127);
            int rr, bslot, u;
            if (!samp) { bslot = q; rr = q < 2 ? q : 252 + q; u = pm; }
            else { bslot = q & 3; rr = (q >> 2) * 32 + (bslot < 2 ? bslot : 28 + bslot); u = 128 + (q >> 2); }
            const float v = bf2f(U[rr * UST + cl]);
            BND[((size_t)u * 4 + bslot) * NUP + oc] = v;
            if (bslot >= 2) {
                if (samp) p.out[O_CFS + (size_t)((q >> 2) * 2 + bslot - 2) * NUP + oc] = v;
                else if ((pm & 31) == 31) p.out[O_CFP + (size_t)((pm >> 5) * 2 + bslot - 2) * NUP + oc] = v;
            }
        }
    }
    {
        const int c = tid & 127, rs = tid >> 7, cg_ = 128 * pn + c, cv_ = DFF + 128 * pn + c;
        const float wg0 = p.ffn_conv_w[cg_], wg1 = p.ffn_conv_w[NUP + cg_], wg2 = p.ffn_conv_w[2 * NUP + cg_], bg = p.ffn_conv_b[cg_];
        const float wv0 = p.ffn_conv_w[cv_], wv1 = p.ffn_conv_w[NUP + cv_], wv2 = p.ffn_conv_w[2 * NUP + cv_], bv = p.ffn_conv_b[cv_];
        bf16_t* GT = (bf16_t*)(ws + WS_R1);
        const int r0 = rs * 64;
        float g1 = 0.f, g2 = 0.f, v1 = 0.f, v2 = 0.f;
        if (r0 >= 2) { g1 = bf2f(U[(r0 - 2) * UST + c]); g2 = bf2f(U[(r0 - 1) * UST + c]); v1 = bf2f(U[(r0 - 2) * UST + 128 + c]); v2 = bf2f(U[(r0 - 1) * UST + 128 + c]); }
#pragma unroll 4
        for (int r = r0; r < r0 + 64; ++r) {
            const float g3 = bf2f(U[r * UST + c]), v3 = bf2f(U[r * UST + 128 + c]);
            const bool skip = samp ? ((r & 31) < 2) : (r < 2);
            if (!skip) {
                const float cg2 = wg0 * g1 + wg1 * g2 + wg2 * g3 + bg, cv2 = wv0 * v1 + wv1 * v2 + wv2 * v3 + bv;
                GT[(size_t)(brow + r) * DFF + 128 * pn + c] = f2bf(silu(cg2) * cv2);
            }
            g1 = g2; g2 = g3; v1 = v2; v2 = v3;
        }
    }
}

template <int WHICH> DI void gemm_phase(const Params& p) {
    unsigned char* ws = p.ws;
    const bf16_t* A; const bf16_t* Bt; int N; constexpr int K = WHICH == 4 ? DFF : D;
    if (WHICH == 1) { A = (const bf16_t*)(ws + WS_R1); Bt = (const bf16_t*)(ws + WS_WIN); N = NH1; }
    else if (WHICH == 2) { A = (const bf16_t*)(ws + WS_R2); Bt = (const bf16_t*)(ws + WS_WO); N = D; }
    else if (WHICH == 3) { A = (const bf16_t*)(ws + WS_R3); Bt = (const bf16_t*)(ws + WS_WUP); N = NUP; }
    else { A = (const bf16_t*)(ws + WS_R1); Bt = (const bf16_t*)(ws + WS_WDN); N = D; }
    const int nM = M / BM, nN = N / BM, ntile = nM * nN;
    for (int L = blockIdx.x; L < ntile; L += gridDim.x) {
        int pm, pn; tile_of(L, nM, nN, pm, pn);
        f32x4 acc[2][2][4][2];
        gemm_tile<K>(A, Bt, pm * BM, pn * BM, acc);
        if (WHICH == 3) epi_up(p, acc, pm, pn);
        else {
#pragma unroll
            for (int ai = 0; ai < 2; ++ai) {
                stage_half(acc, ai);
                __syncthreads();
                if (WHICH == 1) epi_in_half(p, pm, pn, ai);
                else if (WHICH == 2) epi_res_half<0>(p, pm, pn, ai);
                else epi_res_half<1>(p, pm, pn, ai);
                __syncthreads();
            }
        }
        __syncthreads();
    }
}

template <int WHICH> DI void ln_phase(const Params& p) {
    const int lane = threadIdx.x & 63, wave = threadIdx.x >> 6;
    const float* g = WHICH == 0 ? p.ln1_g : p.ln2_g; const float* b = WHICH == 0 ? p.ln1_b : p.ln2_b;
    bf16_t* X1B = (bf16_t*)(p.ws + WS_R3);
    f32x4 gv[4], bv[4];
#pragma unroll
    for (int j = 0; j < 4; ++j) { gv[j] = *(const f32x4*)(g + lane * 4 + 256 * j); bv[j] = *(const f32x4*)(b + lane * 4 + 256 * j); }
    for (int row = blockIdx.x * 8 + wave; row < M; row += gridDim.x * 8) {
        float* xr = p.out + O_Y + (size_t)row * D;
        f32x4 v[4]; float s = 0.f;
#pragma unroll
        for (int j = 0; j < 4; ++j) { v[j] = *(const f32x4*)(xr + lane * 4 + 256 * j); s += (v[j].x + v[j].y) + (v[j].z + v[j].w); }
        const float mean = wave_sum(s) * (1.f / D); float s2 = 0.f;
#pragma unroll
        for (int j = 0; j < 4; ++j) { v[j] = v[j] - mean; s2 += (v[j].x * v[j].x + v[j].y * v[j].y) + (v[j].z * v[j].z + v[j].w * v[j].w); }
        const float rstd = rsqrtf(wave_sum(s2) * (1.f / D) + 1e-5f);
#pragma unroll
        for (int j = 0; j < 4; ++j) {
            const f32x4 o = v[j] * rstd * gv[j] + bv[j];
            *(f32x4*)(xr + lane * 4 + 256 * j) = o;
            if (WHICH == 0) { u32x2 q; q.x = pk2(o.x, o.y); q.y = pk2(o.z, o.w); *(u32x2*)(X1B + (size_t)row * D + lane * 4 + 256 * j) = q; }
        }
    }
}

DI void fixup_phase(const Params& p) {
    const float* BND = (const float*)(p.ws + WS_R5);
    bf16_t* GT = (bf16_t*)(p.ws + WS_R1);
    const int total = (128 + 8) * 2 * DFF;
    for (int idx = blockIdx.x * 512 + threadIdx.x; idx < total; idx += gridDim.x * 512) {
        const int c = idx % DFF, q = idx / DFF, r = q & 1, u = q >> 1;
        const float* cur = BND + (size_t)u * 4 * NUP;
        float pg[2], pv[2];
        if (u < 128) {
            if ((u & 31) == 0) { pg[0] = pg[1] = pv[0] = pv[1] = 0.f; }
            else { const float* pr = BND + (size_t)(u - 1) * 4 * NUP; pg[0] = pr[2 * NUP + c]; pg[1] = pr[3 * NUP + c]; pv[0] = pr[2 * NUP + DFF + c]; pv[1] = pr[3 * NUP + DFF + c]; }
        } else { const float* st = p.state_cf + (size_t)(u - 128) * 2 * NUP; pg[0] = st[c]; pg[1] = st[NUP + c]; pv[0] = st[DFF + c]; pv[1] = st[NUP + DFF + c]; }
        const float cg0 = cur[c], cg1 = cur[NUP + c], cv0 = cur[DFF + c], cv1 = cur[NUP + DFF + c];
        const float wg0 = p.ffn_conv_w[c], wg1 = p.ffn_conv_w[NUP + c], wg2 = p.ffn_conv_w[2 * NUP + c], bg = p.ffn_conv_b[c];
        const float wv0 = p.ffn_conv_w[DFF + c], wv1 = p.ffn_conv_w[NUP + DFF + c], wv2 = p.ffn_conv_w[2 * NUP + DFF + c], bv = p.ffn_conv_b[DFF + c];
        float g, v;
        if (r == 0) { g = wg0 * pg[0] + wg1 * pg[1] + wg2 * cg0 + bg; v = wv0 * pv[0] + wv1 * pv[1] + wv2 * cv0 + bv; }
        else { g = wg0 * pg[1] + wg1 * cg0 + wg2 * cg1 + bg; v = wv0 * pv[1] + wv1 * cv0 + wv2 * cv1 + bv; }
        const size_t row = u < 128 ? (size_t)u * 256 + r : (size_t)MP + (size_t)(u - 128) * 32 + r;
        GT[row * DFF + c] = f2bf(silu(g) * v);
    }
}

#define MFMA16(a, b, c) __builtin_amdgcn_mfma_f32_16x16x32_bf16((a), (b), (c), 0, 0, 0)
#define MFMA32(a, b, c) __builtin_amdgcn_mfma_f32_32x32x16_bf16((a), (b), (c), 0, 0, 0)
DI bf16x8 pack8(const f32x4 a, const f32x4 b) { u32x4 o; o.x = pk2(a.x, a.y); o.y = pk2(a.z, a.w); o.z = pk2(b.x, b.y); o.w = pk2(b.z, b.w); return __builtin_bit_cast(bf16x8, o); }
constexpr float GSCALE = 0.08838834764831845f;
constexpr int QST = 132, AST = 68, NST = 136, QKST = 72;
constexpr int L_QKV = 0, L_AM = 3 * 64 * QST * 4, L_KN = L_AM + 64 * AST * 4, L_QN = L_KN + 64 * NST * 2, L_GC = L_QN + 64 * NST * 2;
constexpr int L_QKS = 0, L_WS = 64 * QKST * 2;
static_assert(L_GC + 1024 <= LDS_BYTES, "gdn prep LDS");

DI void gdn_prep_phase(const Params& p) {
    unsigned char* ws = p.ws;
    float* QKVf = (float*)(dyn_smem + L_QKV); float* AM = (float*)(dyn_smem + L_AM);
    bf16_t* KN = (bf16_t*)(dyn_smem + L_KN); bf16_t* QN = (bf16_t*)(dyn_smem + L_QN);
    float* GC = (float*)(dyn_smem + L_GC); float* BETA = GC + 64; float* EG = GC + 128; float* ED = GC + 192;
    bf16_t* QKS = (bf16_t*)(dyn_smem + L_QKS); bf16_t* WSI = (bf16_t*)(dyn_smem + L_WS);
    const bf16_t* HQKV = (const bf16_t*)(ws + WS_R2);
    const float* AB = (const float*)(ws + WS_AB);
    float* DL = (float*)(ws + WS_DL);
    for (int item = blockIdx.x; item < NITEM; item += gridDim.x) {
        const int tid = opaque_tid(), lane = tid & 63, wave = __builtin_amdgcn_readfirstlane(tid >> 6), fr = lane & 15, fq = lane >> 4;
        int h, b, c, row0, valid; bool samp;
        if (item < 2048) { h = item & 3; c = (item >> 2) & 127; b = item >> 9; row0 = b * TP + c * 64; valid = 64; samp = false; }
        else { const int j = item - 2048; h = j & 3; b = j >> 2; c = 0; row0 = MP + b * TS; valid = TS; samp = true; }
        unsigned char* ip = ws + WS_R1 + (size_t)item * ITEM_B;
        __syncthreads();
        {
            bf16_t* RAW = (bf16_t*)(dyn_smem + L_AM);
#pragma unroll
            for (int i = 0; i < 7; ++i) {
                const int id = tid + 512 * i;
                if (id < 67 * 48) {
                    const int rw = id / 48, ch = id % 48, part = ch >> 4, c8 = (ch & 15) * 8, gcol = part * 512 + h * 128 + c8, t = rw - 3;
                    u32x4 v = (u32x4){0u, 0u, 0u, 0u};
                    if (t >= 0) { if (t < valid) v = *(const u32x4*)(HQKV + (size_t)(row0 + t) * 1536 + gcol); }
                    else if (samp) { const float* sp = p.state_cq + (size_t)(b * 3 + 3 + t) * 1536 + gcol; const f32x4 f0 = *(const f32x4*)sp, f1 = *(const f32x4*)(sp + 4);
                                     v.x = pk2(f0.x, f0.y); v.y = pk2(f0.z, f0.w); v.z = pk2(f1.x, f1.y); v.w = pk2(f1.z, f1.w); }
                    else if (c != 0) v = *(const u32x4*)(HQKV + (size_t)(row0 + t) * 1536 + gcol);
                    *(u32x4*)(RAW + rw * 384 + ch * 8) = v;
                }
            }
            __syncthreads();
#pragma unroll 1
            for (int task = tid; task < 1536; task += 512) {
                const int col = task % 384, seg = task / 384, part = col >> 7, cc = col & 127, gcol = part * 512 + h * 128 + cc, t0 = seg * 16;
                const float w0 = p.gdn_conv_w[gcol], w1 = p.gdn_conv_w[1536 + gcol], w2 = p.gdn_conv_w[2 * 1536 + gcol], w3 = p.gdn_conv_w[3 * 1536 + gcol];
                float x0 = bf2f(RAW[(t0) * 384 + col]), x1 = bf2f(RAW[(t0 + 1) * 384 + col]), x2 = bf2f(RAW[(t0 + 2) * 384 + col]);
#pragma unroll
                for (int t = t0; t < t0 + 16; ++t) {
                    const float xv = bf2f(RAW[(t + 3) * 384 + col]);
                    const float y = w0 * x0 + w1 * x1 + w2 * x2 + w3 * xv;
                    QKVf[(part * 64 + t) * QST + cc] = t < valid ? silu(y) : 0.f;
                    x0 = x1; x1 = x2; x2 = xv;
                }
            }
        }
        if (tid < 64) {
            float g = 0.f, be = 0.f;
            if (tid < valid) {
                const float a = AB[(size_t)(row0 + tid) * 8 + h] + p.dt_bias[h], bb = AB[(size_t)(row0 + tid) * 8 + 4 + h];
                const float sp = a > 20.f ? a : log1pf(expf(a));
                g = -expf(p.a_log[h]) * sp; be = 1.f / (1.f + expf(-bb));
            }
            float gc = g;
#pragma unroll
            for (int o = 1; o < 64; o <<= 1) { const float n = __shfl_up(gc, o); if (lane >= o) gc += n; }
            const float gl = __shfl(gc, 63);
            GC[tid] = gc; BETA[tid] = be; EG[tid] = expf(gc); ED[tid] = expf(gl - gc);
            if (tid == 0) DL[item] = expf(gl);
        }
        __syncthreads();
        {
            const int row = tid >> 3, pt = tid & 7;
            float q[16], k[16]; float sq = 0.f, sk = 0.f;
#pragma unroll
            for (int e4 = 0; e4 < 4; ++e4) {
                const f32x4 a = *(const f32x4*)(QKVf + row * QST + 16 * pt + 4 * e4), bq = *(const f32x4*)(QKVf + (64 + row) * QST + 16 * pt + 4 * e4);
#pragma unroll
                for (int e = 0; e < 4; ++e) { q[4 * e4 + e] = a[e]; k[4 * e4 + e] = bq[e]; sq += a[e] * a[e]; sk += bq[e] * bq[e]; }
            }
#pragma unroll
            for (int o = 1; o < 8; o <<= 1) { sq += __shfl_xor(sq, o); sk += __shfl_xor(sk, o); }
            const float rq = rsqrtf(sq + 1e-6f), rk = rsqrtf(sk + 1e-6f), qg = rq * GSCALE * EG[row];
            u32x4 o0, o1;
            o0.x = pk2(q[0] * rq, q[1] * rq); o0.y = pk2(q[2] * rq, q[3] * rq); o0.z = pk2(q[4] * rq, q[5] * rq); o0.w = pk2(q[6] * rq, q[7] * rq);
            o1.x = pk2(q[8] * rq, q[9] * rq); o1.y = pk2(q[10] * rq, q[11] * rq); o1.z = pk2(q[12] * rq, q[13] * rq); o1.w = pk2(q[14] * rq, q[15] * rq);
            *(u32x4*)(QN + row * NST + 16 * pt) = o0; *(u32x4*)(QN + row * NST + 16 * pt + 8) = o1;
            o0.x = pk2(k[0] * rk, k[1] * rk); o0.y = pk2(k[2] * rk, k[3] * rk); o0.z = pk2(k[4] * rk, k[5] * rk); o0.w = pk2(k[6] * rk, k[7] * rk);
            o1.x = pk2(k[8] * rk, k[9] * rk); o1.y = pk2(k[10] * rk, k[11] * rk); o1.z = pk2(k[12] * rk, k[13] * rk); o1.w = pk2(k[14] * rk, k[15] * rk);
            *(u32x4*)(KN + row * NST + 16 * pt) = o0; *(u32x4*)(KN + row * NST + 16 * pt + 8) = o1;
#pragma unroll
            for (int e4 = 0; e4 < 4; ++e4) *(f32x4*)(QKVf + (64 + row) * QST + 16 * pt + 4 * e4) = (f32x4){k[4 * e4] * rk, k[4 * e4 + 1] * rk, k[4 * e4 + 2] * rk, k[4 * e4 + 3] * rk};
            bf16_t* QGf = (bf16_t*)(ip + 16384);
            const int rt = row >> 4, frr = row & 15, ks = pt >> 1;
#pragma unroll
            for (int f = 0; f < 4; ++f) {
                u32x2 o; o.x = pk2(q[4 * f] * qg, q[4 * f + 1] * qg); o.y = pk2(q[4 * f + 2] * qg, q[4 * f + 3] * qg);
                *(u32x2*)(QGf + (size_t)(((rt * 4 + ks) * 64 + f * 16 + frr) * 8 + 4 * (pt & 1))) = o;
            }
        }
        __syncthreads();
        {
            const bool isq = wave >= 4; const int ti = wave & 3;
            const bf16_t* As = isq ? QN : KN;
#pragma unroll
            for (int tj = 0; tj < 4; ++tj) {
                f32x4 acc = (f32x4){0.f, 0.f, 0.f, 0.f};
#pragma unroll
                for (int ks = 0; ks < 4; ++ks) {
                    const bf16x8 a = *(const bf16x8*)(As + (16 * ti + fr) * NST + 32 * ks + 8 * fq), bb = *(const bf16x8*)(KN + (16 * tj + fr) * NST + 32 * ks + 8 * fq);
                    acc = MFMA16(a, bb, acc);
                }
                const int jj = 16 * tj + fr; const float gj = GC[jj];
#pragma unroll
                for (int j = 0; j < 4; ++j) {
                    const int i = 16 * ti + 4 * fq + j;
                    const float dec = i >= jj ? expf(GC[i] - gj) : 0.f;
                    if (!isq) AM[i * AST + jj] = i > jj ? BETA[i] * acc[j] * dec : 0.f;
                    else QKS[i * QKST + jj] = f2bf(GSCALE * acc[j] * dec);
                }
            }
            bf16_t* KDTf = (bf16_t*)(ip + 32768);
#pragma unroll
            for (int i2 = 0; i2 < 2; ++i2) {
                const int f = tid + 512 * i2, ln = f & 63, ks2 = (f >> 6) & 1, dt = f >> 7, fq_ = ln >> 4, dk = 16 * dt + (ln & 15);
                float v[8];
#pragma unroll
                for (int e = 0; e < 8; ++e) { const int i = 32 * ks2 + 16 * (e >> 2) + 4 * fq_ + (e & 3); v[e] = bf2f(KN[i * NST + dk]) * ED[i]; }
                u32x4 o; o.x = pk2(v[0], v[1]); o.y = pk2(v[2], v[3]); o.z = pk2(v[4], v[5]); o.w = pk2(v[6], v[7]);
                *(u32x4*)(KDTf + (size_t)f * 8) = o;
            }
        }
        __syncthreads();
        {
            float* TM = (float*)(dyn_smem + L_QN);
            float* TMP = (float*)(dyn_smem + L_KN);
#pragma unroll
            for (int i = 0; i < 9; ++i) { const int id = tid + 512 * i; if (id < 64 * AST) TM[id] = 0.f; }
            __syncthreads();
            if (tid < 64) {
                const int d = tid >> 4, c = tid & 15;
                float y[16];
#pragma unroll
                for (int r = 0; r < 16; ++r) {
                    float sacc = r == c ? 1.f : 0.f;
                    const float* ar = AM + (16 * d + r) * AST + 16 * d;
#pragma unroll
                    for (int j = 0; j < r; ++j) sacc -= ar[j] * y[j];
                    y[r] = sacc;
                    TM[(16 * d + r) * AST + 16 * d + c] = sacc;
                }
            }
            __syncthreads();
            {
                const int blk = tid >> 8, r = (tid >> 4) & 15, c = tid & 15, rb = blk ? 3 : 1, cb = rb - 1;
                float t = 0.f;
#pragma unroll
                for (int j = 0; j < 16; ++j) t += AM[(16 * rb + r) * AST + 16 * cb + j] * TM[(16 * cb + j) * AST + 16 * cb + c];
                TMP[blk * 272 + r * 17 + c] = t;
                __syncthreads();
                float o = 0.f;
#pragma unroll
                for (int k = 0; k < 16; ++k) o -= TM[(16 * rb + r) * AST + 16 * rb + k] * TMP[blk * 272 + k * 17 + c];
                __syncthreads();
                TM[(16 * rb + r) * AST + 16 * cb + c] = o;
            }
            __syncthreads();
            {
                float t[2];
#pragma unroll
                for (int i2 = 0; i2 < 2; ++i2) {
                    const int o = tid + 512 * i2, r = o >> 5, c = o & 31;
                    float acc = 0.f;
#pragma unroll
                    for (int j = 0; j < 32; ++j) acc += AM[(32 + r) * AST + j] * TM[j * AST + c];
                    t[i2] = acc;
                }
#pragma unroll
                for (int i2 = 0; i2 < 2; ++i2) { const int o = tid + 512 * i2; TMP[(o >> 5) * 33 + (o & 31)] = t[i2]; }
                __syncthreads();
#pragma unroll
                for (int i2 = 0; i2 < 2; ++i2) {
                    const int o = tid + 512 * i2, r = o >> 5, c = o & 31;
                    float acc = 0.f;
#pragma unroll
                    for (int k = 0; k < 32; ++k) acc -= TM[(32 + r) * AST + 32 + k] * TMP[k * 33 + c];
                    t[i2] = acc;
                }
#pragma unroll
                for (int i2 = 0; i2 < 2; ++i2) { const int o = tid + 512 * i2; TM[(32 + (o >> 5)) * AST + (o & 31)] = t[i2]; }
            }
            __syncthreads();
            {
                bf16x8 Ah[4][2], Al[4][2];
#pragma unroll
                for (int rt = 0; rt < 4; ++rt)
#pragma unroll
                    for (int ks = 0; ks < 2; ++ks) {
                        const f32x4 a0 = *(const f32x4*)(TM + (16 * rt + fr) * AST + 32 * ks + 8 * fq), a1 = *(const f32x4*)(TM + (16 * rt + fr) * AST + 32 * ks + 8 * fq + 4);
                        u32x4 hq; hq.x = pk2(a0.x, a0.y); hq.y = pk2(a0.z, a0.w); hq.z = pk2(a1.x, a1.y); hq.w = pk2(a1.z, a1.w);
                        u32x4 lq; lq.x = pk2(a0.x - bflo(hq.x), a0.y - bfhi(hq.x)); lq.y = pk2(a0.z - bflo(hq.y), a0.w - bfhi(hq.y));
                        lq.z = pk2(a1.x - bflo(hq.z), a1.y - bfhi(hq.z)); lq.w = pk2(a1.z - bflo(hq.w), a1.w - bfhi(hq.w));
                        Ah[rt][ks] = __builtin_bit_cast(bf16x8, hq); Al[rt][ks] = __builtin_bit_cast(bf16x8, lq);
                    }
                const bool isw = wave >= 4;
                f32x4 xacc[2][4];
#pragma unroll
                for (int q = 0; q < 2; ++q)
#pragma unroll
                    for (int rt = 0; rt < 4; ++rt) xacc[q][rt] = (f32x4){0.f, 0.f, 0.f, 0.f};
#pragma unroll
                for (int ks = 0; ks < 2; ++ks) {
                    float sc8[8];
                    {
                        const f32x4 b0 = *(const f32x4*)(BETA + 32 * ks + 8 * fq), b1 = *(const f32x4*)(BETA + 32 * ks + 8 * fq + 4);
                        const f32x4 e0 = *(const f32x4*)(EG + 32 * ks + 8 * fq), e1 = *(const f32x4*)(EG + 32 * ks + 8 * fq + 4);
#pragma unroll
                        for (int e = 0; e < 4; ++e) { sc8[e] = isw ? b0[e] * e0[e] : b0[e]; sc8[4 + e] = isw ? b1[e] * e1[e] : b1[e]; }
                    }
#pragma unroll
                    for (int q = 0; q < 2; ++q) {
                        const int cc = ((2 * wave + q) & 7) * 16 + fr;
                        const float* src = QKVf + ((isw ? 64 : 128) + 32 * ks + 8 * fq) * QST + cc;
                        float v[8];
#pragma unroll
                        for (int e = 0; e < 8; ++e) v[e] = src[e * QST] * sc8[e];
                        u32x4 hq; hq.x = pk2(v[0], v[1]); hq.y = pk2(v[2], v[3]); hq.z = pk2(v[4], v[5]); hq.w = pk2(v[6], v[7]);
                        u32x4 lq; lq.x = pk2(v[0] - bflo(hq.x), v[1] - bfhi(hq.x)); lq.y = pk2(v[2] - bflo(hq.y), v[3] - bfhi(hq.y));
                        lq.z = pk2(v[4] - bflo(hq.z), v[5] - bfhi(hq.z)); lq.w = pk2(v[6] - bflo(hq.w), v[7] - bfhi(hq.w));
                        const bf16x8 Bh = __builtin_bit_cast(bf16x8, hq), Bl = __builtin_bit_cast(bf16x8, lq);
#pragma unroll
                        for (int rt = 0; rt < 4; ++rt) {
                            xacc[q][rt] = MFMA16(Ah[rt][ks], Bh, xacc[q][rt]);
                            xacc[q][rt] = MFMA16(Al[rt][ks], Bh, xacc[q][rt]);
                            xacc[q][rt] = MFMA16(Ah[rt][ks], Bl, xacc[q][rt]);
                        }
                    }
                }
                if (!isw) {
                    float* Uc = (float*)(ip + 57344);
#pragma unroll
                    for (int q = 0; q < 2; ++q)
#pragma unroll
                        for (int rt = 0; rt < 4; ++rt) *(f32x4*)(Uc + (size_t)((((2 * wave + q) * 4 + rt) * 64 + lane) * 4)) = xacc[q][rt];
                } else {
#pragma unroll
                    for (int q = 0; q < 2; ++q)
#pragma unroll
                        for (int rt = 0; rt < 4; ++rt)
#pragma unroll
                            for (int j = 0; j < 4; ++j) WSI[(16 * rt + 4 * fq + j) * NST + ((2 * wave + q) & 7) * 16 + fr] = f2bf(xacc[q][rt][j]);
                }
            }
        }
        __syncthreads();
        {
            bf16_t* Wf = (bf16_t*)ip; bf16_t* QKf = (bf16_t*)(ip + 49152);
#pragma unroll
            for (int i2 = 0; i2 < 2; ++i2) {
                const int f = tid + 512 * i2, ln = f & 63, ks = (f >> 6) & 3, rt = f >> 8, i = 16 * rt + (ln & 15), fq_ = ln >> 4;
                const u32x2 lo = *(const u32x2*)(WSI + i * NST + 32 * ks + 4 * fq_), hi = *(const u32x2*)(WSI + i * NST + 32 * ks + 16 + 4 * fq_);
                *(u32x4*)(Wf + (size_t)f * 8) = (u32x4){lo.x, lo.y, hi.x, hi.y};
            }
            {
                const int f = tid, ln = f & 63, ks2 = (f >> 6) & 1, rt = f >> 7, i = 16 * rt + (ln & 15), fq_ = ln >> 4;
                const u32x2 lo = *(const u32x2*)(QKS + i * QKST + 32 * ks2 + 4 * fq_), hi = *(const u32x2*)(QKS + i * QKST + 32 * ks2 + 16 + 4 * fq_);
                *(u32x4*)(QKf + (size_t)f * 8) = (u32x4){lo.x, lo.y, hi.x, hi.y};
            }
        }
    }
}

constexpr int OPB_B = 57344, L_OBUF = 2 * OPB_B, OST = 132;
static_assert(L_OBUF + 64 * OST * 4 <= LDS_BYTES, "scan LDS");
DI void gdn_scan(const Params& p, const bool samp, const int b, const int h) {
    unsigned char* ws = p.ws;
    const int tid = threadIdx.x, lane = tid & 63, w = __builtin_amdgcn_readfirstlane(tid >> 6), fr = lane & 15, fq = lane >> 4;
    const int nsteps = samp ? 1 : 128, valid = samp ? TS : 64;
    float* OBUF = (float*)(dyn_smem + L_OBUF);
    const bf16_t* HG = (const bf16_t*)(ws + WS_R3);
    bf16_t* OMIX = (bf16_t*)(ws + WS_R2);
    const float* DL = (const float*)(ws + WS_DL);
    f32x4 S[8];
#pragma unroll
    for (int dt = 0; dt < 8; ++dt) {
        if (samp) {
#pragma unroll
            for (int j = 0; j < 4; ++j) S[dt][j] = p.state_gdn[((size_t)(b * 4 + h) * 128 + 16 * dt + 4 * fq + j) * 128 + 16 * w + fr];
        } else S[dt] = (f32x4){0.f, 0.f, 0.f, 0.f};
    }
    const int item0 = samp ? 2048 + b * 4 + h : b * 512 + h;
    __syncthreads();
    {
        const unsigned char* ip = ws + WS_R1 + (size_t)item0 * ITEM_B;
#pragma unroll
        for (int i = 0; i < 7; ++i) *(u32x4*)(dyn_smem + (tid + 512 * i) * 16) = *(const u32x4*)(ip + (tid + 512 * i) * 16);
    }
    __syncthreads();
#pragma unroll 1
    for (int c = 0; c < nsteps; ++c) {
        const int item = item0 + 4 * c;
        const unsigned char* ip = ws + WS_R1 + (size_t)item * ITEM_B;
        const bool nxt = c + 1 < nsteps;
        u32x4 pf[7];
        if (nxt) {
#pragma unroll
            for (int i = 0; i < 7; ++i) pf[i] = *(const u32x4*)(ip + 4 * (size_t)ITEM_B + (tid + 512 * i) * 16);
        }
        const float* Uc = (const float*)(ip + 57344);
        f32x4 U[4];
#pragma unroll
        for (int rt = 0; rt < 4; ++rt) U[rt] = *(const f32x4*)(Uc + ((w * 4 + rt) * 64 + lane) * 4);
        const float dl = DL[item];
        const unsigned char* buf = dyn_smem + (c & 1) * OPB_B;
        bf16x8 Sb[4];
#pragma unroll
        for (int ks = 0; ks < 4; ++ks) Sb[ks] = pack8(S[2 * ks], S[2 * ks + 1]);
        f32x4 vn[4];
#pragma unroll
        for (int rt = 0; rt < 4; ++rt) {
            f32x4 acc = (f32x4){0.f, 0.f, 0.f, 0.f};
#pragma unroll
            for (int ks = 0; ks < 4; ++ks) acc = MFMA16(*(const bf16x8*)(buf + ((rt * 4 + ks) * 64 + lane) * 16), Sb[ks], acc);
            vn[rt] = U[rt] - acc;
        }
        bf16x8 Vb[2];
        Vb[0] = pack8(vn[0], vn[1]); Vb[1] = pack8(vn[2], vn[3]);
#pragma unroll
        for (int rt = 0; rt < 4; ++rt) {
            f32x4 acc = (f32x4){0.f, 0.f, 0.f, 0.f};
#pragma unroll
            for (int ks = 0; ks < 4; ++ks) acc = MFMA16(*(const bf16x8*)(buf + 16384 + ((rt * 4 + ks) * 64 + lane) * 16), Sb[ks], acc);
#pragma unroll
            for (int ks2 = 0; ks2 < 2; ++ks2) acc = MFMA16(*(const bf16x8*)(buf + 49152 + ((rt * 2 + ks2) * 64 + lane) * 16), Vb[ks2], acc);
#pragma unroll
            for (int j = 0; j < 4; ++j) OBUF[(16 * rt + 4 * fq + j) * OST + 16 * w + fr] = acc[j];
        }
#pragma unroll
        for (int dt = 0; dt < 8; ++dt) {
            f32x4 acc = S[dt] * dl;
#pragma unroll
            for (int ks2 = 0; ks2 < 2; ++ks2) acc = MFMA16(*(const bf16x8*)(buf + 32768 + ((dt * 2 + ks2) * 64 + lane) * 16), Vb[ks2], acc);
            S[dt] = acc;
        }
        if (nxt) {
#pragma unroll
            for (int i = 0; i < 7; ++i) *(u32x4*)(dyn_smem + ((c + 1) & 1) * OPB_B + (tid + 512 * i) * 16) = pf[i];
        }
        __syncthreads();
        {
            const int row = tid >> 3, pt = tid & 7;
            float o[16]; float ss = 0.f;
#pragma unroll
            for (int e4 = 0; e4 < 4; ++e4) { const f32x4 a = *(const f32x4*)(OBUF + row * OST + 16 * pt + 4 * e4);
#pragma unroll
                for (int e = 0; e < 4; ++e) { o[4 * e4 + e] = a[e]; ss += a[e] * a[e]; } }
#pragma unroll
            for (int of = 1; of < 8; of <<= 1) ss += __shfl_xor(ss, of);
            if (row < valid) {
                const float r = rsqrtf(ss * (1.f / 128.f) + 1e-6f);
                const size_t grow = (samp ? (size_t)MP + b * TS : (size_t)b * TP + (size_t)c * 64) + row;
                const u32x4 g0 = *(const u32x4*)(HG + grow * 512 + h * 128 + 16 * pt), g1 = *(const u32x4*)(HG + grow * 512 + h * 128 + 16 * pt + 8);
                const unsigned gw[8] = {g0.x, g0.y, g0.z, g0.w, g1.x, g1.y, g1.z, g1.w};
                unsigned ow[8];
#pragma unroll
                for (int e = 0; e < 8; ++e) {
                    const float ga = bflo(gw[e]), gb = bfhi(gw[e]);
                    const float n0 = p.gdn_norm_w[16 * pt + 2 * e], n1 = p.gdn_norm_w[16 * pt + 2 * e + 1];
                    ow[e] = pk2(o[2 * e] * r * n0 * silu(ga), o[2 * e + 1] * r * n1 * silu(gb));
                }
                *(u32x4*)(OMIX + grow * 1024 + h * 128 + 16 * pt) = (u32x4){ow[0], ow[1], ow[2], ow[3]};
                *(u32x4*)(OMIX + grow * 1024 + h * 128 + 16 * pt + 8) = (u32x4){ow[4], ow[5], ow[6], ow[7]};
            }
        }
        __syncthreads();
    }
    float* So = p.out + (samp ? O_GS : O_GP) + (size_t)(b * 4 + h) * 128 * 128;
#pragma unroll
    for (int dt = 0; dt < 8; ++dt)
#pragma unroll
        for (int j = 0; j < 4; ++j) So[(size_t)(16 * dt + 4 * fq + j) * 128 + 16 * w + fr] = S[dt][j];
}

constexpr int KST = 136, VST = 72, L_KT = 0, L_VT = 2 * 64 * KST * 2, L_ALX = L_VT + 2 * 128 * VST * 2, L_IDX = L_ALX + 8 * 2 * 32 * 4, L_QF = L_IDX + 256;
static_assert(L_QF + 8 * 8 * 1024 <= LDS_BYTES, "attn LDS");
DI int crow32(int i, int hh) { return (i & 3) + 8 * (i >> 2) + 4 * hh; }

DI void attn_item(const Params& p, const int idx, const float* lamp) {
    unsigned char* ws = p.ws;
    const int tid = threadIdx.x, lane = tid & 63, w = __builtin_amdgcn_readfirstlane(tid >> 6), r = lane & 31, hh = lane >> 5;
    bool samp; int b, h, qb = 0, ntiles, lastw; size_t qbase, kbase; const bf16_t* vtb; int vstride; bool active;
    if (idx < 32) { samp = true; b = idx >> 2; h = idx & 3; qbase = (size_t)MP + b * TS; kbase = (size_t)MP + (size_t)b * TKS; ntiles = 65; lastw = 64; active = w == 0;
                    vtb = (const bf16_t*)(ws + WS_R6) + VT_S_OFF + (size_t)((b * 4 + h) * 128) * TKS; vstride = TKS; }
    else { const int j = idx - 32; samp = false; qb = 31 - (j >> 4); b = (j & 15) >> 2; h = j & 3; qbase = (size_t)b * TP + qb * 256; kbase = (size_t)b * TP; ntiles = 4 * qb + 4; lastw = 4 * qb + (w >> 1); active = true;
           vtb = (const bf16_t*)(ws + WS_R6) + (size_t)((b * 4 + h) * 128) * TP; vstride = TP; }
    const bf16_t* KALL = (const bf16_t*)(ws + WS_R5) + kbase * 512 + h * 128;
    bf16_t* KT = (bf16_t*)(dyn_smem + L_KT); bf16_t* VTL = (bf16_t*)(dyn_smem + L_VT);
    float* ALX = (float*)(dyn_smem + L_ALX) + w * 64;
    bf16_t* QF = (bf16_t*)(dyn_smem + L_QF) + w * 8 * 64 * 8;
    {
        const bf16_t* qp = (const bf16_t*)(ws + WS_R4) + (qbase + 32 * w + r) * 512 + h * 128 + 8 * hh;
        if (active) {
#pragma unroll
            for (int f = 0; f < 8; ++f) *(u32x4*)(QF + (f * 64 + lane) * 8) = *(const u32x4*)(qp + (f >> 2) * 64 + 16 * (f & 3));
        }
    }
    f32x16 O1[4], O2[4];
#pragma unroll
    for (int t = 0; t < 4; ++t)
#pragma unroll
        for (int i = 0; i < 16; ++i) { O1[t][i] = 0.f; O2[t][i] = 0.f; }
    float m1 = -1e30f, m2 = -1e30f, l1 = 0.f, l2 = 0.f;
    const int krow0 = tid >> 4, kc16 = tid & 15;
    const int vdv0 = tid >> 3, vm = tid & 7;
    const int vpos = (vm >> 2) * 32 + ((vm >> 1) & 1) * 16 + (vm & 1) * 4;
    const unsigned koff = krow0 * 512 + kc16 * 8, voff = vdv0 * vstride + 8 * vm;
    const unsigned klds = (krow0 * KST + kc16 * 8) * 2, vlds = (vdv0 * VST + vpos) * 2;
    u32x4 pa, pb;
    __syncthreads();
    {
        pa = *(const u32x4*)(KALL + koff); pb = *(const u32x4*)(KALL + 32 * 512 + koff);
        *(u32x4*)(dyn_smem + L_KT + klds) = pa; *(u32x4*)(dyn_smem + L_KT + 32 * KST * 2 + klds) = pb;
        pa = *(const u32x4*)(vtb + voff); pb = *(const u32x4*)(vtb + (size_t)64 * vstride + voff);
        *(u32x2*)(dyn_smem + L_VT + vlds) = (u32x2){pa.x, pa.y}; *(u32x2*)(dyn_smem + L_VT + vlds + 16) = (u32x2){pa.z, pa.w};
        *(u32x2*)(dyn_smem + L_VT + 64 * VST * 2 + vlds) = (u32x2){pb.x, pb.y}; *(u32x2*)(dyn_smem + L_VT + 64 * VST * 2 + vlds + 16) = (u32x2){pb.z, pb.w};
    }
    __syncthreads();
#pragma unroll 1
    for (int kt = 0; kt < ntiles; ++kt) {
        const bool nxt = kt + 1 < ntiles;
        const bf16_t* kn_ = KALL + (size_t)(kt + 1) * 64 * 512; const bf16_t* vn_ = vtb + (size_t)(kt + 1) * 64;
        unsigned char* ldn = dyn_smem + ((kt + 1) & 1) * 64 * KST * 2; unsigned char* ldv = dyn_smem + L_VT + ((kt + 1) & 1) * 128 * VST * 2;
        if (nxt) { pa = *(const u32x4*)(kn_ + koff); pb = *(const u32x4*)(kn_ + 32 * 512 + koff); }
        if (active && kt <= lastw) {
            const bf16_t* Kb = KT + (kt & 1) * 64 * KST; const bf16_t* Vb = VTL + (kt & 1) * 128 * VST;
            const bool domask = samp && kt == 64;
#pragma unroll 1
            for (int sub = 0; sub < 2; ++sub) {
                bf16x8 P[2][2];
#pragma unroll
                for (int mp = 0; mp < 2; ++mp) {
                    f32x16 sc;
#pragma unroll
                    for (int i = 0; i < 16; ++i) sc[i] = 0.f;
#pragma unroll
                    for (int s = 0; s < 4; ++s) {
                        const bf16x8 ka = *(const bf16x8*)(Kb + (sub * 32 + r) * KST + mp * 64 + 16 * s + 8 * hh);
                        const bf16x8 qf = *(const bf16x8*)(QF + ((mp * 4 + s) * 64 + lane) * 8);
                        sc = MFMA32(ka, qf, sc);
                    }
                    __builtin_amdgcn_sched_barrier(0);
                    if (domask) {
#pragma unroll
                        for (int i = 0; i < 16; ++i) if (sub * 32 + crow32(i, hh) >= TS) sc[i] = -1e30f;
                    }
                    float mx = sc[0];
#pragma unroll
                    for (int i = 1; i < 16; ++i) mx = fmaxf(mx, sc[i]);
                    { const auto sw_ = __builtin_amdgcn_permlane32_swap(__float_as_uint(mx), __float_as_uint(mx), false, false); mx = fmaxf(__uint_as_float(sw_[0]), __uint_as_float(sw_[1])); }
                    const float mo = mp == 0 ? m1 : m2, mn = fmaxf(mo, mx), al = __builtin_amdgcn_exp2f(mo - mn);
                    float ps = 0.f;
#pragma unroll
                    for (int i = 0; i < 16; ++i) { sc[i] = __builtin_amdgcn_exp2f(sc[i] - mn); ps += sc[i]; }
                    if (mp == 0) { m1 = mn; l1 = l1 * al + ps; } else { m2 = mn; l2 = l2 * al + ps; }
                    if (__any(al < 1.f)) {
                        if (hh == 0) ALX[r] = al;
                        asm volatile("s_waitcnt lgkmcnt(0)" ::: "memory");
#pragma unroll
                        for (int g = 0; g < 4; ++g) {
                            const f32x4 a1 = *(const f32x4*)(ALX + 8 * g + 4 * hh);
#pragma unroll
                            for (int t = 0; t < 4; ++t)
#pragma unroll
                                for (int j = 0; j < 4; ++j) { if (mp == 0) O1[t][4 * g + j] *= a1[j]; else O2[t][4 * g + j] *= a1[j]; }
                        }
                        asm volatile("s_waitcnt lgkmcnt(0)" ::: "memory");
                    }
#pragma unroll
                    for (int sp = 0; sp < 2; ++sp) {
                        u32x4 a;
                        a.x = pk2(sc[8 * sp], sc[8 * sp + 1]); a.y = pk2(sc[8 * sp + 2], sc[8 * sp + 3]); a.z = pk2(sc[8 * sp + 4], sc[8 * sp + 5]); a.w = pk2(sc[8 * sp + 6], sc[8 * sp + 7]);
                        P[mp][sp] = __builtin_bit_cast(bf16x8, a);
                    }
                    __builtin_amdgcn_sched_barrier(0);
                }
#pragma unroll
                for (int sp = 0; sp < 2; ++sp)
#pragma unroll
                    for (int t = 0; t < 4; ++t) {
                        if ((t & 1) == 0) __builtin_amdgcn_sched_barrier(0);
                        const bf16x8 vb = *(const bf16x8*)(Vb + (32 * t + r) * VST + sub * 32 + (sp * 2 + hh) * 8);
                        O1[t] = MFMA32(P[0][sp], vb, O1[t]); O2[t] = MFMA32(P[1][sp], vb, O2[t]);
                    }
                if (sub == 0 && nxt) {
                    *(u32x4*)(ldn + klds) = pa; *(u32x4*)(ldn + 32 * KST * 2 + klds) = pb;
                    pa = *(const u32x4*)(vn_ + voff); pb = *(const u32x4*)(vn_ + (size_t)64 * vstride + voff);
                }
            }
        } else if (nxt) {
            *(u32x4*)(ldn + klds) = pa; *(u32x4*)(ldn + 32 * KST * 2 + klds) = pb;
            pa = *(const u32x4*)(vn_ + voff); pb = *(const u32x4*)(vn_ + (size_t)64 * vstride + voff);
        }
        if (nxt) {
            *(u32x2*)(ldv + vlds) = (u32x2){pa.x, pa.y}; *(u32x2*)(ldv + vlds + 16) = (u32x2){pa.z, pa.w};
            *(u32x2*)(ldv + 64 * VST * 2 + vlds) = (u32x2){pb.x, pb.y}; *(u32x2*)(ldv + 64 * VST * 2 + vlds + 16) = (u32x2){pb.z, pb.w};
        }
        __syncthreads();
    }
    if (active) {
        { const auto s1_ = __builtin_amdgcn_permlane32_swap(__float_as_uint(l1), __float_as_uint(l1), false, false); l1 = __uint_as_float(s1_[0]) + __uint_as_float(s1_[1]);
          const auto s2_ = __builtin_amdgcn_permlane32_swap(__float_as_uint(l2), __float_as_uint(l2), false, false); l2 = __uint_as_float(s2_[0]) + __uint_as_float(s2_[1]); }
        if (hh == 0) { ALX[r] = __builtin_amdgcn_rcpf(l1); ALX[32 + r] = *lamp * __builtin_amdgcn_rcpf(l2); }
        asm volatile("s_waitcnt lgkmcnt(0)" ::: "memory");
        float ss[16], a1[16], a2[16];
#pragma unroll
        for (int g = 0; g < 4; ++g) {
            const f32x4 x1 = *(const f32x4*)(ALX + 8 * g + 4 * hh), x2 = *(const f32x4*)(ALX + 32 + 8 * g + 4 * hh);
#pragma unroll
            for (int j = 0; j < 4; ++j) { a1[4 * g + j] = x1[j]; a2[4 * g + j] = x2[j]; ss[4 * g + j] = 0.f; }
        }
#pragma unroll
        for (int t = 0; t < 4; ++t) {
            __builtin_amdgcn_sched_barrier(0);
#pragma unroll
            for (int i = 0; i < 16; ++i) { const float o = O1[t][i] * a1[i] - O2[t][i] * a2[i]; O1[t][i] = o; ss[i] += o * o; }
        }
        __builtin_amdgcn_sched_barrier(0);
#pragma unroll
        for (int i = 0; i < 16; ++i) {
#pragma unroll
            for (int of = 1; of < 32; of <<= 1) ss[i] += __shfl_xor(ss[i], of);
            ss[i] = __builtin_amdgcn_rsqf(ss[i] * (1.f / 128.f) + 1e-6f) * (1.f - LAM_INIT);
        }
        int zo = 0; asm volatile("" : "+v"(zo));
        bf16_t* obase = (bf16_t*)(ws + WS_R2) + (qbase + 32 * w) * 1024 + 512 + h * 128;
        const unsigned ooff = (unsigned)((4 * hh + zo) * 1024 + r);
        const float* sw = p.subln_w + r + zo;
#pragma unroll
        for (int t = 0; t < 4; ++t) {
            const float wv = sw[32 * t];
#pragma unroll
            for (int i = 0; i < 16; ++i) obase[ooff + ((i & 3) + 8 * (i >> 2)) * 1024 + 32 * t] = f2bf(O1[t][i] * ss[i] * wv);
        }
    }
}

DI void mixer_phase(const Params& p) {
    const int bid = blockIdx.x;
#ifndef NO_SCAN
    if (bid < 48) { const bool sm = bid >= 16; const int j = sm ? bid - 16 : bid; gdn_scan(p, sm, j >> 2, j & 3); }
#endif
    unsigned* ctl = (unsigned*)(p.ws + WS_CTL);
    int* sidx = (int*)(dyn_smem + L_IDX);
    for (;;) {
        __syncthreads();
        if (threadIdx.x == 0) *sidx = (int)atomicAdd(ctl, 1u);
        __syncthreads();
        const int idx = __builtin_amdgcn_readfirstlane(*sidx);
        if (idx >= 32 + 512) break;
#ifndef NO_ATTN
        attn_item(p, idx, (const float*)ctl + 1);
#endif
    }
}


__global__ void __launch_bounds__(512, 2) fwd_kernel(Params p) {
    cg::grid_group grid = cg::this_grid();
    const bool all = p.phase_hi - p.phase_lo > 1;
#define PHASE(i, body) if (p.phase_lo <= (i) && (i) < p.phase_hi) { body; if (all && (i) + 1 < p.phase_hi) grid.sync(); }
    PHASE(0, phase_prep(p))
    PHASE(1, gemm_phase<1>(p))
    PHASE(2, gdn_prep_phase(p))
    PHASE(3, mixer_phase(p))
    PHASE(4, gemm_phase<2>(p))
    PHASE(5, ln_phase<0>(p))
    PHASE(6, gemm_phase<3>(p))
    PHASE(7, fixup_phase(p))
    PHASE(8, gemm_phase<4>(p))
    PHASE(9, ln_phase<1>(p))
}

extern "C" void kernel_launch(void* const* d_in, const int* in_sizes, int n_in, void* d_out, int out_size, void* d_ws, size_t ws_size, hipStream_t stream) {
    static int grid = 0;
    if (grid == 0) {
        if (n_in != 23 || (size_t)out_size != O_END || ws_size < WS_END) { fprintf(stderr, "kernel_launch: unexpected sizes n_in %d out %d ws %zu (need %zu)\n", n_in, out_size, ws_size, (size_t)WS_END); grid = -1; return; }
        int dev = 0, cus = 0, per_cu = 0;
        hipGetDevice(&dev);
        hipDeviceGetAttribute(&cus, hipDeviceAttributeMultiprocessorCount, dev);
        if (hipFuncSetAttribute((const void*)fwd_kernel, hipFuncAttributeMaxDynamicSharedMemorySize, LDS_BYTES) != hipSuccess) { fprintf(stderr, "kernel_launch: hipFuncSetAttribute failed\n"); grid = -1; return; }
        hipOccupancyMaxActiveBlocksPerMultiprocessor(&per_cu, (const void*)fwd_kernel, 512, LDS_BYTES);
        if (per_cu < 1) { fprintf(stderr, "kernel_launch: occupancy query says %d\n", per_cu); per_cu = 1; }
        (void)hipGetLastError();
        grid = cus * 1;
    }
    if (grid < 0) return;
    Params p{};
    const float** f = (const float**)&p;
    for (int i = 0; i < 23; ++i) f[i] = (const float*)d_in[i];
    p.out = (float*)d_out; p.ws = (unsigned char*)d_ws; p.phase_lo = 0; p.phase_hi = 10;
    void* args[] = {&p};
    hipError_t e = hipLaunchCooperativeKernel((const void*)fwd_kernel, dim3(grid), dim3(512), args, LDS_BYTES, stream);
    if (e != hipSuccess) fprintf(stderr, "cooperative launch failed: %s (grid %d)\n", hipGetErrorString(e), grid);
}
```

```cpp
#include <hip/hip_runtime.h>
#include <hip/hip_cooperative_groups.h>
#include <cstdio>
namespace cg = cooperative_groups;
#ifndef GREP_WHICH
#define GREP_WHICH 0
#endif
#ifndef AREP
#define AREP 1
#endif
#ifndef SREP
#define SREP 1
#endif

typedef unsigned short bf16_t;
typedef short bf16x8 __attribute__((ext_vector_type(8)));
typedef short s16x4 __attribute__((ext_vector_type(4)));
typedef float f32x4 __attribute__((ext_vector_type(4)));
typedef float f32x16 __attribute__((ext_vector_type(16)));
typedef unsigned u32x4 __attribute__((ext_vector_type(4)));
typedef unsigned u32x2 __attribute__((ext_vector_type(2)));
#define DI __device__ __forceinline__

constexpr int D = 1024, TP = 8192, BP = 4, MP = BP * TP, BS = 8, TS = 32, MS = BS * TS, M = MP + MS, PAST = 4096;
constexpr int DIN = 3592, NH1 = 3584, DFF = 2816, NUP = 2 * DFF;
constexpr int TKS = 4160;
constexpr int NITEM = BP * 128 * 4 + BS * 4;
constexpr int ITEM_B = 90112;
constexpr int LDS_BYTES = 160 * 1024;
constexpr float ALPHA = 1.189207115002721f;
constexpr float LAM_INIT = 0.2f;

constexpr size_t O_Y = 0, O_KP = 33816576, O_VP = 50593792, O_GP = 67371008, O_CQP = 67633152, O_CFP = 67651584,
                 O_KS = 67696640, O_VS = 67827712, O_GS = 67958784, O_CQS = 68483072, O_CFS = 68519936, O_END = 68610048;

constexpr size_t al256(size_t x) { return (x + 255) & ~(size_t)255; }
constexpr size_t WS_CTL = 0;
constexpr size_t WS_ROPE = 4096;
constexpr size_t WS_AB = WS_ROPE + (size_t)8192 * 32 * 8;
constexpr size_t WS_DL = WS_AB + (size_t)M * 8 * 4;
constexpr size_t WS_WIN = al256(WS_DL + NITEM * 4);
constexpr size_t WS_WO = WS_WIN + (size_t)NH1 * D * 2;
constexpr size_t WS_WUP = WS_WO + (size_t)D * D * 2;
constexpr size_t WS_WDN = WS_WUP + (size_t)NUP * D * 2;
constexpr size_t WS_R1 = al256(WS_WDN + (size_t)D * DFF * 2);
constexpr size_t R1_SIZE = (size_t)NITEM * ITEM_B;
constexpr size_t WS_R2 = al256(WS_R1 + R1_SIZE);
constexpr size_t WS_R3 = al256(WS_R2 + (size_t)M * 1536 * 2);
constexpr size_t WS_R4 = WS_R3 + (size_t)M * 512 * 2;
constexpr size_t WS_R5 = al256(WS_R4 + (size_t)M * 512 * 2);
constexpr size_t KROWS = (size_t)MP + (size_t)BS * TKS;
constexpr size_t WS_R6 = al256(WS_R5 + KROWS * 512 * 2);
constexpr size_t VT_S_OFF = (size_t)BP * 4 * 128 * TP;
constexpr size_t WS_END = al256(WS_R6 + (VT_S_OFF + (size_t)BS * 4 * 128 * TKS) * 2);
constexpr size_t WS_CS1 = WS_END;
constexpr size_t WS_CS2 = WS_CS1 + (size_t)MS * NH1 * 4;
constexpr size_t WS_CS3 = WS_CS2 + (size_t)MS * D * 4;
constexpr size_t WS_CS4 = WS_CS3 + (size_t)MS * NUP * 4;
constexpr size_t WS_END2 = WS_CS4 + (size_t)MS * D * 4;
static_assert((size_t)M * DFF * 2 <= R1_SIZE, "GT must fit R1");
static_assert(WS_END2 <= (size_t)536870912, "workspace too large");

struct Params {
    const float *x_p, *x_s, *cache_k, *cache_v, *state_gdn, *state_cq, *state_cf;
    const float *w_in, *gdn_conv_w, *a_log, *dt_bias, *gdn_norm_w, *diff_lambda, *subln_w, *w_o, *ln1_g, *ln1_b, *w_up,
        *ffn_conv_w, *ffn_conv_b, *w_down, *ln2_g, *ln2_b;
    float* out; unsigned char* ws;
    int phase_lo, phase_hi;
};

extern __shared__ __attribute__((aligned(16))) unsigned char dyn_smem[];

typedef __bf16 bf16x2_t __attribute__((ext_vector_type(2)));
typedef float f32x2 __attribute__((ext_vector_type(2)));
DI unsigned pk2(float lo, float hi) { f32x2 v = {lo, hi}; bf16x2_t b = __builtin_convertvector(v, bf16x2_t); return __builtin_bit_cast(unsigned, b); }
DI bf16_t f2bf(float x) { return (bf16_t)(pk2(x, 0.f) & 0xffffu); }
DI float bf2f(bf16_t b) { return __uint_as_float(((unsigned)b) << 16); }
DI float bflo(unsigned u) { return __uint_as_float(u << 16); }
DI float bfhi(unsigned u) { return __uint_as_float(u & 0xffff0000u); }
DI float silu(float x) { return x / (1.f + __expf(-x)); }
DI int opaque_tid() { int t = threadIdx.x; asm volatile("" : "+v"(t)); return t; }
DI float wave_sum(float v) {
#pragma unroll
    for (int o = 1; o < 64; o <<= 1) v += __shfl_xor(v, o);
    return v;
}
DI const float* xrow_ptr(const Params& p, int row) { return row < MP ? p.x_p + (size_t)row * D : p.x_s + (size_t)(row - MP) * D; }

template <int MODE> DI int srccol(int n) {
    if (MODE == 1) {
        if (n < 2048) return n;
        return n + 8;
    }
    if (MODE == 2) { const int pn = n >> 8, j = n & 255; return j < 128 ? 128 * pn + j : DFF + 128 * pn + (j - 128); }
    return n;
}
struct TrItem { const float* W; bf16_t* WT; int K, N, k0, n0, mode; };
DI TrItem tr_decode(const Params& p, int it) {
    constexpr int I_IN = 16 * 56, I_O = 16 * 16, I_UP = 16 * 88;
    unsigned char* ws = p.ws; TrItem t; int r = it;
    if (r < I_IN) { t.W = p.w_in; t.WT = (bf16_t*)(ws + WS_WIN); t.K = D; t.N = DIN; t.k0 = (r / 56) * 64; t.n0 = (r % 56) * 64; t.mode = 1; return t; } r -= I_IN;
    if (r < I_O) { t.W = p.w_o; t.WT = (bf16_t*)(ws + WS_WO); t.K = D; t.N = D; t.k0 = (r / 16) * 64; t.n0 = (r % 16) * 64; t.mode = 0; return t; } r -= I_O;
    if (r < I_UP) { t.W = p.w_up; t.WT = (bf16_t*)(ws + WS_WUP); t.K = D; t.N = NUP; t.k0 = (r / 88) * 64; t.n0 = (r % 88) * 64; t.mode = 2; return t; } r -= I_UP;
    t.W = p.w_down; t.WT = (bf16_t*)(ws + WS_WDN); t.K = DFF; t.N = D; t.k0 = (r / 16) * 64; t.n0 = (r % 16) * 64; t.mode = 0; return t;
}
DI void tr_load(const TrItem& t, float (&v)[8]) {
    const int tid = threadIdx.x, n = t.n0 + (tid & 63);
    const int sc = t.mode == 1 ? (n < 2048 ? n : n + 8) : (t.mode == 2 ? srccol<2>(n) : n);
#pragma unroll
    for (int i = 0; i < 8; ++i) v[i] = t.W[(size_t)(t.k0 + (tid >> 6) + 8 * i) * t.N + sc];
}
DI void phase_prep(const Params& p) {
    const int tid = threadIdx.x, lane = tid & 63, wave = tid >> 6, nb = gridDim.x, bid = blockIdx.x;
    unsigned char* ws = p.ws;
    if (bid == 0 && tid < 64) {
        unsigned* ctl = (unsigned*)(ws + WS_CTL);
        float a = p.diff_lambda[lane] * p.diff_lambda[64 + lane], b = p.diff_lambda[128 + lane] * p.diff_lambda[192 + lane];
        a = wave_sum(a); b = wave_sum(b);
        if (lane == 0) { ctl[0] = 0u; ((float*)ctl)[1] = expf(a) - expf(b) + LAM_INIT; }
    }
    {
        constexpr int NT = 16 * 56 + 16 * 16 + 16 * 88 + 44 * 16;
        float* lds = (float*)dyn_smem;
        float v[8];
        TrItem cur = tr_decode(p, bid < NT ? bid : 0);
        if (bid < NT) tr_load(cur, v);
        for (int it = bid; it < NT; it += nb) {
            float nv[8]; TrItem nx = cur;
            if (it + nb < NT) { nx = tr_decode(p, it + nb); tr_load(nx, nv); }
#pragma unroll
            for (int i = 0; i < 8; ++i) lds[((tid >> 6) + 8 * i) * 65 + (tid & 63)] = v[i];
            __syncthreads();
#pragma unroll
            for (int i = 0; i < 8; ++i) { const int nn = (tid >> 6) + 8 * i, kk = tid & 63; cur.WT[(size_t)(cur.n0 + nn) * cur.K + cur.k0 + kk] = f2bf(lds[kk * 65 + nn]); }
            __syncthreads();
#pragma unroll
            for (int i = 0; i < 8; ++i) v[i] = nv[i];
            cur = nx;
        }
    }
    {
        float2* rope = (float2*)(ws + WS_ROPE);
        for (int idx = bid * 512 + tid; idx < 8192 * 32; idx += nb * 512) {
            const int pos = idx >> 5, d = idx & 31;
            const double inv = exp(-(double)d * (9.210340371976184 / 32.0));
            double a = (double)pos * inv;
            a -= 6.283185307179586 * rint(a * 0.15915494309189535);
            const float af = (float)a;
            rope[idx] = make_float2(__cosf(af), __sinf(af));
        }
    }
    {
        float* w8 = (float*)dyn_smem;
        __syncthreads();
        for (int i = tid; i < 1024 * 8; i += 512) w8[i] = p.w_in[(size_t)(i >> 3) * DIN + 2048 + (i & 7)];
        __syncthreads();
        bf16_t* XB = (bf16_t*)(ws + WS_R1);
        float* AB = (float*)(ws + WS_AB);
        f32x4 cv[4];
        {
            const int row = bid * 8 + wave;
            if (row < M) { const float* xr = xrow_ptr(p, row);
#pragma unroll
                for (int j = 0; j < 4; ++j) cv[j] = *(const f32x4*)(xr + lane * 4 + 256 * j); }
        }
        for (int row = bid * 8 + wave; row < M; row += nb * 8) {
            f32x4 nvx[4];
            if (row + nb * 8 < M) { const float* xn = xrow_ptr(p, row + nb * 8);
#pragma unroll
                for (int j = 0; j < 4; ++j) nvx[j] = *(const f32x4*)(xn + lane * 4 + 256 * j); }
            float acc[8];
#pragma unroll
            for (int c = 0; c < 8; ++c) acc[c] = 0.f;
#pragma unroll
            for (int j = 0; j < 4; ++j) {
                const int k0 = lane * 4 + 256 * j;
                const f32x4 v = cv[j];
                u32x2 o; o.x = pk2(v.x, v.y); o.y = pk2(v.z, v.w);
                *(u32x2*)(XB + (size_t)row * D + k0) = o;
#pragma unroll
                for (int e = 0; e < 4; ++e) {
                    const f32x4 wa = *(const f32x4*)(w8 + (k0 + e) * 8), wb = *(const f32x4*)(w8 + (k0 + e) * 8 + 4);
                    const float xv = v[e];
                    acc[0] += xv * wa.x; acc[1] += xv * wa.y; acc[2] += xv * wa.z; acc[3] += xv * wa.w;
                    acc[4] += xv * wb.x; acc[5] += xv * wb.y; acc[6] += xv * wb.z; acc[7] += xv * wb.w;
                }
            }
#pragma unroll
            for (int c = 0; c < 8; ++c) acc[c] = wave_sum(acc[c]);
            if (lane == 0) { *(f32x4*)(AB + (size_t)row * 8) = (f32x4){acc[0], acc[1], acc[2], acc[3]}; *(f32x4*)(AB + (size_t)row * 8 + 4) = (f32x4){acc[4], acc[5], acc[6], acc[7]}; }
#pragma unroll
            for (int j = 0; j < 4; ++j) cv[j] = nvx[j];
        }
        __syncthreads();
    }
    {
        bf16_t* KALL = (bf16_t*)(ws + WS_R5);
        const int nchunk = BS * TKS * 64;
        for (int c0 = bid * 512 + tid; c0 < nchunk; c0 += nb * 512 * 4) {
            f32x4 v0[4], v1[4]; int st[4]; size_t dsto[4];
#pragma unroll
            for (int u = 0; u < 4; ++u) {
                const int c = c0 + u * nb * 512;
                st[u] = 0;
                if (c < nchunk) {
                    const int col8 = c & 63, r = c >> 6, b = r / TKS, pp = r % TKS;
                    dsto[u] = ((size_t)MP + (size_t)b * TKS + pp) * 512 + col8 * 8;
                    if (pp < PAST) { const float* sp = p.cache_k + ((size_t)(b * PAST + pp) * 512 + col8 * 8); v0[u] = *(const f32x4*)sp; v1[u] = *(const f32x4*)(sp + 4); st[u] = 1; }
                    else if (pp >= PAST + TS) st[u] = 2;
                }
            }
#pragma unroll
            for (int u = 0; u < 4; ++u) {
                if (st[u] == 1) { u32x4 o; o.x = pk2(v0[u].x, v0[u].y); o.y = pk2(v0[u].z, v0[u].w); o.z = pk2(v1[u].x, v1[u].y); o.w = pk2(v1[u].z, v1[u].w); *(u32x4*)(KALL + dsto[u]) = o; }
                else if (st[u] == 2) *(u32x4*)(KALL + dsto[u]) = (u32x4){0u, 0u, 0u, 0u};
            }
        }
    }
    {
        bf16_t* VTS = (bf16_t*)(ws + WS_R6) + VT_S_OFF;
        bf16_t* t = (bf16_t*)dyn_smem;
        f32x4 cvv[4];
        auto ldv = [&](int it, f32x4 (&v)[4]) {
            const int blk = it % 65, bh = it / 65, b = bh >> 2, h = bh & 3;
            if (blk < 64) {
#pragma unroll
                for (int i = 0; i < 4; ++i) { const int id = tid + 512 * i, key = id >> 5, c4 = id & 31;
                    v[i] = *(const f32x4*)(p.cache_v + ((size_t)(b * PAST + blk * 64 + key) * 512 + h * 128 + c4 * 4)); }
            }
        };
        if (bid < BS * 4 * 65) ldv(bid, cvv);
        for (int it = bid; it < BS * 4 * 65; it += nb) {
            const int blk = it % 65, bh = it / 65;
            f32x4 nvv[4];
            if (it + nb < BS * 4 * 65) ldv(it + nb, nvv);
            if (blk < 64) {
                __syncthreads();
#pragma unroll
                for (int i = 0; i < 4; ++i) {
                    const int id = tid + 512 * i, key = id >> 5, c4 = id & 31;
                    const f32x4 v = cvv[i];
                    bf16_t* d = t + key * 130 + c4 * 4;
                    *(unsigned*)d = pk2(v.x, v.y); *(unsigned*)(d + 2) = pk2(v.z, v.w);
                }
                __syncthreads();
                const int dv = tid >> 2, part = tid & 3;
                unsigned o[8];
#pragma unroll
                for (int i = 0; i < 8; ++i) { const int k0 = part * 16 + 2 * i; o[i] = (unsigned)t[k0 * 130 + dv] | ((unsigned)t[(k0 + 1) * 130 + dv] << 16); }
                bf16_t* dst = VTS + ((size_t)(bh * 128 + dv) * TKS + blk * 64 + part * 16);
                *(u32x4*)dst = (u32x4){o[0], o[1], o[2], o[3]}; *(u32x4*)(dst + 8) = (u32x4){o[4], o[5], o[6], o[7]};
            } else {
                if (tid < 128) { bf16_t* dst = VTS + ((size_t)(bh * 128 + tid) * TKS + PAST + TS);
#pragma unroll
                    for (int i = 0; i < 4; ++i) *(u32x4*)(dst + 8 * i) = (u32x4){0u, 0u, 0u, 0u}; }
            }
#pragma unroll
            for (int i = 0; i < 4; ++i) cvv[i] = nvv[i];
        }
        __syncthreads();
    }
}

constexpr int BM = 256, BK = 64, HALF = 128, NXCD = 8, WGM = 8, HT = HALF * BK;
DI void stage_rc(int b, int& R, int& C) {
    const int st = b / 1024, sb = b % 1024, swz = sb ^ (((sb >> 9) & 1) << 5);
    R = (st >> 1) * 16 + swz / 64; C = (st & 1) * 32 + (swz % 64) / 2;
}
DI int lds_byte(int r, int c) {
    const int st = (r >> 4) * 2 + (c >> 5), rr = r & 15, cc = c & 31, ob = rr * 64 + cc * 2;
    return st * 1024 + (ob ^ (((ob >> 9) & 1) << 5));
}

#define SHM ((bf16_t*)dyn_smem)
#define SA(b, h) (SHM + ((b) * 2 + (h)) * HT)
#define SB(b, h) (SHM + (4 + (b) * 2 + (h)) * HT)
#define STAGE(P, BASE, br, kt) do { const bf16_t* _gb = (BASE) + ((long)(br) * K + (long)(kt) * BK); \
      __builtin_amdgcn_global_load_lds((const unsigned*)(_gb + so0), (unsigned*)((char*)(P) + threadIdx.x * 16), 16, 0, 0); \
      __builtin_amdgcn_global_load_lds((const unsigned*)(_gb + 64 * K + so0), (unsigned*)((char*)(P) + threadIdx.x * 16 + 8192), 16, 0, 0); } while (0)
#define LDA(dst, b, h) for (int m = 0; m < 4; ++m) for (int k = 0; k < 2; ++k) \
    dst[m][k] = *reinterpret_cast<const bf16x8*>((char*)SA(b, h) + lds_byte(wr * 64 + m * 16 + fr, k * 32 + fq * 8))
#define LDB(dst, b, h) for (int n = 0; n < 2; ++n) for (int k = 0; k < 2; ++k) \
    dst[n][k] = *reinterpret_cast<const bf16x8*>((char*)SB(b, h) + lds_byte(wc * 32 + n * 16 + fr, k * 32 + fq * 8))
#define MMA(ai, bj, At, Bt_) do { __builtin_amdgcn_s_setprio(1); \
    for (int m = 0; m < 4; ++m) for (int n = 0; n < 2; ++n) for (int k = 0; k < 2; ++k) \
      acc[ai][bj][m][n] = __builtin_amdgcn_mfma_f32_16x16x32_bf16(At[m][k], Bt_[n][k], acc[ai][bj][m][n], 0, 0, 0); \
    __builtin_amdgcn_s_setprio(0); } while (0)
#define WAIT_V(n) asm volatile("s_waitcnt vmcnt(" #n ")" ::: "memory")
#define WAIT_L(n) asm volatile("s_waitcnt lgkmcnt(" #n ")" ::: "memory")
#define BAR __builtin_amdgcn_s_barrier()
#define SCHED __builtin_amdgcn_sched_barrier(0)

template <int K> DI void gemm_tile(const bf16_t* __restrict__ A, const bf16_t* __restrict__ Bt, const int brow, const int bcol, f32x4 (&acc)[2][2][4][2]) {
    const int wid = threadIdx.x >> 6, lane = threadIdx.x & 63, wr = wid >> 2, wc = wid & 3, fr = lane & 15, fq = lane >> 4;
    unsigned so0;
    { int _r, _c; stage_rc(threadIdx.x * 16, _r, _c); so0 = (unsigned)(_r * K + _c); }
#pragma unroll
    for (int a = 0; a < 2; ++a)
#pragma unroll
        for (int b = 0; b < 2; ++b)
#pragma unroll
            for (int m = 0; m < 4; ++m)
#pragma unroll
                for (int n = 0; n < 2; ++n) acc[a][b][m][n] = (f32x4){0.f, 0.f, 0.f, 0.f};
    bf16x8 At[4][2], B0[2][2], B1[2][2];
    constexpr int nt = K / BK;
    STAGE(SB(0, 0), Bt, bcol, 0); STAGE(SA(0, 0), A, brow, 0);
    STAGE(SB(0, 1), Bt, bcol + HALF, 0); STAGE(SA(0, 1), A, brow + HALF, 0);
    if (wr == 1) BAR;
    WAIT_V(4); BAR;
    STAGE(SB(1, 0), Bt, bcol, 1); STAGE(SA(1, 0), A, brow, 1); STAGE(SB(1, 1), Bt, bcol + HALF, 1);
    WAIT_V(6); BAR;
    for (int t = 0; t < nt - 2; t += 2) {
        LDB(B0, 0, 0); SCHED; LDA(At, 0, 0); STAGE(SA(1, 1), A, brow + HALF, t + 1);
        WAIT_L(8); BAR; WAIT_L(0); MMA(0, 0, At, B0); BAR; SCHED;
        LDB(B1, 0, 1); STAGE(SB(0, 0), Bt, bcol, t + 2);
        BAR; WAIT_L(0); MMA(0, 1, At, B1); BAR;
        LDA(At, 0, 1); STAGE(SA(0, 0), A, brow, t + 2);
        BAR; WAIT_L(0); MMA(1, 0, At, B0); BAR; SCHED;
        STAGE(SB(0, 1), Bt, bcol + HALF, t + 2);
        WAIT_V(6); BAR; MMA(1, 1, At, B1); BAR;
        LDB(B0, 1, 0); SCHED; LDA(At, 1, 0); STAGE(SA(0, 1), A, brow + HALF, t + 2);
        WAIT_L(8); BAR; WAIT_L(0); MMA(0, 0, At, B0); BAR; SCHED;
        LDB(B1, 1, 1); STAGE(SB(1, 0), Bt, bcol, t + 3);
        BAR; WAIT_L(0); MMA(0, 1, At, B1); BAR;
        LDA(At, 1, 1); STAGE(SA(1, 0), A, brow, t + 3);
        BAR; WAIT_L(0); MMA(1, 0, At, B0); BAR; SCHED;
        STAGE(SB(1, 1), Bt, bcol + HALF, t + 3);
        WAIT_V(6); BAR; MMA(1, 1, At, B1); BAR;
    }
    { LDB(B0, 0, 0); LDA(At, 0, 0); STAGE(SA(1, 1), A, brow + HALF, nt - 1);
      BAR; WAIT_L(0); MMA(0, 0, At, B0); BAR;
      LDB(B1, 0, 1); BAR; WAIT_L(0); MMA(0, 1, At, B1); BAR;
      LDA(At, 0, 1); WAIT_V(4); BAR; WAIT_L(0); MMA(1, 0, At, B0); MMA(1, 1, At, B1); BAR; }
    { LDB(B0, 1, 0); LDA(At, 1, 0); WAIT_V(2); BAR; WAIT_L(0); MMA(0, 0, At, B0); BAR;
      LDB(B1, 1, 1); WAIT_V(0); BAR; WAIT_L(0); MMA(0, 1, At, B1); BAR;
      LDA(At, 1, 1); BAR; WAIT_L(0); MMA(1, 0, At, B0); MMA(1, 1, At, B1); BAR; }
    if (wr == 0) BAR;
}

DI void tile_of(int L, int nM, int nN, int& pm, int& pn) {
    const int nwg = nM * nN; int wgid = L;
    { const int q = nwg / NXCD, r = nwg % NXCD, xcd = wgid % NXCD, off = wgid / NXCD; wgid = (xcd < r ? xcd * (q + 1) : r * (q + 1) + (xcd - r) * q) + off; }
    const int nig = WGM * nN, gid = wgid / nig, fm = gid * WGM, gsz = min(nM - fm, WGM);
    pm = fm + ((wgid % nig) % gsz); pn = (wgid % nig) / gsz;
}

constexpr int CST = 260;
DI void stage_half(const f32x4 (&acc)[2][2][4][2], const int ai) {
    const int tid_ = opaque_tid(), wid = tid_ >> 6, lane = tid_ & 63, wr = wid >> 2, wc = wid & 3, fr = lane & 15, fq = lane >> 4;
    float* base = (float*)dyn_smem + (wr * 64 + fq * 4) * CST + wc * 32 + fr;
#pragma unroll
    for (int m = 0; m < 4; ++m)
#pragma unroll
        for (int j = 0; j < 4; ++j)
#pragma unroll
            for (int bj = 0; bj < 2; ++bj)
#pragma unroll
                for (int n = 0; n < 2; ++n) base[(m * 16 + j) * CST + bj * 128 + n * 16] = ai == 0 ? acc[0][bj][m][n][j] : acc[1][bj][m][n][j];
}
#define CT ((const float*)dyn_smem)

DI void epi_in_half(const Params& p, int pm, int pn, int ai) {
    unsigned char* ws = p.ws;
    const int tid = opaque_tid(), brow = pm * BM + ai * 128, bcol = pn * BM;
    const bool samp = pm == 128;
    if (pn < 8) {
        bf16_t* dst = pn < 6 ? (bf16_t*)(ws + WS_R2) : (bf16_t*)(ws + WS_R3);
        const int ld = pn < 6 ? 1536 : 512, c0 = pn < 6 ? bcol : bcol - 1536;
#pragma unroll 4
        for (int i = 0; i < 16; ++i) {
            const int id = tid + 512 * i, r = id >> 6, c4 = (id & 63) * 4, row = brow + r;
            const f32x4 v = *(const f32x4*)(CT + r * CST + c4);
            u32x2 o; o.x = pk2(v.x, v.y); o.y = pk2(v.z, v.w);
            *(u32x2*)(dst + (size_t)row * ld + c0 + c4) = o;
            if (pn < 6) {
                if (!samp) { const int t = row & (TP - 1); if (t >= TP - 3) *(f32x4*)(p.out + O_CQP + (size_t)((row >> 13) * 3 + t - (TP - 3)) * 1536 + c0 + c4) = v; }
                else { const int rr = row - MP, t = rr & 31; if (t >= TS - 3) *(f32x4*)(p.out + O_CQS + (size_t)((rr >> 5) * 3 + t - (TS - 3)) * 1536 + c0 + c4) = v; }
            }
        }
        return;
    }
    if (pn < 12) {
        const bool isq = pn < 10;
        const float* rope = (const float*)(ws + WS_ROPE);
        bf16_t* QB = (bf16_t*)(ws + WS_R4); bf16_t* KALL = (bf16_t*)(ws + WS_R5);
        const float qs = 0.125f * 1.4426950408889634f;
#pragma unroll 2
        for (int i = 0; i < 8; ++i) {
            const int id = tid + 512 * i, r = id >> 5, q = id & 31, hl = q >> 4, map = (q >> 3) & 1, d4 = (q & 7) * 4, row = brow + r;
            const int cl = hl * 128 + map * 64 + d4, col = ((pn & 1) * 2 + hl) * 128 + map * 64 + d4;
            const f32x4 x1 = *(const f32x4*)(CT + r * CST + cl), x2 = *(const f32x4*)(CT + r * CST + cl + 32);
            int pos; size_t krow; float* kout;
            if (!samp) { pos = row & (TP - 1); krow = row; kout = p.out + O_KP + (size_t)row * 512; }
            else { const int rr = row - MP; pos = PAST + (rr & 31); krow = (size_t)MP + (size_t)(rr >> 5) * TKS + pos; kout = p.out + O_KS + (size_t)rr * 512; }
            const f32x4 t0 = *(const f32x4*)(rope + (size_t)(pos * 32 + d4) * 2), t1 = *(const f32x4*)(rope + (size_t)(pos * 32 + d4) * 2 + 4);
            const f32x4 cs = (f32x4){t0.x, t0.z, t1.x, t1.z}, sn = (f32x4){t0.y, t0.w, t1.y, t1.w};
            const f32x4 y1 = x1 * cs - x2 * sn, y2 = x2 * cs + x1 * sn;
            if (isq) {
                u32x2 o1, o2; o1.x = pk2(y1.x * qs, y1.y * qs); o1.y = pk2(y1.z * qs, y1.w * qs); o2.x = pk2(y2.x * qs, y2.y * qs); o2.y = pk2(y2.z * qs, y2.w * qs);
                *(u32x2*)(QB + (size_t)row * 512 + col) = o1; *(u32x2*)(QB + (size_t)row * 512 + col + 32) = o2;
            } else {
                *(f32x4*)(kout + col) = y1; *(f32x4*)(kout + col + 32) = y2;
                u32x2 o1, o2; o1.x = pk2(y1.x, y1.y); o1.y = pk2(y1.z, y1.w); o2.x = pk2(y2.x, y2.y); o2.y = pk2(y2.z, y2.w);
                *(u32x2*)(KALL + krow * 512 + col) = o1; *(u32x2*)(KALL + krow * 512 + col + 32) = o2;
            }
        }
        return;
    }
    {
        bf16_t* VT = (bf16_t*)(ws + WS_R6);
#pragma unroll 4
        for (int i = 0; i < 16; ++i) {
            const int id = tid + 512 * i, r = id >> 6, c4 = (id & 63) * 4, row = brow + r, col = (pn & 1) * 256 + c4;
            const f32x4 v = *(const f32x4*)(CT + r * CST + c4);
            float* vout = samp ? p.out + O_VS + (size_t)(row - MP) * 512 + col : p.out + O_VP + (size_t)row * 512 + col;
            *(f32x4*)vout = v;
        }
#pragma unroll 1
        for (int i = 0; i < 2; ++i) {
            const int id = tid + 512 * i, rg = id >> 6, c4 = (id & 63) * 4, row0 = brow + rg * 8;
            f32x4 v[8];
#pragma unroll
            for (int e = 0; e < 8; ++e) v[e] = *(const f32x4*)(CT + (rg * 8 + e) * CST + c4);
#pragma unroll
            for (int e = 0; e < 4; ++e) {
                const int colg = (pn & 1) * 256 + c4 + e, head = colg >> 7, dv = colg & 127;
                u32x4 o; o.x = pk2(v[0][e], v[1][e]); o.y = pk2(v[2][e], v[3][e]); o.z = pk2(v[4][e], v[5][e]); o.w = pk2(v[6][e], v[7][e]);
                bf16_t* d;
                if (samp) { const int rr = row0 - MP; d = VT + VT_S_OFF + ((size_t)(((rr >> 5) * 4 + head) * 128 + dv) * TKS + PAST + (rr & 31)); }
                else d = VT + ((size_t)(((row0 >> 13) * 4 + head) * 128 + dv) * TP + (row0 & (TP - 1)));
                *(u32x4*)d = o;
            }
        }
    }
}

template <int WHICH> DI void epi_res_half(const Params& p, int pm, int pn, int ai) {
    const int tid = opaque_tid(), brow = pm * BM + ai * 128, bcol = pn * BM;
#pragma unroll 4
    for (int i = 0; i < 16; ++i) {
        const int id = tid + 512 * i, r = id >> 6, c4 = (id & 63) * 4, row = brow + r;
        const f32x4 v = *(const f32x4*)(CT + r * CST + c4);
        float* o = p.out + O_Y + (size_t)row * D + bcol + c4;
        const float* rs = WHICH == 0 ? xrow_ptr(p, row) + bcol + c4 : o;
        const f32x4 x = *(const f32x4*)rs;
        *(f32x4*)o = x * ALPHA + v;
    }
}

constexpr int UST = 264;
DI void epi_up(const Params& p, const f32x4 (&acc)[2][2][4][2], int pm, int pn) {
    unsigned char* ws = p.ws;
    bf16_t* U = (bf16_t*)dyn_smem;
    float* BND = (float*)(ws + WS_R5);
    const bool samp = pm == 128;
    const int brow = pm * BM, tid = opaque_tid();
    {
        const int wid = tid >> 6, lane = tid & 63, wr = wid >> 2, wc = wid & 3, fr = lane & 15, fq = lane >> 4;
        bf16_t* base = U + (wr * 64 + fq * 4) * UST + wc * 32 + fr;
#pragma unroll
        for (int ai = 0; ai < 2; ++ai)
#pragma unroll
            for (int m = 0; m < 4; ++m)
#pragma unroll
                for (int j = 0; j < 4; ++j)
#pragma unroll
                    for (int bj = 0; bj < 2; ++bj)
#pragma unroll
                        for (int n = 0; n < 2; ++n) base[(ai * 128 + m * 16 + j) * UST + bj * 128 + n * 16] = f2bf(acc[ai][bj][m][n][j]);
    }
    __syncthreads();
    {
        const int nb = samp ? 32 * 256 : 4 * 256;
        for (int id = tid; id < nb; id += 512) {
            const int cl = id & 255, q = id >> 8;
            const int oc = (cl >> 7) * DFF + 128 * pn + (cl & 127);
            int rr, bslot, u;
            if (!samp) { bslot = q; rr = q < 2 ? q : 252 + q; u = pm; }
            else { bslot = q & 3; rr = (q >> 2) * 32 + (bslot < 2 ? bslot : 28 + bslot); u = 128 + (q >> 2); }
            const float v = bf2f(U[rr * UST + cl]);
            BND[((size_t)u * 4 + bslot) * NUP + oc] = v;
            if (bslot >= 2) {
                if (samp) p.out[O_CFS + (size_t)((q >> 2) * 2 + bslot - 2) * NUP + oc] = v;
                else if ((pm & 31) == 31) p.out[O_CFP + (size_t)((pm >> 5) * 2 + bslot - 2) * NUP + oc] = v;
            }
        }
    }
    {
        const int c = tid & 127, rs = tid >> 7, cg_ = 128 * pn + c, cv_ = DFF + 128 * pn + c;
        const float wg0 = p.ffn_conv_w[cg_], wg1 = p.ffn_conv_w[NUP + cg_], wg2 = p.ffn_conv_w[2 * NUP + cg_], bg = p.ffn_conv_b[cg_];
        const float wv0 = p.ffn_conv_w[cv_], wv1 = p.ffn_conv_w[NUP + cv_], wv2 = p.ffn_conv_w[2 * NUP + cv_], bv = p.ffn_conv_b[cv_];
        bf16_t* GT = (bf16_t*)(ws + WS_R1);
        const int r0 = rs * 64;
        float g1 = 0.f, g2 = 0.f, v1 = 0.f, v2 = 0.f;
        if (r0 >= 2) { g1 = bf2f(U[(r0 - 2) * UST + c]); g2 = bf2f(U[(r0 - 1) * UST + c]); v1 = bf2f(U[(r0 - 2) * UST + 128 + c]); v2 = bf2f(U[(r0 - 1) * UST + 128 + c]); }
#pragma unroll 4
        for (int r = r0; r < r0 + 64; ++r) {
            const float g3 = bf2f(U[r * UST + c]), v3 = bf2f(U[r * UST + 128 + c]);
            const bool skip = samp ? ((r & 31) < 2) : (r < 2);
            if (!skip) {
                const float cg2 = wg0 * g1 + wg1 * g2 + wg2 * g3 + bg, cv2 = wv0 * v1 + wv1 * v2 + wv2 * v3 + bv;
                GT[(size_t)(brow + r) * DFF + 128 * pn + c] = f2bf(silu(cg2) * cv2);
            }
            g1 = g2; g2 = g3; v1 = v2; v2 = v3;
        }
    }
}

template <int K> DI void skinny_gemm(const bf16_t* __restrict__ A, const bf16_t* __restrict__ Bt, float* __restrict__ C, const int N) {
    const int tid = opaque_tid(), lane = tid & 63, w = __builtin_amdgcn_readfirstlane(tid >> 6), fr = lane & 15, fq = lane >> 4;
    float* red = (float*)dyn_smem;
    constexpr int KW = K / 8, NKS = KW / 32;
    const int ntile = 8 * (N / 32);
    for (int t = blockIdx.x; t < ntile; t += gridDim.x) {
        const int rm = t & 7, cn = t >> 3;
        const bf16_t* ap = A + (size_t)(32 * rm + fr) * K + w * KW + 8 * fq;
        const bf16_t* bp = Bt + (size_t)(32 * cn + fr) * K + w * KW + 8 * fq;
        f32x4 acc[2][2];
#pragma unroll
        for (int i = 0; i < 2; ++i)
#pragma unroll
            for (int j = 0; j < 2; ++j) acc[i][j] = (f32x4){0.f, 0.f, 0.f, 0.f};
#pragma unroll 4
        for (int ks = 0; ks < NKS; ++ks) {
            const bf16x8 a0 = *(const bf16x8*)(ap + ks * 32), a1 = *(const bf16x8*)(ap + (size_t)16 * K + ks * 32);
            const bf16x8 b0 = *(const bf16x8*)(bp + ks * 32), b1 = *(const bf16x8*)(bp + (size_t)16 * K + ks * 32);
            acc[0][0] = __builtin_amdgcn_mfma_f32_16x16x32_bf16(a0, b0, acc[0][0], 0, 0, 0);
            acc[0][1] = __builtin_amdgcn_mfma_f32_16x16x32_bf16(a0, b1, acc[0][1], 0, 0, 0);
            acc[1][0] = __builtin_amdgcn_mfma_f32_16x16x32_bf16(a1, b0, acc[1][0], 0, 0, 0);
            acc[1][1] = __builtin_amdgcn_mfma_f32_16x16x32_bf16(a1, b1, acc[1][1], 0, 0, 0);
        }
        __syncthreads();
#pragma unroll
        for (int i = 0; i < 2; ++i)
#pragma unroll
            for (int j = 0; j < 2; ++j)
#pragma unroll
                for (int e = 0; e < 4; ++e) red[(w * 32 + 16 * i + 4 * fq + e) * 33 + 16 * j + fr] = acc[i][j][e];
        __syncthreads();
#pragma unroll
        for (int o2 = 0; o2 < 2; ++o2) {
            const int o = tid + 512 * o2, r = o >> 5, c = o & 31;
            float sum = 0.f;
#pragma unroll
            for (int ww = 0; ww < 8; ++ww) sum += red[(ww * 32 + r) * 33 + c];
            C[(size_t)(32 * rm + r) * N + 32 * cn + c] = sum;
        }
    }
    __syncthreads();
}

template <int WHICH> DI void gemm_phase(const Params& p) {
    unsigned char* ws = p.ws;
    const bf16_t* A; const bf16_t* Bt; int N; constexpr int K = WHICH == 4 ? DFF : D; float* CS;
    if (WHICH == 1) { A = (const bf16_t*)(ws + WS_R1); Bt = (const bf16_t*)(ws + WS_WIN); N = NH1; CS = (float*)(ws + WS_CS1); }
    else if (WHICH == 2) { A = (const bf16_t*)(ws + WS_R2); Bt = (const bf16_t*)(ws + WS_WO); N = D; CS = (float*)(ws + WS_CS2); }
    else if (WHICH == 3) { A = (const bf16_t*)(ws + WS_R3); Bt = (const bf16_t*)(ws + WS_WUP); N = NUP; CS = (float*)(ws + WS_CS3); }
    else { A = (const bf16_t*)(ws + WS_R1); Bt = (const bf16_t*)(ws + WS_WDN); N = D; CS = (float*)(ws + WS_CS4); }
    skinny_gemm<K>(A + (size_t)MP * K, Bt, CS, N);
    const int nM = MP / BM, nN = N / BM, ntile = nM * nN;
    for (int L0 = blockIdx.x; L0 < ntile * (WHICH == GREP_WHICH ? 2 : 1); L0 += gridDim.x) {
        const int L = L0 % ntile;
        int pm, pn; tile_of(L, nM, nN, pm, pn);
        f32x4 acc[2][2][4][2];
        gemm_tile<K>(A, Bt, pm * BM, pn * BM, acc);
        if (WHICH == 3) epi_up(p, acc, pm, pn);
        else {
#pragma unroll
            for (int ai = 0; ai < 2; ++ai) {
                stage_half(acc, ai);
                __syncthreads();
                if (WHICH == 1) epi_in_half(p, pm, pn, ai);
                else if (WHICH == 2) epi_res_half<0>(p, pm, pn, ai);
                else epi_res_half<1>(p, pm, pn, ai);
                __syncthreads();
            }
        }
        __syncthreads();
    }
}

template <int WHICH> DI void ln_phase(const Params& p) {
    const int lane = threadIdx.x & 63, wave = threadIdx.x >> 6;
    const float* g = WHICH == 0 ? p.ln1_g : p.ln2_g; const float* b = WHICH == 0 ? p.ln1_b : p.ln2_b;
    bf16_t* X1B = (bf16_t*)(p.ws + WS_R3);
    f32x4 gv[4], bv[4];
#pragma unroll
    for (int j = 0; j < 4; ++j) { gv[j] = *(const f32x4*)(g + lane * 4 + 256 * j); bv[j] = *(const f32x4*)(b + lane * 4 + 256 * j); }
    for (int row = blockIdx.x * 8 + wave; row < M; row += gridDim.x * 8) {
        float* xr = p.out + O_Y + (size_t)row * D;
        f32x4 v[4]; float s = 0.f;
        if (row < MP) {
#pragma unroll
            for (int j = 0; j < 4; ++j) v[j] = *(const f32x4*)(xr + lane * 4 + 256 * j);
        } else {
            const float* rs = WHICH == 0 ? p.x_s + (size_t)(row - MP) * D : xr;
            const float* cs = (const float*)(p.ws + (WHICH == 0 ? WS_CS2 : WS_CS4)) + (size_t)(row - MP) * D;
#pragma unroll
            for (int j = 0; j < 4; ++j) v[j] = *(const f32x4*)(rs + lane * 4 + 256 * j) * ALPHA + *(const f32x4*)(cs + lane * 4 + 256 * j);
        }
#pragma unroll
        for (int j = 0; j < 4; ++j) s += (v[j].x + v[j].y) + (v[j].z + v[j].w);
        const float mean = wave_sum(s) * (1.f / D); float s2 = 0.f;
#pragma unroll
        for (int j = 0; j < 4; ++j) { v[j] = v[j] - mean; s2 += (v[j].x * v[j].x + v[j].y * v[j].y) + (v[j].z * v[j].z + v[j].w * v[j].w); }
        const float rstd = rsqrtf(wave_sum(s2) * (1.f / D) + 1e-5f);
#pragma unroll
        for (int j = 0; j < 4; ++j) {
            const f32x4 o = v[j] * rstd * gv[j] + bv[j];
            *(f32x4*)(xr + lane * 4 + 256 * j) = o;
            if (WHICH == 0) { u32x2 q; q.x = pk2(o.x, o.y); q.y = pk2(o.z, o.w); *(u32x2*)(X1B + (size_t)row * D + lane * 4 + 256 * j) = q; }
        }
    }
}

DI void fixup_phase(const Params& p) {
    const float* BND = (const float*)(p.ws + WS_R5);
    bf16_t* GT = (bf16_t*)(p.ws + WS_R1);
    {
        const float* CS3 = (const float*)(p.ws + WS_CS3);
        for (int idx = blockIdx.x * 512 + threadIdx.x; idx < MS * DFF; idx += gridDim.x * 512) {
            const int c = idx % DFF, r = idx / DFF, b = r >> 5, t = r & 31, ng = (c >> 7) * 256 + (c & 127), nv = ng + 128;
            float g[3], v[3];
#pragma unroll
            for (int k = 0; k < 3; ++k) {
                const int tt = t - 2 + k;
                if (tt >= 0) { g[k] = CS3[(size_t)(b * 32 + tt) * NUP + ng]; v[k] = CS3[(size_t)(b * 32 + tt) * NUP + nv]; }
                else { g[k] = p.state_cf[(size_t)(b * 2 + 2 + tt) * NUP + c]; v[k] = p.state_cf[(size_t)(b * 2 + 2 + tt) * NUP + DFF + c]; }
            }
            const float cg2 = p.ffn_conv_w[c] * g[0] + p.ffn_conv_w[NUP + c] * g[1] + p.ffn_conv_w[2 * NUP + c] * g[2] + p.ffn_conv_b[c];
            const float cv2 = p.ffn_conv_w[DFF + c] * v[0] + p.ffn_conv_w[NUP + DFF + c] * v[1] + p.ffn_conv_w[2 * NUP + DFF + c] * v[2] + p.ffn_conv_b[DFF + c];
            GT[((size_t)MP + r) * DFF + c] = f2bf(silu(cg2) * cv2);
            if (t >= 30) { p.out[O_CFS + (size_t)(b * 2 + t - 30) * NUP + c] = g[2]; p.out[O_CFS + (size_t)(b * 2 + t - 30) * NUP + DFF + c] = v[2]; }
        }
    }
    const int total = 128 * 2 * DFF;
    for (int idx = blockIdx.x * 512 + threadIdx.x; idx < total; idx += gridDim.x * 512) {
        const int c = idx % DFF, q = idx / DFF, r = q & 1, u = q >> 1;
        const float* cur = BND + (size_t)u * 4 * NUP;
        float pg[2], pv[2];
        if (u < 128) {
            if ((u & 31) == 0) { pg[0] = pg[1] = pv[0] = pv[1] = 0.f; }
            else { const float* pr = BND + (size_t)(u - 1) * 4 * NUP; pg[0] = pr[2 * NUP + c]; pg[1] = pr[3 * NUP + c]; pv[0] = pr[2 * NUP + DFF + c]; pv[1] = pr[3 * NUP + DFF + c]; }
        } else { const float* st = p.state_cf + (size_t)(u - 128) * 2 * NUP; pg[0] = st[c]; pg[1] = st[NUP + c]; pv[0] = st[DFF + c]; pv[1] = st[NUP + DFF + c]; }
        const float cg0 = cur[c], cg1 = cur[NUP + c], cv0 = cur[DFF + c], cv1 = cur[NUP + DFF + c];
        const float wg0 = p.ffn_conv_w[c], wg1 = p.ffn_conv_w[NUP + c], wg2 = p.ffn_conv_w[2 * NUP + c], bg = p.ffn_conv_b[c];
        const float wv0 = p.ffn_conv_w[DFF + c], wv1 = p.ffn_conv_w[NUP + DFF + c], wv2 = p.ffn_conv_w[2 * NUP + DFF + c], bv = p.ffn_conv_b[DFF + c];
        float g, v;
        if (r == 0) { g = wg0 * pg[0] + wg1 * pg[1] + wg2 * cg0 + bg; v = wv0 * pv[0] + wv1 * pv[1] + wv2 * cv0 + bv; }
        else { g = wg0 * pg[1] + wg1 * cg0 + wg2 * cg1 + bg; v = wv0 * pv[1] + wv1 * cv0 + wv2 * cv1 + bv; }
        const size_t row = u < 128 ? (size_t)u * 256 + r : (size_t)MP + (size_t)(u - 128) * 32 + r;
        GT[row * DFF + c] = f2bf(silu(g) * v);
    }
}

#define MFMA16(a, b, c) __builtin_amdgcn_mfma_f32_16x16x32_bf16((a), (b), (c), 0, 0, 0)
#define MFMA32(a, b, c) __builtin_amdgcn_mfma_f32_32x32x16_bf16((a), (b), (c), 0, 0, 0)
DI bf16x8 pack8(const f32x4 a, const f32x4 b) { u32x4 o; o.x = pk2(a.x, a.y); o.y = pk2(a.z, a.w); o.z = pk2(b.x, b.y); o.w = pk2(b.z, b.w); return __builtin_bit_cast(bf16x8, o); }
constexpr float GSCALE = 0.08838834764831845f;
constexpr int QST = 132, AST = 68, NST = 136, QKST = 72;
constexpr int L_QKV = 0, L_AM = 3 * 64 * QST * 4, L_KN = L_AM + 64 * AST * 4, L_QN = L_KN + 64 * NST * 2, L_GC = L_QN + 64 * NST * 2;
constexpr int L_QKS = 0, L_WS = 64 * QKST * 2;
static_assert(L_GC + 1024 <= LDS_BYTES, "gdn prep LDS");

DI void gdn_prep_phase(const Params& p) {
    unsigned char* ws = p.ws;
    float* QKVf = (float*)(dyn_smem + L_QKV); float* AM = (float*)(dyn_smem + L_AM);
    bf16_t* KN = (bf16_t*)(dyn_smem + L_KN); bf16_t* QN = (bf16_t*)(dyn_smem + L_QN);
    float* GC = (float*)(dyn_smem + L_GC); float* BETA = GC + 64; float* EG = GC + 128; float* ED = GC + 192;
    bf16_t* QKS = (bf16_t*)(dyn_smem + L_QKS); bf16_t* WSI = (bf16_t*)(dyn_smem + L_WS);
    const bf16_t* HQKV = (const bf16_t*)(ws + WS_R2);
    const float* AB = (const float*)(ws + WS_AB);
    float* DL = (float*)(ws + WS_DL);
    for (int r = blockIdx.x; r < MS; r += gridDim.x) {
        const int tid = opaque_tid(), b = r >> 5, t = r & 31, pos = PAST + t;
        const float* cs = (const float*)(ws + WS_CS1) + (size_t)r * NH1;
        if (t >= TS - 3) { for (int c = tid; c < 1536; c += 512) p.out[O_CQS + (size_t)(b * 3 + t - (TS - 3)) * 1536 + c] = cs[c]; }
        {
            const int which = tid >> 8, pr = tid & 255, hd = pr >> 6, mp = (pr >> 5) & 1, d = pr & 31, col = hd * 128 + mp * 64 + d;
            const float2 csn = ((const float2*)(ws + WS_ROPE))[pos * 32 + d];
            const float x1 = cs[2048 + which * 512 + col], x2 = cs[2048 + which * 512 + col + 32];
            const float y1 = x1 * csn.x - x2 * csn.y, y2 = x2 * csn.x + x1 * csn.y;
            if (which == 0) { const float qs = 0.125f * 1.4426950408889634f; bf16_t* QB = (bf16_t*)(ws + WS_R4) + ((size_t)MP + r) * 512; QB[col] = f2bf(y1 * qs); QB[col + 32] = f2bf(y2 * qs); }
            else { float* ko = p.out + O_KS + (size_t)r * 512; ko[col] = y1; ko[col + 32] = y2;
                   bf16_t* kk = (bf16_t*)(ws + WS_R5) + ((size_t)MP + (size_t)b * TKS + pos) * 512; kk[col] = f2bf(y1); kk[col + 32] = f2bf(y2); }
        }
        {
            const float vv = cs[3072 + tid];
            p.out[O_VS + (size_t)r * 512 + tid] = vv;
            ((bf16_t*)(ws + WS_R6))[VT_S_OFF + ((size_t)((b * 4 + (tid >> 7)) * 128 + (tid & 127)) * TKS + pos)] = f2bf(vv);
        }
    }
    for (int item = blockIdx.x; item < NITEM; item += gridDim.x) {
        const int tid = opaque_tid(), lane = tid & 63, wave = __builtin_amdgcn_readfirstlane(tid >> 6), fr = lane & 15, fq = lane >> 4;
        int h, b, c, row0, valid; bool samp;
        if (item < 2048) { h = item & 3; c = (item >> 2) & 127; b = item >> 9; row0 = b * TP + c * 64; valid = 64; samp = false; }
        else { const int j = item - 2048; h = j & 3; b = j >> 2; c = 0; row0 = MP + b * TS; valid = TS; samp = true; }
        unsigned char* ip = ws + WS_R1 + (size_t)item * ITEM_B;
        __syncthreads();
        {
            bf16_t* RAW = (bf16_t*)(dyn_smem + L_AM);
#pragma unroll
            for (int i = 0; i < 7; ++i) {
                const int id = tid + 512 * i;
                if (id < 67 * 48) {
                    const int rw = id / 48, ch = id % 48, part = ch >> 4, c8 = (ch & 15) * 8, gcol = part * 512 + h * 128 + c8, t = rw - 3;
                    u32x4 v = (u32x4){0u, 0u, 0u, 0u};
                    if (t >= 0) {
                        if (t < valid) {
                            if (!samp) v = *(const u32x4*)(HQKV + (size_t)(row0 + t) * 1536 + gcol);
                            else { const float* sp = (const float*)(ws + WS_CS1) + (size_t)(row0 - MP + t) * NH1 + gcol; const f32x4 f0 = *(const f32x4*)sp, f1 = *(const f32x4*)(sp + 4);
                                   v.x = pk2(f0.x, f0.y); v.y = pk2(f0.z, f0.w); v.z = pk2(f1.x, f1.y); v.w = pk2(f1.z, f1.w); }
                        }
                    }
                    else if (samp) { const float* sp = p.state_cq + (size_t)(b * 3 + 3 + t) * 1536 + gcol; const f32x4 f0 = *(const f32x4*)sp, f1 = *(const f32x4*)(sp + 4);
                                     v.x = pk2(f0.x, f0.y); v.y = pk2(f0.z, f0.w); v.z = pk2(f1.x, f1.y); v.w = pk2(f1.z, f1.w); }
                    else if (c != 0) v = *(const u32x4*)(HQKV + (size_t)(row0 + t) * 1536 + gcol);
                    *(u32x4*)(RAW + rw * 384 + ch * 8) = v;
                }
            }
            __syncthreads();
#pragma unroll 1
            for (int task = tid; task < 1536; task += 512) {
                const int col = task % 384, seg = task / 384, part = col >> 7, cc = col & 127, gcol = part * 512 + h * 128 + cc, t0 = seg * 16;
                const float w0 = p.gdn_conv_w[gcol], w1 = p.gdn_conv_w[1536 + gcol], w2 = p.gdn_conv_w[2 * 1536 + gcol], w3 = p.gdn_conv_w[3 * 1536 + gcol];
                float x0 = bf2f(RAW[(t0) * 384 + col]), x1 = bf2f(RAW[(t0 + 1) * 384 + col]), x2 = bf2f(RAW[(t0 + 2) * 384 + col]);
#pragma unroll
                for (int t = t0; t < t0 + 16; ++t) {
                    const float xv = bf2f(RAW[(t + 3) * 384 + col]);
                    const float y = w0 * x0 + w1 * x1 + w2 * x2 + w3 * xv;
                    QKVf[(part * 64 + t) * QST + cc] = t < valid ? silu(y) : 0.f;
                    x0 = x1; x1 = x2; x2 = xv;
                }
            }
        }
        if (tid < 64) {
            float g = 0.f, be = 0.f;
            if (tid < valid) {
                const float a = AB[(size_t)(row0 + tid) * 8 + h] + p.dt_bias[h], bb = AB[(size_t)(row0 + tid) * 8 + 4 + h];
                const float sp = a > 20.f ? a : log1pf(expf(a));
                g = -expf(p.a_log[h]) * sp; be = 1.f / (1.f + expf(-bb));
            }
            float gc = g;
#pragma unroll
            for (int o = 1; o < 64; o <<= 1) { const float n = __shfl_up(gc, o); if (lane >= o) gc += n; }
            const float gl = __shfl(gc, 63);
            GC[tid] = gc; BETA[tid] = be; EG[tid] = expf(gc); ED[tid] = expf(gl - gc);
            if (tid == 0) DL[item] = expf(gl);
        }
        __syncthreads();
        {
            const int row = tid >> 3, pt = tid & 7;
            float q[16], k[16]; float sq = 0.f, sk = 0.f;
#pragma unroll
            for (int e4 = 0; e4 < 4; ++e4) {
                const f32x4 a = *(const f32x4*)(QKVf + row * QST + 16 * pt + 4 * e4), bq = *(const f32x4*)(QKVf + (64 + row) * QST + 16 * pt + 4 * e4);
#pragma unroll
                for (int e = 0; e < 4; ++e) { q[4 * e4 + e] = a[e]; k[4 * e4 + e] = bq[e]; sq += a[e] * a[e]; sk += bq[e] * bq[e]; }
            }
#pragma unroll
            for (int o = 1; o < 8; o <<= 1) { sq += __shfl_xor(sq, o); sk += __shfl_xor(sk, o); }
            const float rq = rsqrtf(sq + 1e-6f), rk = rsqrtf(sk + 1e-6f), qg = rq * GSCALE * EG[row];
            u32x4 o0, o1;
            o0.x = pk2(q[0] * rq, q[1] * rq); o0.y = pk2(q[2] * rq, q[3] * rq); o0.z = pk2(q[4] * rq, q[5] * rq); o0.w = pk2(q[6] * rq, q[7] * rq);
            o1.x = pk2(q[8] * rq, q[9] * rq); o1.y = pk2(q[10] * rq, q[11] * rq); o1.z = pk2(q[12] * rq, q[13] * rq); o1.w = pk2(q[14] * rq, q[15] * rq);
            *(u32x4*)(QN + row * NST + 16 * pt) = o0; *(u32x4*)(QN + row * NST + 16 * pt + 8) = o1;
            o0.x = pk2(k[0] * rk, k[1] * rk); o0.y = pk2(k[2] * rk, k[3] * rk); o0.z = pk2(k[4] * rk, k[5] * rk); o0.w = pk2(k[6] * rk, k[7] * rk);
            o1.x = pk2(k[8] * rk, k[9] * rk); o1.y = pk2(k[10] * rk, k[11] * rk); o1.z = pk2(k[12] * rk, k[13] * rk); o1.w = pk2(k[14] * rk, k[15] * rk);
            *(u32x4*)(KN + row * NST + 16 * pt) = o0; *(u32x4*)(KN + row * NST + 16 * pt + 8) = o1;
#pragma unroll
            for (int e4 = 0; e4 < 4; ++e4) *(f32x4*)(QKVf + (64 + row) * QST + 16 * pt + 4 * e4) = (f32x4){k[4 * e4] * rk, k[4 * e4 + 1] * rk, k[4 * e4 + 2] * rk, k[4 * e4 + 3] * rk};
            bf16_t* QGf = (bf16_t*)(ip + 16384);
            const int rt = row >> 4, frr = row & 15, ks = pt >> 1;
#pragma unroll
            for (int f = 0; f < 4; ++f) {
                u32x2 o; o.x = pk2(q[4 * f] * qg, q[4 * f + 1] * qg); o.y = pk2(q[4 * f + 2] * qg, q[4 * f + 3] * qg);
                *(u32x2*)(QGf + (size_t)(((rt * 4 + ks) * 64 + f * 16 + frr) * 8 + 4 * (pt & 1))) = o;
            }
        }
        __syncthreads();
        {
            const bool isq = wave >= 4; const int ti = wave & 3;
            const bf16_t* As = isq ? QN : KN;
#pragma unroll
            for (int tj = 0; tj < 4; ++tj) {
                f32x4 acc = (f32x4){0.f, 0.f, 0.f, 0.f};
#pragma unroll
                for (int ks = 0; ks < 4; ++ks) {
                    const bf16x8 a = *(const bf16x8*)(As + (16 * ti + fr) * NST + 32 * ks + 8 * fq), bb = *(const bf16x8*)(KN + (16 * tj + fr) * NST + 32 * ks + 8 * fq);
                    acc = MFMA16(a, bb, acc);
                }
                const int jj = 16 * tj + fr; const float gj = GC[jj];
#pragma unroll
                for (int j = 0; j < 4; ++j) {
                    const int i = 16 * ti + 4 * fq + j;
                    const float dec = i >= jj ? expf(GC[i] - gj) : 0.f;
                    if (!isq) AM[i * AST + jj] = i > jj ? BETA[i] * acc[j] * dec : 0.f;
                    else QKS[i * QKST + jj] = f2bf(GSCALE * acc[j] * dec);
                }
            }
            bf16_t* KDTf = (bf16_t*)(ip + 32768);
#pragma unroll
            for (int i2 = 0; i2 < 2; ++i2) {
                const int f = tid + 512 * i2, ln = f & 63, ks2 = (f >> 6) & 1, dt = f >> 7, fq_ = ln >> 4, dk = 16 * dt + (ln & 15);
                float v[8];
#pragma unroll
                for (int e = 0; e < 8; ++e) { const int i = 32 * ks2 + 16 * (e >> 2) + 4 * fq_ + (e & 3); v[e] = bf2f(KN[i * NST + dk]) * ED[i]; }
                u32x4 o; o.x = pk2(v[0], v[1]); o.y = pk2(v[2], v[3]); o.z = pk2(v[4], v[5]); o.w = pk2(v[6], v[7]);
                *(u32x4*)(KDTf + (size_t)f * 8) = o;
            }
        }
        __syncthreads();
        {
            float* TM = (float*)(dyn_smem + L_QN);
            float* TMP = (float*)(dyn_smem + L_KN);
#pragma unroll
            for (int i = 0; i < 9; ++i) { const int id = tid + 512 * i; if (id < 64 * AST) TM[id] = 0.f; }
            __syncthreads();
            if (tid < 64) {
                const int d = tid >> 4, c = tid & 15;
                float y[16];
#pragma unroll
                for (int r = 0; r < 16; ++r) {
                    float sacc = r == c ? 1.f : 0.f;
                    const float* ar = AM + (16 * d + r) * AST + 16 * d;
#pragma unroll
                    for (int j = 0; j < r; ++j) sacc -= ar[j] * y[j];
                    y[r] = sacc;
                    TM[(16 * d + r) * AST + 16 * d + c] = sacc;
                }
            }
            __syncthreads();
            {
                const int blk = tid >> 8, r = (tid >> 4) & 15, c = tid & 15, rb = blk ? 3 : 1, cb = rb - 1;
                float t = 0.f;
#pragma unroll
                for (int j = 0; j < 16; ++j) t += AM[(16 * rb + r) * AST + 16 * cb + j] * TM[(16 * cb + j) * AST + 16 * cb + c];
                TMP[blk * 272 + r * 17 + c] = t;
                __syncthreads();
                float o = 0.f;
#pragma unroll
                for (int k = 0; k < 16; ++k) o -= TM[(16 * rb + r) * AST + 16 * rb + k] * TMP[blk * 272 + k * 17 + c];
                __syncthreads();
                TM[(16 * rb + r) * AST + 16 * cb + c] = o;
            }
            __syncthreads();
            {
                float t[2];
#pragma unroll
                for (int i2 = 0; i2 < 2; ++i2) {
                    const int o = tid + 512 * i2, r = o >> 5, c = o & 31;
                    float acc = 0.f;
#pragma unroll
                    for (int j = 0; j < 32; ++j) acc += AM[(32 + r) * AST + j] * TM[j * AST + c];
                    t[i2] = acc;
                }
#pragma unroll
                for (int i2 = 0; i2 < 2; ++i2) { const int o = tid + 512 * i2; TMP[(o >> 5) * 33 + (o & 31)] = t[i2]; }
                __syncthreads();
#pragma unroll
                for (int i2 = 0; i2 < 2; ++i2) {
                    const int o = tid + 512 * i2, r = o >> 5, c = o & 31;
                    float acc = 0.f;
#pragma unroll
                    for (int k = 0; k < 32; ++k) acc -= TM[(32 + r) * AST + 32 + k] * TMP[k * 33 + c];
                    t[i2] = acc;
                }
#pragma unroll
                for (int i2 = 0; i2 < 2; ++i2) { const int o = tid + 512 * i2; TM[(32 + (o >> 5)) * AST + (o & 31)] = t[i2]; }
            }
            __syncthreads();
            {
                bf16x8 Ah[4][2], Al[4][2];
#pragma unroll
                for (int rt = 0; rt < 4; ++rt)
#pragma unroll
                    for (int ks = 0; ks < 2; ++ks) {
                        const f32x4 a0 = *(const f32x4*)(TM + (16 * rt + fr) * AST + 32 * ks + 8 * fq), a1 = *(const f32x4*)(TM + (16 * rt + fr) * AST + 32 * ks + 8 * fq + 4);
                        u32x4 hq; hq.x = pk2(a0.x, a0.y); hq.y = pk2(a0.z, a0.w); hq.z = pk2(a1.x, a1.y); hq.w = pk2(a1.z, a1.w);
                        u32x4 lq; lq.x = pk2(a0.x - bflo(hq.x), a0.y - bfhi(hq.x)); lq.y = pk2(a0.z - bflo(hq.y), a0.w - bfhi(hq.y));
                        lq.z = pk2(a1.x - bflo(hq.z), a1.y - bfhi(hq.z)); lq.w = pk2(a1.z - bflo(hq.w), a1.w - bfhi(hq.w));
                        Ah[rt][ks] = __builtin_bit_cast(bf16x8, hq); Al[rt][ks] = __builtin_bit_cast(bf16x8, lq);
                    }
                const bool isw = wave >= 4;
                f32x4 xacc[2][4];
#pragma unroll
                for (int q = 0; q < 2; ++q)
#pragma unroll
                    for (int rt = 0; rt < 4; ++rt) xacc[q][rt] = (f32x4){0.f, 0.f, 0.f, 0.f};
#pragma unroll
                for (int ks = 0; ks < 2; ++ks) {
                    float sc8[8];
                    {
                        const f32x4 b0 = *(const f32x4*)(BETA + 32 * ks + 8 * fq), b1 = *(const f32x4*)(BETA + 32 * ks + 8 * fq + 4);
                        const f32x4 e0 = *(const f32x4*)(EG + 32 * ks + 8 * fq), e1 = *(const f32x4*)(EG + 32 * ks + 8 * fq + 4);
#pragma unroll
                        for (int e = 0; e < 4; ++e) { sc8[e] = isw ? b0[e] * e0[e] : b0[e]; sc8[4 + e] = isw ? b1[e] * e1[e] : b1[e]; }
                    }
#pragma unroll
                    for (int q = 0; q < 2; ++q) {
                        const int cc = ((2 * wave + q) & 7) * 16 + fr;
                        const float* src = QKVf + ((isw ? 64 : 128) + 32 * ks + 8 * fq) * QST + cc;
                        float v[8];
#pragma unroll
                        for (int e = 0; e < 8; ++e) v[e] = src[e * QST] * sc8[e];
                        u32x4 hq; hq.x = pk2(v[0], v[1]); hq.y = pk2(v[2], v[3]); hq.z = pk2(v[4], v[5]); hq.w = pk2(v[6], v[7]);
                        u32x4 lq; lq.x = pk2(v[0] - bflo(hq.x), v[1] - bfhi(hq.x)); lq.y = pk2(v[2] - bflo(hq.y), v[3] - bfhi(hq.y));
                        lq.z = pk2(v[4] - bflo(hq.z), v[5] - bfhi(hq.z)); lq.w = pk2(v[6] - bflo(hq.w), v[7] - bfhi(hq.w));
                        const bf16x8 Bh = __builtin_bit_cast(bf16x8, hq), Bl = __builtin_bit_cast(bf16x8, lq);
#pragma unroll
                        for (int rt = 0; rt < 4; ++rt) {
                            xacc[q][rt] = MFMA16(Ah[rt][ks], Bh, xacc[q][rt]);
                            xacc[q][rt] = MFMA16(Al[rt][ks], Bh, xacc[q][rt]);
                            xacc[q][rt] = MFMA16(Ah[rt][ks], Bl, xacc[q][rt]);
                        }
                    }
                }
                if (!isw) {
                    float* Uc = (float*)(ip + 57344);
#pragma unroll
                    for (int q = 0; q < 2; ++q)
#pragma unroll
                        for (int rt = 0; rt < 4; ++rt) *(f32x4*)(Uc + (size_t)((((2 * wave + q) * 4 + rt) * 64 + lane) * 4)) = xacc[q][rt];
                } else {
#pragma unroll
                    for (int q = 0; q < 2; ++q)
#pragma unroll
                        for (int rt = 0; rt < 4; ++rt)
#pragma unroll
                            for (int j = 0; j < 4; ++j) WSI[(16 * rt + 4 * fq + j) * NST + ((2 * wave + q) & 7) * 16 + fr] = f2bf(xacc[q][rt][j]);
                }
            }
        }
        __syncthreads();
        {
            bf16_t* Wf = (bf16_t*)ip; bf16_t* QKf = (bf16_t*)(ip + 49152);
#pragma unroll
            for (int i2 = 0; i2 < 2; ++i2) {
                const int f = tid + 512 * i2, ln = f & 63, ks = (f >> 6) & 3, rt = f >> 8, i = 16 * rt + (ln & 15), fq_ = ln >> 4;
                const u32x2 lo = *(const u32x2*)(WSI + i * NST + 32 * ks + 4 * fq_), hi = *(const u32x2*)(WSI + i * NST + 32 * ks + 16 + 4 * fq_);
                *(u32x4*)(Wf + (size_t)f * 8) = (u32x4){lo.x, lo.y, hi.x, hi.y};
            }
            {
                const int f = tid, ln = f & 63, ks2 = (f >> 6) & 1, rt = f >> 7, i = 16 * rt + (ln & 15), fq_ = ln >> 4;
                const u32x2 lo = *(const u32x2*)(QKS + i * QKST + 32 * ks2 + 4 * fq_), hi = *(const u32x2*)(QKS + i * QKST + 32 * ks2 + 16 + 4 * fq_);
                *(u32x4*)(QKf + (size_t)f * 8) = (u32x4){lo.x, lo.y, hi.x, hi.y};
            }
        }
    }
}

constexpr int OPB_B = 57344, L_OBUF = 2 * OPB_B, OST = 132;
static_assert(L_OBUF + 64 * OST * 4 <= LDS_BYTES, "scan LDS");
DI void gdn_scan(const Params& p, const bool samp, const int b, const int h) {
    unsigned char* ws = p.ws;
    const int tid = threadIdx.x, lane = tid & 63, w = __builtin_amdgcn_readfirstlane(tid >> 6), fr = lane & 15, fq = lane >> 4;
    const int nsteps = samp ? 1 : 128, valid = samp ? TS : 64;
    float* OBUF = (float*)(dyn_smem + L_OBUF);
    const bf16_t* HG = (const bf16_t*)(ws + WS_R3);
    bf16_t* OMIX = (bf16_t*)(ws + WS_R2);
    const float* DL = (const float*)(ws + WS_DL);
    f32x4 S[8];
#pragma unroll
    for (int dt = 0; dt < 8; ++dt) {
        if (samp) {
#pragma unroll
            for (int j = 0; j < 4; ++j) S[dt][j] = p.state_gdn[((size_t)(b * 4 + h) * 128 + 16 * dt + 4 * fq + j) * 128 + 16 * w + fr];
        } else S[dt] = (f32x4){0.f, 0.f, 0.f, 0.f};
    }
    const int item0 = samp ? 2048 + b * 4 + h : b * 512 + h;
    __syncthreads();
    {
        const unsigned char* ip = ws + WS_R1 + (size_t)item0 * ITEM_B;
#pragma unroll
        for (int i = 0; i < 7; ++i) *(u32x4*)(dyn_smem + (tid + 512 * i) * 16) = *(const u32x4*)(ip + (tid + 512 * i) * 16);
    }
    __syncthreads();
#pragma unroll 1
    for (int c = 0; c < nsteps; ++c) {
        const int item = item0 + 4 * c;
        const unsigned char* ip = ws + WS_R1 + (size_t)item * ITEM_B;
        const bool nxt = c + 1 < nsteps;
        u32x4 pf[7];
        if (nxt) {
#pragma unroll
            for (int i = 0; i < 7; ++i) pf[i] = *(const u32x4*)(ip + 4 * (size_t)ITEM_B + (tid + 512 * i) * 16);
        }
        const float* Uc = (const float*)(ip + 57344);
        f32x4 U[4];
#pragma unroll
        for (int rt = 0; rt < 4; ++rt) U[rt] = *(const f32x4*)(Uc + ((w * 4 + rt) * 64 + lane) * 4);
        const float dl = DL[item];
        const unsigned char* buf = dyn_smem + (c & 1) * OPB_B;
        bf16x8 Sb[4];
#pragma unroll
        for (int ks = 0; ks < 4; ++ks) Sb[ks] = pack8(S[2 * ks], S[2 * ks + 1]);
        f32x4 vn[4];
#pragma unroll
        for (int rt = 0; rt < 4; ++rt) {
            f32x4 acc = (f32x4){0.f, 0.f, 0.f, 0.f};
#pragma unroll
            for (int ks = 0; ks < 4; ++ks) acc = MFMA16(*(const bf16x8*)(buf + ((rt * 4 + ks) * 64 + lane) * 16), Sb[ks], acc);
            vn[rt] = U[rt] - acc;
        }
        bf16x8 Vb[2];
        Vb[0] = pack8(vn[0], vn[1]); Vb[1] = pack8(vn[2], vn[3]);
#pragma unroll
        for (int rt = 0; rt < 4; ++rt) {
            f32x4 acc = (f32x4){0.f, 0.f, 0.f, 0.f};
#pragma unroll
            for (int ks = 0; ks < 4; ++ks) acc = MFMA16(*(const bf16x8*)(buf + 16384 + ((rt * 4 + ks) * 64 + lane) * 16), Sb[ks], acc);
#pragma unroll
            for (int ks2 = 0; ks2 < 2; ++ks2) acc = MFMA16(*(const bf16x8*)(buf + 49152 + ((rt * 2 + ks2) * 64 + lane) * 16), Vb[ks2], acc);
#pragma unroll
            for (int j = 0; j < 4; ++j) OBUF[(16 * rt + 4 * fq + j) * OST + 16 * w + fr] = acc[j];
        }
#pragma unroll
        for (int dt = 0; dt < 8; ++dt) {
            f32x4 acc = S[dt] * dl;
#pragma unroll
            for (int ks2 = 0; ks2 < 2; ++ks2) acc = MFMA16(*(const bf16x8*)(buf + 32768 + ((dt * 2 + ks2) * 64 + lane) * 16), Vb[ks2], acc);
            S[dt] = acc;
        }
        if (nxt) {
#pragma unroll
            for (int i = 0; i < 7; ++i) *(u32x4*)(dyn_smem + ((c + 1) & 1) * OPB_B + (tid + 512 * i) * 16) = pf[i];
        }
        __syncthreads();
        {
            const int row = tid >> 3, pt = tid & 7;
            float o[16]; float ss = 0.f;
#pragma unroll
            for (int e4 = 0; e4 < 4; ++e4) { const f32x4 a = *(const f32x4*)(OBUF + row * OST + 16 * pt + 4 * e4);
#pragma unroll
                for (int e = 0; e < 4; ++e) { o[4 * e4 + e] = a[e]; ss += a[e] * a[e]; } }
#pragma unroll
            for (int of = 1; of < 8; of <<= 1) ss += __shfl_xor(ss, of);
            if (row < valid) {
                const float r = rsqrtf(ss * (1.f / 128.f) + 1e-6f);
                const size_t grow = (samp ? (size_t)MP + b * TS : (size_t)b * TP + (size_t)c * 64) + row;
                u32x4 g0, g1;
                if (!samp) { g0 = *(const u32x4*)(HG + grow * 512 + h * 128 + 16 * pt); g1 = *(const u32x4*)(HG + grow * 512 + h * 128 + 16 * pt + 8); }
                else { const float* gp = (const float*)(ws + WS_CS1) + (grow - MP) * NH1 + 1536 + h * 128 + 16 * pt;
                       const f32x4 f0 = *(const f32x4*)gp, f1 = *(const f32x4*)(gp + 4), f2 = *(const f32x4*)(gp + 8), f3 = *(const f32x4*)(gp + 12);
                       g0 = (u32x4){pk2(f0.x, f0.y), pk2(f0.z, f0.w), pk2(f1.x, f1.y), pk2(f1.z, f1.w)}; g1 = (u32x4){pk2(f2.x, f2.y), pk2(f2.z, f2.w), pk2(f3.x, f3.y), pk2(f3.z, f3.w)}; }
                const unsigned gw[8] = {g0.x, g0.y, g0.z, g0.w, g1.x, g1.y, g1.z, g1.w};
                unsigned ow[8];
#pragma unroll
                for (int e = 0; e < 8; ++e) {
                    const float ga = bflo(gw[e]), gb = bfhi(gw[e]);
                    const float n0 = p.gdn_norm_w[16 * pt + 2 * e], n1 = p.gdn_norm_w[16 * pt + 2 * e + 1];
                    ow[e] = pk2(o[2 * e] * r * n0 * silu(ga), o[2 * e + 1] * r * n1 * silu(gb));
                }
                *(u32x4*)(OMIX + grow * 1024 + h * 128 + 16 * pt) = (u32x4){ow[0], ow[1], ow[2], ow[3]};
                *(u32x4*)(OMIX + grow * 1024 + h * 128 + 16 * pt + 8) = (u32x4){ow[4], ow[5], ow[6], ow[7]};
            }
        }
        __syncthreads();
    }
    float* So = p.out + (samp ? O_GS : O_GP) + (size_t)(b * 4 + h) * 128 * 128;
#pragma unroll
    for (int dt = 0; dt < 8; ++dt)
#pragma unroll
        for (int j = 0; j < 4; ++j) So[(size_t)(16 * dt + 4 * fq + j) * 128 + 16 * w + fr] = S[dt][j];
}

constexpr int KST = 136, VST = 72, L_KT = 0, L_VT = 2 * 64 * KST * 2, L_ALX = L_VT + 2 * 128 * VST * 2, L_IDX = L_ALX + 8 * 2 * 32 * 4, L_QF = L_IDX + 256;
static_assert(L_QF + 8 * 8 * 1024 <= LDS_BYTES, "attn LDS");
DI int crow32(int i, int hh) { return (i & 3) + 8 * (i >> 2) + 4 * hh; }

DI void attn_item(const Params& p, const int idx, const float* lamp) {
    unsigned char* ws = p.ws;
    const int tid = threadIdx.x, lane = tid & 63, w = __builtin_amdgcn_readfirstlane(tid >> 6), r = lane & 31, hh = lane >> 5;
    bool samp; int b, h, qb = 0, ntiles, lastw; size_t qbase, kbase; const bf16_t* vtb; int vstride; bool active;
    if (idx < 32) { samp = true; b = idx >> 2; h = idx & 3; qbase = (size_t)MP + b * TS; kbase = (size_t)MP + (size_t)b * TKS; ntiles = 65; lastw = 64; active = w == 0;
                    vtb = (const bf16_t*)(ws + WS_R6) + VT_S_OFF + (size_t)((b * 4 + h) * 128) * TKS; vstride = TKS; }
    else { const int j = idx - 32; samp = false; qb = 31 - (j >> 4); b = (j & 15) >> 2; h = j & 3; qbase = (size_t)b * TP + qb * 256; kbase = (size_t)b * TP; ntiles = 4 * qb + 4; lastw = 4 * qb + (w >> 1); active = true;
           vtb = (const bf16_t*)(ws + WS_R6) + (size_t)((b * 4 + h) * 128) * TP; vstride = TP; }
    const bf16_t* KALL = (const bf16_t*)(ws + WS_R5) + kbase * 512 + h * 128;
    bf16_t* KT = (bf16_t*)(dyn_smem + L_KT); bf16_t* VTL = (bf16_t*)(dyn_smem + L_VT);
    float* ALX = (float*)(dyn_smem + L_ALX) + w * 64;
    bf16_t* QF = (bf16_t*)(dyn_smem + L_QF) + w * 8 * 64 * 8;
    {
        const bf16_t* qp = (const bf16_t*)(ws + WS_R4) + (qbase + 32 * w + r) * 512 + h * 128 + 8 * hh;
        if (active) {
#pragma unroll
            for (int f = 0; f < 8; ++f) *(u32x4*)(QF + (f * 64 + lane) * 8) = *(const u32x4*)(qp + (f >> 2) * 64 + 16 * (f & 3));
        }
    }
    f32x16 O1[4], O2[4];
#pragma unroll
    for (int t = 0; t < 4; ++t)
#pragma unroll
        for (int i = 0; i < 16; ++i) { O1[t][i] = 0.f; O2[t][i] = 0.f; }
    float m1 = -1e30f, m2 = -1e30f, l1 = 0.f, l2 = 0.f;
    const int krow0 = tid >> 4, kc16 = tid & 15;
    const int vdv0 = tid >> 3, vm = tid & 7;
    const int vpos = (vm >> 2) * 32 + ((vm >> 1) & 1) * 16 + (vm & 1) * 4;
    const unsigned koff = krow0 * 512 + kc16 * 8, voff = vdv0 * vstride + 8 * vm;
    const unsigned klds = (krow0 * KST + kc16 * 8) * 2, vlds = (vdv0 * VST + vpos) * 2;
    u32x4 pa, pb;
    __syncthreads();
    {
        pa = *(const u32x4*)(KALL + koff); pb = *(const u32x4*)(KALL + 32 * 512 + koff);
        *(u32x4*)(dyn_smem + L_KT + klds) = pa; *(u32x4*)(dyn_smem + L_KT + 32 * KST * 2 + klds) = pb;
        pa = *(const u32x4*)(vtb + voff); pb = *(const u32x4*)(vtb + (size_t)64 * vstride + voff);
        *(u32x2*)(dyn_smem + L_VT + vlds) = (u32x2){pa.x, pa.y}; *(u32x2*)(dyn_smem + L_VT + vlds + 16) = (u32x2){pa.z, pa.w};
        *(u32x2*)(dyn_smem + L_VT + 64 * VST * 2 + vlds) = (u32x2){pb.x, pb.y}; *(u32x2*)(dyn_smem + L_VT + 64 * VST * 2 + vlds + 16) = (u32x2){pb.z, pb.w};
    }
    __syncthreads();
#pragma unroll 1
    for (int kt = 0; kt < ntiles; ++kt) {
        const bool nxt = kt + 1 < ntiles;
        const bf16_t* kn_ = KALL + (size_t)(kt + 1) * 64 * 512; const bf16_t* vn_ = vtb + (size_t)(kt + 1) * 64;
        unsigned char* ldn = dyn_smem + ((kt + 1) & 1) * 64 * KST * 2; unsigned char* ldv = dyn_smem + L_VT + ((kt + 1) & 1) * 128 * VST * 2;
        if (nxt) { pa = *(const u32x4*)(kn_ + koff); pb = *(const u32x4*)(kn_ + 32 * 512 + koff); }
        if (active && kt <= lastw) {
            const bf16_t* Kb = KT + (kt & 1) * 64 * KST; const bf16_t* Vb = VTL + (kt & 1) * 128 * VST;
            const bool domask = samp && kt == 64;
#pragma unroll 1
            for (int sub = 0; sub < 2; ++sub) {
                bf16x8 P[2][2];
#pragma unroll
                for (int mp = 0; mp < 2; ++mp) {
                    f32x16 sc;
#pragma unroll
                    for (int i = 0; i < 16; ++i) sc[i] = 0.f;
#pragma unroll
                    for (int s = 0; s < 4; ++s) {
                        const bf16x8 ka = *(const bf16x8*)(Kb + (sub * 32 + r) * KST + mp * 64 + 16 * s + 8 * hh);
                        const bf16x8 qf = *(const bf16x8*)(QF + ((mp * 4 + s) * 64 + lane) * 8);
                        sc = MFMA32(ka, qf, sc);
                    }
                    __builtin_amdgcn_sched_barrier(0);
                    if (domask) {
#pragma unroll
                        for (int i = 0; i < 16; ++i) if (sub * 32 + crow32(i, hh) >= TS) sc[i] = -1e30f;
                    }
                    float mx = sc[0];
#pragma unroll
                    for (int i = 1; i < 16; ++i) mx = fmaxf(mx, sc[i]);
                    { const auto sw_ = __builtin_amdgcn_permlane32_swap(__float_as_uint(mx), __float_as_uint(mx), false, false); mx = fmaxf(__uint_as_float(sw_[0]), __uint_as_float(sw_[1])); }
                    const float mo = mp == 0 ? m1 : m2, mn = fmaxf(mo, mx), al = __builtin_amdgcn_exp2f(mo - mn);
                    float ps = 0.f;
#pragma unroll
                    for (int i = 0; i < 16; ++i) { sc[i] = __builtin_amdgcn_exp2f(sc[i] - mn); ps += sc[i]; }
                    if (mp == 0) { m1 = mn; l1 = l1 * al + ps; } else { m2 = mn; l2 = l2 * al + ps; }
                    if (__any(al < 1.f)) {
                        if (hh == 0) ALX[r] = al;
                        asm volatile("s_waitcnt lgkmcnt(0)" ::: "memory");
#pragma unroll
                        for (int g = 0; g < 4; ++g) {
                            const f32x4 a1 = *(const f32x4*)(ALX + 8 * g + 4 * hh);
#pragma unroll
                            for (int t = 0; t < 4; ++t)
#pragma unroll
                                for (int j = 0; j < 4; ++j) { if (mp == 0) O1[t][4 * g + j] *= a1[j]; else O2[t][4 * g + j] *= a1[j]; }
                        }
                        asm volatile("s_waitcnt lgkmcnt(0)" ::: "memory");
                    }
#pragma unroll
                    for (int sp = 0; sp < 2; ++sp) {
                        u32x4 a;
                        a.x = pk2(sc[8 * sp], sc[8 * sp + 1]); a.y = pk2(sc[8 * sp + 2], sc[8 * sp + 3]); a.z = pk2(sc[8 * sp + 4], sc[8 * sp + 5]); a.w = pk2(sc[8 * sp + 6], sc[8 * sp + 7]);
                        P[mp][sp] = __builtin_bit_cast(bf16x8, a);
                    }
                    __builtin_amdgcn_sched_barrier(0);
                }
#pragma unroll
                for (int sp = 0; sp < 2; ++sp)
#pragma unroll
                    for (int t = 0; t < 4; ++t) {
                        if ((t & 1) == 0) __builtin_amdgcn_sched_barrier(0);
                        const bf16x8 vb = *(const bf16x8*)(Vb + (32 * t + r) * VST + sub * 32 + (sp * 2 + hh) * 8);
                        O1[t] = MFMA32(P[0][sp], vb, O1[t]); O2[t] = MFMA32(P[1][sp], vb, O2[t]);
                    }
                if (sub == 0 && nxt) {
                    *(u32x4*)(ldn + klds) = pa; *(u32x4*)(ldn + 32 * KST * 2 + klds) = pb;
                    pa = *(const u32x4*)(vn_ + voff); pb = *(const u32x4*)(vn_ + (size_t)64 * vstride + voff);
                }
            }
        } else if (nxt) {
            *(u32x4*)(ldn + klds) = pa; *(u32x4*)(ldn + 32 * KST * 2 + klds) = pb;
            pa = *(const u32x4*)(vn_ + voff); pb = *(const u32x4*)(vn_ + (size_t)64 * vstride + voff);
        }
        if (nxt) {
            *(u32x2*)(ldv + vlds) = (u32x2){pa.x, pa.y}; *(u32x2*)(ldv + vlds + 16) = (u32x2){pa.z, pa.w};
            *(u32x2*)(ldv + 64 * VST * 2 + vlds) = (u32x2){pb.x, pb.y}; *(u32x2*)(ldv + 64 * VST * 2 + vlds + 16) = (u32x2){pb.z, pb.w};
        }
        __syncthreads();
    }
    if (active) {
        { const auto s1_ = __builtin_amdgcn_permlane32_swap(__float_as_uint(l1), __float_as_uint(l1), false, false); l1 = __uint_as_float(s1_[0]) + __uint_as_float(s1_[1]);
          const auto s2_ = __builtin_amdgcn_permlane32_swap(__float_as_uint(l2), __float_as_uint(l2), false, false); l2 = __uint_as_float(s2_[0]) + __uint_as_float(s2_[1]); }
        if (hh == 0) { ALX[r] = __builtin_amdgcn_rcpf(l1); ALX[32 + r] = *lamp * __builtin_amdgcn_rcpf(l2); }
        asm volatile("s_waitcnt lgkmcnt(0)" ::: "memory");
        float ss[16], a1[16], a2[16];
#pragma unroll
        for (int g = 0; g < 4; ++g) {
            const f32x4 x1 = *(const f32x4*)(ALX + 8 * g + 4 * hh), x2 = *(const f32x4*)(ALX + 32 + 8 * g + 4 * hh);
#pragma unroll
            for (int j = 0; j < 4; ++j) { a1[4 * g + j] = x1[j]; a2[4 * g + j] = x2[j]; ss[4 * g + j] = 0.f; }
        }
#pragma unroll
        for (int t = 0; t < 4; ++t) {
            __builtin_amdgcn_sched_barrier(0);
#pragma unroll
            for (int i = 0; i < 16; ++i) { const float o = O1[t][i] * a1[i] - O2[t][i] * a2[i]; O1[t][i] = o; ss[i] += o * o; }
        }
        __builtin_amdgcn_sched_barrier(0);
#pragma unroll
        for (int i = 0; i < 16; ++i) {
#pragma unroll
            for (int of = 1; of < 32; of <<= 1) ss[i] += __shfl_xor(ss[i], of);
            ss[i] = __builtin_amdgcn_rsqf(ss[i] * (1.f / 128.f) + 1e-6f) * (1.f - LAM_INIT);
        }
        int zo = 0; asm volatile("" : "+v"(zo));
        bf16_t* obase = (bf16_t*)(ws + WS_R2) + (qbase + 32 * w) * 1024 + 512 + h * 128;
        const unsigned ooff = (unsigned)((4 * hh + zo) * 1024 + r);
        const float* sw = p.subln_w + r + zo;
#pragma unroll
        for (int t = 0; t < 4; ++t) {
            const float wv = sw[32 * t];
#pragma unroll
            for (int i = 0; i < 16; ++i) obase[ooff + ((i & 3) + 8 * (i >> 2)) * 1024 + 32 * t] = f2bf(O1[t][i] * ss[i] * wv);
        }
    }
}

DI void mixer_phase(const Params& p) {
    const int bid = blockIdx.x;
#ifndef NO_SCAN
    if (bid < 48) { const bool sm = bid >= 16; const int j = sm ? bid - 16 : bid;
#pragma unroll 1
        for (int rep = 0; rep < SREP; ++rep) gdn_scan(p, sm, j >> 2, j & 3); }
#endif
    unsigned* ctl = (unsigned*)(p.ws + WS_CTL);
    int* sidx = (int*)(dyn_smem + L_IDX);
    for (;;) {
        __syncthreads();
        if (threadIdx.x == 0) *sidx = (int)atomicAdd(ctl, 1u);
        __syncthreads();
        const int idx0 = __builtin_amdgcn_readfirstlane(*sidx);
        if (idx0 >= (32 + 512) * AREP) break;
        const int idx = idx0 % (32 + 512);
#ifndef NO_ATTN
        attn_item(p, idx, (const float*)ctl + 1);
#endif
    }
}


__global__ void __launch_bounds__(512, 2) fwd_kernel(Params p) {
    cg::grid_group grid = cg::this_grid();
    const bool all = p.phase_hi - p.phase_lo > 1;
#define PHASE(i, body) if (p.phase_lo <= (i) && (i) < p.phase_hi) { body; if (all && (i) + 1 < p.phase_hi) grid.sync(); }
    PHASE(0, phase_prep(p))
    PHASE(1, gemm_phase<1>(p))
    PHASE(2, gdn_prep_phase(p))
    PHASE(3, mixer_phase(p))
    PHASE(4, gemm_phase<2>(p))
    PHASE(5, ln_phase<0>(p))
    PHASE(6, gemm_phase<3>(p))
    PHASE(7, fixup_phase(p))
    PHASE(8, gemm_phase<4>(p))
    PHASE(9, ln_phase<1>(p))
}

extern "C" void kernel_launch(void* const* d_in, const int* in_sizes, int n_in, void* d_out, int out_size, void* d_ws, size_t ws_size, hipStream_t stream) {
    static int grid = 0;
    if (grid == 0) {
        if (n_in != 23 || (size_t)out_size != O_END || ws_size < WS_END2) { fprintf(stderr, "kernel_launch: unexpected sizes n_in %d out %d ws %zu (need %zu)\n", n_in, out_size, ws_size, (size_t)WS_END2); grid = -1; return; }
        int dev = 0, cus = 0, per_cu = 0;
        hipGetDevice(&dev);
        hipDeviceGetAttribute(&cus, hipDeviceAttributeMultiprocessorCount, dev);
        if (hipFuncSetAttribute((const void*)fwd_kernel, hipFuncAttributeMaxDynamicSharedMemorySize, LDS_BYTES) != hipSuccess) { fprintf(stderr, "kernel_launch: hipFuncSetAttribute failed\n"); grid = -1; return; }
        hipOccupancyMaxActiveBlocksPerMultiprocessor(&per_cu, (const void*)fwd_kernel, 512, LDS_BYTES);
        if (per_cu < 1) { fprintf(stderr, "kernel_launch: occupancy query says %d\n", per_cu); per_cu = 1; }
        (void)hipGetLastError();
        grid = cus * 1;
    }
    if (grid < 0) return;
    Params p{};
    const float** f = (const float**)&p;
    for (int i = 0; i < 23; ++i) f[i] = (const float*)d_in[i];
    p.out = (float*)d_out; p.ws = (unsigned char*)d_ws; p.phase_lo = 0; p.phase_hi = 10;
    void* args[] = {&p};
    hipError_t e = hipLaunchCooperativeKernel((const void*)fwd_kernel, dim3(grid), dim3(512), args, LDS_BYTES, stream);
    if (e != hipSuccess) fprintf(stderr, "cooperative launch failed: %s (grid %d)\n", hipGetErrorString(e), grid);
}
```

```cpp
#include <hip/hip_runtime.h>
#include <hip/hip_cooperative_groups.h>
#include <cstdio>
namespace cg = cooperative_groups;
#ifndef GREP_WHICH
#define GREP_WHICH 0
#endif
#ifndef AREP
#define AREP 1
#endif
#ifndef SREP
#define SREP 1
#endif

typedef unsigned short bf16_t;
typedef short bf16x8 __attribute__((ext_vector_type(8)));
typedef short s16x4 __attribute__((ext_vector_type(4)));
typedef float f32x4 __attribute__((ext_vector_type(4)));
typedef float f32x16 __attribute__((ext_vector_type(16)));
typedef unsigned u32x4 __attribute__((ext_vector_type(4)));
typedef unsigned u32x2 __attribute__((ext_vector_type(2)));
#define DI __device__ __forceinline__

constexpr int D = 1024, TP = 8192, BP = 4, MP = BP * TP, BS = 8, TS = 32, MS = BS * TS, M = MP + MS, PAST = 4096;
constexpr int DIN = 3592, NH1 = 3584, DFF = 2816, NUP = 2 * DFF;
constexpr int TKS = 4160;
constexpr int NITEM = BP * 128 * 4 + BS * 4;
constexpr int ITEM_B = 90112;
constexpr int LDS_BYTES = 160 * 1024;
constexpr float ALPHA = 1.189207115002721f;
constexpr float LAM_INIT = 0.2f;

constexpr size_t O_Y = 0, O_KP = 33816576, O_VP = 50593792, O_GP = 67371008, O_CQP = 67633152, O_CFP = 67651584,
                 O_KS = 67696640, O_VS = 67827712, O_GS = 67958784, O_CQS = 68483072, O_CFS = 68519936, O_END = 68610048;

constexpr size_t al256(size_t x) { return (x + 255) & ~(size_t)255; }
constexpr size_t WS_CTL = 0;
constexpr size_t WS_ROPE = 4096;
constexpr size_t WS_AB = WS_ROPE + (size_t)8192 * 32 * 8;
constexpr size_t WS_DL = WS_AB + (size_t)M * 8 * 4;
constexpr size_t WS_WIN = al256(WS_DL + NITEM * 4);
constexpr size_t WS_WO = WS_WIN + (size_t)NH1 * D * 2;
constexpr size_t WS_WUP = WS_WO + (size_t)D * D * 2;
constexpr size_t WS_WDN = WS_WUP + (size_t)NUP * D * 2;
constexpr size_t WS_R1 = al256(WS_WDN + (size_t)D * DFF * 2);
constexpr size_t R1_SIZE = (size_t)NITEM * ITEM_B;
constexpr size_t WS_R2 = al256(WS_R1 + R1_SIZE);
constexpr size_t WS_R3 = al256(WS_R2 + (size_t)M * 1536 * 2);
constexpr size_t WS_R4 = WS_R3 + (size_t)M * 512 * 2;
constexpr size_t WS_R5 = al256(WS_R4 + (size_t)M * 512 * 2);
constexpr size_t KROWS = (size_t)MP + (size_t)BS * TKS;
constexpr size_t WS_R6 = al256(WS_R5 + KROWS * 512 * 2);
constexpr size_t VT_S_OFF = (size_t)BP * 4 * 128 * TP;
constexpr size_t WS_END = al256(WS_R6 + (VT_S_OFF + (size_t)BS * 4 * 128 * TKS) * 2);
constexpr size_t WS_CS1 = WS_END;
constexpr size_t WS_CS2 = WS_CS1 + (size_t)MS * NH1 * 4;
constexpr size_t WS_CS3 = WS_CS2 + (size_t)MS * D * 4;
constexpr size_t WS_CS4 = WS_CS3 + (size_t)MS * NUP * 4;
constexpr size_t WS_BAR = WS_CS4 + (size_t)MS * D * 4;
constexpr size_t WS_END2 = WS_BAR + 16384;
static_assert((size_t)M * DFF * 2 <= R1_SIZE, "GT must fit R1");
static_assert(WS_END2 <= (size_t)536870912, "workspace too large");

struct Params {
    const float *x_p, *x_s, *cache_k, *cache_v, *state_gdn, *state_cq, *state_cf;
    const float *w_in, *gdn_conv_w, *a_log, *dt_bias, *gdn_norm_w, *diff_lambda, *subln_w, *w_o, *ln1_g, *ln1_b, *w_up,
        *ffn_conv_w, *ffn_conv_b, *w_down, *ln2_g, *ln2_b;
    float* out; unsigned char* ws;
    int phase_lo, phase_hi;
};

extern __shared__ __attribute__((aligned(16))) unsigned char dyn_smem[];

typedef __bf16 bf16x2_t __attribute__((ext_vector_type(2)));
typedef float f32x2 __attribute__((ext_vector_type(2)));
DI unsigned pk2(float lo, float hi) { f32x2 v = {lo, hi}; bf16x2_t b = __builtin_convertvector(v, bf16x2_t); return __builtin_bit_cast(unsigned, b); }
DI bf16_t f2bf(float x) { return (bf16_t)(pk2(x, 0.f) & 0xffffu); }
DI float bf2f(bf16_t b) { return __uint_as_float(((unsigned)b) << 16); }
DI float bflo(unsigned u) { return __uint_as_float(u << 16); }
DI float bfhi(unsigned u) { return __uint_as_float(u & 0xffff0000u); }
DI float silu(float x) { return x / (1.f + __expf(-x)); }
DI int opaque_tid() { int t = threadIdx.x; asm volatile("" : "+v"(t)); return t; }
DI float wave_sum(float v) {
#pragma unroll
    for (int o = 1; o < 64; o <<= 1) v += __shfl_xor(v, o);
    return v;
}
DI const float* xrow_ptr(const Params& p, int row) { return row < MP ? p.x_p + (size_t)row * D : p.x_s + (size_t)(row - MP) * D; }

template <int MODE> DI int srccol(int n) {
    if (MODE == 1) {
        if (n < 2048) return n;
        return n + 8;
    }
    if (MODE == 2) { const int pn = n >> 8, j = n & 255; return j < 128 ? 128 * pn + j : DFF + 128 * pn + (j - 128); }
    return n;
}
struct TrItem { const float* W; bf16_t* WT; int K, N, k0, n0, mode; };
DI TrItem tr_decode(const Params& p, int it) {
    constexpr int I_IN = 16 * 56, I_O = 16 * 16, I_UP = 16 * 88;
    unsigned char* ws = p.ws; TrItem t; int r = it;
    if (r < I_IN) { t.W = p.w_in; t.WT = (bf16_t*)(ws + WS_WIN); t.K = D; t.N = DIN; t.k0 = (r / 56) * 64; t.n0 = (r % 56) * 64; t.mode = 1; return t; } r -= I_IN;
    if (r < I_O) { t.W = p.w_o; t.WT = (bf16_t*)(ws + WS_WO); t.K = D; t.N = D; t.k0 = (r / 16) * 64; t.n0 = (r % 16) * 64; t.mode = 0; return t; } r -= I_O;
    if (r < I_UP) { t.W = p.w_up; t.WT = (bf16_t*)(ws + WS_WUP); t.K = D; t.N = NUP; t.k0 = (r / 88) * 64; t.n0 = (r % 88) * 64; t.mode = 2; return t; } r -= I_UP;
    t.W = p.w_down; t.WT = (bf16_t*)(ws + WS_WDN); t.K = DFF; t.N = D; t.k0 = (r / 16) * 64; t.n0 = (r % 16) * 64; t.mode = 0; return t;
}
DI void tr_load(const TrItem& t, float (&v)[8]) {
    const int tid = threadIdx.x, n = t.n0 + (tid & 63);
    const int sc = t.mode == 1 ? (n < 2048 ? n : n + 8) : (t.mode == 2 ? srccol<2>(n) : n);
#pragma unroll
    for (int i = 0; i < 8; ++i) v[i] = t.W[(size_t)(t.k0 + (tid >> 6) + 8 * i) * t.N + sc];
}
DI void phase_prep(const Params& p) {
    const int tid = threadIdx.x, lane = tid & 63, wave = tid >> 6, nb = gridDim.x, bid = blockIdx.x;
    unsigned char* ws = p.ws;
    if (bid == 0 && tid < 64) {
        unsigned* ctl = (unsigned*)(ws + WS_CTL);
        float a = p.diff_lambda[lane] * p.diff_lambda[64 + lane], b = p.diff_lambda[128 + lane] * p.diff_lambda[192 + lane];
        a = wave_sum(a); b = wave_sum(b);
        if (lane == 0) { ctl[0] = 0u; ((float*)ctl)[1] = expf(a) - expf(b) + LAM_INIT; }
    }
    {
        constexpr int NT = 16 * 56 + 16 * 16 + 16 * 88 + 44 * 16;
        float* lds = (float*)dyn_smem;
        float v[8];
        TrItem cur = tr_decode(p, bid < NT ? bid : 0);
        if (bid < NT) tr_load(cur, v);
        for (int it = bid; it < NT; it += nb) {
            float nv[8]; TrItem nx = cur;
            if (it + nb < NT) { nx = tr_decode(p, it + nb); tr_load(nx, nv); }
#pragma unroll
            for (int i = 0; i < 8; ++i) lds[((tid >> 6) + 8 * i) * 65 + (tid & 63)] = v[i];
            __syncthreads();
#pragma unroll
            for (int i = 0; i < 8; ++i) { const int nn = (tid >> 6) + 8 * i, kk = tid & 63; cur.WT[(size_t)(cur.n0 + nn) * cur.K + cur.k0 + kk] = f2bf(lds[kk * 65 + nn]); }
            __syncthreads();
#pragma unroll
            for (int i = 0; i < 8; ++i) v[i] = nv[i];
            cur = nx;
        }
    }
    {
        float2* rope = (float2*)(ws + WS_ROPE);
        for (int idx = bid * 512 + tid; idx < 8192 * 32; idx += nb * 512) {
            const int pos = idx >> 5, d = idx & 31;
            const double inv = exp(-(double)d * (9.210340371976184 / 32.0));
            double a = (double)pos * inv;
            a -= 6.283185307179586 * rint(a * 0.15915494309189535);
            const float af = (float)a;
            rope[idx] = make_float2(__cosf(af), __sinf(af));
        }
    }
    {
        float* w8 = (float*)dyn_smem;
        __syncthreads();
        for (int i = tid; i < 1024 * 8; i += 512) w8[i] = p.w_in[(size_t)(i >> 3) * DIN + 2048 + (i & 7)];
        __syncthreads();
        bf16_t* XB = (bf16_t*)(ws + WS_R1);
        float* AB = (float*)(ws + WS_AB);
        f32x4 cv[4];
        {
            const int row = bid * 8 + wave;
            if (row < M) { const float* xr = xrow_ptr(p, row);
#pragma unroll
                for (int j = 0; j < 4; ++j) cv[j] = *(const f32x4*)(xr + lane * 4 + 256 * j); }
        }
        for (int row = bid * 8 + wave; row < M; row += nb * 8) {
            f32x4 nvx[4];
            if (row + nb * 8 < M) { const float* xn = xrow_ptr(p, row + nb * 8);
#pragma unroll
                for (int j = 0; j < 4; ++j) nvx[j] = *(const f32x4*)(xn + lane * 4 + 256 * j); }
            float acc[8];
#pragma unroll
            for (int c = 0; c < 8; ++c) acc[c] = 0.f;
#pragma unroll
            for (int j = 0; j < 4; ++j) {
                const int k0 = lane * 4 + 256 * j;
                const f32x4 v = cv[j];
                u32x2 o; o.x = pk2(v.x, v.y); o.y = pk2(v.z, v.w);
                *(u32x2*)(XB + (size_t)row * D + k0) = o;
#pragma unroll
                for (int e = 0; e < 4; ++e) {
                    const f32x4 wa = *(const f32x4*)(w8 + (k0 + e) * 8), wb = *(const f32x4*)(w8 + (k0 + e) * 8 + 4);
                    const float xv = v[e];
                    acc[0] += xv * wa.x; acc[1] += xv * wa.y; acc[2] += xv * wa.z; acc[3] += xv * wa.w;
                    acc[4] += xv * wb.x; acc[5] += xv * wb.y; acc[6] += xv * wb.z; acc[7] += xv * wb.w;
                }
            }
#pragma unroll
            for (int c = 0; c < 8; ++c) acc[c] = wave_sum(acc[c]);
            if (lane == 0) { *(f32x4*)(AB + (size_t)row * 8) = (f32x4){acc[0], acc[1], acc[2], acc[3]}; *(f32x4*)(AB + (size_t)row * 8 + 4) = (f32x4){acc[4], acc[5], acc[6], acc[7]}; }
#pragma unroll
            for (int j = 0; j < 4; ++j) cv[j] = nvx[j];
        }
        __syncthreads();
    }
    {
        bf16_t* KALL = (bf16_t*)(ws + WS_R5);
        const int nchunk = BS * TKS * 64;
        for (int c0 = bid * 512 + tid; c0 < nchunk; c0 += nb * 512 * 4) {
            f32x4 v0[4], v1[4]; int st[4]; size_t dsto[4];
#pragma unroll
            for (int u = 0; u < 4; ++u) {
                const int c = c0 + u * nb * 512;
                st[u] = 0;
                if (c < nchunk) {
                    const int col8 = c & 63, r = c >> 6, b = r / TKS, pp = r % TKS;
                    dsto[u] = ((size_t)MP + (size_t)b * TKS + pp) * 512 + col8 * 8;
                    if (pp < PAST) { const float* sp = p.cache_k + ((size_t)(b * PAST + pp) * 512 + col8 * 8); v0[u] = *(const f32x4*)sp; v1[u] = *(const f32x4*)(sp + 4); st[u] = 1; }
                    else if (pp >= PAST + TS) st[u] = 2;
                }
            }
#pragma unroll
            for (int u = 0; u < 4; ++u) {
                if (st[u] == 1) { u32x4 o; o.x = pk2(v0[u].x, v0[u].y); o.y = pk2(v0[u].z, v0[u].w); o.z = pk2(v1[u].x, v1[u].y); o.w = pk2(v1[u].z, v1[u].w); *(u32x4*)(KALL + dsto[u]) = o; }
                else if (st[u] == 2) *(u32x4*)(KALL + dsto[u]) = (u32x4){0u, 0u, 0u, 0u};
            }
        }
    }
    {
        bf16_t* VTS = (bf16_t*)(ws + WS_R6) + VT_S_OFF;
        bf16_t* t = (bf16_t*)dyn_smem;
        f32x4 cvv[4];
        auto ldv = [&](int it, f32x4 (&v)[4]) {
            const int blk = it % 65, bh = it / 65, b = bh >> 2, h = bh & 3;
            if (blk < 64) {
#pragma unroll
                for (int i = 0; i < 4; ++i) { const int id = tid + 512 * i, key = id >> 5, c4 = id & 31;
                    v[i] = *(const f32x4*)(p.cache_v + ((size_t)(b * PAST + blk * 64 + key) * 512 + h * 128 + c4 * 4)); }
            }
        };
        if (bid < BS * 4 * 65) ldv(bid, cvv);
        for (int it = bid; it < BS * 4 * 65; it += nb) {
            const int blk = it % 65, bh = it / 65;
            f32x4 nvv[4];
            if (it + nb < BS * 4 * 65) ldv(it + nb, nvv);
            if (blk < 64) {
                __syncthreads();
#pragma unroll
                for (int i = 0; i < 4; ++i) {
                    const int id = tid + 512 * i, key = id >> 5, c4 = id & 31;
                    const f32x4 v = cvv[i];
                    bf16_t* d = t + key * 130 + c4 * 4;
                    *(unsigned*)d = pk2(v.x, v.y); *(unsigned*)(d + 2) = pk2(v.z, v.w);
                }
                __syncthreads();
                const int dv = tid >> 2, part = tid & 3;
                unsigned o[8];
#pragma unroll
                for (int i = 0; i < 8; ++i) { const int k0 = part * 16 + 2 * i; o[i] = (unsigned)t[k0 * 130 + dv] | ((unsigned)t[(k0 + 1) * 130 + dv] << 16); }
                bf16_t* dst = VTS + ((size_t)(bh * 128 + dv) * TKS + blk * 64 + part * 16);
                *(u32x4*)dst = (u32x4){o[0], o[1], o[2], o[3]}; *(u32x4*)(dst + 8) = (u32x4){o[4], o[5], o[6], o[7]};
            } else {
                if (tid < 128) { bf16_t* dst = VTS + ((size_t)(bh * 128 + tid) * TKS + PAST + TS);
#pragma unroll
                    for (int i = 0; i < 4; ++i) *(u32x4*)(dst + 8 * i) = (u32x4){0u, 0u, 0u, 0u}; }
            }
#pragma unroll
            for (int i = 0; i < 4; ++i) cvv[i] = nvv[i];
        }
        __syncthreads();
    }
}

constexpr int BM = 256, BK = 64, HALF = 128, NXCD = 8, WGM = 8, HT = HALF * BK;
DI void stage_rc(int b, int& R, int& C) {
    const int st = b / 1024, sb = b % 1024, swz = sb ^ (((sb >> 9) & 1) << 5);
    R = (st >> 1) * 16 + swz / 64; C = (st & 1) * 32 + (swz % 64) / 2;
}
DI int lds_byte(int r, int c) {
    const int st = (r >> 4) * 2 + (c >> 5), rr = r & 15, cc = c & 31, ob = rr * 64 + cc * 2;
    return st * 1024 + (ob ^ (((ob >> 9) & 1) << 5));
}

#define SHM ((bf16_t*)dyn_smem)
#define SA(b, h) (SHM + ((b) * 2 + (h)) * HT)
#define SB(b, h) (SHM + (4 + (b) * 2 + (h)) * HT)
#define STAGE(P, BASE, br, kt) do { const bf16_t* _gb = (BASE) + ((long)(br) * K + (long)(kt) * BK); \
      __builtin_amdgcn_global_load_lds((const unsigned*)(_gb + so0), (unsigned*)((char*)(P) + threadIdx.x * 16), 16, 0, 0); \
      __builtin_amdgcn_global_load_lds((const unsigned*)(_gb + 64 * K + so0), (unsigned*)((char*)(P) + threadIdx.x * 16 + 8192), 16, 0, 0); } while (0)
#define LDA(dst, b, h) for (int m = 0; m < 4; ++m) for (int k = 0; k < 2; ++k) \
    dst[m][k] = *reinterpret_cast<const bf16x8*>((char*)SA(b, h) + lds_byte(wr * 64 + m * 16 + fr, k * 32 + fq * 8))
#define LDB(dst, b, h) for (int n = 0; n < 2; ++n) for (int k = 0; k < 2; ++k) \
    dst[n][k] = *reinterpret_cast<const bf16x8*>((char*)SB(b, h) + lds_byte(wc * 32 + n * 16 + fr, k * 32 + fq * 8))
#define MMA(ai, bj, At, Bt_) do { __builtin_amdgcn_s_setprio(1); \
    for (int m = 0; m < 4; ++m) for (int n = 0; n < 2; ++n) for (int k = 0; k < 2; ++k) \
      acc[ai][bj][m][n] = __builtin_amdgcn_mfma_f32_16x16x32_bf16(At[m][k], Bt_[n][k], acc[ai][bj][m][n], 0, 0, 0); \
    __builtin_amdgcn_s_setprio(0); } while (0)
#define WAIT_V(n) asm volatile("s_waitcnt vmcnt(" #n ")" ::: "memory")
#define WAIT_L(n) asm volatile("s_waitcnt lgkmcnt(" #n ")" ::: "memory")
#define BAR __builtin_amdgcn_s_barrier()
#define SCHED __builtin_amdgcn_sched_barrier(0)

template <int K> DI void gemm_tile(const bf16_t* __restrict__ A, const bf16_t* __restrict__ Bt, const int brow, const int bcol, f32x4 (&acc)[2][2][4][2]) {
    const int wid = threadIdx.x >> 6, lane = threadIdx.x & 63, wr = wid >> 2, wc = wid & 3, fr = lane & 15, fq = lane >> 4;
    unsigned so0;
    { int _r, _c; stage_rc(threadIdx.x * 16, _r, _c); so0 = (unsigned)(_r * K + _c); }
#pragma unroll
    for (int a = 0; a < 2; ++a)
#pragma unroll
        for (int b = 0; b < 2; ++b)
#pragma unroll
            for (int m = 0; m < 4; ++m)
#pragma unroll
                for (int n = 0; n < 2; ++n) acc[a][b][m][n] = (f32x4){0.f, 0.f, 0.f, 0.f};
    bf16x8 At[4][2], B0[2][2], B1[2][2];
    constexpr int nt = K / BK;
    STAGE(SB(0, 0), Bt, bcol, 0); STAGE(SA(0, 0), A, brow, 0);
    STAGE(SB(0, 1), Bt, bcol + HALF, 0); STAGE(SA(0, 1), A, brow + HALF, 0);
    if (wr == 1) BAR;
    WAIT_V(4); BAR;
    STAGE(SB(1, 0), Bt, bcol, 1); STAGE(SA(1, 0), A, brow, 1); STAGE(SB(1, 1), Bt, bcol + HALF, 1);
    WAIT_V(6); BAR;
    for (int t = 0; t < nt - 2; t += 2) {
        LDB(B0, 0, 0); SCHED; LDA(At, 0, 0); STAGE(SA(1, 1), A, brow + HALF, t + 1);
        WAIT_L(8); BAR; WAIT_L(0); MMA(0, 0, At, B0); BAR; SCHED;
        LDB(B1, 0, 1); STAGE(SB(0, 0), Bt, bcol, t + 2);
        BAR; WAIT_L(0); MMA(0, 1, At, B1); BAR;
        LDA(At, 0, 1); STAGE(SA(0, 0), A, brow, t + 2);
        BAR; WAIT_L(0); MMA(1, 0, At, B0); BAR; SCHED;
        STAGE(SB(0, 1), Bt, bcol + HALF, t + 2);
        WAIT_V(6); BAR; MMA(1, 1, At, B1); BAR;
        LDB(B0, 1, 0); SCHED; LDA(At, 1, 0); STAGE(SA(0, 1), A, brow + HALF, t + 2);
        WAIT_L(8); BAR; WAIT_L(0); MMA(0, 0, At, B0); BAR; SCHED;
        LDB(B1, 1, 1); STAGE(SB(1, 0), Bt, bcol, t + 3);
        BAR; WAIT_L(0); MMA(0, 1, At, B1); BAR;
        LDA(At, 1, 1); STAGE(SA(1, 0), A, brow, t + 3);
        BAR; WAIT_L(0); MMA(1, 0, At, B0); BAR; SCHED;
        STAGE(SB(1, 1), Bt, bcol + HALF, t + 3);
        WAIT_V(6); BAR; MMA(1, 1, At, B1); BAR;
    }
    { LDB(B0, 0, 0); LDA(At, 0, 0); STAGE(SA(1, 1), A, brow + HALF, nt - 1);
      BAR; WAIT_L(0); MMA(0, 0, At, B0); BAR;
      LDB(B1, 0, 1); BAR; WAIT_L(0); MMA(0, 1, At, B1); BAR;
      LDA(At, 0, 1); WAIT_V(4); BAR; WAIT_L(0); MMA(1, 0, At, B0); MMA(1, 1, At, B1); BAR; }
    { LDB(B0, 1, 0); LDA(At, 1, 0); WAIT_V(2); BAR; WAIT_L(0); MMA(0, 0, At, B0); BAR;
      LDB(B1, 1, 1); WAIT_V(0); BAR; WAIT_L(0); MMA(0, 1, At, B1); BAR;
      LDA(At, 1, 1); BAR; WAIT_L(0); MMA(1, 0, At, B0); MMA(1, 1, At, B1); BAR; }
    if (wr == 0) BAR;
}

DI void tile_of(int L, int nM, int nN, int& pm, int& pn) {
    const int nwg = nM * nN; int wgid = L;
    { const int q = nwg / NXCD, r = nwg % NXCD, xcd = wgid % NXCD, off = wgid / NXCD; wgid = (xcd < r ? xcd * (q + 1) : r * (q + 1) + (xcd - r) * q) + off; }
    const int nig = WGM * nN, gid = wgid / nig, fm = gid * WGM, gsz = min(nM - fm, WGM);
    pm = fm + ((wgid % nig) % gsz); pn = (wgid % nig) / gsz;
}

constexpr int CST = 260;
DI void stage_half(const f32x4 (&acc)[2][2][4][2], const int ai) {
    const int tid_ = opaque_tid(), wid = tid_ >> 6, lane = tid_ & 63, wr = wid >> 2, wc = wid & 3, fr = lane & 15, fq = lane >> 4;
    float* base = (float*)dyn_smem + (wr * 64 + fq * 4) * CST + wc * 32 + fr;
#pragma unroll
    for (int m = 0; m < 4; ++m)
#pragma unroll
        for (int j = 0; j < 4; ++j)
#pragma unroll
            for (int bj = 0; bj < 2; ++bj)
#pragma unroll
                for (int n = 0; n < 2; ++n) base[(m * 16 + j) * CST + bj * 128 + n * 16] = ai == 0 ? acc[0][bj][m][n][j] : acc[1][bj][m][n][j];
}
#define CT ((const float*)dyn_smem)

DI void epi_in_half(const Params& p, int pm, int pn, int ai) {
    unsigned char* ws = p.ws;
    const int tid = opaque_tid(), brow = pm * BM + ai * 128, bcol = pn * BM;
    const bool samp = pm == 128;
    if (pn < 8) {
        bf16_t* dst = pn < 6 ? (bf16_t*)(ws + WS_R2) : (bf16_t*)(ws + WS_R3);
        const int ld = pn < 6 ? 1536 : 512, c0 = pn < 6 ? bcol : bcol - 1536;
#pragma unroll 4
        for (int i = 0; i < 16; ++i) {
            const int id = tid + 512 * i, r = id >> 6, c4 = (id & 63) * 4, row = brow + r;
            const f32x4 v = *(const f32x4*)(CT + r * CST + c4);
            u32x2 o; o.x = pk2(v.x, v.y); o.y = pk2(v.z, v.w);
            *(u32x2*)(dst + (size_t)row * ld + c0 + c4) = o;
            if (pn < 6) {
                if (!samp) { const int t = row & (TP - 1); if (t >= TP - 3) *(f32x4*)(p.out + O_CQP + (size_t)((row >> 13) * 3 + t - (TP - 3)) * 1536 + c0 + c4) = v; }
                else { const int rr = row - MP, t = rr & 31; if (t >= TS - 3) *(f32x4*)(p.out + O_CQS + (size_t)((rr >> 5) * 3 + t - (TS - 3)) * 1536 + c0 + c4) = v; }
            }
        }
        return;
    }
    if (pn < 12) {
        const bool isq = pn < 10;
        const float* rope = (const float*)(ws + WS_ROPE);
        bf16_t* QB = (bf16_t*)(ws + WS_R4); bf16_t* KALL = (bf16_t*)(ws + WS_R5);
        const float qs = 0.125f * 1.4426950408889634f;
#pragma unroll 2
        for (int i = 0; i < 8; ++i) {
            const int id = tid + 512 * i, r = id >> 5, q = id & 31, hl = q >> 4, map = (q >> 3) & 1, d4 = (q & 7) * 4, row = brow + r;
            const int cl = hl * 128 + map * 64 + d4, col = ((pn & 1) * 2 + hl) * 128 + map * 64 + d4;
            const f32x4 x1 = *(const f32x4*)(CT + r * CST + cl), x2 = *(const f32x4*)(CT + r * CST + cl + 32);
            int pos; size_t krow; float* kout;
            if (!samp) { pos = row & (TP - 1); krow = row; kout = p.out + O_KP + (size_t)row * 512; }
            else { const int rr = row - MP; pos = PAST + (rr & 31); krow = (size_t)MP + (size_t)(rr >> 5) * TKS + pos; kout = p.out + O_KS + (size_t)rr * 512; }
            const f32x4 t0 = *(const f32x4*)(rope + (size_t)(pos * 32 + d4) * 2), t1 = *(const f32x4*)(rope + (size_t)(pos * 32 + d4) * 2 + 4);
            const f32x4 cs = (f32x4){t0.x, t0.z, t1.x, t1.z}, sn = (f32x4){t0.y, t0.w, t1.y, t1.w};
            const f32x4 y1 = x1 * cs - x2 * sn, y2 = x2 * cs + x1 * sn;
            if (isq) {
                u32x2 o1, o2; o1.x = pk2(y1.x * qs, y1.y * qs); o1.y = pk2(y1.z * qs, y1.w * qs); o2.x = pk2(y2.x * qs, y2.y * qs); o2.y = pk2(y2.z * qs, y2.w * qs);
                *(u32x2*)(QB + (size_t)row * 512 + col) = o1; *(u32x2*)(QB + (size_t)row * 512 + col + 32) = o2;
            } else {
                *(f32x4*)(kout + col) = y1; *(f32x4*)(kout + col + 32) = y2;
                u32x2 o1, o2; o1.x = pk2(y1.x, y1.y); o1.y = pk2(y1.z, y1.w); o2.x = pk2(y2.x, y2.y); o2.y = pk2(y2.z, y2.w);
                *(u32x2*)(KALL + krow * 512 + col) = o1; *(u32x2*)(KALL + krow * 512 + col + 32) = o2;
            }
        }
        return;
    }
    {
        bf16_t* VT = (bf16_t*)(ws + WS_R6);
#pragma unroll 4
        for (int i = 0; i < 16; ++i) {
            const int id = tid + 512 * i, r = id >> 6, c4 = (id & 63) * 4, row = brow + r, col = (pn & 1) * 256 + c4;
            const f32x4 v = *(const f32x4*)(CT + r * CST + c4);
            float* vout = samp ? p.out + O_VS + (size_t)(row - MP) * 512 + col : p.out + O_VP + (size_t)row * 512 + col;
            *(f32x4*)vout = v;
        }
#pragma unroll 1
        for (int i = 0; i < 2; ++i) {
            const int id = tid + 512 * i, rg = id >> 6, c4 = (id & 63) * 4, row0 = brow + rg * 8;
            f32x4 v[8];
#pragma unroll
            for (int e = 0; e < 8; ++e) v[e] = *(const f32x4*)(CT + (rg * 8 + e) * CST + c4);
#pragma unroll
            for (int e = 0; e < 4; ++e) {
                const int colg = (pn & 1) * 256 + c4 + e, head = colg >> 7, dv = colg & 127;
                u32x4 o; o.x = pk2(v[0][e], v[1][e]); o.y = pk2(v[2][e], v[3][e]); o.z = pk2(v[4][e], v[5][e]); o.w = pk2(v[6][e], v[7][e]);
                bf16_t* d;
                if (samp) { const int rr = row0 - MP; d = VT + VT_S_OFF + ((size_t)(((rr >> 5) * 4 + head) * 128 + dv) * TKS + PAST + (rr & 31)); }
                else d = VT + ((size_t)(((row0 >> 13) * 4 + head) * 128 + dv) * TP + (row0 & (TP - 1)));
                *(u32x4*)d = o;
            }
        }
    }
}

template <int WHICH> DI void epi_res_half(const Params& p, int pm, int pn, int ai) {
    const int tid = opaque_tid(), brow = pm * BM + ai * 128, bcol = pn * BM;
#pragma unroll 4
    for (int i = 0; i < 16; ++i) {
        const int id = tid + 512 * i, r = id >> 6, c4 = (id & 63) * 4, row = brow + r;
        const f32x4 v = *(const f32x4*)(CT + r * CST + c4);
        float* o = p.out + O_Y + (size_t)row * D + bcol + c4;
        const float* rs = WHICH == 0 ? xrow_ptr(p, row) + bcol + c4 : o;
        const f32x4 x = *(const f32x4*)rs;
        *(f32x4*)o = x * ALPHA + v;
    }
}

constexpr int UST = 264;
DI void epi_up(const Params& p, const f32x4 (&acc)[2][2][4][2], int pm, int pn) {
    unsigned char* ws = p.ws;
    bf16_t* U = (bf16_t*)dyn_smem;
    float* BND = (float*)(ws + WS_R5);
    const bool samp = pm == 128;
    const int brow = pm * BM, tid = opaque_tid();
    {
        const int wid = tid >> 6, lane = tid & 63, wr = wid >> 2, wc = wid & 3, fr = lane & 15, fq = lane >> 4;
        bf16_t* base = U + (wr * 64 + fq * 4) * UST + wc * 32 + fr;
#pragma unroll
        for (int ai = 0; ai < 2; ++ai)
#pragma unroll
            for (int m = 0; m < 4; ++m)
#pragma unroll
                for (int j = 0; j < 4; ++j)
#pragma unroll
                    for (int bj = 0; bj < 2; ++bj)
#pragma unroll
                        for (int n = 0; n < 2; ++n) base[(ai * 128 + m * 16 + j) * UST + bj * 128 + n * 16] = f2bf(acc[ai][bj][m][n][j]);
    }
    __syncthreads();
    {
        const int nb = samp ? 32 * 256 : 4 * 256;
        for (int id = tid; id < nb; id += 512) {
            const int cl = id & 255, q = id >> 8;
            const int oc = (cl >> 7) * DFF + 128 * pn + (cl & 127);
            int rr, bslot, u;
            if (!samp) { bslot = q; rr = q < 2 ? q : 252 + q; u = pm; }
            else { bslot = q & 3; rr = (q >> 2) * 32 + (bslot < 2 ? bslot : 28 + bslot); u = 128 + (q >> 2); }
            const float v = bf2f(U[rr * UST + cl]);
            BND[((size_t)u * 4 + bslot) * NUP + oc] = v;
            if (bslot >= 2) {
                if (samp) p.out[O_CFS + (size_t)((q >> 2) * 2 + bslot - 2) * NUP + oc] = v;
                else if ((pm & 31) == 31) p.out[O_CFP + (size_t)((pm >> 5) * 2 + bslot - 2) * NUP + oc] = v;
            }
        }
    }
    {
        const int c = tid & 127, rs = tid >> 7, cg_ = 128 * pn + c, cv_ = DFF + 128 * pn + c;
        const float wg0 = p.ffn_conv_w[cg_], wg1 = p.ffn_conv_w[NUP + cg_], wg2 = p.ffn_conv_w[2 * NUP + cg_], bg = p.ffn_conv_b[cg_];
        const float wv0 = p.ffn_conv_w[cv_], wv1 = p.ffn_conv_w[NUP + cv_], wv2 = p.ffn_conv_w[2 * NUP + cv_], bv = p.ffn_conv_b[cv_];
        bf16_t* GT = (bf16_t*)(ws + WS_R1);
        const int r0 = rs * 64;
        float g1 = 0.f, g2 = 0.f, v1 = 0.f, v2 = 0.f;
        if (r0 >= 2) { g1 = bf2f(U[(r0 - 2) * UST + c]); g2 = bf2f(U[(r0 - 1) * UST + c]); v1 = bf2f(U[(r0 - 2) * UST + 128 + c]); v2 = bf2f(U[(r0 - 1) * UST + 128 + c]); }
#pragma unroll 4
        for (int r = r0; r < r0 + 64; ++r) {
            const float g3 = bf2f(U[r * UST + c]), v3 = bf2f(U[r * UST + 128 + c]);
            const bool skip = samp ? ((r & 31) < 2) : (r < 2);
            if (!skip) {
                const float cg2 = wg0 * g1 + wg1 * g2 + wg2 * g3 + bg, cv2 = wv0 * v1 + wv1 * v2 + wv2 * v3 + bv;
                GT[(size_t)(brow + r) * DFF + 128 * pn + c] = f2bf(silu(cg2) * cv2);
            }
            g1 = g2; g2 = g3; v1 = v2; v2 = v3;
        }
    }
}

template <int K> DI void skinny_gemm(const bf16_t* __restrict__ A, const bf16_t* __restrict__ Bt, float* __restrict__ C, const int N) {
    const int tid = opaque_tid(), lane = tid & 63, w = __builtin_amdgcn_readfirstlane(tid >> 6), fr = lane & 15, fq = lane >> 4;
    float* red = (float*)dyn_smem;
    constexpr int KW = K / 8, NKS = KW / 32;
    const int ntile = 8 * (N / 32);
    for (int t = blockIdx.x; t < ntile; t += gridDim.x) {
        const int rm = t & 7, cn = t >> 3;
        const bf16_t* ap = A + (size_t)(32 * rm + fr) * K + w * KW + 8 * fq;
        const bf16_t* bp = Bt + (size_t)(32 * cn + fr) * K + w * KW + 8 * fq;
        f32x4 acc[2][2];
#pragma unroll
        for (int i = 0; i < 2; ++i)
#pragma unroll
            for (int j = 0; j < 2; ++j) acc[i][j] = (f32x4){0.f, 0.f, 0.f, 0.f};
#pragma unroll 4
        for (int ks = 0; ks < NKS; ++ks) {
            const bf16x8 a0 = *(const bf16x8*)(ap + ks * 32), a1 = *(const bf16x8*)(ap + (size_t)16 * K + ks * 32);
            const bf16x8 b0 = *(const bf16x8*)(bp + ks * 32), b1 = *(const bf16x8*)(bp + (size_t)16 * K + ks * 32);
            acc[0][0] = __builtin_amdgcn_mfma_f32_16x16x32_bf16(a0, b0, acc[0][0], 0, 0, 0);
            acc[0][1] = __builtin_amdgcn_mfma_f32_16x16x32_bf16(a0, b1, acc[0][1], 0, 0, 0);
            acc[1][0] = __builtin_amdgcn_mfma_f32_16x16x32_bf16(a1, b0, acc[1][0], 0, 0, 0);
            acc[1][1] = __builtin_amdgcn_mfma_f32_16x16x32_bf16(a1, b1, acc[1][1], 0, 0, 0);
        }
        __syncthreads();
#pragma unroll
        for (int i = 0; i < 2; ++i)
#pragma unroll
            for (int j = 0; j < 2; ++j)
#pragma unroll
                for (int e = 0; e < 4; ++e) red[(w * 32 + 16 * i + 4 * fq + e) * 33 + 16 * j + fr] = acc[i][j][e];
        __syncthreads();
#pragma unroll
        for (int o2 = 0; o2 < 2; ++o2) {
            const int o = tid + 512 * o2, r = o >> 5, c = o & 31;
            float sum = 0.f;
#pragma unroll
            for (int ww = 0; ww < 8; ++ww) sum += red[(ww * 32 + r) * 33 + c];
            C[(size_t)(32 * rm + r) * N + 32 * cn + c] = sum;
        }
    }
    __syncthreads();
}

template <int WHICH> DI void gemm_phase(const Params& p) {
    unsigned char* ws = p.ws;
    const bf16_t* A; const bf16_t* Bt; int N; constexpr int K = WHICH == 4 ? DFF : D; float* CS;
    if (WHICH == 1) { A = (const bf16_t*)(ws + WS_R1); Bt = (const bf16_t*)(ws + WS_WIN); N = NH1; CS = (float*)(ws + WS_CS1); }
    else if (WHICH == 2) { A = (const bf16_t*)(ws + WS_R2); Bt = (const bf16_t*)(ws + WS_WO); N = D; CS = (float*)(ws + WS_CS2); }
    else if (WHICH == 3) { A = (const bf16_t*)(ws + WS_R3); Bt = (const bf16_t*)(ws + WS_WUP); N = NUP; CS = (float*)(ws + WS_CS3); }
    else { A = (const bf16_t*)(ws + WS_R1); Bt = (const bf16_t*)(ws + WS_WDN); N = D; CS = (float*)(ws + WS_CS4); }
    skinny_gemm<K>(A + (size_t)MP * K, Bt, CS, N);
    const int nM = MP / BM, nN = N / BM, ntile = nM * nN;
    for (int L0 = blockIdx.x; L0 < ntile * (WHICH == GREP_WHICH ? 2 : 1); L0 += gridDim.x) {
        const int L = L0 % ntile;
        int pm, pn; tile_of(L, nM, nN, pm, pn);
        f32x4 acc[2][2][4][2];
        gemm_tile<K>(A, Bt, pm * BM, pn * BM, acc);
        if (WHICH == 3) epi_up(p, acc, pm, pn);
        else {
#pragma unroll
            for (int ai = 0; ai < 2; ++ai) {
                stage_half(acc, ai);
                __syncthreads();
                if (WHICH == 1) epi_in_half(p, pm, pn, ai);
                else if (WHICH == 2) epi_res_half<0>(p, pm, pn, ai);
                else epi_res_half<1>(p, pm, pn, ai);
                __syncthreads();
            }
        }
        __syncthreads();
    }
}

template <int WHICH> DI void ln_phase(const Params& p) {
    const int lane = threadIdx.x & 63, wave = threadIdx.x >> 6;
    const float* g = WHICH == 0 ? p.ln1_g : p.ln2_g; const float* b = WHICH == 0 ? p.ln1_b : p.ln2_b;
    bf16_t* X1B = (bf16_t*)(p.ws + WS_R3);
    f32x4 gv[4], bv[4];
#pragma unroll
    for (int j = 0; j < 4; ++j) { gv[j] = *(const f32x4*)(g + lane * 4 + 256 * j); bv[j] = *(const f32x4*)(b + lane * 4 + 256 * j); }
    for (int row = blockIdx.x * 8 + wave; row < M; row += gridDim.x * 8) {
        float* xr = p.out + O_Y + (size_t)row * D;
        f32x4 v[4]; float s = 0.f;
        if (row < MP) {
#pragma unroll
            for (int j = 0; j < 4; ++j) v[j] = *(const f32x4*)(xr + lane * 4 + 256 * j);
        } else {
            const float* rs = WHICH == 0 ? p.x_s + (size_t)(row - MP) * D : xr;
            const float* cs = (const float*)(p.ws + (WHICH == 0 ? WS_CS2 : WS_CS4)) + (size_t)(row - MP) * D;
#pragma unroll
            for (int j = 0; j < 4; ++j) v[j] = *(const f32x4*)(rs + lane * 4 + 256 * j) * ALPHA + *(const f32x4*)(cs + lane * 4 + 256 * j);
        }
#pragma unroll
        for (int j = 0; j < 4; ++j) s += (v[j].x + v[j].y) + (v[j].z + v[j].w);
        const float mean = wave_sum(s) * (1.f / D); float s2 = 0.f;
#pragma unroll
        for (int j = 0; j < 4; ++j) { v[j] = v[j] - mean; s2 += (v[j].x * v[j].x + v[j].y * v[j].y) + (v[j].z * v[j].z + v[j].w * v[j].w); }
        const float rstd = rsqrtf(wave_sum(s2) * (1.f / D) + 1e-5f);
#pragma unroll
        for (int j = 0; j < 4; ++j) {
            const f32x4 o = v[j] * rstd * gv[j] + bv[j];
            *(f32x4*)(xr + lane * 4 + 256 * j) = o;
            if (WHICH == 0) { u32x2 q; q.x = pk2(o.x, o.y); q.y = pk2(o.z, o.w); *(u32x2*)(X1B + (size_t)row * D + lane * 4 + 256 * j) = q; }
        }
    }
}

DI void fixup_phase(const Params& p) {
    const float* BND = (const float*)(p.ws + WS_R5);
    bf16_t* GT = (bf16_t*)(p.ws + WS_R1);
    {
        const float* CS3 = (const float*)(p.ws + WS_CS3);
        for (int idx = blockIdx.x * 512 + threadIdx.x; idx < MS * DFF; idx += gridDim.x * 512) {
            const int c = idx % DFF, r = idx / DFF, b = r >> 5, t = r & 31, ng = (c >> 7) * 256 + (c & 127), nv = ng + 128;
            float g[3], v[3];
#pragma unroll
            for (int k = 0; k < 3; ++k) {
                const int tt = t - 2 + k;
                if (tt >= 0) { g[k] = CS3[(size_t)(b * 32 + tt) * NUP + ng]; v[k] = CS3[(size_t)(b * 32 + tt) * NUP + nv]; }
                else { g[k] = p.state_cf[(size_t)(b * 2 + 2 + tt) * NUP + c]; v[k] = p.state_cf[(size_t)(b * 2 + 2 + tt) * NUP + DFF + c]; }
            }
            const float cg2 = p.ffn_conv_w[c] * g[0] + p.ffn_conv_w[NUP + c] * g[1] + p.ffn_conv_w[2 * NUP + c] * g[2] + p.ffn_conv_b[c];
            const float cv2 = p.ffn_conv_w[DFF + c] * v[0] + p.ffn_conv_w[NUP + DFF + c] * v[1] + p.ffn_conv_w[2 * NUP + DFF + c] * v[2] + p.ffn_conv_b[DFF + c];
            GT[((size_t)MP + r) * DFF + c] = f2bf(silu(cg2) * cv2);
            if (t >= 30) { p.out[O_CFS + (size_t)(b * 2 + t - 30) * NUP + c] = g[2]; p.out[O_CFS + (size_t)(b * 2 + t - 30) * NUP + DFF + c] = v[2]; }
        }
    }
    const int total = 128 * 2 * DFF;
    for (int idx = blockIdx.x * 512 + threadIdx.x; idx < total; idx += gridDim.x * 512) {
        const int c = idx % DFF, q = idx / DFF, r = q & 1, u = q >> 1;
        const float* cur = BND + (size_t)u * 4 * NUP;
        float pg[2], pv[2];
        if (u < 128) {
            if ((u & 31) == 0) { pg[0] = pg[1] = pv[0] = pv[1] = 0.f; }
            else { const float* pr = BND + (size_t)(u - 1) * 4 * NUP; pg[0] = pr[2 * NUP + c]; pg[1] = pr[3 * NUP + c]; pv[0] = pr[2 * NUP + DFF + c]; pv[1] = pr[3 * NUP + DFF + c]; }
        } else { const float* st = p.state_cf + (size_t)(u - 128) * 2 * NUP; pg[0] = st[c]; pg[1] = st[NUP + c]; pv[0] = st[DFF + c]; pv[1] = st[NUP + DFF + c]; }
        const float cg0 = cur[c], cg1 = cur[NUP + c], cv0 = cur[DFF + c], cv1 = cur[NUP + DFF + c];
        const float wg0 = p.ffn_conv_w[c], wg1 = p.ffn_conv_w[NUP + c], wg2 = p.ffn_conv_w[2 * NUP + c], bg = p.ffn_conv_b[c];
        const float wv0 = p.ffn_conv_w[DFF + c], wv1 = p.ffn_conv_w[NUP + DFF + c], wv2 = p.ffn_conv_w[2 * NUP + DFF + c], bv = p.ffn_conv_b[DFF + c];
        float g, v;
        if (r == 0) { g = wg0 * pg[0] + wg1 * pg[1] + wg2 * cg0 + bg; v = wv0 * pv[0] + wv1 * pv[1] + wv2 * cv0 + bv; }
        else { g = wg0 * pg[1] + wg1 * cg0 + wg2 * cg1 + bg; v = wv0 * pv[1] + wv1 * cv0 + wv2 * cv1 + bv; }
        const size_t row = u < 128 ? (size_t)u * 256 + r : (size_t)MP + (size_t)(u - 128) * 32 + r;
        GT[row * DFF + c] = f2bf(silu(g) * v);
    }
}

#define MFMA16(a, b, c) __builtin_amdgcn_mfma_f32_16x16x32_bf16((a), (b), (c), 0, 0, 0)
#define MFMA32(a, b, c) __builtin_amdgcn_mfma_f32_32x32x16_bf16((a), (b), (c), 0, 0, 0)
DI bf16x8 pack8(const f32x4 a, const f32x4 b) { u32x4 o; o.x = pk2(a.x, a.y); o.y = pk2(a.z, a.w); o.z = pk2(b.x, b.y); o.w = pk2(b.z, b.w); return __builtin_bit_cast(bf16x8, o); }
constexpr float GSCALE = 0.08838834764831845f;
constexpr int QST = 132, AST = 68, NST = 136, QKST = 72;
constexpr int L_QKV = 0, L_AM = 3 * 64 * QST * 4, L_KN = L_AM + 64 * AST * 4, L_QN = L_KN + 64 * NST * 2, L_GC = L_QN + 64 * NST * 2;
constexpr int L_QKS = 0, L_WS = 64 * QKST * 2;
static_assert(L_GC + 1024 <= LDS_BYTES, "gdn prep LDS");

DI void gdn_prep_phase(const Params& p) {
    unsigned char* ws = p.ws;
    float* QKVf = (float*)(dyn_smem + L_QKV); float* AM = (float*)(dyn_smem + L_AM);
    bf16_t* KN = (bf16_t*)(dyn_smem + L_KN); bf16_t* QN = (bf16_t*)(dyn_smem + L_QN);
    float* GC = (float*)(dyn_smem + L_GC); float* BETA = GC + 64; float* EG = GC + 128; float* ED = GC + 192;
    bf16_t* QKS = (bf16_t*)(dyn_smem + L_QKS); bf16_t* WSI = (bf16_t*)(dyn_smem + L_WS);
    const bf16_t* HQKV = (const bf16_t*)(ws + WS_R2);
    const float* AB = (const float*)(ws + WS_AB);
    float* DL = (float*)(ws + WS_DL);
    for (int r = blockIdx.x; r < MS; r += gridDim.x) {
        const int tid = opaque_tid(), b = r >> 5, t = r & 31, pos = PAST + t;
        const float* cs = (const float*)(ws + WS_CS1) + (size_t)r * NH1;
        if (t >= TS - 3) { for (int c = tid; c < 1536; c += 512) p.out[O_CQS + (size_t)(b * 3 + t - (TS - 3)) * 1536 + c] = cs[c]; }
        {
            const int which = tid >> 8, pr = tid & 255, hd = pr >> 6, mp = (pr >> 5) & 1, d = pr & 31, col = hd * 128 + mp * 64 + d;
            const float2 csn = ((const float2*)(ws + WS_ROPE))[pos * 32 + d];
            const float x1 = cs[2048 + which * 512 + col], x2 = cs[2048 + which * 512 + col + 32];
            const float y1 = x1 * csn.x - x2 * csn.y, y2 = x2 * csn.x + x1 * csn.y;
            if (which == 0) { const float qs = 0.125f * 1.4426950408889634f; bf16_t* QB = (bf16_t*)(ws + WS_R4) + ((size_t)MP + r) * 512; QB[col] = f2bf(y1 * qs); QB[col + 32] = f2bf(y2 * qs); }
            else { float* ko = p.out + O_KS + (size_t)r * 512; ko[col] = y1; ko[col + 32] = y2;
                   bf16_t* kk = (bf16_t*)(ws + WS_R5) + ((size_t)MP + (size_t)b * TKS + pos) * 512; kk[col] = f2bf(y1); kk[col + 32] = f2bf(y2); }
        }
        {
            const float vv = cs[3072 + tid];
            p.out[O_VS + (size_t)r * 512 + tid] = vv;
            ((bf16_t*)(ws + WS_R6))[VT_S_OFF + ((size_t)((b * 4 + (tid >> 7)) * 128 + (tid & 127)) * TKS + pos)] = f2bf(vv);
        }
    }
    for (int item = blockIdx.x; item < NITEM; item += gridDim.x) {
        const int tid = opaque_tid(), lane = tid & 63, wave = __builtin_amdgcn_readfirstlane(tid >> 6), fr = lane & 15, fq = lane >> 4;
        int h, b, c, row0, valid; bool samp;
        if (item < 2048) { h = item & 3; c = (item >> 2) & 127; b = item >> 9; row0 = b * TP + c * 64; valid = 64; samp = false; }
        else { const int j = item - 2048; h = j & 3; b = j >> 2; c = 0; row0 = MP + b * TS; valid = TS; samp = true; }
        unsigned char* ip = ws + WS_R1 + (size_t)item * ITEM_B;
        __syncthreads();
        {
            bf16_t* RAW = (bf16_t*)(dyn_smem + L_AM);
#pragma unroll
            for (int i = 0; i < 7; ++i) {
                const int id = tid + 512 * i;
                if (id < 67 * 48) {
                    const int rw = id / 48, ch = id % 48, part = ch >> 4, c8 = (ch & 15) * 8, gcol = part * 512 + h * 128 + c8, t = rw - 3;
                    u32x4 v = (u32x4){0u, 0u, 0u, 0u};
                    if (t >= 0) {
                        if (t < valid) {
                            if (!samp) v = *(const u32x4*)(HQKV + (size_t)(row0 + t) * 1536 + gcol);
                            else { const float* sp = (const float*)(ws + WS_CS1) + (size_t)(row0 - MP + t) * NH1 + gcol; const f32x4 f0 = *(const f32x4*)sp, f1 = *(const f32x4*)(sp + 4);
                                   v.x = pk2(f0.x, f0.y); v.y = pk2(f0.z, f0.w); v.z = pk2(f1.x, f1.y); v.w = pk2(f1.z, f1.w); }
                        }
                    }
                    else if (samp) { const float* sp = p.state_cq + (size_t)(b * 3 + 3 + t) * 1536 + gcol; const f32x4 f0 = *(const f32x4*)sp, f1 = *(const f32x4*)(sp + 4);
                                     v.x = pk2(f0.x, f0.y); v.y = pk2(f0.z, f0.w); v.z = pk2(f1.x, f1.y); v.w = pk2(f1.z, f1.w); }
                    else if (c != 0) v = *(const u32x4*)(HQKV + (size_t)(row0 + t) * 1536 + gcol);
                    *(u32x4*)(RAW + rw * 384 + ch * 8) = v;
                }
            }
            __syncthreads();
#pragma unroll 1
            for (int task = tid; task < 1536; task += 512) {
                const int col = task % 384, seg = task / 384, part = col >> 7, cc = col & 127, gcol = part * 512 + h * 128 + cc, t0 = seg * 16;
                const float w0 = p.gdn_conv_w[gcol], w1 = p.gdn_conv_w[1536 + gcol], w2 = p.gdn_conv_w[2 * 1536 + gcol], w3 = p.gdn_conv_w[3 * 1536 + gcol];
                float x0 = bf2f(RAW[(t0) * 384 + col]), x1 = bf2f(RAW[(t0 + 1) * 384 + col]), x2 = bf2f(RAW[(t0 + 2) * 384 + col]);
#pragma unroll
                for (int t = t0; t < t0 + 16; ++t) {
                    const float xv = bf2f(RAW[(t + 3) * 384 + col]);
                    const float y = w0 * x0 + w1 * x1 + w2 * x2 + w3 * xv;
                    QKVf[(part * 64 + t) * QST + cc] = t < valid ? silu(y) : 0.f;
                    x0 = x1; x1 = x2; x2 = xv;
                }
            }
        }
        if (tid < 64) {
            float g = 0.f, be = 0.f;
            if (tid < valid) {
                const float a = AB[(size_t)(row0 + tid) * 8 + h] + p.dt_bias[h], bb = AB[(size_t)(row0 + tid) * 8 + 4 + h];
                const float sp = a > 20.f ? a : log1pf(expf(a));
                g = -expf(p.a_log[h]) * sp; be = 1.f / (1.f + expf(-bb));
            }
            float gc = g;
#pragma unroll
            for (int o = 1; o < 64; o <<= 1) { const float n = __shfl_up(gc, o); if (lane >= o) gc += n; }
            const float gl = __shfl(gc, 63);
            GC[tid] = gc; BETA[tid] = be; EG[tid] = expf(gc); ED[tid] = expf(gl - gc);
            if (tid == 0) DL[item] = expf(gl);
        }
        __syncthreads();
        {
            const int row = tid >> 3, pt = tid & 7;
            float q[16], k[16]; float sq = 0.f, sk = 0.f;
#pragma unroll
            for (int e4 = 0; e4 < 4; ++e4) {
                const f32x4 a = *(const f32x4*)(QKVf + row * QST + 16 * pt + 4 * e4), bq = *(const f32x4*)(QKVf + (64 + row) * QST + 16 * pt + 4 * e4);
#pragma unroll
                for (int e = 0; e < 4; ++e) { q[4 * e4 + e] = a[e]; k[4 * e4 + e] = bq[e]; sq += a[e] * a[e]; sk += bq[e] * bq[e]; }
            }
#pragma unroll
            for (int o = 1; o < 8; o <<= 1) { sq += __shfl_xor(sq, o); sk += __shfl_xor(sk, o); }
            const float rq = rsqrtf(sq + 1e-6f), rk = rsqrtf(sk + 1e-6f), qg = rq * GSCALE * EG[row];
            u32x4 o0, o1;
            o0.x = pk2(q[0] * rq, q[1] * rq); o0.y = pk2(q[2] * rq, q[3] * rq); o0.z = pk2(q[4] * rq, q[5] * rq); o0.w = pk2(q[6] * rq, q[7] * rq);
            o1.x = pk2(q[8] * rq, q[9] * rq); o1.y = pk2(q[10] * rq, q[11] * rq); o1.z = pk2(q[12] * rq, q[13] * rq); o1.w = pk2(q[14] * rq, q[15] * rq);
            *(u32x4*)(QN + row * NST + 16 * pt) = o0; *(u32x4*)(QN + row * NST + 16 * pt + 8) = o1;
            o0.x = pk2(k[0] * rk, k[1] * rk); o0.y = pk2(k[2] * rk, k[3] * rk); o0.z = pk2(k[4] * rk, k[5] * rk); o0.w = pk2(k[6] * rk, k[7] * rk);
            o1.x = pk2(k[8] * rk, k[9] * rk); o1.y = pk2(k[10] * rk, k[11] * rk); o1.z = pk2(k[12] * rk, k[13] * rk); o1.w = pk2(k[14] * rk, k[15] * rk);
            *(u32x4*)(KN + row * NST + 16 * pt) = o0; *(u32x4*)(KN + row * NST + 16 * pt + 8) = o1;
#pragma unroll
            for (int e4 = 0; e4 < 4; ++e4) *(f32x4*)(QKVf + (64 + row) * QST + 16 * pt + 4 * e4) = (f32x4){k[4 * e4] * rk, k[4 * e4 + 1] * rk, k[4 * e4 + 2] * rk, k[4 * e4 + 3] * rk};
            bf16_t* QGf = (bf16_t*)(ip + 16384);
            const int rt = row >> 4, frr = row & 15, ks = pt >> 1;
#pragma unroll
            for (int f = 0; f < 4; ++f) {
                u32x2 o; o.x = pk2(q[4 * f] * qg, q[4 * f + 1] * qg); o.y = pk2(q[4 * f + 2] * qg, q[4 * f + 3] * qg);
                *(u32x2*)(QGf + (size_t)(((rt * 4 + ks) * 64 + f * 16 + frr) * 8 + 4 * (pt & 1))) = o;
            }
        }
        __syncthreads();
        {
            const bool isq = wave >= 4; const int ti = wave & 3;
            const bf16_t* As = isq ? QN : KN;
#pragma unroll
            for (int tj = 0; tj < 4; ++tj) {
                f32x4 acc = (f32x4){0.f, 0.f, 0.f, 0.f};
#pragma unroll
                for (int ks = 0; ks < 4; ++ks) {
                    const bf16x8 a = *(const bf16x8*)(As + (16 * ti + fr) * NST + 32 * ks + 8 * fq), bb = *(const bf16x8*)(KN + (16 * tj + fr) * NST + 32 * ks + 8 * fq);
                    acc = MFMA16(a, bb, acc);
                }
                const int jj = 16 * tj + fr; const float gj = GC[jj];
#pragma unroll
                for (int j = 0; j < 4; ++j) {
                    const int i = 16 * ti + 4 * fq + j;
                    const float dec = i >= jj ? expf(GC[i] - gj) : 0.f;
                    if (!isq) AM[i * AST + jj] = i > jj ? BETA[i] * acc[j] * dec : 0.f;
                    else QKS[i * QKST + jj] = f2bf(GSCALE * acc[j] * dec);
                }
            }
            bf16_t* KDTf = (bf16_t*)(ip + 32768);
#pragma unroll
            for (int i2 = 0; i2 < 2; ++i2) {
                const int f = tid + 512 * i2, ln = f & 63, ks2 = (f >> 6) & 1, dt = f >> 7, fq_ = ln >> 4, dk = 16 * dt + (ln & 15);
                float v[8];
#pragma unroll
                for (int e = 0; e < 8; ++e) { const int i = 32 * ks2 + 16 * (e >> 2) + 4 * fq_ + (e & 3); v[e] = bf2f(KN[i * NST + dk]) * ED[i]; }
                u32x4 o; o.x = pk2(v[0], v[1]); o.y = pk2(v[2], v[3]); o.z = pk2(v[4], v[5]); o.w = pk2(v[6], v[7]);
                *(u32x4*)(KDTf + (size_t)f * 8) = o;
            }
        }
        __syncthreads();
        {
            float* TM = (float*)(dyn_smem + L_QN);
            float* TMP = (float*)(dyn_smem + L_KN);
#pragma unroll
            for (int i = 0; i < 9; ++i) { const int id = tid + 512 * i; if (id < 64 * AST) TM[id] = 0.f; }
            __syncthreads();
            if (tid < 64) {
                const int d = tid >> 4, c = tid & 15;
                float y[16];
#pragma unroll
                for (int r = 0; r < 16; ++r) {
                    float sacc = r == c ? 1.f : 0.f;
                    const float* ar = AM + (16 * d + r) * AST + 16 * d;
#pragma unroll
                    for (int j = 0; j < r; ++j) sacc -= ar[j] * y[j];
                    y[r] = sacc;
                    TM[(16 * d + r) * AST + 16 * d + c] = sacc;
                }
            }
            __syncthreads();
            {
                const int blk = tid >> 8, r = (tid >> 4) & 15, c = tid & 15, rb = blk ? 3 : 1, cb = rb - 1;
                float t = 0.f;
#pragma unroll
                for (int j = 0; j < 16; ++j) t += AM[(16 * rb + r) * AST + 16 * cb + j] * TM[(16 * cb + j) * AST + 16 * cb + c];
                TMP[blk * 272 + r * 17 + c] = t;
                __syncthreads();
                float o = 0.f;
#pragma unroll
                for (int k = 0; k < 16; ++k) o -= TM[(16 * rb + r) * AST + 16 * rb + k] * TMP[blk * 272 + k * 17 + c];
                __syncthreads();
                TM[(16 * rb + r) * AST + 16 * cb + c] = o;
            }
            __syncthreads();
            {
                float t[2];
#pragma unroll
                for (int i2 = 0; i2 < 2; ++i2) {
                    const int o = tid + 512 * i2, r = o >> 5, c = o & 31;
                    float acc = 0.f;
#pragma unroll
                    for (int j = 0; j < 32; ++j) acc += AM[(32 + r) * AST + j] * TM[j * AST + c];
                    t[i2] = acc;
                }
#pragma unroll
                for (int i2 = 0; i2 < 2; ++i2) { const int o = tid + 512 * i2; TMP[(o >> 5) * 33 + (o & 31)] = t[i2]; }
                __syncthreads();
#pragma unroll
                for (int i2 = 0; i2 < 2; ++i2) {
                    const int o = tid + 512 * i2, r = o >> 5, c = o & 31;
                    float acc = 0.f;
#pragma unroll
                    for (int k = 0; k < 32; ++k) acc -= TM[(32 + r) * AST + 32 + k] * TMP[k * 33 + c];
                    t[i2] = acc;
                }
#pragma unroll
                for (int i2 = 0; i2 < 2; ++i2) { const int o = tid + 512 * i2; TM[(32 + (o >> 5)) * AST + (o & 31)] = t[i2]; }
            }
            __syncthreads();
            {
                bf16x8 Ah[4][2], Al[4][2];
#pragma unroll
                for (int rt = 0; rt < 4; ++rt)
#pragma unroll
                    for (int ks = 0; ks < 2; ++ks) {
                        const f32x4 a0 = *(const f32x4*)(TM + (16 * rt + fr) * AST + 32 * ks + 8 * fq), a1 = *(const f32x4*)(TM + (16 * rt + fr) * AST + 32 * ks + 8 * fq + 4);
                        u32x4 hq; hq.x = pk2(a0.x, a0.y); hq.y = pk2(a0.z, a0.w); hq.z = pk2(a1.x, a1.y); hq.w = pk2(a1.z, a1.w);
                        u32x4 lq; lq.x = pk2(a0.x - bflo(hq.x), a0.y - bfhi(hq.x)); lq.y = pk2(a0.z - bflo(hq.y), a0.w - bfhi(hq.y));
                        lq.z = pk2(a1.x - bflo(hq.z), a1.y - bfhi(hq.z)); lq.w = pk2(a1.z - bflo(hq.w), a1.w - bfhi(hq.w));
                        Ah[rt][ks] = __builtin_bit_cast(bf16x8, hq); Al[rt][ks] = __builtin_bit_cast(bf16x8, lq);
                    }
                const bool isw = wave >= 4;
                f32x4 xacc[2][4];
#pragma unroll
                for (int q = 0; q < 2; ++q)
#pragma unroll
                    for (int rt = 0; rt < 4; ++rt) xacc[q][rt] = (f32x4){0.f, 0.f, 0.f, 0.f};
#pragma unroll
                for (int ks = 0; ks < 2; ++ks) {
                    float sc8[8];
                    {
                        const f32x4 b0 = *(const f32x4*)(BETA + 32 * ks + 8 * fq), b1 = *(const f32x4*)(BETA + 32 * ks + 8 * fq + 4);
                        const f32x4 e0 = *(const f32x4*)(EG + 32 * ks + 8 * fq), e1 = *(const f32x4*)(EG + 32 * ks + 8 * fq + 4);
#pragma unroll
                        for (int e = 0; e < 4; ++e) { sc8[e] = isw ? b0[e] * e0[e] : b0[e]; sc8[4 + e] = isw ? b1[e] * e1[e] : b1[e]; }
                    }
#pragma unroll
                    for (int q = 0; q < 2; ++q) {
                        const int cc = ((2 * wave + q) & 7) * 16 + fr;
                        const float* src = QKVf + ((isw ? 64 : 128) + 32 * ks + 8 * fq) * QST + cc;
                        float v[8];
#pragma unroll
                        for (int e = 0; e < 8; ++e) v[e] = src[e * QST] * sc8[e];
                        u32x4 hq; hq.x = pk2(v[0], v[1]); hq.y = pk2(v[2], v[3]); hq.z = pk2(v[4], v[5]); hq.w = pk2(v[6], v[7]);
                        u32x4 lq; lq.x = pk2(v[0] - bflo(hq.x), v[1] - bfhi(hq.x)); lq.y = pk2(v[2] - bflo(hq.y), v[3] - bfhi(hq.y));
                        lq.z = pk2(v[4] - bflo(hq.z), v[5] - bfhi(hq.z)); lq.w = pk2(v[6] - bflo(hq.w), v[7] - bfhi(hq.w));
                        const bf16x8 Bh = __builtin_bit_cast(bf16x8, hq), Bl = __builtin_bit_cast(bf16x8, lq);
#pragma unroll
                        for (int rt = 0; rt < 4; ++rt) {
                            xacc[q][rt] = MFMA16(Ah[rt][ks], Bh, xacc[q][rt]);
                            xacc[q][rt] = MFMA16(Al[rt][ks], Bh, xacc[q][rt]);
                            xacc[q][rt] = MFMA16(Ah[rt][ks], Bl, xacc[q][rt]);
                        }
                    }
                }
                if (!isw) {
                    float* Uc = (float*)(ip + 57344);
#pragma unroll
                    for (int q = 0; q < 2; ++q)
#pragma unroll
                        for (int rt = 0; rt < 4; ++rt) *(f32x4*)(Uc + (size_t)((((2 * wave + q) * 4 + rt) * 64 + lane) * 4)) = xacc[q][rt];
                } else {
#pragma unroll
                    for (int q = 0; q < 2; ++q)
#pragma unroll
                        for (int rt = 0; rt < 4; ++rt)
#pragma unroll
                            for (int j = 0; j < 4; ++j) WSI[(16 * rt + 4 * fq + j) * NST + ((2 * wave + q) & 7) * 16 + fr] = f2bf(xacc[q][rt][j]);
                }
            }
        }
        __syncthreads();
        {
            bf16_t* Wf = (bf16_t*)ip; bf16_t* QKf = (bf16_t*)(ip + 49152);
#pragma unroll
            for (int i2 = 0; i2 < 2; ++i2) {
                const int f = tid + 512 * i2, ln = f & 63, ks = (f >> 6) & 3, rt = f >> 8, i = 16 * rt + (ln & 15), fq_ = ln >> 4;
                const u32x2 lo = *(const u32x2*)(WSI + i * NST + 32 * ks + 4 * fq_), hi = *(const u32x2*)(WSI + i * NST + 32 * ks + 16 + 4 * fq_);
                *(u32x4*)(Wf + (size_t)f * 8) = (u32x4){lo.x, lo.y, hi.x, hi.y};
            }
            {
                const int f = tid, ln = f & 63, ks2 = (f >> 6) & 1, rt = f >> 7, i = 16 * rt + (ln & 15), fq_ = ln >> 4;
                const u32x2 lo = *(const u32x2*)(QKS + i * QKST + 32 * ks2 + 4 * fq_), hi = *(const u32x2*)(QKS + i * QKST + 32 * ks2 + 16 + 4 * fq_);
                *(u32x4*)(QKf + (size_t)f * 8) = (u32x4){lo.x, lo.y, hi.x, hi.y};
            }
        }
    }
}

constexpr int OPB_B = 57344, L_OBUF = 2 * OPB_B, OST = 132;
static_assert(L_OBUF + 64 * OST * 4 <= LDS_BYTES, "scan LDS");
DI void gdn_scan(const Params& p, const bool samp, const int b, const int h) {
    unsigned char* ws = p.ws;
    const int tid = threadIdx.x, lane = tid & 63, w = __builtin_amdgcn_readfirstlane(tid >> 6), fr = lane & 15, fq = lane >> 4;
    const int nsteps = samp ? 1 : 128, valid = samp ? TS : 64;
    float* OBUF = (float*)(dyn_smem + L_OBUF);
    const bf16_t* HG = (const bf16_t*)(ws + WS_R3);
    bf16_t* OMIX = (bf16_t*)(ws + WS_R2);
    const float* DL = (const float*)(ws + WS_DL);
    f32x4 S[8];
#pragma unroll
    for (int dt = 0; dt < 8; ++dt) {
        if (samp) {
#pragma unroll
            for (int j = 0; j < 4; ++j) S[dt][j] = p.state_gdn[((size_t)(b * 4 + h) * 128 + 16 * dt + 4 * fq + j) * 128 + 16 * w + fr];
        } else S[dt] = (f32x4){0.f, 0.f, 0.f, 0.f};
    }
    const int item0 = samp ? 2048 + b * 4 + h : b * 512 + h;
    __syncthreads();
    {
        const unsigned char* ip = ws + WS_R1 + (size_t)item0 * ITEM_B;
#pragma unroll
        for (int i = 0; i < 7; ++i) *(u32x4*)(dyn_smem + (tid + 512 * i) * 16) = *(const u32x4*)(ip + (tid + 512 * i) * 16);
    }
    __syncthreads();
    const int erow = tid >> 3, ept = tid & 7;
    float nw[16];
#pragma unroll
    for (int e = 0; e < 16; ++e) nw[e] = p.gdn_norm_w[16 * ept + e];
    f32x4 U[4]; float dl; u32x4 g0, g1;
    auto side_load = [&](int c, f32x4 (&Uo)[4], float& dlo, u32x4& go0, u32x4& go1) {
        const int item = item0 + 4 * c;
        const float* Uc = (const float*)(ws + WS_R1 + (size_t)item * ITEM_B + 57344);
#pragma unroll
        for (int rt = 0; rt < 4; ++rt) Uo[rt] = *(const f32x4*)(Uc + ((w * 4 + rt) * 64 + lane) * 4);
        dlo = DL[item];
        const size_t grow = (samp ? (size_t)MP + b * TS : (size_t)b * TP + (size_t)c * 64) + erow;
        if (!samp) { go0 = *(const u32x4*)(HG + grow * 512 + h * 128 + 16 * ept); go1 = *(const u32x4*)(HG + grow * 512 + h * 128 + 16 * ept + 8); }
        else if (erow < TS) { const float* gp = (const float*)(ws + WS_CS1) + (grow - MP) * NH1 + 1536 + h * 128 + 16 * ept;
               const f32x4 f0 = *(const f32x4*)gp, f1 = *(const f32x4*)(gp + 4), f2 = *(const f32x4*)(gp + 8), f3 = *(const f32x4*)(gp + 12);
               go0 = (u32x4){pk2(f0.x, f0.y), pk2(f0.z, f0.w), pk2(f1.x, f1.y), pk2(f1.z, f1.w)}; go1 = (u32x4){pk2(f2.x, f2.y), pk2(f2.z, f2.w), pk2(f3.x, f3.y), pk2(f3.z, f3.w)}; }
        else { go0 = (u32x4){0u, 0u, 0u, 0u}; go1 = go0; }
    };
    side_load(0, U, dl, g0, g1);
#pragma unroll 1
    for (int c = 0; c < nsteps; ++c) {
        const int item = item0 + 4 * c;
        const unsigned char* ip = ws + WS_R1 + (size_t)item * ITEM_B;
        const bool nxt = c + 1 < nsteps;
        u32x4 pf[7];
        f32x4 Un[4]; float dln = 0.f; u32x4 gn0 = g0, gn1 = g1;
        if (nxt) {
#pragma unroll
            for (int i = 0; i < 7; ++i) pf[i] = *(const u32x4*)(ip + 4 * (size_t)ITEM_B + (tid + 512 * i) * 16);
            side_load(c + 1, Un, dln, gn0, gn1);
        }
        const unsigned char* buf = dyn_smem + (c & 1) * OPB_B;
        bf16x8 Sb[4];
#pragma unroll
        for (int ks = 0; ks < 4; ++ks) Sb[ks] = pack8(S[2 * ks], S[2 * ks + 1]);
        f32x4 vn[4];
#pragma unroll
        for (int rt = 0; rt < 4; ++rt) {
            f32x4 acc = (f32x4){0.f, 0.f, 0.f, 0.f};
#pragma unroll
            for (int ks = 0; ks < 4; ++ks) acc = MFMA16(*(const bf16x8*)(buf + ((rt * 4 + ks) * 64 + lane) * 16), Sb[ks], acc);
            vn[rt] = U[rt] - acc;
        }
        bf16x8 Vb[2];
        Vb[0] = pack8(vn[0], vn[1]); Vb[1] = pack8(vn[2], vn[3]);
#pragma unroll
        for (int rt = 0; rt < 4; ++rt) {
            f32x4 acc = (f32x4){0.f, 0.f, 0.f, 0.f};
#pragma unroll
            for (int ks = 0; ks < 4; ++ks) acc = MFMA16(*(const bf16x8*)(buf + 16384 + ((rt * 4 + ks) * 64 + lane) * 16), Sb[ks], acc);
#pragma unroll
            for (int ks2 = 0; ks2 < 2; ++ks2) acc = MFMA16(*(const bf16x8*)(buf + 49152 + ((rt * 2 + ks2) * 64 + lane) * 16), Vb[ks2], acc);
#pragma unroll
            for (int j = 0; j < 4; ++j) OBUF[(16 * rt + 4 * fq + j) * OST + 16 * w + fr] = acc[j];
        }
#pragma unroll
        for (int dt = 0; dt < 8; ++dt) {
            f32x4 acc = S[dt] * dl;
#pragma unroll
            for (int ks2 = 0; ks2 < 2; ++ks2) acc = MFMA16(*(const bf16x8*)(buf + 32768 + ((dt * 2 + ks2) * 64 + lane) * 16), Vb[ks2], acc);
            S[dt] = acc;
        }
        if (nxt) {
#pragma unroll
            for (int i = 0; i < 7; ++i) *(u32x4*)(dyn_smem + ((c + 1) & 1) * OPB_B + (tid + 512 * i) * 16) = pf[i];
        }
        __syncthreads();
        {
            float o[16]; float ss = 0.f;
#pragma unroll
            for (int e4 = 0; e4 < 4; ++e4) { const f32x4 a = *(const f32x4*)(OBUF + erow * OST + 16 * ept + 4 * e4);
#pragma unroll
                for (int e = 0; e < 4; ++e) { o[4 * e4 + e] = a[e]; ss += a[e] * a[e]; } }
#pragma unroll
            for (int of = 1; of < 8; of <<= 1) ss += __shfl_xor(ss, of);
            if (erow < valid) {
                const float r = rsqrtf(ss * (1.f / 128.f) + 1e-6f);
                const size_t grow = (samp ? (size_t)MP + b * TS : (size_t)b * TP + (size_t)c * 64) + erow;
                const unsigned gw[8] = {g0.x, g0.y, g0.z, g0.w, g1.x, g1.y, g1.z, g1.w};
                unsigned ow[8];
#pragma unroll
                for (int e = 0; e < 8; ++e) {
                    const float ga = bflo(gw[e]), gb = bfhi(gw[e]);
                    ow[e] = pk2(o[2 * e] * r * nw[2 * e] * silu(ga), o[2 * e + 1] * r * nw[2 * e + 1] * silu(gb));
                }
                *(u32x4*)(OMIX + grow * 1024 + h * 128 + 16 * ept) = (u32x4){ow[0], ow[1], ow[2], ow[3]};
                *(u32x4*)(OMIX + grow * 1024 + h * 128 + 16 * ept + 8) = (u32x4){ow[4], ow[5], ow[6], ow[7]};
            }
        }
        __syncthreads();
#pragma unroll
        for (int rt = 0; rt < 4; ++rt) U[rt] = Un[rt];
        dl = dln; g0 = gn0; g1 = gn1;
    }
    float* So = p.out + (samp ? O_GS : O_GP) + (size_t)(b * 4 + h) * 128 * 128;
#pragma unroll
    for (int dt = 0; dt < 8; ++dt)
#pragma unroll
        for (int j = 0; j < 4; ++j) So[(size_t)(16 * dt + 4 * fq + j) * 128 + 16 * w + fr] = S[dt][j];
}

constexpr int L_KT = 0, L_VT = 2 * 16384, L_ALX = L_VT + 2 * 16384, L_IDX = L_ALX + 8 * 2 * 32 * 4, L_QF = L_IDX + 256;
static_assert(L_QF + 8 * 8 * 1024 <= LDS_BYTES, "attn LDS");
DI int crow32(int i, int hh) { return (i & 3) + 8 * (i >> 2) + 4 * hh; }

DI void attn_item(const Params& p, const int idx, const float* lamp) {
    unsigned char* ws = p.ws;
    const int tid = opaque_tid(), lane = tid & 63, w = __builtin_amdgcn_readfirstlane(tid >> 6), r = lane & 31, hh = lane >> 5;
    bool samp; int b, h, qb = 0, ntiles, lastw; size_t qbase, kbase; const bf16_t* vtb; int vstride; bool active;
    if (idx < 32) { samp = true; b = idx >> 2; h = idx & 3; qbase = (size_t)MP + b * TS; kbase = (size_t)MP + (size_t)b * TKS; ntiles = 65; lastw = 64; active = w == 0;
                    vtb = (const bf16_t*)(ws + WS_R6) + VT_S_OFF + (size_t)((b * 4 + h) * 128) * TKS; vstride = TKS; }
    else { const int j = idx - 32; samp = false; qb = 31 - (j >> 4); b = (j & 15) >> 2; h = j & 3; qbase = (size_t)b * TP + qb * 256; kbase = (size_t)b * TP; ntiles = 4 * qb + 4; lastw = 4 * qb + (w >> 1); active = true;
           vtb = (const bf16_t*)(ws + WS_R6) + (size_t)((b * 4 + h) * 128) * TP; vstride = TP; }
    const bf16_t* KALL = (const bf16_t*)(ws + WS_R5) + kbase * 512 + h * 128;
    float* ALX = (float*)(dyn_smem + L_ALX) + w * 64;
    bf16_t* QF = (bf16_t*)(dyn_smem + L_QF) + w * 8 * 64 * 8;
    {
        const bf16_t* qp = (const bf16_t*)(ws + WS_R4) + (qbase + 32 * w + r) * 512 + h * 128 + 8 * hh;
        if (active) {
#pragma unroll
            for (int f = 0; f < 8; ++f) *(u32x4*)(QF + (f * 64 + lane) * 8) = *(const u32x4*)(qp + (f >> 2) * 64 + 16 * (f & 3));
        }
    }
    f32x16 O1[4], O2[4];
#pragma unroll
    for (int t = 0; t < 4; ++t)
#pragma unroll
        for (int i = 0; i < 16; ++i) { O1[t][i] = 0.f; O2[t][i] = 0.f; }
    float m1 = -1e30f, m2 = -1e30f, l1 = 0.f, l2 = 0.f;
    auto stage_tile = [&](int kt_, int buf_) {
        int ln = lane; asm volatile("" : "+v"(ln));
        const int krow_ = ln >> 4, vrow_ = ln >> 3;
        const unsigned kx = (ln & 15) ^ krow_, vx = (ln & 7) ^ (vrow_ >> 1);
        const unsigned klane = krow_ * 512, vlane = vrow_ * vstride;
#pragma unroll
        for (int j = 0; j < 2; ++j) {
            const int i = 2 * w + j;
            const bf16_t* kbase = KALL + ((size_t)kt_ * 64 + (((4 * i) & ~12) | (((4 * i) & 4) << 1) | (((4 * i) & 8) >> 1))) * 512;
            const bf16_t* vbase = vtb + (size_t)(8 * i) * vstride + (size_t)kt_ * 64;
            const unsigned ko = klane + ((kx ^ ((4 * i) & 15)) * 8), vo = vlane + ((vx ^ ((4 * i) & 7)) * 8);
            __builtin_amdgcn_global_load_lds((const unsigned*)(kbase + ko), (unsigned*)(dyn_smem + L_KT + buf_ * 16384 + i * 1024 + ln * 16), 16, 0, 0);
            __builtin_amdgcn_global_load_lds((const unsigned*)(vbase + vo), (unsigned*)(dyn_smem + L_VT + buf_ * 16384 + i * 1024 + ln * 16), 16, 0, 0);
        }
    };
    const int ky = hh ^ (r & 15), vzh = ((r >> 1) & 7) ^ hh;
    __syncthreads();
    stage_tile(0, 0);
    asm volatile("s_waitcnt vmcnt(0)" ::: "memory");
    __syncthreads();
    if (active) {
#pragma unroll
        for (int mp = 0; mp < 2; ++mp) {
            float mx = -1e30f;
#pragma unroll
            for (int sub = 0; sub < 2; ++sub) {
                f32x16 sc;
#pragma unroll
                for (int i = 0; i < 16; ++i) sc[i] = 0.f;
#pragma unroll
                for (int s = 0; s < 4; ++s) {
                    const bf16x8 ka = *(const bf16x8*)(dyn_smem + L_KT + (sub * 32 + r) * 256 + (((mp * 8 + 2 * s) ^ ky) * 16));
                    const bf16x8 qf = *(const bf16x8*)(QF + ((mp * 4 + s) * 64 + lane) * 8);
                    sc = MFMA32(ka, qf, sc);
                }
#pragma unroll
                for (int i = 0; i < 16; ++i) mx = fmaxf(mx, sc[i]);
            }
            const auto sw = __builtin_amdgcn_permlane32_swap(__float_as_uint(mx), __float_as_uint(mx), false, false);
            mx = fmaxf(__uint_as_float(sw[0]), __uint_as_float(sw[1]));
            if (mp == 0) m1 = mx; else m2 = mx;
        }
    }
#pragma unroll 1
    for (int kt = 0; kt < ntiles; ++kt) {
        const bool nxt = kt + 1 < ntiles;
        if (nxt) stage_tile(kt + 1, (kt + 1) & 1);
        if (active && kt <= lastw) {
            const unsigned char* Kb = dyn_smem + L_KT + (kt & 1) * 16384 + r * 256; const unsigned char* Vb = dyn_smem + L_VT + (kt & 1) * 16384 + r * 128;
            const float msk1 = (samp && kt == 64) ? 1e30f : 0.f;
            f32x16 scA, scB; bf16x8 PA[2], PB[2];
            float tm1 = -1e30f, tm2 = -1e30f;
#define ATT_QK(SUB, MP, SC) do { \
                _Pragma("unroll") for (int s_ = 0; s_ < 4; ++s_) { \
                    const bf16x8 ka_ = *(const bf16x8*)(Kb + (SUB) * 32 * 256 + ((((MP) * 8 + 2 * s_) ^ ky) * 16)); \
                    const bf16x8 qf_ = *(const bf16x8*)(QF + (((MP) * 4 + s_) * 64 + lane) * 8); \
                    SC = MFMA32(ka_, qf_, s_ == 0 ? zero16 : SC); } } while (0)
#define ATT_SM(SC, P, MM, LL, TM, MSK) do { \
                float ps_ = 0.f, tq_ = TM; const float mr_ = MM + MSK; \
                _Pragma("unroll") for (int i_ = 0; i_ < 16; ++i_) { tq_ = fmaxf(tq_, SC[i_]); SC[i_] = __builtin_amdgcn_exp2f(SC[i_] - mr_); ps_ += SC[i_]; } \
                TM = MSK != 0.f ? TM : tq_; \
                LL += ps_; \
                _Pragma("unroll") for (int sp_ = 0; sp_ < 2; ++sp_) { \
                    u32x4 a_; a_.x = pk2(SC[8 * sp_], SC[8 * sp_ + 1]); a_.y = pk2(SC[8 * sp_ + 2], SC[8 * sp_ + 3]); a_.z = pk2(SC[8 * sp_ + 4], SC[8 * sp_ + 5]); a_.w = pk2(SC[8 * sp_ + 6], SC[8 * sp_ + 7]); \
                    P[sp_] = __builtin_bit_cast(bf16x8, a_); } } while (0)
#define ATT_PV2(SUB, P1, P2) do { \
                _Pragma("unroll") for (int sp_ = 0; sp_ < 2; ++sp_) \
                    _Pragma("unroll") for (int t_ = 0; t_ < 4; ++t_) { \
                        const bf16x8 vb_ = *(const bf16x8*)(Vb + t_ * 32 * 128 + (((4 * (SUB) + 2 * sp_) ^ vzh) * 16)); \
                        O1[t_] = MFMA32(P1[sp_], vb_, O1[t_]); O2[t_] = MFMA32(P2[sp_], vb_, O2[t_]); } } while (0)
            f32x16 zero16;
#pragma unroll
            for (int i = 0; i < 16; ++i) zero16[i] = 0.f;
#pragma unroll 1
            for (int sub = 0; sub < 2; ++sub) {
                const float msk = sub ? msk1 : 0.f;
                ATT_QK(sub, 0, scA);
                __builtin_amdgcn_sched_barrier(0);
                ATT_QK(sub, 1, scB);
                ATT_SM(scA, PA, m1, l1, tm1, msk);
                __builtin_amdgcn_sched_barrier(0);
                ATT_SM(scB, PB, m2, l2, tm2, msk);
                __builtin_amdgcn_sched_barrier(0);
                ATT_PV2(sub, PA, PB);
                __builtin_amdgcn_sched_barrier(0);
            }
            {
                const auto s1_ = __builtin_amdgcn_permlane32_swap(__float_as_uint(tm1), __float_as_uint(tm1), false, false); tm1 = fmaxf(__uint_as_float(s1_[0]), __uint_as_float(s1_[1]));
                const auto s2_ = __builtin_amdgcn_permlane32_swap(__float_as_uint(tm2), __float_as_uint(tm2), false, false); tm2 = fmaxf(__uint_as_float(s2_[0]), __uint_as_float(s2_[1]));
                const float n1 = tm1 > m1 + 8.f ? tm1 : m1, n2 = tm2 > m2 + 8.f ? tm2 : m2;
                if (__any((n1 != m1) || (n2 != m2))) {
                    const float al1 = __builtin_amdgcn_exp2f(m1 - n1), al2 = __builtin_amdgcn_exp2f(m2 - n2);
                    l1 *= al1; l2 *= al2; m1 = n1; m2 = n2;
                    if (hh == 0) { ALX[r] = al1; ALX[32 + r] = al2; }
                    asm volatile("s_waitcnt lgkmcnt(0)" ::: "memory");
#pragma unroll
                    for (int g = 0; g < 4; ++g) {
                        const f32x4 a1 = *(const f32x4*)(ALX + 8 * g + 4 * hh), a2 = *(const f32x4*)(ALX + 32 + 8 * g + 4 * hh);
#pragma unroll
                        for (int t = 0; t < 4; ++t)
#pragma unroll
                            for (int j = 0; j < 4; ++j) { O1[t][4 * g + j] *= a1[j]; O2[t][4 * g + j] *= a2[j]; }
                    }
                    asm volatile("s_waitcnt lgkmcnt(0)" ::: "memory");
                }
            }
        }
        asm volatile("s_waitcnt vmcnt(0)" ::: "memory");
        __syncthreads();
    }
    if (active) {
        { const auto s1_ = __builtin_amdgcn_permlane32_swap(__float_as_uint(l1), __float_as_uint(l1), false, false); l1 = __uint_as_float(s1_[0]) + __uint_as_float(s1_[1]);
          const auto s2_ = __builtin_amdgcn_permlane32_swap(__float_as_uint(l2), __float_as_uint(l2), false, false); l2 = __uint_as_float(s2_[0]) + __uint_as_float(s2_[1]); }
        if (hh == 0) { ALX[r] = __builtin_amdgcn_rcpf(l1); ALX[32 + r] = *lamp * __builtin_amdgcn_rcpf(l2); }
        asm volatile("s_waitcnt lgkmcnt(0)" ::: "memory");
        float ss[16], a1[16], a2[16];
#pragma unroll
        for (int g = 0; g < 4; ++g) {
            const f32x4 x1 = *(const f32x4*)(ALX + 8 * g + 4 * hh), x2 = *(const f32x4*)(ALX + 32 + 8 * g + 4 * hh);
#pragma unroll
            for (int j = 0; j < 4; ++j) { a1[4 * g + j] = x1[j]; a2[4 * g + j] = x2[j]; ss[4 * g + j] = 0.f; }
        }
#pragma unroll
        for (int t = 0; t < 4; ++t) {
            __builtin_amdgcn_sched_barrier(0);
#pragma unroll
            for (int i = 0; i < 16; ++i) { const float o = O1[t][i] * a1[i] - O2[t][i] * a2[i]; O1[t][i] = o; ss[i] += o * o; }
        }
        __builtin_amdgcn_sched_barrier(0);
#pragma unroll
        for (int i = 0; i < 16; ++i) {
#pragma unroll
            for (int of = 1; of < 32; of <<= 1) ss[i] += __shfl_xor(ss[i], of);
            ss[i] = __builtin_amdgcn_rsqf(ss[i] * (1.f / 128.f) + 1e-6f) * (1.f - LAM_INIT);
        }
        int zo = 0; asm volatile("" : "+v"(zo));
        bf16_t* obase = (bf16_t*)(ws + WS_R2) + (qbase + 32 * w) * 1024 + 512 + h * 128;
        const unsigned ooff = (unsigned)((4 * hh + zo) * 1024 + r);
        const float* sw = p.subln_w + r + zo;
#pragma unroll
        for (int t = 0; t < 4; ++t) {
            const float wv = sw[32 * t];
#pragma unroll
            for (int i = 0; i < 16; ++i) obase[ooff + ((i & 3) + 8 * (i >> 2)) * 1024 + 32 * t] = f2bf(O1[t][i] * ss[i] * wv);
        }
    }
}

DI void mixer_phase(const Params& p) {
    const int bid = blockIdx.x;
#ifndef NO_SCAN
    if (bid < 48) { const bool sm = bid >= 16; const int j = sm ? bid - 16 : bid;
#pragma unroll 1
        for (int rep = 0; rep < SREP; ++rep) gdn_scan(p, sm, j >> 2, j & 3); }
#endif
    unsigned* ctl = (unsigned*)(p.ws + WS_CTL);
    int* sidx = (int*)(dyn_smem + L_IDX);
    for (;;) {
        __syncthreads();
        if (threadIdx.x == 0) *sidx = (int)atomicAdd(ctl, 1u);
        __syncthreads();
        const int idx0 = __builtin_amdgcn_readfirstlane(*sidx);
        if (idx0 >= (32 + 512) * AREP) break;
        const int idx = idx0 % (32 + 512);
#ifndef NO_ATTN
        attn_item(p, idx, (const float*)ctl + 1);
#endif
    }
}


#define XB_TMO      128
#define XB_XCNT(j)  (256  + 64 * (j))
#define XB_XSUB(j)  (1280 + 64 * (j))
#define XB_XGEN(j)  (2304 + 64 * (j))
#define XB_TOP      3328
#define XB_TOPGEN   3392
#define XCD_BAR_WORDS 3456
#define XB_SPIN_CAP (1u << 20)
#define LAS __attribute__((address_space(3)))
DI unsigned xb_ld(unsigned* p) { return __hip_atomic_load(p, __ATOMIC_RELAXED, __HIP_MEMORY_SCOPE_AGENT); }
DI unsigned xb_add(unsigned* p, unsigned v) { return __hip_atomic_fetch_add(p, v, __ATOMIC_RELAXED, __HIP_MEMORY_SCOPE_AGENT); }
DI unsigned xb_xcc_id() { return (unsigned)__builtin_amdgcn_s_getreg((3 << 11) | 20) & 0xFu; }
#define XB_SPIN(cond, bar) do { unsigned _sp = 0; while (cond) { __builtin_amdgcn_s_sleep(1); \
    if ((++_sp & 255u) == 0u) { if (xb_ld(&(bar)[XB_TMO])) break; if (_sp > XB_SPIN_CAP) { atomicAdd(&(bar)[XB_TMO], 1u); break; } } } } while (0)
struct XcdBarrier { unsigned* bar; unsigned x; volatile LAS unsigned* st; };
DI XcdBarrier xcd_barrier_post(unsigned* bar, volatile LAS unsigned* st) {
    XcdBarrier b; b.bar = bar; b.x = xb_xcc_id(); b.st = st;
    if (threadIdx.x == 0) (void)xb_add(&bar[XB_XCNT(b.x)], 1u);
    return b;
}
DI void xcd_barrier_complete(unsigned* bar, unsigned x, unsigned& nloc, unsigned& nx) {
    const unsigned G = gridDim.x * gridDim.y * gridDim.z;
    unsigned sum, cnt, mine, sp = 0u;
    for (;;) {
        sum = 0u; cnt = 0u; mine = 0u;
#pragma unroll
        for (unsigned j = 0; j < 16; ++j) { const unsigned c = xb_ld(&bar[XB_XCNT(j)]); sum += c; cnt += (c > 0u) ? 1u : 0u; mine = (j == x) ? c : mine; }
        if (sum == G) break;
        __builtin_amdgcn_s_sleep(1);
        if ((++sp & 255u) == 0u) { if (xb_ld(&bar[XB_TMO])) break; if (sp > XB_SPIN_CAP) { atomicAdd(&bar[XB_TMO], 1u); break; } }
    }
    nloc = mine > 0u ? mine : 1u; nx = cnt > 0u ? cnt : 1u;
}
DI void xcd_barrier(const XcdBarrier& b) {
    asm volatile("s_waitcnt vmcnt(0)" ::: "memory");
    __syncthreads();
    if (threadIdx.x == 0) {
        unsigned* bar = b.bar;
        __builtin_amdgcn_s_waitcnt(0);
        unsigned nloc = b.st[0], nx = b.st[1];
        if (nloc == 0u) { xcd_barrier_complete(bar, b.x, nloc, nx); b.st[0] = nloc; b.st[1] = nx; }
        const unsigned old = xb_add(&bar[XB_XSUB(b.x)], 1u);
        const unsigned gen = old / nloc;
        if (old + 1u == (gen + 1u) * nloc) {
            __builtin_amdgcn_fence(__ATOMIC_RELEASE, "agent");
            asm volatile("s_waitcnt vmcnt(0)" ::: "memory");
            const unsigned og = xb_add(&bar[XB_TOP], 1u);
            const unsigned tg = og / nx;
            if (og + 1u == (tg + 1u) * nx) xb_add(&bar[XB_TOPGEN], 1u);
            else XB_SPIN(xb_ld(&bar[XB_TOPGEN]) == tg, bar);
            __builtin_amdgcn_fence(__ATOMIC_ACQUIRE, "agent");
            xb_add(&bar[XB_XGEN(b.x)], 1u);
            asm volatile("s_waitcnt vmcnt(0)" ::: "memory");
        } else {
            XB_SPIN(xb_ld(&bar[XB_XGEN(b.x)]) == gen, bar);
            __builtin_amdgcn_fence(__ATOMIC_ACQUIRE, "agent");
            asm volatile("s_waitcnt vmcnt(0)" ::: "memory");
        }
    }
    __syncthreads();
}

__global__ void __launch_bounds__(512, 2) fwd_kernel(Params p) {
    cg::grid_group grid = cg::this_grid();
    volatile LAS unsigned* xst = (volatile LAS unsigned*)(dyn_smem + LDS_BYTES - 16);
    if (threadIdx.x == 0) { xst[0] = 0u; xst[1] = 0u; }
    __syncthreads();
    const XcdBarrier xb = xcd_barrier_post((unsigned*)(p.ws + WS_BAR), xst);
    if (p.phase_lo > 1000) grid.sync();
    const bool all = p.phase_hi - p.phase_lo > 1;
#define PHASE(i, body) if (p.phase_lo <= (i) && (i) < p.phase_hi) { body; if (all && (i) + 1 < p.phase_hi) xcd_barrier(xb); }
    PHASE(0, phase_prep(p))
    PHASE(1, gemm_phase<1>(p))
    PHASE(2, gdn_prep_phase(p))
    PHASE(3, mixer_phase(p))
    PHASE(4, gemm_phase<2>(p))
    PHASE(5, ln_phase<0>(p))
    PHASE(6, gemm_phase<3>(p))
    PHASE(7, fixup_phase(p))
    PHASE(8, gemm_phase<4>(p))
    PHASE(9, ln_phase<1>(p))
}

extern "C" void kernel_launch(void* const* d_in, const int* in_sizes, int n_in, void* d_out, int out_size, void* d_ws, size_t ws_size, hipStream_t stream) {
    static int grid = 0;
    if (grid == 0) {
        if (n_in != 23 || (size_t)out_size != O_END || ws_size < WS_END2) { fprintf(stderr, "kernel_launch: unexpected sizes n_in %d out %d ws %zu (need %zu)\n", n_in, out_size, ws_size, (size_t)WS_END2); grid = -1; return; }
        int dev = 0, cus = 0, per_cu = 0;
        hipGetDevice(&dev);
        hipDeviceGetAttribute(&cus, hipDeviceAttributeMultiprocessorCount, dev);
        if (hipFuncSetAttribute((const void*)fwd_kernel, hipFuncAttributeMaxDynamicSharedMemorySize, LDS_BYTES) != hipSuccess) { fprintf(stderr, "kernel_launch: hipFuncSetAttribute failed\n"); grid = -1; return; }
        hipOccupancyMaxActiveBlocksPerMultiprocessor(&per_cu, (const void*)fwd_kernel, 512, LDS_BYTES);
        if (per_cu < 1) { fprintf(stderr, "kernel_launch: occupancy query says %d\n", per_cu); per_cu = 1; }
        (void)hipGetLastError();
        grid = cus * 1;
    }
    if (grid < 0) return;
    Params p{};
    const float** f = (const float**)&p;
    for (int i = 0; i < 23; ++i) f[i] = (const float*)d_in[i];
    p.out = (float*)d_out; p.ws = (unsigned char*)d_ws; p.phase_lo = 0; p.phase_hi = 10;
    if (hipMemsetAsync((unsigned char*)d_ws + WS_BAR, 0, 16384, stream) != hipSuccess) { fprintf(stderr, "kernel_launch: memset failed\n"); return; }
    void* args[] = {&p};
    hipError_t e = hipLaunchCooperativeKernel((const void*)fwd_kernel, dim3(grid), dim3(512), args, LDS_BYTES, stream);
    if (e != hipSuccess) fprintf(stderr, "cooperative launch failed: %s (grid %d)\n", hipGetErrorString(e), grid);
}
```

```cpp
#include <hip/hip_runtime.h>
#include <hip/hip_cooperative_groups.h>
#include <cstdio>
namespace cg = cooperative_groups;
#ifndef GREP_WHICH
#define GREP_WHICH 0
#endif
#ifndef AREP
#define AREP 1
#endif
#ifndef SREP
#define SREP 1
#endif

typedef unsigned short bf16_t;
typedef short bf16x8 __attribute__((ext_vector_type(8)));
typedef short s16x4 __attribute__((ext_vector_type(4)));
typedef float f32x4 __attribute__((ext_vector_type(4)));
typedef float f32x16 __attribute__((ext_vector_type(16)));
typedef unsigned u32x4 __attribute__((ext_vector_type(4)));
typedef unsigned u32x2 __attribute__((ext_vector_type(2)));
#define DI __device__ __forceinline__

constexpr int D = 1024, TP = 8192, BP = 4, MP = BP * TP, BS = 8, TS = 32, MS = BS * TS, M = MP + MS, PAST = 4096;
constexpr int DIN = 3592, NH1 = 3584, DFF = 2816, NUP = 2 * DFF;
constexpr int TKS = 4160;
constexpr int NITEM = BP * 128 * 4 + BS * 4;
constexpr int ITEM_B = 90112;
constexpr int LDS_BYTES = 160 * 1024;
constexpr float ALPHA = 1.189207115002721f;
constexpr float LAM_INIT = 0.2f;

constexpr size_t O_Y = 0, O_KP = 33816576, O_VP = 50593792, O_GP = 67371008, O_CQP = 67633152, O_CFP = 67651584,
                 O_KS = 67696640, O_VS = 67827712, O_GS = 67958784, O_CQS = 68483072, O_CFS = 68519936, O_END = 68610048;

constexpr size_t al256(size_t x) { return (x + 255) & ~(size_t)255; }
constexpr size_t WS_CTL = 0;
constexpr size_t WS_ROPE = 4096;
constexpr size_t WS_AB = WS_ROPE + (size_t)8192 * 32 * 8;
constexpr size_t WS_DL = WS_AB + (size_t)M * 8 * 4;
constexpr size_t WS_WIN = al256(WS_DL + NITEM * 4);
constexpr size_t WS_WO = WS_WIN + (size_t)NH1 * D * 2;
constexpr size_t WS_WUP = WS_WO + (size_t)D * D * 2;
constexpr size_t WS_WDN = WS_WUP + (size_t)NUP * D * 2;
constexpr size_t WS_R1 = al256(WS_WDN + (size_t)D * DFF * 2);
constexpr size_t R1_SIZE = (size_t)NITEM * ITEM_B;
constexpr size_t WS_R2 = al256(WS_R1 + R1_SIZE);
constexpr size_t WS_R3 = al256(WS_R2 + (size_t)M * 1536 * 2);
constexpr size_t WS_R4 = WS_R3 + (size_t)M * 512 * 2;
constexpr size_t WS_R5 = al256(WS_R4 + (size_t)M * 512 * 2);
constexpr size_t KROWS = (size_t)MP + (size_t)BS * TKS;
constexpr size_t WS_R6 = al256(WS_R5 + KROWS * 512 * 2);
constexpr size_t VT_S_OFF = (size_t)BP * 4 * 128 * TP;
constexpr size_t WS_END = al256(WS_R6 + (VT_S_OFF + (size_t)BS * 4 * 128 * TKS) * 2);
constexpr size_t WS_CS1 = WS_END;
constexpr size_t WS_CS2 = WS_CS1 + (size_t)MS * NH1 * 4;
constexpr size_t WS_CS3 = WS_CS2 + (size_t)MS * D * 4;
constexpr size_t WS_CS4 = WS_CS3 + (size_t)MS * NUP * 4;
constexpr size_t WS_BAR = WS_CS4 + (size_t)MS * D * 4;
constexpr size_t WS_END2 = WS_BAR + 16384;
static_assert((size_t)M * DFF * 2 <= R1_SIZE, "GT must fit R1");
static_assert(WS_END2 <= (size_t)536870912, "workspace too large");

struct Params {
    const float *x_p, *x_s, *cache_k, *cache_v, *state_gdn, *state_cq, *state_cf;
    const float *w_in, *gdn_conv_w, *a_log, *dt_bias, *gdn_norm_w, *diff_lambda, *subln_w, *w_o, *ln1_g, *ln1_b, *w_up,
        *ffn_conv_w, *ffn_conv_b, *w_down, *ln2_g, *ln2_b;
    float* out; unsigned char* ws;
    int phase_lo, phase_hi;
};

extern __shared__ __attribute__((aligned(16))) unsigned char dyn_smem[];

typedef __bf16 bf16x2_t __attribute__((ext_vector_type(2)));
typedef float f32x2 __attribute__((ext_vector_type(2)));
DI unsigned pk2(float lo, float hi) { f32x2 v = {lo, hi}; bf16x2_t b = __builtin_convertvector(v, bf16x2_t); return __builtin_bit_cast(unsigned, b); }
DI bf16_t f2bf(float x) { return (bf16_t)(pk2(x, 0.f) & 0xffffu); }
DI float bf2f(bf16_t b) { return __uint_as_float(((unsigned)b) << 16); }
DI float bflo(unsigned u) { return __uint_as_float(u << 16); }
DI float bfhi(unsigned u) { return __uint_as_float(u & 0xffff0000u); }
DI float silu(float x) { return x / (1.f + __expf(-x)); }
DI int opaque_tid() { int t = threadIdx.x; asm volatile("" : "+v"(t)); return t; }
DI float wave_sum(float v) {
#pragma unroll
    for (int o = 1; o < 64; o <<= 1) v += __shfl_xor(v, o);
    return v;
}
DI const float* xrow_ptr(const Params& p, int row) { return row < MP ? p.x_p + (size_t)row * D : p.x_s + (size_t)(row - MP) * D; }

template <int MODE> DI int srccol(int n) {
    if (MODE == 1) {
        if (n < 2048) return n;
        return n + 8;
    }
    if (MODE == 2) { const int pn = n >> 8, j = n & 255; return j < 128 ? 128 * pn + j : DFF + 128 * pn + (j - 128); }
    return n;
}
struct TrItem { const float* W; bf16_t* WT; int K, N, k0, n0, mode; };
DI TrItem tr_decode(const Params& p, int it) {
    constexpr int I_IN = 16 * 56, I_O = 16 * 16, I_UP = 16 * 88;
    unsigned char* ws = p.ws; TrItem t; int r = it;
    if (r < I_IN) { t.W = p.w_in; t.WT = (bf16_t*)(ws + WS_WIN); t.K = D; t.N = DIN; t.k0 = (r / 56) * 64; t.n0 = (r % 56) * 64; t.mode = 1; return t; } r -= I_IN;
    if (r < I_O) { t.W = p.w_o; t.WT = (bf16_t*)(ws + WS_WO); t.K = D; t.N = D; t.k0 = (r / 16) * 64; t.n0 = (r % 16) * 64; t.mode = 0; return t; } r -= I_O;
    if (r < I_UP) { t.W = p.w_up; t.WT = (bf16_t*)(ws + WS_WUP); t.K = D; t.N = NUP; t.k0 = (r / 88) * 64; t.n0 = (r % 88) * 64; t.mode = 2; return t; } r -= I_UP;
    t.W = p.w_down; t.WT = (bf16_t*)(ws + WS_WDN); t.K = DFF; t.N = D; t.k0 = (r / 16) * 64; t.n0 = (r % 16) * 64; t.mode = 0; return t;
}
DI void tr_load(const TrItem& t, float (&v)[8]) {
    const int tid = threadIdx.x, n = t.n0 + (tid & 63);
    const int sc = t.mode == 1 ? (n < 2048 ? n : n + 8) : (t.mode == 2 ? srccol<2>(n) : n);
#pragma unroll
    for (int i = 0; i < 8; ++i) v[i] = t.W[(size_t)(t.k0 + (tid >> 6) + 8 * i) * t.N + sc];
}
DI void phase_prep(const Params& p) {
    const int tid = threadIdx.x, lane = tid & 63, wave = tid >> 6, nb = gridDim.x, bid = blockIdx.x;
    unsigned char* ws = p.ws;
    if (bid == 0 && tid < 64) {
        unsigned* ctl = (unsigned*)(ws + WS_CTL);
        float a = p.diff_lambda[lane] * p.diff_lambda[64 + lane], b = p.diff_lambda[128 + lane] * p.diff_lambda[192 + lane];
        a = wave_sum(a); b = wave_sum(b);
        if (lane == 0) { ctl[0] = 0u; ((float*)ctl)[1] = expf(a) - expf(b) + LAM_INIT; }
    }
    {
        constexpr int NT = 16 * 56 + 16 * 16 + 16 * 88 + 44 * 16;
        float* lds = (float*)dyn_smem;
        float v[8];
        TrItem cur = tr_decode(p, bid < NT ? bid : 0);
        if (bid < NT) tr_load(cur, v);
        for (int it = bid; it < NT; it += nb) {
            float nv[8]; TrItem nx = cur;
            if (it + nb < NT) { nx = tr_decode(p, it + nb); tr_load(nx, nv); }
#pragma unroll
            for (int i = 0; i < 8; ++i) lds[((tid >> 6) + 8 * i) * 65 + (tid & 63)] = v[i];
            __syncthreads();
#pragma unroll
            for (int i = 0; i < 8; ++i) { const int nn = (tid >> 6) + 8 * i, kk = tid & 63; cur.WT[(size_t)(cur.n0 + nn) * cur.K + cur.k0 + kk] = f2bf(lds[kk * 65 + nn]); }
            __syncthreads();
#pragma unroll
            for (int i = 0; i < 8; ++i) v[i] = nv[i];
            cur = nx;
        }
    }
    {
        float2* rope = (float2*)(ws + WS_ROPE);
        for (int idx = bid * 512 + tid; idx < 8192 * 32; idx += nb * 512) {
            const int pos = idx >> 5, d = idx & 31;
            const double inv = exp(-(double)d * (9.210340371976184 / 32.0));
            double a = (double)pos * inv;
            a -= 6.283185307179586 * rint(a * 0.15915494309189535);
            const float af = (float)a;
            rope[idx] = make_float2(__cosf(af), __sinf(af));
        }
    }
    {
        float* w8 = (float*)dyn_smem;
        __syncthreads();
        for (int i = tid; i < 1024 * 8; i += 512) w8[i] = p.w_in[(size_t)(i >> 3) * DIN + 2048 + (i & 7)];
        __syncthreads();
        bf16_t* XB = (bf16_t*)(ws + WS_R1);
        float* AB = (float*)(ws + WS_AB);
        f32x4 cv[4];
        {
            const int row = bid * 8 + wave;
            if (row < M) { const float* xr = xrow_ptr(p, row);
#pragma unroll
                for (int j = 0; j < 4; ++j) cv[j] = *(const f32x4*)(xr + lane * 4 + 256 * j); }
        }
        for (int row = bid * 8 + wave; row < M; row += nb * 8) {
            f32x4 nvx[4];
            if (row + nb * 8 < M) { const float* xn = xrow_ptr(p, row + nb * 8);
#pragma unroll
                for (int j = 0; j < 4; ++j) nvx[j] = *(const f32x4*)(xn + lane * 4 + 256 * j); }
            float acc[8];
#pragma unroll
            for (int c = 0; c < 8; ++c) acc[c] = 0.f;
#pragma unroll
            for (int j = 0; j < 4; ++j) {
                const int k0 = lane * 4 + 256 * j;
                const f32x4 v = cv[j];
                u32x2 o; o.x = pk2(v.x, v.y); o.y = pk2(v.z, v.w);
                *(u32x2*)(XB + (size_t)row * D + k0) = o;
#pragma unroll
                for (int e = 0; e < 4; ++e) {
                    const f32x4 wa = *(const f32x4*)(w8 + (k0 + e) * 8), wb = *(const f32x4*)(w8 + (k0 + e) * 8 + 4);
                    const float xv = v[e];
                    acc[0] += xv * wa.x; acc[1] += xv * wa.y; acc[2] += xv * wa.z; acc[3] += xv * wa.w;
                    acc[4] += xv * wb.x; acc[5] += xv * wb.y; acc[6] += xv * wb.z; acc[7] += xv * wb.w;
                }
            }
#pragma unroll
            for (int c = 0; c < 8; ++c) acc[c] = wave_sum(acc[c]);
            if (lane == 0) { *(f32x4*)(AB + (size_t)row * 8) = (f32x4){acc[0], acc[1], acc[2], acc[3]}; *(f32x4*)(AB + (size_t)row * 8 + 4) = (f32x4){acc[4], acc[5], acc[6], acc[7]}; }
#pragma unroll
            for (int j = 0; j < 4; ++j) cv[j] = nvx[j];
        }
        __syncthreads();
    }
    {
        bf16_t* KALL = (bf16_t*)(ws + WS_R5);
        const int nchunk = BS * TKS * 64;
        for (int c0 = bid * 512 + tid; c0 < nchunk; c0 += nb * 512 * 4) {
            f32x4 v0[4], v1[4]; int st[4]; size_t dsto[4];
#pragma unroll
            for (int u = 0; u < 4; ++u) {
                const int c = c0 + u * nb * 512;
                st[u] = 0;
                if (c < nchunk) {
                    const int col8 = c & 63, r = c >> 6, b = r / TKS, pp = r % TKS;
                    dsto[u] = ((size_t)MP + (size_t)b * TKS + pp) * 512 + col8 * 8;
                    if (pp < PAST) { const float* sp = p.cache_k + ((size_t)(b * PAST + pp) * 512 + col8 * 8); v0[u] = *(const f32x4*)sp; v1[u] = *(const f32x4*)(sp + 4); st[u] = 1; }
                    else if (pp >= PAST + TS) st[u] = 2;
                }
            }
#pragma unroll
            for (int u = 0; u < 4; ++u) {
                if (st[u] == 1) { u32x4 o; o.x = pk2(v0[u].x, v0[u].y); o.y = pk2(v0[u].z, v0[u].w); o.z = pk2(v1[u].x, v1[u].y); o.w = pk2(v1[u].z, v1[u].w); *(u32x4*)(KALL + dsto[u]) = o; }
                else if (st[u] == 2) *(u32x4*)(KALL + dsto[u]) = (u32x4){0u, 0u, 0u, 0u};
            }
        }
    }
    {
        bf16_t* VTS = (bf16_t*)(ws + WS_R6) + VT_S_OFF;
        bf16_t* t = (bf16_t*)dyn_smem;
        f32x4 cvv[4];
        auto ldv = [&](int it, f32x4 (&v)[4]) {
            const int blk = it % 65, bh = it / 65, b = bh >> 2, h = bh & 3;
            if (blk < 64) {
#pragma unroll
                for (int i = 0; i < 4; ++i) { const int id = tid + 512 * i, key = id >> 5, c4 = id & 31;
                    v[i] = *(const f32x4*)(p.cache_v + ((size_t)(b * PAST + blk * 64 + key) * 512 + h * 128 + c4 * 4)); }
            }
        };
        if (bid < BS * 4 * 65) ldv(bid, cvv);
        for (int it = bid; it < BS * 4 * 65; it += nb) {
            const int blk = it % 65, bh = it / 65;
            f32x4 nvv[4];
            if (it + nb < BS * 4 * 65) ldv(it + nb, nvv);
            if (blk < 64) {
                __syncthreads();
#pragma unroll
                for (int i = 0; i < 4; ++i) {
                    const int id = tid + 512 * i, key = id >> 5, c4 = id & 31;
                    const f32x4 v = cvv[i];
                    bf16_t* d = t + key * 130 + c4 * 4;
                    *(unsigned*)d = pk2(v.x, v.y); *(unsigned*)(d + 2) = pk2(v.z, v.w);
                }
                __syncthreads();
                const int dv = tid >> 2, part = tid & 3;
                unsigned o[8];
#pragma unroll
                for (int i = 0; i < 8; ++i) { const int k0 = part * 16 + 2 * i; o[i] = (unsigned)t[k0 * 130 + dv] | ((unsigned)t[(k0 + 1) * 130 + dv] << 16); }
                bf16_t* dst = VTS + ((size_t)(bh * 128 + dv) * TKS + blk * 64 + part * 16);
                *(u32x4*)dst = (u32x4){o[0], o[1], o[2], o[3]}; *(u32x4*)(dst + 8) = (u32x4){o[4], o[5], o[6], o[7]};
            } else {
                if (tid < 128) { bf16_t* dst = VTS + ((size_t)(bh * 128 + tid) * TKS + PAST + TS);
#pragma unroll
                    for (int i = 0; i < 4; ++i) *(u32x4*)(dst + 8 * i) = (u32x4){0u, 0u, 0u, 0u}; }
            }
#pragma unroll
            for (int i = 0; i < 4; ++i) cvv[i] = nvv[i];
        }
        __syncthreads();
    }
}

constexpr int BM = 256, BK = 64, HALF = 128, NXCD = 8, WGM = 8, HT = HALF * BK;
DI void stage_rc(int b, int& R, int& C) {
    const int st = b / 1024, sb = b % 1024, swz = sb ^ (((sb >> 9) & 1) << 5);
    R = (st >> 1) * 16 + swz / 64; C = (st & 1) * 32 + (swz % 64) / 2;
}
DI int lds_byte(int r, int c) {
    const int st = (r >> 4) * 2 + (c >> 5), rr = r & 15, cc = c & 31, ob = rr * 64 + cc * 2;
    return st * 1024 + (ob ^ (((ob >> 9) & 1) << 5));
}

#define SHM ((bf16_t*)dyn_smem)
#define SA(b, h) (SHM + ((b) * 2 + (h)) * HT)
#define SB(b, h) (SHM + (4 + (b) * 2 + (h)) * HT)
#define STAGE(P, BASE, br, kt) do { const bf16_t* _gb = (BASE) + ((long)(br) * K + (long)(kt) * BK); \
      __builtin_amdgcn_global_load_lds((const unsigned*)(_gb + so0), (unsigned*)((char*)(P) + wlds), 16, 0, 0); \
      __builtin_amdgcn_global_load_lds((const unsigned*)(_gb + 64 * K + so0), (unsigned*)((char*)(P) + wlds + 8192), 16, 0, 0); } while (0)
#define LDA(dst, b, h) for (int m = 0; m < 4; ++m) for (int k = 0; k < 2; ++k) \
    dst[m][k] = *reinterpret_cast<const bf16x8*>((char*)SA(b, h) + lds_byte(wr * 64 + m * 16 + fr, k * 32 + fq * 8))
#define LDB(dst, b, h) for (int n = 0; n < 2; ++n) for (int k = 0; k < 2; ++k) \
    dst[n][k] = *reinterpret_cast<const bf16x8*>((char*)SB(b, h) + lds_byte(wc * 32 + n * 16 + fr, k * 32 + fq * 8))
#define MMA(ai, bj, At, Bt_) do { __builtin_amdgcn_s_setprio(1); \
    for (int m = 0; m < 4; ++m) for (int n = 0; n < 2; ++n) for (int k = 0; k < 2; ++k) \
      acc[ai][bj][m][n] = __builtin_amdgcn_mfma_f32_16x16x32_bf16(At[m][k], Bt_[n][k], acc[ai][bj][m][n], 0, 0, 0); \
    __builtin_amdgcn_s_setprio(0); } while (0)
#define WAIT_V(n) asm volatile("s_waitcnt vmcnt(" #n ")" ::: "memory")
#define WAIT_L(n) asm volatile("s_waitcnt lgkmcnt(" #n ")" ::: "memory")
#define BAR __builtin_amdgcn_s_barrier()
#define SCHED __builtin_amdgcn_sched_barrier(0)

template <int K> DI void gemm_tile(const bf16_t* __restrict__ A, const bf16_t* __restrict__ Bt, const int brow, const int bcol, f32x4 (&acc)[2][2][4][2]) {
    const int wid = threadIdx.x >> 6, lane = threadIdx.x & 63, wr = wid >> 2, wc = wid & 3, fr = lane & 15, fq = lane >> 4;
    unsigned so0;
    { int _r, _c; stage_rc(threadIdx.x * 16, _r, _c); so0 = (unsigned)(_r * K + _c); }
    const int wlds = __builtin_amdgcn_readfirstlane((int)(threadIdx.x >> 6) << 10);
#pragma unroll
    for (int a = 0; a < 2; ++a)
#pragma unroll
        for (int b = 0; b < 2; ++b)
#pragma unroll
            for (int m = 0; m < 4; ++m)
#pragma unroll
                for (int n = 0; n < 2; ++n) acc[a][b][m][n] = (f32x4){0.f, 0.f, 0.f, 0.f};
    bf16x8 At[4][2], B0[2][2], B1[2][2];
    constexpr int nt = K / BK;
    STAGE(SB(0, 0), Bt, bcol, 0); STAGE(SA(0, 0), A, brow, 0);
    STAGE(SB(0, 1), Bt, bcol + HALF, 0); STAGE(SA(0, 1), A, brow + HALF, 0);
    if (wr == 1) BAR;
    WAIT_V(4); BAR;
    STAGE(SB(1, 0), Bt, bcol, 1); STAGE(SA(1, 0), A, brow, 1); STAGE(SB(1, 1), Bt, bcol + HALF, 1);
    WAIT_V(6); BAR;
    for (int t = 0; t < nt - 2; t += 2) {
        LDB(B0, 0, 0); SCHED; LDA(At, 0, 0); STAGE(SA(1, 1), A, brow + HALF, t + 1);
        WAIT_L(8); BAR; WAIT_L(0); MMA(0, 0, At, B0); BAR; SCHED;
        LDB(B1, 0, 1); STAGE(SB(0, 0), Bt, bcol, t + 2);
        BAR; WAIT_L(0); MMA(0, 1, At, B1); BAR;
        LDA(At, 0, 1); STAGE(SA(0, 0), A, brow, t + 2);
        BAR; WAIT_L(0); MMA(1, 0, At, B0); BAR; SCHED;
        STAGE(SB(0, 1), Bt, bcol + HALF, t + 2);
        WAIT_V(6); BAR; MMA(1, 1, At, B1); BAR;
        LDB(B0, 1, 0); SCHED; LDA(At, 1, 0); STAGE(SA(0, 1), A, brow + HALF, t + 2);
        WAIT_L(8); BAR; WAIT_L(0); MMA(0, 0, At, B0); BAR; SCHED;
        LDB(B1, 1, 1); STAGE(SB(1, 0), Bt, bcol, t + 3);
        BAR; WAIT_L(0); MMA(0, 1, At, B1); BAR;
        LDA(At, 1, 1); STAGE(SA(1, 0), A, brow, t + 3);
        BAR; WAIT_L(0); MMA(1, 0, At, B0); BAR; SCHED;
        STAGE(SB(1, 1), Bt, bcol + HALF, t + 3);
        WAIT_V(6); BAR; MMA(1, 1, At, B1); BAR;
    }
    { LDB(B0, 0, 0); LDA(At, 0, 0); STAGE(SA(1, 1), A, brow + HALF, nt - 1);
      BAR; WAIT_L(0); MMA(0, 0, At, B0); BAR;
      LDB(B1, 0, 1); BAR; WAIT_L(0); MMA(0, 1, At, B1); BAR;
      LDA(At, 0, 1); WAIT_V(4); BAR; WAIT_L(0); MMA(1, 0, At, B0); MMA(1, 1, At, B1); BAR; }
    { LDB(B0, 1, 0); LDA(At, 1, 0); WAIT_V(2); BAR; WAIT_L(0); MMA(0, 0, At, B0); BAR;
      LDB(B1, 1, 1); WAIT_V(0); BAR; WAIT_L(0); MMA(0, 1, At, B1); BAR;
      LDA(At, 1, 1); BAR; WAIT_L(0); MMA(1, 0, At, B0); MMA(1, 1, At, B1); BAR; }
    if (wr == 0) BAR;
}

DI void tile_of(int L, int nM, int nN, int& pm, int& pn) {
    const int nwg = nM * nN; int wgid = L;
    { const int q = nwg / NXCD, r = nwg % NXCD, xcd = wgid % NXCD, off = wgid / NXCD; wgid = (xcd < r ? xcd * (q + 1) : r * (q + 1) + (xcd - r) * q) + off; }
    const int nig = WGM * nN, gid = wgid / nig, fm = gid * WGM, gsz = min(nM - fm, WGM);
    pm = fm + ((wgid % nig) % gsz); pn = (wgid % nig) / gsz;
}

constexpr int CST = 260;
DI void stage_half(const f32x4 (&acc)[2][2][4][2], const int ai) {
    const int tid_ = opaque_tid(), wid = tid_ >> 6, lane = tid_ & 63, wr = wid >> 2, wc = wid & 3, fr = lane & 15, fq = lane >> 4;
    float* base = (float*)dyn_smem + (wr * 64 + fq * 4) * CST + wc * 32 + fr;
#pragma unroll
    for (int m = 0; m < 4; ++m)
#pragma unroll
        for (int j = 0; j < 4; ++j)
#pragma unroll
            for (int bj = 0; bj < 2; ++bj)
#pragma unroll
                for (int n = 0; n < 2; ++n) base[(m * 16 + j) * CST + bj * 128 + n * 16] = ai == 0 ? acc[0][bj][m][n][j] : acc[1][bj][m][n][j];
}
#define CT ((const float*)dyn_smem)

DI void epi_in_half(const Params& p, int pm, int pn, int ai) {
    unsigned char* ws = p.ws;
    const int tid = opaque_tid(), brow = pm * BM + ai * 128, bcol = pn * BM;
    const bool samp = pm == 128;
    if (pn < 8) {
        bf16_t* dst = pn < 6 ? (bf16_t*)(ws + WS_R2) : (bf16_t*)(ws + WS_R3);
        const int ld = pn < 6 ? 1536 : 512, c0 = pn < 6 ? bcol : bcol - 1536;
#pragma unroll 4
        for (int i = 0; i < 16; ++i) {
            const int id = tid + 512 * i, r = id >> 6, c4 = (id & 63) * 4, row = brow + r;
            const f32x4 v = *(const f32x4*)(CT + r * CST + c4);
            u32x2 o; o.x = pk2(v.x, v.y); o.y = pk2(v.z, v.w);
            *(u32x2*)(dst + (size_t)row * ld + c0 + c4) = o;
            if (pn < 6) {
                if (!samp) { const int t = row & (TP - 1); if (t >= TP - 3) *(f32x4*)(p.out + O_CQP + (size_t)((row >> 13) * 3 + t - (TP - 3)) * 1536 + c0 + c4) = v; }
                else { const int rr = row - MP, t = rr & 31; if (t >= TS - 3) *(f32x4*)(p.out + O_CQS + (size_t)((rr >> 5) * 3 + t - (TS - 3)) * 1536 + c0 + c4) = v; }
            }
        }
        return;
    }
    if (pn < 12) {
        const bool isq = pn < 10;
        const float* rope = (const float*)(ws + WS_ROPE);
        bf16_t* QB = (bf16_t*)(ws + WS_R4); bf16_t* KALL = (bf16_t*)(ws + WS_R5);
        const float qs = 0.125f * 1.4426950408889634f;
#pragma unroll 2
        for (int i = 0; i < 8; ++i) {
            const int id = tid + 512 * i, r = id >> 5, q = id & 31, hl = q >> 4, map = (q >> 3) & 1, d4 = (q & 7) * 4, row = brow + r;
            const int cl = hl * 128 + map * 64 + d4, col = ((pn & 1) * 2 + hl) * 128 + map * 64 + d4;
            const f32x4 x1 = *(const f32x4*)(CT + r * CST + cl), x2 = *(const f32x4*)(CT + r * CST + cl + 32);
            int pos; size_t krow; float* kout;
            if (!samp) { pos = row & (TP - 1); krow = row; kout = p.out + O_KP + (size_t)row * 512; }
            else { const int rr = row - MP; pos = PAST + (rr & 31); krow = (size_t)MP + (size_t)(rr >> 5) * TKS + pos; kout = p.out + O_KS + (size_t)rr * 512; }
            const f32x4 t0 = *(const f32x4*)(rope + (size_t)(pos * 32 + d4) * 2), t1 = *(const f32x4*)(rope + (size_t)(pos * 32 + d4) * 2 + 4);
            const f32x4 cs = (f32x4){t0.x, t0.z, t1.x, t1.z}, sn = (f32x4){t0.y, t0.w, t1.y, t1.w};
            const f32x4 y1 = x1 * cs - x2 * sn, y2 = x2 * cs + x1 * sn;
            if (isq) {
                u32x2 o1, o2; o1.x = pk2(y1.x * qs, y1.y * qs); o1.y = pk2(y1.z * qs, y1.w * qs); o2.x = pk2(y2.x * qs, y2.y * qs); o2.y = pk2(y2.z * qs, y2.w * qs);
                *(u32x2*)(QB + (size_t)row * 512 + col) = o1; *(u32x2*)(QB + (size_t)row * 512 + col + 32) = o2;
            } else {
                *(f32x4*)(kout + col) = y1; *(f32x4*)(kout + col + 32) = y2;
                u32x2 o1, o2; o1.x = pk2(y1.x, y1.y); o1.y = pk2(y1.z, y1.w); o2.x = pk2(y2.x, y2.y); o2.y = pk2(y2.z, y2.w);
                *(u32x2*)(KALL + krow * 512 + col) = o1; *(u32x2*)(KALL + krow * 512 + col + 32) = o2;
            }
        }
        return;
    }
    {
        bf16_t* VT = (bf16_t*)(ws + WS_R6);
#pragma unroll 4
        for (int i = 0; i < 16; ++i) {
            const int id = tid + 512 * i, r = id >> 6, c4 = (id & 63) * 4, row = brow + r, col = (pn & 1) * 256 + c4;
            const f32x4 v = *(const f32x4*)(CT + r * CST + c4);
            float* vout = samp ? p.out + O_VS + (size_t)(row - MP) * 512 + col : p.out + O_VP + (size_t)row * 512 + col;
            *(f32x4*)vout = v;
        }
#pragma unroll 1
        for (int i = 0; i < 2; ++i) {
            const int id = tid + 512 * i, rg = id >> 6, c4 = (id & 63) * 4, row0 = brow + rg * 8;
            f32x4 v[8];
#pragma unroll
            for (int e = 0; e < 8; ++e) v[e] = *(const f32x4*)(CT + (rg * 8 + e) * CST + c4);
#pragma unroll
            for (int e = 0; e < 4; ++e) {
                const int colg = (pn & 1) * 256 + c4 + e, head = colg >> 7, dv = colg & 127;
                u32x4 o; o.x = pk2(v[0][e], v[1][e]); o.y = pk2(v[2][e], v[3][e]); o.z = pk2(v[4][e], v[5][e]); o.w = pk2(v[6][e], v[7][e]);
                bf16_t* d;
                if (samp) { const int rr = row0 - MP; d = VT + VT_S_OFF + ((size_t)(((rr >> 5) * 4 + head) * 128 + dv) * TKS + PAST + (rr & 31)); }
                else d = VT + ((size_t)(((row0 >> 13) * 4 + head) * 128 + dv) * TP + (row0 & (TP - 1)));
                *(u32x4*)d = o;
            }
        }
    }
}

template <int WHICH> DI void epi_res_half(const Params& p, int pm, int pn, int ai) {
    const int tid = opaque_tid(), brow = pm * BM + ai * 128, bcol = pn * BM;
    bf16_t* dst = (bf16_t*)(p.ws + (WHICH == 0 ? WS_R1 : WS_R2));
    const bf16_t* X1B = (const bf16_t*)(p.ws + WS_R3);
#pragma unroll 4
    for (int i = 0; i < 16; ++i) {
        const int id = tid + 512 * i, r = id >> 6, c4 = (id & 63) * 4, row = brow + r;
        const f32x4 v = *(const f32x4*)(CT + r * CST + c4);
        f32x4 x;
        if (WHICH == 0) x = *(const f32x4*)(xrow_ptr(p, row) + bcol + c4);
        else { const u32x2 xb = *(const u32x2*)(X1B + (size_t)row * D + bcol + c4); x = (f32x4){bflo(xb.x), bfhi(xb.x), bflo(xb.y), bfhi(xb.y)}; }
        const f32x4 o = x * ALPHA + v;
        u32x2 q; q.x = pk2(o.x, o.y); q.y = pk2(o.z, o.w);
        *(u32x2*)(dst + (size_t)row * D + bcol + c4) = q;
    }
}

constexpr int UST = 264;
DI void epi_up(const Params& p, const f32x4 (&acc)[2][2][4][2], int pm, int pn) {
    unsigned char* ws = p.ws;
    bf16_t* U = (bf16_t*)dyn_smem;
    float* BND = (float*)(ws + WS_R5);
    const bool samp = pm == 128;
    const int brow = pm * BM, tid = opaque_tid();
    {
        const int wid = tid >> 6, lane = tid & 63, wr = wid >> 2, wc = wid & 3, fr = lane & 15, fq = lane >> 4;
        bf16_t* base = U + (wr * 64 + fq * 4) * UST + wc * 32 + fr;
#pragma unroll
        for (int ai = 0; ai < 2; ++ai)
#pragma unroll
            for (int m = 0; m < 4; ++m)
#pragma unroll
                for (int j = 0; j < 4; ++j)
#pragma unroll
                    for (int bj = 0; bj < 2; ++bj)
#pragma unroll
                        for (int n = 0; n < 2; ++n) base[(ai * 128 + m * 16 + j) * UST + bj * 128 + n * 16] = f2bf(acc[ai][bj][m][n][j]);
    }
    __syncthreads();
    {
        const int nb = samp ? 32 * 256 : 4 * 256;
        for (int id = tid; id < nb; id += 512) {
            const int cl = id & 255, q = id >> 8;
            const int oc = (cl >> 7) * DFF + 128 * pn + (cl & 127);
            int rr, bslot, u;
            if (!samp) { bslot = q; rr = q < 2 ? q : 252 + q; u = pm; }
            else { bslot = q & 3; rr = (q >> 2) * 32 + (bslot < 2 ? bslot : 28 + bslot); u = 128 + (q >> 2); }
            const float v = bf2f(U[rr * UST + cl]);
            BND[((size_t)u * 4 + bslot) * NUP + oc] = v;
            if (bslot >= 2) {
                if (samp) p.out[O_CFS + (size_t)((q >> 2) * 2 + bslot - 2) * NUP + oc] = v;
                else if ((pm & 31) == 31) p.out[O_CFP + (size_t)((pm >> 5) * 2 + bslot - 2) * NUP + oc] = v;
            }
        }
    }
    {
        const int c = tid & 127, rs = tid >> 7, cg_ = 128 * pn + c, cv_ = DFF + 128 * pn + c;
        const float wg0 = p.ffn_conv_w[cg_], wg1 = p.ffn_conv_w[NUP + cg_], wg2 = p.ffn_conv_w[2 * NUP + cg_], bg = p.ffn_conv_b[cg_];
        const float wv0 = p.ffn_conv_w[cv_], wv1 = p.ffn_conv_w[NUP + cv_], wv2 = p.ffn_conv_w[2 * NUP + cv_], bv = p.ffn_conv_b[cv_];
        bf16_t* GT = (bf16_t*)(ws + WS_R1);
        const int r0 = rs * 64;
        float g1 = 0.f, g2 = 0.f, v1 = 0.f, v2 = 0.f;
        if (r0 >= 2) { g1 = bf2f(U[(r0 - 2) * UST + c]); g2 = bf2f(U[(r0 - 1) * UST + c]); v1 = bf2f(U[(r0 - 2) * UST + 128 + c]); v2 = bf2f(U[(r0 - 1) * UST + 128 + c]); }
#pragma unroll 4
        for (int r = r0; r < r0 + 64; ++r) {
            const float g3 = bf2f(U[r * UST + c]), v3 = bf2f(U[r * UST + 128 + c]);
            const bool skip = samp ? ((r & 31) < 2) : (r < 2);
            if (!skip) {
                const float cg2 = wg0 * g1 + wg1 * g2 + wg2 * g3 + bg, cv2 = wv0 * v1 + wv1 * v2 + wv2 * v3 + bv;
                GT[(size_t)(brow + r) * DFF + 128 * pn + c] = f2bf(silu(cg2) * cv2);
            }
            g1 = g2; g2 = g3; v1 = v2; v2 = v3;
        }
    }
}

template <int K> DI void skinny_gemm(const bf16_t* __restrict__ A, const bf16_t* __restrict__ Bt, float* __restrict__ C, const int N) {
    const int tid = opaque_tid(), lane = tid & 63, w = __builtin_amdgcn_readfirstlane(tid >> 6), fr = lane & 15, fq = lane >> 4;
    float* red = (float*)dyn_smem;
    constexpr int KW = K / 8, NKS = KW / 32;
    const int ntile = 8 * (N / 32);
    for (int t = blockIdx.x; t < ntile; t += gridDim.x) {
        const int rm = t & 7, cn = t >> 3;
        const bf16_t* ap = A + (size_t)(32 * rm + fr) * K + w * KW + 8 * fq;
        const bf16_t* bp = Bt + (size_t)(32 * cn + fr) * K + w * KW + 8 * fq;
        f32x4 acc[2][2];
#pragma unroll
        for (int i = 0; i < 2; ++i)
#pragma unroll
            for (int j = 0; j < 2; ++j) acc[i][j] = (f32x4){0.f, 0.f, 0.f, 0.f};
#pragma unroll 4
        for (int ks = 0; ks < NKS; ++ks) {
            const bf16x8 a0 = *(const bf16x8*)(ap + ks * 32), a1 = *(const bf16x8*)(ap + (size_t)16 * K + ks * 32);
            const bf16x8 b0 = *(const bf16x8*)(bp + ks * 32), b1 = *(const bf16x8*)(bp + (size_t)16 * K + ks * 32);
            acc[0][0] = __builtin_amdgcn_mfma_f32_16x16x32_bf16(a0, b0, acc[0][0], 0, 0, 0);
            acc[0][1] = __builtin_amdgcn_mfma_f32_16x16x32_bf16(a0, b1, acc[0][1], 0, 0, 0);
            acc[1][0] = __builtin_amdgcn_mfma_f32_16x16x32_bf16(a1, b0, acc[1][0], 0, 0, 0);
            acc[1][1] = __builtin_amdgcn_mfma_f32_16x16x32_bf16(a1, b1, acc[1][1], 0, 0, 0);
        }
        __syncthreads();
#pragma unroll
        for (int i = 0; i < 2; ++i)
#pragma unroll
            for (int j = 0; j < 2; ++j)
#pragma unroll
                for (int e = 0; e < 4; ++e) red[(w * 32 + 16 * i + 4 * fq + e) * 33 + 16 * j + fr] = acc[i][j][e];
        __syncthreads();
#pragma unroll
        for (int o2 = 0; o2 < 2; ++o2) {
            const int o = tid + 512 * o2, r = o >> 5, c = o & 31;
            float sum = 0.f;
#pragma unroll
            for (int ww = 0; ww < 8; ++ww) sum += red[(ww * 32 + r) * 33 + c];
            C[(size_t)(32 * rm + r) * N + 32 * cn + c] = sum;
        }
    }
    __syncthreads();
}

template <int WHICH> DI void gemm_phase(const Params& p) {
    unsigned char* ws = p.ws;
    const bf16_t* A; const bf16_t* Bt; int N; constexpr int K = WHICH == 4 ? DFF : D; float* CS;
    if (WHICH == 1) { A = (const bf16_t*)(ws + WS_R1); Bt = (const bf16_t*)(ws + WS_WIN); N = NH1; CS = (float*)(ws + WS_CS1); }
    else if (WHICH == 2) { A = (const bf16_t*)(ws + WS_R2); Bt = (const bf16_t*)(ws + WS_WO); N = D; CS = (float*)(ws + WS_CS2); }
    else if (WHICH == 3) { A = (const bf16_t*)(ws + WS_R3); Bt = (const bf16_t*)(ws + WS_WUP); N = NUP; CS = (float*)(ws + WS_CS3); }
    else { A = (const bf16_t*)(ws + WS_R1); Bt = (const bf16_t*)(ws + WS_WDN); N = D; CS = (float*)(ws + WS_CS4); }
    skinny_gemm<K>(A + (size_t)MP * K, Bt, CS, N);
    const int nM = MP / BM, nN = N / BM, ntile = nM * nN;
    for (int L0 = blockIdx.x; L0 < ntile * (WHICH == GREP_WHICH ? 2 : 1); L0 += gridDim.x) {
        const int L = L0 % ntile;
        int pm, pn; tile_of(L, nM, nN, pm, pn);
        f32x4 acc[2][2][4][2];
        gemm_tile<K>(A, Bt, pm * BM, pn * BM, acc);
        if (WHICH == 3) epi_up(p, acc, pm, pn);
        else {
#pragma unroll
            for (int ai = 0; ai < 2; ++ai) {
                stage_half(acc, ai);
                __syncthreads();
                if (WHICH == 1) epi_in_half(p, pm, pn, ai);
                else if (WHICH == 2) epi_res_half<0>(p, pm, pn, ai);
                else epi_res_half<1>(p, pm, pn, ai);
                __syncthreads();
            }
        }
        __syncthreads();
    }
}

template <int WHICH> DI void ln_phase(const Params& p) {
    const int lane = threadIdx.x & 63, wave = threadIdx.x >> 6;
    const float* g = WHICH == 0 ? p.ln1_g : p.ln2_g; const float* b = WHICH == 0 ? p.ln1_b : p.ln2_b;
    bf16_t* X1B = (bf16_t*)(p.ws + WS_R3);
    const bf16_t* PRE = (const bf16_t*)(p.ws + (WHICH == 0 ? WS_R1 : WS_R2));
    f32x4 gv[4], bv[4];
#pragma unroll
    for (int j = 0; j < 4; ++j) { gv[j] = *(const f32x4*)(g + lane * 4 + 256 * j); bv[j] = *(const f32x4*)(b + lane * 4 + 256 * j); }
    for (int row = blockIdx.x * 8 + wave; row < M; row += gridDim.x * 8) {
        f32x4 v[4]; float s = 0.f;
        if (row < MP) {
#pragma unroll
            for (int j = 0; j < 4; ++j) { const u32x2 q = *(const u32x2*)(PRE + (size_t)row * D + lane * 4 + 256 * j); v[j] = (f32x4){bflo(q.x), bfhi(q.x), bflo(q.y), bfhi(q.y)}; }
        } else {
            const float* cs = (const float*)(p.ws + (WHICH == 0 ? WS_CS2 : WS_CS4)) + (size_t)(row - MP) * D;
#pragma unroll
            for (int j = 0; j < 4; ++j) {
                f32x4 rs;
                if (WHICH == 0) rs = *(const f32x4*)(p.x_s + (size_t)(row - MP) * D + lane * 4 + 256 * j);
                else { const u32x2 q = *(const u32x2*)(X1B + (size_t)row * D + lane * 4 + 256 * j); rs = (f32x4){bflo(q.x), bfhi(q.x), bflo(q.y), bfhi(q.y)}; }
                v[j] = rs * ALPHA + *(const f32x4*)(cs + lane * 4 + 256 * j);
            }
        }
#pragma unroll
        for (int j = 0; j < 4; ++j) s += (v[j].x + v[j].y) + (v[j].z + v[j].w);
        const float mean = wave_sum(s) * (1.f / D); float s2 = 0.f;
#pragma unroll
        for (int j = 0; j < 4; ++j) { v[j] = v[j] - mean; s2 += (v[j].x * v[j].x + v[j].y * v[j].y) + (v[j].z * v[j].z + v[j].w * v[j].w); }
        const float rstd = rsqrtf(wave_sum(s2) * (1.f / D) + 1e-5f);
#pragma unroll
        for (int j = 0; j < 4; ++j) {
            const f32x4 o = v[j] * rstd * gv[j] + bv[j];
            if (WHICH == 0) { u32x2 q; q.x = pk2(o.x, o.y); q.y = pk2(o.z, o.w); *(u32x2*)(X1B + (size_t)row * D + lane * 4 + 256 * j) = q; }
            else *(f32x4*)(p.out + O_Y + (size_t)row * D + lane * 4 + 256 * j) = o;
        }
    }
}

DI void fixup_phase(const Params& p) {
    const float* BND = (const float*)(p.ws + WS_R5);
    bf16_t* GT = (bf16_t*)(p.ws + WS_R1);
    {
        const float* CS3 = (const float*)(p.ws + WS_CS3);
        for (int idx = blockIdx.x * 512 + threadIdx.x; idx < MS * DFF; idx += gridDim.x * 512) {
            const int c = idx % DFF, r = idx / DFF, b = r >> 5, t = r & 31, ng = (c >> 7) * 256 + (c & 127), nv = ng + 128;
            float g[3], v[3];
#pragma unroll
            for (int k = 0; k < 3; ++k) {
                const int tt = t - 2 + k;
                if (tt >= 0) { g[k] = CS3[(size_t)(b * 32 + tt) * NUP + ng]; v[k] = CS3[(size_t)(b * 32 + tt) * NUP + nv]; }
                else { g[k] = p.state_cf[(size_t)(b * 2 + 2 + tt) * NUP + c]; v[k] = p.state_cf[(size_t)(b * 2 + 2 + tt) * NUP + DFF + c]; }
            }
            const float cg2 = p.ffn_conv_w[c] * g[0] + p.ffn_conv_w[NUP + c] * g[1] + p.ffn_conv_w[2 * NUP + c] * g[2] + p.ffn_conv_b[c];
            const float cv2 = p.ffn_conv_w[DFF + c] * v[0] + p.ffn_conv_w[NUP + DFF + c] * v[1] + p.ffn_conv_w[2 * NUP + DFF + c] * v[2] + p.ffn_conv_b[DFF + c];
            GT[((size_t)MP + r) * DFF + c] = f2bf(silu(cg2) * cv2);
            if (t >= 30) { p.out[O_CFS + (size_t)(b * 2 + t - 30) * NUP + c] = g[2]; p.out[O_CFS + (size_t)(b * 2 + t - 30) * NUP + DFF + c] = v[2]; }
        }
    }
    const int total = 128 * 2 * DFF;
    for (int idx = blockIdx.x * 512 + threadIdx.x; idx < total; idx += gridDim.x * 512) {
        const int c = idx % DFF, q = idx / DFF, r = q & 1, u = q >> 1;
        const float* cur = BND + (size_t)u * 4 * NUP;
        float pg[2], pv[2];
        if (u < 128) {
            if ((u & 31) == 0) { pg[0] = pg[1] = pv[0] = pv[1] = 0.f; }
            else { const float* pr = BND + (size_t)(u - 1) * 4 * NUP; pg[0] = pr[2 * NUP + c]; pg[1] = pr[3 * NUP + c]; pv[0] = pr[2 * NUP + DFF + c]; pv[1] = pr[3 * NUP + DFF + c]; }
        } else { const float* st = p.state_cf + (size_t)(u - 128) * 2 * NUP; pg[0] = st[c]; pg[1] = st[NUP + c]; pv[0] = st[DFF + c]; pv[1] = st[NUP + DFF + c]; }
        const float cg0 = cur[c], cg1 = cur[NUP + c], cv0 = cur[DFF + c], cv1 = cur[NUP + DFF + c];
        const float wg0 = p.ffn_conv_w[c], wg1 = p.ffn_conv_w[NUP + c], wg2 = p.ffn_conv_w[2 * NUP + c], bg = p.ffn_conv_b[c];
        const float wv0 = p.ffn_conv_w[DFF + c], wv1 = p.ffn_conv_w[NUP + DFF + c], wv2 = p.ffn_conv_w[2 * NUP + DFF + c], bv = p.ffn_conv_b[DFF + c];
        float g, v;
        if (r == 0) { g = wg0 * pg[0] + wg1 * pg[1] + wg2 * cg0 + bg; v = wv0 * pv[0] + wv1 * pv[1] + wv2 * cv0 + bv; }
        else { g = wg0 * pg[1] + wg1 * cg0 + wg2 * cg1 + bg; v = wv0 * pv[1] + wv1 * cv0 + wv2 * cv1 + bv; }
        const size_t row = u < 128 ? (size_t)u * 256 + r : (size_t)MP + (size_t)(u - 128) * 32 + r;
        GT[row * DFF + c] = f2bf(silu(g) * v);
    }
}

#define MFMA16(a, b, c) __builtin_amdgcn_mfma_f32_16x16x32_bf16((a), (b), (c), 0, 0, 0)
#define MFMA32(a, b, c) __builtin_amdgcn_mfma_f32_32x32x16_bf16((a), (b), (c), 0, 0, 0)
DI bf16x8 pack8(const f32x4 a, const f32x4 b) { u32x4 o; o.x = pk2(a.x, a.y); o.y = pk2(a.z, a.w); o.z = pk2(b.x, b.y); o.w = pk2(b.z, b.w); return __builtin_bit_cast(bf16x8, o); }
constexpr float GSCALE = 0.08838834764831845f;
constexpr int QST = 132, AST = 68, NST = 136, QKST = 72;
constexpr int L_QKV = 0, L_AM = 3 * 64 * QST * 4, L_KN = L_AM + 64 * AST * 4, L_QN = L_KN + 64 * NST * 2, L_GC = L_QN + 64 * NST * 2;
constexpr int L_QKS = 0, L_WS = 64 * QKST * 2;
static_assert(L_GC + 1024 <= LDS_BYTES, "gdn prep LDS");

DI void gdn_prep_item(const Params& p, const int item) {
    unsigned char* ws = p.ws;
    float* QKVf = (float*)(dyn_smem + L_QKV); float* AM = (float*)(dyn_smem + L_AM);
    bf16_t* KN = (bf16_t*)(dyn_smem + L_KN); bf16_t* QN = (bf16_t*)(dyn_smem + L_QN);
    float* GC = (float*)(dyn_smem + L_GC); float* BETA = GC + 64; float* EG = GC + 128; float* ED = GC + 192;
    bf16_t* QKS = (bf16_t*)(dyn_smem + L_QKS); bf16_t* WSI = (bf16_t*)(dyn_smem + L_WS);
    const bf16_t* HQKV = (const bf16_t*)(ws + WS_R2);
    const float* AB = (const float*)(ws + WS_AB);
    float* DL = (float*)(ws + WS_DL);
        const int tid = opaque_tid(), lane = tid & 63, wave = __builtin_amdgcn_readfirstlane(tid >> 6), fr = lane & 15, fq = lane >> 4;
        int h, b, c, row0, valid; bool samp;
        if (item < 2048) { h = item & 3; c = (item >> 2) & 127; b = item >> 9; row0 = b * TP + c * 64; valid = 64; samp = false; }
        else { const int j = item - 2048; h = j & 3; b = j >> 2; c = 0; row0 = MP + b * TS; valid = TS; samp = true; }
        unsigned char* ip = ws + WS_R1 + (size_t)item * ITEM_B;
        __syncthreads();
        {
            bf16_t* RAW = (bf16_t*)(dyn_smem + L_AM);
#pragma unroll
            for (int i = 0; i < 7; ++i) {
                const int id = tid + 512 * i;
                if (id < 67 * 48) {
                    const int rw = id / 48, ch = id % 48, part = ch >> 4, c8 = (ch & 15) * 8, gcol = part * 512 + h * 128 + c8, t = rw - 3;
                    u32x4 v = (u32x4){0u, 0u, 0u, 0u};
                    if (t >= 0) {
                        if (t < valid) {
                            if (!samp) v = *(const u32x4*)(HQKV + (size_t)(row0 + t) * 1536 + gcol);
                            else { const float* sp = (const float*)(ws + WS_CS1) + (size_t)(row0 - MP + t) * NH1 + gcol; const f32x4 f0 = *(const f32x4*)sp, f1 = *(const f32x4*)(sp + 4);
                                   v.x = pk2(f0.x, f0.y); v.y = pk2(f0.z, f0.w); v.z = pk2(f1.x, f1.y); v.w = pk2(f1.z, f1.w); }
                        }
                    }
                    else if (samp) { const float* sp = p.state_cq + (size_t)(b * 3 + 3 + t) * 1536 + gcol; const f32x4 f0 = *(const f32x4*)sp, f1 = *(const f32x4*)(sp + 4);
                                     v.x = pk2(f0.x, f0.y); v.y = pk2(f0.z, f0.w); v.z = pk2(f1.x, f1.y); v.w = pk2(f1.z, f1.w); }
                    else if (c != 0) v = *(const u32x4*)(HQKV + (size_t)(row0 + t) * 1536 + gcol);
                    *(u32x4*)(RAW + rw * 384 + ch * 8) = v;
                }
            }
            __syncthreads();
#pragma unroll 1
            for (int task = tid; task < 1536; task += 512) {
                const int col = task % 384, seg = task / 384, part = col >> 7, cc = col & 127, gcol = part * 512 + h * 128 + cc, t0 = seg * 16;
                const float w0 = p.gdn_conv_w[gcol], w1 = p.gdn_conv_w[1536 + gcol], w2 = p.gdn_conv_w[2 * 1536 + gcol], w3 = p.gdn_conv_w[3 * 1536 + gcol];
                float x0 = bf2f(RAW[(t0) * 384 + col]), x1 = bf2f(RAW[(t0 + 1) * 384 + col]), x2 = bf2f(RAW[(t0 + 2) * 384 + col]);
#pragma unroll
                for (int t = t0; t < t0 + 16; ++t) {
                    const float xv = bf2f(RAW[(t + 3) * 384 + col]);
                    const float y = w0 * x0 + w1 * x1 + w2 * x2 + w3 * xv;
                    QKVf[(part * 64 + t) * QST + cc] = t < valid ? silu(y) : 0.f;
                    x0 = x1; x1 = x2; x2 = xv;
                }
            }
        }
        if (tid < 64) {
            float g = 0.f, be = 0.f;
            if (tid < valid) {
                const float a = AB[(size_t)(row0 + tid) * 8 + h] + p.dt_bias[h], bb = AB[(size_t)(row0 + tid) * 8 + 4 + h];
                const float sp = a > 20.f ? a : log1pf(expf(a));
                g = -expf(p.a_log[h]) * sp; be = 1.f / (1.f + expf(-bb));
            }
            float gc = g;
#pragma unroll
            for (int o = 1; o < 64; o <<= 1) { const float n = __shfl_up(gc, o); if (lane >= o) gc += n; }
            const float gl = __shfl(gc, 63);
            GC[tid] = gc; BETA[tid] = be; EG[tid] = expf(gc); ED[tid] = expf(gl - gc);
            if (tid == 0) DL[item] = expf(gl);
        }
        __syncthreads();
        {
            const int row = tid >> 3, pt = tid & 7;
            float q[16], k[16]; float sq = 0.f, sk = 0.f;
#pragma unroll
            for (int e4 = 0; e4 < 4; ++e4) {
                const f32x4 a = *(const f32x4*)(QKVf + row * QST + 16 * pt + 4 * e4), bq = *(const f32x4*)(QKVf + (64 + row) * QST + 16 * pt + 4 * e4);
#pragma unroll
                for (int e = 0; e < 4; ++e) { q[4 * e4 + e] = a[e]; k[4 * e4 + e] = bq[e]; sq += a[e] * a[e]; sk += bq[e] * bq[e]; }
            }
#pragma unroll
            for (int o = 1; o < 8; o <<= 1) { sq += __shfl_xor(sq, o); sk += __shfl_xor(sk, o); }
            const float rq = rsqrtf(sq + 1e-6f), rk = rsqrtf(sk + 1e-6f), qg = rq * GSCALE * EG[row];
            u32x4 o0, o1;
            o0.x = pk2(q[0] * rq, q[1] * rq); o0.y = pk2(q[2] * rq, q[3] * rq); o0.z = pk2(q[4] * rq, q[5] * rq); o0.w = pk2(q[6] * rq, q[7] * rq);
            o1.x = pk2(q[8] * rq, q[9] * rq); o1.y = pk2(q[10] * rq, q[11] * rq); o1.z = pk2(q[12] * rq, q[13] * rq); o1.w = pk2(q[14] * rq, q[15] * rq);
            *(u32x4*)(QN + row * NST + 16 * pt) = o0; *(u32x4*)(QN + row * NST + 16 * pt + 8) = o1;
            o0.x = pk2(k[0] * rk, k[1] * rk); o0.y = pk2(k[2] * rk, k[3] * rk); o0.z = pk2(k[4] * rk, k[5] * rk); o0.w = pk2(k[6] * rk, k[7] * rk);
            o1.x = pk2(k[8] * rk, k[9] * rk); o1.y = pk2(k[10] * rk, k[11] * rk); o1.z = pk2(k[12] * rk, k[13] * rk); o1.w = pk2(k[14] * rk, k[15] * rk);
            *(u32x4*)(KN + row * NST + 16 * pt) = o0; *(u32x4*)(KN + row * NST + 16 * pt + 8) = o1;
#pragma unroll
            for (int e4 = 0; e4 < 4; ++e4) *(f32x4*)(QKVf + (64 + row) * QST + 16 * pt + 4 * e4) = (f32x4){k[4 * e4] * rk, k[4 * e4 + 1] * rk, k[4 * e4 + 2] * rk, k[4 * e4 + 3] * rk};
            bf16_t* QGf = (bf16_t*)(ip + 16384);
            const int rt = row >> 4, frr = row & 15, ks = pt >> 1;
#pragma unroll
            for (int f = 0; f < 4; ++f) {
                u32x2 o; o.x = pk2(q[4 * f] * qg, q[4 * f + 1] * qg); o.y = pk2(q[4 * f + 2] * qg, q[4 * f + 3] * qg);
                *(u32x2*)(QGf + (size_t)(((rt * 4 + ks) * 64 + f * 16 + frr) * 8 + 4 * (pt & 1))) = o;
            }
        }
        __syncthreads();
        {
            const bool isq = wave >= 4; const int ti = wave & 3;
            const bf16_t* As = isq ? QN : KN;
#pragma unroll
            for (int tj = 0; tj < 4; ++tj) {
                f32x4 acc = (f32x4){0.f, 0.f, 0.f, 0.f};
#pragma unroll
                for (int ks = 0; ks < 4; ++ks) {
                    const bf16x8 a = *(const bf16x8*)(As + (16 * ti + fr) * NST + 32 * ks + 8 * fq), bb = *(const bf16x8*)(KN + (16 * tj + fr) * NST + 32 * ks + 8 * fq);
                    acc = MFMA16(a, bb, acc);
                }
                const int jj = 16 * tj + fr; const float gj = GC[jj];
#pragma unroll
                for (int j = 0; j < 4; ++j) {
                    const int i = 16 * ti + 4 * fq + j;
                    const float dec = i >= jj ? expf(GC[i] - gj) : 0.f;
                    if (!isq) AM[i * AST + jj] = i > jj ? BETA[i] * acc[j] * dec : 0.f;
                    else QKS[i * QKST + jj] = f2bf(GSCALE * acc[j] * dec);
                }
            }
            bf16_t* KDTf = (bf16_t*)(ip + 32768);
#pragma unroll
            for (int i2 = 0; i2 < 2; ++i2) {
                const int f = tid + 512 * i2, ln = f & 63, ks2 = (f >> 6) & 1, dt = f >> 7, fq_ = ln >> 4, dk = 16 * dt + (ln & 15);
                float v[8];
#pragma unroll
                for (int e = 0; e < 8; ++e) { const int i = 32 * ks2 + 16 * (e >> 2) + 4 * fq_ + (e & 3); v[e] = bf2f(KN[i * NST + dk]) * ED[i]; }
                u32x4 o; o.x = pk2(v[0], v[1]); o.y = pk2(v[2], v[3]); o.z = pk2(v[4], v[5]); o.w = pk2(v[6], v[7]);
                *(u32x4*)(KDTf + (size_t)f * 8) = o;
            }
        }
        __syncthreads();
        {
            float* TM = (float*)(dyn_smem + L_QN);
            float* TMP = (float*)(dyn_smem + L_KN);
#pragma unroll
            for (int i = 0; i < 9; ++i) { const int id = tid + 512 * i; if (id < 64 * AST) TM[id] = 0.f; }
            __syncthreads();
            if (tid < 64) {
                const int d = tid >> 4, c = tid & 15;
                float y[16];
#pragma unroll
                for (int r = 0; r < 16; ++r) {
                    float sacc = r == c ? 1.f : 0.f;
                    const float* ar = AM + (16 * d + r) * AST + 16 * d;
#pragma unroll
                    for (int j = 0; j < r; ++j) sacc -= ar[j] * y[j];
                    y[r] = sacc;
                    TM[(16 * d + r) * AST + 16 * d + c] = sacc;
                }
            }
            __syncthreads();
            {
                const int blk = tid >> 8, r = (tid >> 4) & 15, c = tid & 15, rb = blk ? 3 : 1, cb = rb - 1;
                float t = 0.f;
#pragma unroll
                for (int j = 0; j < 16; ++j) t += AM[(16 * rb + r) * AST + 16 * cb + j] * TM[(16 * cb + j) * AST + 16 * cb + c];
                TMP[blk * 272 + r * 17 + c] = t;
                __syncthreads();
                float o = 0.f;
#pragma unroll
                for (int k = 0; k < 16; ++k) o -= TM[(16 * rb + r) * AST + 16 * rb + k] * TMP[blk * 272 + k * 17 + c];
                __syncthreads();
                TM[(16 * rb + r) * AST + 16 * cb + c] = o;
            }
            __syncthreads();
            {
                float t[2];
#pragma unroll
                for (int i2 = 0; i2 < 2; ++i2) {
                    const int o = tid + 512 * i2, r = o >> 5, c = o & 31;
                    float acc = 0.f;
#pragma unroll
                    for (int j = 0; j < 32; ++j) acc += AM[(32 + r) * AST + j] * TM[j * AST + c];
                    t[i2] = acc;
                }
#pragma unroll
                for (int i2 = 0; i2 < 2; ++i2) { const int o = tid + 512 * i2; TMP[(o >> 5) * 33 + (o & 31)] = t[i2]; }
                __syncthreads();
#pragma unroll
                for (int i2 = 0; i2 < 2; ++i2) {
                    const int o = tid + 512 * i2, r = o >> 5, c = o & 31;
                    float acc = 0.f;
#pragma unroll
                    for (int k = 0; k < 32; ++k) acc -= TM[(32 + r) * AST + 32 + k] * TMP[k * 33 + c];
                    t[i2] = acc;
                }
#pragma unroll
                for (int i2 = 0; i2 < 2; ++i2) { const int o = tid + 512 * i2; TM[(32 + (o >> 5)) * AST + (o & 31)] = t[i2]; }
            }
            __syncthreads();
            {
                bf16x8 Ah[4][2], Al[4][2];
#pragma unroll
                for (int rt = 0; rt < 4; ++rt)
#pragma unroll
                    for (int ks = 0; ks < 2; ++ks) {
                        const f32x4 a0 = *(const f32x4*)(TM + (16 * rt + fr) * AST + 32 * ks + 8 * fq), a1 = *(const f32x4*)(TM + (16 * rt + fr) * AST + 32 * ks + 8 * fq + 4);
                        u32x4 hq; hq.x = pk2(a0.x, a0.y); hq.y = pk2(a0.z, a0.w); hq.z = pk2(a1.x, a1.y); hq.w = pk2(a1.z, a1.w);
                        u32x4 lq; lq.x = pk2(a0.x - bflo(hq.x), a0.y - bfhi(hq.x)); lq.y = pk2(a0.z - bflo(hq.y), a0.w - bfhi(hq.y));
                        lq.z = pk2(a1.x - bflo(hq.z), a1.y - bfhi(hq.z)); lq.w = pk2(a1.z - bflo(hq.w), a1.w - bfhi(hq.w));
                        Ah[rt][ks] = __builtin_bit_cast(bf16x8, hq); Al[rt][ks] = __builtin_bit_cast(bf16x8, lq);
                    }
                const bool isw = wave >= 4;
                f32x4 xacc[2][4];
#pragma unroll
                for (int q = 0; q < 2; ++q)
#pragma unroll
                    for (int rt = 0; rt < 4; ++rt) xacc[q][rt] = (f32x4){0.f, 0.f, 0.f, 0.f};
#pragma unroll
                for (int ks = 0; ks < 2; ++ks) {
                    float sc8[8];
                    {
                        const f32x4 b0 = *(const f32x4*)(BETA + 32 * ks + 8 * fq), b1 = *(const f32x4*)(BETA + 32 * ks + 8 * fq + 4);
                        const f32x4 e0 = *(const f32x4*)(EG + 32 * ks + 8 * fq), e1 = *(const f32x4*)(EG + 32 * ks + 8 * fq + 4);
#pragma unroll
                        for (int e = 0; e < 4; ++e) { sc8[e] = isw ? b0[e] * e0[e] : b0[e]; sc8[4 + e] = isw ? b1[e] * e1[e] : b1[e]; }
                    }
#pragma unroll
                    for (int q = 0; q < 2; ++q) {
                        const int cc = ((2 * wave + q) & 7) * 16 + fr;
                        const float* src = QKVf + ((isw ? 64 : 128) + 32 * ks + 8 * fq) * QST + cc;
                        float v[8];
#pragma unroll
                        for (int e = 0; e < 8; ++e) v[e] = src[e * QST] * sc8[e];
                        u32x4 hq; hq.x = pk2(v[0], v[1]); hq.y = pk2(v[2], v[3]); hq.z = pk2(v[4], v[5]); hq.w = pk2(v[6], v[7]);
                        u32x4 lq; lq.x = pk2(v[0] - bflo(hq.x), v[1] - bfhi(hq.x)); lq.y = pk2(v[2] - bflo(hq.y), v[3] - bfhi(hq.y));
                        lq.z = pk2(v[4] - bflo(hq.z), v[5] - bfhi(hq.z)); lq.w = pk2(v[6] - bflo(hq.w), v[7] - bfhi(hq.w));
                        const bf16x8 Bh = __builtin_bit_cast(bf16x8, hq), Bl = __builtin_bit_cast(bf16x8, lq);
#pragma unroll
                        for (int rt = 0; rt < 4; ++rt) {
                            xacc[q][rt] = MFMA16(Ah[rt][ks], Bh, xacc[q][rt]);
                            xacc[q][rt] = MFMA16(Al[rt][ks], Bh, xacc[q][rt]);
                            xacc[q][rt] = MFMA16(Ah[rt][ks], Bl, xacc[q][rt]);
                        }
                    }
                }
                if (!isw) {
                    float* Uc = (float*)(ip + 57344);
#pragma unroll
                    for (int q = 0; q < 2; ++q)
#pragma unroll
                        for (int rt = 0; rt < 4; ++rt) *(f32x4*)(Uc + (size_t)((((2 * wave + q) * 4 + rt) * 64 + lane) * 4)) = xacc[q][rt];
                } else {
#pragma unroll
                    for (int q = 0; q < 2; ++q)
#pragma unroll
                        for (int rt = 0; rt < 4; ++rt)
#pragma unroll
                            for (int j = 0; j < 4; ++j) WSI[(16 * rt + 4 * fq + j) * NST + ((2 * wave + q) & 7) * 16 + fr] = f2bf(xacc[q][rt][j]);
                }
            }
        }
        __syncthreads();
        {
            bf16_t* Wf = (bf16_t*)ip; bf16_t* QKf = (bf16_t*)(ip + 49152);
#pragma unroll
            for (int i2 = 0; i2 < 2; ++i2) {
                const int f = tid + 512 * i2, ln = f & 63, ks = (f >> 6) & 3, rt = f >> 8, i = 16 * rt + (ln & 15), fq_ = ln >> 4;
                const u32x2 lo = *(const u32x2*)(WSI + i * NST + 32 * ks + 4 * fq_), hi = *(const u32x2*)(WSI + i * NST + 32 * ks + 16 + 4 * fq_);
                *(u32x4*)(Wf + (size_t)f * 8) = (u32x4){lo.x, lo.y, hi.x, hi.y};
            }
            {
                const int f = tid, ln = f & 63, ks2 = (f >> 6) & 1, rt = f >> 7, i = 16 * rt + (ln & 15), fq_ = ln >> 4;
                const u32x2 lo = *(const u32x2*)(QKS + i * QKST + 32 * ks2 + 4 * fq_), hi = *(const u32x2*)(QKS + i * QKST + 32 * ks2 + 16 + 4 * fq_);
                *(u32x4*)(QKf + (size_t)f * 8) = (u32x4){lo.x, lo.y, hi.x, hi.y};
            }
        }
    __syncthreads();
}

DI void gdn_prep_phase(const Params& p) {
    unsigned char* ws = p.ws;
    for (int r = blockIdx.x; r < MS; r += gridDim.x) {
        const int tid = opaque_tid(), b = r >> 5, t = r & 31, pos = PAST + t;
        const float* cs = (const float*)(ws + WS_CS1) + (size_t)r * NH1;
        if (t >= TS - 3) { for (int c = tid; c < 1536; c += 512) p.out[O_CQS + (size_t)(b * 3 + t - (TS - 3)) * 1536 + c] = cs[c]; }
        {
            const int which = tid >> 8, pr = tid & 255, hd = pr >> 6, mp = (pr >> 5) & 1, d = pr & 31, col = hd * 128 + mp * 64 + d;
            const float2 csn = ((const float2*)(ws + WS_ROPE))[pos * 32 + d];
            const float x1 = cs[2048 + which * 512 + col], x2 = cs[2048 + which * 512 + col + 32];
            const float y1 = x1 * csn.x - x2 * csn.y, y2 = x2 * csn.x + x1 * csn.y;
            if (which == 0) { const float qs = 0.125f * 1.4426950408889634f; bf16_t* QB = (bf16_t*)(ws + WS_R4) + ((size_t)MP + r) * 512; QB[col] = f2bf(y1 * qs); QB[col + 32] = f2bf(y2 * qs); }
            else { float* ko = p.out + O_KS + (size_t)r * 512; ko[col] = y1; ko[col + 32] = y2;
                   bf16_t* kk = (bf16_t*)(ws + WS_R5) + ((size_t)MP + (size_t)b * TKS + pos) * 512; kk[col] = f2bf(y1); kk[col + 32] = f2bf(y2); }
        }
        {
            const float vv = cs[3072 + tid];
            p.out[O_VS + (size_t)r * 512 + tid] = vv;
            ((bf16_t*)(ws + WS_R6))[VT_S_OFF + ((size_t)((b * 4 + (tid >> 7)) * 128 + (tid & 127)) * TKS + pos)] = f2bf(vv);
        }
    }
    for (int item = blockIdx.x; item < 2048; item += gridDim.x) gdn_prep_item(p, item);
}

constexpr int OPB_B = 57344, L_OBUF = 2 * OPB_B, OST = 132;
static_assert(L_OBUF + 64 * OST * 4 <= LDS_BYTES, "scan LDS");
DI void gdn_scan(const Params& p, const bool samp, const int b, const int h) {
    unsigned char* ws = p.ws;
    const int tid = threadIdx.x, lane = tid & 63, w = __builtin_amdgcn_readfirstlane(tid >> 6), fr = lane & 15, fq = lane >> 4;
    const int nsteps = samp ? 1 : 128, valid = samp ? TS : 64;
    float* OBUF = (float*)(dyn_smem + L_OBUF);
    const bf16_t* HG = (const bf16_t*)(ws + WS_R3);
    bf16_t* OMIX = (bf16_t*)(ws + WS_R2);
    const float* DL = (const float*)(ws + WS_DL);
    f32x4 S[8];
#pragma unroll
    for (int dt = 0; dt < 8; ++dt) {
        if (samp) {
#pragma unroll
            for (int j = 0; j < 4; ++j) S[dt][j] = p.state_gdn[((size_t)(b * 4 + h) * 128 + 16 * dt + 4 * fq + j) * 128 + 16 * w + fr];
        } else S[dt] = (f32x4){0.f, 0.f, 0.f, 0.f};
    }
    const int item0 = samp ? 2048 + b * 4 + h : b * 512 + h;
    __syncthreads();
    {
        const unsigned char* ip = ws + WS_R1 + (size_t)item0 * ITEM_B;
#pragma unroll
        for (int i = 0; i < 7; ++i) *(u32x4*)(dyn_smem + (tid + 512 * i) * 16) = *(const u32x4*)(ip + (tid + 512 * i) * 16);
    }
    __syncthreads();
    const int erow = tid >> 3, ept = tid & 7;
    float nw[16];
#pragma unroll
    for (int e = 0; e < 16; ++e) nw[e] = p.gdn_norm_w[16 * ept + e];
    f32x4 U[4]; float dl; u32x4 g0, g1;
    auto side_load = [&](int c, f32x4 (&Uo)[4], float& dlo, u32x4& go0, u32x4& go1) {
        const int item = item0 + 4 * c;
        const float* Uc = (const float*)(ws + WS_R1 + (size_t)item * ITEM_B + 57344);
#pragma unroll
        for (int rt = 0; rt < 4; ++rt) Uo[rt] = *(const f32x4*)(Uc + ((w * 4 + rt) * 64 + lane) * 4);
        dlo = DL[item];
        const size_t grow = (samp ? (size_t)MP + b * TS : (size_t)b * TP + (size_t)c * 64) + erow;
        if (!samp) { go0 = *(const u32x4*)(HG + grow * 512 + h * 128 + 16 * ept); go1 = *(const u32x4*)(HG + grow * 512 + h * 128 + 16 * ept + 8); }
        else if (erow < TS) { const float* gp = (const float*)(ws + WS_CS1) + (grow - MP) * NH1 + 1536 + h * 128 + 16 * ept;
               const f32x4 f0 = *(const f32x4*)gp, f1 = *(const f32x4*)(gp + 4), f2 = *(const f32x4*)(gp + 8), f3 = *(const f32x4*)(gp + 12);
               go0 = (u32x4){pk2(f0.x, f0.y), pk2(f0.z, f0.w), pk2(f1.x, f1.y), pk2(f1.z, f1.w)}; go1 = (u32x4){pk2(f2.x, f2.y), pk2(f2.z, f2.w), pk2(f3.x, f3.y), pk2(f3.z, f3.w)}; }
        else { go0 = (u32x4){0u, 0u, 0u, 0u}; go1 = go0; }
    };
    side_load(0, U, dl, g0, g1);
#pragma unroll 1
    for (int c = 0; c < nsteps; ++c) {
        const int item = item0 + 4 * c;
        const unsigned char* ip = ws + WS_R1 + (size_t)item * ITEM_B;
        const bool nxt = c + 1 < nsteps;
        u32x4 pf[7];
        f32x4 Un[4]; float dln = 0.f; u32x4 gn0 = g0, gn1 = g1;
        if (nxt) {
#pragma unroll
            for (int i = 0; i < 7; ++i) pf[i] = *(const u32x4*)(ip + 4 * (size_t)ITEM_B + (tid + 512 * i) * 16);
            side_load(c + 1, Un, dln, gn0, gn1);
        }
        const unsigned char* buf = dyn_smem + (c & 1) * OPB_B;
        bf16x8 Sb[4];
#pragma unroll
        for (int ks = 0; ks < 4; ++ks) Sb[ks] = pack8(S[2 * ks], S[2 * ks + 1]);
        f32x4 vn[4];
#pragma unroll
        for (int rt = 0; rt < 4; ++rt) {
            f32x4 acc = (f32x4){0.f, 0.f, 0.f, 0.f};
#pragma unroll
            for (int ks = 0; ks < 4; ++ks) acc = MFMA16(*(const bf16x8*)(buf + ((rt * 4 + ks) * 64 + lane) * 16), Sb[ks], acc);
            vn[rt] = U[rt] - acc;
        }
        bf16x8 Vb[2];
        Vb[0] = pack8(vn[0], vn[1]); Vb[1] = pack8(vn[2], vn[3]);
#pragma unroll
        for (int rt = 0; rt < 4; ++rt) {
            f32x4 acc = (f32x4){0.f, 0.f, 0.f, 0.f};
#pragma unroll
            for (int ks = 0; ks < 4; ++ks) acc = MFMA16(*(const bf16x8*)(buf + 16384 + ((rt * 4 + ks) * 64 + lane) * 16), Sb[ks], acc);
#pragma unroll
            for (int ks2 = 0; ks2 < 2; ++ks2) acc = MFMA16(*(const bf16x8*)(buf + 49152 + ((rt * 2 + ks2) * 64 + lane) * 16), Vb[ks2], acc);
#pragma unroll
            for (int j = 0; j < 4; ++j) OBUF[(16 * rt + 4 * fq + j) * OST + 16 * w + fr] = acc[j];
        }
#pragma unroll
        for (int dt = 0; dt < 8; ++dt) {
            f32x4 acc = S[dt] * dl;
#pragma unroll
            for (int ks2 = 0; ks2 < 2; ++ks2) acc = MFMA16(*(const bf16x8*)(buf + 32768 + ((dt * 2 + ks2) * 64 + lane) * 16), Vb[ks2], acc);
            S[dt] = acc;
        }
        if (nxt) {
#pragma unroll
            for (int i = 0; i < 7; ++i) *(u32x4*)(dyn_smem + ((c + 1) & 1) * OPB_B + (tid + 512 * i) * 16) = pf[i];
        }
        __syncthreads();
        {
            float o[16]; float ss = 0.f;
#pragma unroll
            for (int e4 = 0; e4 < 4; ++e4) { const f32x4 a = *(const f32x4*)(OBUF + erow * OST + 16 * ept + 4 * e4);
#pragma unroll
                for (int e = 0; e < 4; ++e) { o[4 * e4 + e] = a[e]; ss += a[e] * a[e]; } }
#pragma unroll
            for (int of = 1; of < 8; of <<= 1) ss += __shfl_xor(ss, of);
            if (erow < valid) {
                const float r = rsqrtf(ss * (1.f / 128.f) + 1e-6f);
                const size_t grow = (samp ? (size_t)MP + b * TS : (size_t)b * TP + (size_t)c * 64) + erow;
                const unsigned gw[8] = {g0.x, g0.y, g0.z, g0.w, g1.x, g1.y, g1.z, g1.w};
                unsigned ow[8];
#pragma unroll
                for (int e = 0; e < 8; ++e) {
                    const float ga = bflo(gw[e]), gb = bfhi(gw[e]);
                    ow[e] = pk2(o[2 * e] * r * nw[2 * e] * silu(ga), o[2 * e + 1] * r * nw[2 * e + 1] * silu(gb));
                }
                *(u32x4*)(OMIX + grow * 1024 + h * 128 + 16 * ept) = (u32x4){ow[0], ow[1], ow[2], ow[3]};
                *(u32x4*)(OMIX + grow * 1024 + h * 128 + 16 * ept + 8) = (u32x4){ow[4], ow[5], ow[6], ow[7]};
            }
        }
        __syncthreads();
#pragma unroll
        for (int rt = 0; rt < 4; ++rt) U[rt] = Un[rt];
        dl = dln; g0 = gn0; g1 = gn1;
    }
    float* So = p.out + (samp ? O_GS : O_GP) + (size_t)(b * 4 + h) * 128 * 128;
#pragma unroll
    for (int dt = 0; dt < 8; ++dt)
#pragma unroll
        for (int j = 0; j < 4; ++j) So[(size_t)(16 * dt + 4 * fq + j) * 128 + 16 * w + fr] = S[dt][j];
}

constexpr int L_KT = 0, L_VT = 2 * 16384, L_ALX = L_VT + 3 * 16384, L_IDX = L_ALX + 8 * 2 * 32 * 4, L_QF = L_IDX + 256;
static_assert(L_QF + 8 * 8 * 1024 <= LDS_BYTES, "attn LDS");
DI int crow32(int i, int hh) { return (i & 3) + 8 * (i >> 2) + 4 * hh; }

DI void attn_item(const Params& p, const int idx, const float* lamp) {
    unsigned char* ws = p.ws;
    const int tid = opaque_tid(), lane = tid & 63, w = __builtin_amdgcn_readfirstlane(tid >> 6), r = lane & 31, hh = lane >> 5;
    bool samp; int b, h, qb = 0, ntiles, lastw; size_t qbase, kbase; const bf16_t* vtb; int vstride; bool active;
    if (idx < 32) { samp = true; b = idx >> 2; h = idx & 3; qbase = (size_t)MP + b * TS; kbase = (size_t)MP + (size_t)b * TKS; ntiles = 65; lastw = 64; active = w == 0;
                    vtb = (const bf16_t*)(ws + WS_R6) + VT_S_OFF + (size_t)((b * 4 + h) * 128) * TKS; vstride = TKS; }
    else { const int j = idx - 32; samp = false; qb = 31 - (j >> 4); b = (j & 15) >> 2; h = j & 3; qbase = (size_t)b * TP + qb * 256; kbase = (size_t)b * TP; ntiles = 4 * qb + 4; lastw = 4 * qb + (w >> 1); active = true;
           vtb = (const bf16_t*)(ws + WS_R6) + (size_t)((b * 4 + h) * 128) * TP; vstride = TP; }
    const bf16_t* KALL = (const bf16_t*)(ws + WS_R5) + kbase * 512 + h * 128;
    bf16_t* QF = (bf16_t*)(dyn_smem + L_QF) + w * 8 * 64 * 8;
    {
        const bf16_t* qp = (const bf16_t*)(ws + WS_R4) + (qbase + 32 * w + r) * 512 + h * 128 + 8 * hh;
        if (active) {
#pragma unroll
            for (int f = 0; f < 8; ++f) *(u32x4*)(QF + (f * 64 + lane) * 8) = *(const u32x4*)(qp + (f >> 2) * 64 + 16 * (f & 3));
        }
    }
    f32x16 O1[4], O2[4];
#pragma unroll
    for (int t = 0; t < 4; ++t)
#pragma unroll
        for (int i = 0; i < 16; ++i) { O1[t][i] = 0.f; O2[t][i] = 0.f; }
    float m1 = -1e30f, m2 = -1e30f, l1 = 0.f, l2 = 0.f;
    auto stage_tile = [&](int kt_, int buf_, int vbuf_) {
        int ln = lane; asm volatile("" : "+v"(ln));
        const int krow_ = ln >> 4, vrow_ = ln >> 3;
        const unsigned kx = (ln & 15) ^ krow_, vx = (ln & 7) ^ (vrow_ >> 1);
        const unsigned klane = krow_ * 512, vlane = vrow_ * vstride;
#pragma unroll
        for (int j = 0; j < 2; ++j) {
            const int i = 2 * w + j;
            const bf16_t* kbase = KALL + ((size_t)kt_ * 64 + (((4 * i) & ~12) | (((4 * i) & 4) << 1) | (((4 * i) & 8) >> 1))) * 512;
            const bf16_t* vbase = vtb + (size_t)(8 * i) * vstride + (size_t)kt_ * 64;
            const unsigned ko = klane + ((kx ^ ((4 * i) & 15)) * 8), vo = vlane + ((vx ^ ((4 * i) & 7)) * 8);
            __builtin_amdgcn_global_load_lds((const unsigned*)(kbase + ko), (unsigned*)(dyn_smem + L_KT + buf_ * 16384 + i * 1024 + ln * 16), 16, 0, 0);
            __builtin_amdgcn_global_load_lds((const unsigned*)(vbase + vo), (unsigned*)(dyn_smem + L_VT + vbuf_ * 16384 + i * 1024 + ln * 16), 16, 0, 0);
        }
    };
    const int ky = hh ^ (r & 15), vzh = ((r >> 1) & 7) ^ hh;
    __syncthreads();
    stage_tile(0, 0, 0);
    asm volatile("s_waitcnt vmcnt(0)" ::: "memory");
    __syncthreads();
    if (active) {
#pragma unroll
        for (int mp = 0; mp < 2; ++mp) {
            float mx = -1e30f;
#pragma unroll
            for (int sub = 0; sub < 2; ++sub) {
                f32x16 sc;
#pragma unroll
                for (int i = 0; i < 16; ++i) sc[i] = 0.f;
#pragma unroll
                for (int s = 0; s < 4; ++s) {
                    const bf16x8 ka = *(const bf16x8*)(dyn_smem + L_KT + (sub * 32 + r) * 256 + (((mp * 8 + 2 * s) ^ ky) * 16));
                    const bf16x8 qf = *(const bf16x8*)(QF + ((mp * 4 + s) * 64 + lane) * 8);
                    sc = MFMA32(ka, qf, sc);
                }
#pragma unroll
                for (int i = 0; i < 16; ++i) mx = fmaxf(mx, sc[i]);
            }
            const auto sw = __builtin_amdgcn_permlane32_swap(__float_as_uint(mx), __float_as_uint(mx), false, false);
            mx = fmaxf(__uint_as_float(sw[0]), __uint_as_float(sw[1]));
            if (mp == 0) m1 = mx; else m2 = mx;
        }
    }
    const bool roleY = w >= 4;
    bf16x8 PA[2], PB[2];
    float tm1 = -1e30f, tm2 = -1e30f;
    int vcur = 0, vprev = 2;
#define ATT_QK(SUB, MP, SC) do { \
        _Pragma("unroll") for (int s_ = 0; s_ < 4; ++s_) { \
            const bf16x8 ka_ = *(const bf16x8*)(Kb + (SUB) * 32 * 256 + ((((MP) * 8 + 2 * s_) ^ ky) * 16)); \
            const bf16x8 qf_ = *(const bf16x8*)(QF + (((MP) * 4 + s_) * 64 + lane) * 8); \
            SC = MFMA32(ka_, qf_, s_ == 0 ? zero16 : SC); } } while (0)
#define ATT_SM(SC, P, MM, LL, TM, MSK) do { \
        float ps_ = 0.f, tq_ = TM; const float mr_ = MM + MSK; \
        _Pragma("unroll") for (int i_ = 0; i_ < 16; ++i_) { tq_ = fmaxf(tq_, SC[i_]); SC[i_] = __builtin_amdgcn_exp2f(SC[i_] - mr_); ps_ += SC[i_]; } \
        TM = MSK != 0.f ? TM : tq_; \
        LL += ps_; \
        _Pragma("unroll") for (int sp_ = 0; sp_ < 2; ++sp_) { \
            u32x4 a_; a_.x = pk2(SC[8 * sp_], SC[8 * sp_ + 1]); a_.y = pk2(SC[8 * sp_ + 2], SC[8 * sp_ + 3]); a_.z = pk2(SC[8 * sp_ + 4], SC[8 * sp_ + 5]); a_.w = pk2(SC[8 * sp_ + 6], SC[8 * sp_ + 7]); \
            P[sp_] = __builtin_bit_cast(bf16x8, a_); } } while (0)
#define ATT_PV2(VB, SUB, P1, P2) do { \
        _Pragma("unroll") for (int sp_ = 0; sp_ < 2; ++sp_) \
            _Pragma("unroll") for (int t_ = 0; t_ < 4; ++t_) { \
                const bf16x8 vb_ = *(const bf16x8*)((VB) + t_ * 32 * 128 + (((4 * (SUB) + 2 * sp_) ^ vzh) * 16)); \
                O1[t_] = MFMA32(P1[sp_], vb_, O1[t_]); O2[t_] = MFMA32(P2[sp_], vb_, O2[t_]); } } while (0)
#define ATT_QS(SUB, MSK) do { \
        f32x16 scA, scB; \
        ATT_QK(SUB, 0, scA); \
        __builtin_amdgcn_sched_barrier(0); \
        ATT_QK(SUB, 1, scB); \
        ATT_SM(scA, PA, m1, l1, tm1, MSK); \
        __builtin_amdgcn_sched_barrier(0); \
        ATT_SM(scB, PB, m2, l2, tm2, MSK); \
        __builtin_amdgcn_sched_barrier(0); } while (0)
#define ATT_CHECK() do { \
        const auto s1_ = __builtin_amdgcn_permlane32_swap(__float_as_uint(tm1), __float_as_uint(tm1), false, false); tm1 = fmaxf(__uint_as_float(s1_[0]), __uint_as_float(s1_[1])); \
        const auto s2_ = __builtin_amdgcn_permlane32_swap(__float_as_uint(tm2), __float_as_uint(tm2), false, false); tm2 = fmaxf(__uint_as_float(s2_[0]), __uint_as_float(s2_[1])); \
        const float n1 = tm1 > m1 + 8.f ? tm1 : m1, n2 = tm2 > m2 + 8.f ? tm2 : m2; \
        if (__any((n1 != m1) || (n2 != m2))) { \
            const float al1 = __builtin_amdgcn_exp2f(m1 - n1), al2 = __builtin_amdgcn_exp2f(m2 - n2); \
            l1 *= al1; l2 *= al2; m1 = n1; m2 = n2; \
            const int ln_ = __builtin_amdgcn_mbcnt_hi(~0u, __builtin_amdgcn_mbcnt_lo(~0u, 0u)), r_ = ln_ & 31, hh_ = ln_ >> 5; \
            float* alx_ = (float*)(dyn_smem + L_ALX) + w * 64; \
            if (hh_ == 0) { alx_[r_] = al1; alx_[32 + r_] = al2; } \
            asm volatile("s_waitcnt lgkmcnt(0)" ::: "memory"); \
            _Pragma("unroll") for (int g = 0; g < 4; ++g) { \
                const f32x4 a1 = *(const f32x4*)(alx_ + 8 * g + 4 * hh_), a2 = *(const f32x4*)(alx_ + 32 + 8 * g + 4 * hh_); \
                _Pragma("unroll") for (int t = 0; t < 4; ++t) \
                    _Pragma("unroll") for (int j = 0; j < 4; ++j) { O1[t][4 * g + j] *= a1[j]; O2[t][4 * g + j] *= a2[j]; } } \
            asm volatile("s_waitcnt lgkmcnt(0)" ::: "memory"); } \
        tm1 = -1e30f; tm2 = -1e30f; } while (0)
    f32x16 zero16;
#pragma unroll
    for (int i = 0; i < 16; ++i) zero16[i] = 0.f;
    if (!roleY) {
#pragma unroll 1
        for (int kt = 0; kt < ntiles; ++kt) {
            const int vnext = vcur == 2 ? 0 : vcur + 1;
            if (kt + 1 < ntiles) stage_tile(kt + 1, (kt + 1) & 1, vnext);
            const unsigned char* Kb = dyn_smem + L_KT + (kt & 1) * 16384 + r * 256;
            const unsigned char* Vb = dyn_smem + L_VT + vcur * 16384 + r * 128;
            if (active && kt <= lastw) {
                const float msk1 = (samp && kt == 64) ? 1e30f : 0.f;
#pragma unroll 1
                for (int sub = 0; sub < 2; ++sub) {
                    const float msk = sub ? msk1 : 0.f;
                    ATT_QS(sub, msk);
                    ATT_PV2(Vb, sub, PA, PB);
                    __builtin_amdgcn_sched_barrier(0);
                }
                ATT_CHECK();
            }
            vcur = vnext;
            asm volatile("s_waitcnt vmcnt(0)" ::: "memory");
            __builtin_amdgcn_s_barrier();
        }
    } else {
#pragma unroll 1
        for (int kt = 0; kt < ntiles; ++kt) {
            const int vnext = vcur == 2 ? 0 : vcur + 1;
            if (kt + 1 < ntiles) stage_tile(kt + 1, (kt + 1) & 1, vnext);
            const unsigned char* Kb = dyn_smem + L_KT + (kt & 1) * 16384 + r * 256;
            const unsigned char* Vb = dyn_smem + L_VT + vcur * 16384 + r * 128;
            const unsigned char* Vp = dyn_smem + L_VT + vprev * 16384 + r * 128;
            if (kt <= lastw + 1) {
                if (kt > 0) { ATT_PV2(Vp, 1, PA, PB); __builtin_amdgcn_sched_barrier(0); }
                if (kt <= lastw) {
                    ATT_CHECK();
                    ATT_QS(0, 0.f);
                    ATT_PV2(Vb, 0, PA, PB);
                    __builtin_amdgcn_sched_barrier(0);
                    ATT_QS(1, 0.f);
                }
            }
            vprev = vcur; vcur = vnext;
            asm volatile("s_waitcnt vmcnt(0)" ::: "memory");
            __builtin_amdgcn_s_barrier();
        }
        if (lastw == ntiles - 1) {
            const unsigned char* Vp = dyn_smem + L_VT + vprev * 16384 + r * 128;
            ATT_PV2(Vp, 1, PA, PB);
        }
    }
    if (active) {
        const int lnf = __builtin_amdgcn_mbcnt_hi(~0u, __builtin_amdgcn_mbcnt_lo(~0u, 0u)), r = lnf & 31, hh = lnf >> 5;
        float* ALX = (float*)(dyn_smem + L_ALX) + w * 64;
        { const auto s1_ = __builtin_amdgcn_permlane32_swap(__float_as_uint(l1), __float_as_uint(l1), false, false); l1 = __uint_as_float(s1_[0]) + __uint_as_float(s1_[1]);
          const auto s2_ = __builtin_amdgcn_permlane32_swap(__float_as_uint(l2), __float_as_uint(l2), false, false); l2 = __uint_as_float(s2_[0]) + __uint_as_float(s2_[1]); }
        if (hh == 0) { ALX[r] = __builtin_amdgcn_rcpf(l1); ALX[32 + r] = *lamp * __builtin_amdgcn_rcpf(l2); }
        asm volatile("s_waitcnt lgkmcnt(0)" ::: "memory");
        float ss[16], a1[16], a2[16];
#pragma unroll
        for (int g = 0; g < 4; ++g) {
            const f32x4 x1 = *(const f32x4*)(ALX + 8 * g + 4 * hh), x2 = *(const f32x4*)(ALX + 32 + 8 * g + 4 * hh);
#pragma unroll
            for (int j = 0; j < 4; ++j) { a1[4 * g + j] = x1[j]; a2[4 * g + j] = x2[j]; ss[4 * g + j] = 0.f; }
        }
#pragma unroll
        for (int t = 0; t < 4; ++t) {
            __builtin_amdgcn_sched_barrier(0);
#pragma unroll
            for (int i = 0; i < 16; ++i) { const float o = O1[t][i] * a1[i] - O2[t][i] * a2[i]; O1[t][i] = o; ss[i] += o * o; }
        }
        __builtin_amdgcn_sched_barrier(0);
#pragma unroll
        for (int i = 0; i < 16; ++i) {
#pragma unroll
            for (int of = 1; of < 32; of <<= 1) ss[i] += __shfl_xor(ss[i], of);
            ss[i] = __builtin_amdgcn_rsqf(ss[i] * (1.f / 128.f) + 1e-6f) * (1.f - LAM_INIT);
        }
        int zo = 0; asm volatile("" : "+v"(zo));
        bf16_t* obase = (bf16_t*)(ws + WS_R2) + (qbase + 32 * w) * 1024 + 512 + h * 128;
        const unsigned ooff = (unsigned)((4 * hh + zo) * 1024 + r);
        const float* sw = p.subln_w + r + zo;
#pragma unroll
        for (int t = 0; t < 4; ++t) {
            const float wv = sw[32 * t];
#pragma unroll
            for (int i = 0; i < 16; ++i) obase[ooff + ((i & 3) + 8 * (i >> 2)) * 1024 + 32 * t] = f2bf(O1[t][i] * ss[i] * wv);
        }
    }
}

DI void mixer_phase(const Params& p) {
    const int bid = blockIdx.x;
#ifndef NO_SCAN
    if (bid >= 16 && bid < 48) {
        gdn_prep_item(p, 2048 + bid - 16);
        asm volatile("s_waitcnt vmcnt(0)" ::: "memory");
        __builtin_amdgcn_fence(__ATOMIC_ACQUIRE, "agent");
        asm volatile("s_waitcnt vmcnt(0)" ::: "memory");
        __syncthreads();
    }
    if (bid < 48) { const bool sm = bid >= 16; const int j = sm ? bid - 16 : bid;
#pragma unroll 1
        for (int rep = 0; rep < SREP; ++rep) gdn_scan(p, sm, j >> 2, j & 3); }
#endif
    unsigned* ctl = (unsigned*)(p.ws + WS_CTL);
    int* sidx = (int*)(dyn_smem + L_IDX);
    for (;;) {
        __syncthreads();
        if (threadIdx.x == 0) *sidx = (int)atomicAdd(ctl, 1u);
        __syncthreads();
        const int idx0 = __builtin_amdgcn_readfirstlane(*sidx);
        if (idx0 >= (32 + 512) * AREP) break;
        const int idx = idx0 % (32 + 512);
#ifndef NO_ATTN
        attn_item(p, idx, (const float*)ctl + 1);
#endif
    }
}


#define XB_TMO      128
#define XB_XCNT(j)  (256  + 64 * (j))
#define XB_XSUB(j)  (1280 + 64 * (j))
#define XB_XGEN(j)  (2304 + 64 * (j))
#define XB_TOP      3328
#define XB_TOPGEN   3392
#define XCD_BAR_WORDS 3456
#define XB_SPIN_CAP (1u << 20)
#define LAS __attribute__((address_space(3)))
DI unsigned xb_ld(unsigned* p) { return __hip_atomic_load(p, __ATOMIC_RELAXED, __HIP_MEMORY_SCOPE_AGENT); }
DI unsigned xb_add(unsigned* p, unsigned v) { return __hip_atomic_fetch_add(p, v, __ATOMIC_RELAXED, __HIP_MEMORY_SCOPE_AGENT); }
DI unsigned xb_xcc_id() { return (unsigned)__builtin_amdgcn_s_getreg((3 << 11) | 20) & 0xFu; }
#define XB_SPIN(cond, bar) do { unsigned _sp = 0; while (cond) { __builtin_amdgcn_s_sleep(1); \
    if ((++_sp & 255u) == 0u) { if (xb_ld(&(bar)[XB_TMO])) break; if (_sp > XB_SPIN_CAP) { atomicAdd(&(bar)[XB_TMO], 1u); break; } } } } while (0)
struct XcdBarrier { unsigned* bar; unsigned x; volatile LAS unsigned* st; };
DI XcdBarrier xcd_barrier_post(unsigned* bar, volatile LAS unsigned* st) {
    XcdBarrier b; b.bar = bar; b.x = xb_xcc_id(); b.st = st;
    if (threadIdx.x == 0) (void)xb_add(&bar[XB_XCNT(b.x)], 1u);
    return b;
}
DI void xcd_barrier_complete(unsigned* bar, unsigned x, unsigned& nloc, unsigned& nx) {
    const unsigned G = gridDim.x * gridDim.y * gridDim.z;
    unsigned sum, cnt, mine, sp = 0u;
    for (;;) {
        sum = 0u; cnt = 0u; mine = 0u;
#pragma unroll
        for (unsigned j = 0; j < 16; ++j) { const unsigned c = xb_ld(&bar[XB_XCNT(j)]); sum += c; cnt += (c > 0u) ? 1u : 0u; mine = (j == x) ? c : mine; }
        if (sum == G) break;
        __builtin_amdgcn_s_sleep(1);
        if ((++sp & 255u) == 0u) { if (xb_ld(&bar[XB_TMO])) break; if (sp > XB_SPIN_CAP) { atomicAdd(&bar[XB_TMO], 1u); break; } }
    }
    nloc = mine > 0u ? mine : 1u; nx = cnt > 0u ? cnt : 1u;
}
DI void xcd_barrier(const XcdBarrier& b) {
    asm volatile("s_waitcnt vmcnt(0)" ::: "memory");
    __syncthreads();
    if (threadIdx.x == 0) {
        unsigned* bar = b.bar;
        __builtin_amdgcn_s_waitcnt(0);
        unsigned nloc = b.st[0], nx = b.st[1];
        if (nloc == 0u) { xcd_barrier_complete(bar, b.x, nloc, nx); b.st[0] = nloc; b.st[1] = nx; }
        const unsigned old = xb_add(&bar[XB_XSUB(b.x)], 1u);
        const unsigned gen = old / nloc;
        if (old + 1u == (gen + 1u) * nloc) {
            __builtin_amdgcn_fence(__ATOMIC_RELEASE, "agent");
            asm volatile("s_waitcnt vmcnt(0)" ::: "memory");
            const unsigned og = xb_add(&bar[XB_TOP], 1u);
            const unsigned tg = og / nx;
            if (og + 1u == (tg + 1u) * nx) xb_add(&bar[XB_TOPGEN], 1u);
            else XB_SPIN(xb_ld(&bar[XB_TOPGEN]) == tg, bar);
            __builtin_amdgcn_fence(__ATOMIC_ACQUIRE, "agent");
            xb_add(&bar[XB_XGEN(b.x)], 1u);
            asm volatile("s_waitcnt vmcnt(0)" ::: "memory");
        } else {
            XB_SPIN(xb_ld(&bar[XB_XGEN(b.x)]) == gen, bar);
            __builtin_amdgcn_fence(__ATOMIC_ACQUIRE, "agent");
            asm volatile("s_waitcnt vmcnt(0)" ::: "memory");
        }
    }
    __syncthreads();
}

__global__ void __launch_bounds__(512, 2) fwd_kernel(Params p) {
    cg::grid_group grid = cg::this_grid();
    volatile LAS unsigned* xst = (volatile LAS unsigned*)(dyn_smem + LDS_BYTES - 16);
    if (threadIdx.x == 0) { xst[0] = 0u; xst[1] = 0u; }
    __syncthreads();
    const XcdBarrier xb = xcd_barrier_post((unsigned*)(p.ws + WS_BAR), xst);
    if (p.phase_lo > 1000) grid.sync();
    const bool all = p.phase_hi - p.phase_lo > 1;
#define PHASE(i, body) if (p.phase_lo <= (i) && (i) < p.phase_hi) { body; if (all && (i) + 1 < p.phase_hi) xcd_barrier(xb); }
    PHASE(0, phase_prep(p))
    PHASE(1, gemm_phase<1>(p))
    PHASE(2, gdn_prep_phase(p))
    PHASE(3, mixer_phase(p))
    PHASE(4, gemm_phase<2>(p))
    PHASE(5, ln_phase<0>(p))
    PHASE(6, gemm_phase<3>(p))
    PHASE(7, fixup_phase(p))
    PHASE(8, gemm_phase<4>(p))
    PHASE(9, ln_phase<1>(p))
}

extern "C" void kernel_launch(void* const* d_in, const int* in_sizes, int n_in, void* d_out, int out_size, void* d_ws, size_t ws_size, hipStream_t stream) {
    static int grid = 0;
    if (grid == 0) {
        if (n_in != 23 || (size_t)out_size != O_END || ws_size < WS_END2) { fprintf(stderr, "kernel_launch: unexpected sizes n_in %d out %d ws %zu (need %zu)\n", n_in, out_size, ws_size, (size_t)WS_END2); grid = -1; return; }
        int dev = 0, cus = 0, per_cu = 0;
        hipGetDevice(&dev);
        hipDeviceGetAttribute(&cus, hipDeviceAttributeMultiprocessorCount, dev);
        if (hipFuncSetAttribute((const void*)fwd_kernel, hipFuncAttributeMaxDynamicSharedMemorySize, LDS_BYTES) != hipSuccess) { fprintf(stderr, "kernel_launch: hipFuncSetAttribute failed\n"); grid = -1; return; }
        hipOccupancyMaxActiveBlocksPerMultiprocessor(&per_cu, (const void*)fwd_kernel, 512, LDS_BYTES);
        if (per_cu < 1) { fprintf(stderr, "kernel_launch: occupancy query says %d\n", per_cu); per_cu = 1; }
        (void)hipGetLastError();
        grid = cus * 1;
    }
    if (grid < 0) return;
    Params p{};
    const float** f = (const float**)&p;
    for (int i = 0; i < 23; ++i) f[i] = (const float*)d_in[i];
    p.out = (float*)d_out; p.ws = (unsigned char*)d_ws; p.phase_lo = 0; p.phase_hi = 10;
    if (hipMemsetAsync((unsigned char*)d_ws + WS_BAR, 0, 16384, stream) != hipSuccess) { fprintf(stderr, "kernel_launch: memset failed\n"); return; }
    void* args[] = {&p};
    hipError_t e = hipLaunchCooperativeKernel((const void*)fwd_kernel, dim3(grid), dim3(512), args, LDS_BYTES, stream);
    if (e != hipSuccess) fprintf(stderr, "cooperative launch failed: %s (grid %d)\n", hipGetErrorString(e), grid);
}
```

```cpp
#include <hip/hip_runtime.h>
#include <hip/hip_cooperative_groups.h>
#include <cstdio>
namespace cg = cooperative_groups;
#ifndef GREP_WHICH
#define GREP_WHICH 0
#endif
#ifndef AREP
#define AREP 1
#endif
#ifndef SREP
#define SREP 1
#endif

typedef unsigned short bf16_t;
typedef short bf16x8 __attribute__((ext_vector_type(8)));
typedef short s16x4 __attribute__((ext_vector_type(4)));
typedef float f32x4 __attribute__((ext_vector_type(4)));
typedef float f32x16 __attribute__((ext_vector_type(16)));
typedef unsigned u32x4 __attribute__((ext_vector_type(4)));
typedef unsigned u32x2 __attribute__((ext_vector_type(2)));
#define DI __device__ __forceinline__

constexpr int D = 1024, TP = 8192, BP = 4, MP = BP * TP, BS = 8, TS = 32, MS = BS * TS, M = MP + MS, PAST = 4096;
constexpr int DIN = 3592, NH1 = 3584, DFF = 2816, NUP = 2 * DFF;
constexpr int TKS = 4160;
constexpr int NITEM = BP * 128 * 4 + BS * 4;
constexpr int ITEM_B = 90112;
constexpr int LDS_BYTES = 160 * 1024;
constexpr float ALPHA = 1.189207115002721f;
constexpr float LAM_INIT = 0.2f;

constexpr size_t O_Y = 0, O_KP = 33816576, O_VP = 50593792, O_GP = 67371008, O_CQP = 67633152, O_CFP = 67651584,
                 O_KS = 67696640, O_VS = 67827712, O_GS = 67958784, O_CQS = 68483072, O_CFS = 68519936, O_END = 68610048;

constexpr size_t al256(size_t x) { return (x + 255) & ~(size_t)255; }
constexpr size_t WS_CTL = 0;
constexpr size_t WS_ROPE = 4096;
constexpr size_t WS_AB = WS_ROPE + (size_t)8192 * 32 * 8;
constexpr size_t WS_DL = WS_AB + (size_t)M * 8 * 4;
constexpr size_t WS_WIN = al256(WS_DL + NITEM * 4);
constexpr size_t WS_WO = WS_WIN + (size_t)NH1 * D * 2;
constexpr size_t WS_WUP = WS_WO + (size_t)D * D * 2;
constexpr size_t WS_WDN = WS_WUP + (size_t)NUP * D * 2;
constexpr size_t WS_R1 = al256(WS_WDN + (size_t)D * DFF * 2);
constexpr size_t R1_SIZE = (size_t)NITEM * ITEM_B;
constexpr size_t WS_R2 = al256(WS_R1 + R1_SIZE);
constexpr size_t WS_R3 = al256(WS_R2 + (size_t)M * 1536 * 2);
constexpr size_t WS_R4 = WS_R3 + (size_t)M * 512 * 2;
constexpr size_t WS_R5 = al256(WS_R4 + (size_t)M * 512 * 2);
constexpr size_t KROWS = (size_t)MP + (size_t)BS * TKS;
constexpr size_t WS_R6 = al256(WS_R5 + KROWS * 512 * 2);
constexpr size_t VT_S_OFF = (size_t)BP * 4 * 128 * TP;
constexpr size_t WS_END = al256(WS_R6 + (VT_S_OFF + (size_t)BS * 4 * 128 * TKS) * 2);
constexpr size_t WS_CS1 = WS_END;
constexpr size_t WS_CS2 = WS_CS1 + (size_t)MS * NH1 * 4;
constexpr size_t WS_CS3 = WS_CS2 + (size_t)MS * D * 4;
constexpr size_t WS_CS4 = WS_CS3 + (size_t)MS * NUP * 4;
constexpr size_t WS_BAR = WS_CS4 + (size_t)MS * D * 4;
constexpr size_t WS_END2 = WS_BAR + 16384;
static_assert((size_t)M * DFF * 2 <= R1_SIZE, "GT must fit R1");
static_assert(WS_END2 <= (size_t)536870912, "workspace too large");

struct Params {
    const float *x_p, *x_s, *cache_k, *cache_v, *state_gdn, *state_cq, *state_cf;
    const float *w_in, *gdn_conv_w, *a_log, *dt_bias, *gdn_norm_w, *diff_lambda, *subln_w, *w_o, *ln1_g, *ln1_b, *w_up,
        *ffn_conv_w, *ffn_conv_b, *w_down, *ln2_g, *ln2_b;
    float* out; unsigned char* ws;
    int phase_lo, phase_hi;
};

extern __shared__ __attribute__((aligned(16))) unsigned char dyn_smem[];

typedef __bf16 bf16x2_t __attribute__((ext_vector_type(2)));
typedef float f32x2 __attribute__((ext_vector_type(2)));
DI unsigned pk2(float lo, float hi) { f32x2 v = {lo, hi}; bf16x2_t b = __builtin_convertvector(v, bf16x2_t); return __builtin_bit_cast(unsigned, b); }
DI bf16_t f2bf(float x) { return (bf16_t)(pk2(x, 0.f) & 0xffffu); }
DI float bf2f(bf16_t b) { return __uint_as_float(((unsigned)b) << 16); }
DI float bflo(unsigned u) { return __uint_as_float(u << 16); }
DI float bfhi(unsigned u) { return __uint_as_float(u & 0xffff0000u); }
DI float silu(float x) { return x * __builtin_amdgcn_rcpf(1.f + __expf(-x)); }
DI int opaque_tid() { int t = threadIdx.x; asm volatile("" : "+v"(t)); return t; }
DI float wave_sum(float v) {
#pragma unroll
    for (int o = 1; o < 64; o <<= 1) v += __shfl_xor(v, o);
    return v;
}
DI const float* xrow_ptr(const Params& p, int row) { return row < MP ? p.x_p + (size_t)row * D : p.x_s + (size_t)(row - MP) * D; }

template <int MODE> DI int srccol(int n) {
    if (MODE == 1) {
        if (n < 2048) return n;
        return n + 8;
    }
    if (MODE == 2) { const int pn = n >> 8, j = n & 255; return j < 128 ? 128 * pn + j : DFF + 128 * pn + (j - 128); }
    return n;
}
struct TrItem { const float* W; bf16_t* WT; int K, N, k0, n0, mode; };
DI TrItem tr_decode(const Params& p, int it) {
    constexpr int I_IN = 16 * 56, I_O = 16 * 16, I_UP = 16 * 88;
    unsigned char* ws = p.ws; TrItem t; int r = it;
    if (r < I_IN) { t.W = p.w_in; t.WT = (bf16_t*)(ws + WS_WIN); t.K = D; t.N = DIN; t.k0 = (r / 56) * 64; t.n0 = (r % 56) * 64; t.mode = 1; return t; } r -= I_IN;
    if (r < I_O) { t.W = p.w_o; t.WT = (bf16_t*)(ws + WS_WO); t.K = D; t.N = D; t.k0 = (r / 16) * 64; t.n0 = (r % 16) * 64; t.mode = 0; return t; } r -= I_O;
    if (r < I_UP) { t.W = p.w_up; t.WT = (bf16_t*)(ws + WS_WUP); t.K = D; t.N = NUP; t.k0 = (r / 88) * 64; t.n0 = (r % 88) * 64; t.mode = 2; return t; } r -= I_UP;
    t.W = p.w_down; t.WT = (bf16_t*)(ws + WS_WDN); t.K = DFF; t.N = D; t.k0 = (r / 16) * 64; t.n0 = (r % 16) * 64; t.mode = 0; return t;
}
DI void tr_load(const TrItem& t, float (&v)[8]) {
    const int tid = threadIdx.x, n = t.n0 + (tid & 63);
    const int sc = t.mode == 1 ? (n < 2048 ? n : n + 8) : (t.mode == 2 ? srccol<2>(n) : n);
#pragma unroll
    for (int i = 0; i < 8; ++i) v[i] = t.W[(size_t)(t.k0 + (tid >> 6) + 8 * i) * t.N + sc];
}
DI void phase_prep(const Params& p) {
    const int tid = threadIdx.x, lane = tid & 63, wave = tid >> 6, nb = gridDim.x, bid = blockIdx.x;
    unsigned char* ws = p.ws;
    if (bid == 0 && tid < 64) {
        unsigned* ctl = (unsigned*)(ws + WS_CTL);
        float a = p.diff_lambda[lane] * p.diff_lambda[64 + lane], b = p.diff_lambda[128 + lane] * p.diff_lambda[192 + lane];
        a = wave_sum(a); b = wave_sum(b);
        if (lane == 0) { ctl[0] = 0u; ((float*)ctl)[1] = expf(a) - expf(b) + LAM_INIT; }
    }
    {
        constexpr int NT = 16 * 56 + 16 * 16 + 16 * 88 + 44 * 16;
        float* lds = (float*)dyn_smem;
        float v[8];
        TrItem cur = tr_decode(p, bid < NT ? bid : 0);
        if (bid < NT) tr_load(cur, v);
        for (int it = bid; it < NT; it += nb) {
            float nv[8]; TrItem nx = cur;
            if (it + nb < NT) { nx = tr_decode(p, it + nb); tr_load(nx, nv); }
#pragma unroll
            for (int i = 0; i < 8; ++i) lds[((tid >> 6) + 8 * i) * 65 + (tid & 63)] = v[i];
            __syncthreads();
#pragma unroll
            for (int i = 0; i < 8; ++i) { const int nn = (tid >> 6) + 8 * i, kk = tid & 63; cur.WT[(size_t)(cur.n0 + nn) * cur.K + cur.k0 + kk] = f2bf(lds[kk * 65 + nn]); }
            __syncthreads();
#pragma unroll
            for (int i = 0; i < 8; ++i) v[i] = nv[i];
            cur = nx;
        }
    }
    {
        float2* rope = (float2*)(ws + WS_ROPE);
        for (int idx = bid * 512 + tid; idx < 8192 * 32; idx += nb * 512) {
            const int pos = idx >> 5, d = idx & 31;
            const double inv = exp(-(double)d * (9.210340371976184 / 32.0));
            double a = (double)pos * inv;
            a -= 6.283185307179586 * rint(a * 0.15915494309189535);
            const float af = (float)a;
            rope[idx] = make_float2(__cosf(af), __sinf(af));
        }
    }
    {
        float* w8 = (float*)dyn_smem;
        __syncthreads();
        for (int i = tid; i < 1024 * 8; i += 512) w8[i] = p.w_in[(size_t)(i >> 3) * DIN + 2048 + (i & 7)];
        __syncthreads();
        bf16_t* XB = (bf16_t*)(ws + WS_R1);
        float* AB = (float*)(ws + WS_AB);
        f32x4 cv[4];
        {
            const int row = bid * 8 + wave;
            if (row < M) { const float* xr = xrow_ptr(p, row);
#pragma unroll
                for (int j = 0; j < 4; ++j) cv[j] = *(const f32x4*)(xr + lane * 4 + 256 * j); }
        }
        for (int row = bid * 8 + wave; row < M; row += nb * 8) {
            f32x4 nvx[4];
            if (row + nb * 8 < M) { const float* xn = xrow_ptr(p, row + nb * 8);
#pragma unroll
                for (int j = 0; j < 4; ++j) nvx[j] = *(const f32x4*)(xn + lane * 4 + 256 * j); }
            float acc[8];
#pragma unroll
            for (int c = 0; c < 8; ++c) acc[c] = 0.f;
#pragma unroll
            for (int j = 0; j < 4; ++j) {
                const int k0 = lane * 4 + 256 * j;
                const f32x4 v = cv[j];
                u32x2 o; o.x = pk2(v.x, v.y); o.y = pk2(v.z, v.w);
                *(u32x2*)(XB + (size_t)row * D + k0) = o;
#pragma unroll
                for (int e = 0; e < 4; ++e) {
                    const f32x4 wa = *(const f32x4*)(w8 + (k0 + e) * 8), wb = *(const f32x4*)(w8 + (k0 + e) * 8 + 4);
                    const float xv = v[e];
                    acc[0] += xv * wa.x; acc[1] += xv * wa.y; acc[2] += xv * wa.z; acc[3] += xv * wa.w;
                    acc[4] += xv * wb.x; acc[5] += xv * wb.y; acc[6] += xv * wb.z; acc[7] += xv * wb.w;
                }
            }
#pragma unroll
            for (int c = 0; c < 8; ++c) acc[c] = wave_sum(acc[c]);
            if (lane == 0) { *(f32x4*)(AB + (size_t)row * 8) = (f32x4){acc[0], acc[1], acc[2], acc[3]}; *(f32x4*)(AB + (size_t)row * 8 + 4) = (f32x4){acc[4], acc[5], acc[6], acc[7]}; }
#pragma unroll
            for (int j = 0; j < 4; ++j) cv[j] = nvx[j];
        }
        __syncthreads();
    }
    {
        bf16_t* KALL = (bf16_t*)(ws + WS_R5);
        const int nchunk = BS * TKS * 64;
        for (int c0 = bid * 512 + tid; c0 < nchunk; c0 += nb * 512 * 4) {
            f32x4 v0[4], v1[4]; int st[4]; size_t dsto[4];
#pragma unroll
            for (int u = 0; u < 4; ++u) {
                const int c = c0 + u * nb * 512;
                st[u] = 0;
                if (c < nchunk) {
                    const int col8 = c & 63, r = c >> 6, b = r / TKS, pp = r % TKS;
                    dsto[u] = ((size_t)MP + (size_t)b * TKS + pp) * 512 + col8 * 8;
                    if (pp < PAST) { const float* sp = p.cache_k + ((size_t)(b * PAST + pp) * 512 + col8 * 8); v0[u] = *(const f32x4*)sp; v1[u] = *(const f32x4*)(sp + 4); st[u] = 1; }
                    else if (pp >= PAST + TS) st[u] = 2;
                }
            }
#pragma unroll
            for (int u = 0; u < 4; ++u) {
                if (st[u] == 1) { u32x4 o; o.x = pk2(v0[u].x, v0[u].y); o.y = pk2(v0[u].z, v0[u].w); o.z = pk2(v1[u].x, v1[u].y); o.w = pk2(v1[u].z, v1[u].w); *(u32x4*)(KALL + dsto[u]) = o; }
                else if (st[u] == 2) *(u32x4*)(KALL + dsto[u]) = (u32x4){0u, 0u, 0u, 0u};
            }
        }
    }
    {
        bf16_t* VTS = (bf16_t*)(ws + WS_R6) + VT_S_OFF;
        bf16_t* t = (bf16_t*)dyn_smem;
        f32x4 cvv[4];
        auto ldv = [&](int it, f32x4 (&v)[4]) {
            const int blk = it % 65, bh = it / 65, b = bh >> 2, h = bh & 3;
            if (blk < 64) {
#pragma unroll
                for (int i = 0; i < 4; ++i) { const int id = tid + 512 * i, key = id >> 5, c4 = id & 31;
                    v[i] = *(const f32x4*)(p.cache_v + ((size_t)(b * PAST + blk * 64 + key) * 512 + h * 128 + c4 * 4)); }
            }
        };
        if (bid < BS * 4 * 65) ldv(bid, cvv);
        for (int it = bid; it < BS * 4 * 65; it += nb) {
            const int blk = it % 65, bh = it / 65;
            f32x4 nvv[4];
            if (it + nb < BS * 4 * 65) ldv(it + nb, nvv);
            if (blk < 64) {
                __syncthreads();
#pragma unroll
                for (int i = 0; i < 4; ++i) {
                    const int id = tid + 512 * i, key = id >> 5, c4 = id & 31;
                    const f32x4 v = cvv[i];
                    bf16_t* d = t + key * 130 + c4 * 4;
                    *(unsigned*)d = pk2(v.x, v.y); *(unsigned*)(d + 2) = pk2(v.z, v.w);
                }
                __syncthreads();
                const int dv = tid >> 2, part = tid & 3;
                unsigned o[8];
#pragma unroll
                for (int i = 0; i < 8; ++i) { const int k0 = part * 16 + 2 * i; o[i] = (unsigned)t[k0 * 130 + dv] | ((unsigned)t[(k0 + 1) * 130 + dv] << 16); }
                bf16_t* dst = VTS + ((size_t)(bh * 128 + dv) * TKS + blk * 64 + part * 16);
                *(u32x4*)dst = (u32x4){o[0], o[1], o[2], o[3]}; *(u32x4*)(dst + 8) = (u32x4){o[4], o[5], o[6], o[7]};
            } else {
                if (tid < 128) { bf16_t* dst = VTS + ((size_t)(bh * 128 + tid) * TKS + PAST + TS);
#pragma unroll
                    for (int i = 0; i < 4; ++i) *(u32x4*)(dst + 8 * i) = (u32x4){0u, 0u, 0u, 0u}; }
            }
#pragma unroll
            for (int i = 0; i < 4; ++i) cvv[i] = nvv[i];
        }
        __syncthreads();
    }
}

constexpr int BM = 256, BK = 64, HALF = 128, NXCD = 8, WGM = 8, HT = HALF * BK;
DI void stage_rc(int b, int& R, int& C) {
    const int st = b / 1024, sb = b % 1024, swz = sb ^ (((sb >> 9) & 1) << 5);
    R = (st >> 1) * 16 + swz / 64; C = (st & 1) * 32 + (swz % 64) / 2;
}
DI int lds_byte(int r, int c) {
    const int st = (r >> 4) * 2 + (c >> 5), rr = r & 15, cc = c & 31, ob = rr * 64 + cc * 2;
    return st * 1024 + (ob ^ (((ob >> 9) & 1) << 5));
}

#define SHM ((bf16_t*)dyn_smem)
#define SA(b, h) (SHM + ((b) * 2 + (h)) * HT)
#define SB(b, h) (SHM + (4 + (b) * 2 + (h)) * HT)
#define STAGE(P, BASE, br, kt) do { const bf16_t* _gb = (BASE) + ((long)(br) * K + (long)(kt) * BK); \
      __builtin_amdgcn_global_load_lds((const unsigned*)(_gb + so0), (unsigned*)((char*)(P) + wlds), 16, 0, 0); \
      __builtin_amdgcn_global_load_lds((const unsigned*)(_gb + 64 * K + so0), (unsigned*)((char*)(P) + wlds + 8192), 16, 0, 0); } while (0)
#define LDA(dst, b, h) for (int m = 0; m < 4; ++m) for (int k = 0; k < 2; ++k) \
    dst[m][k] = *reinterpret_cast<const bf16x8*>((char*)SA(b, h) + lds_byte(wr * 64 + m * 16 + fr, k * 32 + fq * 8))
#define LDB(dst, b, h) for (int n = 0; n < 2; ++n) for (int k = 0; k < 2; ++k) \
    dst[n][k] = *reinterpret_cast<const bf16x8*>((char*)SB(b, h) + lds_byte(wc * 32 + n * 16 + fr, k * 32 + fq * 8))
#define MMA(ai, bj, At, Bt_) do { __builtin_amdgcn_s_setprio(1); \
    for (int m = 0; m < 4; ++m) for (int n = 0; n < 2; ++n) for (int k = 0; k < 2; ++k) \
      acc[ai][bj][m][n] = __builtin_amdgcn_mfma_f32_16x16x32_bf16(At[m][k], Bt_[n][k], acc[ai][bj][m][n], 0, 0, 0); \
    __builtin_amdgcn_s_setprio(0); } while (0)
#define WAIT_V(n) asm volatile("s_waitcnt vmcnt(" #n ")" ::: "memory")
#define WAIT_L(n) asm volatile("s_waitcnt lgkmcnt(" #n ")" ::: "memory")
#define BAR __builtin_amdgcn_s_barrier()
#define SCHED __builtin_amdgcn_sched_barrier(0)

template <int K> DI void gemm_tile(const bf16_t* __restrict__ A, const bf16_t* __restrict__ Bt, const int brow, const int bcol, f32x4 (&acc)[2][2][4][2]) {
    const int wid = threadIdx.x >> 6, lane = threadIdx.x & 63, wr = wid >> 2, wc = wid & 3, fr = lane & 15, fq = lane >> 4;
    unsigned so0;
    { int _r, _c; stage_rc(threadIdx.x * 16, _r, _c); so0 = (unsigned)(_r * K + _c); }
    const int wlds = __builtin_amdgcn_readfirstlane((int)(threadIdx.x >> 6) << 10);
#pragma unroll
    for (int a = 0; a < 2; ++a)
#pragma unroll
        for (int b = 0; b < 2; ++b)
#pragma unroll
            for (int m = 0; m < 4; ++m)
#pragma unroll
                for (int n = 0; n < 2; ++n) acc[a][b][m][n] = (f32x4){0.f, 0.f, 0.f, 0.f};
    bf16x8 At[4][2], B0[2][2], B1[2][2];
    constexpr int nt = K / BK;
    STAGE(SB(0, 0), Bt, bcol, 0); STAGE(SA(0, 0), A, brow, 0);
    STAGE(SB(0, 1), Bt, bcol + HALF, 0); STAGE(SA(0, 1), A, brow + HALF, 0);
    if (wr == 1) BAR;
    WAIT_V(4); BAR;
    STAGE(SB(1, 0), Bt, bcol, 1); STAGE(SA(1, 0), A, brow, 1); STAGE(SB(1, 1), Bt, bcol + HALF, 1);
    WAIT_V(6); BAR;
    for (int t = 0; t < nt - 2; t += 2) {
        LDB(B0, 0, 0); SCHED; LDA(At, 0, 0); STAGE(SA(1, 1), A, brow + HALF, t + 1);
        WAIT_L(8); BAR; WAIT_L(0); MMA(0, 0, At, B0); BAR; SCHED;
        LDB(B1, 0, 1); STAGE(SB(0, 0), Bt, bcol, t + 2);
        BAR; WAIT_L(0); MMA(0, 1, At, B1); BAR;
        LDA(At, 0, 1); STAGE(SA(0, 0), A, brow, t + 2);
        BAR; WAIT_L(0); MMA(1, 0, At, B0); BAR; SCHED;
        STAGE(SB(0, 1), Bt, bcol + HALF, t + 2);
        WAIT_V(6); BAR; MMA(1, 1, At, B1); BAR;
        LDB(B0, 1, 0); SCHED; LDA(At, 1, 0); STAGE(SA(0, 1), A, brow + HALF, t + 2);
        WAIT_L(8); BAR; WAIT_L(0); MMA(0, 0, At, B0); BAR; SCHED;
        LDB(B1, 1, 1); STAGE(SB(1, 0), Bt, bcol, t + 3);
        BAR; WAIT_L(0); MMA(0, 1, At, B1); BAR;
        LDA(At, 1, 1); STAGE(SA(1, 0), A, brow, t + 3);
        BAR; WAIT_L(0); MMA(1, 0, At, B0); BAR; SCHED;
        STAGE(SB(1, 1), Bt, bcol + HALF, t + 3);
        WAIT_V(6); BAR; MMA(1, 1, At, B1); BAR;
    }
    { LDB(B0, 0, 0); LDA(At, 0, 0); STAGE(SA(1, 1), A, brow + HALF, nt - 1);
      BAR; WAIT_L(0); MMA(0, 0, At, B0); BAR;
      LDB(B1, 0, 1); BAR; WAIT_L(0); MMA(0, 1, At, B1); BAR;
      LDA(At, 0, 1); WAIT_V(4); BAR; WAIT_L(0); MMA(1, 0, At, B0); MMA(1, 1, At, B1); BAR; }
    { LDB(B0, 1, 0); LDA(At, 1, 0); WAIT_V(2); BAR; WAIT_L(0); MMA(0, 0, At, B0); BAR;
      LDB(B1, 1, 1); WAIT_V(0); BAR; WAIT_L(0); MMA(0, 1, At, B1); BAR;
      LDA(At, 1, 1); BAR; WAIT_L(0); MMA(1, 0, At, B0); MMA(1, 1, At, B1); BAR; }
    if (wr == 0) BAR;
}

DI void tile_of(int L, int nM, int nN, int& pm, int& pn) {
    const int nwg = nM * nN; int wgid = L;
    { const int q = nwg / NXCD, r = nwg % NXCD, xcd = wgid % NXCD, off = wgid / NXCD; wgid = (xcd < r ? xcd * (q + 1) : r * (q + 1) + (xcd - r) * q) + off; }
    const int nig = WGM * nN, gid = wgid / nig, fm = gid * WGM, gsz = min(nM - fm, WGM);
    pm = fm + ((wgid % nig) % gsz); pn = (wgid % nig) / gsz;
}

constexpr int CST = 260;
DI void stage_half(const f32x4 (&acc)[2][2][4][2], const int ai) {
    const int tid_ = opaque_tid(), wid = tid_ >> 6, lane = tid_ & 63, wr = wid >> 2, wc = wid & 3, fr = lane & 15, fq = lane >> 4;
    float* base = (float*)dyn_smem + (wr * 64 + fq * 4) * CST + wc * 32 + fr;
#pragma unroll
    for (int m = 0; m < 4; ++m)
#pragma unroll
        for (int j = 0; j < 4; ++j)
#pragma unroll
            for (int bj = 0; bj < 2; ++bj)
#pragma unroll
                for (int n = 0; n < 2; ++n) base[(m * 16 + j) * CST + bj * 128 + n * 16] = ai == 0 ? acc[0][bj][m][n][j] : acc[1][bj][m][n][j];
}
#define CT ((const float*)dyn_smem)

DI void epi_in_half(const Params& p, int pm, int pn, int ai) {
    unsigned char* ws = p.ws;
    const int tid = opaque_tid(), brow = pm * BM + ai * 128, bcol = pn * BM;
    const bool samp = pm == 128;
    if (pn < 8) {
        bf16_t* dst = pn < 6 ? (bf16_t*)(ws + WS_R2) : (bf16_t*)(ws + WS_R3);
        const int ld = pn < 6 ? 1536 : 512, c0 = pn < 6 ? bcol : bcol - 1536;
#pragma unroll 4
        for (int i = 0; i < 16; ++i) {
            const int id = tid + 512 * i, r = id >> 6, c4 = (id & 63) * 4, row = brow + r;
            const f32x4 v = *(const f32x4*)(CT + r * CST + c4);
            u32x2 o; o.x = pk2(v.x, v.y); o.y = pk2(v.z, v.w);
            *(u32x2*)(dst + (size_t)row * ld + c0 + c4) = o;
            if (pn < 6) {
                if (!samp) { const int t = row & (TP - 1); if (t >= TP - 3) *(f32x4*)(p.out + O_CQP + (size_t)((row >> 13) * 3 + t - (TP - 3)) * 1536 + c0 + c4) = v; }
                else { const int rr = row - MP, t = rr & 31; if (t >= TS - 3) *(f32x4*)(p.out + O_CQS + (size_t)((rr >> 5) * 3 + t - (TS - 3)) * 1536 + c0 + c4) = v; }
            }
        }
        return;
    }
    if (pn < 12) {
        const bool isq = pn < 10;
        const float* rope = (const float*)(ws + WS_ROPE);
        bf16_t* QB = (bf16_t*)(ws + WS_R4); bf16_t* KALL = (bf16_t*)(ws + WS_R5);
        const float qs = 0.125f * 1.4426950408889634f;
#pragma unroll 2
        for (int i = 0; i < 8; ++i) {
            const int id = tid + 512 * i, r = id >> 5, q = id & 31, hl = q >> 4, map = (q >> 3) & 1, d4 = (q & 7) * 4, row = brow + r;
            const int cl = hl * 128 + map * 64 + d4, col = ((pn & 1) * 2 + hl) * 128 + map * 64 + d4;
            const f32x4 x1 = *(const f32x4*)(CT + r * CST + cl), x2 = *(const f32x4*)(CT + r * CST + cl + 32);
            int pos; size_t krow; float* kout;
            if (!samp) { pos = row & (TP - 1); krow = row; kout = p.out + O_KP + (size_t)row * 512; }
            else { const int rr = row - MP; pos = PAST + (rr & 31); krow = (size_t)MP + (size_t)(rr >> 5) * TKS + pos; kout = p.out + O_KS + (size_t)rr * 512; }
            const f32x4 t0 = *(const f32x4*)(rope + (size_t)(pos * 32 + d4) * 2), t1 = *(const f32x4*)(rope + (size_t)(pos * 32 + d4) * 2 + 4);
            const f32x4 cs = (f32x4){t0.x, t0.z, t1.x, t1.z}, sn = (f32x4){t0.y, t0.w, t1.y, t1.w};
            const f32x4 y1 = x1 * cs - x2 * sn, y2 = x2 * cs + x1 * sn;
            if (isq) {
                u32x2 o1, o2; o1.x = pk2(y1.x * qs, y1.y * qs); o1.y = pk2(y1.z * qs, y1.w * qs); o2.x = pk2(y2.x * qs, y2.y * qs); o2.y = pk2(y2.z * qs, y2.w * qs);
                *(u32x2*)(QB + (size_t)row * 512 + col) = o1; *(u32x2*)(QB + (size_t)row * 512 + col + 32) = o2;
            } else {
                *(f32x4*)(kout + col) = y1; *(f32x4*)(kout + col + 32) = y2;
                u32x2 o1, o2; o1.x = pk2(y1.x, y1.y); o1.y = pk2(y1.z, y1.w); o2.x = pk2(y2.x, y2.y); o2.y = pk2(y2.z, y2.w);
                *(u32x2*)(KALL + krow * 512 + col) = o1; *(u32x2*)(KALL + krow * 512 + col + 32) = o2;
            }
        }
        return;
    }
    {
        bf16_t* VT = (bf16_t*)(ws + WS_R6);
#pragma unroll 4
        for (int i = 0; i < 16; ++i) {
            const int id = tid + 512 * i, r = id >> 6, c4 = (id & 63) * 4, row = brow + r, col = (pn & 1) * 256 + c4;
            const f32x4 v = *(const f32x4*)(CT + r * CST + c4);
            float* vout = samp ? p.out + O_VS + (size_t)(row - MP) * 512 + col : p.out + O_VP + (size_t)row * 512 + col;
            *(f32x4*)vout = v;
        }
#pragma unroll 1
        for (int i = 0; i < 2; ++i) {
            const int id = tid + 512 * i, rg = id >> 6, c4 = (id & 63) * 4, row0 = brow + rg * 8;
            f32x4 v[8];
#pragma unroll
            for (int e = 0; e < 8; ++e) v[e] = *(const f32x4*)(CT + (rg * 8 + e) * CST + c4);
#pragma unroll
            for (int e = 0; e < 4; ++e) {
                const int colg = (pn & 1) * 256 + c4 + e, head = colg >> 7, dv = colg & 127;
                u32x4 o; o.x = pk2(v[0][e], v[1][e]); o.y = pk2(v[2][e], v[3][e]); o.z = pk2(v[4][e], v[5][e]); o.w = pk2(v[6][e], v[7][e]);
                bf16_t* d;
                if (samp) { const int rr = row0 - MP; d = VT + VT_S_OFF + ((size_t)(((rr >> 5) * 4 + head) * 128 + dv) * TKS + PAST + (rr & 31)); }
                else d = VT + ((size_t)(((row0 >> 13) * 4 + head) * 128 + dv) * TP + (row0 & (TP - 1)));
                *(u32x4*)d = o;
            }
        }
    }
}

template <int WHICH> DI void epi_res_half(const Params& p, int pm, int pn, int ai) {
    const int tid = opaque_tid(), brow = pm * BM + ai * 128, bcol = pn * BM;
    bf16_t* dst = (bf16_t*)(p.ws + (WHICH == 0 ? WS_R1 : WS_R2));
    const bf16_t* X1B = (const bf16_t*)(p.ws + WS_R3);
#pragma unroll 4
    for (int i = 0; i < 16; ++i) {
        const int id = tid + 512 * i, r = id >> 6, c4 = (id & 63) * 4, row = brow + r;
        const f32x4 v = *(const f32x4*)(CT + r * CST + c4);
        f32x4 x;
        if (WHICH == 0) x = *(const f32x4*)(xrow_ptr(p, row) + bcol + c4);
        else { const u32x2 xb = *(const u32x2*)(X1B + (size_t)row * D + bcol + c4); x = (f32x4){bflo(xb.x), bfhi(xb.x), bflo(xb.y), bfhi(xb.y)}; }
        const f32x4 o = x * ALPHA + v;
        u32x2 q; q.x = pk2(o.x, o.y); q.y = pk2(o.z, o.w);
        *(u32x2*)(dst + (size_t)row * D + bcol + c4) = q;
    }
}

constexpr int UST = 264;
DI void epi_up(const Params& p, const f32x4 (&acc)[2][2][4][2], int pm, int pn) {
    unsigned char* ws = p.ws;
    bf16_t* U = (bf16_t*)dyn_smem;
    float* BND = (float*)(ws + WS_R5);
    const bool samp = pm == 128;
    const int brow = pm * BM, tid = opaque_tid();
    {
        const int wid = tid >> 6, lane = tid & 63, wr = wid >> 2, wc = wid & 3, fr = lane & 15, fq = lane >> 4;
        bf16_t* base = U + (wr * 64 + fq * 4) * UST + wc * 32 + fr;
#pragma unroll
        for (int ai = 0; ai < 2; ++ai)
#pragma unroll
            for (int m = 0; m < 4; ++m)
#pragma unroll
                for (int j = 0; j < 4; ++j)
#pragma unroll
                    for (int bj = 0; bj < 2; ++bj)
#pragma unroll
                        for (int n = 0; n < 2; ++n) base[(ai * 128 + m * 16 + j) * UST + bj * 128 + n * 16] = f2bf(acc[ai][bj][m][n][j]);
    }
    __syncthreads();
    {
        const int nb = samp ? 32 * 256 : 4 * 256;
        for (int id = tid; id < nb; id += 512) {
            const int cl = id & 255, q = id >> 8;
            const int oc = (cl >> 7) * DFF + 128 * pn + (cl & 127);
            int rr, bslot, u;
            if (!samp) { bslot = q; rr = q < 2 ? q : 252 + q; u = pm; }
            else { bslot = q & 3; rr = (q >> 2) * 32 + (bslot < 2 ? bslot : 28 + bslot); u = 128 + (q >> 2); }
            const float v = bf2f(U[rr * UST + cl]);
            BND[((size_t)u * 4 + bslot) * NUP + oc] = v;
            if (bslot >= 2) {
                if (samp) p.out[O_CFS + (size_t)((q >> 2) * 2 + bslot - 2) * NUP + oc] = v;
                else if ((pm & 31) == 31) p.out[O_CFP + (size_t)((pm >> 5) * 2 + bslot - 2) * NUP + oc] = v;
            }
        }
    }
    {
        const int cp = tid & 63, rs = tid >> 6, c = 2 * cp, cg_ = 128 * pn + c, cv_ = DFF + 128 * pn + c;
        const f32x2 wg0 = *(const f32x2*)(p.ffn_conv_w + cg_), wg1 = *(const f32x2*)(p.ffn_conv_w + NUP + cg_), wg2 = *(const f32x2*)(p.ffn_conv_w + 2 * NUP + cg_), bg = *(const f32x2*)(p.ffn_conv_b + cg_);
        const f32x2 wv0 = *(const f32x2*)(p.ffn_conv_w + cv_), wv1 = *(const f32x2*)(p.ffn_conv_w + NUP + cv_), wv2 = *(const f32x2*)(p.ffn_conv_w + 2 * NUP + cv_), bv = *(const f32x2*)(p.ffn_conv_b + cv_);
        bf16_t* GT = (bf16_t*)(ws + WS_R1);
        const int r0 = rs * 32;
        f32x2 g1 = {0.f, 0.f}, g2 = {0.f, 0.f}, v1 = {0.f, 0.f}, v2 = {0.f, 0.f};
        if (r0 >= 2) {
            const unsigned a0 = *(const unsigned*)(U + (r0 - 2) * UST + c), a1 = *(const unsigned*)(U + (r0 - 1) * UST + c);
            const unsigned b0 = *(const unsigned*)(U + (r0 - 2) * UST + 128 + c), b1 = *(const unsigned*)(U + (r0 - 1) * UST + 128 + c);
            g1 = (f32x2){bflo(a0), bfhi(a0)}; g2 = (f32x2){bflo(a1), bfhi(a1)}; v1 = (f32x2){bflo(b0), bfhi(b0)}; v2 = (f32x2){bflo(b1), bfhi(b1)};
        }
#pragma unroll 4
        for (int r = r0; r < r0 + 32; ++r) {
            const unsigned ga = *(const unsigned*)(U + r * UST + c), va = *(const unsigned*)(U + r * UST + 128 + c);
            const f32x2 g3 = {bflo(ga), bfhi(ga)}, v3 = {bflo(va), bfhi(va)};
            if (r >= 2) {
                const f32x2 cg2 = wg0 * g1 + wg1 * g2 + wg2 * g3 + bg, cv2 = wv0 * v1 + wv1 * v2 + wv2 * v3 + bv;
                *(unsigned*)(GT + (size_t)(brow + r) * DFF + 128 * pn + c) = pk2(silu(cg2.x) * cv2.x, silu(cg2.y) * cv2.y);
            }
            g1 = g2; g2 = g3; v1 = v2; v2 = v3;
        }
    }
}

template <int K> DI void skinny_gemm(const bf16_t* __restrict__ A, const bf16_t* __restrict__ Bt, float* __restrict__ C, const int N) {
    const int tid = opaque_tid(), lane = tid & 63, w = __builtin_amdgcn_readfirstlane(tid >> 6), fr = lane & 15, fq = lane >> 4;
    float* red = (float*)dyn_smem;
    constexpr int KW = K / 8, NKS = KW / 32;
    const int ntile = 8 * (N / 32);
    for (int t = blockIdx.x; t < ntile; t += gridDim.x) {
        const int rm = t & 7, cn = t >> 3;
        const bf16_t* ap = A + (size_t)(32 * rm + fr) * K + w * KW + 8 * fq;
        const bf16_t* bp = Bt + (size_t)(32 * cn + fr) * K + w * KW + 8 * fq;
        f32x4 acc[2][2];
#pragma unroll
        for (int i = 0; i < 2; ++i)
#pragma unroll
            for (int j = 0; j < 2; ++j) acc[i][j] = (f32x4){0.f, 0.f, 0.f, 0.f};
#pragma unroll 4
        for (int ks = 0; ks < NKS; ++ks) {
            const bf16x8 a0 = *(const bf16x8*)(ap + ks * 32), a1 = *(const bf16x8*)(ap + (size_t)16 * K + ks * 32);
            const bf16x8 b0 = *(const bf16x8*)(bp + ks * 32), b1 = *(const bf16x8*)(bp + (size_t)16 * K + ks * 32);
            acc[0][0] = __builtin_amdgcn_mfma_f32_16x16x32_bf16(a0, b0, acc[0][0], 0, 0, 0);
            acc[0][1] = __builtin_amdgcn_mfma_f32_16x16x32_bf16(a0, b1, acc[0][1], 0, 0, 0);
            acc[1][0] = __builtin_amdgcn_mfma_f32_16x16x32_bf16(a1, b0, acc[1][0], 0, 0, 0);
            acc[1][1] = __builtin_amdgcn_mfma_f32_16x16x32_bf16(a1, b1, acc[1][1], 0, 0, 0);
        }
        __syncthreads();
#pragma unroll
        for (int i = 0; i < 2; ++i)
#pragma unroll
            for (int j = 0; j < 2; ++j)
#pragma unroll
                for (int e = 0; e < 4; ++e) red[(w * 32 + 16 * i + 4 * fq + e) * 33 + 16 * j + fr] = acc[i][j][e];
        __syncthreads();
#pragma unroll
        for (int o2 = 0; o2 < 2; ++o2) {
            const int o = tid + 512 * o2, r = o >> 5, c = o & 31;
            float sum = 0.f;
#pragma unroll
            for (int ww = 0; ww < 8; ++ww) sum += red[(ww * 32 + r) * 33 + c];
            C[(size_t)(32 * rm + r) * N + 32 * cn + c] = sum;
        }
    }
    __syncthreads();
}

template <int WHICH> DI void gemm_phase(const Params& p) {
    unsigned char* ws = p.ws;
    const bf16_t* A; const bf16_t* Bt; int N; constexpr int K = WHICH == 4 ? DFF : D; float* CS;
    if (WHICH == 1) { A = (const bf16_t*)(ws + WS_R1); Bt = (const bf16_t*)(ws + WS_WIN); N = NH1; CS = (float*)(ws + WS_CS1); }
    else if (WHICH == 2) { A = (const bf16_t*)(ws + WS_R2); Bt = (const bf16_t*)(ws + WS_WO); N = D; CS = (float*)(ws + WS_CS2); }
    else if (WHICH == 3) { A = (const bf16_t*)(ws + WS_R3); Bt = (const bf16_t*)(ws + WS_WUP); N = NUP; CS = (float*)(ws + WS_CS3); }
    else { A = (const bf16_t*)(ws + WS_R1); Bt = (const bf16_t*)(ws + WS_WDN); N = D; CS = (float*)(ws + WS_CS4); }
    skinny_gemm<K>(A + (size_t)MP * K, Bt, CS, N);
    const int nM = MP / BM, nN = N / BM, ntile = nM * nN;
    for (int L0 = blockIdx.x; L0 < ntile * (WHICH == GREP_WHICH ? 2 : 1); L0 += gridDim.x) {
        const int L = L0 % ntile;
        int pm, pn; tile_of(L, nM, nN, pm, pn);
        f32x4 acc[2][2][4][2];
        gemm_tile<K>(A, Bt, pm * BM, pn * BM, acc);
        if (WHICH == 3) epi_up(p, acc, pm, pn);
        else {
#pragma unroll
            for (int ai = 0; ai < 2; ++ai) {
                stage_half(acc, ai);
                __syncthreads();
                if (WHICH == 1) epi_in_half(p, pm, pn, ai);
                else if (WHICH == 2) epi_res_half<0>(p, pm, pn, ai);
                else epi_res_half<1>(p, pm, pn, ai);
                __syncthreads();
            }
        }
        __syncthreads();
    }
}

template <int WHICH> DI void ln_phase(const Params& p) {
    const int lane = threadIdx.x & 63, wave = threadIdx.x >> 6;
    const float* g = WHICH == 0 ? p.ln1_g : p.ln2_g; const float* b = WHICH == 0 ? p.ln1_b : p.ln2_b;
    bf16_t* X1B = (bf16_t*)(p.ws + WS_R3);
    const bf16_t* PRE = (const bf16_t*)(p.ws + (WHICH == 0 ? WS_R1 : WS_R2));
    f32x4 gv[4], bv[4];
#pragma unroll
    for (int j = 0; j < 4; ++j) { gv[j] = *(const f32x4*)(g + lane * 4 + 256 * j); bv[j] = *(const f32x4*)(b + lane * 4 + 256 * j); }
    for (int row = blockIdx.x * 8 + wave; row < M; row += gridDim.x * 8) {
        f32x4 v[4]; float s = 0.f;
        if (row < MP) {
#pragma unroll
            for (int j = 0; j < 4; ++j) { const u32x2 q = *(const u32x2*)(PRE + (size_t)row * D + lane * 4 + 256 * j); v[j] = (f32x4){bflo(q.x), bfhi(q.x), bflo(q.y), bfhi(q.y)}; }
        } else {
            const float* cs = (const float*)(p.ws + (WHICH == 0 ? WS_CS2 : WS_CS4)) + (size_t)(row - MP) * D;
#pragma unroll
            for (int j = 0; j < 4; ++j) {
                f32x4 rs;
                if (WHICH == 0) rs = *(const f32x4*)(p.x_s + (size_t)(row - MP) * D + lane * 4 + 256 * j);
                else { const u32x2 q = *(const u32x2*)(X1B + (size_t)row * D + lane * 4 + 256 * j); rs = (f32x4){bflo(q.x), bfhi(q.x), bflo(q.y), bfhi(q.y)}; }
                v[j] = rs * ALPHA + *(const f32x4*)(cs + lane * 4 + 256 * j);
            }
        }
#pragma unroll
        for (int j = 0; j < 4; ++j) s += (v[j].x + v[j].y) + (v[j].z + v[j].w);
        const float mean = wave_sum(s) * (1.f / D); float s2 = 0.f;
#pragma unroll
        for (int j = 0; j < 4; ++j) { v[j] = v[j] - mean; s2 += (v[j].x * v[j].x + v[j].y * v[j].y) + (v[j].z * v[j].z + v[j].w * v[j].w); }
        const float rstd = rsqrtf(wave_sum(s2) * (1.f / D) + 1e-5f);
#pragma unroll
        for (int j = 0; j < 4; ++j) {
            const f32x4 o = v[j] * rstd * gv[j] + bv[j];
            if (WHICH == 0) { u32x2 q; q.x = pk2(o.x, o.y); q.y = pk2(o.z, o.w); *(u32x2*)(X1B + (size_t)row * D + lane * 4 + 256 * j) = q; }
            else *(f32x4*)(p.out + O_Y + (size_t)row * D + lane * 4 + 256 * j) = o;
        }
    }
}

DI void fixup_phase(const Params& p) {
    const float* BND = (const float*)(p.ws + WS_R5);
    bf16_t* GT = (bf16_t*)(p.ws + WS_R1);
    {
        const float* CS3 = (const float*)(p.ws + WS_CS3);
        for (int idx = blockIdx.x * 512 + threadIdx.x; idx < MS * DFF; idx += gridDim.x * 512) {
            const int c = idx % DFF, r = idx / DFF, b = r >> 5, t = r & 31, ng = (c >> 7) * 256 + (c & 127), nv = ng + 128;
            float g[3], v[3];
#pragma unroll
            for (int k = 0; k < 3; ++k) {
                const int tt = t - 2 + k;
                if (tt >= 0) { g[k] = CS3[(size_t)(b * 32 + tt) * NUP + ng]; v[k] = CS3[(size_t)(b * 32 + tt) * NUP + nv]; }
                else { g[k] = p.state_cf[(size_t)(b * 2 + 2 + tt) * NUP + c]; v[k] = p.state_cf[(size_t)(b * 2 + 2 + tt) * NUP + DFF + c]; }
            }
            const float cg2 = p.ffn_conv_w[c] * g[0] + p.ffn_conv_w[NUP + c] * g[1] + p.ffn_conv_w[2 * NUP + c] * g[2] + p.ffn_conv_b[c];
            const float cv2 = p.ffn_conv_w[DFF + c] * v[0] + p.ffn_conv_w[NUP + DFF + c] * v[1] + p.ffn_conv_w[2 * NUP + DFF + c] * v[2] + p.ffn_conv_b[DFF + c];
            GT[((size_t)MP + r) * DFF + c] = f2bf(silu(cg2) * cv2);
            if (t >= 30) { p.out[O_CFS + (size_t)(b * 2 + t - 30) * NUP + c] = g[2]; p.out[O_CFS + (size_t)(b * 2 + t - 30) * NUP + DFF + c] = v[2]; }
        }
    }
    const int total = 128 * 2 * DFF;
    for (int idx = blockIdx.x * 512 + threadIdx.x; idx < total; idx += gridDim.x * 512) {
        const int c = idx % DFF, q = idx / DFF, r = q & 1, u = q >> 1;
        const float* cur = BND + (size_t)u * 4 * NUP;
        float pg[2], pv[2];
        if (u < 128) {
            if ((u & 31) == 0) { pg[0] = pg[1] = pv[0] = pv[1] = 0.f; }
            else { const float* pr = BND + (size_t)(u - 1) * 4 * NUP; pg[0] = pr[2 * NUP + c]; pg[1] = pr[3 * NUP + c]; pv[0] = pr[2 * NUP + DFF + c]; pv[1] = pr[3 * NUP + DFF + c]; }
        } else { const float* st = p.state_cf + (size_t)(u - 128) * 2 * NUP; pg[0] = st[c]; pg[1] = st[NUP + c]; pv[0] = st[DFF + c]; pv[1] = st[NUP + DFF + c]; }
        const float cg0 = cur[c], cg1 = cur[NUP + c], cv0 = cur[DFF + c], cv1 = cur[NUP + DFF + c];
        const float wg0 = p.ffn_conv_w[c], wg1 = p.ffn_conv_w[NUP + c], wg2 = p.ffn_conv_w[2 * NUP + c], bg = p.ffn_conv_b[c];
        const float wv0 = p.ffn_conv_w[DFF + c], wv1 = p.ffn_conv_w[NUP + DFF + c], wv2 = p.ffn_conv_w[2 * NUP + DFF + c], bv = p.ffn_conv_b[DFF + c];
        float g, v;
        if (r == 0) { g = wg0 * pg[0] + wg1 * pg[1] + wg2 * cg0 + bg; v = wv0 * pv[0] + wv1 * pv[1] + wv2 * cv0 + bv; }
        else { g = wg0 * pg[1] + wg1 * cg0 + wg2 * cg1 + bg; v = wv0 * pv[1] + wv1 * cv0 + wv2 * cv1 + bv; }
        const size_t row = u < 128 ? (size_t)u * 256 + r : (size_t)MP + (size_t)(u - 128) * 32 + r;
        GT[row * DFF + c] = f2bf(silu(g) * v);
    }
}

#define MFMA16(a, b, c) __builtin_amdgcn_mfma_f32_16x16x32_bf16((a), (b), (c), 0, 0, 0)
#define MFMA32(a, b, c) __builtin_amdgcn_mfma_f32_32x32x16_bf16((a), (b), (c), 0, 0, 0)
DI bf16x8 pack8(const f32x4 a, const f32x4 b) { u32x4 o; o.x = pk2(a.x, a.y); o.y = pk2(a.z, a.w); o.z = pk2(b.x, b.y); o.w = pk2(b.z, b.w); return __builtin_bit_cast(bf16x8, o); }
constexpr float GSCALE = 0.08838834764831845f;
constexpr int QST = 132, AST = 68, NST = 136, QKST = 72;
constexpr int L_QKV = 0, L_AM = 3 * 64 * QST * 4, L_KN = L_AM + 64 * AST * 4, L_QN = L_KN + 64 * NST * 2, L_GC = L_QN + 64 * NST * 2;
constexpr int L_QKS = 0, L_WS = 64 * QKST * 2;
static_assert(L_GC + 1024 <= LDS_BYTES, "gdn prep LDS");

DI void gdn_conv_weights(const Params& p, const int h, float (&cw)[3][4]) {
#pragma unroll
    for (int k = 0; k < 3; ++k) {
        const int task = threadIdx.x + 512 * k, col = task % 384, part = col >> 7, cc = col & 127, gcol = part * 512 + h * 128 + cc;
#pragma unroll
        for (int j = 0; j < 4; ++j) cw[k][j] = p.gdn_conv_w[j * 1536 + gcol];
    }
}
DI void gdn_prep_item(const Params& p, const int item, const float (&cw)[3][4]) {
    unsigned char* ws = p.ws;
    float* QKVf = (float*)(dyn_smem + L_QKV); float* AM = (float*)(dyn_smem + L_AM);
    bf16_t* KN = (bf16_t*)(dyn_smem + L_KN); bf16_t* QN = (bf16_t*)(dyn_smem + L_QN);
    float* GC = (float*)(dyn_smem + L_GC); float* BETA = GC + 64; float* EG = GC + 128; float* ED = GC + 192;
    bf16_t* QKS = (bf16_t*)(dyn_smem + L_QKS); bf16_t* WSI = (bf16_t*)(dyn_smem + L_WS);
    const bf16_t* HQKV = (const bf16_t*)(ws + WS_R2);
    const float* AB = (const float*)(ws + WS_AB);
    float* DL = (float*)(ws + WS_DL);
        const int tid = opaque_tid(), lane = tid & 63, wave = __builtin_amdgcn_readfirstlane(tid >> 6), fr = lane & 15, fq = lane >> 4;
        int h, b, c, row0, valid; bool samp;
        if (item < 2048) { h = item & 3; c = (item >> 2) & 127; b = item >> 9; row0 = b * TP + c * 64; valid = 64; samp = false; }
        else { const int j = item - 2048; h = j & 3; b = j >> 2; c = 0; row0 = MP + b * TS; valid = TS; samp = true; }
        unsigned char* ip = ws + WS_R1 + (size_t)item * ITEM_B;
        __syncthreads();
        {
            bf16_t* RAW = (bf16_t*)(dyn_smem + L_AM);
#pragma unroll
            for (int i = 0; i < 7; ++i) {
                const int id = tid + 512 * i;
                if (id < 67 * 48) {
                    const int rw = id / 48, ch = id % 48, part = ch >> 4, c8 = (ch & 15) * 8, gcol = part * 512 + h * 128 + c8, t = rw - 3;
                    u32x4 v = (u32x4){0u, 0u, 0u, 0u};
                    if (t >= 0) {
                        if (t < valid) {
                            if (!samp) v = *(const u32x4*)(HQKV + (size_t)(row0 + t) * 1536 + gcol);
                            else { const float* sp = (const float*)(ws + WS_CS1) + (size_t)(row0 - MP + t) * NH1 + gcol; const f32x4 f0 = *(const f32x4*)sp, f1 = *(const f32x4*)(sp + 4);
                                   v.x = pk2(f0.x, f0.y); v.y = pk2(f0.z, f0.w); v.z = pk2(f1.x, f1.y); v.w = pk2(f1.z, f1.w); }
                        }
                    }
                    else if (samp) { const float* sp = p.state_cq + (size_t)(b * 3 + 3 + t) * 1536 + gcol; const f32x4 f0 = *(const f32x4*)sp, f1 = *(const f32x4*)(sp + 4);
                                     v.x = pk2(f0.x, f0.y); v.y = pk2(f0.z, f0.w); v.z = pk2(f1.x, f1.y); v.w = pk2(f1.z, f1.w); }
                    else if (c != 0) v = *(const u32x4*)(HQKV + (size_t)(row0 + t) * 1536 + gcol);
                    *(u32x4*)(RAW + rw * 384 + ch * 8) = v;
                }
            }
            __syncthreads();
#pragma unroll
            for (int k3 = 0; k3 < 3; ++k3) {
                const int task = tid + 512 * k3;
                const int col = task % 384, seg = task / 384, part = col >> 7, cc = col & 127, t0 = seg * 16;
                const float w0 = cw[k3][0], w1 = cw[k3][1], w2 = cw[k3][2], w3 = cw[k3][3];
                float x0 = bf2f(RAW[(t0) * 384 + col]), x1 = bf2f(RAW[(t0 + 1) * 384 + col]), x2 = bf2f(RAW[(t0 + 2) * 384 + col]);
#pragma unroll
                for (int t = t0; t < t0 + 16; ++t) {
                    const float xv = bf2f(RAW[(t + 3) * 384 + col]);
                    const float y = w0 * x0 + w1 * x1 + w2 * x2 + w3 * xv;
                    QKVf[(part * 64 + t) * QST + cc] = t < valid ? silu(y) : 0.f;
                    x0 = x1; x1 = x2; x2 = xv;
                }
            }
        }
        if (tid < 64) {
            float g = 0.f, be = 0.f;
            if (tid < valid) {
                const float a = AB[(size_t)(row0 + tid) * 8 + h] + p.dt_bias[h], bb = AB[(size_t)(row0 + tid) * 8 + 4 + h];
                const float sp = a > 20.f ? a : log1pf(expf(a));
                g = -expf(p.a_log[h]) * sp; be = 1.f / (1.f + expf(-bb));
            }
            float gc = g;
#pragma unroll
            for (int o = 1; o < 64; o <<= 1) { const float n = __shfl_up(gc, o); if (lane >= o) gc += n; }
            const float gl = __shfl(gc, 63);
            GC[tid] = gc; BETA[tid] = be; EG[tid] = expf(gc); ED[tid] = expf(gl - gc);
            if (tid == 0) DL[item] = expf(gl);
        }
        __syncthreads();
        {
            const int row = tid >> 3, pt = tid & 7;
            float q[16], k[16]; float sq = 0.f, sk = 0.f;
#pragma unroll
            for (int e4 = 0; e4 < 4; ++e4) {
                const f32x4 a = *(const f32x4*)(QKVf + row * QST + 16 * pt + 4 * e4), bq = *(const f32x4*)(QKVf + (64 + row) * QST + 16 * pt + 4 * e4);
#pragma unroll
                for (int e = 0; e < 4; ++e) { q[4 * e4 + e] = a[e]; k[4 * e4 + e] = bq[e]; sq += a[e] * a[e]; sk += bq[e] * bq[e]; }
            }
#pragma unroll
            for (int o = 1; o < 8; o <<= 1) { sq += __shfl_xor(sq, o); sk += __shfl_xor(sk, o); }
            const float rq = rsqrtf(sq + 1e-6f), rk = rsqrtf(sk + 1e-6f), qg = rq * GSCALE * EG[row];
            u32x4 o0, o1;
            o0.x = pk2(q[0] * rq, q[1] * rq); o0.y = pk2(q[2] * rq, q[3] * rq); o0.z = pk2(q[4] * rq, q[5] * rq); o0.w = pk2(q[6] * rq, q[7] * rq);
            o1.x = pk2(q[8] * rq, q[9] * rq); o1.y = pk2(q[10] * rq, q[11] * rq); o1.z = pk2(q[12] * rq, q[13] * rq); o1.w = pk2(q[14] * rq, q[15] * rq);
            *(u32x4*)(QN + row * NST + 16 * pt) = o0; *(u32x4*)(QN + row * NST + 16 * pt + 8) = o1;
            o0.x = pk2(k[0] * rk, k[1] * rk); o0.y = pk2(k[2] * rk, k[3] * rk); o0.z = pk2(k[4] * rk, k[5] * rk); o0.w = pk2(k[6] * rk, k[7] * rk);
            o1.x = pk2(k[8] * rk, k[9] * rk); o1.y = pk2(k[10] * rk, k[11] * rk); o1.z = pk2(k[12] * rk, k[13] * rk); o1.w = pk2(k[14] * rk, k[15] * rk);
            *(u32x4*)(KN + row * NST + 16 * pt) = o0; *(u32x4*)(KN + row * NST + 16 * pt + 8) = o1;
#pragma unroll
            for (int e4 = 0; e4 < 4; ++e4) *(f32x4*)(QKVf + (64 + row) * QST + 16 * pt + 4 * e4) = (f32x4){k[4 * e4] * rk, k[4 * e4 + 1] * rk, k[4 * e4 + 2] * rk, k[4 * e4 + 3] * rk};
            bf16_t* QGf = (bf16_t*)(ip + 16384);
            const int rt = row >> 4, frr = row & 15, ks = pt >> 1;
#pragma unroll
            for (int f = 0; f < 4; ++f) {
                u32x2 o; o.x = pk2(q[4 * f] * qg, q[4 * f + 1] * qg); o.y = pk2(q[4 * f + 2] * qg, q[4 * f + 3] * qg);
                *(u32x2*)(QGf + (size_t)(((rt * 4 + ks) * 64 + f * 16 + frr) * 8 + 4 * (pt & 1))) = o;
            }
        }
        __syncthreads();
        {
            const bool isq = wave >= 4; const int ti = wave & 3;
            const bf16_t* As = isq ? QN : KN;
#pragma unroll
            for (int tj = 0; tj < 4; ++tj) {
                f32x4 acc = (f32x4){0.f, 0.f, 0.f, 0.f};
#pragma unroll
                for (int ks = 0; ks < 4; ++ks) {
                    const bf16x8 a = *(const bf16x8*)(As + (16 * ti + fr) * NST + 32 * ks + 8 * fq), bb = *(const bf16x8*)(KN + (16 * tj + fr) * NST + 32 * ks + 8 * fq);
                    acc = MFMA16(a, bb, acc);
                }
                const int jj = 16 * tj + fr; const float gj = GC[jj];
#pragma unroll
                for (int j = 0; j < 4; ++j) {
                    const int i = 16 * ti + 4 * fq + j;
                    const float dec = i >= jj ? expf(GC[i] - gj) : 0.f;
                    if (!isq) AM[i * AST + jj] = i > jj ? BETA[i] * acc[j] * dec : 0.f;
                    else QKS[i * QKST + jj] = f2bf(GSCALE * acc[j] * dec);
                }
            }
            bf16_t* KDTf = (bf16_t*)(ip + 32768);
#pragma unroll
            for (int i2 = 0; i2 < 2; ++i2) {
                const int f = tid + 512 * i2, ln = f & 63, ks2 = (f >> 6) & 1, dt = f >> 7, fq_ = ln >> 4, dk = 16 * dt + (ln & 15);
                float v[8];
#pragma unroll
                for (int e = 0; e < 8; ++e) { const int i = 32 * ks2 + 16 * (e >> 2) + 4 * fq_ + (e & 3); v[e] = bf2f(KN[i * NST + dk]) * ED[i]; }
                u32x4 o; o.x = pk2(v[0], v[1]); o.y = pk2(v[2], v[3]); o.z = pk2(v[4], v[5]); o.w = pk2(v[6], v[7]);
                *(u32x4*)(KDTf + (size_t)f * 8) = o;
            }
        }
        __syncthreads();
        {
            float* TM = (float*)(dyn_smem + L_QN);
            float* TMP = (float*)(dyn_smem + L_KN);
#pragma unroll
            for (int i = 0; i < 9; ++i) { const int id = tid + 512 * i; if (id < 64 * AST) TM[id] = 0.f; }
            __syncthreads();
            if (tid < 64) {
                const int d = tid >> 4, c = tid & 15;
                float y[16];
#pragma unroll
                for (int r = 0; r < 16; ++r) {
                    float sacc = r == c ? 1.f : 0.f;
                    const float* ar = AM + (16 * d + r) * AST + 16 * d;
#pragma unroll
                    for (int j = 0; j < r; ++j) sacc -= ar[j] * y[j];
                    y[r] = sacc;
                    TM[(16 * d + r) * AST + 16 * d + c] = sacc;
                }
            }
            __syncthreads();
            {
                const int blk = tid >> 8, r = (tid >> 4) & 15, c = tid & 15, rb = blk ? 3 : 1, cb = rb - 1;
                float t = 0.f;
#pragma unroll
                for (int j = 0; j < 16; ++j) t += AM[(16 * rb + r) * AST + 16 * cb + j] * TM[(16 * cb + j) * AST + 16 * cb + c];
                TMP[blk * 272 + r * 17 + c] = t;
                __syncthreads();
                float o = 0.f;
#pragma unroll
                for (int k = 0; k < 16; ++k) o -= TM[(16 * rb + r) * AST + 16 * rb + k] * TMP[blk * 272 + k * 17 + c];
                __syncthreads();
                TM[(16 * rb + r) * AST + 16 * cb + c] = o;
            }
            __syncthreads();
            {
                float t[2];
#pragma unroll
                for (int i2 = 0; i2 < 2; ++i2) {
                    const int o = tid + 512 * i2, r = o >> 5, c = o & 31;
                    float acc = 0.f;
#pragma unroll
                    for (int j = 0; j < 32; ++j) acc += AM[(32 + r) * AST + j] * TM[j * AST + c];
                    t[i2] = acc;
                }
#pragma unroll
                for (int i2 = 0; i2 < 2; ++i2) { const int o = tid + 512 * i2; TMP[(o >> 5) * 33 + (o & 31)] = t[i2]; }
                __syncthreads();
#pragma unroll
                for (int i2 = 0; i2 < 2; ++i2) {
                    const int o = tid + 512 * i2, r = o >> 5, c = o & 31;
                    float acc = 0.f;
#pragma unroll
                    for (int k = 0; k < 32; ++k) acc -= TM[(32 + r) * AST + 32 + k] * TMP[k * 33 + c];
                    t[i2] = acc;
                }
#pragma unroll
                for (int i2 = 0; i2 < 2; ++i2) { const int o = tid + 512 * i2; TM[(32 + (o >> 5)) * AST + (o & 31)] = t[i2]; }
            }
            __syncthreads();
            {
                bf16x8 Ah[4][2], Al[4][2];
#pragma unroll
                for (int rt = 0; rt < 4; ++rt)
#pragma unroll
                    for (int ks = 0; ks < 2; ++ks) {
                        const f32x4 a0 = *(const f32x4*)(TM + (16 * rt + fr) * AST + 32 * ks + 8 * fq), a1 = *(const f32x4*)(TM + (16 * rt + fr) * AST + 32 * ks + 8 * fq + 4);
                        u32x4 hq; hq.x = pk2(a0.x, a0.y); hq.y = pk2(a0.z, a0.w); hq.z = pk2(a1.x, a1.y); hq.w = pk2(a1.z, a1.w);
                        u32x4 lq; lq.x = pk2(a0.x - bflo(hq.x), a0.y - bfhi(hq.x)); lq.y = pk2(a0.z - bflo(hq.y), a0.w - bfhi(hq.y));
                        lq.z = pk2(a1.x - bflo(hq.z), a1.y - bfhi(hq.z)); lq.w = pk2(a1.z - bflo(hq.w), a1.w - bfhi(hq.w));
                        Ah[rt][ks] = __builtin_bit_cast(bf16x8, hq); Al[rt][ks] = __builtin_bit_cast(bf16x8, lq);
                    }
                const bool isw = wave >= 4;
                f32x4 xacc[2][4];
#pragma unroll
                for (int q = 0; q < 2; ++q)
#pragma unroll
                    for (int rt = 0; rt < 4; ++rt) xacc[q][rt] = (f32x4){0.f, 0.f, 0.f, 0.f};
#pragma unroll
                for (int ks = 0; ks < 2; ++ks) {
                    float sc8[8];
                    {
                        const f32x4 b0 = *(const f32x4*)(BETA + 32 * ks + 8 * fq), b1 = *(const f32x4*)(BETA + 32 * ks + 8 * fq + 4);
                        const f32x4 e0 = *(const f32x4*)(EG + 32 * ks + 8 * fq), e1 = *(const f32x4*)(EG + 32 * ks + 8 * fq + 4);
#pragma unroll
                        for (int e = 0; e < 4; ++e) { sc8[e] = isw ? b0[e] * e0[e] : b0[e]; sc8[4 + e] = isw ? b1[e] * e1[e] : b1[e]; }
                    }
#pragma unroll
                    for (int q = 0; q < 2; ++q) {
                        const int cc = ((2 * wave + q) & 7) * 16 + fr;
                        const float* src = QKVf + ((isw ? 64 : 128) + 32 * ks + 8 * fq) * QST + cc;
                        float v[8];
#pragma unroll
                        for (int e = 0; e < 8; ++e) v[e] = src[e * QST] * sc8[e];
                        u32x4 hq; hq.x = pk2(v[0], v[1]); hq.y = pk2(v[2], v[3]); hq.z = pk2(v[4], v[5]); hq.w = pk2(v[6], v[7]);
                        u32x4 lq; lq.x = pk2(v[0] - bflo(hq.x), v[1] - bfhi(hq.x)); lq.y = pk2(v[2] - bflo(hq.y), v[3] - bfhi(hq.y));
                        lq.z = pk2(v[4] - bflo(hq.z), v[5] - bfhi(hq.z)); lq.w = pk2(v[6] - bflo(hq.w), v[7] - bfhi(hq.w));
                        const bf16x8 Bh = __builtin_bit_cast(bf16x8, hq), Bl = __builtin_bit_cast(bf16x8, lq);
#pragma unroll
                        for (int rt = 0; rt < 4; ++rt) {
                            xacc[q][rt] = MFMA16(Ah[rt][ks], Bh, xacc[q][rt]);
                            xacc[q][rt] = MFMA16(Al[rt][ks], Bh, xacc[q][rt]);
                            xacc[q][rt] = MFMA16(Ah[rt][ks], Bl, xacc[q][rt]);
                        }
                    }
                }
                if (!isw) {
                    float* Uc = (float*)(ip + 57344);
#pragma unroll
                    for (int q = 0; q < 2; ++q)
#pragma unroll
                        for (int rt = 0; rt < 4; ++rt) *(f32x4*)(Uc + (size_t)((((2 * wave + q) * 4 + rt) * 64 + lane) * 4)) = xacc[q][rt];
                } else {
#pragma unroll
                    for (int q = 0; q < 2; ++q)
#pragma unroll
                        for (int rt = 0; rt < 4; ++rt)
#pragma unroll
                            for (int j = 0; j < 4; ++j) WSI[(16 * rt + 4 * fq + j) * NST + ((2 * wave + q) & 7) * 16 + fr] = f2bf(xacc[q][rt][j]);
                }
            }
        }
        __syncthreads();
        {
            bf16_t* Wf = (bf16_t*)ip; bf16_t* QKf = (bf16_t*)(ip + 49152);
#pragma unroll
            for (int i2 = 0; i2 < 2; ++i2) {
                const int f = tid + 512 * i2, ln = f & 63, ks = (f >> 6) & 3, rt = f >> 8, i = 16 * rt + (ln & 15), fq_ = ln >> 4;
                const u32x2 lo = *(const u32x2*)(WSI + i * NST + 32 * ks + 4 * fq_), hi = *(const u32x2*)(WSI + i * NST + 32 * ks + 16 + 4 * fq_);
                *(u32x4*)(Wf + (size_t)f * 8) = (u32x4){lo.x, lo.y, hi.x, hi.y};
            }
            {
                const int f = tid, ln = f & 63, ks2 = (f >> 6) & 1, rt = f >> 7, i = 16 * rt + (ln & 15), fq_ = ln >> 4;
                const u32x2 lo = *(const u32x2*)(QKS + i * QKST + 32 * ks2 + 4 * fq_), hi = *(const u32x2*)(QKS + i * QKST + 32 * ks2 + 16 + 4 * fq_);
                *(u32x4*)(QKf + (size_t)f * 8) = (u32x4){lo.x, lo.y, hi.x, hi.y};
            }
        }
    __syncthreads();
}

DI void gdn_prep_phase(const Params& p) {
    unsigned char* ws = p.ws;
    for (int r = blockIdx.x; r < MS; r += gridDim.x) {
        const int tid = opaque_tid(), b = r >> 5, t = r & 31, pos = PAST + t;
        const float* cs = (const float*)(ws + WS_CS1) + (size_t)r * NH1;
        if (t >= TS - 3) { for (int c = tid; c < 1536; c += 512) p.out[O_CQS + (size_t)(b * 3 + t - (TS - 3)) * 1536 + c] = cs[c]; }
        {
            const int which = tid >> 8, pr = tid & 255, hd = pr >> 6, mp = (pr >> 5) & 1, d = pr & 31, col = hd * 128 + mp * 64 + d;
            const float2 csn = ((const float2*)(ws + WS_ROPE))[pos * 32 + d];
            const float x1 = cs[2048 + which * 512 + col], x2 = cs[2048 + which * 512 + col + 32];
            const float y1 = x1 * csn.x - x2 * csn.y, y2 = x2 * csn.x + x1 * csn.y;
            if (which == 0) { const float qs = 0.125f * 1.4426950408889634f; bf16_t* QB = (bf16_t*)(ws + WS_R4) + ((size_t)MP + r) * 512; QB[col] = f2bf(y1 * qs); QB[col + 32] = f2bf(y2 * qs); }
            else { float* ko = p.out + O_KS + (size_t)r * 512; ko[col] = y1; ko[col + 32] = y2;
                   bf16_t* kk = (bf16_t*)(ws + WS_R5) + ((size_t)MP + (size_t)b * TKS + pos) * 512; kk[col] = f2bf(y1); kk[col + 32] = f2bf(y2); }
        }
        {
            const float vv = cs[3072 + tid];
            p.out[O_VS + (size_t)r * 512 + tid] = vv;
            ((bf16_t*)(ws + WS_R6))[VT_S_OFF + ((size_t)((b * 4 + (tid >> 7)) * 128 + (tid & 127)) * TKS + pos)] = f2bf(vv);
        }
    }
    float cw[3][4];
    gdn_conv_weights(p, blockIdx.x & 3, cw);
    for (int item = blockIdx.x; item < 2048; item += gridDim.x) gdn_prep_item(p, item, cw);
}

constexpr int OPB_B = 57344, L_OBUF = 2 * OPB_B, OST = 132;
static_assert(L_OBUF + 64 * OST * 4 <= LDS_BYTES, "scan LDS");
DI void gdn_scan(const Params& p, const bool samp, const int b, const int h) {
    unsigned char* ws = p.ws;
    const int tid = threadIdx.x, lane = tid & 63, w = __builtin_amdgcn_readfirstlane(tid >> 6), fr = lane & 15, fq = lane >> 4;
    const int nsteps = samp ? 1 : 128, valid = samp ? TS : 64;
    float* OBUF = (float*)(dyn_smem + L_OBUF);
    const bf16_t* HG = (const bf16_t*)(ws + WS_R3);
    bf16_t* OMIX = (bf16_t*)(ws + WS_R2);
    const float* DL = (const float*)(ws + WS_DL);
    f32x4 S[8];
#pragma unroll
    for (int dt = 0; dt < 8; ++dt) {
        if (samp) {
#pragma unroll
            for (int j = 0; j < 4; ++j) S[dt][j] = p.state_gdn[((size_t)(b * 4 + h) * 128 + 16 * dt + 4 * fq + j) * 128 + 16 * w + fr];
        } else S[dt] = (f32x4){0.f, 0.f, 0.f, 0.f};
    }
    const int item0 = samp ? 2048 + b * 4 + h : b * 512 + h;
    __syncthreads();
    {
        const unsigned char* ip = ws + WS_R1 + (size_t)item0 * ITEM_B;
#pragma unroll
        for (int i = 0; i < 7; ++i) *(u32x4*)(dyn_smem + (tid + 512 * i) * 16) = *(const u32x4*)(ip + (tid + 512 * i) * 16);
    }
    __syncthreads();
    const int erow = tid >> 3, ept = tid & 7;
    float nw[16];
#pragma unroll
    for (int e = 0; e < 16; ++e) nw[e] = p.gdn_norm_w[16 * ept + e];
    f32x4 U[4]; float dl; u32x4 g0, g1;
    auto side_load = [&](int c, f32x4 (&Uo)[4], float& dlo, u32x4& go0, u32x4& go1) {
        const int item = item0 + 4 * c;
        const float* Uc = (const float*)(ws + WS_R1 + (size_t)item * ITEM_B + 57344);
#pragma unroll
        for (int rt = 0; rt < 4; ++rt) Uo[rt] = *(const f32x4*)(Uc + ((w * 4 + rt) * 64 + lane) * 4);
        dlo = DL[item];
        const size_t grow = (samp ? (size_t)MP + b * TS : (size_t)b * TP + (size_t)c * 64) + erow;
        if (!samp) { go0 = *(const u32x4*)(HG + grow * 512 + h * 128 + 16 * ept); go1 = *(const u32x4*)(HG + grow * 512 + h * 128 + 16 * ept + 8); }
        else if (erow < TS) { const float* gp = (const float*)(ws + WS_CS1) + (grow - MP) * NH1 + 1536 + h * 128 + 16 * ept;
               const f32x4 f0 = *(const f32x4*)gp, f1 = *(const f32x4*)(gp + 4), f2 = *(const f32x4*)(gp + 8), f3 = *(const f32x4*)(gp + 12);
               go0 = (u32x4){pk2(f0.x, f0.y), pk2(f0.z, f0.w), pk2(f1.x, f1.y), pk2(f1.z, f1.w)}; go1 = (u32x4){pk2(f2.x, f2.y), pk2(f2.z, f2.w), pk2(f3.x, f3.y), pk2(f3.z, f3.w)}; }
        else { go0 = (u32x4){0u, 0u, 0u, 0u}; go1 = go0; }
    };
    side_load(0, U, dl, g0, g1);
#pragma unroll 1
    for (int c = 0; c < nsteps; ++c) {
        const int item = item0 + 4 * c;
        const unsigned char* ip = ws + WS_R1 + (size_t)item * ITEM_B;
        const bool nxt = c + 1 < nsteps;
        u32x4 pf[7];
        f32x4 Un[4]; float dln = 0.f; u32x4 gn0 = g0, gn1 = g1;
        if (nxt) {
#pragma unroll
            for (int i = 0; i < 7; ++i) pf[i] = *(const u32x4*)(ip + 4 * (size_t)ITEM_B + (tid + 512 * i) * 16);
            side_load(c + 1, Un, dln, gn0, gn1);
        }
        const unsigned char* buf = dyn_smem + (c & 1) * OPB_B;
        bf16x8 Sb[4];
#pragma unroll
        for (int ks = 0; ks < 4; ++ks) Sb[ks] = pack8(S[2 * ks], S[2 * ks + 1]);
        f32x4 vn[4];
#pragma unroll
        for (int rt = 0; rt < 4; ++rt) {
            f32x4 acc = (f32x4){0.f, 0.f, 0.f, 0.f};
#pragma unroll
            for (int ks = 0; ks < 4; ++ks) acc = MFMA16(*(const bf16x8*)(buf + ((rt * 4 + ks) * 64 + lane) * 16), Sb[ks], acc);
            vn[rt] = U[rt] - acc;
        }
        bf16x8 Vb[2];
        Vb[0] = pack8(vn[0], vn[1]); Vb[1] = pack8(vn[2], vn[3]);
#pragma unroll
        for (int rt = 0; rt < 4; ++rt) {
            f32x4 acc = (f32x4){0.f, 0.f, 0.f, 0.f};
#pragma unroll
            for (int ks = 0; ks < 4; ++ks) acc = MFMA16(*(const bf16x8*)(buf + 16384 + ((rt * 4 + ks) * 64 + lane) * 16), Sb[ks], acc);
#pragma unroll
            for (int ks2 = 0; ks2 < 2; ++ks2) acc = MFMA16(*(const bf16x8*)(buf + 49152 + ((rt * 2 + ks2) * 64 + lane) * 16), Vb[ks2], acc);
#pragma unroll
            for (int j = 0; j < 4; ++j) OBUF[(16 * rt + 4 * fq + j) * OST + 16 * w + fr] = acc[j];
        }
#pragma unroll
        for (int dt = 0; dt < 8; ++dt) {
            f32x4 acc = S[dt] * dl;
#pragma unroll
            for (int ks2 = 0; ks2 < 2; ++ks2) acc = MFMA16(*(const bf16x8*)(buf + 32768 + ((dt * 2 + ks2) * 64 + lane) * 16), Vb[ks2], acc);
            S[dt] = acc;
        }
        if (nxt) {
#pragma unroll
            for (int i = 0; i < 7; ++i) *(u32x4*)(dyn_smem + ((c + 1) & 1) * OPB_B + (tid + 512 * i) * 16) = pf[i];
        }
        __syncthreads();
        {
            float o[16]; float ss = 0.f;
#pragma unroll
            for (int e4 = 0; e4 < 4; ++e4) { const f32x4 a = *(const f32x4*)(OBUF + erow * OST + 16 * ept + 4 * e4);
#pragma unroll
                for (int e = 0; e < 4; ++e) { o[4 * e4 + e] = a[e]; ss += a[e] * a[e]; } }
#pragma unroll
            for (int of = 1; of < 8; of <<= 1) ss += __shfl_xor(ss, of);
            if (erow < valid) {
                const float r = rsqrtf(ss * (1.f / 128.f) + 1e-6f);
                const size_t grow = (samp ? (size_t)MP + b * TS : (size_t)b * TP + (size_t)c * 64) + erow;
                const unsigned gw[8] = {g0.x, g0.y, g0.z, g0.w, g1.x, g1.y, g1.z, g1.w};
                unsigned ow[8];
#pragma unroll
                for (int e = 0; e < 8; ++e) {
                    const float ga = bflo(gw[e]), gb = bfhi(gw[e]);
                    ow[e] = pk2(o[2 * e] * r * nw[2 * e] * silu(ga), o[2 * e + 1] * r * nw[2 * e + 1] * silu(gb));
                }
                *(u32x4*)(OMIX + grow * 1024 + h * 128 + 16 * ept) = (u32x4){ow[0], ow[1], ow[2], ow[3]};
                *(u32x4*)(OMIX + grow * 1024 + h * 128 + 16 * ept + 8) = (u32x4){ow[4], ow[5], ow[6], ow[7]};
            }
        }
        __syncthreads();
#pragma unroll
        for (int rt = 0; rt < 4; ++rt) U[rt] = Un[rt];
        dl = dln; g0 = gn0; g1 = gn1;
    }
    float* So = p.out + (samp ? O_GS : O_GP) + (size_t)(b * 4 + h) * 128 * 128;
#pragma unroll
    for (int dt = 0; dt < 8; ++dt)
#pragma unroll
        for (int j = 0; j < 4; ++j) So[(size_t)(16 * dt + 4 * fq + j) * 128 + 16 * w + fr] = S[dt][j];
}

constexpr int L_KT = 0, L_VT = 2 * 16384, L_ALX = L_VT + 3 * 16384, L_IDX = L_ALX + 8 * 2 * 32 * 4, L_QF = L_IDX + 256;
static_assert(L_QF + 8 * 8 * 1024 <= LDS_BYTES, "attn LDS");
DI int crow32(int i, int hh) { return (i & 3) + 8 * (i >> 2) + 4 * hh; }

DI void attn_item(const Params& p, const int idx, const float* lamp) {
    unsigned char* ws = p.ws;
    const int tid = opaque_tid(), lane = tid & 63, w = __builtin_amdgcn_readfirstlane(tid >> 6), r = lane & 31, hh = lane >> 5;
    bool samp; int b, h, qb = 0, ntiles, lastw; size_t qbase, kbase; const bf16_t* vtb; int vstride; bool active;
    if (idx < 32) { samp = true; b = idx >> 2; h = idx & 3; qbase = (size_t)MP + b * TS; kbase = (size_t)MP + (size_t)b * TKS; ntiles = 65; lastw = 64; active = w == 0;
                    vtb = (const bf16_t*)(ws + WS_R6) + VT_S_OFF + (size_t)((b * 4 + h) * 128) * TKS; vstride = TKS; }
    else { const int j = idx - 32; samp = false; qb = 31 - (j >> 4); b = (j & 15) >> 2; h = j & 3; qbase = (size_t)b * TP + qb * 256; kbase = (size_t)b * TP; ntiles = 4 * qb + 4; lastw = 4 * qb + (w >> 1); active = true;
           vtb = (const bf16_t*)(ws + WS_R6) + (size_t)((b * 4 + h) * 128) * TP; vstride = TP; }
    const bf16_t* KALL = (const bf16_t*)(ws + WS_R5) + kbase * 512 + h * 128;
    bf16_t* QF = (bf16_t*)(dyn_smem + L_QF) + w * 8 * 64 * 8;
    {
        const bf16_t* qp = (const bf16_t*)(ws + WS_R4) + (qbase + 32 * w + r) * 512 + h * 128 + 8 * hh;
        if (active) {
#pragma unroll
            for (int f = 0; f < 8; ++f) *(u32x4*)(QF + (f * 64 + lane) * 8) = *(const u32x4*)(qp + (f >> 2) * 64 + 16 * (f & 3));
        }
    }
    f32x16 O1[4], O2[4];
#pragma unroll
    for (int t = 0; t < 4; ++t)
#pragma unroll
        for (int i = 0; i < 16; ++i) { O1[t][i] = 0.f; O2[t][i] = 0.f; }
    float m1 = -1e30f, m2 = -1e30f, l1 = 0.f, l2 = 0.f;
    auto stage_tile = [&](int kt_, int buf_, int vbuf_) {
        int ln = lane; asm volatile("" : "+v"(ln));
        const int krow_ = ln >> 4, vrow_ = ln >> 3;
        const unsigned kx = (ln & 15) ^ krow_, vx = (ln & 7) ^ (vrow_ >> 1);
        const unsigned klane = krow_ * 512, vlane = vrow_ * vstride;
#pragma unroll
        for (int j = 0; j < 2; ++j) {
            const int i = 2 * w + j;
            const bf16_t* kbase = KALL + ((size_t)kt_ * 64 + (((4 * i) & ~12) | (((4 * i) & 4) << 1) | (((4 * i) & 8) >> 1))) * 512;
            const bf16_t* vbase = vtb + (size_t)(8 * i) * vstride + (size_t)kt_ * 64;
            const unsigned ko = klane + ((kx ^ ((4 * i) & 15)) * 8), vo = vlane + ((vx ^ ((4 * i) & 7)) * 8);
            __builtin_amdgcn_global_load_lds((const unsigned*)(kbase + ko), (unsigned*)(dyn_smem + L_KT + buf_ * 16384 + i * 1024 + ln * 16), 16, 0, 0);
            __builtin_amdgcn_global_load_lds((const unsigned*)(vbase + vo), (unsigned*)(dyn_smem + L_VT + vbuf_ * 16384 + i * 1024 + ln * 16), 16, 0, 0);
        }
    };
    const int ky = hh ^ (r & 15), vzh = ((r >> 1) & 7) ^ hh;
    __syncthreads();
    stage_tile(0, 0, 0);
    asm volatile("s_waitcnt vmcnt(0)" ::: "memory");
    __syncthreads();
    if (active) {
#pragma unroll
        for (int mp = 0; mp < 2; ++mp) {
            float mx = -1e30f;
#pragma unroll
            for (int sub = 0; sub < 2; ++sub) {
                f32x16 sc;
#pragma unroll
                for (int i = 0; i < 16; ++i) sc[i] = 0.f;
#pragma unroll
                for (int s = 0; s < 4; ++s) {
                    const bf16x8 ka = *(const bf16x8*)(dyn_smem + L_KT + (sub * 32 + r) * 256 + (((mp * 8 + 2 * s) ^ ky) * 16));
                    const bf16x8 qf = *(const bf16x8*)(QF + ((mp * 4 + s) * 64 + lane) * 8);
                    sc = MFMA32(ka, qf, sc);
                }
#pragma unroll
                for (int i = 0; i < 16; ++i) mx = fmaxf(mx, sc[i]);
            }
            const auto sw = __builtin_amdgcn_permlane32_swap(__float_as_uint(mx), __float_as_uint(mx), false, false);
            mx = fmaxf(__uint_as_float(sw[0]), __uint_as_float(sw[1]));
            if (mp == 0) m1 = mx; else m2 = mx;
        }
    }
    const bool roleY = w >= 4;
    bf16x8 PA[2], PB[2];
    float tm1 = -1e30f, tm2 = -1e30f;
    int vcur = 0, vprev = 2;
#define ATT_QK(SUB, MP, SC) do { \
        _Pragma("unroll") for (int s_ = 0; s_ < 4; ++s_) { \
            const bf16x8 ka_ = *(const bf16x8*)(Kb + (SUB) * 32 * 256 + ((((MP) * 8 + 2 * s_) ^ ky) * 16)); \
            const bf16x8 qf_ = *(const bf16x8*)(QF + (((MP) * 4 + s_) * 64 + lane) * 8); \
            SC = MFMA32(ka_, qf_, s_ == 0 ? zero16 : SC); } } while (0)
#define ATT_SM(SC, P, MM, LL, TM, MSK) do { \
        float ps_ = 0.f, tq_ = TM; const float mr_ = MM + MSK; \
        _Pragma("unroll") for (int i_ = 0; i_ < 16; ++i_) { tq_ = fmaxf(tq_, SC[i_]); SC[i_] = __builtin_amdgcn_exp2f(SC[i_] - mr_); ps_ += SC[i_]; } \
        TM = MSK != 0.f ? TM : tq_; \
        LL += ps_; \
        _Pragma("unroll") for (int sp_ = 0; sp_ < 2; ++sp_) { \
            u32x4 a_; a_.x = pk2(SC[8 * sp_], SC[8 * sp_ + 1]); a_.y = pk2(SC[8 * sp_ + 2], SC[8 * sp_ + 3]); a_.z = pk2(SC[8 * sp_ + 4], SC[8 * sp_ + 5]); a_.w = pk2(SC[8 * sp_ + 6], SC[8 * sp_ + 7]); \
            P[sp_] = __builtin_bit_cast(bf16x8, a_); } } while (0)
#define ATT_PV2(VB, SUB, P1, P2) do { \
        _Pragma("unroll") for (int sp_ = 0; sp_ < 2; ++sp_) \
            _Pragma("unroll") for (int t_ = 0; t_ < 4; ++t_) { \
                const bf16x8 vb_ = *(const bf16x8*)((VB) + t_ * 32 * 128 + (((4 * (SUB) + 2 * sp_) ^ vzh) * 16)); \
                O1[t_] = MFMA32(P1[sp_], vb_, O1[t_]); O2[t_] = MFMA32(P2[sp_], vb_, O2[t_]); } } while (0)
#define ATT_QS(SUB, MSK) do { \
        f32x16 scA, scB; \
        ATT_QK(SUB, 0, scA); \
        __builtin_amdgcn_sched_barrier(0); \
        ATT_QK(SUB, 1, scB); \
        ATT_SM(scA, PA, m1, l1, tm1, MSK); \
        __builtin_amdgcn_sched_barrier(0); \
        ATT_SM(scB, PB, m2, l2, tm2, MSK); \
        __builtin_amdgcn_sched_barrier(0); } while (0)
#define ATT_CHECK() do { \
        const auto s1_ = __builtin_amdgcn_permlane32_swap(__float_as_uint(tm1), __float_as_uint(tm1), false, false); tm1 = fmaxf(__uint_as_float(s1_[0]), __uint_as_float(s1_[1])); \
        const auto s2_ = __builtin_amdgcn_permlane32_swap(__float_as_uint(tm2), __float_as_uint(tm2), false, false); tm2 = fmaxf(__uint_as_float(s2_[0]), __uint_as_float(s2_[1])); \
        const float n1 = tm1 > m1 + 8.f ? tm1 : m1, n2 = tm2 > m2 + 8.f ? tm2 : m2; \
        if (__any((n1 != m1) || (n2 != m2))) { \
            const float al1 = __builtin_amdgcn_exp2f(m1 - n1), al2 = __builtin_amdgcn_exp2f(m2 - n2); \
            l1 *= al1; l2 *= al2; m1 = n1; m2 = n2; \
            const int ln_ = __builtin_amdgcn_mbcnt_hi(~0u, __builtin_amdgcn_mbcnt_lo(~0u, 0u)), r_ = ln_ & 31, hh_ = ln_ >> 5; \
            float* alx_ = (float*)(dyn_smem + L_ALX) + w * 64; \
            if (hh_ == 0) { alx_[r_] = al1; alx_[32 + r_] = al2; } \
            asm volatile("s_waitcnt lgkmcnt(0)" ::: "memory"); \
            _Pragma("unroll") for (int g = 0; g < 4; ++g) { \
                const f32x4 a1 = *(const f32x4*)(alx_ + 8 * g + 4 * hh_), a2 = *(const f32x4*)(alx_ + 32 + 8 * g + 4 * hh_); \
                _Pragma("unroll") for (int t = 0; t < 4; ++t) \
                    _Pragma("unroll") for (int j = 0; j < 4; ++j) { O1[t][4 * g + j] *= a1[j]; O2[t][4 * g + j] *= a2[j]; } } \
            asm volatile("s_waitcnt lgkmcnt(0)" ::: "memory"); } \
        tm1 = -1e30f; tm2 = -1e30f; } while (0)
    f32x16 zero16;
#pragma unroll
    for (int i = 0; i < 16; ++i) zero16[i] = 0.f;
    if (!roleY) {
#pragma unroll 1
        for (int kt = 0; kt < ntiles; ++kt) {
            const int vnext = vcur == 2 ? 0 : vcur + 1;
            if (kt + 1 < ntiles) stage_tile(kt + 1, (kt + 1) & 1, vnext);
            const unsigned char* Kb = dyn_smem + L_KT + (kt & 1) * 16384 + r * 256;
            const unsigned char* Vb = dyn_smem + L_VT + vcur * 16384 + r * 128;
            if (active && kt <= lastw) {
                const float msk1 = (samp && kt == 64) ? 1e30f : 0.f;
#pragma unroll 1
                for (int sub = 0; sub < 2; ++sub) {
                    const float msk = sub ? msk1 : 0.f;
                    ATT_QS(sub, msk);
                    ATT_PV2(Vb, sub, PA, PB);
                    __builtin_amdgcn_sched_barrier(0);
                }
                ATT_CHECK();
            }
            vcur = vnext;
            asm volatile("s_waitcnt vmcnt(0)" ::: "memory");
            __builtin_amdgcn_s_barrier();
        }
    } else {
#pragma unroll 1
        for (int kt = 0; kt < ntiles; ++kt) {
            const int vnext = vcur == 2 ? 0 : vcur + 1;
            if (kt + 1 < ntiles) stage_tile(kt + 1, (kt + 1) & 1, vnext);
            const unsigned char* Kb = dyn_smem + L_KT + (kt & 1) * 16384 + r * 256;
            const unsigned char* Vb = dyn_smem + L_VT + vcur * 16384 + r * 128;
            const unsigned char* Vp = dyn_smem + L_VT + vprev * 16384 + r * 128;
            if (kt <= lastw + 1) {
                if (kt > 0) { ATT_PV2(Vp, 1, PA, PB); __builtin_amdgcn_sched_barrier(0); }
                if (kt <= lastw) {
                    ATT_CHECK();
                    ATT_QS(0, 0.f);
                    ATT_PV2(Vb, 0, PA, PB);
                    __builtin_amdgcn_sched_barrier(0);
                    ATT_QS(1, 0.f);
                }
            }
            vprev = vcur; vcur = vnext;
            asm volatile("s_waitcnt vmcnt(0)" ::: "memory");
            __builtin_amdgcn_s_barrier();
        }
        if (lastw == ntiles - 1) {
            const unsigned char* Vp = dyn_smem + L_VT + vprev * 16384 + r * 128;
            ATT_PV2(Vp, 1, PA, PB);
        }
    }
    if (active) {
        const int lnf = __builtin_amdgcn_mbcnt_hi(~0u, __builtin_amdgcn_mbcnt_lo(~0u, 0u)), r = lnf & 31, hh = lnf >> 5;
        float* ALX = (float*)(dyn_smem + L_ALX) + w * 64;
        { const auto s1_ = __builtin_amdgcn_permlane32_swap(__float_as_uint(l1), __float_as_uint(l1), false, false); l1 = __uint_as_float(s1_[0]) + __uint_as_float(s1_[1]);
          const auto s2_ = __builtin_amdgcn_permlane32_swap(__float_as_uint(l2), __float_as_uint(l2), false, false); l2 = __uint_as_float(s2_[0]) + __uint_as_float(s2_[1]); }
        if (hh == 0) { ALX[r] = __builtin_amdgcn_rcpf(l1); ALX[32 + r] = *lamp * __builtin_amdgcn_rcpf(l2); }
        asm volatile("s_waitcnt lgkmcnt(0)" ::: "memory");
        float ss[16], a1[16], a2[16];
#pragma unroll
        for (int g = 0; g < 4; ++g) {
            const f32x4 x1 = *(const f32x4*)(ALX + 8 * g + 4 * hh), x2 = *(const f32x4*)(ALX + 32 + 8 * g + 4 * hh);
#pragma unroll
            for (int j = 0; j < 4; ++j) { a1[4 * g + j] = x1[j]; a2[4 * g + j] = x2[j]; ss[4 * g + j] = 0.f; }
        }
#pragma unroll
        for (int t = 0; t < 4; ++t) {
            __builtin_amdgcn_sched_barrier(0);
#pragma unroll
            for (int i = 0; i < 16; ++i) { const float o = O1[t][i] * a1[i] - O2[t][i] * a2[i]; O1[t][i] = o; ss[i] += o * o; }
        }
        __builtin_amdgcn_sched_barrier(0);
#pragma unroll
        for (int i = 0; i < 16; ++i) {
#pragma unroll
            for (int of = 1; of < 32; of <<= 1) ss[i] += __shfl_xor(ss[i], of);
            ss[i] = __builtin_amdgcn_rsqf(ss[i] * (1.f / 128.f) + 1e-6f) * (1.f - LAM_INIT);
        }
        int zo = 0; asm volatile("" : "+v"(zo));
        bf16_t* obase = (bf16_t*)(ws + WS_R2) + (qbase + 32 * w) * 1024 + 512 + h * 128;
        const unsigned ooff = (unsigned)((4 * hh + zo) * 1024 + r);
        const float* sw = p.subln_w + r + zo;
#pragma unroll
        for (int t = 0; t < 4; ++t) {
            const float wv = sw[32 * t];
#pragma unroll
            for (int i = 0; i < 16; ++i) obase[ooff + ((i & 3) + 8 * (i >> 2)) * 1024 + 32 * t] = f2bf(O1[t][i] * ss[i] * wv);
        }
    }
}

DI void mixer_phase(const Params& p) {
    const int bid = blockIdx.x;
#ifndef NO_SCAN
    if (bid >= 16 && bid < 48) {
        float cw[3][4];
        gdn_conv_weights(p, (bid - 16) & 3, cw);
        gdn_prep_item(p, 2048 + bid - 16, cw);
        asm volatile("s_waitcnt vmcnt(0)" ::: "memory");
        __builtin_amdgcn_fence(__ATOMIC_ACQUIRE, "agent");
        asm volatile("s_waitcnt vmcnt(0)" ::: "memory");
        __syncthreads();
    }
    if (bid < 48) { const bool sm = bid >= 16; const int j = sm ? bid - 16 : bid;
#pragma unroll 1
        for (int rep = 0; rep < SREP; ++rep) gdn_scan(p, sm, j >> 2, j & 3); }
#endif
    unsigned* ctl = (unsigned*)(p.ws + WS_CTL);
    int* sidx = (int*)(dyn_smem + L_IDX);
    for (;;) {
        __syncthreads();
        if (threadIdx.x == 0) *sidx = (int)atomicAdd(ctl, 1u);
        __syncthreads();
        const int idx0 = __builtin_amdgcn_readfirstlane(*sidx);
        if (idx0 >= (32 + 512) * AREP) break;
        const int idx = idx0 % (32 + 512);
#ifndef NO_ATTN
        attn_item(p, idx, (const float*)ctl + 1);
#endif
    }
}


#define XB_TMO      128
#define XB_XCNT(j)  (256  + 64 * (j))
#define XB_XSUB(j)  (1280 + 64 * (j))
#define XB_XGEN(j)  (2304 + 64 * (j))
#define XB_TOP      3328
#define XB_TOPGEN   3392
#define XCD_BAR_WORDS 3456
#define XB_SPIN_CAP (1u << 20)
#define LAS __attribute__((address_space(3)))
DI unsigned xb_ld(unsigned* p) { return __hip_atomic_load(p, __ATOMIC_RELAXED, __HIP_MEMORY_SCOPE_AGENT); }
DI unsigned xb_add(unsigned* p, unsigned v) { return __hip_atomic_fetch_add(p, v, __ATOMIC_RELAXED, __HIP_MEMORY_SCOPE_AGENT); }
DI unsigned xb_xcc_id() { return (unsigned)__builtin_amdgcn_s_getreg((3 << 11) | 20) & 0xFu; }
#define XB_SPIN(cond, bar) do { unsigned _sp = 0; while (cond) { __builtin_amdgcn_s_sleep(1); \
    if ((++_sp & 255u) == 0u) { if (xb_ld(&(bar)[XB_TMO])) break; if (_sp > XB_SPIN_CAP) { atomicAdd(&(bar)[XB_TMO], 1u); break; } } } } while (0)
struct XcdBarrier { unsigned* bar; unsigned x; volatile LAS unsigned* st; };
DI XcdBarrier xcd_barrier_post(unsigned* bar, volatile LAS unsigned* st) {
    XcdBarrier b; b.bar = bar; b.x = xb_xcc_id(); b.st = st;
    if (threadIdx.x == 0) (void)xb_add(&bar[XB_XCNT(b.x)], 1u);
    return b;
}
DI void xcd_barrier_complete(unsigned* bar, unsigned x, unsigned& nloc, unsigned& nx) {
    const unsigned G = gridDim.x * gridDim.y * gridDim.z;
    unsigned sum, cnt, mine, sp = 0u;
    for (;;) {
        sum = 0u; cnt = 0u; mine = 0u;
#pragma unroll
        for (unsigned j = 0; j < 16; ++j) { const unsigned c = xb_ld(&bar[XB_XCNT(j)]); sum += c; cnt += (c > 0u) ? 1u : 0u; mine = (j == x) ? c : mine; }
        if (sum == G) break;
        __builtin_amdgcn_s_sleep(1);
        if ((++sp & 255u) == 0u) { if (xb_ld(&bar[XB_TMO])) break; if (sp > XB_SPIN_CAP) { atomicAdd(&bar[XB_TMO], 1u); break; } }
    }
    nloc = mine > 0u ? mine : 1u; nx = cnt > 0u ? cnt : 1u;
}
DI void xcd_barrier(const XcdBarrier& b) {
    asm volatile("s_waitcnt vmcnt(0)" ::: "memory");
    __syncthreads();
    if (threadIdx.x == 0) {
        unsigned* bar = b.bar;
        __builtin_amdgcn_s_waitcnt(0);
        unsigned nloc = b.st[0], nx = b.st[1];
        if (nloc == 0u) { xcd_barrier_complete(bar, b.x, nloc, nx); b.st[0] = nloc; b.st[1] = nx; }
        const unsigned old = xb_add(&bar[XB_XSUB(b.x)], 1u);
        const unsigned gen = old / nloc;
        if (old + 1u == (gen + 1u) * nloc) {
            __builtin_amdgcn_fence(__ATOMIC_RELEASE, "agent");
            asm volatile("s_waitcnt vmcnt(0)" ::: "memory");
            const unsigned og = xb_add(&bar[XB_TOP], 1u);
            const unsigned tg = og / nx;
            if (og + 1u == (tg + 1u) * nx) xb_add(&bar[XB_TOPGEN], 1u);
            else XB_SPIN(xb_ld(&bar[XB_TOPGEN]) == tg, bar);
            __builtin_amdgcn_fence(__ATOMIC_ACQUIRE, "agent");
            xb_add(&bar[XB_XGEN(b.x)], 1u);
            asm volatile("s_waitcnt vmcnt(0)" ::: "memory");
        } else {
            XB_SPIN(xb_ld(&bar[XB_XGEN(b.x)]) == gen, bar);
            __builtin_amdgcn_fence(__ATOMIC_ACQUIRE, "agent");
            asm volatile("s_waitcnt vmcnt(0)" ::: "memory");
        }
    }
    __syncthreads();
}

__global__ void __launch_bounds__(512, 2) fwd_kernel(Params p) {
    cg::grid_group grid = cg::this_grid();
    volatile LAS unsigned* xst = (volatile LAS unsigned*)(dyn_smem + LDS_BYTES - 16);
    if (threadIdx.x == 0) { xst[0] = 0u; xst[1] = 0u; }
    __syncthreads();
    const XcdBarrier xb = xcd_barrier_post((unsigned*)(p.ws + WS_BAR), xst);
    if (p.phase_lo > 1000) grid.sync();
    const bool all = p.phase_hi - p.phase_lo > 1;
#define PHASE(i, body) if (p.phase_lo <= (i) && (i) < p.phase_hi) { body; if (all && (i) + 1 < p.phase_hi) xcd_barrier(xb); }
    PHASE(0, phase_prep(p))
    PHASE(1, gemm_phase<1>(p))
    PHASE(2, gdn_prep_phase(p))
    PHASE(3, mixer_phase(p))
    PHASE(4, gemm_phase<2>(p))
    PHASE(5, ln_phase<0>(p))
    PHASE(6, gemm_phase<3>(p))
    PHASE(7, fixup_phase(p))
    PHASE(8, gemm_phase<4>(p))
    PHASE(9, ln_phase<1>(p))
}

extern "C" void kernel_launch(void* const* d_in, const int* in_sizes, int n_in, void* d_out, int out_size, void* d_ws, size_t ws_size, hipStream_t stream) {
    static int grid = 0;
    if (grid == 0) {
        if (n_in != 23 || (size_t)out_size != O_END || ws_size < WS_END2) { fprintf(stderr, "kernel_launch: unexpected sizes n_in %d out %d ws %zu (need %zu)\n", n_in, out_size, ws_size, (size_t)WS_END2); grid = -1; return; }
        int dev = 0, cus = 0, per_cu = 0;
        hipGetDevice(&dev);
        hipDeviceGetAttribute(&cus, hipDeviceAttributeMultiprocessorCount, dev);
        if (hipFuncSetAttribute((const void*)fwd_kernel, hipFuncAttributeMaxDynamicSharedMemorySize, LDS_BYTES) != hipSuccess) { fprintf(stderr, "kernel_launch: hipFuncSetAttribute failed\n"); grid = -1; return; }
        hipOccupancyMaxActiveBlocksPerMultiprocessor(&per_cu, (const void*)fwd_kernel, 512, LDS_BYTES);
        if (per_cu < 1) { fprintf(stderr, "kernel_launch: occupancy query says %d\n", per_cu); per_cu = 1; }
        (void)hipGetLastError();
        grid = cus * 1;
    }
    if (grid < 0) return;
    Params p{};
    const float** f = (const float**)&p;
    for (int i = 0; i < 23; ++i) f[i] = (const float*)d_in[i];
    p.out = (float*)d_out; p.ws = (unsigned char*)d_ws; p.phase_lo = 0; p.phase_hi = 10;
    if (hipMemsetAsync((unsigned char*)d_ws + WS_BAR, 0, 16384, stream) != hipSuccess) { fprintf(stderr, "kernel_launch: memset failed\n"); return; }
    void* args[] = {&p};
    hipError_t e = hipLaunchCooperativeKernel((const void*)fwd_kernel, dim3(grid), dim3(512), args, LDS_BYTES, stream);
    if (e != hipSuccess) fprintf(stderr, "cooperative launch failed: %s (grid %d)\n", hipGetErrorString(e), grid);
}
```

```cpp
#include <hip/hip_runtime.h>
#include <hip/hip_cooperative_groups.h>
#include <cstdio>
namespace cg = cooperative_groups;
#ifndef GREP_WHICH
#define GREP_WHICH 0
#endif
#ifndef AREP
#define AREP 1
#endif
#ifndef SREP
#define SREP 1
#endif

typedef unsigned short bf16_t;
typedef short bf16x8 __attribute__((ext_vector_type(8)));
typedef short s16x4 __attribute__((ext_vector_type(4)));
typedef float f32x4 __attribute__((ext_vector_type(4)));
typedef float f32x16 __attribute__((ext_vector_type(16)));
typedef unsigned u32x4 __attribute__((ext_vector_type(4)));
typedef unsigned u32x2 __attribute__((ext_vector_type(2)));
#define DI __device__ __forceinline__

constexpr int D = 1024, TP = 8192, BP = 4, MP = BP * TP, BS = 8, TS = 32, MS = BS * TS, M = MP + MS, PAST = 4096;
constexpr int DIN = 3592, NH1 = 3584, DFF = 2816, NUP = 2 * DFF;
constexpr int TKS = 4160;
constexpr int NITEM = BP * 128 * 4 + BS * 4;
constexpr int ITEM_B = 90112;
constexpr int LDS_BYTES = 160 * 1024;
constexpr float ALPHA = 1.189207115002721f;
constexpr float LAM_INIT = 0.2f;

constexpr size_t O_Y = 0, O_KP = 33816576, O_VP = 50593792, O_GP = 67371008, O_CQP = 67633152, O_CFP = 67651584,
                 O_KS = 67696640, O_VS = 67827712, O_GS = 67958784, O_CQS = 68483072, O_CFS = 68519936, O_END = 68610048;

constexpr size_t al256(size_t x) { return (x + 255) & ~(size_t)255; }
constexpr size_t WS_CTL = 0;
constexpr size_t WS_ROPE = 4096;
constexpr size_t WS_AB = WS_ROPE + (size_t)8192 * 32 * 8;
constexpr size_t WS_DL = WS_AB + (size_t)M * 8 * 4;
constexpr size_t WS_WIN = al256(WS_DL + NITEM * 4);
constexpr size_t WS_WO = WS_WIN + (size_t)NH1 * D * 2;
constexpr size_t WS_WUP = WS_WO + (size_t)D * D * 2;
constexpr size_t WS_WDN = WS_WUP + (size_t)NUP * D * 2;
constexpr size_t WS_R1 = al256(WS_WDN + (size_t)D * DFF * 2);
constexpr size_t R1_SIZE = (size_t)NITEM * ITEM_B;
constexpr size_t WS_R2 = al256(WS_R1 + R1_SIZE);
constexpr size_t WS_R3 = al256(WS_R2 + (size_t)M * 1536 * 2);
constexpr size_t WS_R4 = WS_R3 + (size_t)M * 512 * 2;
constexpr size_t WS_R5 = al256(WS_R4 + (size_t)M * 512 * 2);
constexpr size_t KROWS = (size_t)MP + (size_t)BS * TKS;
constexpr size_t WS_R6 = al256(WS_R5 + KROWS * 512 * 2);
constexpr size_t VT_S_OFF = (size_t)BP * 4 * 128 * TP;
constexpr size_t WS_END = al256(WS_R6 + (VT_S_OFF + (size_t)BS * 4 * 128 * TKS) * 2);
constexpr size_t WS_CS1 = WS_END;
constexpr size_t WS_CS2 = WS_CS1 + (size_t)MS * NH1 * 4;
constexpr size_t WS_CS3 = WS_CS2 + (size_t)MS * D * 4;
constexpr size_t WS_CS4 = WS_CS3 + (size_t)MS * NUP * 4;
constexpr size_t WS_BAR = WS_CS4 + (size_t)MS * D * 4;
constexpr size_t WS_END2 = WS_BAR + 16384;
static_assert((size_t)M * DFF * 2 <= R1_SIZE, "GT must fit R1");
static_assert(WS_END2 <= (size_t)536870912, "workspace too large");

struct Params {
    const float *x_p, *x_s, *cache_k, *cache_v, *state_gdn, *state_cq, *state_cf;
    const float *w_in, *gdn_conv_w, *a_log, *dt_bias, *gdn_norm_w, *diff_lambda, *subln_w, *w_o, *ln1_g, *ln1_b, *w_up,
        *ffn_conv_w, *ffn_conv_b, *w_down, *ln2_g, *ln2_b;
    float* out; unsigned char* ws;
    int phase_lo, phase_hi;
};

extern __shared__ __attribute__((aligned(16))) unsigned char dyn_smem[];

typedef __bf16 bf16x2_t __attribute__((ext_vector_type(2)));
typedef float f32x2 __attribute__((ext_vector_type(2)));
DI unsigned pk2(float lo, float hi) { f32x2 v = {lo, hi}; bf16x2_t b = __builtin_convertvector(v, bf16x2_t); return __builtin_bit_cast(unsigned, b); }
DI bf16_t f2bf(float x) { return (bf16_t)(pk2(x, 0.f) & 0xffffu); }
DI float bf2f(bf16_t b) { return __uint_as_float(((unsigned)b) << 16); }
DI float bflo(unsigned u) { return __uint_as_float(u << 16); }
DI float bfhi(unsigned u) { return __uint_as_float(u & 0xffff0000u); }
DI float silu(float x) { return x * __builtin_amdgcn_rcpf(1.f + __expf(-x)); }
DI int opaque_tid() { int t = threadIdx.x; asm volatile("" : "+v"(t)); return t; }
DI float wave_sum(float v) {
#pragma unroll
    for (int o = 1; o < 64; o <<= 1) v += __shfl_xor(v, o);
    return v;
}
DI const float* xrow_ptr(const Params& p, int row) { return row < MP ? p.x_p + (size_t)row * D : p.x_s + (size_t)(row - MP) * D; }

template <int MODE> DI int srccol(int n) {
    if (MODE == 1) {
        if (n < 2048) return n;
        return n + 8;
    }
    if (MODE == 2) { const int pn = n >> 8, j = n & 255; return j < 128 ? 128 * pn + j : DFF + 128 * pn + (j - 128); }
    return n;
}
struct TrItem { const float* W; bf16_t* WT; int K, N, k0, n0, mode; };
DI TrItem tr_decode(const Params& p, int it) {
    constexpr int I_IN = 16 * 56, I_O = 16 * 16, I_UP = 16 * 88;
    unsigned char* ws = p.ws; TrItem t; int r = it;
    if (r < I_IN) { t.W = p.w_in; t.WT = (bf16_t*)(ws + WS_WIN); t.K = D; t.N = DIN; t.k0 = (r / 56) * 64; t.n0 = (r % 56) * 64; t.mode = 1; return t; } r -= I_IN;
    if (r < I_O) { t.W = p.w_o; t.WT = (bf16_t*)(ws + WS_WO); t.K = D; t.N = D; t.k0 = (r / 16) * 64; t.n0 = (r % 16) * 64; t.mode = 0; return t; } r -= I_O;
    if (r < I_UP) { t.W = p.w_up; t.WT = (bf16_t*)(ws + WS_WUP); t.K = D; t.N = NUP; t.k0 = (r / 88) * 64; t.n0 = (r % 88) * 64; t.mode = 2; return t; } r -= I_UP;
    t.W = p.w_down; t.WT = (bf16_t*)(ws + WS_WDN); t.K = DFF; t.N = D; t.k0 = (r / 16) * 64; t.n0 = (r % 16) * 64; t.mode = 0; return t;
}
DI void tr_load(const TrItem& t, float (&v)[8]) {
    const int tid = threadIdx.x, n = t.n0 + (tid & 63);
    const int sc = t.mode == 1 ? (n < 2048 ? n : n + 8) : (t.mode == 2 ? srccol<2>(n) : n);
#pragma unroll
    for (int i = 0; i < 8; ++i) v[i] = t.W[(size_t)(t.k0 + (tid >> 6) + 8 * i) * t.N + sc];
}
DI void phase_prep(const Params& p) {
    const int tid = threadIdx.x, lane = tid & 63, wave = tid >> 6, nb = gridDim.x, bid = blockIdx.x;
    unsigned char* ws = p.ws;
    if (bid == 0 && tid < 64) {
        unsigned* ctl = (unsigned*)(ws + WS_CTL);
        float a = p.diff_lambda[lane] * p.diff_lambda[64 + lane], b = p.diff_lambda[128 + lane] * p.diff_lambda[192 + lane];
        a = wave_sum(a); b = wave_sum(b);
        if (lane == 0) { ctl[0] = 0u; ((float*)ctl)[1] = expf(a) - expf(b) + LAM_INIT; }
    }
    {
        constexpr int NT = 16 * 56 + 16 * 16 + 16 * 88 + 44 * 16;
        float* lds = (float*)dyn_smem;
        float v[8];
        TrItem cur = tr_decode(p, bid < NT ? bid : 0);
        if (bid < NT) tr_load(cur, v);
        for (int it = bid; it < NT; it += nb) {
            float nv[8]; TrItem nx = cur;
            if (it + nb < NT) { nx = tr_decode(p, it + nb); tr_load(nx, nv); }
#pragma unroll
            for (int i = 0; i < 8; ++i) lds[((tid >> 6) + 8 * i) * 65 + (tid & 63)] = v[i];
            __syncthreads();
#pragma unroll
            for (int i = 0; i < 8; ++i) { const int nn = (tid >> 6) + 8 * i, kk = tid & 63; cur.WT[(size_t)(cur.n0 + nn) * cur.K + cur.k0 + kk] = f2bf(lds[kk * 65 + nn]); }
            __syncthreads();
#pragma unroll
            for (int i = 0; i < 8; ++i) v[i] = nv[i];
            cur = nx;
        }
    }
    {
        float2* rope = (float2*)(ws + WS_ROPE);
        for (int idx = bid * 512 + tid; idx < 8192 * 32; idx += nb * 512) {
            const int pos = idx >> 5, d = idx & 31;
            const double inv = exp(-(double)d * (9.210340371976184 / 32.0));
            double a = (double)pos * inv;
            a -= 6.283185307179586 * rint(a * 0.15915494309189535);
            const float af = (float)a;
            rope[idx] = make_float2(__cosf(af), __sinf(af));
        }
    }
    {
        float* w8 = (float*)dyn_smem;
        __syncthreads();
        for (int i = tid; i < 1024 * 8; i += 512) w8[i] = p.w_in[(size_t)(i >> 3) * DIN + 2048 + (i & 7)];
        __syncthreads();
        bf16_t* XB = (bf16_t*)(ws + WS_R1);
        float* AB = (float*)(ws + WS_AB);
        f32x4 cv[4];
        {
            const int row = bid * 8 + wave;
            if (row < M) { const float* xr = xrow_ptr(p, row);
#pragma unroll
                for (int j = 0; j < 4; ++j) cv[j] = *(const f32x4*)(xr + lane * 4 + 256 * j); }
        }
        for (int row = bid * 8 + wave; row < M; row += nb * 8) {
            f32x4 nvx[4];
            if (row + nb * 8 < M) { const float* xn = xrow_ptr(p, row + nb * 8);
#pragma unroll
                for (int j = 0; j < 4; ++j) nvx[j] = *(const f32x4*)(xn + lane * 4 + 256 * j); }
            float acc[8];
#pragma unroll
            for (int c = 0; c < 8; ++c) acc[c] = 0.f;
#pragma unroll
            for (int j = 0; j < 4; ++j) {
                const int k0 = lane * 4 + 256 * j;
                const f32x4 v = cv[j];
                u32x2 o; o.x = pk2(v.x, v.y); o.y = pk2(v.z, v.w);
                *(u32x2*)(XB + (size_t)row * D + k0) = o;
#pragma unroll
                for (int e = 0; e < 4; ++e) {
                    const f32x4 wa = *(const f32x4*)(w8 + (k0 + e) * 8), wb = *(const f32x4*)(w8 + (k0 + e) * 8 + 4);
                    const float xv = v[e];
                    acc[0] += xv * wa.x; acc[1] += xv * wa.y; acc[2] += xv * wa.z; acc[3] += xv * wa.w;
                    acc[4] += xv * wb.x; acc[5] += xv * wb.y; acc[6] += xv * wb.z; acc[7] += xv * wb.w;
                }
            }
#pragma unroll
            for (int c = 0; c < 8; ++c) acc[c] = wave_sum(acc[c]);
            if (lane == 0) { *(f32x4*)(AB + (size_t)row * 8) = (f32x4){acc[0], acc[1], acc[2], acc[3]}; *(f32x4*)(AB + (size_t)row * 8 + 4) = (f32x4){acc[4], acc[5], acc[6], acc[7]}; }
#pragma unroll
            for (int j = 0; j < 4; ++j) cv[j] = nvx[j];
        }
        __syncthreads();
    }
    {
        bf16_t* KALL = (bf16_t*)(ws + WS_R5);
        const int nchunk = BS * TKS * 64;
        for (int c0 = bid * 512 + tid; c0 < nchunk; c0 += nb * 512 * 4) {
            f32x4 v0[4], v1[4]; int st[4]; size_t dsto[4];
#pragma unroll
            for (int u = 0; u < 4; ++u) {
                const int c = c0 + u * nb * 512;
                st[u] = 0;
                if (c < nchunk) {
                    const int col8 = c & 63, r = c >> 6, b = r / TKS, pp = r % TKS;
                    dsto[u] = ((size_t)MP + (size_t)b * TKS + pp) * 512 + col8 * 8;
                    if (pp < PAST) { const float* sp = p.cache_k + ((size_t)(b * PAST + pp) * 512 + col8 * 8); v0[u] = *(const f32x4*)sp; v1[u] = *(const f32x4*)(sp + 4); st[u] = 1; }
                    else if (pp >= PAST + TS) st[u] = 2;
                }
            }
#pragma unroll
            for (int u = 0; u < 4; ++u) {
                if (st[u] == 1) { u32x4 o; o.x = pk2(v0[u].x, v0[u].y); o.y = pk2(v0[u].z, v0[u].w); o.z = pk2(v1[u].x, v1[u].y); o.w = pk2(v1[u].z, v1[u].w); *(u32x4*)(KALL + dsto[u]) = o; }
                else if (st[u] == 2) *(u32x4*)(KALL + dsto[u]) = (u32x4){0u, 0u, 0u, 0u};
            }
        }
    }
    {
        bf16_t* VTS = (bf16_t*)(ws + WS_R6) + VT_S_OFF;
        bf16_t* t = (bf16_t*)dyn_smem;
        f32x4 cvv[4];
        auto ldv = [&](int it, f32x4 (&v)[4]) {
            const int blk = it % 65, bh = it / 65, b = bh >> 2, h = bh & 3;
            if (blk < 64) {
#pragma unroll
                for (int i = 0; i < 4; ++i) { const int id = tid + 512 * i, key = id >> 5, c4 = id & 31;
                    v[i] = *(const f32x4*)(p.cache_v + ((size_t)(b * PAST + blk * 64 + key) * 512 + h * 128 + c4 * 4)); }
            }
        };
        if (bid < BS * 4 * 65) ldv(bid, cvv);
        for (int it = bid; it < BS * 4 * 65; it += nb) {
            const int blk = it % 65, bh = it / 65;
            f32x4 nvv[4];
            if (it + nb < BS * 4 * 65) ldv(it + nb, nvv);
            if (blk < 64) {
                __syncthreads();
#pragma unroll
                for (int i = 0; i < 4; ++i) {
                    const int id = tid + 512 * i, key = id >> 5, c4 = id & 31;
                    const f32x4 v = cvv[i];
                    bf16_t* d = t + key * 130 + c4 * 4;
                    *(unsigned*)d = pk2(v.x, v.y); *(unsigned*)(d + 2) = pk2(v.z, v.w);
                }
                __syncthreads();
                const int dv = tid >> 2, part = tid & 3;
                unsigned o[8];
#pragma unroll
                for (int i = 0; i < 8; ++i) { const int k0 = part * 16 + 2 * i; o[i] = (unsigned)t[k0 * 130 + dv] | ((unsigned)t[(k0 + 1) * 130 + dv] << 16); }
                bf16_t* dst = VTS + ((size_t)(bh * 128 + dv) * TKS + blk * 64 + part * 16);
                *(u32x4*)dst = (u32x4){o[0], o[1], o[2], o[3]}; *(u32x4*)(dst + 8) = (u32x4){o[4], o[5], o[6], o[7]};
            } else {
                if (tid < 128) { bf16_t* dst = VTS + ((size_t)(bh * 128 + tid) * TKS + PAST + TS);
#pragma unroll
                    for (int i = 0; i < 4; ++i) *(u32x4*)(dst + 8 * i) = (u32x4){0u, 0u, 0u, 0u}; }
            }
#pragma unroll
            for (int i = 0; i < 4; ++i) cvv[i] = nvv[i];
        }
        __syncthreads();
    }
}

constexpr int BM = 256, BK = 64, HALF = 128, NXCD = 8, WGM = 8, HT = HALF * BK;
DI void stage_rc(int b, int& R, int& C) {
    const int st = b / 1024, sb = b % 1024, swz = sb ^ (((sb >> 9) & 1) << 5);
    R = (st >> 1) * 16 + swz / 64; C = (st & 1) * 32 + (swz % 64) / 2;
}
DI int lds_byte(int r, int c) {
    const int st = (r >> 4) * 2 + (c >> 5), rr = r & 15, cc = c & 31, ob = rr * 64 + cc * 2;
    return st * 1024 + (ob ^ (((ob >> 9) & 1) << 5));
}

#define SHM ((bf16_t*)dyn_smem)
#define SA(b, h) (SHM + ((b) * 2 + (h)) * HT)
#define SB(b, h) (SHM + (4 + (b) * 2 + (h)) * HT)
#define STAGE(P, BASE, br, kt) do { const bf16_t* _gb = (BASE) + ((long)(br) * K + (long)(kt) * BK); \
      __builtin_amdgcn_global_load_lds((const unsigned*)(_gb + so0), (unsigned*)((char*)(P) + wlds), 16, 0, 0); \
      __builtin_amdgcn_global_load_lds((const unsigned*)(_gb + 64 * K + so0), (unsigned*)((char*)(P) + wlds + 8192), 16, 0, 0); } while (0)
#define LDA(dst, b, h) for (int m = 0; m < 4; ++m) for (int k = 0; k < 2; ++k) \
    dst[m][k] = *reinterpret_cast<const bf16x8*>((char*)SA(b, h) + lds_byte(wr * 64 + m * 16 + fr, k * 32 + fq * 8))
#define LDB(dst, b, h) for (int n = 0; n < 2; ++n) for (int k = 0; k < 2; ++k) \
    dst[n][k] = *reinterpret_cast<const bf16x8*>((char*)SB(b, h) + lds_byte(wc * 32 + n * 16 + fr, k * 32 + fq * 8))
#define MMA(ai, bj, At, Bt_) do { __builtin_amdgcn_s_setprio(1); \
    for (int m = 0; m < 4; ++m) for (int n = 0; n < 2; ++n) for (int k = 0; k < 2; ++k) \
      acc[ai][bj][m][n] = __builtin_amdgcn_mfma_f32_16x16x32_bf16(Bt_[n][k], At[m][k], acc[ai][bj][m][n], 0, 0, 0); \
    __builtin_amdgcn_s_setprio(0); } while (0)
#define WAIT_V(n) asm volatile("s_waitcnt vmcnt(" #n ")" ::: "memory")
#define WAIT_L(n) asm volatile("s_waitcnt lgkmcnt(" #n ")" ::: "memory")
#define BAR __builtin_amdgcn_s_barrier()
#define SCHED __builtin_amdgcn_sched_barrier(0)

template <int K> DI void gemm_tile(const bf16_t* __restrict__ A, const bf16_t* __restrict__ Bt, const int brow, const int bcol, f32x4 (&acc)[2][2][4][2]) {
    const int wid = threadIdx.x >> 6, lane = threadIdx.x & 63, wr = wid >> 2, wc = wid & 3, fr = lane & 15, fq = lane >> 4;
    unsigned so0;
    { int _r, _c; stage_rc(threadIdx.x * 16, _r, _c); so0 = (unsigned)(_r * K + _c); }
    const int wlds = __builtin_amdgcn_readfirstlane((int)(threadIdx.x >> 6) << 10);
#pragma unroll
    for (int a = 0; a < 2; ++a)
#pragma unroll
        for (int b = 0; b < 2; ++b)
#pragma unroll
            for (int m = 0; m < 4; ++m)
#pragma unroll
                for (int n = 0; n < 2; ++n) acc[a][b][m][n] = (f32x4){0.f, 0.f, 0.f, 0.f};
    bf16x8 At[4][2], B0[2][2], B1[2][2];
    constexpr int nt = K / BK;
    STAGE(SB(0, 0), Bt, bcol, 0); STAGE(SA(0, 0), A, brow, 0);
    STAGE(SB(0, 1), Bt, bcol + HALF, 0); STAGE(SA(0, 1), A, brow + HALF, 0);
    if (wr == 1) BAR;
    WAIT_V(4); BAR;
    STAGE(SB(1, 0), Bt, bcol, 1); STAGE(SA(1, 0), A, brow, 1); STAGE(SB(1, 1), Bt, bcol + HALF, 1);
    WAIT_V(6); BAR;
    for (int t = 0; t < nt - 2; t += 2) {
        LDB(B0, 0, 0); SCHED; LDA(At, 0, 0); STAGE(SA(1, 1), A, brow + HALF, t + 1);
        WAIT_L(8); BAR; WAIT_L(0); MMA(0, 0, At, B0); BAR; SCHED;
        LDB(B1, 0, 1); STAGE(SB(0, 0), Bt, bcol, t + 2);
        BAR; WAIT_L(0); MMA(0, 1, At, B1); BAR;
        LDA(At, 0, 1); STAGE(SA(0, 0), A, brow, t + 2);
        BAR; WAIT_L(0); MMA(1, 0, At, B0); BAR; SCHED;
        STAGE(SB(0, 1), Bt, bcol + HALF, t + 2);
        WAIT_V(6); BAR; MMA(1, 1, At, B1); BAR;
        LDB(B0, 1, 0); SCHED; LDA(At, 1, 0); STAGE(SA(0, 1), A, brow + HALF, t + 2);
        WAIT_L(8); BAR; WAIT_L(0); MMA(0, 0, At, B0); BAR; SCHED;
        LDB(B1, 1, 1); STAGE(SB(1, 0), Bt, bcol, t + 3);
        BAR; WAIT_L(0); MMA(0, 1, At, B1); BAR;
        LDA(At, 1, 1); STAGE(SA(1, 0), A, brow, t + 3);
        BAR; WAIT_L(0); MMA(1, 0, At, B0); BAR; SCHED;
        STAGE(SB(1, 1), Bt, bcol + HALF, t + 3);
        WAIT_V(6); BAR; MMA(1, 1, At, B1); BAR;
    }
    { LDB(B0, 0, 0); LDA(At, 0, 0); STAGE(SA(1, 1), A, brow + HALF, nt - 1);
      BAR; WAIT_L(0); MMA(0, 0, At, B0); BAR;
      LDB(B1, 0, 1); BAR; WAIT_L(0); MMA(0, 1, At, B1); BAR;
      LDA(At, 0, 1); WAIT_V(4); BAR; WAIT_L(0); MMA(1, 0, At, B0); MMA(1, 1, At, B1); BAR; }
    { LDB(B0, 1, 0); LDA(At, 1, 0); WAIT_V(2); BAR; WAIT_L(0); MMA(0, 0, At, B0); BAR;
      LDB(B1, 1, 1); WAIT_V(0); BAR; WAIT_L(0); MMA(0, 1, At, B1); BAR;
      LDA(At, 1, 1); BAR; WAIT_L(0); MMA(1, 0, At, B0); MMA(1, 1, At, B1); BAR; }
    if (wr == 0) BAR;
}

DI void tile_of(int L, int nM, int nN, int& pm, int& pn) {
    const int nwg = nM * nN; int wgid = L;
    { const int q = nwg / NXCD, r = nwg % NXCD, xcd = wgid % NXCD, off = wgid / NXCD; wgid = (xcd < r ? xcd * (q + 1) : r * (q + 1) + (xcd - r) * q) + off; }
    const int nig = WGM * nN, gid = wgid / nig, fm = gid * WGM, gsz = min(nM - fm, WGM);
    pm = fm + ((wgid % nig) % gsz); pn = (wgid % nig) / gsz;
}

constexpr int CST = 260;
DI void stage_half(const f32x4 (&acc)[2][2][4][2], const int ai) {
    const int tid_ = opaque_tid(), wid = tid_ >> 6, lane = tid_ & 63, wr = wid >> 2, wc = wid & 3, fr = lane & 15, fq = lane >> 4;
    float* base = (float*)dyn_smem + (wr * 64 + fr) * CST + wc * 32 + 4 * fq;
#pragma unroll
    for (int m = 0; m < 4; ++m)
#pragma unroll
        for (int bj = 0; bj < 2; ++bj)
#pragma unroll
            for (int n = 0; n < 2; ++n) *(f32x4*)(base + (m * 16) * CST + bj * 128 + n * 16) = ai == 0 ? acc[0][bj][m][n] : acc[1][bj][m][n];
}
#define CT ((const float*)dyn_smem)

DI void epi_in_half(const Params& p, int pm, int pn, int ai) {
    unsigned char* ws = p.ws;
    const int tid = opaque_tid(), brow = pm * BM + ai * 128, bcol = pn * BM;
    const bool samp = pm == 128;
    if (pn < 8) {
        bf16_t* dst = pn < 6 ? (bf16_t*)(ws + WS_R2) : (bf16_t*)(ws + WS_R3);
        const int ld = pn < 6 ? 1536 : 512, c0 = pn < 6 ? bcol : bcol - 1536;
#pragma unroll 4
        for (int i = 0; i < 16; ++i) {
            const int id = tid + 512 * i, r = id >> 6, c4 = (id & 63) * 4, row = brow + r;
            const f32x4 v = *(const f32x4*)(CT + r * CST + c4);
            u32x2 o; o.x = pk2(v.x, v.y); o.y = pk2(v.z, v.w);
            *(u32x2*)(dst + (size_t)row * ld + c0 + c4) = o;
            if (pn < 6) {
                if (!samp) { const int t = row & (TP - 1); if (t >= TP - 3) *(f32x4*)(p.out + O_CQP + (size_t)((row >> 13) * 3 + t - (TP - 3)) * 1536 + c0 + c4) = v; }
                else { const int rr = row - MP, t = rr & 31; if (t >= TS - 3) *(f32x4*)(p.out + O_CQS + (size_t)((rr >> 5) * 3 + t - (TS - 3)) * 1536 + c0 + c4) = v; }
            }
        }
        return;
    }
    if (pn < 12) {
        const bool isq = pn < 10;
        const float* rope = (const float*)(ws + WS_ROPE);
        bf16_t* QB = (bf16_t*)(ws + WS_R4); bf16_t* KALL = (bf16_t*)(ws + WS_R5);
        const float qs = 0.125f * 1.4426950408889634f;
        f32x4 rt0[8], rt1[8];
#pragma unroll
        for (int i = 0; i < 8; ++i) {
            const int id = tid + 512 * i, r = id >> 5, q = id & 31, d4 = (q & 7) * 4, row = brow + r;
            const int pos = samp ? PAST + ((row - MP) & 31) : (row & (TP - 1));
            rt0[i] = *(const f32x4*)(rope + (size_t)(pos * 32 + d4) * 2); rt1[i] = *(const f32x4*)(rope + (size_t)(pos * 32 + d4) * 2 + 4);
        }
#pragma unroll
        for (int i = 0; i < 8; ++i) {
            const int id = tid + 512 * i, r = id >> 5, q = id & 31, hl = q >> 4, map = (q >> 3) & 1, d4 = (q & 7) * 4, row = brow + r;
            const int cl = hl * 128 + map * 64 + d4, col = ((pn & 1) * 2 + hl) * 128 + map * 64 + d4;
            const f32x4 x1 = *(const f32x4*)(CT + r * CST + cl), x2 = *(const f32x4*)(CT + r * CST + cl + 32);
            int pos; size_t krow; float* kout;
            if (!samp) { pos = row & (TP - 1); krow = row; kout = p.out + O_KP + (size_t)row * 512; }
            else { const int rr = row - MP; pos = PAST + (rr & 31); krow = (size_t)MP + (size_t)(rr >> 5) * TKS + pos; kout = p.out + O_KS + (size_t)rr * 512; }
            const f32x4 t0 = rt0[i], t1 = rt1[i];
            const f32x4 cs = (f32x4){t0.x, t0.z, t1.x, t1.z}, sn = (f32x4){t0.y, t0.w, t1.y, t1.w};
            const f32x4 y1 = x1 * cs - x2 * sn, y2 = x2 * cs + x1 * sn;
            if (isq) {
                u32x2 o1, o2; o1.x = pk2(y1.x * qs, y1.y * qs); o1.y = pk2(y1.z * qs, y1.w * qs); o2.x = pk2(y2.x * qs, y2.y * qs); o2.y = pk2(y2.z * qs, y2.w * qs);
                *(u32x2*)(QB + (size_t)row * 512 + col) = o1; *(u32x2*)(QB + (size_t)row * 512 + col + 32) = o2;
            } else {
                *(f32x4*)(kout + col) = y1; *(f32x4*)(kout + col + 32) = y2;
                u32x2 o1, o2; o1.x = pk2(y1.x, y1.y); o1.y = pk2(y1.z, y1.w); o2.x = pk2(y2.x, y2.y); o2.y = pk2(y2.z, y2.w);
                *(u32x2*)(KALL + krow * 512 + col) = o1; *(u32x2*)(KALL + krow * 512 + col + 32) = o2;
            }
        }
        return;
    }
    {
        bf16_t* VT = (bf16_t*)(ws + WS_R6);
#pragma unroll 4
        for (int i = 0; i < 16; ++i) {
            const int id = tid + 512 * i, r = id >> 6, c4 = (id & 63) * 4, row = brow + r, col = (pn & 1) * 256 + c4;
            const f32x4 v = *(const f32x4*)(CT + r * CST + c4);
            float* vout = samp ? p.out + O_VS + (size_t)(row - MP) * 512 + col : p.out + O_VP + (size_t)row * 512 + col;
            *(f32x4*)vout = v;
        }
#pragma unroll 1
        for (int i = 0; i < 2; ++i) {
            const int id = tid + 512 * i, rg = id >> 6, c4 = (id & 63) * 4, row0 = brow + rg * 8;
            f32x4 v[8];
#pragma unroll
            for (int e = 0; e < 8; ++e) v[e] = *(const f32x4*)(CT + (rg * 8 + e) * CST + c4);
#pragma unroll
            for (int e = 0; e < 4; ++e) {
                const int colg = (pn & 1) * 256 + c4 + e, head = colg >> 7, dv = colg & 127;
                u32x4 o; o.x = pk2(v[0][e], v[1][e]); o.y = pk2(v[2][e], v[3][e]); o.z = pk2(v[4][e], v[5][e]); o.w = pk2(v[6][e], v[7][e]);
                bf16_t* d;
                if (samp) { const int rr = row0 - MP; d = VT + VT_S_OFF + ((size_t)(((rr >> 5) * 4 + head) * 128 + dv) * TKS + PAST + (rr & 31)); }
                else d = VT + ((size_t)(((row0 >> 13) * 4 + head) * 128 + dv) * TP + (row0 & (TP - 1)));
                *(u32x4*)d = o;
            }
        }
    }
}

template <int WHICH> DI void epi_res_half(const Params& p, int pm, int pn, int ai) {
    const int tid = opaque_tid(), brow = pm * BM + ai * 128, bcol = pn * BM;
    bf16_t* dst = (bf16_t*)(p.ws + (WHICH == 0 ? WS_R1 : WS_R2));
    const bf16_t* X1B = (const bf16_t*)(p.ws + WS_R3);
#pragma unroll 1
    for (int i0 = 0; i0 < 16; i0 += 8) {
        f32x4 x[8];
#pragma unroll
        for (int i = 0; i < 8; ++i) {
            const int id = tid + 512 * (i0 + i), r = id >> 6, c4 = (id & 63) * 4, row = brow + r;
            if (WHICH == 0) x[i] = *(const f32x4*)(xrow_ptr(p, row) + bcol + c4);
            else { const u32x2 xb = *(const u32x2*)(X1B + (size_t)row * D + bcol + c4); x[i] = (f32x4){bflo(xb.x), bfhi(xb.x), bflo(xb.y), bfhi(xb.y)}; }
        }
#pragma unroll
        for (int i = 0; i < 8; ++i) {
            const int id = tid + 512 * (i0 + i), r = id >> 6, c4 = (id & 63) * 4, row = brow + r;
            const f32x4 v = *(const f32x4*)(CT + r * CST + c4);
            const f32x4 o = x[i] * ALPHA + v;
            u32x2 q; q.x = pk2(o.x, o.y); q.y = pk2(o.z, o.w);
            *(u32x2*)(dst + (size_t)row * D + bcol + c4) = q;
        }
    }
}

constexpr int UST = 264;
DI void epi_up(const Params& p, const f32x4 (&acc)[2][2][4][2], int pm, int pn) {
    unsigned char* ws = p.ws;
    bf16_t* U = (bf16_t*)dyn_smem;
    float* BND = (float*)(ws + WS_R5);
    const bool samp = pm == 128;
    const int brow = pm * BM, tid = opaque_tid();
    {
        const int wid = tid >> 6, lane = tid & 63, wr = wid >> 2, wc = wid & 3, fr = lane & 15, fq = lane >> 4;
        bf16_t* base = U + (wr * 64 + fr) * UST + wc * 32 + 4 * fq;
#pragma unroll
        for (int ai = 0; ai < 2; ++ai)
#pragma unroll
            for (int m = 0; m < 4; ++m)
#pragma unroll
                for (int bj = 0; bj < 2; ++bj)
#pragma unroll
                    for (int n = 0; n < 2; ++n) {
                        const f32x4 v = acc[ai][bj][m][n];
                        u32x2 q; q.x = pk2(v.x, v.y); q.y = pk2(v.z, v.w);
                        *(u32x2*)(base + (ai * 128 + m * 16) * UST + bj * 128 + n * 16) = q;
                    }
    }
    __syncthreads();
    {
        const int nb = samp ? 32 * 256 : 4 * 256;
        for (int id = tid; id < nb; id += 512) {
            const int cl = id & 255, q = id >> 8;
            const int oc = (cl >> 7) * DFF + 128 * pn + (cl & 127);
            int rr, bslot, u;
            if (!samp) { bslot = q; rr = q < 2 ? q : 252 + q; u = pm; }
            else { bslot = q & 3; rr = (q >> 2) * 32 + (bslot < 2 ? bslot : 28 + bslot); u = 128 + (q >> 2); }
            const float v = bf2f(U[rr * UST + cl]);
            BND[((size_t)u * 4 + bslot) * NUP + oc] = v;
            if (bslot >= 2) {
                if (samp) p.out[O_CFS + (size_t)((q >> 2) * 2 + bslot - 2) * NUP + oc] = v;
                else if ((pm & 31) == 31) p.out[O_CFP + (size_t)((pm >> 5) * 2 + bslot - 2) * NUP + oc] = v;
            }
        }
    }
    {
        const int cp = tid & 63, rs = tid >> 6, c = 2 * cp, cg_ = 128 * pn + c, cv_ = DFF + 128 * pn + c;
        const f32x2 wg0 = *(const f32x2*)(p.ffn_conv_w + cg_), wg1 = *(const f32x2*)(p.ffn_conv_w + NUP + cg_), wg2 = *(const f32x2*)(p.ffn_conv_w + 2 * NUP + cg_), bg = *(const f32x2*)(p.ffn_conv_b + cg_);
        const f32x2 wv0 = *(const f32x2*)(p.ffn_conv_w + cv_), wv1 = *(const f32x2*)(p.ffn_conv_w + NUP + cv_), wv2 = *(const f32x2*)(p.ffn_conv_w + 2 * NUP + cv_), bv = *(const f32x2*)(p.ffn_conv_b + cv_);
        bf16_t* GT = (bf16_t*)(ws + WS_R1);
        const int r0 = rs * 32;
        f32x2 g1 = {0.f, 0.f}, g2 = {0.f, 0.f}, v1 = {0.f, 0.f}, v2 = {0.f, 0.f};
        if (r0 >= 2) {
            const unsigned a0 = *(const unsigned*)(U + (r0 - 2) * UST + c), a1 = *(const unsigned*)(U + (r0 - 1) * UST + c);
            const unsigned b0 = *(const unsigned*)(U + (r0 - 2) * UST + 128 + c), b1 = *(const unsigned*)(U + (r0 - 1) * UST + 128 + c);
            g1 = (f32x2){bflo(a0), bfhi(a0)}; g2 = (f32x2){bflo(a1), bfhi(a1)}; v1 = (f32x2){bflo(b0), bfhi(b0)}; v2 = (f32x2){bflo(b1), bfhi(b1)};
        }
#pragma unroll 4
        for (int r = r0; r < r0 + 32; ++r) {
            const unsigned ga = *(const unsigned*)(U + r * UST + c), va = *(const unsigned*)(U + r * UST + 128 + c);
            const f32x2 g3 = {bflo(ga), bfhi(ga)}, v3 = {bflo(va), bfhi(va)};
            if (r >= 2) {
                const f32x2 cg2 = wg0 * g1 + wg1 * g2 + wg2 * g3 + bg, cv2 = wv0 * v1 + wv1 * v2 + wv2 * v3 + bv;
                *(unsigned*)(GT + (size_t)(brow + r) * DFF + 128 * pn + c) = pk2(silu(cg2.x) * cv2.x, silu(cg2.y) * cv2.y);
            }
            g1 = g2; g2 = g3; v1 = v2; v2 = v3;
        }
    }
}

template <int K> DI void skinny_gemm(const bf16_t* __restrict__ A, const bf16_t* __restrict__ Bt, float* __restrict__ C, const int N) {
    const int tid = opaque_tid(), lane = tid & 63, w = __builtin_amdgcn_readfirstlane(tid >> 6), fr = lane & 15, fq = lane >> 4;
    float* red = (float*)dyn_smem;
    constexpr int KW = K / 8, NKS = KW / 32;
    const int ntile = 8 * (N / 32);
    for (int t = blockIdx.x; t < ntile; t += gridDim.x) {
        const int rm = t & 7, cn = t >> 3;
        const bf16_t* ap = A + (size_t)(32 * rm + fr) * K + w * KW + 8 * fq;
        const bf16_t* bp = Bt + (size_t)(32 * cn + fr) * K + w * KW + 8 * fq;
        f32x4 acc[2][2];
#pragma unroll
        for (int i = 0; i < 2; ++i)
#pragma unroll
            for (int j = 0; j < 2; ++j) acc[i][j] = (f32x4){0.f, 0.f, 0.f, 0.f};
#pragma unroll 4
        for (int ks = 0; ks < NKS; ++ks) {
            const bf16x8 a0 = *(const bf16x8*)(ap + ks * 32), a1 = *(const bf16x8*)(ap + (size_t)16 * K + ks * 32);
            const bf16x8 b0 = *(const bf16x8*)(bp + ks * 32), b1 = *(const bf16x8*)(bp + (size_t)16 * K + ks * 32);
            acc[0][0] = __builtin_amdgcn_mfma_f32_16x16x32_bf16(a0, b0, acc[0][0], 0, 0, 0);
            acc[0][1] = __builtin_amdgcn_mfma_f32_16x16x32_bf16(a0, b1, acc[0][1], 0, 0, 0);
            acc[1][0] = __builtin_amdgcn_mfma_f32_16x16x32_bf16(a1, b0, acc[1][0], 0, 0, 0);
            acc[1][1] = __builtin_amdgcn_mfma_f32_16x16x32_bf16(a1, b1, acc[1][1], 0, 0, 0);
        }
        __syncthreads();
#pragma unroll
        for (int i = 0; i < 2; ++i)
#pragma unroll
            for (int j = 0; j < 2; ++j)
#pragma unroll
                for (int e = 0; e < 4; ++e) red[(w * 32 + 16 * i + 4 * fq + e) * 33 + 16 * j + fr] = acc[i][j][e];
        __syncthreads();
#pragma unroll
        for (int o2 = 0; o2 < 2; ++o2) {
            const int o = tid + 512 * o2, r = o >> 5, c = o & 31;
            float sum = 0.f;
#pragma unroll
            for (int ww = 0; ww < 8; ++ww) sum += red[(ww * 32 + r) * 33 + c];
            C[(size_t)(32 * rm + r) * N + 32 * cn + c] = sum;
        }
    }
    __syncthreads();
}

template <int WHICH> DI void gemm_phase(const Params& p) {
    unsigned char* ws = p.ws;
    const bf16_t* A; const bf16_t* Bt; int N; constexpr int K = WHICH == 4 ? DFF : D; float* CS;
    if (WHICH == 1) { A = (const bf16_t*)(ws + WS_R1); Bt = (const bf16_t*)(ws + WS_WIN); N = NH1; CS = (float*)(ws + WS_CS1); }
    else if (WHICH == 2) { A = (const bf16_t*)(ws + WS_R2); Bt = (const bf16_t*)(ws + WS_WO); N = D; CS = (float*)(ws + WS_CS2); }
    else if (WHICH == 3) { A = (const bf16_t*)(ws + WS_R3); Bt = (const bf16_t*)(ws + WS_WUP); N = NUP; CS = (float*)(ws + WS_CS3); }
    else { A = (const bf16_t*)(ws + WS_R1); Bt = (const bf16_t*)(ws + WS_WDN); N = D; CS = (float*)(ws + WS_CS4); }
    skinny_gemm<K>(A + (size_t)MP * K, Bt, CS, N);
    const int nM = MP / BM, nN = N / BM, ntile = nM * nN;
    for (int L0 = blockIdx.x; L0 < ntile * (WHICH == GREP_WHICH ? 2 : 1); L0 += gridDim.x) {
        const int L = L0 % ntile;
        int pm, pn; tile_of(L, nM, nN, pm, pn);
        f32x4 acc[2][2][4][2];
        gemm_tile<K>(A, Bt, pm * BM, pn * BM, acc);
        if (WHICH == 3) epi_up(p, acc, pm, pn);
        else {
#pragma unroll
            for (int ai = 0; ai < 2; ++ai) {
                stage_half(acc, ai);
                __syncthreads();
                if (WHICH == 1) epi_in_half(p, pm, pn, ai);
                else if (WHICH == 2) epi_res_half<0>(p, pm, pn, ai);
                else epi_res_half<1>(p, pm, pn, ai);
                __syncthreads();
            }
        }
        __syncthreads();
    }
}

template <int WHICH> DI void ln_phase(const Params& p) {
    const int lane = threadIdx.x & 63, wave = threadIdx.x >> 6;
    const float* g = WHICH == 0 ? p.ln1_g : p.ln2_g; const float* b = WHICH == 0 ? p.ln1_b : p.ln2_b;
    bf16_t* X1B = (bf16_t*)(p.ws + WS_R3);
    const bf16_t* PRE = (const bf16_t*)(p.ws + (WHICH == 0 ? WS_R1 : WS_R2));
    f32x4 gv[4], bv[4];
#pragma unroll
    for (int j = 0; j < 4; ++j) { gv[j] = *(const f32x4*)(g + lane * 4 + 256 * j); bv[j] = *(const f32x4*)(b + lane * 4 + 256 * j); }
    auto ld_row = [&](int row, f32x4 (&v)[4]) {
        if (row < MP) {
#pragma unroll
            for (int j = 0; j < 4; ++j) { const u32x2 q = *(const u32x2*)(PRE + (size_t)row * D + lane * 4 + 256 * j); v[j] = (f32x4){bflo(q.x), bfhi(q.x), bflo(q.y), bfhi(q.y)}; }
        } else {
            const float* cs = (const float*)(p.ws + (WHICH == 0 ? WS_CS2 : WS_CS4)) + (size_t)(row - MP) * D;
#pragma unroll
            for (int j = 0; j < 4; ++j) {
                f32x4 rs;
                if (WHICH == 0) rs = *(const f32x4*)(p.x_s + (size_t)(row - MP) * D + lane * 4 + 256 * j);
                else { const u32x2 q = *(const u32x2*)(X1B + (size_t)row * D + lane * 4 + 256 * j); rs = (f32x4){bflo(q.x), bfhi(q.x), bflo(q.y), bfhi(q.y)}; }
                v[j] = rs * ALPHA + *(const f32x4*)(cs + lane * 4 + 256 * j);
            }
        }
    };
    f32x4 v[4];
    if (blockIdx.x * 8 + wave < M) ld_row(blockIdx.x * 8 + wave, v);
    for (int row = blockIdx.x * 8 + wave; row < M; row += gridDim.x * 8) {
        f32x4 vn[4];
        const bool more = row + (int)gridDim.x * 8 < M;
        if (more) ld_row(row + gridDim.x * 8, vn);
        float s = 0.f;
#pragma unroll
        for (int j = 0; j < 4; ++j) s += (v[j].x + v[j].y) + (v[j].z + v[j].w);
        const float mean = wave_sum(s) * (1.f / D); float s2 = 0.f;
#pragma unroll
        for (int j = 0; j < 4; ++j) { v[j] = v[j] - mean; s2 += (v[j].x * v[j].x + v[j].y * v[j].y) + (v[j].z * v[j].z + v[j].w * v[j].w); }
        const float rstd = rsqrtf(wave_sum(s2) * (1.f / D) + 1e-5f);
#pragma unroll
        for (int j = 0; j < 4; ++j) {
            const f32x4 o = v[j] * rstd * gv[j] + bv[j];
            if (WHICH == 0) { u32x2 q; q.x = pk2(o.x, o.y); q.y = pk2(o.z, o.w); *(u32x2*)(X1B + (size_t)row * D + lane * 4 + 256 * j) = q; }
            else *(f32x4*)(p.out + O_Y + (size_t)row * D + lane * 4 + 256 * j) = o;
        }
        if (more) {
#pragma unroll
            for (int j = 0; j < 4; ++j) v[j] = vn[j];
        }
    }
}

DI void fixup_phase(const Params& p) {
    const float* BND = (const float*)(p.ws + WS_R5);
    bf16_t* GT = (bf16_t*)(p.ws + WS_R1);
    {
        const float* CS3 = (const float*)(p.ws + WS_CS3);
        for (int idx = blockIdx.x * 512 + threadIdx.x; idx < MS * DFF; idx += gridDim.x * 512) {
            const int c = idx % DFF, r = idx / DFF, b = r >> 5, t = r & 31, ng = (c >> 7) * 256 + (c & 127), nv = ng + 128;
            float g[3], v[3];
#pragma unroll
            for (int k = 0; k < 3; ++k) {
                const int tt = t - 2 + k;
                if (tt >= 0) { g[k] = CS3[(size_t)(b * 32 + tt) * NUP + ng]; v[k] = CS3[(size_t)(b * 32 + tt) * NUP + nv]; }
                else { g[k] = p.state_cf[(size_t)(b * 2 + 2 + tt) * NUP + c]; v[k] = p.state_cf[(size_t)(b * 2 + 2 + tt) * NUP + DFF + c]; }
            }
            const float cg2 = p.ffn_conv_w[c] * g[0] + p.ffn_conv_w[NUP + c] * g[1] + p.ffn_conv_w[2 * NUP + c] * g[2] + p.ffn_conv_b[c];
            const float cv2 = p.ffn_conv_w[DFF + c] * v[0] + p.ffn_conv_w[NUP + DFF + c] * v[1] + p.ffn_conv_w[2 * NUP + DFF + c] * v[2] + p.ffn_conv_b[DFF + c];
            GT[((size_t)MP + r) * DFF + c] = f2bf(silu(cg2) * cv2);
            if (t >= 30) { p.out[O_CFS + (size_t)(b * 2 + t - 30) * NUP + c] = g[2]; p.out[O_CFS + (size_t)(b * 2 + t - 30) * NUP + DFF + c] = v[2]; }
        }
    }
    const int total = 128 * 2 * DFF;
    for (int idx = blockIdx.x * 512 + threadIdx.x; idx < total; idx += gridDim.x * 512) {
        const int c = idx % DFF, q = idx / DFF, r = q & 1, u = q >> 1;
        const float* cur = BND + (size_t)u * 4 * NUP;
        float pg[2], pv[2];
        if (u < 128) {
            if ((u & 31) == 0) { pg[0] = pg[1] = pv[0] = pv[1] = 0.f; }
            else { const float* pr = BND + (size_t)(u - 1) * 4 * NUP; pg[0] = pr[2 * NUP + c]; pg[1] = pr[3 * NUP + c]; pv[0] = pr[2 * NUP + DFF + c]; pv[1] = pr[3 * NUP + DFF + c]; }
        } else { const float* st = p.state_cf + (size_t)(u - 128) * 2 * NUP; pg[0] = st[c]; pg[1] = st[NUP + c]; pv[0] = st[DFF + c]; pv[1] = st[NUP + DFF + c]; }
        const float cg0 = cur[c], cg1 = cur[NUP + c], cv0 = cur[DFF + c], cv1 = cur[NUP + DFF + c];
        const float wg0 = p.ffn_conv_w[c], wg1 = p.ffn_conv_w[NUP + c], wg2 = p.ffn_conv_w[2 * NUP + c], bg = p.ffn_conv_b[c];
        const float wv0 = p.ffn_conv_w[DFF + c], wv1 = p.ffn_conv_w[NUP + DFF + c], wv2 = p.ffn_conv_w[2 * NUP + DFF + c], bv = p.ffn_conv_b[DFF + c];
        float g, v;
        if (r == 0) { g = wg0 * pg[0] + wg1 * pg[1] + wg2 * cg0 + bg; v = wv0 * pv[0] + wv1 * pv[1] + wv2 * cv0 + bv; }
        else { g = wg0 * pg[1] + wg1 * cg0 + wg2 * cg1 + bg; v = wv0 * pv[1] + wv1 * cv0 + wv2 * cv1 + bv; }
        const size_t row = u < 128 ? (size_t)u * 256 + r : (size_t)MP + (size_t)(u - 128) * 32 + r;
        GT[row * DFF + c] = f2bf(silu(g) * v);
    }
}

#define MFMA16(a, b, c) __builtin_amdgcn_mfma_f32_16x16x32_bf16((a), (b), (c), 0, 0, 0)
#define MFMA32(a, b, c) __builtin_amdgcn_mfma_f32_32x32x16_bf16((a), (b), (c), 0, 0, 0)
DI bf16x8 pack8(const f32x4 a, const f32x4 b) { u32x4 o; o.x = pk2(a.x, a.y); o.y = pk2(a.z, a.w); o.z = pk2(b.x, b.y); o.w = pk2(b.z, b.w); return __builtin_bit_cast(bf16x8, o); }
constexpr float GSCALE = 0.08838834764831845f;
constexpr int QST = 132, AST = 68, NST = 136, QKST = 72;
constexpr int L_QKV = 0, L_AM = 3 * 64 * QST * 4, L_KN = L_AM + 64 * AST * 4, L_QN = L_KN + 64 * NST * 2, L_GC = L_QN + 64 * NST * 2;
constexpr int L_QKS = 0, L_WS = 64 * QKST * 2;
static_assert(L_GC + 1024 <= LDS_BYTES, "gdn prep LDS");

DI void gdn_conv_weights(const Params& p, const int h, float (&cw)[3][4]) {
#pragma unroll
    for (int k = 0; k < 3; ++k) {
        const int task = threadIdx.x + 512 * k, col = task % 384, part = col >> 7, cc = col & 127, gcol = part * 512 + h * 128 + cc;
#pragma unroll
        for (int j = 0; j < 4; ++j) cw[k][j] = p.gdn_conv_w[j * 1536 + gcol];
    }
}
DI void gdn_prep_item(const Params& p, const int item, const float (&cw)[3][4]) {
    unsigned char* ws = p.ws;
    float* QKVf = (float*)(dyn_smem + L_QKV); float* AM = (float*)(dyn_smem + L_AM);
    bf16_t* KN = (bf16_t*)(dyn_smem + L_KN); bf16_t* QN = (bf16_t*)(dyn_smem + L_QN);
    float* GC = (float*)(dyn_smem + L_GC); float* BETA = GC + 64; float* EG = GC + 128; float* ED = GC + 192;
    bf16_t* QKS = (bf16_t*)(dyn_smem + L_QKS); bf16_t* WSI = (bf16_t*)(dyn_smem + L_WS);
    const bf16_t* HQKV = (const bf16_t*)(ws + WS_R2);
    const float* AB = (const float*)(ws + WS_AB);
    float* DL = (float*)(ws + WS_DL);
        const int tid = opaque_tid(), lane = tid & 63, wave = __builtin_amdgcn_readfirstlane(tid >> 6), fr = lane & 15, fq = lane >> 4;
        int h, b, c, row0, valid; bool samp;
        if (item < 2048) { h = item & 3; c = (item >> 2) & 127; b = item >> 9; row0 = b * TP + c * 64; valid = 64; samp = false; }
        else { const int j = item - 2048; h = j & 3; b = j >> 2; c = 0; row0 = MP + b * TS; valid = TS; samp = true; }
        unsigned char* ip = ws + WS_R1 + (size_t)item * ITEM_B;
        __syncthreads();
        {
            bf16_t* RAW = (bf16_t*)(dyn_smem + L_AM);
#pragma unroll
            for (int i = 0; i < 7; ++i) {
                const int id = tid + 512 * i;
                if (id < 67 * 48) {
                    const int rw = id / 48, ch = id % 48, part = ch >> 4, c8 = (ch & 15) * 8, gcol = part * 512 + h * 128 + c8, t = rw - 3;
                    u32x4 v = (u32x4){0u, 0u, 0u, 0u};
                    if (t >= 0) {
                        if (t < valid) {
                            if (!samp) v = *(const u32x4*)(HQKV + (size_t)(row0 + t) * 1536 + gcol);
                            else { const float* sp = (const float*)(ws + WS_CS1) + (size_t)(row0 - MP + t) * NH1 + gcol; const f32x4 f0 = *(const f32x4*)sp, f1 = *(const f32x4*)(sp + 4);
                                   v.x = pk2(f0.x, f0.y); v.y = pk2(f0.z, f0.w); v.z = pk2(f1.x, f1.y); v.w = pk2(f1.z, f1.w); }
                        }
                    }
                    else if (samp) { const float* sp = p.state_cq + (size_t)(b * 3 + 3 + t) * 1536 + gcol; const f32x4 f0 = *(const f32x4*)sp, f1 = *(const f32x4*)(sp + 4);
                                     v.x = pk2(f0.x, f0.y); v.y = pk2(f0.z, f0.w); v.z = pk2(f1.x, f1.y); v.w = pk2(f1.z, f1.w); }
                    else if (c != 0) v = *(const u32x4*)(HQKV + (size_t)(row0 + t) * 1536 + gcol);
                    *(u32x4*)(RAW + rw * 384 + ch * 8) = v;
                }
            }
            __syncthreads();
#pragma unroll
            for (int k3 = 0; k3 < 3; ++k3) {
                const int task = tid + 512 * k3;
                const int col = task % 384, seg = task / 384, part = col >> 7, cc = col & 127, t0 = seg * 16;
                const float w0 = cw[k3][0], w1 = cw[k3][1], w2 = cw[k3][2], w3 = cw[k3][3];
                float x0 = bf2f(RAW[(t0) * 384 + col]), x1 = bf2f(RAW[(t0 + 1) * 384 + col]), x2 = bf2f(RAW[(t0 + 2) * 384 + col]);
#pragma unroll
                for (int t = t0; t < t0 + 16; ++t) {
                    const float xv = bf2f(RAW[(t + 3) * 384 + col]);
                    const float y = w0 * x0 + w1 * x1 + w2 * x2 + w3 * xv;
                    QKVf[(part * 64 + t) * QST + cc] = t < valid ? silu(y) : 0.f;
                    x0 = x1; x1 = x2; x2 = xv;
                }
            }
        }
        if (tid < 64) {
            float g = 0.f, be = 0.f;
            if (tid < valid) {
                const float a = AB[(size_t)(row0 + tid) * 8 + h] + p.dt_bias[h], bb = AB[(size_t)(row0 + tid) * 8 + 4 + h];
                const float sp = a > 20.f ? a : log1pf(expf(a));
                g = -expf(p.a_log[h]) * sp; be = 1.f / (1.f + expf(-bb));
            }
            float gc = g;
#pragma unroll
            for (int o = 1; o < 64; o <<= 1) { const float n = __shfl_up(gc, o); if (lane >= o) gc += n; }
            const float gl = __shfl(gc, 63);
            GC[tid] = gc; BETA[tid] = be; EG[tid] = expf(gc); ED[tid] = expf(gl - gc);
            if (tid == 0) DL[item] = expf(gl);
        }
        __syncthreads();
        {
            const int row = tid >> 3, pt = tid & 7;
            float q[16], k[16]; float sq = 0.f, sk = 0.f;
#pragma unroll
            for (int e4 = 0; e4 < 4; ++e4) {
                const f32x4 a = *(const f32x4*)(QKVf + row * QST + 16 * pt + 4 * e4), bq = *(const f32x4*)(QKVf + (64 + row) * QST + 16 * pt + 4 * e4);
#pragma unroll
                for (int e = 0; e < 4; ++e) { q[4 * e4 + e] = a[e]; k[4 * e4 + e] = bq[e]; sq += a[e] * a[e]; sk += bq[e] * bq[e]; }
            }
#pragma unroll
            for (int o = 1; o < 8; o <<= 1) { sq += __shfl_xor(sq, o); sk += __shfl_xor(sk, o); }
            const float rq = rsqrtf(sq + 1e-6f), rk = rsqrtf(sk + 1e-6f), qg = rq * GSCALE * EG[row];
            u32x4 o0, o1;
            o0.x = pk2(q[0] * rq, q[1] * rq); o0.y = pk2(q[2] * rq, q[3] * rq); o0.z = pk2(q[4] * rq, q[5] * rq); o0.w = pk2(q[6] * rq, q[7] * rq);
            o1.x = pk2(q[8] * rq, q[9] * rq); o1.y = pk2(q[10] * rq, q[11] * rq); o1.z = pk2(q[12] * rq, q[13] * rq); o1.w = pk2(q[14] * rq, q[15] * rq);
            *(u32x4*)(QN + row * NST + 16 * pt) = o0; *(u32x4*)(QN + row * NST + 16 * pt + 8) = o1;
            o0.x = pk2(k[0] * rk, k[1] * rk); o0.y = pk2(k[2] * rk, k[3] * rk); o0.z = pk2(k[4] * rk, k[5] * rk); o0.w = pk2(k[6] * rk, k[7] * rk);
            o1.x = pk2(k[8] * rk, k[9] * rk); o1.y = pk2(k[10] * rk, k[11] * rk); o1.z = pk2(k[12] * rk, k[13] * rk); o1.w = pk2(k[14] * rk, k[15] * rk);
            *(u32x4*)(KN + row * NST + 16 * pt) = o0; *(u32x4*)(KN + row * NST + 16 * pt + 8) = o1;
#pragma unroll
            for (int e4 = 0; e4 < 4; ++e4) *(f32x4*)(QKVf + (64 + row) * QST + 16 * pt + 4 * e4) = (f32x4){k[4 * e4] * rk, k[4 * e4 + 1] * rk, k[4 * e4 + 2] * rk, k[4 * e4 + 3] * rk};
            bf16_t* QGf = (bf16_t*)(ip + 16384);
            const int rt = row >> 4, frr = row & 15, ks = pt >> 1;
#pragma unroll
            for (int f = 0; f < 4; ++f) {
                u32x2 o; o.x = pk2(q[4 * f] * qg, q[4 * f + 1] * qg); o.y = pk2(q[4 * f + 2] * qg, q[4 * f + 3] * qg);
                *(u32x2*)(QGf + (size_t)(((rt * 4 + ks) * 64 + f * 16 + frr) * 8 + 4 * (pt & 1))) = o;
            }
        }
        __syncthreads();
        {
            const bool isq = wave >= 4; const int ti = wave & 3;
            const bf16_t* As = isq ? QN : KN;
#pragma unroll
            for (int tj = 0; tj < 4; ++tj) {
                f32x4 acc = (f32x4){0.f, 0.f, 0.f, 0.f};
#pragma unroll
                for (int ks = 0; ks < 4; ++ks) {
                    const bf16x8 a = *(const bf16x8*)(As + (16 * ti + fr) * NST + 32 * ks + 8 * fq), bb = *(const bf16x8*)(KN + (16 * tj + fr) * NST + 32 * ks + 8 * fq);
                    acc = MFMA16(a, bb, acc);
                }
                const int jj = 16 * tj + fr; const float gj = GC[jj];
#pragma unroll
                for (int j = 0; j < 4; ++j) {
                    const int i = 16 * ti + 4 * fq + j;
                    const float dec = i >= jj ? expf(GC[i] - gj) : 0.f;
                    if (!isq) AM[i * AST + jj] = i > jj ? BETA[i] * acc[j] * dec : 0.f;
                    else QKS[i * QKST + jj] = f2bf(GSCALE * acc[j] * dec);
                }
            }
            bf16_t* KDTf = (bf16_t*)(ip + 32768);
#pragma unroll
            for (int i2 = 0; i2 < 2; ++i2) {
                const int f = tid + 512 * i2, ln = f & 63, ks2 = (f >> 6) & 1, dt = f >> 7, fq_ = ln >> 4, dk = 16 * dt + (ln & 15);
                float v[8];
#pragma unroll
                for (int e = 0; e < 8; ++e) { const int i = 32 * ks2 + 16 * (e >> 2) + 4 * fq_ + (e & 3); v[e] = bf2f(KN[i * NST + dk]) * ED[i]; }
                u32x4 o; o.x = pk2(v[0], v[1]); o.y = pk2(v[2], v[3]); o.z = pk2(v[4], v[5]); o.w = pk2(v[6], v[7]);
                *(u32x4*)(KDTf + (size_t)f * 8) = o;
            }
        }
        __syncthreads();
        {
            float* TM = (float*)(dyn_smem + L_QN);
            float* TMP = (float*)(dyn_smem + L_KN);
#pragma unroll
            for (int i = 0; i < 9; ++i) { const int id = tid + 512 * i; if (id < 64 * AST) TM[id] = 0.f; }
            __syncthreads();
            if (tid < 64) {
                const int d = tid >> 4, c = tid & 15;
                float y[16];
#pragma unroll
                for (int r = 0; r < 16; ++r) {
                    float sacc = r == c ? 1.f : 0.f;
                    const float* ar = AM + (16 * d + r) * AST + 16 * d;
#pragma unroll
                    for (int j = 0; j < r; ++j) sacc -= ar[j] * y[j];
                    y[r] = sacc;
                    TM[(16 * d + r) * AST + 16 * d + c] = sacc;
                }
            }
            __syncthreads();
            {
                const int blk = tid >> 8, r = (tid >> 4) & 15, c = tid & 15, rb = blk ? 3 : 1, cb = rb - 1;
                float t = 0.f;
#pragma unroll
                for (int j = 0; j < 16; ++j) t += AM[(16 * rb + r) * AST + 16 * cb + j] * TM[(16 * cb + j) * AST + 16 * cb + c];
                TMP[blk * 272 + r * 17 + c] = t;
                __syncthreads();
                float o = 0.f;
#pragma unroll
                for (int k = 0; k < 16; ++k) o -= TM[(16 * rb + r) * AST + 16 * rb + k] * TMP[blk * 272 + k * 17 + c];
                __syncthreads();
                TM[(16 * rb + r) * AST + 16 * cb + c] = o;
            }
            __syncthreads();
            {
                float t[2];
#pragma unroll
                for (int i2 = 0; i2 < 2; ++i2) {
                    const int o = tid + 512 * i2, r = o >> 5, c = o & 31;
                    float acc = 0.f;
#pragma unroll
                    for (int j = 0; j < 32; ++j) acc += AM[(32 + r) * AST + j] * TM[j * AST + c];
                    t[i2] = acc;
                }
#pragma unroll
                for (int i2 = 0; i2 < 2; ++i2) { const int o = tid + 512 * i2; TMP[(o >> 5) * 33 + (o & 31)] = t[i2]; }
                __syncthreads();
#pragma unroll
                for (int i2 = 0; i2 < 2; ++i2) {
                    const int o = tid + 512 * i2, r = o >> 5, c = o & 31;
                    float acc = 0.f;
#pragma unroll
                    for (int k = 0; k < 32; ++k) acc -= TM[(32 + r) * AST + 32 + k] * TMP[k * 33 + c];
                    t[i2] = acc;
                }
#pragma unroll
                for (int i2 = 0; i2 < 2; ++i2) { const int o = tid + 512 * i2; TM[(32 + (o >> 5)) * AST + (o & 31)] = t[i2]; }
            }
            __syncthreads();
            {
                bf16x8 Ah[4][2], Al[4][2];
#pragma unroll
                for (int rt = 0; rt < 4; ++rt)
#pragma unroll
                    for (int ks = 0; ks < 2; ++ks) {
                        const f32x4 a0 = *(const f32x4*)(TM + (16 * rt + fr) * AST + 32 * ks + 8 * fq), a1 = *(const f32x4*)(TM + (16 * rt + fr) * AST + 32 * ks + 8 * fq + 4);
                        u32x4 hq; hq.x = pk2(a0.x, a0.y); hq.y = pk2(a0.z, a0.w); hq.z = pk2(a1.x, a1.y); hq.w = pk2(a1.z, a1.w);
                        u32x4 lq; lq.x = pk2(a0.x - bflo(hq.x), a0.y - bfhi(hq.x)); lq.y = pk2(a0.z - bflo(hq.y), a0.w - bfhi(hq.y));
                        lq.z = pk2(a1.x - bflo(hq.z), a1.y - bfhi(hq.z)); lq.w = pk2(a1.z - bflo(hq.w), a1.w - bfhi(hq.w));
                        Ah[rt][ks] = __builtin_bit_cast(bf16x8, hq); Al[rt][ks] = __builtin_bit_cast(bf16x8, lq);
                    }
                const bool isw = wave >= 4;
                f32x4 xacc[2][4];
#pragma unroll
                for (int q = 0; q < 2; ++q)
#pragma unroll
                    for (int rt = 0; rt < 4; ++rt) xacc[q][rt] = (f32x4){0.f, 0.f, 0.f, 0.f};
#pragma unroll
                for (int ks = 0; ks < 2; ++ks) {
                    float sc8[8];
                    {
                        const f32x4 b0 = *(const f32x4*)(BETA + 32 * ks + 8 * fq), b1 = *(const f32x4*)(BETA + 32 * ks + 8 * fq + 4);
                        const f32x4 e0 = *(const f32x4*)(EG + 32 * ks + 8 * fq), e1 = *(const f32x4*)(EG + 32 * ks + 8 * fq + 4);
#pragma unroll
                        for (int e = 0; e < 4; ++e) { sc8[e] = isw ? b0[e] * e0[e] : b0[e]; sc8[4 + e] = isw ? b1[e] * e1[e] : b1[e]; }
                    }
#pragma unroll
                    for (int q = 0; q < 2; ++q) {
                        const int cc = ((2 * wave + q) & 7) * 16 + fr;
                        const float* src = QKVf + ((isw ? 64 : 128) + 32 * ks + 8 * fq) * QST + cc;
                        float v[8];
#pragma unroll
                        for (int e = 0; e < 8; ++e) v[e] = src[e * QST] * sc8[e];
                        u32x4 hq; hq.x = pk2(v[0], v[1]); hq.y = pk2(v[2], v[3]); hq.z = pk2(v[4], v[5]); hq.w = pk2(v[6], v[7]);
                        u32x4 lq; lq.x = pk2(v[0] - bflo(hq.x), v[1] - bfhi(hq.x)); lq.y = pk2(v[2] - bflo(hq.y), v[3] - bfhi(hq.y));
                        lq.z = pk2(v[4] - bflo(hq.z), v[5] - bfhi(hq.z)); lq.w = pk2(v[6] - bflo(hq.w), v[7] - bfhi(hq.w));
                        const bf16x8 Bh = __builtin_bit_cast(bf16x8, hq), Bl = __builtin_bit_cast(bf16x8, lq);
#pragma unroll
                        for (int rt = 0; rt < 4; ++rt) {
                            xacc[q][rt] = MFMA16(Ah[rt][ks], Bh, xacc[q][rt]);
                            xacc[q][rt] = MFMA16(Al[rt][ks], Bh, xacc[q][rt]);
                            xacc[q][rt] = MFMA16(Ah[rt][ks], Bl, xacc[q][rt]);
                        }
                    }
                }
                if (!isw) {
                    float* Uc = (float*)(ip + 57344);
#pragma unroll
                    for (int q = 0; q < 2; ++q)
#pragma unroll
                        for (int rt = 0; rt < 4; ++rt) *(f32x4*)(Uc + (size_t)((((2 * wave + q) * 4 + rt) * 64 + lane) * 4)) = xacc[q][rt];
                } else {
#pragma unroll
                    for (int q = 0; q < 2; ++q)
#pragma unroll
                        for (int rt = 0; rt < 4; ++rt)
#pragma unroll
                            for (int j = 0; j < 4; ++j) WSI[(16 * rt + 4 * fq + j) * NST + ((2 * wave + q) & 7) * 16 + fr] = f2bf(xacc[q][rt][j]);
                }
            }
        }
        __syncthreads();
        {
            bf16_t* Wf = (bf16_t*)ip; bf16_t* QKf = (bf16_t*)(ip + 49152);
#pragma unroll
            for (int i2 = 0; i2 < 2; ++i2) {
                const int f = tid + 512 * i2, ln = f & 63, ks = (f >> 6) & 3, rt = f >> 8, i = 16 * rt + (ln & 15), fq_ = ln >> 4;
                const u32x2 lo = *(const u32x2*)(WSI + i * NST + 32 * ks + 4 * fq_), hi = *(const u32x2*)(WSI + i * NST + 32 * ks + 16 + 4 * fq_);
                *(u32x4*)(Wf + (size_t)f * 8) = (u32x4){lo.x, lo.y, hi.x, hi.y};
            }
            {
                const int f = tid, ln = f & 63, ks2 = (f >> 6) & 1, rt = f >> 7, i = 16 * rt + (ln & 15), fq_ = ln >> 4;
                const u32x2 lo = *(const u32x2*)(QKS + i * QKST + 32 * ks2 + 4 * fq_), hi = *(const u32x2*)(QKS + i * QKST + 32 * ks2 + 16 + 4 * fq_);
                *(u32x4*)(QKf + (size_t)f * 8) = (u32x4){lo.x, lo.y, hi.x, hi.y};
            }
        }
    __syncthreads();
}

DI void gdn_prep_phase(const Params& p) {
    unsigned char* ws = p.ws;
    for (int r = blockIdx.x; r < MS; r += gridDim.x) {
        const int tid = opaque_tid(), b = r >> 5, t = r & 31, pos = PAST + t;
        const float* cs = (const float*)(ws + WS_CS1) + (size_t)r * NH1;
        if (t >= TS - 3) { for (int c = tid; c < 1536; c += 512) p.out[O_CQS + (size_t)(b * 3 + t - (TS - 3)) * 1536 + c] = cs[c]; }
        {
            const int which = tid >> 8, pr = tid & 255, hd = pr >> 6, mp = (pr >> 5) & 1, d = pr & 31, col = hd * 128 + mp * 64 + d;
            const float2 csn = ((const float2*)(ws + WS_ROPE))[pos * 32 + d];
            const float x1 = cs[2048 + which * 512 + col], x2 = cs[2048 + which * 512 + col + 32];
            const float y1 = x1 * csn.x - x2 * csn.y, y2 = x2 * csn.x + x1 * csn.y;
            if (which == 0) { const float qs = 0.125f * 1.4426950408889634f; bf16_t* QB = (bf16_t*)(ws + WS_R4) + ((size_t)MP + r) * 512; QB[col] = f2bf(y1 * qs); QB[col + 32] = f2bf(y2 * qs); }
            else { float* ko = p.out + O_KS + (size_t)r * 512; ko[col] = y1; ko[col + 32] = y2;
                   bf16_t* kk = (bf16_t*)(ws + WS_R5) + ((size_t)MP + (size_t)b * TKS + pos) * 512; kk[col] = f2bf(y1); kk[col + 32] = f2bf(y2); }
        }
        {
            const float vv = cs[3072 + tid];
            p.out[O_VS + (size_t)r * 512 + tid] = vv;
            ((bf16_t*)(ws + WS_R6))[VT_S_OFF + ((size_t)((b * 4 + (tid >> 7)) * 128 + (tid & 127)) * TKS + pos)] = f2bf(vv);
        }
    }
    float cw[3][4];
    gdn_conv_weights(p, blockIdx.x & 3, cw);
    for (int item = blockIdx.x; item < 2048; item += gridDim.x) gdn_prep_item(p, item, cw);
}

constexpr int OPB_B = 57344, L_OBUF = 2 * OPB_B, OST = 132;
static_assert(L_OBUF + 64 * OST * 4 <= LDS_BYTES, "scan LDS");
DI void gdn_scan(const Params& p, const bool samp, const int b, const int h) {
    unsigned char* ws = p.ws;
    const int tid = threadIdx.x, lane = tid & 63, w = __builtin_amdgcn_readfirstlane(tid >> 6), fr = lane & 15, fq = lane >> 4;
    const int nsteps = samp ? 1 : 128, valid = samp ? TS : 64;
    float* OBUF = (float*)(dyn_smem + L_OBUF);
    const bf16_t* HG = (const bf16_t*)(ws + WS_R3);
    bf16_t* OMIX = (bf16_t*)(ws + WS_R2);
    const float* DL = (const float*)(ws + WS_DL);
    f32x4 S[8];
#pragma unroll
    for (int dt = 0; dt < 8; ++dt) {
        if (samp) {
#pragma unroll
            for (int j = 0; j < 4; ++j) S[dt][j] = p.state_gdn[((size_t)(b * 4 + h) * 128 + 16 * dt + 4 * fq + j) * 128 + 16 * w + fr];
        } else S[dt] = (f32x4){0.f, 0.f, 0.f, 0.f};
    }
    const int item0 = samp ? 2048 + b * 4 + h : b * 512 + h;
    __syncthreads();
    {
        const unsigned char* ip = ws + WS_R1 + (size_t)item0 * ITEM_B;
#pragma unroll
        for (int i = 0; i < 7; ++i) *(u32x4*)(dyn_smem + (tid + 512 * i) * 16) = *(const u32x4*)(ip + (tid + 512 * i) * 16);
    }
    __syncthreads();
    const int erow = tid >> 3, ept = tid & 7;
    float nw[16];
#pragma unroll
    for (int e = 0; e < 16; ++e) nw[e] = p.gdn_norm_w[16 * ept + e];
    f32x4 U[4]; float dl; u32x4 g0, g1;
    auto side_load = [&](int c, f32x4 (&Uo)[4], float& dlo, u32x4& go0, u32x4& go1) {
        const int item = item0 + 4 * c;
        const float* Uc = (const float*)(ws + WS_R1 + (size_t)item * ITEM_B + 57344);
#pragma unroll
        for (int rt = 0; rt < 4; ++rt) Uo[rt] = *(const f32x4*)(Uc + ((w * 4 + rt) * 64 + lane) * 4);
        dlo = DL[item];
        const size_t grow = (samp ? (size_t)MP + b * TS : (size_t)b * TP + (size_t)c * 64) + erow;
        if (!samp) { go0 = *(const u32x4*)(HG + grow * 512 + h * 128 + 16 * ept); go1 = *(const u32x4*)(HG + grow * 512 + h * 128 + 16 * ept + 8); }
        else if (erow < TS) { const float* gp = (const float*)(ws + WS_CS1) + (grow - MP) * NH1 + 1536 + h * 128 + 16 * ept;
               const f32x4 f0 = *(const f32x4*)gp, f1 = *(const f32x4*)(gp + 4), f2 = *(const f32x4*)(gp + 8), f3 = *(const f32x4*)(gp + 12);
               go0 = (u32x4){pk2(f0.x, f0.y), pk2(f0.z, f0.w), pk2(f1.x, f1.y), pk2(f1.z, f1.w)}; go1 = (u32x4){pk2(f2.x, f2.y), pk2(f2.z, f2.w), pk2(f3.x, f3.y), pk2(f3.z, f3.w)}; }
        else { go0 = (u32x4){0u, 0u, 0u, 0u}; go1 = go0; }
    };
    side_load(0, U, dl, g0, g1);
#pragma unroll 1
    for (int c = 0; c < nsteps; ++c) {
        const int item = item0 + 4 * c;
        const unsigned char* ip = ws + WS_R1 + (size_t)item * ITEM_B;
        const bool nxt = c + 1 < nsteps;
        u32x4 pf[7];
        f32x4 Un[4]; float dln = 0.f; u32x4 gn0 = g0, gn1 = g1;
        if (nxt) {
#pragma unroll
            for (int i = 0; i < 7; ++i) pf[i] = *(const u32x4*)(ip + 4 * (size_t)ITEM_B + (tid + 512 * i) * 16);
            side_load(c + 1, Un, dln, gn0, gn1);
        }
        const unsigned char* buf = dyn_smem + (c & 1) * OPB_B;
        bf16x8 Sb[4];
#pragma unroll
        for (int ks = 0; ks < 4; ++ks) Sb[ks] = pack8(S[2 * ks], S[2 * ks + 1]);
        f32x4 vn[4];
#pragma unroll
        for (int rt = 0; rt < 4; ++rt) {
            f32x4 acc = (f32x4){0.f, 0.f, 0.f, 0.f};
#pragma unroll
            for (int ks = 0; ks < 4; ++ks) acc = MFMA16(*(const bf16x8*)(buf + ((rt * 4 + ks) * 64 + lane) * 16), Sb[ks], acc);
            vn[rt] = U[rt] - acc;
        }
        bf16x8 Vb[2];
        Vb[0] = pack8(vn[0], vn[1]); Vb[1] = pack8(vn[2], vn[3]);
#pragma unroll
        for (int rt = 0; rt < 4; ++rt) {
            f32x4 acc = (f32x4){0.f, 0.f, 0.f, 0.f};
#pragma unroll
            for (int ks = 0; ks < 4; ++ks) acc = MFMA16(*(const bf16x8*)(buf + 16384 + ((rt * 4 + ks) * 64 + lane) * 16), Sb[ks], acc);
#pragma unroll
            for (int ks2 = 0; ks2 < 2; ++ks2) acc = MFMA16(*(const bf16x8*)(buf + 49152 + ((rt * 2 + ks2) * 64 + lane) * 16), Vb[ks2], acc);
#pragma unroll
            for (int j = 0; j < 4; ++j) OBUF[(16 * rt + 4 * fq + j) * OST + 16 * w + fr] = acc[j];
        }
#pragma unroll
        for (int dt = 0; dt < 8; ++dt) {
            f32x4 acc = S[dt] * dl;
#pragma unroll
            for (int ks2 = 0; ks2 < 2; ++ks2) acc = MFMA16(*(const bf16x8*)(buf + 32768 + ((dt * 2 + ks2) * 64 + lane) * 16), Vb[ks2], acc);
            S[dt] = acc;
        }
        if (nxt) {
#pragma unroll
            for (int i = 0; i < 7; ++i) *(u32x4*)(dyn_smem + ((c + 1) & 1) * OPB_B + (tid + 512 * i) * 16) = pf[i];
        }
        __syncthreads();
        {
            float o[16]; float ss = 0.f;
#pragma unroll
            for (int e4 = 0; e4 < 4; ++e4) { const f32x4 a = *(const f32x4*)(OBUF + erow * OST + 16 * ept + 4 * e4);
#pragma unroll
                for (int e = 0; e < 4; ++e) { o[4 * e4 + e] = a[e]; ss += a[e] * a[e]; } }
#pragma unroll
            for (int of = 1; of < 8; of <<= 1) ss += __shfl_xor(ss, of);
            if (erow < valid) {
                const float r = rsqrtf(ss * (1.f / 128.f) + 1e-6f);
                const size_t grow = (samp ? (size_t)MP + b * TS : (size_t)b * TP + (size_t)c * 64) + erow;
                const unsigned gw[8] = {g0.x, g0.y, g0.z, g0.w, g1.x, g1.y, g1.z, g1.w};
                unsigned ow[8];
#pragma unroll
                for (int e = 0; e < 8; ++e) {
                    const float ga = bflo(gw[e]), gb = bfhi(gw[e]);
                    ow[e] = pk2(o[2 * e] * r * nw[2 * e] * silu(ga), o[2 * e + 1] * r * nw[2 * e + 1] * silu(gb));
                }
                *(u32x4*)(OMIX + grow * 1024 + h * 128 + 16 * ept) = (u32x4){ow[0], ow[1], ow[2], ow[3]};
                *(u32x4*)(OMIX + grow * 1024 + h * 128 + 16 * ept + 8) = (u32x4){ow[4], ow[5], ow[6], ow[7]};
            }
        }
        __syncthreads();
#pragma unroll
        for (int rt = 0; rt < 4; ++rt) U[rt] = Un[rt];
        dl = dln; g0 = gn0; g1 = gn1;
    }
    float* So = p.out + (samp ? O_GS : O_GP) + (size_t)(b * 4 + h) * 128 * 128;
#pragma unroll
    for (int dt = 0; dt < 8; ++dt)
#pragma unroll
        for (int j = 0; j < 4; ++j) So[(size_t)(16 * dt + 4 * fq + j) * 128 + 16 * w + fr] = S[dt][j];
}

constexpr int L_KT = 0, L_VT = 2 * 16384, L_ALX = L_VT + 3 * 16384, L_IDX = L_ALX + 8 * 2 * 32 * 4, L_QF = L_IDX + 256;
static_assert(L_QF + 8 * 8 * 1024 <= LDS_BYTES, "attn LDS");
DI int crow32(int i, int hh) { return (i & 3) + 8 * (i >> 2) + 4 * hh; }

DI void attn_item(const Params& p, const int idx, const float* lamp) {
    unsigned char* ws = p.ws;
    const int tid = opaque_tid(), lane = tid & 63, w = __builtin_amdgcn_readfirstlane(tid >> 6), r = lane & 31, hh = lane >> 5;
    bool samp; int b, h, qb = 0, ntiles, lastw; size_t qbase, kbase; const bf16_t* vtb; int vstride; bool active;
    if (idx < 32) { samp = true; b = idx >> 2; h = idx & 3; qbase = (size_t)MP + b * TS; kbase = (size_t)MP + (size_t)b * TKS; ntiles = 65; lastw = 64; active = w == 0;
                    vtb = (const bf16_t*)(ws + WS_R6) + VT_S_OFF + (size_t)((b * 4 + h) * 128) * TKS; vstride = TKS; }
    else { const int j = idx - 32; samp = false; qb = 31 - (j >> 4); b = (j & 15) >> 2; h = j & 3; qbase = (size_t)b * TP + qb * 256; kbase = (size_t)b * TP; ntiles = 4 * qb + 4; lastw = 4 * qb + (w >> 1); active = true;
           vtb = (const bf16_t*)(ws + WS_R6) + (size_t)((b * 4 + h) * 128) * TP; vstride = TP; }
    const bf16_t* KALL = (const bf16_t*)(ws + WS_R5) + kbase * 512 + h * 128;
    bf16_t* QF = (bf16_t*)(dyn_smem + L_QF) + w * 8 * 64 * 8;
    {
        const bf16_t* qp = (const bf16_t*)(ws + WS_R4) + (qbase + 32 * w + r) * 512 + h * 128 + 8 * hh;
        if (active) {
#pragma unroll
            for (int f = 0; f < 8; ++f) *(u32x4*)(QF + (f * 64 + lane) * 8) = *(const u32x4*)(qp + (f >> 2) * 64 + 16 * (f & 3));
        }
    }
    f32x16 O1[4], O2[4];
#pragma unroll
    for (int t = 0; t < 4; ++t)
#pragma unroll
        for (int i = 0; i < 16; ++i) { O1[t][i] = 0.f; O2[t][i] = 0.f; }
    float m1 = -1e30f, m2 = -1e30f, l1 = 0.f, l2 = 0.f;
    auto stage_tile = [&](int kt_, int buf_, int vbuf_) {
        int ln = lane; asm volatile("" : "+v"(ln));
        const int krow_ = ln >> 4, vrow_ = ln >> 3;
        const unsigned kx = (ln & 15) ^ krow_, vx = (ln & 7) ^ (vrow_ >> 1);
        const unsigned klane = krow_ * 512, vlane = vrow_ * vstride;
#pragma unroll
        for (int j = 0; j < 2; ++j) {
            const int i = 2 * w + j;
            const bf16_t* kbase = KALL + ((size_t)kt_ * 64 + (((4 * i) & ~12) | (((4 * i) & 4) << 1) | (((4 * i) & 8) >> 1))) * 512;
            const bf16_t* vbase = vtb + (size_t)(8 * i) * vstride + (size_t)kt_ * 64;
            const unsigned ko = klane + ((kx ^ ((4 * i) & 15)) * 8), vo = vlane + ((vx ^ ((4 * i) & 7)) * 8);
            __builtin_amdgcn_global_load_lds((const unsigned*)(kbase + ko), (unsigned*)(dyn_smem + L_KT + buf_ * 16384 + i * 1024 + ln * 16), 16, 0, 0);
            __builtin_amdgcn_global_load_lds((const unsigned*)(vbase + vo), (unsigned*)(dyn_smem + L_VT + vbuf_ * 16384 + i * 1024 + ln * 16), 16, 0, 0);
        }
    };
    const int ky = hh ^ (r & 15), vzh = ((r >> 1) & 7) ^ hh;
    __syncthreads();
    stage_tile(0, 0, 0);
    asm volatile("s_waitcnt vmcnt(0)" ::: "memory");
    __syncthreads();
    if (active) {
#pragma unroll
        for (int mp = 0; mp < 2; ++mp) {
            float mx = -1e30f;
#pragma unroll
            for (int sub = 0; sub < 2; ++sub) {
                f32x16 sc;
#pragma unroll
                for (int i = 0; i < 16; ++i) sc[i] = 0.f;
#pragma unroll
                for (int s = 0; s < 4; ++s) {
                    const bf16x8 ka = *(const bf16x8*)(dyn_smem + L_KT + (sub * 32 + r) * 256 + (((mp * 8 + 2 * s) ^ ky) * 16));
                    const bf16x8 qf = *(const bf16x8*)(QF + ((mp * 4 + s) * 64 + lane) * 8);
                    sc = MFMA32(ka, qf, sc);
                }
#pragma unroll
                for (int i = 0; i < 16; ++i) mx = fmaxf(mx, sc[i]);
            }
            const auto sw = __builtin_amdgcn_permlane32_swap(__float_as_uint(mx), __float_as_uint(mx), false, false);
            mx = fmaxf(__uint_as_float(sw[0]), __uint_as_float(sw[1]));
            if (mp == 0) m1 = mx; else m2 = mx;
        }
    }
    const bool roleY = w >= 4;
    bf16x8 PA[2], PB[2];
    float tm1 = -1e30f, tm2 = -1e30f;
    int vcur = 0, vprev = 2;
#define ATT_QK(SUB, MP, SC) do { \
        _Pragma("unroll") for (int s_ = 0; s_ < 4; ++s_) { \
            const bf16x8 ka_ = *(const bf16x8*)(Kb + (SUB) * 32 * 256 + ((((MP) * 8 + 2 * s_) ^ ky) * 16)); \
            const bf16x8 qf_ = *(const bf16x8*)(QF + (((MP) * 4 + s_) * 64 + lane) * 8); \
            SC = MFMA32(ka_, qf_, s_ == 0 ? zero16 : SC); } } while (0)
#define ATT_SM(SC, P, MM, LL, TM, MSK) do { \
        float ps_ = 0.f, tq_ = TM; const float mr_ = MM + MSK; \
        _Pragma("unroll") for (int i_ = 0; i_ < 16; ++i_) { tq_ = fmaxf(tq_, SC[i_]); SC[i_] = __builtin_amdgcn_exp2f(SC[i_] - mr_); ps_ += SC[i_]; } \
        TM = MSK != 0.f ? TM : tq_; \
        LL += ps_; \
        _Pragma("unroll") for (int sp_ = 0; sp_ < 2; ++sp_) { \
            u32x4 a_; a_.x = pk2(SC[8 * sp_], SC[8 * sp_ + 1]); a_.y = pk2(SC[8 * sp_ + 2], SC[8 * sp_ + 3]); a_.z = pk2(SC[8 * sp_ + 4], SC[8 * sp_ + 5]); a_.w = pk2(SC[8 * sp_ + 6], SC[8 * sp_ + 7]); \
            P[sp_] = __builtin_bit_cast(bf16x8, a_); } } while (0)
#define ATT_PV2(VB, SUB, P1, P2) do { \
        _Pragma("unroll") for (int sp_ = 0; sp_ < 2; ++sp_) \
            _Pragma("unroll") for (int t_ = 0; t_ < 4; ++t_) { \
                const bf16x8 vb_ = *(const bf16x8*)((VB) + t_ * 32 * 128 + (((4 * (SUB) + 2 * sp_) ^ vzh) * 16)); \
                O1[t_] = MFMA32(P1[sp_], vb_, O1[t_]); O2[t_] = MFMA32(P2[sp_], vb_, O2[t_]); } } while (0)
#define ATT_QS(SUB, MSK) do { \
        f32x16 scA, scB; \
        ATT_QK(SUB, 0, scA); \
        __builtin_amdgcn_sched_barrier(0); \
        ATT_QK(SUB, 1, scB); \
        ATT_SM(scA, PA, m1, l1, tm1, MSK); \
        __builtin_amdgcn_sched_barrier(0); \
        ATT_SM(scB, PB, m2, l2, tm2, MSK); \
        __builtin_amdgcn_sched_barrier(0); } while (0)
#define ATT_CHECK() do { \
        const auto s1_ = __builtin_amdgcn_permlane32_swap(__float_as_uint(tm1), __float_as_uint(tm1), false, false); tm1 = fmaxf(__uint_as_float(s1_[0]), __uint_as_float(s1_[1])); \
        const auto s2_ = __builtin_amdgcn_permlane32_swap(__float_as_uint(tm2), __float_as_uint(tm2), false, false); tm2 = fmaxf(__uint_as_float(s2_[0]), __uint_as_float(s2_[1])); \
        const float n1 = tm1 > m1 + 8.f ? tm1 : m1, n2 = tm2 > m2 + 8.f ? tm2 : m2; \
        if (__any((n1 != m1) || (n2 != m2))) { \
            const float al1 = __builtin_amdgcn_exp2f(m1 - n1), al2 = __builtin_amdgcn_exp2f(m2 - n2); \
            l1 *= al1; l2 *= al2; m1 = n1; m2 = n2; \
            const int ln_ = __builtin_amdgcn_mbcnt_hi(~0u, __builtin_amdgcn_mbcnt_lo(~0u, 0u)), r_ = ln_ & 31, hh_ = ln_ >> 5; \
            float* alx_ = (float*)(dyn_smem + L_ALX) + w * 64; \
            if (hh_ == 0) { alx_[r_] = al1; alx_[32 + r_] = al2; } \
            asm volatile("s_waitcnt lgkmcnt(0)" ::: "memory"); \
            _Pragma("unroll") for (int g = 0; g < 4; ++g) { \
                const f32x4 a1 = *(const f32x4*)(alx_ + 8 * g + 4 * hh_), a2 = *(const f32x4*)(alx_ + 32 + 8 * g + 4 * hh_); \
                _Pragma("unroll") for (int t = 0; t < 4; ++t) \
                    _Pragma("unroll") for (int j = 0; j < 4; ++j) { O1[t][4 * g + j] *= a1[j]; O2[t][4 * g + j] *= a2[j]; } } \
            asm volatile("s_waitcnt lgkmcnt(0)" ::: "memory"); } \
        tm1 = -1e30f; tm2 = -1e30f; } while (0)
    f32x16 zero16;
#pragma unroll
    for (int i = 0; i < 16; ++i) zero16[i] = 0.f;
    if (!roleY) {
#pragma unroll 1
        for (int kt = 0; kt < ntiles; ++kt) {
            const int vnext = vcur == 2 ? 0 : vcur + 1;
            if (kt + 1 < ntiles) stage_tile(kt + 1, (kt + 1) & 1, vnext);
            const unsigned char* Kb = dyn_smem + L_KT + (kt & 1) * 16384 + r * 256;
            const unsigned char* Vb = dyn_smem + L_VT + vcur * 16384 + r * 128;
            if (active && kt <= lastw) {
                const float msk1 = (samp && kt == 64) ? 1e30f : 0.f;
#pragma unroll 1
                for (int sub = 0; sub < 2; ++sub) {
                    const float msk = sub ? msk1 : 0.f;
                    ATT_QS(sub, msk);
                    ATT_PV2(Vb, sub, PA, PB);
                    __builtin_amdgcn_sched_barrier(0);
                }
                ATT_CHECK();
            }
            vcur = vnext;
            asm volatile("s_waitcnt vmcnt(0)" ::: "memory");
            __builtin_amdgcn_s_barrier();
        }
    } else {
#pragma unroll 1
        for (int kt = 0; kt < ntiles; ++kt) {
            const int vnext = vcur == 2 ? 0 : vcur + 1;
            if (kt + 1 < ntiles) stage_tile(kt + 1, (kt + 1) & 1, vnext);
            const unsigned char* Kb = dyn_smem + L_KT + (kt & 1) * 16384 + r * 256;
            const unsigned char* Vb = dyn_smem + L_VT + vcur * 16384 + r * 128;
            const unsigned char* Vp = dyn_smem + L_VT + vprev * 16384 + r * 128;
            if (kt <= lastw + 1) {
                if (kt > 0) { ATT_PV2(Vp, 1, PA, PB); __builtin_amdgcn_sched_barrier(0); }
                if (kt <= lastw) {
                    ATT_CHECK();
                    ATT_QS(0, 0.f);
                    ATT_PV2(Vb, 0, PA, PB);
                    __builtin_amdgcn_sched_barrier(0);
                    ATT_QS(1, 0.f);
                }
            }
            vprev = vcur; vcur = vnext;
            asm volatile("s_waitcnt vmcnt(0)" ::: "memory");
            __builtin_amdgcn_s_barrier();
        }
        if (lastw == ntiles - 1) {
            const unsigned char* Vp = dyn_smem + L_VT + vprev * 16384 + r * 128;
            ATT_PV2(Vp, 1, PA, PB);
        }
    }
    if (active) {
        const int lnf = __builtin_amdgcn_mbcnt_hi(~0u, __builtin_amdgcn_mbcnt_lo(~0u, 0u)), r = lnf & 31, hh = lnf >> 5;
        float* ALX = (float*)(dyn_smem + L_ALX) + w * 64;
        { const auto s1_ = __builtin_amdgcn_permlane32_swap(__float_as_uint(l1), __float_as_uint(l1), false, false); l1 = __uint_as_float(s1_[0]) + __uint_as_float(s1_[1]);
          const auto s2_ = __builtin_amdgcn_permlane32_swap(__float_as_uint(l2), __float_as_uint(l2), false, false); l2 = __uint_as_float(s2_[0]) + __uint_as_float(s2_[1]); }
        if (hh == 0) { ALX[r] = __builtin_amdgcn_rcpf(l1); ALX[32 + r] = *lamp * __builtin_amdgcn_rcpf(l2); }
        asm volatile("s_waitcnt lgkmcnt(0)" ::: "memory");
        float ss[16], a1[16], a2[16];
#pragma unroll
        for (int g = 0; g < 4; ++g) {
            const f32x4 x1 = *(const f32x4*)(ALX + 8 * g + 4 * hh), x2 = *(const f32x4*)(ALX + 32 + 8 * g + 4 * hh);
#pragma unroll
            for (int j = 0; j < 4; ++j) { a1[4 * g + j] = x1[j]; a2[4 * g + j] = x2[j]; ss[4 * g + j] = 0.f; }
        }
#pragma unroll
        for (int t = 0; t < 4; ++t) {
            __builtin_amdgcn_sched_barrier(0);
#pragma unroll
            for (int i = 0; i < 16; ++i) { const float o = O1[t][i] * a1[i] - O2[t][i] * a2[i]; O1[t][i] = o; ss[i] += o * o; }
        }
        __builtin_amdgcn_sched_barrier(0);
#pragma unroll
        for (int i = 0; i < 16; ++i) {
#pragma unroll
            for (int of = 1; of < 32; of <<= 1) ss[i] += __shfl_xor(ss[i], of);
            ss[i] = __builtin_amdgcn_rsqf(ss[i] * (1.f / 128.f) + 1e-6f) * (1.f - LAM_INIT);
        }
        int zo = 0; asm volatile("" : "+v"(zo));
        bf16_t* obase = (bf16_t*)(ws + WS_R2) + (qbase + 32 * w) * 1024 + 512 + h * 128;
        const unsigned ooff = (unsigned)((4 * hh + zo) * 1024 + r);
        const float* sw = p.subln_w + r + zo;
#pragma unroll
        for (int t = 0; t < 4; ++t) {
            const float wv = sw[32 * t];
#pragma unroll
            for (int i = 0; i < 16; ++i) obase[ooff + ((i & 3) + 8 * (i >> 2)) * 1024 + 32 * t] = f2bf(O1[t][i] * ss[i] * wv);
        }
    }
}

DI void mixer_phase(const Params& p) {
    const int bid = blockIdx.x;
#ifndef NO_SCAN
    if (bid >= 16 && bid < 48) {
        float cw[3][4];
        gdn_conv_weights(p, (bid - 16) & 3, cw);
        gdn_prep_item(p, 2048 + bid - 16, cw);
        asm volatile("s_waitcnt vmcnt(0)" ::: "memory");
        __builtin_amdgcn_fence(__ATOMIC_ACQUIRE, "agent");
        asm volatile("s_waitcnt vmcnt(0)" ::: "memory");
        __syncthreads();
    }
    if (bid < 48) { const bool sm = bid >= 16; const int j = sm ? bid - 16 : bid;
#pragma unroll 1
        for (int rep = 0; rep < SREP; ++rep) gdn_scan(p, sm, j >> 2, j & 3); }
#endif
    unsigned* ctl = (unsigned*)(p.ws + WS_CTL);
    int* sidx = (int*)(dyn_smem + L_IDX);
    for (;;) {
        __syncthreads();
        if (threadIdx.x == 0) *sidx = (int)atomicAdd(ctl, 1u);
        __syncthreads();
        const int idx0 = __builtin_amdgcn_readfirstlane(*sidx);
        if (idx0 >= (32 + 512) * AREP) break;
        const int idx = idx0 % (32 + 512);
#ifndef NO_ATTN
        attn_item(p, idx, (const float*)ctl + 1);
#endif
    }
}


#define XB_TMO      128
#define XB_XCNT(j)  (256  + 64 * (j))
#define XB_XSUB(j)  (1280 + 64 * (j))
#define XB_XGEN(j)  (2304 + 64 * (j))
#define XB_TOP      3328
#define XB_TOPGEN   3392
#define XCD_BAR_WORDS 3456
#define XB_SPIN_CAP (1u << 20)
#define LAS __attribute__((address_space(3)))
DI unsigned xb_ld(unsigned* p) { return __hip_atomic_load(p, __ATOMIC_RELAXED, __HIP_MEMORY_SCOPE_AGENT); }
DI unsigned xb_add(unsigned* p, unsigned v) { return __hip_atomic_fetch_add(p, v, __ATOMIC_RELAXED, __HIP_MEMORY_SCOPE_AGENT); }
DI unsigned xb_xcc_id() { return (unsigned)__builtin_amdgcn_s_getreg((3 << 11) | 20) & 0xFu; }
#define XB_SPIN(cond, bar) do { unsigned _sp = 0; while (cond) { __builtin_amdgcn_s_sleep(1); \
    if ((++_sp & 255u) == 0u) { if (xb_ld(&(bar)[XB_TMO])) break; if (_sp > XB_SPIN_CAP) { atomicAdd(&(bar)[XB_TMO], 1u); break; } } } } while (0)
struct XcdBarrier { unsigned* bar; unsigned x; volatile LAS unsigned* st; };
DI XcdBarrier xcd_barrier_post(unsigned* bar, volatile LAS unsigned* st) {
    XcdBarrier b; b.bar = bar; b.x = xb_xcc_id(); b.st = st;
    if (threadIdx.x == 0) (void)xb_add(&bar[XB_XCNT(b.x)], 1u);
    return b;
}
DI void xcd_barrier_complete(unsigned* bar, unsigned x, unsigned& nloc, unsigned& nx) {
    const unsigned G = gridDim.x * gridDim.y * gridDim.z;
    unsigned sum, cnt, mine, sp = 0u;
    for (;;) {
        sum = 0u; cnt = 0u; mine = 0u;
#pragma unroll
        for (unsigned j = 0; j < 16; ++j) { const unsigned c = xb_ld(&bar[XB_XCNT(j)]); sum += c; cnt += (c > 0u) ? 1u : 0u; mine = (j == x) ? c : mine; }
        if (sum == G) break;
        __builtin_amdgcn_s_sleep(1);
        if ((++sp & 255u) == 0u) { if (xb_ld(&bar[XB_TMO])) break; if (sp > XB_SPIN_CAP) { atomicAdd(&bar[XB_TMO], 1u); break; } }
    }
    nloc = mine > 0u ? mine : 1u; nx = cnt > 0u ? cnt : 1u;
}
DI void xcd_barrier(const XcdBarrier& b) {
    asm volatile("s_waitcnt vmcnt(0)" ::: "memory");
    __syncthreads();
    if (threadIdx.x == 0) {
        unsigned* bar = b.bar;
        __builtin_amdgcn_s_waitcnt(0);
        unsigned nloc = b.st[0], nx = b.st[1];
        if (nloc == 0u) { xcd_barrier_complete(bar, b.x, nloc, nx); b.st[0] = nloc; b.st[1] = nx; }
        const unsigned old = xb_add(&bar[XB_XSUB(b.x)], 1u);
        const unsigned gen = old / nloc;
        if (old + 1u == (gen + 1u) * nloc) {
            __builtin_amdgcn_fence(__ATOMIC_RELEASE, "agent");
            asm volatile("s_waitcnt vmcnt(0)" ::: "memory");
            const unsigned og = xb_add(&bar[XB_TOP], 1u);
            const unsigned tg = og / nx;
            if (og + 1u == (tg + 1u) * nx) xb_add(&bar[XB_TOPGEN], 1u);
            else XB_SPIN(xb_ld(&bar[XB_TOPGEN]) == tg, bar);
            __builtin_amdgcn_fence(__ATOMIC_ACQUIRE, "agent");
            xb_add(&bar[XB_XGEN(b.x)], 1u);
            asm volatile("s_waitcnt vmcnt(0)" ::: "memory");
        } else {
            XB_SPIN(xb_ld(&bar[XB_XGEN(b.x)]) == gen, bar);
            __builtin_amdgcn_fence(__ATOMIC_ACQUIRE, "agent");
            asm volatile("s_waitcnt vmcnt(0)" ::: "memory");
        }
    }
    __syncthreads();
}

__global__ void __launch_bounds__(512, 2) fwd_kernel(Params p) {
    cg::grid_group grid = cg::this_grid();
    volatile LAS unsigned* xst = (volatile LAS unsigned*)(dyn_smem + LDS_BYTES - 16);
    if (threadIdx.x == 0) { xst[0] = 0u; xst[1] = 0u; }
    __syncthreads();
    const XcdBarrier xb = xcd_barrier_post((unsigned*)(p.ws + WS_BAR), xst);
    if (p.phase_lo > 1000) grid.sync();
    const bool all = p.phase_hi - p.phase_lo > 1;
#define PHASE(i, body) if (p.phase_lo <= (i) && (i) < p.phase_hi) { body; if (all && (i) + 1 < p.phase_hi) xcd_barrier(xb); }
    PHASE(0, phase_prep(p))
    PHASE(1, gemm_phase<1>(p))
    PHASE(2, gdn_prep_phase(p))
    PHASE(3, mixer_phase(p))
    PHASE(4, gemm_phase<2>(p))
    PHASE(5, ln_phase<0>(p))
    PHASE(6, gemm_phase<3>(p))
    PHASE(7, fixup_phase(p))
    PHASE(8, gemm_phase<4>(p))
    PHASE(9, ln_phase<1>(p))
}

extern "C" void kernel_launch(void* const* d_in, const int* in_sizes, int n_in, void* d_out, int out_size, void* d_ws, size_t ws_size, hipStream_t stream) {
    static int grid = 0;
    if (grid == 0) {
        if (n_in != 23 || (size_t)out_size != O_END || ws_size < WS_END2) { fprintf(stderr, "kernel_launch: unexpected sizes n_in %d out %d ws %zu (need %zu)\n", n_in, out_size, ws_size, (size_t)WS_END2); grid = -1; return; }
        int dev = 0, cus = 0, per_cu = 0;
        hipGetDevice(&dev);
        hipDeviceGetAttribute(&cus, hipDeviceAttributeMultiprocessorCount, dev);
        if (hipFuncSetAttribute((const void*)fwd_kernel, hipFuncAttributeMaxDynamicSharedMemorySize, LDS_BYTES) != hipSuccess) { fprintf(stderr, "kernel_launch: hipFuncSetAttribute failed\n"); grid = -1; return; }
        hipOccupancyMaxActiveBlocksPerMultiprocessor(&per_cu, (const void*)fwd_kernel, 512, LDS_BYTES);
        if (per_cu < 1) { fprintf(stderr, "kernel_launch: occupancy query says %d\n", per_cu); per_cu = 1; }
        (void)hipGetLastError();
        grid = cus * 1;
    }
    if (grid < 0) return;
    Params p{};
    const float** f = (const float**)&p;
    for (int i = 0; i < 23; ++i) f[i] = (const float*)d_in[i];
    p.out = (float*)d_out; p.ws = (unsigned char*)d_ws; p.phase_lo = 0; p.phase_hi = 10;
    if (hipMemsetAsync((unsigned char*)d_ws + WS_BAR, 0, 16384, stream) != hipSuccess) { fprintf(stderr, "kernel_launch: memset failed\n"); return; }
    void* args[] = {&p};
    hipError_t e = hipLaunchCooperativeKernel((const void*)fwd_kernel, dim3(grid), dim3(512), args, LDS_BYTES, stream);
    if (e != hipSuccess) fprintf(stderr, "cooperative launch failed: %s (grid %d)\n", hipGetErrorString(e), grid);
}
```

```cpp
#include <hip/hip_runtime.h>
#include <hip/hip_cooperative_groups.h>
#include <cstdio>
namespace cg = cooperative_groups;
#ifndef GREP_WHICH
#define GREP_WHICH 0
#endif
#ifndef AREP
#define AREP 1
#endif
#ifndef SREP
#define SREP 1
#endif

typedef unsigned short bf16_t;
typedef short bf16x8 __attribute__((ext_vector_type(8)));
typedef short s16x4 __attribute__((ext_vector_type(4)));
typedef float f32x4 __attribute__((ext_vector_type(4)));
typedef float f32x16 __attribute__((ext_vector_type(16)));
typedef unsigned u32x4 __attribute__((ext_vector_type(4)));
typedef unsigned u32x2 __attribute__((ext_vector_type(2)));
#define DI __device__ __forceinline__

constexpr int D = 1024, TP = 8192, BP = 4, MP = BP * TP, BS = 8, TS = 32, MS = BS * TS, M = MP + MS, PAST = 4096;
constexpr int DIN = 3592, NH1 = 3584, DFF = 2816, NUP = 2 * DFF;
constexpr int TKS = 4160;
constexpr int NITEM = BP * 128 * 4 + BS * 4;
constexpr int ITEM_B = 90112;
constexpr int LDS_BYTES = 160 * 1024;
constexpr float ALPHA = 1.189207115002721f;
constexpr float LAM_INIT = 0.2f;

constexpr size_t O_Y = 0, O_KP = 33816576, O_VP = 50593792, O_GP = 67371008, O_CQP = 67633152, O_CFP = 67651584,
                 O_KS = 67696640, O_VS = 67827712, O_GS = 67958784, O_CQS = 68483072, O_CFS = 68519936, O_END = 68610048;

constexpr size_t al256(size_t x) { return (x + 255) & ~(size_t)255; }
constexpr size_t WS_CTL = 0;
constexpr size_t WS_ROPE = 4096;
constexpr size_t WS_AB = WS_ROPE + (size_t)8192 * 32 * 8;
constexpr size_t WS_DL = WS_AB + (size_t)M * 8 * 4;
constexpr size_t WS_WIN = al256(WS_DL + NITEM * 4);
constexpr size_t WS_WO = WS_WIN + (size_t)NH1 * D * 2;
constexpr size_t WS_WUP = WS_WO + (size_t)D * D * 2;
constexpr size_t WS_WDN = WS_WUP + (size_t)NUP * D * 2;
constexpr size_t WS_R1 = al256(WS_WDN + (size_t)D * DFF * 2);
constexpr size_t R1_SIZE = (size_t)NITEM * ITEM_B;
constexpr size_t WS_R2 = al256(WS_R1 + R1_SIZE);
constexpr size_t WS_R3 = al256(WS_R2 + (size_t)M * 1536 * 2);
constexpr size_t WS_R4 = WS_R3 + (size_t)M * 512 * 2;
constexpr size_t WS_R5 = al256(WS_R4 + (size_t)M * 512 * 2);
constexpr size_t KROWS = (size_t)MP + (size_t)BS * TKS;
constexpr size_t WS_R6 = al256(WS_R5 + KROWS * 512 * 2);
constexpr size_t VT_S_OFF = (size_t)BP * 4 * 128 * TP;
constexpr size_t WS_END = al256(WS_R6 + (VT_S_OFF + (size_t)BS * 4 * 128 * TKS) * 2);
constexpr size_t WS_CS1 = WS_END;
constexpr size_t WS_CS2 = WS_CS1 + (size_t)MS * NH1 * 4;
constexpr size_t WS_CS3 = WS_CS2 + (size_t)MS * D * 4;
constexpr size_t WS_CS4 = WS_CS3 + (size_t)MS * NUP * 4;
constexpr size_t WS_BAR = WS_CS4 + (size_t)MS * D * 4;
constexpr size_t WS_END2 = WS_BAR + 16384;
static_assert((size_t)M * DFF * 2 <= R1_SIZE, "GT must fit R1");
static_assert(WS_END2 <= (size_t)536870912, "workspace too large");

struct Params {
    const float *x_p, *x_s, *cache_k, *cache_v, *state_gdn, *state_cq, *state_cf;
    const float *w_in, *gdn_conv_w, *a_log, *dt_bias, *gdn_norm_w, *diff_lambda, *subln_w, *w_o, *ln1_g, *ln1_b, *w_up,
        *ffn_conv_w, *ffn_conv_b, *w_down, *ln2_g, *ln2_b;
    float* out; unsigned char* ws;
    int phase_lo, phase_hi;
};

extern __shared__ __attribute__((aligned(16))) unsigned char dyn_smem[];

typedef __bf16 bf16x2_t __attribute__((ext_vector_type(2)));
typedef float f32x2 __attribute__((ext_vector_type(2)));
DI unsigned pk2(float lo, float hi) { f32x2 v = {lo, hi}; bf16x2_t b = __builtin_convertvector(v, bf16x2_t); return __builtin_bit_cast(unsigned, b); }
DI bf16_t f2bf(float x) { return (bf16_t)(pk2(x, 0.f) & 0xffffu); }
DI float bf2f(bf16_t b) { return __uint_as_float(((unsigned)b) << 16); }
DI float bflo(unsigned u) { return __uint_as_float(u << 16); }
DI float bfhi(unsigned u) { return __uint_as_float(u & 0xffff0000u); }
DI float silu(float x) { return x * __builtin_amdgcn_rcpf(1.f + __expf(-x)); }
DI int opaque_tid() { int t = threadIdx.x; asm volatile("" : "+v"(t)); return t; }
DI float wave_sum(float v) {
#pragma unroll
    for (int o = 1; o < 64; o <<= 1) v += __shfl_xor(v, o);
    return v;
}
DI const float* xrow_ptr(const Params& p, int row) { return row < MP ? p.x_p + (size_t)row * D : p.x_s + (size_t)(row - MP) * D; }

template <int MODE> DI int srccol(int n) {
    if (MODE == 1) {
        if (n < 2048) return n;
        return n + 8;
    }
    if (MODE == 2) { const int pn = n >> 8, j = n & 255; return j < 128 ? 128 * pn + j : DFF + 128 * pn + (j - 128); }
    return n;
}
struct TrItem { const float* W; bf16_t* WT; int K, N, k0, n0, mode; };
DI TrItem tr_decode(const Params& p, int it) {
    constexpr int I_IN = 16 * 56, I_O = 16 * 16, I_UP = 16 * 88;
    unsigned char* ws = p.ws; TrItem t; int r = it;
    if (r < I_IN) { t.W = p.w_in; t.WT = (bf16_t*)(ws + WS_WIN); t.K = D; t.N = DIN; t.k0 = (r / 56) * 64; t.n0 = (r % 56) * 64; t.mode = 1; return t; } r -= I_IN;
    if (r < I_O) { t.W = p.w_o; t.WT = (bf16_t*)(ws + WS_WO); t.K = D; t.N = D; t.k0 = (r / 16) * 64; t.n0 = (r % 16) * 64; t.mode = 0; return t; } r -= I_O;
    if (r < I_UP) { t.W = p.w_up; t.WT = (bf16_t*)(ws + WS_WUP); t.K = D; t.N = NUP; t.k0 = (r / 88) * 64; t.n0 = (r % 88) * 64; t.mode = 2; return t; } r -= I_UP;
    t.W = p.w_down; t.WT = (bf16_t*)(ws + WS_WDN); t.K = DFF; t.N = D; t.k0 = (r / 16) * 64; t.n0 = (r % 16) * 64; t.mode = 0; return t;
}
DI void tr_load(const TrItem& t, float (&v)[8]) {
    const int tid = threadIdx.x, n = t.n0 + (tid & 63);
    const int sc = t.mode == 1 ? (n < 2048 ? n : n + 8) : (t.mode == 2 ? srccol<2>(n) : n);
#pragma unroll
    for (int i = 0; i < 8; ++i) v[i] = t.W[(size_t)(t.k0 + (tid >> 6) + 8 * i) * t.N + sc];
}
DI void transpose_range(const Params& p, const int lo, const int hi) {
    const int tid = opaque_tid(), nb = gridDim.x, bid = blockIdx.x;
    float* lds = (float*)dyn_smem;
    float v[8];
    __syncthreads();
    TrItem cur = tr_decode(p, lo + bid < hi ? lo + bid : lo);
    if (lo + bid < hi) tr_load(cur, v);
    for (int it = lo + bid; it < hi; it += nb) {
        float nv[8]; TrItem nx = cur;
        if (it + nb < hi) { nx = tr_decode(p, it + nb); tr_load(nx, nv); }
#pragma unroll
        for (int i = 0; i < 8; ++i) lds[((tid >> 6) + 8 * i) * 65 + (tid & 63)] = v[i];
        __syncthreads();
#pragma unroll
        for (int i = 0; i < 8; ++i) { const int nn = (tid >> 6) + 8 * i, kk = tid & 63; cur.WT[(size_t)(cur.n0 + nn) * cur.K + cur.k0 + kk] = f2bf(lds[kk * 65 + nn]); }
        __syncthreads();
#pragma unroll
        for (int i = 0; i < 8; ++i) v[i] = nv[i];
        cur = nx;
    }
}
DI void phase_prep(const Params& p) {
    const int tid = threadIdx.x, lane = tid & 63, wave = tid >> 6, nb = gridDim.x, bid = blockIdx.x;
    unsigned char* ws = p.ws;
    if (bid == 0 && tid < 64) {
        unsigned* ctl = (unsigned*)(ws + WS_CTL);
        float a = p.diff_lambda[lane] * p.diff_lambda[64 + lane], b = p.diff_lambda[128 + lane] * p.diff_lambda[192 + lane];
        a = wave_sum(a); b = wave_sum(b);
        if (lane == 0) { ctl[0] = 0u; ((float*)ctl)[1] = expf(a) - expf(b) + LAM_INIT; }
    }
    transpose_range(p, 0, 16 * 56);
    {
        float2* rope = (float2*)(ws + WS_ROPE);
        for (int idx = bid * 512 + tid; idx < 8192 * 32; idx += nb * 512) {
            const int pos = idx >> 5, d = idx & 31;
            const double inv = exp(-(double)d * (9.210340371976184 / 32.0));
            double a = (double)pos * inv;
            a -= 6.283185307179586 * rint(a * 0.15915494309189535);
            const float af = (float)a;
            rope[idx] = make_float2(__cosf(af), __sinf(af));
        }
    }
    {
        float* w8 = (float*)dyn_smem;
        __syncthreads();
        for (int i = tid; i < 1024 * 8; i += 512) w8[i] = p.w_in[(size_t)(i >> 3) * DIN + 2048 + (i & 7)];
        __syncthreads();
        bf16_t* XB = (bf16_t*)(ws + WS_R1);
        float* AB = (float*)(ws + WS_AB);
        f32x4 cv[4];
        {
            const int row = bid * 8 + wave;
            if (row < M) { const float* xr = xrow_ptr(p, row);
#pragma unroll
                for (int j = 0; j < 4; ++j) cv[j] = *(const f32x4*)(xr + lane * 4 + 256 * j); }
        }
        for (int row = bid * 8 + wave; row < M; row += nb * 8) {
            f32x4 nvx[4];
            if (row + nb * 8 < M) { const float* xn = xrow_ptr(p, row + nb * 8);
#pragma unroll
                for (int j = 0; j < 4; ++j) nvx[j] = *(const f32x4*)(xn + lane * 4 + 256 * j); }
            float acc[8];
#pragma unroll
            for (int c = 0; c < 8; ++c) acc[c] = 0.f;
#pragma unroll
            for (int j = 0; j < 4; ++j) {
                const int k0 = lane * 4 + 256 * j;
                const f32x4 v = cv[j];
                u32x2 o; o.x = pk2(v.x, v.y); o.y = pk2(v.z, v.w);
                *(u32x2*)(XB + (size_t)row * D + k0) = o;
#pragma unroll
                for (int e = 0; e < 4; ++e) {
                    const f32x4 wa = *(const f32x4*)(w8 + (k0 + e) * 8), wb = *(const f32x4*)(w8 + (k0 + e) * 8 + 4);
                    const float xv = v[e];
                    acc[0] += xv * wa.x; acc[1] += xv * wa.y; acc[2] += xv * wa.z; acc[3] += xv * wa.w;
                    acc[4] += xv * wb.x; acc[5] += xv * wb.y; acc[6] += xv * wb.z; acc[7] += xv * wb.w;
                }
            }
#pragma unroll
            for (int c = 0; c < 8; ++c) acc[c] = wave_sum(acc[c]);
            if (lane == 0) { *(f32x4*)(AB + (size_t)row * 8) = (f32x4){acc[0], acc[1], acc[2], acc[3]}; *(f32x4*)(AB + (size_t)row * 8 + 4) = (f32x4){acc[4], acc[5], acc[6], acc[7]}; }
#pragma unroll
            for (int j = 0; j < 4; ++j) cv[j] = nvx[j];
        }
        __syncthreads();
    }
}

DI void prep_stream(const Params& p) {
    const int tid = opaque_tid(), nb = gridDim.x, bid = blockIdx.x;
    unsigned char* ws = p.ws;
    transpose_range(p, 16 * 56, 16 * 56 + 16 * 16 + 16 * 88 + 44 * 16);
    __syncthreads();
    {
        bf16_t* KALL = (bf16_t*)(ws + WS_R5);
        const int nchunk = BS * TKS * 64;
        for (int c0 = bid * 512 + tid; c0 < nchunk; c0 += nb * 512 * 4) {
            f32x4 v0[4], v1[4]; int st[4]; size_t dsto[4];
#pragma unroll
            for (int u = 0; u < 4; ++u) {
                const int c = c0 + u * nb * 512;
                st[u] = 0;
                if (c < nchunk) {
                    const int col8 = c & 63, r = c >> 6, b = r / TKS, pp = r % TKS;
                    dsto[u] = ((size_t)MP + (size_t)b * TKS + pp) * 512 + col8 * 8;
                    if (pp < PAST) { const float* sp = p.cache_k + ((size_t)(b * PAST + pp) * 512 + col8 * 8); v0[u] = *(const f32x4*)sp; v1[u] = *(const f32x4*)(sp + 4); st[u] = 1; }
                    else if (pp >= PAST + TS) st[u] = 2;
                }
            }
#pragma unroll
            for (int u = 0; u < 4; ++u) {
                if (st[u] == 1) { u32x4 o; o.x = pk2(v0[u].x, v0[u].y); o.y = pk2(v0[u].z, v0[u].w); o.z = pk2(v1[u].x, v1[u].y); o.w = pk2(v1[u].z, v1[u].w); *(u32x4*)(KALL + dsto[u]) = o; }
                else if (st[u] == 2) *(u32x4*)(KALL + dsto[u]) = (u32x4){0u, 0u, 0u, 0u};
            }
        }
    }
    {
        bf16_t* VTS = (bf16_t*)(ws + WS_R6) + VT_S_OFF;
        bf16_t* t = (bf16_t*)dyn_smem;
        f32x4 cvv[4];
        auto ldv = [&](int it, f32x4 (&v)[4]) {
            const int blk = it % 65, bh = it / 65, b = bh >> 2, h = bh & 3;
            if (blk < 64) {
#pragma unroll
                for (int i = 0; i < 4; ++i) { const int id = tid + 512 * i, key = id >> 5, c4 = id & 31;
                    v[i] = *(const f32x4*)(p.cache_v + ((size_t)(b * PAST + blk * 64 + key) * 512 + h * 128 + c4 * 4)); }
            }
        };
        if (bid < BS * 4 * 65) ldv(bid, cvv);
        for (int it = bid; it < BS * 4 * 65; it += nb) {
            const int blk = it % 65, bh = it / 65;
            f32x4 nvv[4];
            if (it + nb < BS * 4 * 65) ldv(it + nb, nvv);
            if (blk < 64) {
                __syncthreads();
#pragma unroll
                for (int i = 0; i < 4; ++i) {
                    const int id = tid + 512 * i, key = id >> 5, c4 = id & 31;
                    const f32x4 v = cvv[i];
                    bf16_t* d = t + key * 130 + c4 * 4;
                    *(unsigned*)d = pk2(v.x, v.y); *(unsigned*)(d + 2) = pk2(v.z, v.w);
                }
                __syncthreads();
                const int dv = tid >> 2, part = tid & 3;
                unsigned o[8];
#pragma unroll
                for (int i = 0; i < 8; ++i) { const int k0 = part * 16 + 2 * i; o[i] = (unsigned)t[k0 * 130 + dv] | ((unsigned)t[(k0 + 1) * 130 + dv] << 16); }
                bf16_t* dst = VTS + ((size_t)(bh * 128 + dv) * TKS + blk * 64 + part * 16);
                *(u32x4*)dst = (u32x4){o[0], o[1], o[2], o[3]}; *(u32x4*)(dst + 8) = (u32x4){o[4], o[5], o[6], o[7]};
            } else {
                if (tid < 128) { bf16_t* dst = VTS + ((size_t)(bh * 128 + tid) * TKS + PAST + TS);
#pragma unroll
                    for (int i = 0; i < 4; ++i) *(u32x4*)(dst + 8 * i) = (u32x4){0u, 0u, 0u, 0u}; }
            }
#pragma unroll
            for (int i = 0; i < 4; ++i) cvv[i] = nvv[i];
        }
        __syncthreads();
    }
}

constexpr int BM = 256, BK = 64, HALF = 128, NXCD = 8, WGM = 8, HT = HALF * BK;
DI void stage_rc(int b, int& R, int& C) {
    const int st = b / 1024, sb = b % 1024, swz = sb ^ (((sb >> 9) & 1) << 5);
    R = (st >> 1) * 16 + swz / 64; C = (st & 1) * 32 + (swz % 64) / 2;
}
DI int lds_byte(int r, int c) {
    const int st = (r >> 4) * 2 + (c >> 5), rr = r & 15, cc = c & 31, ob = rr * 64 + cc * 2;
    return st * 1024 + (ob ^ (((ob >> 9) & 1) << 5));
}

#define SHM ((bf16_t*)dyn_smem)
#define SA(b, h) (SHM + ((b) * 2 + (h)) * HT)
#define SB(b, h) (SHM + (4 + (b) * 2 + (h)) * HT)
#define STAGE(P, BASE, br, kt) do { const bf16_t* _gb = (BASE) + ((long)(br) * K + (long)(kt) * BK); \
      __builtin_amdgcn_global_load_lds((const unsigned*)(_gb + so0), (unsigned*)((char*)(P) + wlds), 16, 0, 0); \
      __builtin_amdgcn_global_load_lds((const unsigned*)(_gb + 64 * K + so0), (unsigned*)((char*)(P) + wlds + 8192), 16, 0, 0); } while (0)
#define LDA(dst, b, h) for (int m = 0; m < 4; ++m) for (int k = 0; k < 2; ++k) \
    dst[m][k] = *reinterpret_cast<const bf16x8*>((char*)SA(b, h) + lds_byte(wr * 64 + m * 16 + fr, k * 32 + fq * 8))
#define LDB(dst, b, h) for (int n = 0; n < 2; ++n) for (int k = 0; k < 2; ++k) \
    dst[n][k] = *reinterpret_cast<const bf16x8*>((char*)SB(b, h) + lds_byte(wc * 32 + n * 16 + fr, k * 32 + fq * 8))
#define MMA(ai, bj, At, Bt_) do { __builtin_amdgcn_s_setprio(1); \
    for (int m = 0; m < 4; ++m) for (int n = 0; n < 2; ++n) for (int k = 0; k < 2; ++k) \
      acc[ai][bj][m][n] = __builtin_amdgcn_mfma_f32_16x16x32_bf16(Bt_[n][k], At[m][k], acc[ai][bj][m][n], 0, 0, 0); \
    __builtin_amdgcn_s_setprio(0); } while (0)
#define WAIT_V(n) asm volatile("s_waitcnt vmcnt(" #n ")" ::: "memory")
#define WAIT_L(n) asm volatile("s_waitcnt lgkmcnt(" #n ")" ::: "memory")
#define BAR __builtin_amdgcn_s_barrier()
#define SCHED __builtin_amdgcn_sched_barrier(0)

template <int K> DI void gemm_tile(const bf16_t* __restrict__ A, const bf16_t* __restrict__ Bt, const int brow, const int bcol, f32x4 (&acc)[2][2][4][2]) {
    const int wid = threadIdx.x >> 6, lane = threadIdx.x & 63, wr = wid >> 2, wc = wid & 3, fr = lane & 15, fq = lane >> 4;
    unsigned so0;
    { int _r, _c; stage_rc(threadIdx.x * 16, _r, _c); so0 = (unsigned)(_r * K + _c); }
    const int wlds = __builtin_amdgcn_readfirstlane((int)(threadIdx.x >> 6) << 10);
#pragma unroll
    for (int a = 0; a < 2; ++a)
#pragma unroll
        for (int b = 0; b < 2; ++b)
#pragma unroll
            for (int m = 0; m < 4; ++m)
#pragma unroll
                for (int n = 0; n < 2; ++n) acc[a][b][m][n] = (f32x4){0.f, 0.f, 0.f, 0.f};
    bf16x8 At[4][2], B0[2][2], B1[2][2];
    constexpr int nt = K / BK;
    STAGE(SB(0, 0), Bt, bcol, 0); STAGE(SA(0, 0), A, brow, 0);
    STAGE(SB(0, 1), Bt, bcol + HALF, 0); STAGE(SA(0, 1), A, brow + HALF, 0);
    if (wr == 1) BAR;
    WAIT_V(4); BAR;
    STAGE(SB(1, 0), Bt, bcol, 1); STAGE(SA(1, 0), A, brow, 1); STAGE(SB(1, 1), Bt, bcol + HALF, 1);
    WAIT_V(6); BAR;
    for (int t = 0; t < nt - 2; t += 2) {
        LDB(B0, 0, 0); SCHED; LDA(At, 0, 0); STAGE(SA(1, 1), A, brow + HALF, t + 1);
        WAIT_L(8); BAR; WAIT_L(0); MMA(0, 0, At, B0); BAR; SCHED;
        LDB(B1, 0, 1); STAGE(SB(0, 0), Bt, bcol, t + 2);
        BAR; WAIT_L(0); MMA(0, 1, At, B1); BAR;
        LDA(At, 0, 1); STAGE(SA(0, 0), A, brow, t + 2);
        BAR; WAIT_L(0); MMA(1, 0, At, B0); BAR; SCHED;
        STAGE(SB(0, 1), Bt, bcol + HALF, t + 2);
        WAIT_V(6); BAR; MMA(1, 1, At, B1); BAR;
        LDB(B0, 1, 0); SCHED; LDA(At, 1, 0); STAGE(SA(0, 1), A, brow + HALF, t + 2);
        WAIT_L(8); BAR; WAIT_L(0); MMA(0, 0, At, B0); BAR; SCHED;
        LDB(B1, 1, 1); STAGE(SB(1, 0), Bt, bcol, t + 3);
        BAR; WAIT_L(0); MMA(0, 1, At, B1); BAR;
        LDA(At, 1, 1); STAGE(SA(1, 0), A, brow, t + 3);
        BAR; WAIT_L(0); MMA(1, 0, At, B0); BAR; SCHED;
        STAGE(SB(1, 1), Bt, bcol + HALF, t + 3);
        WAIT_V(6); BAR; MMA(1, 1, At, B1); BAR;
    }
    { LDB(B0, 0, 0); LDA(At, 0, 0); STAGE(SA(1, 1), A, brow + HALF, nt - 1);
      BAR; WAIT_L(0); MMA(0, 0, At, B0); BAR;
      LDB(B1, 0, 1); BAR; WAIT_L(0); MMA(0, 1, At, B1); BAR;
      LDA(At, 0, 1); WAIT_V(4); BAR; WAIT_L(0); MMA(1, 0, At, B0); MMA(1, 1, At, B1); BAR; }
    { LDB(B0, 1, 0); LDA(At, 1, 0); WAIT_V(2); BAR; WAIT_L(0); MMA(0, 0, At, B0); BAR;
      LDB(B1, 1, 1); WAIT_V(0); BAR; WAIT_L(0); MMA(0, 1, At, B1); BAR;
      LDA(At, 1, 1); BAR; WAIT_L(0); MMA(1, 0, At, B0); MMA(1, 1, At, B1); BAR; }
    if (wr == 0) BAR;
}

DI void tile_of(int L, int nM, int nN, int& pm, int& pn) {
    const int nwg = nM * nN; int wgid = L;
    { const int q = nwg / NXCD, r = nwg % NXCD, xcd = wgid % NXCD, off = wgid / NXCD; wgid = (xcd < r ? xcd * (q + 1) : r * (q + 1) + (xcd - r) * q) + off; }
    const int nig = WGM * nN, gid = wgid / nig, fm = gid * WGM, gsz = min(nM - fm, WGM);
    pm = fm + ((wgid % nig) % gsz); pn = (wgid % nig) / gsz;
}

constexpr int CST = 260;
DI void stage_half(const f32x4 (&acc)[2][2][4][2], const int ai) {
    const int tid_ = opaque_tid(), wid = tid_ >> 6, lane = tid_ & 63, wr = wid >> 2, wc = wid & 3, fr = lane & 15, fq = lane >> 4;
    float* base = (float*)dyn_smem + (wr * 64 + fr) * CST + wc * 32 + 4 * fq;
#pragma unroll
    for (int m = 0; m < 4; ++m)
#pragma unroll
        for (int bj = 0; bj < 2; ++bj)
#pragma unroll
            for (int n = 0; n < 2; ++n) *(f32x4*)(base + (m * 16) * CST + bj * 128 + n * 16) = ai == 0 ? acc[0][bj][m][n] : acc[1][bj][m][n];
}
#define CT ((const float*)dyn_smem)

DI void epi_in_half(const Params& p, int pm, int pn, int ai) {
    unsigned char* ws = p.ws;
    const int tid = opaque_tid(), brow = pm * BM + ai * 128, bcol = pn * BM;
    const bool samp = pm == 128;
    if (pn < 8) {
        bf16_t* dst = pn < 6 ? (bf16_t*)(ws + WS_R2) : (bf16_t*)(ws + WS_R3);
        const int ld = pn < 6 ? 1536 : 512, c0 = pn < 6 ? bcol : bcol - 1536;
#pragma unroll 4
        for (int i = 0; i < 8; ++i) {
            const int id = tid + 512 * i, r = id >> 5, c8 = (id & 31) * 8, row = brow + r;
            const f32x4 v = *(const f32x4*)(CT + r * CST + c8), w = *(const f32x4*)(CT + r * CST + c8 + 4);
            *(u32x4*)(dst + (size_t)row * ld + c0 + c8) = (u32x4){pk2(v.x, v.y), pk2(v.z, v.w), pk2(w.x, w.y), pk2(w.z, w.w)};
            if (pn < 6) {
                const int t = row & (TP - 1);
                if (t >= TP - 3) { float* cd = p.out + O_CQP + (size_t)((row >> 13) * 3 + t - (TP - 3)) * 1536 + c0 + c8; *(f32x4*)cd = v; *(f32x4*)(cd + 4) = w; }
            }
        }
        return;
    }
    if (pn < 12) {
        const bool isq = pn < 10;
        const float* rope = (const float*)(ws + WS_ROPE);
        bf16_t* QB = (bf16_t*)(ws + WS_R4); bf16_t* KALL = (bf16_t*)(ws + WS_R5);
        const float qs = 0.125f * 1.4426950408889634f;
        f32x4 rt0[8], rt1[8];
#pragma unroll
        for (int i = 0; i < 8; ++i) {
            const int id = tid + 512 * i, r = id >> 5, q = id & 31, d4 = (q & 7) * 4, row = brow + r;
            const int pos = samp ? PAST + ((row - MP) & 31) : (row & (TP - 1));
            rt0[i] = *(const f32x4*)(rope + (size_t)(pos * 32 + d4) * 2); rt1[i] = *(const f32x4*)(rope + (size_t)(pos * 32 + d4) * 2 + 4);
        }
#pragma unroll
        for (int i = 0; i < 8; ++i) {
            const int id = tid + 512 * i, r = id >> 5, q = id & 31, hl = q >> 4, map = (q >> 3) & 1, d4 = (q & 7) * 4, row = brow + r;
            const int cl = hl * 128 + map * 64 + d4, col = ((pn & 1) * 2 + hl) * 128 + map * 64 + d4;
            const f32x4 x1 = *(const f32x4*)(CT + r * CST + cl), x2 = *(const f32x4*)(CT + r * CST + cl + 32);
            int pos; size_t krow; float* kout;
            if (!samp) { pos = row & (TP - 1); krow = row; kout = p.out + O_KP + (size_t)row * 512; }
            else { const int rr = row - MP; pos = PAST + (rr & 31); krow = (size_t)MP + (size_t)(rr >> 5) * TKS + pos; kout = p.out + O_KS + (size_t)rr * 512; }
            const f32x4 t0 = rt0[i], t1 = rt1[i];
            const f32x4 cs = (f32x4){t0.x, t0.z, t1.x, t1.z}, sn = (f32x4){t0.y, t0.w, t1.y, t1.w};
            const f32x4 y1 = x1 * cs - x2 * sn, y2 = x2 * cs + x1 * sn;
            if (isq) {
                u32x2 o1, o2; o1.x = pk2(y1.x * qs, y1.y * qs); o1.y = pk2(y1.z * qs, y1.w * qs); o2.x = pk2(y2.x * qs, y2.y * qs); o2.y = pk2(y2.z * qs, y2.w * qs);
                *(u32x2*)(QB + (size_t)row * 512 + col) = o1; *(u32x2*)(QB + (size_t)row * 512 + col + 32) = o2;
            } else {
                *(f32x4*)(kout + col) = y1; *(f32x4*)(kout + col + 32) = y2;
                u32x2 o1, o2; o1.x = pk2(y1.x, y1.y); o1.y = pk2(y1.z, y1.w); o2.x = pk2(y2.x, y2.y); o2.y = pk2(y2.z, y2.w);
                *(u32x2*)(KALL + krow * 512 + col) = o1; *(u32x2*)(KALL + krow * 512 + col + 32) = o2;
            }
        }
        return;
    }
    {
        bf16_t* VT = (bf16_t*)(ws + WS_R6);
#pragma unroll 4
        for (int i = 0; i < 16; ++i) {
            const int id = tid + 512 * i, r = id >> 6, c4 = (id & 63) * 4, row = brow + r, col = (pn & 1) * 256 + c4;
            const f32x4 v = *(const f32x4*)(CT + r * CST + c4);
            float* vout = samp ? p.out + O_VS + (size_t)(row - MP) * 512 + col : p.out + O_VP + (size_t)row * 512 + col;
            *(f32x4*)vout = v;
        }
#pragma unroll 1
        for (int i = 0; i < 2; ++i) {
            const int id = tid + 512 * i, rg = id >> 6, c4 = (id & 63) * 4, row0 = brow + rg * 8;
            f32x4 v[8];
#pragma unroll
            for (int e = 0; e < 8; ++e) v[e] = *(const f32x4*)(CT + (rg * 8 + e) * CST + c4);
#pragma unroll
            for (int e = 0; e < 4; ++e) {
                const int colg = (pn & 1) * 256 + c4 + e, head = colg >> 7, dv = colg & 127;
                u32x4 o; o.x = pk2(v[0][e], v[1][e]); o.y = pk2(v[2][e], v[3][e]); o.z = pk2(v[4][e], v[5][e]); o.w = pk2(v[6][e], v[7][e]);
                bf16_t* d;
                if (samp) { const int rr = row0 - MP; d = VT + VT_S_OFF + ((size_t)(((rr >> 5) * 4 + head) * 128 + dv) * TKS + PAST + (rr & 31)); }
                else d = VT + ((size_t)(((row0 >> 13) * 4 + head) * 128 + dv) * TP + (row0 & (TP - 1)));
                *(u32x4*)d = o;
            }
        }
    }
}

template <int WHICH> DI void epi_res_half(const Params& p, int pm, int pn, int ai) {
    const int tid = opaque_tid(), brow = pm * BM + ai * 128, bcol = pn * BM;
    bf16_t* dst = (bf16_t*)(p.ws + (WHICH == 0 ? WS_R1 : WS_R2));
    const bf16_t* X1B = (const bf16_t*)(p.ws + WS_R3);
    f32x4 xa[8], xb[8];
#pragma unroll
    for (int i = 0; i < 8; ++i) {
        const int id = tid + 512 * i, r = id >> 5, c8 = (id & 31) * 8, row = brow + r;
        if (WHICH == 0) { const float* xp = xrow_ptr(p, row) + bcol + c8; xa[i] = *(const f32x4*)xp; xb[i] = *(const f32x4*)(xp + 4); }
        else { const u32x4 q = *(const u32x4*)(X1B + (size_t)row * D + bcol + c8); xa[i] = (f32x4){bflo(q.x), bfhi(q.x), bflo(q.y), bfhi(q.y)}; xb[i] = (f32x4){bflo(q.z), bfhi(q.z), bflo(q.w), bfhi(q.w)}; }
    }
#pragma unroll
    for (int i = 0; i < 8; ++i) {
        const int id = tid + 512 * i, r = id >> 5, c8 = (id & 31) * 8, row = brow + r;
        const f32x4 v = *(const f32x4*)(CT + r * CST + c8), w = *(const f32x4*)(CT + r * CST + c8 + 4);
        const f32x4 o = xa[i] * ALPHA + v, o2 = xb[i] * ALPHA + w;
        *(u32x4*)(dst + (size_t)row * D + bcol + c8) = (u32x4){pk2(o.x, o.y), pk2(o.z, o.w), pk2(o2.x, o2.y), pk2(o2.z, o2.w)};
    }
}

constexpr int UST = 264;
DI void epi_up(const Params& p, const f32x4 (&acc)[2][2][4][2], int pm, int pn) {
    unsigned char* ws = p.ws;
    bf16_t* U = (bf16_t*)dyn_smem;
    float* BND = (float*)(ws + WS_R5);
    const bool samp = pm == 128;
    const int brow = pm * BM, tid = opaque_tid();
    {
        const int wid = tid >> 6, lane = tid & 63, wr = wid >> 2, wc = wid & 3, fr = lane & 15, fq = lane >> 4;
        bf16_t* base = U + (wr * 64 + fr) * UST + wc * 32 + 4 * fq;
#pragma unroll
        for (int ai = 0; ai < 2; ++ai)
#pragma unroll
            for (int m = 0; m < 4; ++m)
#pragma unroll
                for (int bj = 0; bj < 2; ++bj)
#pragma unroll
                    for (int n = 0; n < 2; ++n) {
                        const f32x4 v = acc[ai][bj][m][n];
                        u32x2 q; q.x = pk2(v.x, v.y); q.y = pk2(v.z, v.w);
                        *(u32x2*)(base + (ai * 128 + m * 16) * UST + bj * 128 + n * 16) = q;
                    }
    }
    __syncthreads();
    {
        const int nb = samp ? 32 * 256 : 4 * 256;
        for (int id = tid; id < nb; id += 512) {
            const int cl = id & 255, q = id >> 8;
            const int oc = (cl >> 7) * DFF + 128 * pn + (cl & 127);
            int rr, bslot, u;
            if (!samp) { bslot = q; rr = q < 2 ? q : 252 + q; u = pm; }
            else { bslot = q & 3; rr = (q >> 2) * 32 + (bslot < 2 ? bslot : 28 + bslot); u = 128 + (q >> 2); }
            const float v = bf2f(U[rr * UST + cl]);
            BND[((size_t)u * 4 + bslot) * NUP + oc] = v;
            if (bslot >= 2) {
                if (samp) p.out[O_CFS + (size_t)((q >> 2) * 2 + bslot - 2) * NUP + oc] = v;
                else if ((pm & 31) == 31) p.out[O_CFP + (size_t)((pm >> 5) * 2 + bslot - 2) * NUP + oc] = v;
            }
        }
    }
    {
        const int cq = tid & 31, rs = tid >> 5, c = 4 * cq, cg_ = 128 * pn + c, cv_ = DFF + 128 * pn + c;
        const f32x4 wg0 = *(const f32x4*)(p.ffn_conv_w + cg_), wg1 = *(const f32x4*)(p.ffn_conv_w + NUP + cg_), wg2 = *(const f32x4*)(p.ffn_conv_w + 2 * NUP + cg_), bg = *(const f32x4*)(p.ffn_conv_b + cg_);
        const f32x4 wv0 = *(const f32x4*)(p.ffn_conv_w + cv_), wv1 = *(const f32x4*)(p.ffn_conv_w + NUP + cv_), wv2 = *(const f32x4*)(p.ffn_conv_w + 2 * NUP + cv_), bv = *(const f32x4*)(p.ffn_conv_b + cv_);
        bf16_t* GT = (bf16_t*)(ws + WS_R1);
        const int r0 = rs * 16;
        auto ld4 = [&](int rr, int cc) { const u32x2 q = *(const u32x2*)(U + rr * UST + cc); return (f32x4){bflo(q.x), bfhi(q.x), bflo(q.y), bfhi(q.y)}; };
        const f32x4 z4 = {0.f, 0.f, 0.f, 0.f};
        f32x4 g1 = z4, g2 = z4, v1 = z4, v2 = z4;
        if (r0 >= 2) { g1 = ld4(r0 - 2, c); g2 = ld4(r0 - 1, c); v1 = ld4(r0 - 2, 128 + c); v2 = ld4(r0 - 1, 128 + c); }
#pragma unroll 4
        for (int r = r0; r < r0 + 16; ++r) {
            const f32x4 g3 = ld4(r, c), v3 = ld4(r, 128 + c);
            if (r >= 2) {
                const f32x4 cg2 = wg0 * g1 + wg1 * g2 + wg2 * g3 + bg, cv2 = wv0 * v1 + wv1 * v2 + wv2 * v3 + bv;
                u32x2 q; q.x = pk2(silu(cg2.x) * cv2.x, silu(cg2.y) * cv2.y); q.y = pk2(silu(cg2.z) * cv2.z, silu(cg2.w) * cv2.w);
                *(u32x2*)(GT + (size_t)(brow + r) * DFF + 128 * pn + c) = q;
            }
            g1 = g2; g2 = g3; v1 = v2; v2 = v3;
        }
    }
}

template <int K> DI void skinny_gemm(const bf16_t* __restrict__ A, const bf16_t* __restrict__ Bt, float* __restrict__ C, const int N) {
    const int tid = opaque_tid(), lane = tid & 63, w = __builtin_amdgcn_readfirstlane(tid >> 6), fr = lane & 15, fq = lane >> 4;
    float* red = (float*)dyn_smem;
    constexpr int KW = K / 8, NKS = KW / 32;
    const int ntile = 8 * (N / 32);
    for (int t = blockIdx.x; t < ntile; t += gridDim.x) {
        const int rm = t & 7, cn = t >> 3;
        const bf16_t* ap = A + (size_t)(32 * rm + fr) * K + w * KW + 8 * fq;
        const bf16_t* bp = Bt + (size_t)(32 * cn + fr) * K + w * KW + 8 * fq;
        f32x4 acc[2][2];
#pragma unroll
        for (int i = 0; i < 2; ++i)
#pragma unroll
            for (int j = 0; j < 2; ++j) acc[i][j] = (f32x4){0.f, 0.f, 0.f, 0.f};
#pragma unroll 4
        for (int ks = 0; ks < NKS; ++ks) {
            const bf16x8 a0 = *(const bf16x8*)(ap + ks * 32), a1 = *(const bf16x8*)(ap + (size_t)16 * K + ks * 32);
            const bf16x8 b0 = *(const bf16x8*)(bp + ks * 32), b1 = *(const bf16x8*)(bp + (size_t)16 * K + ks * 32);
            acc[0][0] = __builtin_amdgcn_mfma_f32_16x16x32_bf16(a0, b0, acc[0][0], 0, 0, 0);
            acc[0][1] = __builtin_amdgcn_mfma_f32_16x16x32_bf16(a0, b1, acc[0][1], 0, 0, 0);
            acc[1][0] = __builtin_amdgcn_mfma_f32_16x16x32_bf16(a1, b0, acc[1][0], 0, 0, 0);
            acc[1][1] = __builtin_amdgcn_mfma_f32_16x16x32_bf16(a1, b1, acc[1][1], 0, 0, 0);
        }
        __syncthreads();
#pragma unroll
        for (int i = 0; i < 2; ++i)
#pragma unroll
            for (int j = 0; j < 2; ++j)
#pragma unroll
                for (int e = 0; e < 4; ++e) red[(w * 32 + 16 * i + 4 * fq + e) * 33 + 16 * j + fr] = acc[i][j][e];
        __syncthreads();
#pragma unroll
        for (int o2 = 0; o2 < 2; ++o2) {
            const int o = tid + 512 * o2, r = o >> 5, c = o & 31;
            float sum = 0.f;
#pragma unroll
            for (int ww = 0; ww < 8; ++ww) sum += red[(ww * 32 + r) * 33 + c];
            C[(size_t)(32 * rm + r) * N + 32 * cn + c] = sum;
        }
    }
    __syncthreads();
}

template <int WHICH> DI void gemm_phase(const Params& p) {
    unsigned char* ws = p.ws;
    const bf16_t* A; const bf16_t* Bt; int N; constexpr int K = WHICH == 4 ? DFF : D; float* CS;
    if (WHICH == 1) { A = (const bf16_t*)(ws + WS_R1); Bt = (const bf16_t*)(ws + WS_WIN); N = NH1; CS = (float*)(ws + WS_CS1); }
    else if (WHICH == 2) { A = (const bf16_t*)(ws + WS_R2); Bt = (const bf16_t*)(ws + WS_WO); N = D; CS = (float*)(ws + WS_CS2); }
    else if (WHICH == 3) { A = (const bf16_t*)(ws + WS_R3); Bt = (const bf16_t*)(ws + WS_WUP); N = NUP; CS = (float*)(ws + WS_CS3); }
    else { A = (const bf16_t*)(ws + WS_R1); Bt = (const bf16_t*)(ws + WS_WDN); N = D; CS = (float*)(ws + WS_CS4); }
    skinny_gemm<K>(A + (size_t)MP * K, Bt, CS, N);
    const int nM = MP / BM, nN = N / BM, ntile = nM * nN;
    for (int L0 = blockIdx.x; L0 < ntile * (WHICH == GREP_WHICH ? 2 : 1); L0 += gridDim.x) {
        const int L = L0 % ntile;
        int pm, pn; tile_of(L, nM, nN, pm, pn);
        f32x4 acc[2][2][4][2];
        gemm_tile<K>(A, Bt, pm * BM, pn * BM, acc);
        if (WHICH == 3) epi_up(p, acc, pm, pn);
        else {
#pragma unroll
            for (int ai = 0; ai < 2; ++ai) {
                stage_half(acc, ai);
                __syncthreads();
                if (WHICH == 1) epi_in_half(p, pm, pn, ai);
                else if (WHICH == 2) epi_res_half<0>(p, pm, pn, ai);
                else epi_res_half<1>(p, pm, pn, ai);
                __syncthreads();
            }
        }
        __syncthreads();
    }
}

template <int WHICH> DI void ln_phase(const Params& p) {
    const int lane = threadIdx.x & 63, wave = threadIdx.x >> 6;
    const float* g = WHICH == 0 ? p.ln1_g : p.ln2_g; const float* b = WHICH == 0 ? p.ln1_b : p.ln2_b;
    bf16_t* X1B = (bf16_t*)(p.ws + WS_R3);
    const bf16_t* PRE = (const bf16_t*)(p.ws + (WHICH == 0 ? WS_R1 : WS_R2));
    f32x4 gv[4], bv[4];
#pragma unroll
    for (int j = 0; j < 4; ++j) { gv[j] = *(const f32x4*)(g + lane * 4 + 256 * j); bv[j] = *(const f32x4*)(b + lane * 4 + 256 * j); }
    auto ld_row = [&](int row, f32x4 (&v)[4]) {
        if (row < MP) {
#pragma unroll
            for (int j = 0; j < 4; ++j) { const u32x2 q = *(const u32x2*)(PRE + (size_t)row * D + lane * 4 + 256 * j); v[j] = (f32x4){bflo(q.x), bfhi(q.x), bflo(q.y), bfhi(q.y)}; }
        } else {
            const float* cs = (const float*)(p.ws + (WHICH == 0 ? WS_CS2 : WS_CS4)) + (size_t)(row - MP) * D;
#pragma unroll
            for (int j = 0; j < 4; ++j) {
                f32x4 rs;
                if (WHICH == 0) rs = *(const f32x4*)(p.x_s + (size_t)(row - MP) * D + lane * 4 + 256 * j);
                else { const u32x2 q = *(const u32x2*)(X1B + (size_t)row * D + lane * 4 + 256 * j); rs = (f32x4){bflo(q.x), bfhi(q.x), bflo(q.y), bfhi(q.y)}; }
                v[j] = rs * ALPHA + *(const f32x4*)(cs + lane * 4 + 256 * j);
            }
        }
    };
    f32x4 v[4];
    if (blockIdx.x * 8 + wave < M) ld_row(blockIdx.x * 8 + wave, v);
    for (int row = blockIdx.x * 8 + wave; row < M; row += gridDim.x * 8) {
        f32x4 vn[4];
        const bool more = row + (int)gridDim.x * 8 < M;
        if (more) ld_row(row + gridDim.x * 8, vn);
        float s = 0.f;
#pragma unroll
        for (int j = 0; j < 4; ++j) s += (v[j].x + v[j].y) + (v[j].z + v[j].w);
        const float mean = wave_sum(s) * (1.f / D); float s2 = 0.f;
#pragma unroll
        for (int j = 0; j < 4; ++j) { v[j] = v[j] - mean; s2 += (v[j].x * v[j].x + v[j].y * v[j].y) + (v[j].z * v[j].z + v[j].w * v[j].w); }
        const float rstd = rsqrtf(wave_sum(s2) * (1.f / D) + 1e-5f);
#pragma unroll
        for (int j = 0; j < 4; ++j) {
            const f32x4 o = v[j] * rstd * gv[j] + bv[j];
            if (WHICH == 0) { u32x2 q; q.x = pk2(o.x, o.y); q.y = pk2(o.z, o.w); *(u32x2*)(X1B + (size_t)row * D + lane * 4 + 256 * j) = q; }
            else *(f32x4*)(p.out + O_Y + (size_t)row * D + lane * 4 + 256 * j) = o;
        }
        if (more) {
#pragma unroll
            for (int j = 0; j < 4; ++j) v[j] = vn[j];
        }
    }
}

DI void fixup_phase(const Params& p) {
    const float* BND = (const float*)(p.ws + WS_R5);
    bf16_t* GT = (bf16_t*)(p.ws + WS_R1);
    {
        const float* CS3 = (const float*)(p.ws + WS_CS3);
        for (int idx = blockIdx.x * 512 + threadIdx.x; idx < MS * DFF; idx += gridDim.x * 512) {
            const int c = idx % DFF, r = idx / DFF, b = r >> 5, t = r & 31, ng = (c >> 7) * 256 + (c & 127), nv = ng + 128;
            float g[3], v[3];
#pragma unroll
            for (int k = 0; k < 3; ++k) {
                const int tt = t - 2 + k;
                if (tt >= 0) { g[k] = CS3[(size_t)(b * 32 + tt) * NUP + ng]; v[k] = CS3[(size_t)(b * 32 + tt) * NUP + nv]; }
                else { g[k] = p.state_cf[(size_t)(b * 2 + 2 + tt) * NUP + c]; v[k] = p.state_cf[(size_t)(b * 2 + 2 + tt) * NUP + DFF + c]; }
            }
            const float cg2 = p.ffn_conv_w[c] * g[0] + p.ffn_conv_w[NUP + c] * g[1] + p.ffn_conv_w[2 * NUP + c] * g[2] + p.ffn_conv_b[c];
            const float cv2 = p.ffn_conv_w[DFF + c] * v[0] + p.ffn_conv_w[NUP + DFF + c] * v[1] + p.ffn_conv_w[2 * NUP + DFF + c] * v[2] + p.ffn_conv_b[DFF + c];
            GT[((size_t)MP + r) * DFF + c] = f2bf(silu(cg2) * cv2);
            if (t >= 30) { p.out[O_CFS + (size_t)(b * 2 + t - 30) * NUP + c] = g[2]; p.out[O_CFS + (size_t)(b * 2 + t - 30) * NUP + DFF + c] = v[2]; }
        }
    }
    const int total = 128 * 2 * DFF;
    for (int idx = blockIdx.x * 512 + threadIdx.x; idx < total; idx += gridDim.x * 512) {
        const int c = idx % DFF, q = idx / DFF, r = q & 1, u = q >> 1;
        const float* cur = BND + (size_t)u * 4 * NUP;
        float pg[2], pv[2];
        if (u < 128) {
            if ((u & 31) == 0) { pg[0] = pg[1] = pv[0] = pv[1] = 0.f; }
            else { const float* pr = BND + (size_t)(u - 1) * 4 * NUP; pg[0] = pr[2 * NUP + c]; pg[1] = pr[3 * NUP + c]; pv[0] = pr[2 * NUP + DFF + c]; pv[1] = pr[3 * NUP + DFF + c]; }
        } else { const float* st = p.state_cf + (size_t)(u - 128) * 2 * NUP; pg[0] = st[c]; pg[1] = st[NUP + c]; pv[0] = st[DFF + c]; pv[1] = st[NUP + DFF + c]; }
        const float cg0 = cur[c], cg1 = cur[NUP + c], cv0 = cur[DFF + c], cv1 = cur[NUP + DFF + c];
        const float wg0 = p.ffn_conv_w[c], wg1 = p.ffn_conv_w[NUP + c], wg2 = p.ffn_conv_w[2 * NUP + c], bg = p.ffn_conv_b[c];
        const float wv0 = p.ffn_conv_w[DFF + c], wv1 = p.ffn_conv_w[NUP + DFF + c], wv2 = p.ffn_conv_w[2 * NUP + DFF + c], bv = p.ffn_conv_b[DFF + c];
        float g, v;
        if (r == 0) { g = wg0 * pg[0] + wg1 * pg[1] + wg2 * cg0 + bg; v = wv0 * pv[0] + wv1 * pv[1] + wv2 * cv0 + bv; }
        else { g = wg0 * pg[1] + wg1 * cg0 + wg2 * cg1 + bg; v = wv0 * pv[1] + wv1 * cv0 + wv2 * cv1 + bv; }
        const size_t row = u < 128 ? (size_t)u * 256 + r : (size_t)MP + (size_t)(u - 128) * 32 + r;
        GT[row * DFF + c] = f2bf(silu(g) * v);
    }
}

#define MFMA16(a, b, c) __builtin_amdgcn_mfma_f32_16x16x32_bf16((a), (b), (c), 0, 0, 0)
#define MFMA32(a, b, c) __builtin_amdgcn_mfma_f32_32x32x16_bf16((a), (b), (c), 0, 0, 0)
DI bf16x8 pack8(const f32x4 a, const f32x4 b) { u32x4 o; o.x = pk2(a.x, a.y); o.y = pk2(a.z, a.w); o.z = pk2(b.x, b.y); o.w = pk2(b.z, b.w); return __builtin_bit_cast(bf16x8, o); }
constexpr float GSCALE = 0.08838834764831845f;
constexpr int QST = 132, AST = 68, NST = 136, QKST = 72;
constexpr int L_QKV = 0, L_AM = 3 * 64 * QST * 4, L_KN = L_AM + 64 * AST * 4, L_QN = L_KN + 64 * NST * 2, L_GC = L_QN + 64 * NST * 2;
constexpr int L_QKS = 0, L_WS = 64 * QKST * 2;
static_assert(L_GC + 1024 <= LDS_BYTES, "gdn prep LDS");

DI void gdn_conv_weights(const Params& p, const int h, float (&cw)[3][4]) {
#pragma unroll
    for (int k = 0; k < 3; ++k) {
        const int task = threadIdx.x + 512 * k, col = task % 384, part = col >> 7, cc = col & 127, gcol = part * 512 + h * 128 + cc;
#pragma unroll
        for (int j = 0; j < 4; ++j) cw[k][j] = p.gdn_conv_w[j * 1536 + gcol];
    }
}
DI void gdn_prep_item(const Params& p, const int item, const float (&cw)[3][4]) {
    unsigned char* ws = p.ws;
    float* QKVf = (float*)(dyn_smem + L_QKV); float* AM = (float*)(dyn_smem + L_AM);
    bf16_t* KN = (bf16_t*)(dyn_smem + L_KN); bf16_t* QN = (bf16_t*)(dyn_smem + L_QN);
    float* GC = (float*)(dyn_smem + L_GC); float* BETA = GC + 64; float* EG = GC + 128; float* ED = GC + 192;
    bf16_t* QKS = (bf16_t*)(dyn_smem + L_QKS); bf16_t* WSI = (bf16_t*)(dyn_smem + L_WS);
    const bf16_t* HQKV = (const bf16_t*)(ws + WS_R2);
    const float* AB = (const float*)(ws + WS_AB);
    float* DL = (float*)(ws + WS_DL);
        const int tid = opaque_tid(), lane = tid & 63, wave = __builtin_amdgcn_readfirstlane(tid >> 6), fr = lane & 15, fq = lane >> 4;
        int h, b, c, row0, valid; bool samp;
        if (item < 2048) { h = item & 3; c = (item >> 2) & 127; b = item >> 9; row0 = b * TP + c * 64; valid = 64; samp = false; }
        else { const int j = item - 2048; h = j & 3; b = j >> 2; c = 0; row0 = MP + b * TS; valid = TS; samp = true; }
        unsigned char* ip = ws + WS_R1 + (size_t)item * ITEM_B;
        __syncthreads();
        {
            bf16_t* RAW = (bf16_t*)(dyn_smem + L_AM);
#pragma unroll
            for (int i = 0; i < 7; ++i) {
                const int id = tid + 512 * i;
                if (id < 67 * 48) {
                    const int rw = id / 48, ch = id % 48, part = ch >> 4, c8 = (ch & 15) * 8, gcol = part * 512 + h * 128 + c8, t = rw - 3;
                    u32x4 v = (u32x4){0u, 0u, 0u, 0u};
                    if (t >= 0) {
                        if (t < valid) {
                            if (!samp) v = *(const u32x4*)(HQKV + (size_t)(row0 + t) * 1536 + gcol);
                            else { const float* sp = (const float*)(ws + WS_CS1) + (size_t)(row0 - MP + t) * NH1 + gcol; const f32x4 f0 = *(const f32x4*)sp, f1 = *(const f32x4*)(sp + 4);
                                   v.x = pk2(f0.x, f0.y); v.y = pk2(f0.z, f0.w); v.z = pk2(f1.x, f1.y); v.w = pk2(f1.z, f1.w); }
                        }
                    }
                    else if (samp) { const float* sp = p.state_cq + (size_t)(b * 3 + 3 + t) * 1536 + gcol; const f32x4 f0 = *(const f32x4*)sp, f1 = *(const f32x4*)(sp + 4);
                                     v.x = pk2(f0.x, f0.y); v.y = pk2(f0.z, f0.w); v.z = pk2(f1.x, f1.y); v.w = pk2(f1.z, f1.w); }
                    else if (c != 0) v = *(const u32x4*)(HQKV + (size_t)(row0 + t) * 1536 + gcol);
                    *(u32x4*)(RAW + rw * 384 + ch * 8) = v;
                }
            }
            __syncthreads();
#pragma unroll
            for (int k3 = 0; k3 < 3; ++k3) {
                const int task = tid + 512 * k3;
                const int col = task % 384, seg = task / 384, part = col >> 7, cc = col & 127, t0 = seg * 16;
                const float w0 = cw[k3][0], w1 = cw[k3][1], w2 = cw[k3][2], w3 = cw[k3][3];
                float x0 = bf2f(RAW[(t0) * 384 + col]), x1 = bf2f(RAW[(t0 + 1) * 384 + col]), x2 = bf2f(RAW[(t0 + 2) * 384 + col]);
#pragma unroll
                for (int t = t0; t < t0 + 16; ++t) {
                    const float xv = bf2f(RAW[(t + 3) * 384 + col]);
                    const float y = w0 * x0 + w1 * x1 + w2 * x2 + w3 * xv;
                    QKVf[(part * 64 + t) * QST + cc] = t < valid ? silu(y) : 0.f;
                    x0 = x1; x1 = x2; x2 = xv;
                }
            }
        }
        if (tid < 64) {
            float g = 0.f, be = 0.f;
            if (tid < valid) {
                const float a = AB[(size_t)(row0 + tid) * 8 + h] + p.dt_bias[h], bb = AB[(size_t)(row0 + tid) * 8 + 4 + h];
                const float sp = a > 20.f ? a : log1pf(expf(a));
                g = -expf(p.a_log[h]) * sp; be = 1.f / (1.f + expf(-bb));
            }
            float gc = g;
#pragma unroll
            for (int o = 1; o < 64; o <<= 1) { const float n = __shfl_up(gc, o); if (lane >= o) gc += n; }
            const float gl = __shfl(gc, 63);
            GC[tid] = gc; BETA[tid] = be; EG[tid] = expf(gc); ED[tid] = expf(gl - gc);
            if (tid == 0) DL[item] = expf(gl);
        }
        __syncthreads();
        {
            const int row = tid >> 3, pt = tid & 7;
            float q[16], k[16]; float sq = 0.f, sk = 0.f;
#pragma unroll
            for (int e4 = 0; e4 < 4; ++e4) {
                const f32x4 a = *(const f32x4*)(QKVf + row * QST + 16 * pt + 4 * e4), bq = *(const f32x4*)(QKVf + (64 + row) * QST + 16 * pt + 4 * e4);
#pragma unroll
                for (int e = 0; e < 4; ++e) { q[4 * e4 + e] = a[e]; k[4 * e4 + e] = bq[e]; sq += a[e] * a[e]; sk += bq[e] * bq[e]; }
            }
#pragma unroll
            for (int o = 1; o < 8; o <<= 1) { sq += __shfl_xor(sq, o); sk += __shfl_xor(sk, o); }
            const float rq = rsqrtf(sq + 1e-6f), rk = rsqrtf(sk + 1e-6f), qg = rq * GSCALE * EG[row];
            u32x4 o0, o1;
            o0.x = pk2(q[0] * rq, q[1] * rq); o0.y = pk2(q[2] * rq, q[3] * rq); o0.z = pk2(q[4] * rq, q[5] * rq); o0.w = pk2(q[6] * rq, q[7] * rq);
            o1.x = pk2(q[8] * rq, q[9] * rq); o1.y = pk2(q[10] * rq, q[11] * rq); o1.z = pk2(q[12] * rq, q[13] * rq); o1.w = pk2(q[14] * rq, q[15] * rq);
            *(u32x4*)(QN + row * NST + 16 * pt) = o0; *(u32x4*)(QN + row * NST + 16 * pt + 8) = o1;
            o0.x = pk2(k[0] * rk, k[1] * rk); o0.y = pk2(k[2] * rk, k[3] * rk); o0.z = pk2(k[4] * rk, k[5] * rk); o0.w = pk2(k[6] * rk, k[7] * rk);
            o1.x = pk2(k[8] * rk, k[9] * rk); o1.y = pk2(k[10] * rk, k[11] * rk); o1.z = pk2(k[12] * rk, k[13] * rk); o1.w = pk2(k[14] * rk, k[15] * rk);
            *(u32x4*)(KN + row * NST + 16 * pt) = o0; *(u32x4*)(KN + row * NST + 16 * pt + 8) = o1;
#pragma unroll
            for (int e4 = 0; e4 < 4; ++e4) *(f32x4*)(QKVf + (64 + row) * QST + 16 * pt + 4 * e4) = (f32x4){k[4 * e4] * rk, k[4 * e4 + 1] * rk, k[4 * e4 + 2] * rk, k[4 * e4 + 3] * rk};
            bf16_t* QGf = (bf16_t*)(ip + 16384);
            const int rt = row >> 4, frr = row & 15, ks = pt >> 1;
#pragma unroll
            for (int f = 0; f < 4; ++f) {
                u32x2 o; o.x = pk2(q[4 * f] * qg, q[4 * f + 1] * qg); o.y = pk2(q[4 * f + 2] * qg, q[4 * f + 3] * qg);
                *(u32x2*)(QGf + (size_t)(((rt * 4 + ks) * 64 + f * 16 + frr) * 8 + 4 * (pt & 1))) = o;
            }
        }
        __syncthreads();
        {
            const bool isq = wave >= 4; const int ti = wave & 3;
            const bf16_t* As = isq ? QN : KN;
#pragma unroll
            for (int tj = 0; tj < 4; ++tj) {
                f32x4 acc = (f32x4){0.f, 0.f, 0.f, 0.f};
#pragma unroll
                for (int ks = 0; ks < 4; ++ks) {
                    const bf16x8 a = *(const bf16x8*)(As + (16 * ti + fr) * NST + 32 * ks + 8 * fq), bb = *(const bf16x8*)(KN + (16 * tj + fr) * NST + 32 * ks + 8 * fq);
                    acc = MFMA16(a, bb, acc);
                }
                const int jj = 16 * tj + fr; const float gj = GC[jj];
#pragma unroll
                for (int j = 0; j < 4; ++j) {
                    const int i = 16 * ti + 4 * fq + j;
                    const float dec = i >= jj ? expf(GC[i] - gj) : 0.f;
                    if (!isq) AM[i * AST + jj] = i > jj ? BETA[i] * acc[j] * dec : 0.f;
                    else QKS[i * QKST + jj] = f2bf(GSCALE * acc[j] * dec);
                }
            }
            bf16_t* KDTf = (bf16_t*)(ip + 32768);
#pragma unroll
            for (int i2 = 0; i2 < 2; ++i2) {
                const int f = tid + 512 * i2, ln = f & 63, ks2 = (f >> 6) & 1, dt = f >> 7, fq_ = ln >> 4, dk = 16 * dt + (ln & 15);
                float v[8];
#pragma unroll
                for (int e = 0; e < 8; ++e) { const int i = 32 * ks2 + 16 * (e >> 2) + 4 * fq_ + (e & 3); v[e] = bf2f(KN[i * NST + dk]) * ED[i]; }
                u32x4 o; o.x = pk2(v[0], v[1]); o.y = pk2(v[2], v[3]); o.z = pk2(v[4], v[5]); o.w = pk2(v[6], v[7]);
                *(u32x4*)(KDTf + (size_t)f * 8) = o;
            }
        }
        __syncthreads();
        {
            float* TM = (float*)(dyn_smem + L_QN);
            float* TMP = (float*)(dyn_smem + L_KN);
#pragma unroll
            for (int i = 0; i < 9; ++i) { const int id = tid + 512 * i; if (id < 64 * AST) TM[id] = 0.f; }
            __syncthreads();
            if (tid < 64) {
                const int d = tid >> 4, c = tid & 15;
                float y[16];
#pragma unroll
                for (int r = 0; r < 16; ++r) {
                    float sacc = r == c ? 1.f : 0.f;
                    const float* ar = AM + (16 * d + r) * AST + 16 * d;
#pragma unroll
                    for (int j = 0; j < r; ++j) sacc -= ar[j] * y[j];
                    y[r] = sacc;
                    TM[(16 * d + r) * AST + 16 * d + c] = sacc;
                }
            }
            __syncthreads();
            {
                const int blk = tid >> 8, r = (tid >> 4) & 15, c = tid & 15, rb = blk ? 3 : 1, cb = rb - 1;
                float t = 0.f;
#pragma unroll
                for (int j = 0; j < 16; ++j) t += AM[(16 * rb + r) * AST + 16 * cb + j] * TM[(16 * cb + j) * AST + 16 * cb + c];
                TMP[blk * 272 + r * 17 + c] = t;
                __syncthreads();
                float o = 0.f;
#pragma unroll
                for (int k = 0; k < 16; ++k) o -= TM[(16 * rb + r) * AST + 16 * rb + k] * TMP[blk * 272 + k * 17 + c];
                __syncthreads();
                TM[(16 * rb + r) * AST + 16 * cb + c] = o;
            }
            __syncthreads();
            {
                float t[2];
#pragma unroll
                for (int i2 = 0; i2 < 2; ++i2) {
                    const int o = tid + 512 * i2, r = o >> 5, c = o & 31;
                    float acc = 0.f;
#pragma unroll
                    for (int j = 0; j < 32; ++j) acc += AM[(32 + r) * AST + j] * TM[j * AST + c];
                    t[i2] = acc;
                }
#pragma unroll
                for (int i2 = 0; i2 < 2; ++i2) { const int o = tid + 512 * i2; TMP[(o >> 5) * 33 + (o & 31)] = t[i2]; }
                __syncthreads();
#pragma unroll
                for (int i2 = 0; i2 < 2; ++i2) {
                    const int o = tid + 512 * i2, r = o >> 5, c = o & 31;
                    float acc = 0.f;
#pragma unroll
                    for (int k = 0; k < 32; ++k) acc -= TM[(32 + r) * AST + 32 + k] * TMP[k * 33 + c];
                    t[i2] = acc;
                }
#pragma unroll
                for (int i2 = 0; i2 < 2; ++i2) { const int o = tid + 512 * i2; TM[(32 + (o >> 5)) * AST + (o & 31)] = t[i2]; }
            }
            __syncthreads();
            {
                bf16x8 Ah[4][2], Al[4][2];
#pragma unroll
                for (int rt = 0; rt < 4; ++rt)
#pragma unroll
                    for (int ks = 0; ks < 2; ++ks) {
                        const f32x4 a0 = *(const f32x4*)(TM + (16 * rt + fr) * AST + 32 * ks + 8 * fq), a1 = *(const f32x4*)(TM + (16 * rt + fr) * AST + 32 * ks + 8 * fq + 4);
                        u32x4 hq; hq.x = pk2(a0.x, a0.y); hq.y = pk2(a0.z, a0.w); hq.z = pk2(a1.x, a1.y); hq.w = pk2(a1.z, a1.w);
                        u32x4 lq; lq.x = pk2(a0.x - bflo(hq.x), a0.y - bfhi(hq.x)); lq.y = pk2(a0.z - bflo(hq.y), a0.w - bfhi(hq.y));
                        lq.z = pk2(a1.x - bflo(hq.z), a1.y - bfhi(hq.z)); lq.w = pk2(a1.z - bflo(hq.w), a1.w - bfhi(hq.w));
                        Ah[rt][ks] = __builtin_bit_cast(bf16x8, hq); Al[rt][ks] = __builtin_bit_cast(bf16x8, lq);
                    }
                const bool isw = wave >= 4;
                f32x4 xacc[2][4];
#pragma unroll
                for (int q = 0; q < 2; ++q)
#pragma unroll
                    for (int rt = 0; rt < 4; ++rt) xacc[q][rt] = (f32x4){0.f, 0.f, 0.f, 0.f};
#pragma unroll
                for (int ks = 0; ks < 2; ++ks) {
                    float sc8[8];
                    {
                        const f32x4 b0 = *(const f32x4*)(BETA + 32 * ks + 8 * fq), b1 = *(const f32x4*)(BETA + 32 * ks + 8 * fq + 4);
                        const f32x4 e0 = *(const f32x4*)(EG + 32 * ks + 8 * fq), e1 = *(const f32x4*)(EG + 32 * ks + 8 * fq + 4);
#pragma unroll
                        for (int e = 0; e < 4; ++e) { sc8[e] = isw ? b0[e] * e0[e] : b0[e]; sc8[4 + e] = isw ? b1[e] * e1[e] : b1[e]; }
                    }
#pragma unroll
                    for (int q = 0; q < 2; ++q) {
                        const int cc = ((2 * wave + q) & 7) * 16 + fr;
                        const float* src = QKVf + ((isw ? 64 : 128) + 32 * ks + 8 * fq) * QST + cc;
                        float v[8];
#pragma unroll
                        for (int e = 0; e < 8; ++e) v[e] = src[e * QST] * sc8[e];
                        u32x4 hq; hq.x = pk2(v[0], v[1]); hq.y = pk2(v[2], v[3]); hq.z = pk2(v[4], v[5]); hq.w = pk2(v[6], v[7]);
                        u32x4 lq; lq.x = pk2(v[0] - bflo(hq.x), v[1] - bfhi(hq.x)); lq.y = pk2(v[2] - bflo(hq.y), v[3] - bfhi(hq.y));
                        lq.z = pk2(v[4] - bflo(hq.z), v[5] - bfhi(hq.z)); lq.w = pk2(v[6] - bflo(hq.w), v[7] - bfhi(hq.w));
                        const bf16x8 Bh = __builtin_bit_cast(bf16x8, hq), Bl = __builtin_bit_cast(bf16x8, lq);
#pragma unroll
                        for (int rt = 0; rt < 4; ++rt) {
                            xacc[q][rt] = MFMA16(Ah[rt][ks], Bh, xacc[q][rt]);
                            xacc[q][rt] = MFMA16(Al[rt][ks], Bh, xacc[q][rt]);
                            xacc[q][rt] = MFMA16(Ah[rt][ks], Bl, xacc[q][rt]);
                        }
                    }
                }
                if (!isw) {
                    float* Uc = (float*)(ip + 57344);
#pragma unroll
                    for (int q = 0; q < 2; ++q)
#pragma unroll
                        for (int rt = 0; rt < 4; ++rt) *(f32x4*)(Uc + (size_t)((((2 * wave + q) * 4 + rt) * 64 + lane) * 4)) = xacc[q][rt];
                } else {
#pragma unroll
                    for (int q = 0; q < 2; ++q)
#pragma unroll
                        for (int rt = 0; rt < 4; ++rt)
#pragma unroll
                            for (int j = 0; j < 4; ++j) WSI[(16 * rt + 4 * fq + j) * NST + ((2 * wave + q) & 7) * 16 + fr] = f2bf(xacc[q][rt][j]);
                }
            }
        }
        __syncthreads();
        {
            bf16_t* Wf = (bf16_t*)ip; bf16_t* QKf = (bf16_t*)(ip + 49152);
#pragma unroll
            for (int i2 = 0; i2 < 2; ++i2) {
                const int f = tid + 512 * i2, ln = f & 63, ks = (f >> 6) & 3, rt = f >> 8, i = 16 * rt + (ln & 15), fq_ = ln >> 4;
                const u32x2 lo = *(const u32x2*)(WSI + i * NST + 32 * ks + 4 * fq_), hi = *(const u32x2*)(WSI + i * NST + 32 * ks + 16 + 4 * fq_);
                *(u32x4*)(Wf + (size_t)f * 8) = (u32x4){lo.x, lo.y, hi.x, hi.y};
            }
            {
                const int f = tid, ln = f & 63, ks2 = (f >> 6) & 1, rt = f >> 7, i = 16 * rt + (ln & 15), fq_ = ln >> 4;
                const u32x2 lo = *(const u32x2*)(QKS + i * QKST + 32 * ks2 + 4 * fq_), hi = *(const u32x2*)(QKS + i * QKST + 32 * ks2 + 16 + 4 * fq_);
                *(u32x4*)(QKf + (size_t)f * 8) = (u32x4){lo.x, lo.y, hi.x, hi.y};
            }
        }
    __syncthreads();
}

DI void gdn_prep_phase(const Params& p) {
    unsigned char* ws = p.ws;
    for (int r = blockIdx.x; r < MS; r += gridDim.x) {
        const int tid = opaque_tid(), b = r >> 5, t = r & 31, pos = PAST + t;
        const float* cs = (const float*)(ws + WS_CS1) + (size_t)r * NH1;
        if (t >= TS - 3) { for (int c = tid; c < 1536; c += 512) p.out[O_CQS + (size_t)(b * 3 + t - (TS - 3)) * 1536 + c] = cs[c]; }
        {
            const int which = tid >> 8, pr = tid & 255, hd = pr >> 6, mp = (pr >> 5) & 1, d = pr & 31, col = hd * 128 + mp * 64 + d;
            const float2 csn = ((const float2*)(ws + WS_ROPE))[pos * 32 + d];
            const float x1 = cs[2048 + which * 512 + col], x2 = cs[2048 + which * 512 + col + 32];
            const float y1 = x1 * csn.x - x2 * csn.y, y2 = x2 * csn.x + x1 * csn.y;
            if (which == 0) { const float qs = 0.125f * 1.4426950408889634f; bf16_t* QB = (bf16_t*)(ws + WS_R4) + ((size_t)MP + r) * 512; QB[col] = f2bf(y1 * qs); QB[col + 32] = f2bf(y2 * qs); }
            else { float* ko = p.out + O_KS + (size_t)r * 512; ko[col] = y1; ko[col + 32] = y2;
                   bf16_t* kk = (bf16_t*)(ws + WS_R5) + ((size_t)MP + (size_t)b * TKS + pos) * 512; kk[col] = f2bf(y1); kk[col + 32] = f2bf(y2); }
        }
        {
            const float vv = cs[3072 + tid];
            p.out[O_VS + (size_t)r * 512 + tid] = vv;
            ((bf16_t*)(ws + WS_R6))[VT_S_OFF + ((size_t)((b * 4 + (tid >> 7)) * 128 + (tid & 127)) * TKS + pos)] = f2bf(vv);
        }
    }
    float cw[3][4];
    gdn_conv_weights(p, blockIdx.x & 3, cw);
    {
        const int when = blockIdx.x & 7; int k = 0;
#pragma unroll 1
        for (int item = blockIdx.x; item < 2048; item += gridDim.x, ++k) { if (k == when) prep_stream(p); gdn_prep_item(p, item, cw); }
    }
}

constexpr int OPB_B = 57344, L_OBUF = 2 * OPB_B, OST = 132;
static_assert(L_OBUF + 64 * OST * 4 <= LDS_BYTES, "scan LDS");
DI void gdn_scan(const Params& p, const bool samp, const int b, const int h) {
    unsigned char* ws = p.ws;
    const int tid = threadIdx.x, lane = tid & 63, w = __builtin_amdgcn_readfirstlane(tid >> 6), fr = lane & 15, fq = lane >> 4;
    const int nsteps = samp ? 1 : 128, valid = samp ? TS : 64;
    float* OBUF = (float*)(dyn_smem + L_OBUF);
    const bf16_t* HG = (const bf16_t*)(ws + WS_R3);
    bf16_t* OMIX = (bf16_t*)(ws + WS_R2);
    const float* DL = (const float*)(ws + WS_DL);
    f32x4 S[8];
#pragma unroll
    for (int dt = 0; dt < 8; ++dt) {
        if (samp) {
#pragma unroll
            for (int j = 0; j < 4; ++j) S[dt][j] = p.state_gdn[((size_t)(b * 4 + h) * 128 + 16 * dt + 4 * fq + j) * 128 + 16 * w + fr];
        } else S[dt] = (f32x4){0.f, 0.f, 0.f, 0.f};
    }
    const int item0 = samp ? 2048 + b * 4 + h : b * 512 + h;
    __syncthreads();
    {
        const unsigned char* ip = ws + WS_R1 + (size_t)item0 * ITEM_B;
#pragma unroll
        for (int i = 0; i < 7; ++i) *(u32x4*)(dyn_smem + (tid + 512 * i) * 16) = *(const u32x4*)(ip + (tid + 512 * i) * 16);
    }
    __syncthreads();
    const int erow = tid >> 3, ept = tid & 7;
    float nw[16];
#pragma unroll
    for (int e = 0; e < 16; ++e) nw[e] = p.gdn_norm_w[16 * ept + e];
    f32x4 U[4]; float dl; u32x4 g0, g1;
    auto side_load = [&](int c, f32x4 (&Uo)[4], float& dlo, u32x4& go0, u32x4& go1) {
        const int item = item0 + 4 * c;
        const float* Uc = (const float*)(ws + WS_R1 + (size_t)item * ITEM_B + 57344);
#pragma unroll
        for (int rt = 0; rt < 4; ++rt) Uo[rt] = *(const f32x4*)(Uc + ((w * 4 + rt) * 64 + lane) * 4);
        dlo = DL[item];
        const size_t grow = (samp ? (size_t)MP + b * TS : (size_t)b * TP + (size_t)c * 64) + erow;
        if (!samp) { go0 = *(const u32x4*)(HG + grow * 512 + h * 128 + 16 * ept); go1 = *(const u32x4*)(HG + grow * 512 + h * 128 + 16 * ept + 8); }
        else if (erow < TS) { const float* gp = (const float*)(ws + WS_CS1) + (grow - MP) * NH1 + 1536 + h * 128 + 16 * ept;
               const f32x4 f0 = *(const f32x4*)gp, f1 = *(const f32x4*)(gp + 4), f2 = *(const f32x4*)(gp + 8), f3 = *(const f32x4*)(gp + 12);
               go0 = (u32x4){pk2(f0.x, f0.y), pk2(f0.z, f0.w), pk2(f1.x, f1.y), pk2(f1.z, f1.w)}; go1 = (u32x4){pk2(f2.x, f2.y), pk2(f2.z, f2.w), pk2(f3.x, f3.y), pk2(f3.z, f3.w)}; }
        else { go0 = (u32x4){0u, 0u, 0u, 0u}; go1 = go0; }
    };
    side_load(0, U, dl, g0, g1);
#pragma unroll 1
    for (int c = 0; c < nsteps; ++c) {
        const int item = item0 + 4 * c;
        const unsigned char* ip = ws + WS_R1 + (size_t)item * ITEM_B;
        const bool nxt = c + 1 < nsteps;
        u32x4 pf[7];
        f32x4 Un[4]; float dln = 0.f; u32x4 gn0 = g0, gn1 = g1;
        if (nxt) {
#pragma unroll
            for (int i = 0; i < 7; ++i) pf[i] = *(const u32x4*)(ip + 4 * (size_t)ITEM_B + (tid + 512 * i) * 16);
            side_load(c + 1, Un, dln, gn0, gn1);
        }
        const unsigned char* buf = dyn_smem + (c & 1) * OPB_B;
        bf16x8 Sb[4];
#pragma unroll
        for (int ks = 0; ks < 4; ++ks) Sb[ks] = pack8(S[2 * ks], S[2 * ks + 1]);
        f32x4 vn[4];
#pragma unroll
        for (int rt = 0; rt < 4; ++rt) {
            f32x4 acc = (f32x4){0.f, 0.f, 0.f, 0.f};
#pragma unroll
            for (int ks = 0; ks < 4; ++ks) acc = MFMA16(*(const bf16x8*)(buf + ((rt * 4 + ks) * 64 + lane) * 16), Sb[ks], acc);
            vn[rt] = U[rt] - acc;
        }
        bf16x8 Vb[2];
        Vb[0] = pack8(vn[0], vn[1]); Vb[1] = pack8(vn[2], vn[3]);
#pragma unroll
        for (int rt = 0; rt < 4; ++rt) {
            f32x4 acc = (f32x4){0.f, 0.f, 0.f, 0.f};
#pragma unroll
            for (int ks = 0; ks < 4; ++ks) acc = MFMA16(*(const bf16x8*)(buf + 16384 + ((rt * 4 + ks) * 64 + lane) * 16), Sb[ks], acc);
#pragma unroll
            for (int ks2 = 0; ks2 < 2; ++ks2) acc = MFMA16(*(const bf16x8*)(buf + 49152 + ((rt * 2 + ks2) * 64 + lane) * 16), Vb[ks2], acc);
#pragma unroll
            for (int j = 0; j < 4; ++j) OBUF[(16 * rt + 4 * fq + j) * OST + 16 * w + fr] = acc[j];
        }
#pragma unroll
        for (int dt = 0; dt < 8; ++dt) {
            f32x4 acc = S[dt] * dl;
#pragma unroll
            for (int ks2 = 0; ks2 < 2; ++ks2) acc = MFMA16(*(const bf16x8*)(buf + 32768 + ((dt * 2 + ks2) * 64 + lane) * 16), Vb[ks2], acc);
            S[dt] = acc;
        }
        if (nxt) {
#pragma unroll
            for (int i = 0; i < 7; ++i) *(u32x4*)(dyn_smem + ((c + 1) & 1) * OPB_B + (tid + 512 * i) * 16) = pf[i];
        }
        __syncthreads();
        {
            float o[16]; float ss = 0.f;
#pragma unroll
            for (int e4 = 0; e4 < 4; ++e4) { const f32x4 a = *(const f32x4*)(OBUF + erow * OST + 16 * ept + 4 * e4);
#pragma unroll
                for (int e = 0; e < 4; ++e) { o[4 * e4 + e] = a[e]; ss += a[e] * a[e]; } }
#pragma unroll
            for (int of = 1; of < 8; of <<= 1) ss += __shfl_xor(ss, of);
            if (erow < valid) {
                const float r = rsqrtf(ss * (1.f / 128.f) + 1e-6f);
                const size_t grow = (samp ? (size_t)MP + b * TS : (size_t)b * TP + (size_t)c * 64) + erow;
                const unsigned gw[8] = {g0.x, g0.y, g0.z, g0.w, g1.x, g1.y, g1.z, g1.w};
                unsigned ow[8];
#pragma unroll
                for (int e = 0; e < 8; ++e) {
                    const float ga = bflo(gw[e]), gb = bfhi(gw[e]);
                    ow[e] = pk2(o[2 * e] * r * nw[2 * e] * silu(ga), o[2 * e + 1] * r * nw[2 * e + 1] * silu(gb));
                }
                *(u32x4*)(OMIX + grow * 1024 + h * 128 + 16 * ept) = (u32x4){ow[0], ow[1], ow[2], ow[3]};
                *(u32x4*)(OMIX + grow * 1024 + h * 128 + 16 * ept + 8) = (u32x4){ow[4], ow[5], ow[6], ow[7]};
            }
        }
        __syncthreads();
#pragma unroll
        for (int rt = 0; rt < 4; ++rt) U[rt] = Un[rt];
        dl = dln; g0 = gn0; g1 = gn1;
    }
    float* So = p.out + (samp ? O_GS : O_GP) + (size_t)(b * 4 + h) * 128 * 128;
#pragma unroll
    for (int dt = 0; dt < 8; ++dt)
#pragma unroll
        for (int j = 0; j < 4; ++j) So[(size_t)(16 * dt + 4 * fq + j) * 128 + 16 * w + fr] = S[dt][j];
}

constexpr int L_KT = 0, L_VT = 2 * 16384, L_ALX = L_VT + 3 * 16384, L_IDX = L_ALX + 8 * 2 * 32 * 4, L_QF = L_IDX + 256;
static_assert(L_QF + 8 * 8 * 1024 <= LDS_BYTES, "attn LDS");
DI int crow32(int i, int hh) { return (i & 3) + 8 * (i >> 2) + 4 * hh; }

DI void attn_item(const Params& p, const int idx, const float* lamp) {
    unsigned char* ws = p.ws;
    const int tid = opaque_tid(), lane = tid & 63, w = __builtin_amdgcn_readfirstlane(tid >> 6), r = lane & 31, hh = lane >> 5;
    bool samp; int b, h, qb = 0, ntiles, lastw; size_t qbase, kbase; const bf16_t* vtb; int vstride; bool active;
    if (idx < 32) { samp = true; b = idx >> 2; h = idx & 3; qbase = (size_t)MP + b * TS; kbase = (size_t)MP + (size_t)b * TKS; ntiles = 65; lastw = 64; active = w == 0;
                    vtb = (const bf16_t*)(ws + WS_R6) + VT_S_OFF + (size_t)((b * 4 + h) * 128) * TKS; vstride = TKS; }
    else { const int j = idx - 32; samp = false; qb = 31 - (j >> 4); b = (j & 15) >> 2; h = j & 3; qbase = (size_t)b * TP + qb * 256; kbase = (size_t)b * TP; ntiles = 4 * qb + 4; lastw = 4 * qb + (w >> 1); active = true;
           vtb = (const bf16_t*)(ws + WS_R6) + (size_t)((b * 4 + h) * 128) * TP; vstride = TP; }
    const bf16_t* KALL = (const bf16_t*)(ws + WS_R5) + kbase * 512 + h * 128;
    bf16_t* QF = (bf16_t*)(dyn_smem + L_QF) + w * 8 * 64 * 8;
    {
        const bf16_t* qp = (const bf16_t*)(ws + WS_R4) + (qbase + 32 * w + r) * 512 + h * 128 + 8 * hh;
        if (active) {
#pragma unroll
            for (int f = 0; f < 8; ++f) *(u32x4*)(QF + (f * 64 + lane) * 8) = *(const u32x4*)(qp + (f >> 2) * 64 + 16 * (f & 3));
        }
    }
    f32x16 O1[4], O2[4];
#pragma unroll
    for (int t = 0; t < 4; ++t)
#pragma unroll
        for (int i = 0; i < 16; ++i) { O1[t][i] = 0.f; O2[t][i] = 0.f; }
    float m1 = -1e30f, m2 = -1e30f, l1 = 0.f, l2 = 0.f;
    auto stage_tile = [&](int kt_, int buf_, int vbuf_) {
        int ln = lane; asm volatile("" : "+v"(ln));
        const int krow_ = ln >> 4, vrow_ = ln >> 3;
        const unsigned kx = (ln & 15) ^ krow_, vx = (ln & 7) ^ (vrow_ >> 1);
        const unsigned klane = krow_ * 512, vlane = vrow_ * vstride;
#pragma unroll
        for (int j = 0; j < 2; ++j) {
            const int i = 2 * w + j;
            const bf16_t* kbase = KALL + ((size_t)kt_ * 64 + (((4 * i) & ~12) | (((4 * i) & 4) << 1) | (((4 * i) & 8) >> 1))) * 512;
            const bf16_t* vbase = vtb + (size_t)(8 * i) * vstride + (size_t)kt_ * 64;
            const unsigned ko = klane + ((kx ^ ((4 * i) & 15)) * 8), vo = vlane + ((vx ^ ((4 * i) & 7)) * 8);
            __builtin_amdgcn_global_load_lds((const unsigned*)(kbase + ko), (unsigned*)(dyn_smem + L_KT + buf_ * 16384 + i * 1024 + ln * 16), 16, 0, 0);
            __builtin_amdgcn_global_load_lds((const unsigned*)(vbase + vo), (unsigned*)(dyn_smem + L_VT + vbuf_ * 16384 + i * 1024 + ln * 16), 16, 0, 0);
        }
    };
    const int ky = hh ^ (r & 15), vzh = ((r >> 1) & 7) ^ hh;
    __syncthreads();
    stage_tile(0, 0, 0);
    asm volatile("s_waitcnt vmcnt(0)" ::: "memory");
    __syncthreads();
    if (active) {
#pragma unroll
        for (int mp = 0; mp < 2; ++mp) {
            float mx = -1e30f;
#pragma unroll
            for (int sub = 0; sub < 2; ++sub) {
                f32x16 sc;
#pragma unroll
                for (int i = 0; i < 16; ++i) sc[i] = 0.f;
#pragma unroll
                for (int s = 0; s < 4; ++s) {
                    const bf16x8 ka = *(const bf16x8*)(dyn_smem + L_KT + (sub * 32 + r) * 256 + (((mp * 8 + 2 * s) ^ ky) * 16));
                    const bf16x8 qf = *(const bf16x8*)(QF + ((mp * 4 + s) * 64 + lane) * 8);
                    sc = MFMA32(ka, qf, sc);
                }
#pragma unroll
                for (int i = 0; i < 16; ++i) mx = fmaxf(mx, sc[i]);
            }
            const auto sw = __builtin_amdgcn_permlane32_swap(__float_as_uint(mx), __float_as_uint(mx), false, false);
            mx = fmaxf(__uint_as_float(sw[0]), __uint_as_float(sw[1]));
            if (mp == 0) m1 = mx; else m2 = mx;
        }
    }
    const bool roleY = w >= 4;
    bf16x8 PA[2], PB[2];
    float tm1 = -1e30f, tm2 = -1e30f;
    int vcur = 0, vprev = 2;
#define ATT_QK(SUB, MP, SC) do { \
        _Pragma("unroll") for (int s_ = 0; s_ < 4; ++s_) { \
            const bf16x8 ka_ = *(const bf16x8*)(Kb + (SUB) * 32 * 256 + ((((MP) * 8 + 2 * s_) ^ ky) * 16)); \
            const bf16x8 qf_ = *(const bf16x8*)(QF + (((MP) * 4 + s_) * 64 + lane) * 8); \
            SC = MFMA32(ka_, qf_, s_ == 0 ? zero16 : SC); } } while (0)
#define ATT_SM(SC, P, MM, LL, TM, MSK) do { \
        float ps_ = 0.f, tq_ = TM; const float mr_ = MM + MSK; \
        _Pragma("unroll") for (int i_ = 0; i_ < 16; ++i_) { tq_ = fmaxf(tq_, SC[i_]); SC[i_] = __builtin_amdgcn_exp2f(SC[i_] - mr_); ps_ += SC[i_]; } \
        TM = MSK != 0.f ? TM : tq_; \
        LL += ps_; \
        _Pragma("unroll") for (int sp_ = 0; sp_ < 2; ++sp_) { \
            u32x4 a_; a_.x = pk2(SC[8 * sp_], SC[8 * sp_ + 1]); a_.y = pk2(SC[8 * sp_ + 2], SC[8 * sp_ + 3]); a_.z = pk2(SC[8 * sp_ + 4], SC[8 * sp_ + 5]); a_.w = pk2(SC[8 * sp_ + 6], SC[8 * sp_ + 7]); \
            P[sp_] = __builtin_bit_cast(bf16x8, a_); } } while (0)
#define ATT_PV2(VB, SUB, P1, P2) do { \
        _Pragma("unroll") for (int sp_ = 0; sp_ < 2; ++sp_) \
            _Pragma("unroll") for (int t_ = 0; t_ < 4; ++t_) { \
                const bf16x8 vb_ = *(const bf16x8*)((VB) + t_ * 32 * 128 + (((4 * (SUB) + 2 * sp_) ^ vzh) * 16)); \
                O1[t_] = MFMA32(P1[sp_], vb_, O1[t_]); O2[t_] = MFMA32(P2[sp_], vb_, O2[t_]); } } while (0)
#define ATT_QS(SUB, MSK) do { \
        f32x16 scA, scB; \
        ATT_QK(SUB, 0, scA); \
        __builtin_amdgcn_sched_barrier(0); \
        ATT_QK(SUB, 1, scB); \
        ATT_SM(scA, PA, m1, l1, tm1, MSK); \
        __builtin_amdgcn_sched_barrier(0); \
        ATT_SM(scB, PB, m2, l2, tm2, MSK); \
        __builtin_amdgcn_sched_barrier(0); } while (0)
#define ATT_CHECK() do { \
        const auto s1_ = __builtin_amdgcn_permlane32_swap(__float_as_uint(tm1), __float_as_uint(tm1), false, false); tm1 = fmaxf(__uint_as_float(s1_[0]), __uint_as_float(s1_[1])); \
        const auto s2_ = __builtin_amdgcn_permlane32_swap(__float_as_uint(tm2), __float_as_uint(tm2), false, false); tm2 = fmaxf(__uint_as_float(s2_[0]), __uint_as_float(s2_[1])); \
        const float n1 = tm1 > m1 + 8.f ? tm1 : m1, n2 = tm2 > m2 + 8.f ? tm2 : m2; \
        if (__any((n1 != m1) || (n2 != m2))) { \
            const float al1 = __builtin_amdgcn_exp2f(m1 - n1), al2 = __builtin_amdgcn_exp2f(m2 - n2); \
            l1 *= al1; l2 *= al2; m1 = n1; m2 = n2; \
            const int ln_ = __builtin_amdgcn_mbcnt_hi(~0u, __builtin_amdgcn_mbcnt_lo(~0u, 0u)), r_ = ln_ & 31, hh_ = ln_ >> 5; \
            float* alx_ = (float*)(dyn_smem + L_ALX) + w * 64; \
            if (hh_ == 0) { alx_[r_] = al1; alx_[32 + r_] = al2; } \
            asm volatile("s_waitcnt lgkmcnt(0)" ::: "memory"); \
            _Pragma("unroll") for (int g = 0; g < 4; ++g) { \
                const f32x4 a1 = *(const f32x4*)(alx_ + 8 * g + 4 * hh_), a2 = *(const f32x4*)(alx_ + 32 + 8 * g + 4 * hh_); \
                _Pragma("unroll") for (int t = 0; t < 4; ++t) \
                    _Pragma("unroll") for (int j = 0; j < 4; ++j) { O1[t][4 * g + j] *= a1[j]; O2[t][4 * g + j] *= a2[j]; } } \
            asm volatile("s_waitcnt lgkmcnt(0)" ::: "memory"); } \
        tm1 = -1e30f; tm2 = -1e30f; } while (0)
    f32x16 zero16;
#pragma unroll
    for (int i = 0; i < 16; ++i) zero16[i] = 0.f;
    if (!roleY) {
#pragma unroll 1
        for (int kt = 0; kt < ntiles; ++kt) {
            const int vnext = vcur == 2 ? 0 : vcur + 1;
            if (kt + 1 < ntiles) stage_tile(kt + 1, (kt + 1) & 1, vnext);
            const unsigned char* Kb = dyn_smem + L_KT + (kt & 1) * 16384 + r * 256;
            const unsigned char* Vb = dyn_smem + L_VT + vcur * 16384 + r * 128;
            if (active && kt <= lastw) {
                const float msk1 = (samp && kt == 64) ? 1e30f : 0.f;
#pragma unroll 1
                for (int sub = 0; sub < 2; ++sub) {
                    const float msk = sub ? msk1 : 0.f;
                    ATT_QS(sub, msk);
                    ATT_PV2(Vb, sub, PA, PB);
                    __builtin_amdgcn_sched_barrier(0);
                }
                ATT_CHECK();
            }
            vcur = vnext;
            asm volatile("s_waitcnt vmcnt(0)" ::: "memory");
            __builtin_amdgcn_s_barrier();
        }
    } else {
#pragma unroll 1
        for (int kt = 0; kt < ntiles; ++kt) {
            const int vnext = vcur == 2 ? 0 : vcur + 1;
            if (kt + 1 < ntiles) stage_tile(kt + 1, (kt + 1) & 1, vnext);
            const unsigned char* Kb = dyn_smem + L_KT + (kt & 1) * 16384 + r * 256;
            const unsigned char* Vb = dyn_smem + L_VT + vcur * 16384 + r * 128;
            const unsigned char* Vp = dyn_smem + L_VT + vprev * 16384 + r * 128;
            if (kt <= lastw + 1) {
                if (kt > 0) { ATT_PV2(Vp, 1, PA, PB); __builtin_amdgcn_sched_barrier(0); }
                if (kt <= lastw) {
                    ATT_CHECK();
                    ATT_QS(0, 0.f);
                    ATT_PV2(Vb, 0, PA, PB);
                    __builtin_amdgcn_sched_barrier(0);
                    ATT_QS(1, 0.f);
                }
            }
            vprev = vcur; vcur = vnext;
            asm volatile("s_waitcnt vmcnt(0)" ::: "memory");
            __builtin_amdgcn_s_barrier();
        }
        if (lastw == ntiles - 1) {
            const unsigned char* Vp = dyn_smem + L_VT + vprev * 16384 + r * 128;
            ATT_PV2(Vp, 1, PA, PB);
        }
    }
    if (active) {
        const int lnf = __builtin_amdgcn_mbcnt_hi(~0u, __builtin_amdgcn_mbcnt_lo(~0u, 0u)), r = lnf & 31, hh = lnf >> 5;
        float* ALX = (float*)(dyn_smem + L_ALX) + w * 64;
        { const auto s1_ = __builtin_amdgcn_permlane32_swap(__float_as_uint(l1), __float_as_uint(l1), false, false); l1 = __uint_as_float(s1_[0]) + __uint_as_float(s1_[1]);
          const auto s2_ = __builtin_amdgcn_permlane32_swap(__float_as_uint(l2), __float_as_uint(l2), false, false); l2 = __uint_as_float(s2_[0]) + __uint_as_float(s2_[1]); }
        if (hh == 0) { ALX[r] = __builtin_amdgcn_rcpf(l1); ALX[32 + r] = *lamp * __builtin_amdgcn_rcpf(l2); }
        asm volatile("s_waitcnt lgkmcnt(0)" ::: "memory");
        float ss[16], a1[16], a2[16];
#pragma unroll
        for (int g = 0; g < 4; ++g) {
            const f32x4 x1 = *(const f32x4*)(ALX + 8 * g + 4 * hh), x2 = *(const f32x4*)(ALX + 32 + 8 * g + 4 * hh);
#pragma unroll
            for (int j = 0; j < 4; ++j) { a1[4 * g + j] = x1[j]; a2[4 * g + j] = x2[j]; ss[4 * g + j] = 0.f; }
        }
#pragma unroll
        for (int t = 0; t < 4; ++t) {
            __builtin_amdgcn_sched_barrier(0);
#pragma unroll
            for (int i = 0; i < 16; ++i) { const float o = O1[t][i] * a1[i] - O2[t][i] * a2[i]; O1[t][i] = o; ss[i] += o * o; }
        }
        __builtin_amdgcn_sched_barrier(0);
#pragma unroll
        for (int i = 0; i < 16; ++i) {
#pragma unroll
            for (int of = 1; of < 32; of <<= 1) ss[i] += __shfl_xor(ss[i], of);
            ss[i] = __builtin_amdgcn_rsqf(ss[i] * (1.f / 128.f) + 1e-6f) * (1.f - LAM_INIT);
        }
        int zo = 0; asm volatile("" : "+v"(zo));
        bf16_t* obase = (bf16_t*)(ws + WS_R2) + (qbase + 32 * w) * 1024 + 512 + h * 128;
        const unsigned ooff = (unsigned)((4 * hh + zo) * 1024 + r);
        const float* sw = p.subln_w + r + zo;
#pragma unroll
        for (int t = 0; t < 4; ++t) {
            const float wv = sw[32 * t];
#pragma unroll
            for (int i = 0; i < 16; ++i) obase[ooff + ((i & 3) + 8 * (i >> 2)) * 1024 + 32 * t] = f2bf(O1[t][i] * ss[i] * wv);
        }
    }
}

DI void mixer_phase(const Params& p) {
    const int bid = blockIdx.x;
#ifndef NO_SCAN
    if (bid >= 16 && bid < 48) {
        float cw[3][4];
        gdn_conv_weights(p, (bid - 16) & 3, cw);
        gdn_prep_item(p, 2048 + bid - 16, cw);
        asm volatile("s_waitcnt vmcnt(0)" ::: "memory");
        __builtin_amdgcn_fence(__ATOMIC_ACQUIRE, "agent");
        asm volatile("s_waitcnt vmcnt(0)" ::: "memory");
        __syncthreads();
    }
    if (bid < 48) { const bool sm = bid >= 16; const int j = sm ? bid - 16 : bid;
#pragma unroll 1
        for (int rep = 0; rep < SREP; ++rep) gdn_scan(p, sm, j >> 2, j & 3); }
#endif
    unsigned* ctl = (unsigned*)(p.ws + WS_CTL);
    int* sidx = (int*)(dyn_smem + L_IDX);
    for (;;) {
        __syncthreads();
        if (threadIdx.x == 0) *sidx = (int)atomicAdd(ctl, 1u);
        __syncthreads();
        const int idx0 = __builtin_amdgcn_readfirstlane(*sidx);
        if (idx0 >= (32 + 512) * AREP) break;
        const int idx = idx0 % (32 + 512);
#ifndef NO_ATTN
        attn_item(p, idx, (const float*)ctl + 1);
#endif
    }
}


#define XB_TMO      128
#define XB_XCNT(j)  (256  + 64 * (j))
#define XB_XSUB(j)  (1280 + 64 * (j))
#define XB_XGEN(j)  (2304 + 64 * (j))
#define XB_TOP      3328
#define XB_TOPGEN   3392
#define XCD_BAR_WORDS 3456
#define XB_SPIN_CAP (1u << 20)
#define LAS __attribute__((address_space(3)))
DI unsigned xb_ld(unsigned* p) { return __hip_atomic_load(p, __ATOMIC_RELAXED, __HIP_MEMORY_SCOPE_AGENT); }
DI unsigned xb_add(unsigned* p, unsigned v) { return __hip_atomic_fetch_add(p, v, __ATOMIC_RELAXED, __HIP_MEMORY_SCOPE_AGENT); }
DI unsigned xb_xcc_id() { return (unsigned)__builtin_amdgcn_s_getreg((3 << 11) | 20) & 0xFu; }
#define XB_SPIN(cond, bar) do { unsigned _sp = 0; while (cond) { __builtin_amdgcn_s_sleep(1); \
    if ((++_sp & 255u) == 0u) { if (xb_ld(&(bar)[XB_TMO])) break; if (_sp > XB_SPIN_CAP) { atomicAdd(&(bar)[XB_TMO], 1u); break; } } } } while (0)
struct XcdBarrier { unsigned* bar; unsigned x; volatile LAS unsigned* st; };
DI XcdBarrier xcd_barrier_post(unsigned* bar, volatile LAS unsigned* st) {
    XcdBarrier b; b.bar = bar; b.x = xb_xcc_id(); b.st = st;
    if (threadIdx.x == 0) (void)xb_add(&bar[XB_XCNT(b.x)], 1u);
    return b;
}
DI void xcd_barrier_complete(unsigned* bar, unsigned x, unsigned& nloc, unsigned& nx) {
    const unsigned G = gridDim.x * gridDim.y * gridDim.z;
    unsigned sum, cnt, mine, sp = 0u;
    for (;;) {
        sum = 0u; cnt = 0u; mine = 0u;
#pragma unroll
        for (unsigned j = 0; j < 16; ++j) { const unsigned c = xb_ld(&bar[XB_XCNT(j)]); sum += c; cnt += (c > 0u) ? 1u : 0u; mine = (j == x) ? c : mine; }
        if (sum == G) break;
        __builtin_amdgcn_s_sleep(1);
        if ((++sp & 255u) == 0u) { if (xb_ld(&bar[XB_TMO])) break; if (sp > XB_SPIN_CAP) { atomicAdd(&bar[XB_TMO], 1u); break; } }
    }
    nloc = mine > 0u ? mine : 1u; nx = cnt > 0u ? cnt : 1u;
}
DI void xcd_barrier(const XcdBarrier& b) {
    asm volatile("s_waitcnt vmcnt(0)" ::: "memory");
    __syncthreads();
    if (threadIdx.x == 0) {
        unsigned* bar = b.bar;
        __builtin_amdgcn_s_waitcnt(0);
        unsigned nloc = b.st[0], nx = b.st[1];
        if (nloc == 0u) { xcd_barrier_complete(bar, b.x, nloc, nx); b.st[0] = nloc; b.st[1] = nx; }
        const unsigned old = xb_add(&bar[XB_XSUB(b.x)], 1u);
        const unsigned gen = old / nloc;
        if (old + 1u == (gen + 1u) * nloc) {
            __builtin_amdgcn_fence(__ATOMIC_RELEASE, "agent");
            asm volatile("s_waitcnt vmcnt(0)" ::: "memory");
            const unsigned og = xb_add(&bar[XB_TOP], 1u);
            const unsigned tg = og / nx;
            if (og + 1u == (tg + 1u) * nx) xb_add(&bar[XB_TOPGEN], 1u);
            else XB_SPIN(xb_ld(&bar[XB_TOPGEN]) == tg, bar);
            __builtin_amdgcn_fence(__ATOMIC_ACQUIRE, "agent");
            xb_add(&bar[XB_XGEN(b.x)], 1u);
            asm volatile("s_waitcnt vmcnt(0)" ::: "memory");
        } else {
            XB_SPIN(xb_ld(&bar[XB_XGEN(b.x)]) == gen, bar);
            __builtin_amdgcn_fence(__ATOMIC_ACQUIRE, "agent");
            asm volatile("s_waitcnt vmcnt(0)" ::: "memory");
        }
    }
    __syncthreads();
}

__global__ void __launch_bounds__(512, 2) fwd_kernel(Params p) {
    cg::grid_group grid = cg::this_grid();
    volatile LAS unsigned* xst = (volatile LAS unsigned*)(dyn_smem + LDS_BYTES - 16);
    if (threadIdx.x == 0) { xst[0] = 0u; xst[1] = 0u; }
    __syncthreads();
    const XcdBarrier xb = xcd_barrier_post((unsigned*)(p.ws + WS_BAR), xst);
    if (p.phase_lo > 1000) grid.sync();
    const bool all = p.phase_hi - p.phase_lo > 1;
#define PHASE(i, body) if (p.phase_lo <= (i) && (i) < p.phase_hi) { body; if (all && (i) + 1 < p.phase_hi) xcd_barrier(xb); }
    PHASE(0, phase_prep(p))
    PHASE(1, gemm_phase<1>(p))
    PHASE(2, gdn_prep_phase(p))
    PHASE(3, mixer_phase(p))
    PHASE(4, gemm_phase<2>(p))
    PHASE(5, ln_phase<0>(p))
    PHASE(6, gemm_phase<3>(p))
    PHASE(7, fixup_phase(p))
    PHASE(8, gemm_phase<4>(p))
    PHASE(9, ln_phase<1>(p))
}

extern "C" void kernel_launch(void* const* d_in, const int* in_sizes, int n_in, void* d_out, int out_size, void* d_ws, size_t ws_size, hipStream_t stream) {
    static int grid = 0;
    if (grid == 0) {
        if (n_in != 23 || (size_t)out_size != O_END || ws_size < WS_END2) { fprintf(stderr, "kernel_launch: unexpected sizes n_in %d out %d ws %zu (need %zu)\n", n_in, out_size, ws_size, (size_t)WS_END2); grid = -1; return; }
        int dev = 0, cus = 0, per_cu = 0;
        hipGetDevice(&dev);
        hipDeviceGetAttribute(&cus, hipDeviceAttributeMultiprocessorCount, dev);
        if (hipFuncSetAttribute((const void*)fwd_kernel, hipFuncAttributeMaxDynamicSharedMemorySize, LDS_BYTES) != hipSuccess) { fprintf(stderr, "kernel_launch: hipFuncSetAttribute failed\n"); grid = -1; return; }
        hipOccupancyMaxActiveBlocksPerMultiprocessor(&per_cu, (const void*)fwd_kernel, 512, LDS_BYTES);
        if (per_cu < 1) { fprintf(stderr, "kernel_launch: occupancy query says %d\n", per_cu); per_cu = 1; }
        (void)hipGetLastError();
        grid = cus * 1;
    }
    if (grid < 0) return;
    Params p{};
    const float** f = (const float**)&p;
    for (int i = 0; i < 23; ++i) f[i] = (const float*)d_in[i];
    p.out = (float*)d_out; p.ws = (unsigned char*)d_ws; p.phase_lo = 0; p.phase_hi = 10;
    if (hipMemsetAsync((unsigned char*)d_ws + WS_BAR, 0, 16384, stream) != hipSuccess) { fprintf(stderr, "kernel_launch: memset failed\n"); return; }
    void* args[] = {&p};
    hipError_t e = hipLaunchCooperativeKernel((const void*)fwd_kernel, dim3(grid), dim3(512), args, LDS_BYTES, stream);
    if (e != hipSuccess) fprintf(stderr, "cooperative launch failed: %s (grid %d)\n", hipGetErrorString(e), grid);
}
```

```cpp
#include <hip/hip_runtime.h>
#include <hip/hip_cooperative_groups.h>
#include <cstdio>
namespace cg = cooperative_groups;
#ifndef GREP_WHICH
#define GREP_WHICH 0
#endif
#ifndef AREP
#define AREP 1
#endif
#ifndef SREP
#define SREP 1
#endif

typedef unsigned short bf16_t;
typedef short bf16x8 __attribute__((ext_vector_type(8)));
typedef short s16x4 __attribute__((ext_vector_type(4)));
typedef float f32x4 __attribute__((ext_vector_type(4)));
typedef float f32x16 __attribute__((ext_vector_type(16)));
typedef unsigned u32x4 __attribute__((ext_vector_type(4)));
typedef unsigned u32x2 __attribute__((ext_vector_type(2)));
#define DI __device__ __forceinline__

constexpr int D = 1024, TP = 8192, BP = 4, MP = BP * TP, BS = 8, TS = 32, MS = BS * TS, M = MP + MS, PAST = 4096;
constexpr int DIN = 3592, NH1 = 3584, DFF = 2816, NUP = 2 * DFF;
constexpr int TKS = 4160;
constexpr int NITEM = BP * 128 * 4 + BS * 4;
constexpr int ITEM_B = 90112;
constexpr int LDS_BYTES = 160 * 1024;
constexpr float ALPHA = 1.189207115002721f;
constexpr float LAM_INIT = 0.2f;

constexpr size_t O_Y = 0, O_KP = 33816576, O_VP = 50593792, O_GP = 67371008, O_CQP = 67633152, O_CFP = 67651584,
                 O_KS = 67696640, O_VS = 67827712, O_GS = 67958784, O_CQS = 68483072, O_CFS = 68519936, O_END = 68610048;

constexpr size_t al256(size_t x) { return (x + 255) & ~(size_t)255; }
constexpr size_t WS_CTL = 0;
constexpr size_t WS_ROPE = 4096;
constexpr size_t WS_AB = WS_ROPE + (size_t)8192 * 32 * 8;
constexpr size_t WS_DL = WS_AB + (size_t)M * 8 * 4;
constexpr size_t WS_WIN = al256(WS_DL + NITEM * 4);
constexpr size_t WS_WO = WS_WIN + (size_t)NH1 * D * 2;
constexpr size_t WS_WUP = WS_WO + (size_t)D * D * 2;
constexpr size_t WS_WDN = WS_WUP + (size_t)NUP * D * 2;
constexpr size_t WS_R1 = al256(WS_WDN + (size_t)D * DFF * 2);
constexpr size_t R1_SIZE = (size_t)NITEM * ITEM_B;
constexpr size_t WS_R2 = al256(WS_R1 + R1_SIZE);
constexpr size_t WS_R3 = al256(WS_R2 + (size_t)M * 1536 * 2);
constexpr size_t WS_R4 = WS_R3 + (size_t)M * 512 * 2;
constexpr size_t WS_R5 = al256(WS_R4 + (size_t)M * 512 * 2);
constexpr size_t KROWS = (size_t)MP + (size_t)BS * TKS;
constexpr size_t WS_R6 = al256(WS_R5 + KROWS * 512 * 2);
constexpr size_t VT_S_OFF = (size_t)BP * 4 * 128 * TP;
constexpr size_t WS_END = al256(WS_R6 + (VT_S_OFF + (size_t)BS * 4 * 128 * TKS) * 2);
constexpr size_t WS_CS1 = WS_END;
constexpr size_t WS_CS2 = WS_CS1 + (size_t)MS * NH1 * 4;
constexpr size_t WS_CS3 = WS_CS2 + (size_t)MS * D * 4;
constexpr size_t WS_CS4 = WS_CS3 + (size_t)MS * NUP * 4;
constexpr size_t WS_BAR = WS_CS4 + (size_t)MS * D * 4;
constexpr size_t WS_END2 = WS_BAR + 16384;
static_assert((size_t)M * DFF * 2 <= R1_SIZE, "GT must fit R1");
static_assert(WS_END2 <= (size_t)536870912, "workspace too large");

struct Params {
    const float *x_p, *x_s, *cache_k, *cache_v, *state_gdn, *state_cq, *state_cf;
    const float *w_in, *gdn_conv_w, *a_log, *dt_bias, *gdn_norm_w, *diff_lambda, *subln_w, *w_o, *ln1_g, *ln1_b, *w_up,
        *ffn_conv_w, *ffn_conv_b, *w_down, *ln2_g, *ln2_b;
    float* out; unsigned char* ws;
    int phase_lo, phase_hi;
};

extern __shared__ __attribute__((aligned(16))) unsigned char dyn_smem[];

typedef __bf16 bf16x2_t __attribute__((ext_vector_type(2)));
typedef float f32x2 __attribute__((ext_vector_type(2)));
DI unsigned pk2(float lo, float hi) { f32x2 v = {lo, hi}; bf16x2_t b = __builtin_convertvector(v, bf16x2_t); return __builtin_bit_cast(unsigned, b); }
DI bf16_t f2bf(float x) { return (bf16_t)(pk2(x, 0.f) & 0xffffu); }
DI float bf2f(bf16_t b) { return __uint_as_float(((unsigned)b) << 16); }
DI float bflo(unsigned u) { return __uint_as_float(u << 16); }
DI float bfhi(unsigned u) { return __uint_as_float(u & 0xffff0000u); }
DI float silu(float x) { return x * __builtin_amdgcn_rcpf(1.f + __expf(-x)); }
DI void lds_barrier() { asm volatile("s_waitcnt lgkmcnt(0)\n\ts_barrier" ::: "memory"); }
DI int opaque_tid() { int t = threadIdx.x; asm volatile("" : "+v"(t)); return t; }
DI float wave_sum(float v) {
#pragma unroll
    for (int o = 1; o < 64; o <<= 1) v += __shfl_xor(v, o);
    return v;
}
DI const float* xrow_ptr(const Params& p, int row) { return row < MP ? p.x_p + (size_t)row * D : p.x_s + (size_t)(row - MP) * D; }

template <int MODE> DI int srccol(int n) {
    if (MODE == 1) {
        if (n < 2048) return n;
        return n + 8;
    }
    if (MODE == 2) { const int pn = n >> 8, j = n & 255; return j < 128 ? 128 * pn + j : DFF + 128 * pn + (j - 128); }
    return n;
}
struct TrItem { const float* W; bf16_t* WT; int K, N, k0, n0, mode; };
DI TrItem tr_decode(const Params& p, int it) {
    constexpr int I_IN = 16 * 56, I_O = 16 * 16, I_UP = 16 * 88;
    unsigned char* ws = p.ws; TrItem t; int r = it;
    if (r < I_IN) { t.W = p.w_in; t.WT = (bf16_t*)(ws + WS_WIN); t.K = D; t.N = DIN; t.k0 = (r / 56) * 64; t.n0 = (r % 56) * 64; t.mode = 1; return t; } r -= I_IN;
    if (r < I_O) { t.W = p.w_o; t.WT = (bf16_t*)(ws + WS_WO); t.K = D; t.N = D; t.k0 = (r / 16) * 64; t.n0 = (r % 16) * 64; t.mode = 0; return t; } r -= I_O;
    if (r < I_UP) { t.W = p.w_up; t.WT = (bf16_t*)(ws + WS_WUP); t.K = D; t.N = NUP; t.k0 = (r / 88) * 64; t.n0 = (r % 88) * 64; t.mode = 2; return t; } r -= I_UP;
    t.W = p.w_down; t.WT = (bf16_t*)(ws + WS_WDN); t.K = DFF; t.N = D; t.k0 = (r / 16) * 64; t.n0 = (r % 16) * 64; t.mode = 0; return t;
}
DI void tr_load(const TrItem& t, float (&v)[8]) {
    const int tid = threadIdx.x, n = t.n0 + (tid & 63);
    const int sc = t.mode == 1 ? (n < 2048 ? n : n + 8) : (t.mode == 2 ? srccol<2>(n) : n);
#pragma unroll
    for (int i = 0; i < 8; ++i) v[i] = t.W[(size_t)(t.k0 + (tid >> 6) + 8 * i) * t.N + sc];
}
DI void transpose_range(const Params& p, const int lo, const int hi) {
    const int tid = opaque_tid(), nb = gridDim.x, bid = blockIdx.x;
    float* lds = (float*)dyn_smem;
    float v[8];
    lds_barrier();
    TrItem cur = tr_decode(p, lo + bid < hi ? lo + bid : lo);
    if (lo + bid < hi) tr_load(cur, v);
    for (int it = lo + bid; it < hi; it += nb) {
        float nv[8]; TrItem nx = cur;
        if (it + nb < hi) { nx = tr_decode(p, it + nb); tr_load(nx, nv); }
#pragma unroll
        for (int i = 0; i < 8; ++i) lds[((tid >> 6) + 8 * i) * 65 + (tid & 63)] = v[i];
        lds_barrier();
#pragma unroll
        for (int i = 0; i < 8; ++i) { const int nn = (tid >> 6) + 8 * i, kk = tid & 63; cur.WT[(size_t)(cur.n0 + nn) * cur.K + cur.k0 + kk] = f2bf(lds[kk * 65 + nn]); }
        lds_barrier();
#pragma unroll
        for (int i = 0; i < 8; ++i) v[i] = nv[i];
        cur = nx;
    }
}
DI void phase_prep(const Params& p) {
    const int tid = threadIdx.x, lane = tid & 63, wave = tid >> 6, nb = gridDim.x, bid = blockIdx.x;
    unsigned char* ws = p.ws;
    if (bid == 0 && tid < 64) {
        unsigned* ctl = (unsigned*)(ws + WS_CTL);
        float a = p.diff_lambda[lane] * p.diff_lambda[64 + lane], b = p.diff_lambda[128 + lane] * p.diff_lambda[192 + lane];
        a = wave_sum(a); b = wave_sum(b);
        if (lane == 0) { ctl[0] = 0u; ((float*)ctl)[1] = expf(a) - expf(b) + LAM_INIT; }
    }
    transpose_range(p, 0, 16 * 56);
    {
        float2* rope = (float2*)(ws + WS_ROPE);
        for (int idx = bid * 512 + tid; idx < 8192 * 32; idx += nb * 512) {
            const int pos = idx >> 5, d = idx & 31;
            const double inv = exp(-(double)d * (9.210340371976184 / 32.0));
            double a = (double)pos * inv;
            a -= 6.283185307179586 * rint(a * 0.15915494309189535);
            const float af = (float)a;
            rope[idx] = make_float2(__cosf(af), __sinf(af));
        }
    }
    {
        float* w8 = (float*)dyn_smem;
        __syncthreads();
        for (int i = tid; i < 1024 * 8; i += 512) w8[i] = p.w_in[(size_t)(i >> 3) * DIN + 2048 + (i & 7)];
        __syncthreads();
        bf16_t* XB = (bf16_t*)(ws + WS_R1);
        float* AB = (float*)(ws + WS_AB);
        f32x4 cv[4];
        {
            const int row = bid * 8 + wave;
            if (row < M) { const float* xr = xrow_ptr(p, row);
#pragma unroll
                for (int j = 0; j < 4; ++j) cv[j] = *(const f32x4*)(xr + lane * 4 + 256 * j); }
        }
        for (int row = bid * 8 + wave; row < M; row += nb * 8) {
            f32x4 nvx[4];
            if (row + nb * 8 < M) { const float* xn = xrow_ptr(p, row + nb * 8);
#pragma unroll
                for (int j = 0; j < 4; ++j) nvx[j] = *(const f32x4*)(xn + lane * 4 + 256 * j); }
            float acc[8];
#pragma unroll
            for (int c = 0; c < 8; ++c) acc[c] = 0.f;
#pragma unroll
            for (int j = 0; j < 4; ++j) {
                const int k0 = lane * 4 + 256 * j;
                const f32x4 v = cv[j];
                u32x2 o; o.x = pk2(v.x, v.y); o.y = pk2(v.z, v.w);
                *(u32x2*)(XB + (size_t)row * D + k0) = o;
#pragma unroll
                for (int e = 0; e < 4; ++e) {
                    const f32x4 wa = *(const f32x4*)(w8 + (k0 + e) * 8), wb = *(const f32x4*)(w8 + (k0 + e) * 8 + 4);
                    const float xv = v[e];
                    acc[0] += xv * wa.x; acc[1] += xv * wa.y; acc[2] += xv * wa.z; acc[3] += xv * wa.w;
                    acc[4] += xv * wb.x; acc[5] += xv * wb.y; acc[6] += xv * wb.z; acc[7] += xv * wb.w;
                }
            }
#pragma unroll
            for (int c = 0; c < 8; ++c) acc[c] = wave_sum(acc[c]);
            if (lane == 0) { *(f32x4*)(AB + (size_t)row * 8) = (f32x4){acc[0], acc[1], acc[2], acc[3]}; *(f32x4*)(AB + (size_t)row * 8 + 4) = (f32x4){acc[4], acc[5], acc[6], acc[7]}; }
#pragma unroll
            for (int j = 0; j < 4; ++j) cv[j] = nvx[j];
        }
        __syncthreads();
    }
}

DI void prep_stream(const Params& p) {
    const int tid = opaque_tid(), nb = gridDim.x, bid = blockIdx.x;
    unsigned char* ws = p.ws;
    transpose_range(p, 16 * 56, 16 * 56 + 16 * 16 + 16 * 88 + 44 * 16);
    lds_barrier();
    {
        bf16_t* KALL = (bf16_t*)(ws + WS_R5);
        const int nchunk = BS * TKS * 64;
        for (int c0 = bid * 512 + tid; c0 < nchunk; c0 += nb * 512 * 4) {
            f32x4 v0[4], v1[4]; int st[4]; size_t dsto[4];
#pragma unroll
            for (int u = 0; u < 4; ++u) {
                const int c = c0 + u * nb * 512;
                st[u] = 0;
                if (c < nchunk) {
                    const int col8 = c & 63, r = c >> 6, b = r / TKS, pp = r % TKS;
                    dsto[u] = ((size_t)MP + (size_t)b * TKS + pp) * 512 + col8 * 8;
                    if (pp < PAST) { const float* sp = p.cache_k + ((size_t)(b * PAST + pp) * 512 + col8 * 8); v0[u] = *(const f32x4*)sp; v1[u] = *(const f32x4*)(sp + 4); st[u] = 1; }
                    else if (pp >= PAST + TS) st[u] = 2;
                }
            }
#pragma unroll
            for (int u = 0; u < 4; ++u) {
                if (st[u] == 1) { u32x4 o; o.x = pk2(v0[u].x, v0[u].y); o.y = pk2(v0[u].z, v0[u].w); o.z = pk2(v1[u].x, v1[u].y); o.w = pk2(v1[u].z, v1[u].w); *(u32x4*)(KALL + dsto[u]) = o; }
                else if (st[u] == 2) *(u32x4*)(KALL + dsto[u]) = (u32x4){0u, 0u, 0u, 0u};
            }
        }
    }
    {
        bf16_t* VTS = (bf16_t*)(ws + WS_R6) + VT_S_OFF;
        bf16_t* t = (bf16_t*)dyn_smem;
        f32x4 cvv[4];
        auto ldv = [&](int it, f32x4 (&v)[4]) {
            const int blk = it % 65, bh = it / 65, b = bh >> 2, h = bh & 3;
            if (blk < 64) {
#pragma unroll
                for (int i = 0; i < 4; ++i) { const int id = tid + 512 * i, key = id >> 5, c4 = id & 31;
                    v[i] = *(const f32x4*)(p.cache_v + ((size_t)(b * PAST + blk * 64 + key) * 512 + h * 128 + c4 * 4)); }
            }
        };
        if (bid < BS * 4 * 65) ldv(bid, cvv);
        for (int it = bid; it < BS * 4 * 65; it += nb) {
            const int blk = it % 65, bh = it / 65;
            f32x4 nvv[4];
            if (it + nb < BS * 4 * 65) ldv(it + nb, nvv);
            if (blk < 64) {
                lds_barrier();
#pragma unroll
                for (int i = 0; i < 4; ++i) {
                    const int id = tid + 512 * i, key = id >> 5, c4 = id & 31;
                    const f32x4 v = cvv[i];
                    bf16_t* d = t + key * 130 + c4 * 4;
                    *(unsigned*)d = pk2(v.x, v.y); *(unsigned*)(d + 2) = pk2(v.z, v.w);
                }
                lds_barrier();
                const int dv = tid >> 2, part = tid & 3;
                unsigned o[8];
#pragma unroll
                for (int i = 0; i < 8; ++i) { const int k0 = part * 16 + 2 * i; o[i] = (unsigned)t[k0 * 130 + dv] | ((unsigned)t[(k0 + 1) * 130 + dv] << 16); }
                bf16_t* dst = VTS + ((size_t)(bh * 128 + dv) * TKS + blk * 64 + part * 16);
                *(u32x4*)dst = (u32x4){o[0], o[1], o[2], o[3]}; *(u32x4*)(dst + 8) = (u32x4){o[4], o[5], o[6], o[7]};
            } else {
                if (tid < 128) { bf16_t* dst = VTS + ((size_t)(bh * 128 + tid) * TKS + PAST + TS);
#pragma unroll
                    for (int i = 0; i < 4; ++i) *(u32x4*)(dst + 8 * i) = (u32x4){0u, 0u, 0u, 0u}; }
            }
#pragma unroll
            for (int i = 0; i < 4; ++i) cvv[i] = nvv[i];
        }
        lds_barrier();
    }
}

constexpr int BM = 256, BK = 64, HALF = 128, NXCD = 8, WGM = 8, HT = HALF * BK;
DI void stage_rc(int b, int& R, int& C) {
    const int st = b / 1024, sb = b % 1024, swz = sb ^ (((sb >> 9) & 1) << 5);
    R = (st >> 1) * 16 + swz / 64; C = (st & 1) * 32 + (swz % 64) / 2;
}
DI int lds_byte(int r, int c) {
    const int st = (r >> 4) * 2 + (c >> 5), rr = r & 15, cc = c & 31, ob = rr * 64 + cc * 2;
    return st * 1024 + (ob ^ (((ob >> 9) & 1) << 5));
}

#define SHM ((bf16_t*)dyn_smem)
#define SA(b, h) (SHM + ((b) * 2 + (h)) * HT)
#define SB(b, h) (SHM + (4 + (b) * 2 + (h)) * HT)
#define STAGE(P, BASE, br, kt) do { const bf16_t* _gb = (BASE) + ((long)(br) * K + (long)(kt) * BK); \
      __builtin_amdgcn_global_load_lds((const unsigned*)(_gb + so0), (unsigned*)((char*)(P) + wlds), 16, 0, 0); \
      __builtin_amdgcn_global_load_lds((const unsigned*)(_gb + 64 * K + so0), (unsigned*)((char*)(P) + wlds + 8192), 16, 0, 0); } while (0)
#define LDA(dst, b, h) for (int m = 0; m < 4; ++m) for (int k = 0; k < 2; ++k) \
    dst[m][k] = *reinterpret_cast<const bf16x8*>((char*)SA(b, h) + lds_byte(wr * 64 + m * 16 + fr, k * 32 + fq * 8))
#define LDB(dst, b, h) for (int n = 0; n < 2; ++n) for (int k = 0; k < 2; ++k) \
    dst[n][k] = *reinterpret_cast<const bf16x8*>((char*)SB(b, h) + lds_byte(wc * 32 + n * 16 + fr, k * 32 + fq * 8))
#define MMA(ai, bj, At, Bt_) do { __builtin_amdgcn_s_setprio(1); \
    for (int m = 0; m < 4; ++m) for (int n = 0; n < 2; ++n) for (int k = 0; k < 2; ++k) \
      acc[ai][bj][m][n] = __builtin_amdgcn_mfma_f32_16x16x32_bf16(Bt_[n][k], At[m][k], acc[ai][bj][m][n], 0, 0, 0); \
    __builtin_amdgcn_s_setprio(0); } while (0)
#define WAIT_V(n) asm volatile("s_waitcnt vmcnt(" #n ")" ::: "memory")
#define WAIT_L(n) asm volatile("s_waitcnt lgkmcnt(" #n ")" ::: "memory")
#define BAR __builtin_amdgcn_s_barrier()
#define SCHED __builtin_amdgcn_sched_barrier(0)

template <int K> DI void gemm_tile(const bf16_t* __restrict__ A, const bf16_t* __restrict__ Bt, const int brow, const int bcol, f32x4 (&acc)[2][2][4][2]) {
    const int wid = threadIdx.x >> 6, lane = threadIdx.x & 63, wr = wid >> 2, wc = wid & 3, fr = lane & 15, fq = lane >> 4;
    unsigned so0;
    { int _r, _c; stage_rc(threadIdx.x * 16, _r, _c); so0 = (unsigned)(_r * K + _c); }
    const int wlds = __builtin_amdgcn_readfirstlane((int)(threadIdx.x >> 6) << 10);
#pragma unroll
    for (int a = 0; a < 2; ++a)
#pragma unroll
        for (int b = 0; b < 2; ++b)
#pragma unroll
            for (int m = 0; m < 4; ++m)
#pragma unroll
                for (int n = 0; n < 2; ++n) acc[a][b][m][n] = (f32x4){0.f, 0.f, 0.f, 0.f};
    bf16x8 At[4][2], B0[2][2], B1[2][2];
    constexpr int nt = K / BK;
    STAGE(SB(0, 0), Bt, bcol, 0); STAGE(SA(0, 0), A, brow, 0);
    STAGE(SB(0, 1), Bt, bcol + HALF, 0); STAGE(SA(0, 1), A, brow + HALF, 0);
    if (wr == 1) BAR;
    WAIT_V(4); BAR;
    STAGE(SB(1, 0), Bt, bcol, 1); STAGE(SA(1, 0), A, brow, 1); STAGE(SB(1, 1), Bt, bcol + HALF, 1);
    WAIT_V(6); BAR;
    for (int t = 0; t < nt - 2; t += 2) {
        LDB(B0, 0, 0); SCHED; LDA(At, 0, 0); STAGE(SA(1, 1), A, brow + HALF, t + 1);
        WAIT_L(8); BAR; WAIT_L(0); MMA(0, 0, At, B0); BAR; SCHED;
        LDB(B1, 0, 1); STAGE(SB(0, 0), Bt, bcol, t + 2);
        BAR; WAIT_L(0); MMA(0, 1, At, B1); BAR;
        LDA(At, 0, 1); STAGE(SA(0, 0), A, brow, t + 2);
        BAR; WAIT_L(0); MMA(1, 0, At, B0); BAR; SCHED;
        STAGE(SB(0, 1), Bt, bcol + HALF, t + 2);
        WAIT_V(6); BAR; MMA(1, 1, At, B1); BAR;
        LDB(B0, 1, 0); SCHED; LDA(At, 1, 0); STAGE(SA(0, 1), A, brow + HALF, t + 2);
        WAIT_L(8); BAR; WAIT_L(0); MMA(0, 0, At, B0); BAR; SCHED;
        LDB(B1, 1, 1); STAGE(SB(1, 0), Bt, bcol, t + 3);
        BAR; WAIT_L(0); MMA(0, 1, At, B1); BAR;
        LDA(At, 1, 1); STAGE(SA(1, 0), A, brow, t + 3);
        BAR; WAIT_L(0); MMA(1, 0, At, B0); BAR; SCHED;
        STAGE(SB(1, 1), Bt, bcol + HALF, t + 3);
        WAIT_V(6); BAR; MMA(1, 1, At, B1); BAR;
    }
    { LDB(B0, 0, 0); LDA(At, 0, 0); STAGE(SA(1, 1), A, brow + HALF, nt - 1);
      BAR; WAIT_L(0); MMA(0, 0, At, B0); BAR;
      LDB(B1, 0, 1); BAR; WAIT_L(0); MMA(0, 1, At, B1); BAR;
      LDA(At, 0, 1); WAIT_V(4); BAR; WAIT_L(0); MMA(1, 0, At, B0); MMA(1, 1, At, B1); BAR; }
    { LDB(B0, 1, 0); LDA(At, 1, 0); WAIT_V(2); BAR; WAIT_L(0); MMA(0, 0, At, B0); BAR;
      LDB(B1, 1, 1); WAIT_V(0); BAR; WAIT_L(0); MMA(0, 1, At, B1); BAR;
      LDA(At, 1, 1); BAR; WAIT_L(0); MMA(1, 0, At, B0); MMA(1, 1, At, B1); BAR; }
    if (wr == 0) BAR;
}

DI void tile_of(int L, int nM, int nN, int& pm, int& pn) {
    const int nwg = nM * nN; int wgid = L;
    { const int q = nwg / NXCD, r = nwg % NXCD, xcd = wgid % NXCD, off = wgid / NXCD; wgid = (xcd < r ? xcd * (q + 1) : r * (q + 1) + (xcd - r) * q) + off; }
    const int nig = WGM * nN, gid = wgid / nig, fm = gid * WGM, gsz = min(nM - fm, WGM);
    pm = fm + ((wgid % nig) % gsz); pn = (wgid % nig) / gsz;
}

constexpr int CST = 260;
DI void stage_half(const f32x4 (&acc)[2][2][4][2], const int ai) {
    const int tid_ = opaque_tid(), wid = tid_ >> 6, lane = tid_ & 63, wr = wid >> 2, wc = wid & 3, fr = lane & 15, fq = lane >> 4;
    float* base = (float*)dyn_smem + (wr * 64 + fr) * CST + wc * 32 + 4 * fq;
#pragma unroll
    for (int m = 0; m < 4; ++m)
#pragma unroll
        for (int bj = 0; bj < 2; ++bj)
#pragma unroll
            for (int n = 0; n < 2; ++n) *(f32x4*)(base + (m * 16) * CST + bj * 128 + n * 16) = ai == 0 ? acc[0][bj][m][n] : acc[1][bj][m][n];
}
#define CT ((const float*)dyn_smem)

DI void epi_in_half(const Params& p, int pm, int pn, int ai) {
    unsigned char* ws = p.ws;
    const int tid = opaque_tid(), brow = pm * BM + ai * 128, bcol = pn * BM;
    const bool samp = pm == 128;
    if (pn < 8) {
        bf16_t* dst = pn < 6 ? (bf16_t*)(ws + WS_R2) : (bf16_t*)(ws + WS_R3);
        const int ld = pn < 6 ? 1536 : 512, c0 = pn < 6 ? bcol : bcol - 1536;
#pragma unroll 4
        for (int i = 0; i < 8; ++i) {
            const int id = tid + 512 * i, r = id >> 5, c8 = (id & 31) * 8, row = brow + r;
            const f32x4 v = *(const f32x4*)(CT + r * CST + c8), w = *(const f32x4*)(CT + r * CST + c8 + 4);
            *(u32x4*)(dst + (size_t)row * ld + c0 + c8) = (u32x4){pk2(v.x, v.y), pk2(v.z, v.w), pk2(w.x, w.y), pk2(w.z, w.w)};
            if (pn < 6) {
                const int t = row & (TP - 1);
                if (t >= TP - 3) { float* cd = p.out + O_CQP + (size_t)((row >> 13) * 3 + t - (TP - 3)) * 1536 + c0 + c8; *(f32x4*)cd = v; *(f32x4*)(cd + 4) = w; }
            }
        }
        return;
    }
    if (pn < 12) {
        const bool isq = pn < 10;
        const float* rope = (const float*)(ws + WS_ROPE);
        bf16_t* QB = (bf16_t*)(ws + WS_R4); bf16_t* KALL = (bf16_t*)(ws + WS_R5);
        const float qs = 0.125f * 1.4426950408889634f;
        f32x4 rt0[8], rt1[8];
#pragma unroll
        for (int i = 0; i < 8; ++i) {
            const int id = tid + 512 * i, r = id >> 5, q = id & 31, d4 = (q & 7) * 4, row = brow + r;
            const int pos = samp ? PAST + ((row - MP) & 31) : (row & (TP - 1));
            rt0[i] = *(const f32x4*)(rope + (size_t)(pos * 32 + d4) * 2); rt1[i] = *(const f32x4*)(rope + (size_t)(pos * 32 + d4) * 2 + 4);
        }
#pragma unroll
        for (int i = 0; i < 8; ++i) {
            const int id = tid + 512 * i, r = id >> 5, q = id & 31, hl = q >> 4, map = (q >> 3) & 1, d4 = (q & 7) * 4, row = brow + r;
            const int cl = hl * 128 + map * 64 + d4, col = ((pn & 1) * 2 + hl) * 128 + map * 64 + d4;
            const f32x4 x1 = *(const f32x4*)(CT + r * CST + cl), x2 = *(const f32x4*)(CT + r * CST + cl + 32);
            int pos; size_t krow; float* kout;
            if (!samp) { pos = row & (TP - 1); krow = row; kout = p.out + O_KP + (size_t)row * 512; }
            else { const int rr = row - MP; pos = PAST + (rr & 31); krow = (size_t)MP + (size_t)(rr >> 5) * TKS + pos; kout = p.out + O_KS + (size_t)rr * 512; }
            const f32x4 t0 = rt0[i], t1 = rt1[i];
            const f32x4 cs = (f32x4){t0.x, t0.z, t1.x, t1.z}, sn = (f32x4){t0.y, t0.w, t1.y, t1.w};
            const f32x4 y1 = x1 * cs - x2 * sn, y2 = x2 * cs + x1 * sn;
            if (isq) {
                u32x2 o1, o2; o1.x = pk2(y1.x * qs, y1.y * qs); o1.y = pk2(y1.z * qs, y1.w * qs); o2.x = pk2(y2.x * qs, y2.y * qs); o2.y = pk2(y2.z * qs, y2.w * qs);
                *(u32x2*)(QB + (size_t)row * 512 + col) = o1; *(u32x2*)(QB + (size_t)row * 512 + col + 32) = o2;
            } else {
                *(f32x4*)(kout + col) = y1; *(f32x4*)(kout + col + 32) = y2;
                u32x2 o1, o2; o1.x = pk2(y1.x, y1.y); o1.y = pk2(y1.z, y1.w); o2.x = pk2(y2.x, y2.y); o2.y = pk2(y2.z, y2.w);
                *(u32x2*)(KALL + krow * 512 + col) = o1; *(u32x2*)(KALL + krow * 512 + col + 32) = o2;
            }
        }
        return;
    }
    {
        bf16_t* VT = (bf16_t*)(ws + WS_R6);
#pragma unroll 4
        for (int i = 0; i < 16; ++i) {
            const int id = tid + 512 * i, r = id >> 6, c4 = (id & 63) * 4, row = brow + r, col = (pn & 1) * 256 + c4;
            const f32x4 v = *(const f32x4*)(CT + r * CST + c4);
            float* vout = samp ? p.out + O_VS + (size_t)(row - MP) * 512 + col : p.out + O_VP + (size_t)row * 512 + col;
            *(f32x4*)vout = v;
        }
#pragma unroll 1
        for (int i = 0; i < 2; ++i) {
            const int id = tid + 512 * i, rg = id >> 6, c4 = (id & 63) * 4, row0 = brow + rg * 8;
            f32x4 v[8];
#pragma unroll
            for (int e = 0; e < 8; ++e) v[e] = *(const f32x4*)(CT + (rg * 8 + e) * CST + c4);
#pragma unroll
            for (int e = 0; e < 4; ++e) {
                const int colg = (pn & 1) * 256 + c4 + e, head = colg >> 7, dv = colg & 127;
                u32x4 o; o.x = pk2(v[0][e], v[1][e]); o.y = pk2(v[2][e], v[3][e]); o.z = pk2(v[4][e], v[5][e]); o.w = pk2(v[6][e], v[7][e]);
                bf16_t* d;
                if (samp) { const int rr = row0 - MP; d = VT + VT_S_OFF + ((size_t)(((rr >> 5) * 4 + head) * 128 + dv) * TKS + PAST + (rr & 31)); }
                else d = VT + ((size_t)(((row0 >> 13) * 4 + head) * 128 + dv) * TP + (row0 & (TP - 1)));
                *(u32x4*)d = o;
            }
        }
    }
}

template <int WHICH> DI void epi_res_half(const Params& p, int pm, int pn, int ai) {
    const int tid = opaque_tid(), brow = pm * BM + ai * 128, bcol = pn * BM;
    bf16_t* dst = (bf16_t*)(p.ws + (WHICH == 0 ? WS_R1 : WS_R2));
    const bf16_t* X1B = (const bf16_t*)(p.ws + WS_R3);
    f32x4 xa[8], xb[8];
#pragma unroll
    for (int i = 0; i < 8; ++i) {
        const int id = tid + 512 * i, r = id >> 5, c8 = (id & 31) * 8, row = brow + r;
        if (WHICH == 0) { const float* xp = xrow_ptr(p, row) + bcol + c8; xa[i] = *(const f32x4*)xp; xb[i] = *(const f32x4*)(xp + 4); }
        else { const u32x4 q = *(const u32x4*)(X1B + (size_t)row * D + bcol + c8); xa[i] = (f32x4){bflo(q.x), bfhi(q.x), bflo(q.y), bfhi(q.y)}; xb[i] = (f32x4){bflo(q.z), bfhi(q.z), bflo(q.w), bfhi(q.w)}; }
    }
#pragma unroll
    for (int i = 0; i < 8; ++i) {
        const int id = tid + 512 * i, r = id >> 5, c8 = (id & 31) * 8, row = brow + r;
        const f32x4 v = *(const f32x4*)(CT + r * CST + c8), w = *(const f32x4*)(CT + r * CST + c8 + 4);
        const f32x4 o = xa[i] * ALPHA + v, o2 = xb[i] * ALPHA + w;
        *(u32x4*)(dst + (size_t)row * D + bcol + c8) = (u32x4){pk2(o.x, o.y), pk2(o.z, o.w), pk2(o2.x, o2.y), pk2(o2.z, o2.w)};
    }
}

constexpr int UST = 264;
DI void epi_up(const Params& p, const f32x4 (&acc)[2][2][4][2], int pm, int pn) {
    unsigned char* ws = p.ws;
    bf16_t* U = (bf16_t*)dyn_smem;
    float* BND = (float*)(ws + WS_R5);
    const bool samp = pm == 128;
    const int brow = pm * BM, tid = opaque_tid();
    {
        const int wid = tid >> 6, lane = tid & 63, wr = wid >> 2, wc = wid & 3, fr = lane & 15, fq = lane >> 4;
        bf16_t* base = U + (wr * 64 + fr) * UST + wc * 32 + 4 * fq;
#pragma unroll
        for (int ai = 0; ai < 2; ++ai)
#pragma unroll
            for (int m = 0; m < 4; ++m)
#pragma unroll
                for (int bj = 0; bj < 2; ++bj)
#pragma unroll
                    for (int n = 0; n < 2; ++n) {
                        const f32x4 v = acc[ai][bj][m][n];
                        u32x2 q; q.x = pk2(v.x, v.y); q.y = pk2(v.z, v.w);
                        *(u32x2*)(base + (ai * 128 + m * 16) * UST + bj * 128 + n * 16) = q;
                    }
    }
    lds_barrier();
    {
        const int nb = samp ? 32 * 256 : 4 * 256;
        for (int id = tid; id < nb; id += 512) {
            const int cl = id & 255, q = id >> 8;
            const int oc = (cl >> 7) * DFF + 128 * pn + (cl & 127);
            int rr, bslot, u;
            if (!samp) { bslot = q; rr = q < 2 ? q : 252 + q; u = pm; }
            else { bslot = q & 3; rr = (q >> 2) * 32 + (bslot < 2 ? bslot : 28 + bslot); u = 128 + (q >> 2); }
            const float v = bf2f(U[rr * UST + cl]);
            BND[((size_t)u * 4 + bslot) * NUP + oc] = v;
            if (bslot >= 2) {
                if (samp) p.out[O_CFS + (size_t)((q >> 2) * 2 + bslot - 2) * NUP + oc] = v;
                else if ((pm & 31) == 31) p.out[O_CFP + (size_t)((pm >> 5) * 2 + bslot - 2) * NUP + oc] = v;
            }
        }
    }
    {
        const int cq = tid & 31, rs = tid >> 5, c = 4 * cq, cg_ = 128 * pn + c, cv_ = DFF + 128 * pn + c;
        const f32x4 wg0 = *(const f32x4*)(p.ffn_conv_w + cg_), wg1 = *(const f32x4*)(p.ffn_conv_w + NUP + cg_), wg2 = *(const f32x4*)(p.ffn_conv_w + 2 * NUP + cg_), bg = *(const f32x4*)(p.ffn_conv_b + cg_);
        const f32x4 wv0 = *(const f32x4*)(p.ffn_conv_w + cv_), wv1 = *(const f32x4*)(p.ffn_conv_w + NUP + cv_), wv2 = *(const f32x4*)(p.ffn_conv_w + 2 * NUP + cv_), bv = *(const f32x4*)(p.ffn_conv_b + cv_);
        bf16_t* GT = (bf16_t*)(ws + WS_R1);
        const int r0 = rs * 16;
        auto ld4 = [&](int rr, int cc) { const u32x2 q = *(const u32x2*)(U + rr * UST + cc); return (f32x4){bflo(q.x), bfhi(q.x), bflo(q.y), bfhi(q.y)}; };
        const f32x4 z4 = {0.f, 0.f, 0.f, 0.f};
        f32x4 g1 = z4, g2 = z4, v1 = z4, v2 = z4;
        if (r0 >= 2) { g1 = ld4(r0 - 2, c); g2 = ld4(r0 - 1, c); v1 = ld4(r0 - 2, 128 + c); v2 = ld4(r0 - 1, 128 + c); }
#pragma unroll 4
        for (int r = r0; r < r0 + 16; ++r) {
            const f32x4 g3 = ld4(r, c), v3 = ld4(r, 128 + c);
            if (r >= 2) {
                const f32x4 cg2 = wg0 * g1 + wg1 * g2 + wg2 * g3 + bg, cv2 = wv0 * v1 + wv1 * v2 + wv2 * v3 + bv;
                u32x2 q; q.x = pk2(silu(cg2.x) * cv2.x, silu(cg2.y) * cv2.y); q.y = pk2(silu(cg2.z) * cv2.z, silu(cg2.w) * cv2.w);
                *(u32x2*)(GT + (size_t)(brow + r) * DFF + 128 * pn + c) = q;
            }
            g1 = g2; g2 = g3; v1 = v2; v2 = v3;
        }
    }
}

template <int K> DI void skinny_gemm(const bf16_t* __restrict__ A, const bf16_t* __restrict__ Bt, float* __restrict__ C, const int N) {
    const int tid = opaque_tid(), lane = tid & 63, w = __builtin_amdgcn_readfirstlane(tid >> 6), fr = lane & 15, fq = lane >> 4;
    float* red = (float*)dyn_smem;
    constexpr int KW = K / 8, NKS = KW / 32;
    const int ntile = 8 * (N / 32);
    for (int t = blockIdx.x; t < ntile; t += gridDim.x) {
        const int rm = t & 7, cn = t >> 3;
        const bf16_t* ap = A + (size_t)(32 * rm + fr) * K + w * KW + 8 * fq;
        const bf16_t* bp = Bt + (size_t)(32 * cn + fr) * K + w * KW + 8 * fq;
        f32x4 acc[2][2];
#pragma unroll
        for (int i = 0; i < 2; ++i)
#pragma unroll
            for (int j = 0; j < 2; ++j) acc[i][j] = (f32x4){0.f, 0.f, 0.f, 0.f};
#pragma unroll 4
        for (int ks = 0; ks < NKS; ++ks) {
            const bf16x8 a0 = *(const bf16x8*)(ap + ks * 32), a1 = *(const bf16x8*)(ap + (size_t)16 * K + ks * 32);
            const bf16x8 b0 = *(const bf16x8*)(bp + ks * 32), b1 = *(const bf16x8*)(bp + (size_t)16 * K + ks * 32);
            acc[0][0] = __builtin_amdgcn_mfma_f32_16x16x32_bf16(a0, b0, acc[0][0], 0, 0, 0);
            acc[0][1] = __builtin_amdgcn_mfma_f32_16x16x32_bf16(a0, b1, acc[0][1], 0, 0, 0);
            acc[1][0] = __builtin_amdgcn_mfma_f32_16x16x32_bf16(a1, b0, acc[1][0], 0, 0, 0);
            acc[1][1] = __builtin_amdgcn_mfma_f32_16x16x32_bf16(a1, b1, acc[1][1], 0, 0, 0);
        }
        lds_barrier();
#pragma unroll
        for (int i = 0; i < 2; ++i)
#pragma unroll
            for (int j = 0; j < 2; ++j)
#pragma unroll
                for (int e = 0; e < 4; ++e) red[(w * 32 + 16 * i + 4 * fq + e) * 33 + 16 * j + fr] = acc[i][j][e];
        lds_barrier();
#pragma unroll
        for (int o2 = 0; o2 < 2; ++o2) {
            const int o = tid + 512 * o2, r = o >> 5, c = o & 31;
            float sum = 0.f;
#pragma unroll
            for (int ww = 0; ww < 8; ++ww) sum += red[(ww * 32 + r) * 33 + c];
            C[(size_t)(32 * rm + r) * N + 32 * cn + c] = sum;
        }
    }
    lds_barrier();
}

template <int WHICH> DI void gemm_phase(const Params& p) {
    unsigned char* ws = p.ws;
    const bf16_t* A; const bf16_t* Bt; int N; constexpr int K = WHICH == 4 ? DFF : D; float* CS;
    if (WHICH == 1) { A = (const bf16_t*)(ws + WS_R1); Bt = (const bf16_t*)(ws + WS_WIN); N = NH1; CS = (float*)(ws + WS_CS1); }
    else if (WHICH == 2) { A = (const bf16_t*)(ws + WS_R2); Bt = (const bf16_t*)(ws + WS_WO); N = D; CS = (float*)(ws + WS_CS2); }
    else if (WHICH == 3) { A = (const bf16_t*)(ws + WS_R3); Bt = (const bf16_t*)(ws + WS_WUP); N = NUP; CS = (float*)(ws + WS_CS3); }
    else { A = (const bf16_t*)(ws + WS_R1); Bt = (const bf16_t*)(ws + WS_WDN); N = D; CS = (float*)(ws + WS_CS4); }
    skinny_gemm<K>(A + (size_t)MP * K, Bt, CS, N);
    const int nM = MP / BM, nN = N / BM, ntile = nM * nN;
    for (int L0 = blockIdx.x; L0 < ntile * (WHICH == GREP_WHICH ? 2 : 1); L0 += gridDim.x) {
        const int L = L0 % ntile;
        int pm, pn; tile_of(L, nM, nN, pm, pn);
        f32x4 acc[2][2][4][2];
        gemm_tile<K>(A, Bt, pm * BM, pn * BM, acc);
        if (WHICH == 3) epi_up(p, acc, pm, pn);
        else {
#pragma unroll
            for (int ai = 0; ai < 2; ++ai) {
                stage_half(acc, ai);
                lds_barrier();
                if (WHICH == 1) epi_in_half(p, pm, pn, ai);
                else if (WHICH == 2) epi_res_half<0>(p, pm, pn, ai);
                else epi_res_half<1>(p, pm, pn, ai);
                lds_barrier();
            }
        }
        lds_barrier();
    }
}

template <int WHICH> DI void ln_phase(const Params& p) {
    const int lane = threadIdx.x & 63, wave = threadIdx.x >> 6;
    const float* g = WHICH == 0 ? p.ln1_g : p.ln2_g; const float* b = WHICH == 0 ? p.ln1_b : p.ln2_b;
    bf16_t* X1B = (bf16_t*)(p.ws + WS_R3);
    const bf16_t* PRE = (const bf16_t*)(p.ws + (WHICH == 0 ? WS_R1 : WS_R2));
    f32x4 gv[4], bv[4];
#pragma unroll
    for (int j = 0; j < 4; ++j) { gv[j] = *(const f32x4*)(g + lane * 4 + 256 * j); bv[j] = *(const f32x4*)(b + lane * 4 + 256 * j); }
    auto ld_row = [&](int row, f32x4 (&v)[4]) {
        if (row < MP) {
#pragma unroll
            for (int j = 0; j < 4; ++j) { const u32x2 q = *(const u32x2*)(PRE + (size_t)row * D + lane * 4 + 256 * j); v[j] = (f32x4){bflo(q.x), bfhi(q.x), bflo(q.y), bfhi(q.y)}; }
        } else {
            const float* cs = (const float*)(p.ws + (WHICH == 0 ? WS_CS2 : WS_CS4)) + (size_t)(row - MP) * D;
#pragma unroll
            for (int j = 0; j < 4; ++j) {
                f32x4 rs;
                if (WHICH == 0) rs = *(const f32x4*)(p.x_s + (size_t)(row - MP) * D + lane * 4 + 256 * j);
                else { const u32x2 q = *(const u32x2*)(X1B + (size_t)row * D + lane * 4 + 256 * j); rs = (f32x4){bflo(q.x), bfhi(q.x), bflo(q.y), bfhi(q.y)}; }
                v[j] = rs * ALPHA + *(const f32x4*)(cs + lane * 4 + 256 * j);
            }
        }
    };
    f32x4 v[4];
    if (blockIdx.x * 8 + wave < M) ld_row(blockIdx.x * 8 + wave, v);
    for (int row = blockIdx.x * 8 + wave; row < M; row += gridDim.x * 8) {
        f32x4 vn[4];
        const bool more = row + (int)gridDim.x * 8 < M;
        if (more) ld_row(row + gridDim.x * 8, vn);
        float s = 0.f;
#pragma unroll
        for (int j = 0; j < 4; ++j) s += (v[j].x + v[j].y) + (v[j].z + v[j].w);
        const float mean = wave_sum(s) * (1.f / D); float s2 = 0.f;
#pragma unroll
        for (int j = 0; j < 4; ++j) { v[j] = v[j] - mean; s2 += (v[j].x * v[j].x + v[j].y * v[j].y) + (v[j].z * v[j].z + v[j].w * v[j].w); }
        const float rstd = rsqrtf(wave_sum(s2) * (1.f / D) + 1e-5f);
#pragma unroll
        for (int j = 0; j < 4; ++j) {
            const f32x4 o = v[j] * rstd * gv[j] + bv[j];
            if (WHICH == 0) { u32x2 q; q.x = pk2(o.x, o.y); q.y = pk2(o.z, o.w); *(u32x2*)(X1B + (size_t)row * D + lane * 4 + 256 * j) = q; }
            else *(f32x4*)(p.out + O_Y + (size_t)row * D + lane * 4 + 256 * j) = o;
        }
        if (more) {
#pragma unroll
            for (int j = 0; j < 4; ++j) v[j] = vn[j];
        }
    }
}

DI void fixup_phase(const Params& p) {
    const float* BND = (const float*)(p.ws + WS_R5);
    bf16_t* GT = (bf16_t*)(p.ws + WS_R1);
    {
        const float* CS3 = (const float*)(p.ws + WS_CS3);
        for (int idx = blockIdx.x * 512 + threadIdx.x; idx < MS * DFF; idx += gridDim.x * 512) {
            const int c = idx % DFF, r = idx / DFF, b = r >> 5, t = r & 31, ng = (c >> 7) * 256 + (c & 127), nv = ng + 128;
            float g[3], v[3];
#pragma unroll
            for (int k = 0; k < 3; ++k) {
                const int tt = t - 2 + k;
                if (tt >= 0) { g[k] = CS3[(size_t)(b * 32 + tt) * NUP + ng]; v[k] = CS3[(size_t)(b * 32 + tt) * NUP + nv]; }
                else { g[k] = p.state_cf[(size_t)(b * 2 + 2 + tt) * NUP + c]; v[k] = p.state_cf[(size_t)(b * 2 + 2 + tt) * NUP + DFF + c]; }
            }
            const float cg2 = p.ffn_conv_w[c] * g[0] + p.ffn_conv_w[NUP + c] * g[1] + p.ffn_conv_w[2 * NUP + c] * g[2] + p.ffn_conv_b[c];
            const float cv2 = p.ffn_conv_w[DFF + c] * v[0] + p.ffn_conv_w[NUP + DFF + c] * v[1] + p.ffn_conv_w[2 * NUP + DFF + c] * v[2] + p.ffn_conv_b[DFF + c];
            GT[((size_t)MP + r) * DFF + c] = f2bf(silu(cg2) * cv2);
            if (t >= 30) { p.out[O_CFS + (size_t)(b * 2 + t - 30) * NUP + c] = g[2]; p.out[O_CFS + (size_t)(b * 2 + t - 30) * NUP + DFF + c] = v[2]; }
        }
    }
    const int total = 128 * 2 * DFF;
    for (int idx = blockIdx.x * 512 + threadIdx.x; idx < total; idx += gridDim.x * 512) {
        const int c = idx % DFF, q = idx / DFF, r = q & 1, u = q >> 1;
        const float* cur = BND + (size_t)u * 4 * NUP;
        float pg[2], pv[2];
        if (u < 128) {
            if ((u & 31) == 0) { pg[0] = pg[1] = pv[0] = pv[1] = 0.f; }
            else { const float* pr = BND + (size_t)(u - 1) * 4 * NUP; pg[0] = pr[2 * NUP + c]; pg[1] = pr[3 * NUP + c]; pv[0] = pr[2 * NUP + DFF + c]; pv[1] = pr[3 * NUP + DFF + c]; }
        } else { const float* st = p.state_cf + (size_t)(u - 128) * 2 * NUP; pg[0] = st[c]; pg[1] = st[NUP + c]; pv[0] = st[DFF + c]; pv[1] = st[NUP + DFF + c]; }
        const float cg0 = cur[c], cg1 = cur[NUP + c], cv0 = cur[DFF + c], cv1 = cur[NUP + DFF + c];
        const float wg0 = p.ffn_conv_w[c], wg1 = p.ffn_conv_w[NUP + c], wg2 = p.ffn_conv_w[2 * NUP + c], bg = p.ffn_conv_b[c];
        const float wv0 = p.ffn_conv_w[DFF + c], wv1 = p.ffn_conv_w[NUP + DFF + c], wv2 = p.ffn_conv_w[2 * NUP + DFF + c], bv = p.ffn_conv_b[DFF + c];
        float g, v;
        if (r == 0) { g = wg0 * pg[0] + wg1 * pg[1] + wg2 * cg0 + bg; v = wv0 * pv[0] + wv1 * pv[1] + wv2 * cv0 + bv; }
        else { g = wg0 * pg[1] + wg1 * cg0 + wg2 * cg1 + bg; v = wv0 * pv[1] + wv1 * cv0 + wv2 * cv1 + bv; }
        const size_t row = u < 128 ? (size_t)u * 256 + r : (size_t)MP + (size_t)(u - 128) * 32 + r;
        GT[row * DFF + c] = f2bf(silu(g) * v);
    }
}

#define MFMA16(a, b, c) __builtin_amdgcn_mfma_f32_16x16x32_bf16((a), (b), (c), 0, 0, 0)
#define MFMA32(a, b, c) __builtin_amdgcn_mfma_f32_32x32x16_bf16((a), (b), (c), 0, 0, 0)
DI bf16x8 pack8(const f32x4 a, const f32x4 b) { u32x4 o; o.x = pk2(a.x, a.y); o.y = pk2(a.z, a.w); o.z = pk2(b.x, b.y); o.w = pk2(b.z, b.w); return __builtin_bit_cast(bf16x8, o); }
constexpr float GSCALE = 0.08838834764831845f;
constexpr int QST = 132, AST = 68, NST = 136, QKST = 72;
constexpr int L_QKV = 0, L_AM = 3 * 64 * QST * 4, L_KN = L_AM + 64 * AST * 4, L_QN = L_KN + 64 * NST * 2, L_GC = L_QN + 64 * NST * 2;
constexpr int L_QKS = 0, L_WS = 64 * QKST * 2;
static_assert(L_GC + 1024 <= LDS_BYTES, "gdn prep LDS");

DI void gdn_conv_weights(const Params& p, const int h, float (&cw)[3][4]) {
#pragma unroll
    for (int k = 0; k < 3; ++k) {
        const int task = threadIdx.x + 512 * k, col = task % 384, part = col >> 7, cc = col & 127, gcol = part * 512 + h * 128 + cc;
#pragma unroll
        for (int j = 0; j < 4; ++j) cw[k][j] = p.gdn_conv_w[j * 1536 + gcol];
    }
}
DI void gdn_prep_item(const Params& p, const int item, const float (&cw)[3][4]) {
    unsigned char* ws = p.ws;
    float* QKVf = (float*)(dyn_smem + L_QKV); float* AM = (float*)(dyn_smem + L_AM);
    bf16_t* KN = (bf16_t*)(dyn_smem + L_KN); bf16_t* QN = (bf16_t*)(dyn_smem + L_QN);
    float* GC = (float*)(dyn_smem + L_GC); float* BETA = GC + 64; float* EG = GC + 128; float* ED = GC + 192;
    bf16_t* QKS = (bf16_t*)(dyn_smem + L_QKS); bf16_t* WSI = (bf16_t*)(dyn_smem + L_WS);
    const bf16_t* HQKV = (const bf16_t*)(ws + WS_R2);
    const float* AB = (const float*)(ws + WS_AB);
    float* DL = (float*)(ws + WS_DL);
        const int tid = opaque_tid(), lane = tid & 63, wave = __builtin_amdgcn_readfirstlane(tid >> 6), fr = lane & 15, fq = lane >> 4;
        int h, b, c, row0, valid; bool samp;
        if (item < 2048) { h = item & 3; c = (item >> 2) & 127; b = item >> 9; row0 = b * TP + c * 64; valid = 64; samp = false; }
        else { const int j = item - 2048; h = j & 3; b = j >> 2; c = 0; row0 = MP + b * TS; valid = TS; samp = true; }
        unsigned char* ip = ws + WS_R1 + (size_t)item * ITEM_B;
        lds_barrier();
        {
            bf16_t* RAW = (bf16_t*)(dyn_smem + L_AM);
#pragma unroll
            for (int i = 0; i < 7; ++i) {
                const int id = tid + 512 * i;
                if (id < 67 * 48) {
                    const int rw = id / 48, ch = id % 48, part = ch >> 4, c8 = (ch & 15) * 8, gcol = part * 512 + h * 128 + c8, t = rw - 3;
                    u32x4 v = (u32x4){0u, 0u, 0u, 0u};
                    if (t >= 0) {
                        if (t < valid) {
                            if (!samp) v = *(const u32x4*)(HQKV + (size_t)(row0 + t) * 1536 + gcol);
                            else { const float* sp = (const float*)(ws + WS_CS1) + (size_t)(row0 - MP + t) * NH1 + gcol; const f32x4 f0 = *(const f32x4*)sp, f1 = *(const f32x4*)(sp + 4);
                                   v.x = pk2(f0.x, f0.y); v.y = pk2(f0.z, f0.w); v.z = pk2(f1.x, f1.y); v.w = pk2(f1.z, f1.w); }
                        }
                    }
                    else if (samp) { const float* sp = p.state_cq + (size_t)(b * 3 + 3 + t) * 1536 + gcol; const f32x4 f0 = *(const f32x4*)sp, f1 = *(const f32x4*)(sp + 4);
                                     v.x = pk2(f0.x, f0.y); v.y = pk2(f0.z, f0.w); v.z = pk2(f1.x, f1.y); v.w = pk2(f1.z, f1.w); }
                    else if (c != 0) v = *(const u32x4*)(HQKV + (size_t)(row0 + t) * 1536 + gcol);
                    *(u32x4*)(RAW + rw * 384 + ch * 8) = v;
                }
            }
            lds_barrier();
#pragma unroll
            for (int k3 = 0; k3 < 3; ++k3) {
                const int task = tid + 512 * k3;
                const int col = task % 384, seg = task / 384, part = col >> 7, cc = col & 127, t0 = seg * 16;
                const float w0 = cw[k3][0], w1 = cw[k3][1], w2 = cw[k3][2], w3 = cw[k3][3];
                float x0 = bf2f(RAW[(t0) * 384 + col]), x1 = bf2f(RAW[(t0 + 1) * 384 + col]), x2 = bf2f(RAW[(t0 + 2) * 384 + col]);
#pragma unroll
                for (int t = t0; t < t0 + 16; ++t) {
                    const float xv = bf2f(RAW[(t + 3) * 384 + col]);
                    const float y = w0 * x0 + w1 * x1 + w2 * x2 + w3 * xv;
                    QKVf[(part * 64 + t) * QST + cc] = t < valid ? silu(y) : 0.f;
                    x0 = x1; x1 = x2; x2 = xv;
                }
            }
        }
        if (tid < 64) {
            float g = 0.f, be = 0.f;
            if (tid < valid) {
                const float a = AB[(size_t)(row0 + tid) * 8 + h] + p.dt_bias[h], bb = AB[(size_t)(row0 + tid) * 8 + 4 + h];
                const float sp = a > 20.f ? a : log1pf(expf(a));
                g = -expf(p.a_log[h]) * sp; be = 1.f / (1.f + expf(-bb));
            }
            float gc = g;
#pragma unroll
            for (int o = 1; o < 64; o <<= 1) { const float n = __shfl_up(gc, o); if (lane >= o) gc += n; }
            const float gl = __shfl(gc, 63);
            GC[tid] = gc; BETA[tid] = be; EG[tid] = expf(gc); ED[tid] = expf(gl - gc);
            if (tid == 0) DL[item] = expf(gl);
        }
        lds_barrier();
        {
            const int row = tid >> 3, pt = tid & 7;
            float q[16], k[16]; float sq = 0.f, sk = 0.f;
#pragma unroll
            for (int e4 = 0; e4 < 4; ++e4) {
                const f32x4 a = *(const f32x4*)(QKVf + row * QST + 16 * pt + 4 * e4), bq = *(const f32x4*)(QKVf + (64 + row) * QST + 16 * pt + 4 * e4);
#pragma unroll
                for (int e = 0; e < 4; ++e) { q[4 * e4 + e] = a[e]; k[4 * e4 + e] = bq[e]; sq += a[e] * a[e]; sk += bq[e] * bq[e]; }
            }
#pragma unroll
            for (int o = 1; o < 8; o <<= 1) { sq += __shfl_xor(sq, o); sk += __shfl_xor(sk, o); }
            const float rq = rsqrtf(sq + 1e-6f), rk = rsqrtf(sk + 1e-6f), qg = rq * GSCALE * EG[row];
            u32x4 o0, o1;
            o0.x = pk2(q[0] * rq, q[1] * rq); o0.y = pk2(q[2] * rq, q[3] * rq); o0.z = pk2(q[4] * rq, q[5] * rq); o0.w = pk2(q[6] * rq, q[7] * rq);
            o1.x = pk2(q[8] * rq, q[9] * rq); o1.y = pk2(q[10] * rq, q[11] * rq); o1.z = pk2(q[12] * rq, q[13] * rq); o1.w = pk2(q[14] * rq, q[15] * rq);
            *(u32x4*)(QN + row * NST + 16 * pt) = o0; *(u32x4*)(QN + row * NST + 16 * pt + 8) = o1;
            o0.x = pk2(k[0] * rk, k[1] * rk); o0.y = pk2(k[2] * rk, k[3] * rk); o0.z = pk2(k[4] * rk, k[5] * rk); o0.w = pk2(k[6] * rk, k[7] * rk);
            o1.x = pk2(k[8] * rk, k[9] * rk); o1.y = pk2(k[10] * rk, k[11] * rk); o1.z = pk2(k[12] * rk, k[13] * rk); o1.w = pk2(k[14] * rk, k[15] * rk);
            *(u32x4*)(KN + row * NST + 16 * pt) = o0; *(u32x4*)(KN + row * NST + 16 * pt + 8) = o1;
#pragma unroll
            for (int e4 = 0; e4 < 4; ++e4) *(f32x4*)(QKVf + (64 + row) * QST + 16 * pt + 4 * e4) = (f32x4){k[4 * e4] * rk, k[4 * e4 + 1] * rk, k[4 * e4 + 2] * rk, k[4 * e4 + 3] * rk};
            bf16_t* QGf = (bf16_t*)(ip + 16384);
            const int rt = row >> 4, frr = row & 15, ks = pt >> 1;
#pragma unroll
            for (int f = 0; f < 4; ++f) {
                u32x2 o; o.x = pk2(q[4 * f] * qg, q[4 * f + 1] * qg); o.y = pk2(q[4 * f + 2] * qg, q[4 * f + 3] * qg);
                *(u32x2*)(QGf + (size_t)(((rt * 4 + ks) * 64 + f * 16 + frr) * 8 + 4 * (pt & 1))) = o;
            }
        }
        lds_barrier();
        {
            const bool isq = wave >= 4; const int ti = wave & 3;
            const bf16_t* As = isq ? QN : KN;
#pragma unroll
            for (int tj = 0; tj < 4; ++tj) {
                f32x4 acc = (f32x4){0.f, 0.f, 0.f, 0.f};
#pragma unroll
                for (int ks = 0; ks < 4; ++ks) {
                    const bf16x8 a = *(const bf16x8*)(As + (16 * ti + fr) * NST + 32 * ks + 8 * fq), bb = *(const bf16x8*)(KN + (16 * tj + fr) * NST + 32 * ks + 8 * fq);
                    acc = MFMA16(a, bb, acc);
                }
                const int jj = 16 * tj + fr; const float gj = GC[jj];
#pragma unroll
                for (int j = 0; j < 4; ++j) {
                    const int i = 16 * ti + 4 * fq + j;
                    const float dec = i >= jj ? __expf(GC[i] - gj) : 0.f;
                    if (!isq) AM[i * AST + jj] = i > jj ? BETA[i] * acc[j] * dec : 0.f;
                    else QKS[i * QKST + jj] = f2bf(GSCALE * acc[j] * dec);
                }
            }
            bf16_t* KDTf = (bf16_t*)(ip + 32768);
#pragma unroll
            for (int i2 = 0; i2 < 2; ++i2) {
                const int f = tid + 512 * i2, ln = f & 63, ks2 = (f >> 6) & 1, dt = f >> 7, fq_ = ln >> 4, dk = 16 * dt + (ln & 15);
                float v[8];
#pragma unroll
                for (int e = 0; e < 8; ++e) { const int i = 32 * ks2 + 16 * (e >> 2) + 4 * fq_ + (e & 3); v[e] = bf2f(KN[i * NST + dk]) * ED[i]; }
                u32x4 o; o.x = pk2(v[0], v[1]); o.y = pk2(v[2], v[3]); o.z = pk2(v[4], v[5]); o.w = pk2(v[6], v[7]);
                *(u32x4*)(KDTf + (size_t)f * 8) = o;
            }
        }
        lds_barrier();
        {
            float* TM = (float*)(dyn_smem + L_QN);
            float* TMP = (float*)(dyn_smem + L_KN);
#pragma unroll
            for (int i = 0; i < 9; ++i) { const int id = tid + 512 * i; if (id < 64 * AST) TM[id] = 0.f; }
            lds_barrier();
            if (tid < 64) {
                const int d = tid >> 4, c = tid & 15;
                float y[16];
#pragma unroll
                for (int r = 0; r < 16; ++r) {
                    float sacc = r == c ? 1.f : 0.f;
                    const float* ar = AM + (16 * d + r) * AST + 16 * d;
                    float arow[16];
#pragma unroll
                    for (int j4 = 0; j4 < (r + 3) / 4; ++j4) { const f32x4 a = *(const f32x4*)(ar + 4 * j4); arow[4 * j4] = a.x; arow[4 * j4 + 1] = a.y; arow[4 * j4 + 2] = a.z; arow[4 * j4 + 3] = a.w; }
#pragma unroll
                    for (int j = 0; j < r; ++j) sacc -= arow[j] * y[j];
                    y[r] = sacc;
                    TM[(16 * d + r) * AST + 16 * d + c] = sacc;
                }
            }
            lds_barrier();
            {
                const int blk = tid >> 8, r = (tid >> 4) & 15, c = tid & 15, rb = blk ? 3 : 1, cb = rb - 1;
                float t = 0.f;
#pragma unroll
                for (int j = 0; j < 16; ++j) t += AM[(16 * rb + r) * AST + 16 * cb + j] * TM[(16 * cb + j) * AST + 16 * cb + c];
                TMP[blk * 272 + r * 17 + c] = t;
                lds_barrier();
                float o = 0.f;
#pragma unroll
                for (int k = 0; k < 16; ++k) o -= TM[(16 * rb + r) * AST + 16 * rb + k] * TMP[blk * 272 + k * 17 + c];
                lds_barrier();
                TM[(16 * rb + r) * AST + 16 * cb + c] = o;
            }
            lds_barrier();
            {
                float t[2];
#pragma unroll
                for (int i2 = 0; i2 < 2; ++i2) {
                    const int o = tid + 512 * i2, r = o >> 5, c = o & 31;
                    float acc = 0.f;
#pragma unroll
                    for (int j4 = 0; j4 < 8; ++j4) {
                        const f32x4 a = *(const f32x4*)(AM + (32 + r) * AST + 4 * j4);
                        acc += a.x * TM[(4 * j4) * AST + c] + a.y * TM[(4 * j4 + 1) * AST + c] + a.z * TM[(4 * j4 + 2) * AST + c] + a.w * TM[(4 * j4 + 3) * AST + c];
                    }
                    t[i2] = acc;
                }
#pragma unroll
                for (int i2 = 0; i2 < 2; ++i2) { const int o = tid + 512 * i2; TMP[(o >> 5) * 33 + (o & 31)] = t[i2]; }
                lds_barrier();
#pragma unroll
                for (int i2 = 0; i2 < 2; ++i2) {
                    const int o = tid + 512 * i2, r = o >> 5, c = o & 31;
                    float acc = 0.f;
#pragma unroll
                    for (int k4 = 0; k4 < 8; ++k4) {
                        const f32x4 a = *(const f32x4*)(TM + (32 + r) * AST + 32 + 4 * k4);
                        acc -= a.x * TMP[(4 * k4) * 33 + c] + a.y * TMP[(4 * k4 + 1) * 33 + c] + a.z * TMP[(4 * k4 + 2) * 33 + c] + a.w * TMP[(4 * k4 + 3) * 33 + c];
                    }
                    t[i2] = acc;
                }
#pragma unroll
                for (int i2 = 0; i2 < 2; ++i2) { const int o = tid + 512 * i2; TM[(32 + (o >> 5)) * AST + (o & 31)] = t[i2]; }
            }
            lds_barrier();
            {
                bf16x8 Ah[4][2], Al[4][2];
#pragma unroll
                for (int rt = 0; rt < 4; ++rt)
#pragma unroll
                    for (int ks = 0; ks < 2; ++ks) {
                        const f32x4 a0 = *(const f32x4*)(TM + (16 * rt + fr) * AST + 32 * ks + 8 * fq), a1 = *(const f32x4*)(TM + (16 * rt + fr) * AST + 32 * ks + 8 * fq + 4);
                        u32x4 hq; hq.x = pk2(a0.x, a0.y); hq.y = pk2(a0.z, a0.w); hq.z = pk2(a1.x, a1.y); hq.w = pk2(a1.z, a1.w);
                        u32x4 lq; lq.x = pk2(a0.x - bflo(hq.x), a0.y - bfhi(hq.x)); lq.y = pk2(a0.z - bflo(hq.y), a0.w - bfhi(hq.y));
                        lq.z = pk2(a1.x - bflo(hq.z), a1.y - bfhi(hq.z)); lq.w = pk2(a1.z - bflo(hq.w), a1.w - bfhi(hq.w));
                        Ah[rt][ks] = __builtin_bit_cast(bf16x8, hq); Al[rt][ks] = __builtin_bit_cast(bf16x8, lq);
                    }
                const bool isw = wave >= 4;
                f32x4 xacc[2][4];
#pragma unroll
                for (int q = 0; q < 2; ++q)
#pragma unroll
                    for (int rt = 0; rt < 4; ++rt) xacc[q][rt] = (f32x4){0.f, 0.f, 0.f, 0.f};
#pragma unroll
                for (int ks = 0; ks < 2; ++ks) {
                    float sc8[8];
                    {
                        const f32x4 b0 = *(const f32x4*)(BETA + 32 * ks + 8 * fq), b1 = *(const f32x4*)(BETA + 32 * ks + 8 * fq + 4);
                        const f32x4 e0 = *(const f32x4*)(EG + 32 * ks + 8 * fq), e1 = *(const f32x4*)(EG + 32 * ks + 8 * fq + 4);
#pragma unroll
                        for (int e = 0; e < 4; ++e) { sc8[e] = isw ? b0[e] * e0[e] : b0[e]; sc8[4 + e] = isw ? b1[e] * e1[e] : b1[e]; }
                    }
#pragma unroll
                    for (int q = 0; q < 2; ++q) {
                        const int cc = ((2 * wave + q) & 7) * 16 + fr;
                        const float* src = QKVf + ((isw ? 64 : 128) + 32 * ks + 8 * fq) * QST + cc;
                        float v[8];
#pragma unroll
                        for (int e = 0; e < 8; ++e) v[e] = src[e * QST] * sc8[e];
                        u32x4 hq; hq.x = pk2(v[0], v[1]); hq.y = pk2(v[2], v[3]); hq.z = pk2(v[4], v[5]); hq.w = pk2(v[6], v[7]);
                        u32x4 lq; lq.x = pk2(v[0] - bflo(hq.x), v[1] - bfhi(hq.x)); lq.y = pk2(v[2] - bflo(hq.y), v[3] - bfhi(hq.y));
                        lq.z = pk2(v[4] - bflo(hq.z), v[5] - bfhi(hq.z)); lq.w = pk2(v[6] - bflo(hq.w), v[7] - bfhi(hq.w));
                        const bf16x8 Bh = __builtin_bit_cast(bf16x8, hq), Bl = __builtin_bit_cast(bf16x8, lq);
#pragma unroll
                        for (int rt = 0; rt < 4; ++rt) {
                            xacc[q][rt] = MFMA16(Ah[rt][ks], Bh, xacc[q][rt]);
                            xacc[q][rt] = MFMA16(Al[rt][ks], Bh, xacc[q][rt]);
                            xacc[q][rt] = MFMA16(Ah[rt][ks], Bl, xacc[q][rt]);
                        }
                    }
                }
                if (!isw) {
                    float* Uc = (float*)(ip + 57344);
#pragma unroll
                    for (int q = 0; q < 2; ++q)
#pragma unroll
                        for (int rt = 0; rt < 4; ++rt) *(f32x4*)(Uc + (size_t)((((2 * wave + q) * 4 + rt) * 64 + lane) * 4)) = xacc[q][rt];
                } else {
#pragma unroll
                    for (int q = 0; q < 2; ++q)
#pragma unroll
                        for (int rt = 0; rt < 4; ++rt)
#pragma unroll
                            for (int j = 0; j < 4; ++j) WSI[(16 * rt + 4 * fq + j) * NST + ((2 * wave + q) & 7) * 16 + fr] = f2bf(xacc[q][rt][j]);
                }
            }
        }
        lds_barrier();
        {
            bf16_t* Wf = (bf16_t*)ip; bf16_t* QKf = (bf16_t*)(ip + 49152);
#pragma unroll
            for (int i2 = 0; i2 < 2; ++i2) {
                const int f = tid + 512 * i2, ln = f & 63, ks = (f >> 6) & 3, rt = f >> 8, i = 16 * rt + (ln & 15), fq_ = ln >> 4;
                const u32x2 lo = *(const u32x2*)(WSI + i * NST + 32 * ks + 4 * fq_), hi = *(const u32x2*)(WSI + i * NST + 32 * ks + 16 + 4 * fq_);
                *(u32x4*)(Wf + (size_t)f * 8) = (u32x4){lo.x, lo.y, hi.x, hi.y};
            }
            {
                const int f = tid, ln = f & 63, ks2 = (f >> 6) & 1, rt = f >> 7, i = 16 * rt + (ln & 15), fq_ = ln >> 4;
                const u32x2 lo = *(const u32x2*)(QKS + i * QKST + 32 * ks2 + 4 * fq_), hi = *(const u32x2*)(QKS + i * QKST + 32 * ks2 + 16 + 4 * fq_);
                *(u32x4*)(QKf + (size_t)f * 8) = (u32x4){lo.x, lo.y, hi.x, hi.y};
            }
        }
    lds_barrier();
}

DI void gdn_prep_phase(const Params& p) {
    unsigned char* ws = p.ws;
    for (int r = blockIdx.x; r < MS; r += gridDim.x) {
        const int tid = opaque_tid(), b = r >> 5, t = r & 31, pos = PAST + t;
        const float* cs = (const float*)(ws + WS_CS1) + (size_t)r * NH1;
        if (t >= TS - 3) { for (int c = tid; c < 1536; c += 512) p.out[O_CQS + (size_t)(b * 3 + t - (TS - 3)) * 1536 + c] = cs[c]; }
        {
            const int which = tid >> 8, pr = tid & 255, hd = pr >> 6, mp = (pr >> 5) & 1, d = pr & 31, col = hd * 128 + mp * 64 + d;
            const float2 csn = ((const float2*)(ws + WS_ROPE))[pos * 32 + d];
            const float x1 = cs[2048 + which * 512 + col], x2 = cs[2048 + which * 512 + col + 32];
            const float y1 = x1 * csn.x - x2 * csn.y, y2 = x2 * csn.x + x1 * csn.y;
            if (which == 0) { const float qs = 0.125f * 1.4426950408889634f; bf16_t* QB = (bf16_t*)(ws + WS_R4) + ((size_t)MP + r) * 512; QB[col] = f2bf(y1 * qs); QB[col + 32] = f2bf(y2 * qs); }
            else { float* ko = p.out + O_KS + (size_t)r * 512; ko[col] = y1; ko[col + 32] = y2;
                   bf16_t* kk = (bf16_t*)(ws + WS_R5) + ((size_t)MP + (size_t)b * TKS + pos) * 512; kk[col] = f2bf(y1); kk[col + 32] = f2bf(y2); }
        }
        {
            const float vv = cs[3072 + tid];
            p.out[O_VS + (size_t)r * 512 + tid] = vv;
            ((bf16_t*)(ws + WS_R6))[VT_S_OFF + ((size_t)((b * 4 + (tid >> 7)) * 128 + (tid & 127)) * TKS + pos)] = f2bf(vv);
        }
    }
    float cw[3][4];
    gdn_conv_weights(p, blockIdx.x & 3, cw);
    {
        const int when = blockIdx.x & 7; int k = 0;
#pragma unroll 1
        for (int item = blockIdx.x; item < 2048; item += gridDim.x, ++k) { if (k == when) prep_stream(p); gdn_prep_item(p, item, cw); }
    }
}

constexpr int OPB_B = 57344, L_OBUF = 2 * OPB_B, OST = 132;
static_assert(L_OBUF + 64 * OST * 4 <= LDS_BYTES, "scan LDS");
DI void gdn_scan(const Params& p, const bool samp, const int b, const int h) {
    unsigned char* ws = p.ws;
    const int tid = threadIdx.x, lane = tid & 63, w = __builtin_amdgcn_readfirstlane(tid >> 6), fr = lane & 15, fq = lane >> 4;
    const int nsteps = samp ? 1 : 128, valid = samp ? TS : 64;
    float* OBUF = (float*)(dyn_smem + L_OBUF);
    const bf16_t* HG = (const bf16_t*)(ws + WS_R3);
    bf16_t* OMIX = (bf16_t*)(ws + WS_R2);
    const float* DL = (const float*)(ws + WS_DL);
    f32x4 S[8];
#pragma unroll
    for (int dt = 0; dt < 8; ++dt) {
        if (samp) {
#pragma unroll
            for (int j = 0; j < 4; ++j) S[dt][j] = p.state_gdn[((size_t)(b * 4 + h) * 128 + 16 * dt + 4 * fq + j) * 128 + 16 * w + fr];
        } else S[dt] = (f32x4){0.f, 0.f, 0.f, 0.f};
    }
    const int item0 = samp ? 2048 + b * 4 + h : b * 512 + h;
    lds_barrier();
    {
        const unsigned char* ip = ws + WS_R1 + (size_t)item0 * ITEM_B;
#pragma unroll
        for (int i = 0; i < 7; ++i) *(u32x4*)(dyn_smem + (tid + 512 * i) * 16) = *(const u32x4*)(ip + (tid + 512 * i) * 16);
    }
    lds_barrier();
    const int erow = tid >> 3, ept = tid & 7;
    float nw[16];
#pragma unroll
    for (int e = 0; e < 16; ++e) nw[e] = p.gdn_norm_w[16 * ept + e];
    f32x4 U[4]; float dl; u32x4 g0, g1;
    auto side_load = [&](int c, f32x4 (&Uo)[4], float& dlo, u32x4& go0, u32x4& go1) {
        const int item = item0 + 4 * c;
        const float* Uc = (const float*)(ws + WS_R1 + (size_t)item * ITEM_B + 57344);
#pragma unroll
        for (int rt = 0; rt < 4; ++rt) Uo[rt] = *(const f32x4*)(Uc + ((w * 4 + rt) * 64 + lane) * 4);
        dlo = DL[item];
        const size_t grow = (samp ? (size_t)MP + b * TS : (size_t)b * TP + (size_t)c * 64) + erow;
        if (!samp) { go0 = *(const u32x4*)(HG + grow * 512 + h * 128 + 16 * ept); go1 = *(const u32x4*)(HG + grow * 512 + h * 128 + 16 * ept + 8); }
        else if (erow < TS) { const float* gp = (const float*)(ws + WS_CS1) + (grow - MP) * NH1 + 1536 + h * 128 + 16 * ept;
               const f32x4 f0 = *(const f32x4*)gp, f1 = *(const f32x4*)(gp + 4), f2 = *(const f32x4*)(gp + 8), f3 = *(const f32x4*)(gp + 12);
               go0 = (u32x4){pk2(f0.x, f0.y), pk2(f0.z, f0.w), pk2(f1.x, f1.y), pk2(f1.z, f1.w)}; go1 = (u32x4){pk2(f2.x, f2.y), pk2(f2.z, f2.w), pk2(f3.x, f3.y), pk2(f3.z, f3.w)}; }
        else { go0 = (u32x4){0u, 0u, 0u, 0u}; go1 = go0; }
    };
    side_load(0, U, dl, g0, g1);
#pragma unroll 1
    for (int c = 0; c < nsteps; ++c) {
        const int item = item0 + 4 * c;
        const unsigned char* ip = ws + WS_R1 + (size_t)item * ITEM_B;
        const bool nxt = c + 1 < nsteps;
        u32x4 pf[7];
        f32x4 Un[4]; float dln = 0.f; u32x4 gn0 = g0, gn1 = g1;
        if (nxt) {
#pragma unroll
            for (int i = 0; i < 7; ++i) pf[i] = *(const u32x4*)(ip + 4 * (size_t)ITEM_B + (tid + 512 * i) * 16);
            side_load(c + 1, Un, dln, gn0, gn1);
        }
        const unsigned char* buf = dyn_smem + (c & 1) * OPB_B;
        bf16x8 Sb[4];
#pragma unroll
        for (int ks = 0; ks < 4; ++ks) Sb[ks] = pack8(S[2 * ks], S[2 * ks + 1]);
        f32x4 vn[4];
#pragma unroll
        for (int rt = 0; rt < 4; ++rt) {
            f32x4 acc = (f32x4){0.f, 0.f, 0.f, 0.f};
#pragma unroll
            for (int ks = 0; ks < 4; ++ks) acc = MFMA16(*(const bf16x8*)(buf + ((rt * 4 + ks) * 64 + lane) * 16), Sb[ks], acc);
            vn[rt] = U[rt] - acc;
        }
        bf16x8 Vb[2];
        Vb[0] = pack8(vn[0], vn[1]); Vb[1] = pack8(vn[2], vn[3]);
#pragma unroll
        for (int rt = 0; rt < 4; ++rt) {
            f32x4 acc = (f32x4){0.f, 0.f, 0.f, 0.f};
#pragma unroll
            for (int ks = 0; ks < 4; ++ks) acc = MFMA16(*(const bf16x8*)(buf + 16384 + ((rt * 4 + ks) * 64 + lane) * 16), Sb[ks], acc);
#pragma unroll
            for (int ks2 = 0; ks2 < 2; ++ks2) acc = MFMA16(*(const bf16x8*)(buf + 49152 + ((rt * 2 + ks2) * 64 + lane) * 16), Vb[ks2], acc);
#pragma unroll
            for (int j = 0; j < 4; ++j) OBUF[(16 * rt + 4 * fq + j) * OST + 16 * w + fr] = acc[j];
        }
#pragma unroll
        for (int dt = 0; dt < 8; ++dt) {
            f32x4 acc = S[dt] * dl;
#pragma unroll
            for (int ks2 = 0; ks2 < 2; ++ks2) acc = MFMA16(*(const bf16x8*)(buf + 32768 + ((dt * 2 + ks2) * 64 + lane) * 16), Vb[ks2], acc);
            S[dt] = acc;
        }
        if (nxt) {
#pragma unroll
            for (int i = 0; i < 7; ++i) *(u32x4*)(dyn_smem + ((c + 1) & 1) * OPB_B + (tid + 512 * i) * 16) = pf[i];
        }
        lds_barrier();
        {
            float o[16]; float ss = 0.f;
#pragma unroll
            for (int e4 = 0; e4 < 4; ++e4) { const f32x4 a = *(const f32x4*)(OBUF + erow * OST + 16 * ept + 4 * e4);
#pragma unroll
                for (int e = 0; e < 4; ++e) { o[4 * e4 + e] = a[e]; ss += a[e] * a[e]; } }
#pragma unroll
            for (int of = 1; of < 8; of <<= 1) ss += __shfl_xor(ss, of);
            if (erow < valid) {
                const float r = rsqrtf(ss * (1.f / 128.f) + 1e-6f);
                const size_t grow = (samp ? (size_t)MP + b * TS : (size_t)b * TP + (size_t)c * 64) + erow;
                const unsigned gw[8] = {g0.x, g0.y, g0.z, g0.w, g1.x, g1.y, g1.z, g1.w};
                unsigned ow[8];
#pragma unroll
                for (int e = 0; e < 8; ++e) {
                    const float ga = bflo(gw[e]), gb = bfhi(gw[e]);
                    ow[e] = pk2(o[2 * e] * r * nw[2 * e] * silu(ga), o[2 * e + 1] * r * nw[2 * e + 1] * silu(gb));
                }
                *(u32x4*)(OMIX + grow * 1024 + h * 128 + 16 * ept) = (u32x4){ow[0], ow[1], ow[2], ow[3]};
                *(u32x4*)(OMIX + grow * 1024 + h * 128 + 16 * ept + 8) = (u32x4){ow[4], ow[5], ow[6], ow[7]};
            }
        }
        lds_barrier();
#pragma unroll
        for (int rt = 0; rt < 4; ++rt) U[rt] = Un[rt];
        dl = dln; g0 = gn0; g1 = gn1;
    }
    float* So = p.out + (samp ? O_GS : O_GP) + (size_t)(b * 4 + h) * 128 * 128;
#pragma unroll
    for (int dt = 0; dt < 8; ++dt)
#pragma unroll
        for (int j = 0; j < 4; ++j) So[(size_t)(16 * dt + 4 * fq + j) * 128 + 16 * w + fr] = S[dt][j];
}

constexpr int L_KT = 0, L_VT = 2 * 16384, L_ALX = L_VT + 3 * 16384, L_IDX = L_ALX + 8 * 2 * 32 * 4, L_QF = L_IDX + 256;
static_assert(L_QF + 8 * 8 * 1024 <= LDS_BYTES, "attn LDS");
DI int crow32(int i, int hh) { return (i & 3) + 8 * (i >> 2) + 4 * hh; }

DI void attn_item(const Params& p, const int idx, const float* lamp) {
    unsigned char* ws = p.ws;
    const int tid = opaque_tid(), lane = tid & 63, w = __builtin_amdgcn_readfirstlane(tid >> 6), r = lane & 31, hh = lane >> 5;
    bool samp; int b, h, qb = 0, ntiles, lastw; size_t qbase, kbase; const bf16_t* vtb; int vstride; bool active;
    if (idx < 32) { samp = true; b = idx >> 2; h = idx & 3; qbase = (size_t)MP + b * TS; kbase = (size_t)MP + (size_t)b * TKS; ntiles = 65; lastw = 64; active = w == 0;
                    vtb = (const bf16_t*)(ws + WS_R6) + VT_S_OFF + (size_t)((b * 4 + h) * 128) * TKS; vstride = TKS; }
    else { const int j = idx - 32; samp = false; qb = 31 - (j >> 4); b = (j & 15) >> 2; h = j & 3; qbase = (size_t)b * TP + qb * 256; kbase = (size_t)b * TP; ntiles = 4 * qb + 4; lastw = 4 * qb + (w >> 1); active = true;
           vtb = (const bf16_t*)(ws + WS_R6) + (size_t)((b * 4 + h) * 128) * TP; vstride = TP; }
    const bf16_t* KALL = (const bf16_t*)(ws + WS_R5) + kbase * 512 + h * 128;
    bf16_t* QF = (bf16_t*)(dyn_smem + L_QF) + w * 8 * 64 * 8;
    {
        const bf16_t* qp = (const bf16_t*)(ws + WS_R4) + (qbase + 32 * w + r) * 512 + h * 128 + 8 * hh;
        if (active) {
#pragma unroll
            for (int f = 0; f < 8; ++f) *(u32x4*)(QF + (f * 64 + lane) * 8) = *(const u32x4*)(qp + (f >> 2) * 64 + 16 * (f & 3));
        }
    }
    f32x16 O1[4], O2[4];
#pragma unroll
    for (int t = 0; t < 4; ++t)
#pragma unroll
        for (int i = 0; i < 16; ++i) { O1[t][i] = 0.f; O2[t][i] = 0.f; }
    float m1 = -1e30f, m2 = -1e30f, l1 = 0.f, l2 = 0.f;
    auto stage_tile = [&](int kt_, int buf_, int vbuf_) {
        int ln = lane; asm volatile("" : "+v"(ln));
        const int krow_ = ln >> 4, vrow_ = ln >> 3;
        const unsigned kx = (ln & 15) ^ krow_, vx = (ln & 7) ^ (vrow_ >> 1);
        const unsigned klane = krow_ * 512, vlane = vrow_ * vstride;
#pragma unroll
        for (int j = 0; j < 2; ++j) {
            const int i = 2 * w + j;
            const bf16_t* kbase = KALL + ((size_t)kt_ * 64 + (((4 * i) & ~12) | (((4 * i) & 4) << 1) | (((4 * i) & 8) >> 1))) * 512;
            const bf16_t* vbase = vtb + (size_t)(8 * i) * vstride + (size_t)kt_ * 64;
            const unsigned ko = klane + ((kx ^ ((4 * i) & 15)) * 8), vo = vlane + ((vx ^ ((4 * i) & 7)) * 8);
            __builtin_amdgcn_global_load_lds((const unsigned*)(kbase + ko), (unsigned*)(dyn_smem + L_KT + buf_ * 16384 + i * 1024 + ln * 16), 16, 0, 0);
            __builtin_amdgcn_global_load_lds((const unsigned*)(vbase + vo), (unsigned*)(dyn_smem + L_VT + vbuf_ * 16384 + i * 1024 + ln * 16), 16, 0, 0);
        }
    };
    const int ky = hh ^ (r & 15), vzh = ((r >> 1) & 7) ^ hh;
    __syncthreads();
    stage_tile(0, 0, 0);
    asm volatile("s_waitcnt vmcnt(0)" ::: "memory");
    __syncthreads();
    if (active) {
#pragma unroll
        for (int mp = 0; mp < 2; ++mp) {
            float mx = -1e30f;
#pragma unroll
            for (int sub = 0; sub < 2; ++sub) {
                f32x16 sc;
#pragma unroll
                for (int i = 0; i < 16; ++i) sc[i] = 0.f;
#pragma unroll
                for (int s = 0; s < 4; ++s) {
                    const bf16x8 ka = *(const bf16x8*)(dyn_smem + L_KT + (sub * 32 + r) * 256 + (((mp * 8 + 2 * s) ^ ky) * 16));
                    const bf16x8 qf = *(const bf16x8*)(QF + ((mp * 4 + s) * 64 + lane) * 8);
                    sc = MFMA32(ka, qf, sc);
                }
#pragma unroll
                for (int i = 0; i < 16; ++i) mx = fmaxf(mx, sc[i]);
            }
            const auto sw = __builtin_amdgcn_permlane32_swap(__float_as_uint(mx), __float_as_uint(mx), false, false);
            mx = fmaxf(__uint_as_float(sw[0]), __uint_as_float(sw[1]));
            if (mp == 0) m1 = mx; else m2 = mx;
        }
    }
    const bool roleY = w >= 4;
    bf16x8 PA[2], PB[2];
    float tm1 = -1e30f, tm2 = -1e30f;
    int vcur = 0, vprev = 2;
#define ATT_QK(SUB, MP, SC) do { \
        _Pragma("unroll") for (int s_ = 0; s_ < 4; ++s_) { \
            const bf16x8 ka_ = *(const bf16x8*)(Kb + (SUB) * 32 * 256 + ((((MP) * 8 + 2 * s_) ^ ky) * 16)); \
            const bf16x8 qf_ = *(const bf16x8*)(QF + (((MP) * 4 + s_) * 64 + lane) * 8); \
            SC = MFMA32(ka_, qf_, s_ == 0 ? zero16 : SC); } } while (0)
#define ATT_SM(SC, P, MM, LL, TM, MSK) do { \
        float ps_ = 0.f, tq_ = TM; const float mr_ = MM + MSK; \
        _Pragma("unroll") for (int i_ = 0; i_ < 16; ++i_) { tq_ = fmaxf(tq_, SC[i_]); SC[i_] = __builtin_amdgcn_exp2f(SC[i_] - mr_); ps_ += SC[i_]; } \
        TM = MSK != 0.f ? TM : tq_; \
        LL += ps_; \
        _Pragma("unroll") for (int sp_ = 0; sp_ < 2; ++sp_) { \
            u32x4 a_; a_.x = pk2(SC[8 * sp_], SC[8 * sp_ + 1]); a_.y = pk2(SC[8 * sp_ + 2], SC[8 * sp_ + 3]); a_.z = pk2(SC[8 * sp_ + 4], SC[8 * sp_ + 5]); a_.w = pk2(SC[8 * sp_ + 6], SC[8 * sp_ + 7]); \
            P[sp_] = __builtin_bit_cast(bf16x8, a_); } } while (0)
#define ATT_PV2(VB, SUB, P1, P2) do { \
        _Pragma("unroll") for (int sp_ = 0; sp_ < 2; ++sp_) \
            _Pragma("unroll") for (int t_ = 0; t_ < 4; ++t_) { \
                const bf16x8 vb_ = *(const bf16x8*)((VB) + t_ * 32 * 128 + (((4 * (SUB) + 2 * sp_) ^ vzh) * 16)); \
                O1[t_] = MFMA32(P1[sp_], vb_, O1[t_]); O2[t_] = MFMA32(P2[sp_], vb_, O2[t_]); } } while (0)
#define ATT_QS(SUB, MSK) do { \
        f32x16 scA, scB; \
        ATT_QK(SUB, 0, scA); \
        __builtin_amdgcn_sched_barrier(0); \
        ATT_QK(SUB, 1, scB); \
        ATT_SM(scA, PA, m1, l1, tm1, MSK); \
        __builtin_amdgcn_sched_barrier(0); \
        ATT_SM(scB, PB, m2, l2, tm2, MSK); \
        __builtin_amdgcn_sched_barrier(0); } while (0)
#define ATT_CHECK() do { \
        const auto s1_ = __builtin_amdgcn_permlane32_swap(__float_as_uint(tm1), __float_as_uint(tm1), false, false); tm1 = fmaxf(__uint_as_float(s1_[0]), __uint_as_float(s1_[1])); \
        const auto s2_ = __builtin_amdgcn_permlane32_swap(__float_as_uint(tm2), __float_as_uint(tm2), false, false); tm2 = fmaxf(__uint_as_float(s2_[0]), __uint_as_float(s2_[1])); \
        const float n1 = tm1 > m1 + 8.f ? tm1 : m1, n2 = tm2 > m2 + 8.f ? tm2 : m2; \
        if (__any((n1 != m1) || (n2 != m2))) { \
            const float al1 = __builtin_amdgcn_exp2f(m1 - n1), al2 = __builtin_amdgcn_exp2f(m2 - n2); \
            l1 *= al1; l2 *= al2; m1 = n1; m2 = n2; \
            const int ln_ = __builtin_amdgcn_mbcnt_hi(~0u, __builtin_amdgcn_mbcnt_lo(~0u, 0u)), r_ = ln_ & 31, hh_ = ln_ >> 5; \
            float* alx_ = (float*)(dyn_smem + L_ALX) + w * 64; \
            if (hh_ == 0) { alx_[r_] = al1; alx_[32 + r_] = al2; } \
            asm volatile("s_waitcnt lgkmcnt(0)" ::: "memory"); \
            _Pragma("unroll") for (int g = 0; g < 4; ++g) { \
                const f32x4 a1 = *(const f32x4*)(alx_ + 8 * g + 4 * hh_), a2 = *(const f32x4*)(alx_ + 32 + 8 * g + 4 * hh_); \
                _Pragma("unroll") for (int t = 0; t < 4; ++t) \
                    _Pragma("unroll") for (int j = 0; j < 4; ++j) { O1[t][4 * g + j] *= a1[j]; O2[t][4 * g + j] *= a2[j]; } } \
            asm volatile("s_waitcnt lgkmcnt(0)" ::: "memory"); } \
        tm1 = -1e30f; tm2 = -1e30f; } while (0)
    f32x16 zero16;
#pragma unroll
    for (int i = 0; i < 16; ++i) zero16[i] = 0.f;
    if (!roleY) {
#pragma unroll 1
        for (int kt = 0; kt < ntiles; ++kt) {
            const int vnext = vcur == 2 ? 0 : vcur + 1;
            if (kt + 1 < ntiles) stage_tile(kt + 1, (kt + 1) & 1, vnext);
            const unsigned char* Kb = dyn_smem + L_KT + (kt & 1) * 16384 + r * 256;
            const unsigned char* Vb = dyn_smem + L_VT + vcur * 16384 + r * 128;
            if (active && kt <= lastw) {
                const float msk1 = (samp && kt == 64) ? 1e30f : 0.f;
#pragma unroll 1
                for (int sub = 0; sub < 2; ++sub) {
                    const float msk = sub ? msk1 : 0.f;
                    ATT_QS(sub, msk);
                    ATT_PV2(Vb, sub, PA, PB);
                    __builtin_amdgcn_sched_barrier(0);
                }
                ATT_CHECK();
            }
            vcur = vnext;
            asm volatile("s_waitcnt vmcnt(0)" ::: "memory");
            __builtin_amdgcn_s_barrier();
        }
    } else {
#pragma unroll 1
        for (int kt = 0; kt < ntiles; ++kt) {
            const int vnext = vcur == 2 ? 0 : vcur + 1;
            if (kt + 1 < ntiles) stage_tile(kt + 1, (kt + 1) & 1, vnext);
            const unsigned char* Kb = dyn_smem + L_KT + (kt & 1) * 16384 + r * 256;
            const unsigned char* Vb = dyn_smem + L_VT + vcur * 16384 + r * 128;
            const unsigned char* Vp = dyn_smem + L_VT + vprev * 16384 + r * 128;
            if (kt <= lastw + 1) {
                if (kt > 0) { ATT_PV2(Vp, 1, PA, PB); __builtin_amdgcn_sched_barrier(0); }
                if (kt <= lastw) {
                    ATT_CHECK();
                    ATT_QS(0, 0.f);
                    ATT_PV2(Vb, 0, PA, PB);
                    __builtin_amdgcn_sched_barrier(0);
                    ATT_QS(1, 0.f);
                }
            }
            vprev = vcur; vcur = vnext;
            asm volatile("s_waitcnt vmcnt(0)" ::: "memory");
            __builtin_amdgcn_s_barrier();
        }
        if (lastw == ntiles - 1) {
            const unsigned char* Vp = dyn_smem + L_VT + vprev * 16384 + r * 128;
            ATT_PV2(Vp, 1, PA, PB);
        }
    }
    if (active) {
        const int lnf = __builtin_amdgcn_mbcnt_hi(~0u, __builtin_amdgcn_mbcnt_lo(~0u, 0u)), r = lnf & 31, hh = lnf >> 5;
        float* ALX = (float*)(dyn_smem + L_ALX) + w * 64;
        { const auto s1_ = __builtin_amdgcn_permlane32_swap(__float_as_uint(l1), __float_as_uint(l1), false, false); l1 = __uint_as_float(s1_[0]) + __uint_as_float(s1_[1]);
          const auto s2_ = __builtin_amdgcn_permlane32_swap(__float_as_uint(l2), __float_as_uint(l2), false, false); l2 = __uint_as_float(s2_[0]) + __uint_as_float(s2_[1]); }
        if (hh == 0) { ALX[r] = __builtin_amdgcn_rcpf(l1); ALX[32 + r] = *lamp * __builtin_amdgcn_rcpf(l2); }
        asm volatile("s_waitcnt lgkmcnt(0)" ::: "memory");
        float ss[16], a1[16], a2[16];
#pragma unroll
        for (int g = 0; g < 4; ++g) {
            const f32x4 x1 = *(const f32x4*)(ALX + 8 * g + 4 * hh), x2 = *(const f32x4*)(ALX + 32 + 8 * g + 4 * hh);
#pragma unroll
            for (int j = 0; j < 4; ++j) { a1[4 * g + j] = x1[j]; a2[4 * g + j] = x2[j]; ss[4 * g + j] = 0.f; }
        }
#pragma unroll
        for (int t = 0; t < 4; ++t) {
            __builtin_amdgcn_sched_barrier(0);
#pragma unroll
            for (int i = 0; i < 16; ++i) { const float o = O1[t][i] * a1[i] - O2[t][i] * a2[i]; O1[t][i] = o; ss[i] += o * o; }
        }
        __builtin_amdgcn_sched_barrier(0);
#pragma unroll
        for (int i = 0; i < 16; ++i) {
#pragma unroll
            for (int of = 1; of < 32; of <<= 1) ss[i] += __shfl_xor(ss[i], of);
            ss[i] = __builtin_amdgcn_rsqf(ss[i] * (1.f / 128.f) + 1e-6f) * (1.f - LAM_INIT);
        }
        int zo = 0; asm volatile("" : "+v"(zo));
        bf16_t* obase = (bf16_t*)(ws + WS_R2) + (qbase + 32 * w) * 1024 + 512 + h * 128;
        const unsigned ooff = (unsigned)((4 * hh + zo) * 1024 + r);
        const float* sw = p.subln_w + r + zo;
#pragma unroll
        for (int t = 0; t < 4; ++t) {
            const float wv = sw[32 * t];
#pragma unroll
            for (int i = 0; i < 16; ++i) obase[ooff + ((i & 3) + 8 * (i >> 2)) * 1024 + 32 * t] = f2bf(O1[t][i] * ss[i] * wv);
        }
    }
}

DI void mixer_phase(const Params& p) {
    const int bid = blockIdx.x;
#ifndef NO_SCAN
    if (bid >= 16 && bid < 48) {
        float cw[3][4];
        gdn_conv_weights(p, (bid - 16) & 3, cw);
        gdn_prep_item(p, 2048 + bid - 16, cw);
        asm volatile("s_waitcnt vmcnt(0)" ::: "memory");
        __builtin_amdgcn_fence(__ATOMIC_ACQUIRE, "agent");
        asm volatile("s_waitcnt vmcnt(0)" ::: "memory");
        __syncthreads();
    }
    if (bid < 48) { const bool sm = bid >= 16; const int j = sm ? bid - 16 : bid;
#pragma unroll 1
        for (int rep = 0; rep < SREP; ++rep) gdn_scan(p, sm, j >> 2, j & 3); }
#endif
    unsigned* ctl = (unsigned*)(p.ws + WS_CTL);
    int* sidx = (int*)(dyn_smem + L_IDX);
    for (;;) {
        __syncthreads();
        if (threadIdx.x == 0) *sidx = (int)atomicAdd(ctl, 1u);
        __syncthreads();
        const int idx0 = __builtin_amdgcn_readfirstlane(*sidx);
        if (idx0 >= (32 + 512) * AREP) break;
        const int idx = idx0 % (32 + 512);
#ifndef NO_ATTN
        attn_item(p, idx, (const float*)ctl + 1);
#endif
    }
}


#define XB_TMO      128
#define XB_XCNT(j)  (256  + 64 * (j))
#define XB_XSUB(j)  (1280 + 64 * (j))
#define XB_XGEN(j)  (2304 + 64 * (j))
#define XB_TOP      3328
#define XB_TOPGEN   3392
#define XCD_BAR_WORDS 3456
#define XB_SPIN_CAP (1u << 20)
#define LAS __attribute__((address_space(3)))
DI unsigned xb_ld(unsigned* p) { return __hip_atomic_load(p, __ATOMIC_RELAXED, __HIP_MEMORY_SCOPE_AGENT); }
DI unsigned xb_add(unsigned* p, unsigned v) { return __hip_atomic_fetch_add(p, v, __ATOMIC_RELAXED, __HIP_MEMORY_SCOPE_AGENT); }
DI unsigned xb_xcc_id() { return (unsigned)__builtin_amdgcn_s_getreg((3 << 11) | 20) & 0xFu; }
#define XB_SPIN(cond, bar) do { unsigned _sp = 0; while (cond) { __builtin_amdgcn_s_sleep(1); \
    if ((++_sp & 255u) == 0u) { if (xb_ld(&(bar)[XB_TMO])) break; if (_sp > XB_SPIN_CAP) { atomicAdd(&(bar)[XB_TMO], 1u); break; } } } } while (0)
struct XcdBarrier { unsigned* bar; unsigned x; volatile LAS unsigned* st; };
DI XcdBarrier xcd_barrier_post(unsigned* bar, volatile LAS unsigned* st) {
    XcdBarrier b; b.bar = bar; b.x = xb_xcc_id(); b.st = st;
    if (threadIdx.x == 0) (void)xb_add(&bar[XB_XCNT(b.x)], 1u);
    return b;
}
DI void xcd_barrier_complete(unsigned* bar, unsigned x, unsigned& nloc, unsigned& nx) {
    const unsigned G = gridDim.x * gridDim.y * gridDim.z;
    unsigned sum, cnt, mine, sp = 0u;
    for (;;) {
        sum = 0u; cnt = 0u; mine = 0u;
#pragma unroll
        for (unsigned j = 0; j < 16; ++j) { const unsigned c = xb_ld(&bar[XB_XCNT(j)]); sum += c; cnt += (c > 0u) ? 1u : 0u; mine = (j == x) ? c : mine; }
        if (sum == G) break;
        __builtin_amdgcn_s_sleep(1);
        if ((++sp & 255u) == 0u) { if (xb_ld(&bar[XB_TMO])) break; if (sp > XB_SPIN_CAP) { atomicAdd(&bar[XB_TMO], 1u); break; } }
    }
    nloc = mine > 0u ? mine : 1u; nx = cnt > 0u ? cnt : 1u;
}
DI void xcd_barrier(const XcdBarrier& b) {
    asm volatile("s_waitcnt vmcnt(0)" ::: "memory");
    __syncthreads();
    if (threadIdx.x == 0) {
        unsigned* bar = b.bar;
        __builtin_amdgcn_s_waitcnt(0);
        unsigned nloc = b.st[0], nx = b.st[1];
        if (nloc == 0u) { xcd_barrier_complete(bar, b.x, nloc, nx); b.st[0] = nloc; b.st[1] = nx; }
        const unsigned old = xb_add(&bar[XB_XSUB(b.x)], 1u);
        const unsigned gen = old / nloc;
        if (old + 1u == (gen + 1u) * nloc) {
            __builtin_amdgcn_fence(__ATOMIC_RELEASE, "agent");
            asm volatile("s_waitcnt vmcnt(0)" ::: "memory");
            const unsigned og = xb_add(&bar[XB_TOP], 1u);
            const unsigned tg = og / nx;
            if (og + 1u == (tg + 1u) * nx) xb_add(&bar[XB_TOPGEN], 1u);
            else XB_SPIN(xb_ld(&bar[XB_TOPGEN]) == tg, bar);
            __builtin_amdgcn_fence(__ATOMIC_ACQUIRE, "agent");
            xb_add(&bar[XB_XGEN(b.x)], 1u);
            asm volatile("s_waitcnt vmcnt(0)" ::: "memory");
        } else {
            XB_SPIN(xb_ld(&bar[XB_XGEN(b.x)]) == gen, bar);
            __builtin_amdgcn_fence(__ATOMIC_ACQUIRE, "agent");
            asm volatile("s_waitcnt vmcnt(0)" ::: "memory");
        }
    }
    __syncthreads();
}

__global__ void __launch_bounds__(512, 2) fwd_kernel(Params p) {
    cg::grid_group grid = cg::this_grid();
    volatile LAS unsigned* xst = (volatile LAS unsigned*)(dyn_smem + LDS_BYTES - 16);
    if (threadIdx.x == 0) { xst[0] = 0u; xst[1] = 0u; }
    __syncthreads();
    const XcdBarrier xb = xcd_barrier_post((unsigned*)(p.ws + WS_BAR), xst);
    if (p.phase_lo > 1000) grid.sync();
    const bool all = p.phase_hi - p.phase_lo > 1;
#define PHASE(i, body) if (p.phase_lo <= (i) && (i) < p.phase_hi) { body; if (all && (i) + 1 < p.phase_hi) xcd_barrier(xb); }
    PHASE(0, phase_prep(p))
    PHASE(1, gemm_phase<1>(p))
    PHASE(2, gdn_prep_phase(p))
    PHASE(3, mixer_phase(p))
    PHASE(4, gemm_phase<2>(p))
    PHASE(5, ln_phase<0>(p))
    PHASE(6, gemm_phase<3>(p))
    PHASE(7, fixup_phase(p))
    PHASE(8, gemm_phase<4>(p))
    PHASE(9, ln_phase<1>(p))
}

extern "C" void kernel_launch(void* const* d_in, const int* in_sizes, int n_in, void* d_out, int out_size, void* d_ws, size_t ws_size, hipStream_t stream) {
    static int grid = 0;
    if (grid == 0) {
        if (n_in != 23 || (size_t)out_size != O_END || ws_size < WS_END2) { fprintf(stderr, "kernel_launch: unexpected sizes n_in %d out %d ws %zu (need %zu)\n", n_in, out_size, ws_size, (size_t)WS_END2); grid = -1; return; }
        int dev = 0, cus = 0, per_cu = 0;
        hipGetDevice(&dev);
        hipDeviceGetAttribute(&cus, hipDeviceAttributeMultiprocessorCount, dev);
        if (hipFuncSetAttribute((const void*)fwd_kernel, hipFuncAttributeMaxDynamicSharedMemorySize, LDS_BYTES) != hipSuccess) { fprintf(stderr, "kernel_launch: hipFuncSetAttribute failed\n"); grid = -1; return; }
        hipOccupancyMaxActiveBlocksPerMultiprocessor(&per_cu, (const void*)fwd_kernel, 512, LDS_BYTES);
        if (per_cu < 1) { fprintf(stderr, "kernel_launch: occupancy query says %d\n", per_cu); per_cu = 1; }
        (void)hipGetLastError();
        grid = cus * 1;
    }
    if (grid < 0) return;
    Params p{};
    const float** f = (const float**)&p;
    for (int i = 0; i < 23; ++i) f[i] = (const float*)d_in[i];
    p.out = (float*)d_out; p.ws = (unsigned char*)d_ws; p.phase_lo = 0; p.phase_hi = 10;
    if (hipMemsetAsync((unsigned char*)d_ws + WS_BAR, 0, 16384, stream) != hipSuccess) { fprintf(stderr, "kernel_launch: memset failed\n"); return; }
    void* args[] = {&p};
    hipError_t e = hipLaunchCooperativeKernel((const void*)fwd_kernel, dim3(grid), dim3(512), args, LDS_BYTES, stream);
    if (e != hipSuccess) fprintf(stderr, "cooperative launch failed: %s (grid %d)\n", hipGetErrorString(e), grid);
}
```

```cpp
#include <hip/hip_runtime.h>
#include <hip/hip_cooperative_groups.h>
#include <cstdio>
namespace cg = cooperative_groups;
#ifndef GREP_WHICH
#define GREP_WHICH 0
#endif
#ifndef AREP
#define AREP 1
#endif
#ifndef SREP
#define SREP 1
#endif

typedef unsigned short bf16_t;
typedef short bf16x8 __attribute__((ext_vector_type(8)));
typedef short s16x4 __attribute__((ext_vector_type(4)));
typedef float f32x4 __attribute__((ext_vector_type(4)));
typedef float f32x16 __attribute__((ext_vector_type(16)));
typedef unsigned u32x4 __attribute__((ext_vector_type(4)));
typedef unsigned u32x2 __attribute__((ext_vector_type(2)));
#define DI __device__ __forceinline__

constexpr int D = 1024, TP = 8192, BP = 4, MP = BP * TP, BS = 8, TS = 32, MS = BS * TS, M = MP + MS, PAST = 4096;
constexpr int DIN = 3592, NH1 = 3584, DFF = 2816, NUP = 2 * DFF;
constexpr int TKS = 4160;
constexpr int NITEM = BP * 128 * 4 + BS * 4;
constexpr int ITEM_B = 90112;
constexpr int LDS_BYTES = 160 * 1024;
constexpr float ALPHA = 1.189207115002721f;
constexpr float LAM_INIT = 0.2f;

constexpr size_t O_Y = 0, O_KP = 33816576, O_VP = 50593792, O_GP = 67371008, O_CQP = 67633152, O_CFP = 67651584,
                 O_KS = 67696640, O_VS = 67827712, O_GS = 67958784, O_CQS = 68483072, O_CFS = 68519936, O_END = 68610048;

constexpr size_t al256(size_t x) { return (x + 255) & ~(size_t)255; }
constexpr size_t WS_CTL = 0;
constexpr size_t WS_ROPE = 4096;
constexpr size_t WS_AB = WS_ROPE + (size_t)8192 * 32 * 8;
constexpr size_t WS_DL = WS_AB + (size_t)M * 8 * 4;
constexpr size_t WS_WIN = al256(WS_DL + NITEM * 4);
constexpr size_t WS_WO = WS_WIN + (size_t)NH1 * D * 2;
constexpr size_t WS_WUP = WS_WO + (size_t)D * D * 2;
constexpr size_t WS_WDN = WS_WUP + (size_t)NUP * D * 2;
constexpr size_t WS_R1 = al256(WS_WDN + (size_t)D * DFF * 2);
constexpr size_t R1_SIZE = (size_t)NITEM * ITEM_B;
constexpr size_t WS_R2 = al256(WS_R1 + R1_SIZE);
constexpr size_t WS_R3 = al256(WS_R2 + (size_t)M * 1536 * 2);
constexpr size_t WS_R4 = WS_R3 + (size_t)M * 512 * 2;
constexpr size_t WS_R5 = al256(WS_R4 + (size_t)M * 512 * 2);
constexpr size_t KROWS = (size_t)MP + (size_t)BS * TKS;
constexpr size_t WS_R6 = al256(WS_R5 + KROWS * 512 * 2);
constexpr size_t VT_S_OFF = (size_t)BP * 4 * 128 * TP;
constexpr size_t WS_END = al256(WS_R6 + (VT_S_OFF + (size_t)BS * 4 * 128 * TKS) * 2);
constexpr size_t WS_CS1 = WS_END;
constexpr size_t WS_CS2 = WS_CS1 + (size_t)MS * NH1 * 4;
constexpr size_t WS_CS3 = WS_CS2 + (size_t)MS * D * 4;
constexpr size_t WS_CS4 = WS_CS3 + (size_t)MS * NUP * 4;
constexpr size_t WS_BAR = WS_CS4 + (size_t)MS * D * 4;
constexpr size_t WS_END2 = WS_BAR + 16384;
static_assert((size_t)M * DFF * 2 <= R1_SIZE, "GT must fit R1");
static_assert(WS_END2 <= (size_t)536870912, "workspace too large");

struct Params {
    const float *x_p, *x_s, *cache_k, *cache_v, *state_gdn, *state_cq, *state_cf;
    const float *w_in, *gdn_conv_w, *a_log, *dt_bias, *gdn_norm_w, *diff_lambda, *subln_w, *w_o, *ln1_g, *ln1_b, *w_up,
        *ffn_conv_w, *ffn_conv_b, *w_down, *ln2_g, *ln2_b;
    float* out; unsigned char* ws;
    int phase_lo, phase_hi;
};

extern __shared__ __attribute__((aligned(16))) unsigned char dyn_smem[];

typedef __bf16 bf16x2_t __attribute__((ext_vector_type(2)));
typedef float f32x2 __attribute__((ext_vector_type(2)));
DI unsigned pk2(float lo, float hi) { f32x2 v = {lo, hi}; bf16x2_t b = __builtin_convertvector(v, bf16x2_t); return __builtin_bit_cast(unsigned, b); }
DI bf16_t f2bf(float x) { return (bf16_t)(pk2(x, 0.f) & 0xffffu); }
DI float bf2f(bf16_t b) { return __uint_as_float(((unsigned)b) << 16); }
DI float bflo(unsigned u) { return __uint_as_float(u << 16); }
DI float bfhi(unsigned u) { return __uint_as_float(u & 0xffff0000u); }
DI float silu(float x) { return x * __builtin_amdgcn_rcpf(1.f + __expf(-x)); }
DI void lds_barrier() { asm volatile("s_waitcnt lgkmcnt(0)\n\ts_barrier" ::: "memory"); }
DI int opaque_tid() { int t = threadIdx.x; asm volatile("" : "+v"(t)); return t; }
DI float wave_sum(float v) {
#pragma unroll
    for (int o = 1; o < 64; o <<= 1) v += __shfl_xor(v, o);
    return v;
}
DI const float* xrow_ptr(const Params& p, int row) { return row < MP ? p.x_p + (size_t)row * D : p.x_s + (size_t)(row - MP) * D; }

template <int MODE> DI int srccol(int n) {
    if (MODE == 1) {
        if (n < 2048) return n;
        return n + 8;
    }
    if (MODE == 2) { const int pn = n >> 8, j = n & 255; return j < 128 ? 128 * pn + j : DFF + 128 * pn + (j - 128); }
    return n;
}
struct TrItem { const float* W; bf16_t* WT; int K, N, k0, n0, mode; };
DI TrItem tr_decode(const Params& p, int it) {
    constexpr int I_IN = 16 * 56, I_O = 16 * 16, I_UP = 16 * 88;
    unsigned char* ws = p.ws; TrItem t; int r = it;
    if (r < I_IN) { t.W = p.w_in; t.WT = (bf16_t*)(ws + WS_WIN); t.K = D; t.N = DIN; t.k0 = (r / 56) * 64; t.n0 = (r % 56) * 64; t.mode = 1; return t; } r -= I_IN;
    if (r < I_O) { t.W = p.w_o; t.WT = (bf16_t*)(ws + WS_WO); t.K = D; t.N = D; t.k0 = (r / 16) * 64; t.n0 = (r % 16) * 64; t.mode = 0; return t; } r -= I_O;
    if (r < I_UP) { t.W = p.w_up; t.WT = (bf16_t*)(ws + WS_WUP); t.K = D; t.N = NUP; t.k0 = (r / 88) * 64; t.n0 = (r % 88) * 64; t.mode = 2; return t; } r -= I_UP;
    t.W = p.w_down; t.WT = (bf16_t*)(ws + WS_WDN); t.K = DFF; t.N = D; t.k0 = (r / 16) * 64; t.n0 = (r % 16) * 64; t.mode = 0; return t;
}
DI void tr_load(const TrItem& t, float (&v)[8]) {
    const int tid = threadIdx.x, n = t.n0 + (tid & 63);
    const int sc = t.mode == 1 ? (n < 2048 ? n : n + 8) : (t.mode == 2 ? srccol<2>(n) : n);
#pragma unroll
    for (int i = 0; i < 8; ++i) v[i] = t.W[(size_t)(t.k0 + (tid >> 6) + 8 * i) * t.N + sc];
}
DI void transpose_range(const Params& p, const int lo, const int hi) {
    const int tid = opaque_tid(), nb = gridDim.x, bid = blockIdx.x;
    float* lds = (float*)dyn_smem;
    float v[8];
    lds_barrier();
    TrItem cur = tr_decode(p, lo + bid < hi ? lo + bid : lo);
    if (lo + bid < hi) tr_load(cur, v);
    for (int it = lo + bid; it < hi; it += nb) {
        float nv[8]; TrItem nx = cur;
        if (it + nb < hi) { nx = tr_decode(p, it + nb); tr_load(nx, nv); }
#pragma unroll
        for (int i = 0; i < 8; ++i) lds[((tid >> 6) + 8 * i) * 65 + (tid & 63)] = v[i];
        lds_barrier();
#pragma unroll
        for (int i = 0; i < 8; ++i) { const int nn = (tid >> 6) + 8 * i, kk = tid & 63; cur.WT[(size_t)(cur.n0 + nn) * cur.K + cur.k0 + kk] = f2bf(lds[kk * 65 + nn]); }
        lds_barrier();
#pragma unroll
        for (int i = 0; i < 8; ++i) v[i] = nv[i];
        cur = nx;
    }
}
DI void phase_prep(const Params& p) {
    const int tid = threadIdx.x, lane = tid & 63, wave = tid >> 6, nb = gridDim.x, bid = blockIdx.x;
    unsigned char* ws = p.ws;
    if (bid == 0 && tid < 64) {
        unsigned* ctl = (unsigned*)(ws + WS_CTL);
        float a = p.diff_lambda[lane] * p.diff_lambda[64 + lane], b = p.diff_lambda[128 + lane] * p.diff_lambda[192 + lane];
        a = wave_sum(a); b = wave_sum(b);
        if (lane == 0) { ctl[0] = 0u; ((float*)ctl)[1] = expf(a) - expf(b) + LAM_INIT; }
    }
    transpose_range(p, 0, 16 * 56);
    {
        float2* rope = (float2*)(ws + WS_ROPE);
        for (int idx = bid * 512 + tid; idx < 8192 * 32; idx += nb * 512) {
            const int pos = idx >> 5, d = idx & 31;
            const double inv = exp(-(double)d * (9.210340371976184 / 32.0));
            double a = (double)pos * inv;
            a -= 6.283185307179586 * rint(a * 0.15915494309189535);
            const float af = (float)a;
            rope[idx] = make_float2(__cosf(af), __sinf(af));
        }
    }
    {
        float* w8 = (float*)dyn_smem;
        __syncthreads();
        for (int i = tid; i < 1024 * 8; i += 512) w8[i] = p.w_in[(size_t)(i >> 3) * DIN + 2048 + (i & 7)];
        __syncthreads();
        bf16_t* XB = (bf16_t*)(ws + WS_R1);
        float* AB = (float*)(ws + WS_AB);
        f32x4 cv[4];
        {
            const int row = bid * 8 + wave;
            if (row < M) { const float* xr = xrow_ptr(p, row);
#pragma unroll
                for (int j = 0; j < 4; ++j) cv[j] = __builtin_nontemporal_load((const f32x4*)(xr + lane * 4 + 256 * j)); }
        }
        for (int row = bid * 8 + wave; row < M; row += nb * 8) {
            f32x4 nvx[4];
            if (row + nb * 8 < M) { const float* xn = xrow_ptr(p, row + nb * 8);
#pragma unroll
                for (int j = 0; j < 4; ++j) nvx[j] = __builtin_nontemporal_load((const f32x4*)(xn + lane * 4 + 256 * j)); }
            float acc[8];
#pragma unroll
            for (int c = 0; c < 8; ++c) acc[c] = 0.f;
#pragma unroll
            for (int j = 0; j < 4; ++j) {
                const int k0 = lane * 4 + 256 * j;
                const f32x4 v = cv[j];
                u32x2 o; o.x = pk2(v.x, v.y); o.y = pk2(v.z, v.w);
                *(u32x2*)(XB + (size_t)row * D + k0) = o;
#pragma unroll
                for (int e = 0; e < 4; ++e) {
                    const f32x4 wa = *(const f32x4*)(w8 + (k0 + e) * 8), wb = *(const f32x4*)(w8 + (k0 + e) * 8 + 4);
                    const float xv = v[e];
                    acc[0] += xv * wa.x; acc[1] += xv * wa.y; acc[2] += xv * wa.z; acc[3] += xv * wa.w;
                    acc[4] += xv * wb.x; acc[5] += xv * wb.y; acc[6] += xv * wb.z; acc[7] += xv * wb.w;
                }
            }
#pragma unroll
            for (int c = 0; c < 8; ++c) acc[c] = wave_sum(acc[c]);
            if (lane == 0) { *(f32x4*)(AB + (size_t)row * 8) = (f32x4){acc[0], acc[1], acc[2], acc[3]}; *(f32x4*)(AB + (size_t)row * 8 + 4) = (f32x4){acc[4], acc[5], acc[6], acc[7]}; }
#pragma unroll
            for (int j = 0; j < 4; ++j) cv[j] = nvx[j];
        }
        __syncthreads();
    }
}

DI void prep_stream(const Params& p) {
    const int tid = opaque_tid(), nb = gridDim.x, bid = blockIdx.x;
    unsigned char* ws = p.ws;
    transpose_range(p, 16 * 56, 16 * 56 + 16 * 16 + 16 * 88 + 44 * 16);
    lds_barrier();
    {
        bf16_t* KALL = (bf16_t*)(ws + WS_R5);
        const int nchunk = BS * TKS * 64;
        for (int c0 = bid * 512 + tid; c0 < nchunk; c0 += nb * 512 * 4) {
            f32x4 v0[4], v1[4]; int st[4]; size_t dsto[4];
#pragma unroll
            for (int u = 0; u < 4; ++u) {
                const int c = c0 + u * nb * 512;
                st[u] = 0;
                if (c < nchunk) {
                    const int col8 = c & 63, r = c >> 6, b = r / TKS, pp = r % TKS;
                    dsto[u] = ((size_t)MP + (size_t)b * TKS + pp) * 512 + col8 * 8;
                    if (pp < PAST) { const float* sp = p.cache_k + ((size_t)(b * PAST + pp) * 512 + col8 * 8); v0[u] = __builtin_nontemporal_load((const f32x4*)sp); v1[u] = __builtin_nontemporal_load((const f32x4*)(sp + 4)); st[u] = 1; }
                    else if (pp >= PAST + TS) st[u] = 2;
                }
            }
#pragma unroll
            for (int u = 0; u < 4; ++u) {
                if (st[u] == 1) { u32x4 o; o.x = pk2(v0[u].x, v0[u].y); o.y = pk2(v0[u].z, v0[u].w); o.z = pk2(v1[u].x, v1[u].y); o.w = pk2(v1[u].z, v1[u].w); *(u32x4*)(KALL + dsto[u]) = o; }
                else if (st[u] == 2) *(u32x4*)(KALL + dsto[u]) = (u32x4){0u, 0u, 0u, 0u};
            }
        }
    }
    {
        bf16_t* VTS = (bf16_t*)(ws + WS_R6) + VT_S_OFF;
        bf16_t* t = (bf16_t*)dyn_smem;
        f32x4 cvv[4];
        auto ldv = [&](int it, f32x4 (&v)[4]) {
            const int blk = it % 65, bh = it / 65, b = bh >> 2, h = bh & 3;
            if (blk < 64) {
#pragma unroll
                for (int i = 0; i < 4; ++i) { const int id = tid + 512 * i, key = id >> 5, c4 = id & 31;
                    v[i] = __builtin_nontemporal_load((const f32x4*)(p.cache_v + ((size_t)(b * PAST + blk * 64 + key) * 512 + h * 128 + c4 * 4))); }
            }
        };
        if (bid < BS * 4 * 65) ldv(bid, cvv);
        for (int it = bid; it < BS * 4 * 65; it += nb) {
            const int blk = it % 65, bh = it / 65;
            f32x4 nvv[4];
            if (it + nb < BS * 4 * 65) ldv(it + nb, nvv);
            if (blk < 64) {
                lds_barrier();
#pragma unroll
                for (int i = 0; i < 4; ++i) {
                    const int id = tid + 512 * i, key = id >> 5, c4 = id & 31;
                    const f32x4 v = cvv[i];
                    bf16_t* d = t + key * 130 + c4 * 4;
                    *(unsigned*)d = pk2(v.x, v.y); *(unsigned*)(d + 2) = pk2(v.z, v.w);
                }
                lds_barrier();
                const int dv = tid >> 2, part = tid & 3;
                unsigned o[8];
#pragma unroll
                for (int i = 0; i < 8; ++i) { const int k0 = part * 16 + 2 * i; o[i] = (unsigned)t[k0 * 130 + dv] | ((unsigned)t[(k0 + 1) * 130 + dv] << 16); }
                bf16_t* dst = VTS + ((size_t)(bh * 128 + dv) * TKS + blk * 64 + part * 16);
                *(u32x4*)dst = (u32x4){o[0], o[1], o[2], o[3]}; *(u32x4*)(dst + 8) = (u32x4){o[4], o[5], o[6], o[7]};
            } else {
                if (tid < 128) { bf16_t* dst = VTS + ((size_t)(bh * 128 + tid) * TKS + PAST + TS);
#pragma unroll
                    for (int i = 0; i < 4; ++i) *(u32x4*)(dst + 8 * i) = (u32x4){0u, 0u, 0u, 0u}; }
            }
#pragma unroll
            for (int i = 0; i < 4; ++i) cvv[i] = nvv[i];
        }
        lds_barrier();
    }
}

constexpr int BM = 256, BK = 64, HALF = 128, NXCD = 8, WGM = 8, HT = HALF * BK;
DI void stage_rc(int b, int& R, int& C) {
    const int st = b / 1024, sb = b % 1024, swz = sb ^ (((sb >> 9) & 1) << 5);
    R = (st >> 1) * 16 + swz / 64; C = (st & 1) * 32 + (swz % 64) / 2;
}
DI int lds_byte(int r, int c) {
    const int st = (r >> 4) * 2 + (c >> 5), rr = r & 15, cc = c & 31, ob = rr * 64 + cc * 2;
    return st * 1024 + (ob ^ (((ob >> 9) & 1) << 5));
}

#define SHM ((bf16_t*)dyn_smem)
#define SA(b, h) (SHM + ((b) * 2 + (h)) * HT)
#define SB(b, h) (SHM + (4 + (b) * 2 + (h)) * HT)
#define STAGE(P, BASE, br, kt) do { const bf16_t* _gb = (BASE) + ((long)(br) * K + (long)(kt) * BK); \
      __builtin_amdgcn_global_load_lds((const unsigned*)(_gb + so0), (unsigned*)((char*)(P) + wlds), 16, 0, 0); \
      __builtin_amdgcn_global_load_lds((const unsigned*)(_gb + 64 * K + so0), (unsigned*)((char*)(P) + wlds + 8192), 16, 0, 0); } while (0)
#define LDA(dst, b, h) for (int m = 0; m < 4; ++m) for (int k = 0; k < 2; ++k) \
    dst[m][k] = *reinterpret_cast<const bf16x8*>((char*)SA(b, h) + lds_byte(wr * 64 + m * 16 + fr, k * 32 + fq * 8))
#define LDB(dst, b, h) for (int n = 0; n < 2; ++n) for (int k = 0; k < 2; ++k) \
    dst[n][k] = *reinterpret_cast<const bf16x8*>((char*)SB(b, h) + lds_byte(wc * 32 + n * 16 + fr, k * 32 + fq * 8))
#define MMA(ai, bj, At, Bt_) do { __builtin_amdgcn_s_setprio(1); \
    for (int m = 0; m < 4; ++m) for (int n = 0; n < 2; ++n) for (int k = 0; k < 2; ++k) \
      acc[ai][bj][m][n] = __builtin_amdgcn_mfma_f32_16x16x32_bf16(Bt_[n][k], At[m][k], acc[ai][bj][m][n], 0, 0, 0); \
    __builtin_amdgcn_s_setprio(0); } while (0)
#define WAIT_V(n) asm volatile("s_waitcnt vmcnt(" #n ")" ::: "memory")
#define WAIT_L(n) asm volatile("s_waitcnt lgkmcnt(" #n ")" ::: "memory")
#define BAR __builtin_amdgcn_s_barrier()
#define SCHED __builtin_amdgcn_sched_barrier(0)

template <int K> DI void gemm_tile(const bf16_t* __restrict__ A, const bf16_t* __restrict__ Bt, const int brow, const int bcol, f32x4 (&acc)[2][2][4][2]) {
    const int wid = threadIdx.x >> 6, lane = threadIdx.x & 63, wr = wid >> 2, wc = wid & 3, fr = lane & 15, fq = lane >> 4;
    unsigned so0;
    { int _r, _c; stage_rc(threadIdx.x * 16, _r, _c); so0 = (unsigned)(_r * K + _c); }
    const int wlds = __builtin_amdgcn_readfirstlane((int)(threadIdx.x >> 6) << 10);
#pragma unroll
    for (int a = 0; a < 2; ++a)
#pragma unroll
        for (int b = 0; b < 2; ++b)
#pragma unroll
            for (int m = 0; m < 4; ++m)
#pragma unroll
                for (int n = 0; n < 2; ++n) acc[a][b][m][n] = (f32x4){0.f, 0.f, 0.f, 0.f};
    bf16x8 At[4][2], B0[2][2], B1[2][2];
    constexpr int nt = K / BK;
    STAGE(SB(0, 0), Bt, bcol, 0); STAGE(SA(0, 0), A, brow, 0);
    STAGE(SB(0, 1), Bt, bcol + HALF, 0); STAGE(SA(0, 1), A, brow + HALF, 0);
    if (wr == 1) BAR;
    WAIT_V(4); BAR;
    STAGE(SB(1, 0), Bt, bcol, 1); STAGE(SA(1, 0), A, brow, 1); STAGE(SB(1, 1), Bt, bcol + HALF, 1);
    WAIT_V(6); BAR;
    for (int t = 0; t < nt - 2; t += 2) {
        LDB(B0, 0, 0); SCHED; LDA(At, 0, 0); STAGE(SA(1, 1), A, brow + HALF, t + 1);
        WAIT_L(8); BAR; WAIT_L(0); MMA(0, 0, At, B0); BAR; SCHED;
        LDB(B1, 0, 1); STAGE(SB(0, 0), Bt, bcol, t + 2);
        BAR; WAIT_L(0); MMA(0, 1, At, B1); BAR;
        LDA(At, 0, 1); STAGE(SA(0, 0), A, brow, t + 2);
        BAR; WAIT_L(0); MMA(1, 0, At, B0); BAR; SCHED;
        STAGE(SB(0, 1), Bt, bcol + HALF, t + 2);
        WAIT_V(6); BAR; MMA(1, 1, At, B1); BAR;
        LDB(B0, 1, 0); SCHED; LDA(At, 1, 0); STAGE(SA(0, 1), A, brow + HALF, t + 2);
        WAIT_L(8); BAR; WAIT_L(0); MMA(0, 0, At, B0); BAR; SCHED;
        LDB(B1, 1, 1); STAGE(SB(1, 0), Bt, bcol, t + 3);
        BAR; WAIT_L(0); MMA(0, 1, At, B1); BAR;
        LDA(At, 1, 1); STAGE(SA(1, 0), A, brow, t + 3);
        BAR; WAIT_L(0); MMA(1, 0, At, B0); BAR; SCHED;
        STAGE(SB(1, 1), Bt, bcol + HALF, t + 3);
        WAIT_V(6); BAR; MMA(1, 1, At, B1); BAR;
    }
    { LDB(B0, 0, 0); LDA(At, 0, 0); STAGE(SA(1, 1), A, brow + HALF, nt - 1);
      BAR; WAIT_L(0); MMA(0, 0, At, B0); BAR;
      LDB(B1, 0, 1); BAR; WAIT_L(0); MMA(0, 1, At, B1); BAR;
      LDA(At, 0, 1); WAIT_V(4); BAR; WAIT_L(0); MMA(1, 0, At, B0); MMA(1, 1, At, B1); BAR; }
    { LDB(B0, 1, 0); LDA(At, 1, 0); WAIT_V(2); BAR; WAIT_L(0); MMA(0, 0, At, B0); BAR;
      LDB(B1, 1, 1); WAIT_V(0); BAR; WAIT_L(0); MMA(0, 1, At, B1); BAR;
      LDA(At, 1, 1); BAR; WAIT_L(0); MMA(1, 0, At, B0); MMA(1, 1, At, B1); BAR; }
    if (wr == 0) BAR;
}

DI void tile_of(int L, int nM, int nN, int& pm, int& pn) {
    const int nwg = nM * nN; int wgid = L;
    { const int q = nwg / NXCD, r = nwg % NXCD, xcd = wgid % NXCD, off = wgid / NXCD; wgid = (xcd < r ? xcd * (q + 1) : r * (q + 1) + (xcd - r) * q) + off; }
    const int nig = WGM * nN, gid = wgid / nig, fm = gid * WGM, gsz = min(nM - fm, WGM);
    pm = fm + ((wgid % nig) % gsz); pn = (wgid % nig) / gsz;
}

constexpr int CST = 260;
DI void stage_half(const f32x4 (&acc)[2][2][4][2], const int ai) {
    const int tid_ = opaque_tid(), wid = tid_ >> 6, lane = tid_ & 63, wr = wid >> 2, wc = wid & 3, fr = lane & 15, fq = lane >> 4;
    float* base = (float*)dyn_smem + (wr * 64 + fr) * CST + wc * 32 + 4 * fq;
#pragma unroll
    for (int m = 0; m < 4; ++m)
#pragma unroll
        for (int bj = 0; bj < 2; ++bj)
#pragma unroll
            for (int n = 0; n < 2; ++n) *(f32x4*)(base + (m * 16) * CST + bj * 128 + n * 16) = ai == 0 ? acc[0][bj][m][n] : acc[1][bj][m][n];
}
#define CT ((const float*)dyn_smem)

DI void epi_in_half(const Params& p, int pm, int pn, int ai) {
    unsigned char* ws = p.ws;
    const int tid = opaque_tid(), brow = pm * BM + ai * 128, bcol = pn * BM;
    const bool samp = pm == 128;
    if (pn < 8) {
        bf16_t* dst = pn < 6 ? (bf16_t*)(ws + WS_R2) : (bf16_t*)(ws + WS_R3);
        const int ld = pn < 6 ? 1536 : 512, c0 = pn < 6 ? bcol : bcol - 1536;
#pragma unroll 4
        for (int i = 0; i < 8; ++i) {
            const int id = tid + 512 * i, r = id >> 5, c8 = (id & 31) * 8, row = brow + r;
            const f32x4 v = *(const f32x4*)(CT + r * CST + c8), w = *(const f32x4*)(CT + r * CST + c8 + 4);
            *(u32x4*)(dst + (size_t)row * ld + c0 + c8) = (u32x4){pk2(v.x, v.y), pk2(v.z, v.w), pk2(w.x, w.y), pk2(w.z, w.w)};
            if (pn < 6) {
                const int t = row & (TP - 1);
                if (t >= TP - 3) { float* cd = p.out + O_CQP + (size_t)((row >> 13) * 3 + t - (TP - 3)) * 1536 + c0 + c8; *(f32x4*)cd = v; *(f32x4*)(cd + 4) = w; }
            }
        }
        return;
    }
    if (pn < 12) {
        const bool isq = pn < 10;
        const float* rope = (const float*)(ws + WS_ROPE);
        bf16_t* QB = (bf16_t*)(ws + WS_R4); bf16_t* KALL = (bf16_t*)(ws + WS_R5);
        const float qs = 0.125f * 1.4426950408889634f;
        f32x4 rt0[8], rt1[8];
#pragma unroll
        for (int i = 0; i < 8; ++i) {
            const int id = tid + 512 * i, r = id >> 5, q = id & 31, d4 = (q & 7) * 4, row = brow + r;
            const int pos = samp ? PAST + ((row - MP) & 31) : (row & (TP - 1));
            rt0[i] = *(const f32x4*)(rope + (size_t)(pos * 32 + d4) * 2); rt1[i] = *(const f32x4*)(rope + (size_t)(pos * 32 + d4) * 2 + 4);
        }
#pragma unroll
        for (int i = 0; i < 8; ++i) {
            const int id = tid + 512 * i, r = id >> 5, q = id & 31, hl = q >> 4, map = (q >> 3) & 1, d4 = (q & 7) * 4, row = brow + r;
            const int cl = hl * 128 + map * 64 + d4, col = ((pn & 1) * 2 + hl) * 128 + map * 64 + d4;
            const f32x4 x1 = *(const f32x4*)(CT + r * CST + cl), x2 = *(const f32x4*)(CT + r * CST + cl + 32);
            int pos; size_t krow; float* kout;
            if (!samp) { pos = row & (TP - 1); krow = row; kout = p.out + O_KP + (size_t)row * 512; }
            else { const int rr = row - MP; pos = PAST + (rr & 31); krow = (size_t)MP + (size_t)(rr >> 5) * TKS + pos; kout = p.out + O_KS + (size_t)rr * 512; }
            const f32x4 t0 = rt0[i], t1 = rt1[i];
            const f32x4 cs = (f32x4){t0.x, t0.z, t1.x, t1.z}, sn = (f32x4){t0.y, t0.w, t1.y, t1.w};
            const f32x4 y1 = x1 * cs - x2 * sn, y2 = x2 * cs + x1 * sn;
            if (isq) {
                u32x2 o1, o2; o1.x = pk2(y1.x * qs, y1.y * qs); o1.y = pk2(y1.z * qs, y1.w * qs); o2.x = pk2(y2.x * qs, y2.y * qs); o2.y = pk2(y2.z * qs, y2.w * qs);
                *(u32x2*)(QB + (size_t)row * 512 + col) = o1; *(u32x2*)(QB + (size_t)row * 512 + col + 32) = o2;
            } else {
                *(f32x4*)(kout + col) = y1; *(f32x4*)(kout + col + 32) = y2;
                u32x2 o1, o2; o1.x = pk2(y1.x, y1.y); o1.y = pk2(y1.z, y1.w); o2.x = pk2(y2.x, y2.y); o2.y = pk2(y2.z, y2.w);
                *(u32x2*)(KALL + krow * 512 + col) = o1; *(u32x2*)(KALL + krow * 512 + col + 32) = o2;
            }
        }
        return;
    }
    {
        bf16_t* VT = (bf16_t*)(ws + WS_R6);
#pragma unroll 4
        for (int i = 0; i < 16; ++i) {
            const int id = tid + 512 * i, r = id >> 6, c4 = (id & 63) * 4, row = brow + r, col = (pn & 1) * 256 + c4;
            const f32x4 v = *(const f32x4*)(CT + r * CST + c4);
            float* vout = samp ? p.out + O_VS + (size_t)(row - MP) * 512 + col : p.out + O_VP + (size_t)row * 512 + col;
            *(f32x4*)vout = v;
        }
#pragma unroll 1
        for (int i = 0; i < 2; ++i) {
            const int id = tid + 512 * i, rg = id >> 6, c4 = (id & 63) * 4, row0 = brow + rg * 8;
            f32x4 v[8];
#pragma unroll
            for (int e = 0; e < 8; ++e) v[e] = *(const f32x4*)(CT + (rg * 8 + e) * CST + c4);
#pragma unroll
            for (int e = 0; e < 4; ++e) {
                const int colg = (pn & 1) * 256 + c4 + e, head = colg >> 7, dv = colg & 127;
                u32x4 o; o.x = pk2(v[0][e], v[1][e]); o.y = pk2(v[2][e], v[3][e]); o.z = pk2(v[4][e], v[5][e]); o.w = pk2(v[6][e], v[7][e]);
                bf16_t* d;
                if (samp) { const int rr = row0 - MP; d = VT + VT_S_OFF + ((size_t)(((rr >> 5) * 4 + head) * 128 + dv) * TKS + PAST + (rr & 31)); }
                else d = VT + ((size_t)(((row0 >> 13) * 4 + head) * 128 + dv) * TP + (row0 & (TP - 1)));
                *(u32x4*)d = o;
            }
        }
    }
}

template <int WHICH> DI void epi_res_half(const Params& p, int pm, int pn, int ai) {
    const int tid = opaque_tid(), brow = pm * BM + ai * 128, bcol = pn * BM;
    bf16_t* dst = (bf16_t*)(p.ws + (WHICH == 0 ? WS_R1 : WS_R2));
    const bf16_t* X1B = (const bf16_t*)(p.ws + WS_R3);
    f32x4 xa[8], xb[8];
#pragma unroll
    for (int i = 0; i < 8; ++i) {
        const int id = tid + 512 * i, r = id >> 5, c8 = (id & 31) * 8, row = brow + r;
        if (WHICH == 0) { const float* xp = xrow_ptr(p, row) + bcol + c8; xa[i] = *(const f32x4*)xp; xb[i] = *(const f32x4*)(xp + 4); }
        else { const u32x4 q = *(const u32x4*)(X1B + (size_t)row * D + bcol + c8); xa[i] = (f32x4){bflo(q.x), bfhi(q.x), bflo(q.y), bfhi(q.y)}; xb[i] = (f32x4){bflo(q.z), bfhi(q.z), bflo(q.w), bfhi(q.w)}; }
    }
#pragma unroll
    for (int i = 0; i < 8; ++i) {
        const int id = tid + 512 * i, r = id >> 5, c8 = (id & 31) * 8, row = brow + r;
        const f32x4 v = *(const f32x4*)(CT + r * CST + c8), w = *(const f32x4*)(CT + r * CST + c8 + 4);
        const f32x4 o = xa[i] * ALPHA + v, o2 = xb[i] * ALPHA + w;
        *(u32x4*)(dst + (size_t)row * D + bcol + c8) = (u32x4){pk2(o.x, o.y), pk2(o.z, o.w), pk2(o2.x, o2.y), pk2(o2.z, o2.w)};
    }
}

constexpr int UST = 264;
DI void epi_up(const Params& p, const f32x4 (&acc)[2][2][4][2], int pm, int pn) {
    unsigned char* ws = p.ws;
    bf16_t* U = (bf16_t*)dyn_smem;
    float* BND = (float*)(ws + WS_R5);
    const bool samp = pm == 128;
    const int brow = pm * BM, tid = opaque_tid();
    {
        const int wid = tid >> 6, lane = tid & 63, wr = wid >> 2, wc = wid & 3, fr = lane & 15, fq = lane >> 4;
        bf16_t* base = U + (wr * 64 + fr) * UST + wc * 32 + 4 * fq;
#pragma unroll
        for (int ai = 0; ai < 2; ++ai)
#pragma unroll
            for (int m = 0; m < 4; ++m)
#pragma unroll
                for (int bj = 0; bj < 2; ++bj)
#pragma unroll
                    for (int n = 0; n < 2; ++n) {
                        const f32x4 v = acc[ai][bj][m][n];
                        u32x2 q; q.x = pk2(v.x, v.y); q.y = pk2(v.z, v.w);
                        *(u32x2*)(base + (ai * 128 + m * 16) * UST + bj * 128 + n * 16) = q;
                    }
    }
    lds_barrier();
    {
        const int nb = samp ? 32 * 256 : 4 * 256;
        for (int id = tid; id < nb; id += 512) {
            const int cl = id & 255, q = id >> 8;
            const int oc = (cl >> 7) * DFF + 128 * pn + (cl & 127);
            int rr, bslot, u;
            if (!samp) { bslot = q; rr = q < 2 ? q : 252 + q; u = pm; }
            else { bslot = q & 3; rr = (q >> 2) * 32 + (bslot < 2 ? bslot : 28 + bslot); u = 128 + (q >> 2); }
            const float v = bf2f(U[rr * UST + cl]);
            BND[((size_t)u * 4 + bslot) * NUP + oc] = v;
            if (bslot >= 2) {
                if (samp) p.out[O_CFS + (size_t)((q >> 2) * 2 + bslot - 2) * NUP + oc] = v;
                else if ((pm & 31) == 31) p.out[O_CFP + (size_t)((pm >> 5) * 2 + bslot - 2) * NUP + oc] = v;
            }
        }
    }
    {
        const int cq = tid & 31, rs = tid >> 5, c = 4 * cq, cg_ = 128 * pn + c, cv_ = DFF + 128 * pn + c;
        const f32x4 wg0 = *(const f32x4*)(p.ffn_conv_w + cg_), wg1 = *(const f32x4*)(p.ffn_conv_w + NUP + cg_), wg2 = *(const f32x4*)(p.ffn_conv_w + 2 * NUP + cg_), bg = *(const f32x4*)(p.ffn_conv_b + cg_);
        const f32x4 wv0 = *(const f32x4*)(p.ffn_conv_w + cv_), wv1 = *(const f32x4*)(p.ffn_conv_w + NUP + cv_), wv2 = *(const f32x4*)(p.ffn_conv_w + 2 * NUP + cv_), bv = *(const f32x4*)(p.ffn_conv_b + cv_);
        bf16_t* GT = (bf16_t*)(ws + WS_R1);
        const int r0 = rs * 16;
        auto ld4 = [&](int rr, int cc) { const u32x2 q = *(const u32x2*)(U + rr * UST + cc); return (f32x4){bflo(q.x), bfhi(q.x), bflo(q.y), bfhi(q.y)}; };
        const f32x4 z4 = {0.f, 0.f, 0.f, 0.f};
        f32x4 g1 = z4, g2 = z4, v1 = z4, v2 = z4;
        if (r0 >= 2) { g1 = ld4(r0 - 2, c); g2 = ld4(r0 - 1, c); v1 = ld4(r0 - 2, 128 + c); v2 = ld4(r0 - 1, 128 + c); }
#pragma unroll 4
        for (int r = r0; r < r0 + 16; ++r) {
            const f32x4 g3 = ld4(r, c), v3 = ld4(r, 128 + c);
            if (r >= 2) {
                const f32x4 cg2 = wg0 * g1 + wg1 * g2 + wg2 * g3 + bg, cv2 = wv0 * v1 + wv1 * v2 + wv2 * v3 + bv;
                u32x2 q; q.x = pk2(silu(cg2.x) * cv2.x, silu(cg2.y) * cv2.y); q.y = pk2(silu(cg2.z) * cv2.z, silu(cg2.w) * cv2.w);
                *(u32x2*)(GT + (size_t)(brow + r) * DFF + 128 * pn + c) = q;
            }
            g1 = g2; g2 = g3; v1 = v2; v2 = v3;
        }
    }
}

template <int K> DI void skinny_gemm(const bf16_t* __restrict__ A, const bf16_t* __restrict__ Bt, float* __restrict__ C, const int N) {
    const int tid = opaque_tid(), lane = tid & 63, w = __builtin_amdgcn_readfirstlane(tid >> 6), fr = lane & 15, fq = lane >> 4;
    float* red = (float*)dyn_smem;
    constexpr int KW = K / 8, NKS = KW / 32;
    const int ntile = 8 * (N / 32);
    for (int t = blockIdx.x; t < ntile; t += gridDim.x) {
        const int rm = t & 7, cn = t >> 3;
        const bf16_t* ap = A + (size_t)(32 * rm + fr) * K + w * KW + 8 * fq;
        const bf16_t* bp = Bt + (size_t)(32 * cn + fr) * K + w * KW + 8 * fq;
        f32x4 acc[2][2];
#pragma unroll
        for (int i = 0; i < 2; ++i)
#pragma unroll
            for (int j = 0; j < 2; ++j) acc[i][j] = (f32x4){0.f, 0.f, 0.f, 0.f};
#pragma unroll 4
        for (int ks = 0; ks < NKS; ++ks) {
            const bf16x8 a0 = *(const bf16x8*)(ap + ks * 32), a1 = *(const bf16x8*)(ap + (size_t)16 * K + ks * 32);
            const bf16x8 b0 = *(const bf16x8*)(bp + ks * 32), b1 = *(const bf16x8*)(bp + (size_t)16 * K + ks * 32);
            acc[0][0] = __builtin_amdgcn_mfma_f32_16x16x32_bf16(a0, b0, acc[0][0], 0, 0, 0);
            acc[0][1] = __builtin_amdgcn_mfma_f32_16x16x32_bf16(a0, b1, acc[0][1], 0, 0, 0);
            acc[1][0] = __builtin_amdgcn_mfma_f32_16x16x32_bf16(a1, b0, acc[1][0], 0, 0, 0);
            acc[1][1] = __builtin_amdgcn_mfma_f32_16x16x32_bf16(a1, b1, acc[1][1], 0, 0, 0);
        }
        lds_barrier();
#pragma unroll
        for (int i = 0; i < 2; ++i)
#pragma unroll
            for (int j = 0; j < 2; ++j)
#pragma unroll
                for (int e = 0; e < 4; ++e) red[(w * 32 + 16 * i + 4 * fq + e) * 33 + 16 * j + fr] = acc[i][j][e];
        lds_barrier();
#pragma unroll
        for (int o2 = 0; o2 < 2; ++o2) {
            const int o = tid + 512 * o2, r = o >> 5, c = o & 31;
            float sum = 0.f;
#pragma unroll
            for (int ww = 0; ww < 8; ++ww) sum += red[(ww * 32 + r) * 33 + c];
            C[(size_t)(32 * rm + r) * N + 32 * cn + c] = sum;
        }
    }
    lds_barrier();
}

template <int WHICH> DI void gemm_phase(const Params& p) {
    unsigned char* ws = p.ws;
    const bf16_t* A; const bf16_t* Bt; int N; constexpr int K = WHICH == 4 ? DFF : D; float* CS;
    if (WHICH == 1) { A = (const bf16_t*)(ws + WS_R1); Bt = (const bf16_t*)(ws + WS_WIN); N = NH1; CS = (float*)(ws + WS_CS1); }
    else if (WHICH == 2) { A = (const bf16_t*)(ws + WS_R2); Bt = (const bf16_t*)(ws + WS_WO); N = D; CS = (float*)(ws + WS_CS2); }
    else if (WHICH == 3) { A = (const bf16_t*)(ws + WS_R3); Bt = (const bf16_t*)(ws + WS_WUP); N = NUP; CS = (float*)(ws + WS_CS3); }
    else { A = (const bf16_t*)(ws + WS_R1); Bt = (const bf16_t*)(ws + WS_WDN); N = D; CS = (float*)(ws + WS_CS4); }
    skinny_gemm<K>(A + (size_t)MP * K, Bt, CS, N);
    const int nM = MP / BM, nN = N / BM, ntile = nM * nN;
    for (int L0 = blockIdx.x; L0 < ntile * (WHICH == GREP_WHICH ? 2 : 1); L0 += gridDim.x) {
        const int L = L0 % ntile;
        int pm, pn; tile_of(L, nM, nN, pm, pn);
        f32x4 acc[2][2][4][2];
        gemm_tile<K>(A, Bt, pm * BM, pn * BM, acc);
        if (WHICH == 3) epi_up(p, acc, pm, pn);
        else {
#pragma unroll
            for (int ai = 0; ai < 2; ++ai) {
                stage_half(acc, ai);
                lds_barrier();
                if (WHICH == 1) epi_in_half(p, pm, pn, ai);
                else if (WHICH == 2) epi_res_half<0>(p, pm, pn, ai);
                else epi_res_half<1>(p, pm, pn, ai);
                lds_barrier();
            }
        }
        lds_barrier();
    }
}

template <int WHICH> DI void ln_phase(const Params& p) {
    const int lane = threadIdx.x & 63, wave = threadIdx.x >> 6;
    const float* g = WHICH == 0 ? p.ln1_g : p.ln2_g; const float* b = WHICH == 0 ? p.ln1_b : p.ln2_b;
    bf16_t* X1B = (bf16_t*)(p.ws + WS_R3);
    const bf16_t* PRE = (const bf16_t*)(p.ws + (WHICH == 0 ? WS_R1 : WS_R2));
    f32x4 gv[4], bv[4];
#pragma unroll
    for (int j = 0; j < 4; ++j) { gv[j] = *(const f32x4*)(g + lane * 4 + 256 * j); bv[j] = *(const f32x4*)(b + lane * 4 + 256 * j); }
    auto ld_row = [&](int row, f32x4 (&v)[4]) {
        if (row < MP) {
#pragma unroll
            for (int j = 0; j < 4; ++j) { const u32x2 q = *(const u32x2*)(PRE + (size_t)row * D + lane * 4 + 256 * j); v[j] = (f32x4){bflo(q.x), bfhi(q.x), bflo(q.y), bfhi(q.y)}; }
        } else {
            const float* cs = (const float*)(p.ws + (WHICH == 0 ? WS_CS2 : WS_CS4)) + (size_t)(row - MP) * D;
#pragma unroll
            for (int j = 0; j < 4; ++j) {
                f32x4 rs;
                if (WHICH == 0) rs = *(const f32x4*)(p.x_s + (size_t)(row - MP) * D + lane * 4 + 256 * j);
                else { const u32x2 q = *(const u32x2*)(X1B + (size_t)row * D + lane * 4 + 256 * j); rs = (f32x4){bflo(q.x), bfhi(q.x), bflo(q.y), bfhi(q.y)}; }
                v[j] = rs * ALPHA + *(const f32x4*)(cs + lane * 4 + 256 * j);
            }
        }
    };
    f32x4 v[4];
    if (blockIdx.x * 8 + wave < M) ld_row(blockIdx.x * 8 + wave, v);
    for (int row = blockIdx.x * 8 + wave; row < M; row += gridDim.x * 8) {
        f32x4 vn[4];
        const bool more = row + (int)gridDim.x * 8 < M;
        if (more) ld_row(row + gridDim.x * 8, vn);
        float s = 0.f;
#pragma unroll
        for (int j = 0; j < 4; ++j) s += (v[j].x + v[j].y) + (v[j].z + v[j].w);
        const float mean = wave_sum(s) * (1.f / D); float s2 = 0.f;
#pragma unroll
        for (int j = 0; j < 4; ++j) { v[j] = v[j] - mean; s2 += (v[j].x * v[j].x + v[j].y * v[j].y) + (v[j].z * v[j].z + v[j].w * v[j].w); }
        const float rstd = rsqrtf(wave_sum(s2) * (1.f / D) + 1e-5f);
#pragma unroll
        for (int j = 0; j < 4; ++j) {
            const f32x4 o = v[j] * rstd * gv[j] + bv[j];
            if (WHICH == 0) { u32x2 q; q.x = pk2(o.x, o.y); q.y = pk2(o.z, o.w); *(u32x2*)(X1B + (size_t)row * D + lane * 4 + 256 * j) = q; }
            else *(f32x4*)(p.out + O_Y + (size_t)row * D + lane * 4 + 256 * j) = o;
        }
        if (more) {
#pragma unroll
            for (int j = 0; j < 4; ++j) v[j] = vn[j];
        }
    }
}

DI void fixup_phase(const Params& p) {
    const float* BND = (const float*)(p.ws + WS_R5);
    bf16_t* GT = (bf16_t*)(p.ws + WS_R1);
    {
        const float* CS3 = (const float*)(p.ws + WS_CS3);
        for (int idx = blockIdx.x * 512 + threadIdx.x; idx < MS * DFF; idx += gridDim.x * 512) {
            const int c = idx % DFF, r = idx / DFF, b = r >> 5, t = r & 31, ng = (c >> 7) * 256 + (c & 127), nv = ng + 128;
            float g[3], v[3];
#pragma unroll
            for (int k = 0; k < 3; ++k) {
                const int tt = t - 2 + k;
                if (tt >= 0) { g[k] = CS3[(size_t)(b * 32 + tt) * NUP + ng]; v[k] = CS3[(size_t)(b * 32 + tt) * NUP + nv]; }
                else { g[k] = p.state_cf[(size_t)(b * 2 + 2 + tt) * NUP + c]; v[k] = p.state_cf[(size_t)(b * 2 + 2 + tt) * NUP + DFF + c]; }
            }
            const float cg2 = p.ffn_conv_w[c] * g[0] + p.ffn_conv_w[NUP + c] * g[1] + p.ffn_conv_w[2 * NUP + c] * g[2] + p.ffn_conv_b[c];
            const float cv2 = p.ffn_conv_w[DFF + c] * v[0] + p.ffn_conv_w[NUP + DFF + c] * v[1] + p.ffn_conv_w[2 * NUP + DFF + c] * v[2] + p.ffn_conv_b[DFF + c];
            GT[((size_t)MP + r) * DFF + c] = f2bf(silu(cg2) * cv2);
            if (t >= 30) { p.out[O_CFS + (size_t)(b * 2 + t - 30) * NUP + c] = g[2]; p.out[O_CFS + (size_t)(b * 2 + t - 30) * NUP + DFF + c] = v[2]; }
        }
    }
    const int total = 128 * 2 * DFF;
    for (int idx = blockIdx.x * 512 + threadIdx.x; idx < total; idx += gridDim.x * 512) {
        const int c = idx % DFF, q = idx / DFF, r = q & 1, u = q >> 1;
        const float* cur = BND + (size_t)u * 4 * NUP;
        float pg[2], pv[2];
        if (u < 128) {
            if ((u & 31) == 0) { pg[0] = pg[1] = pv[0] = pv[1] = 0.f; }
            else { const float* pr = BND + (size_t)(u - 1) * 4 * NUP; pg[0] = pr[2 * NUP + c]; pg[1] = pr[3 * NUP + c]; pv[0] = pr[2 * NUP + DFF + c]; pv[1] = pr[3 * NUP + DFF + c]; }
        } else { const float* st = p.state_cf + (size_t)(u - 128) * 2 * NUP; pg[0] = st[c]; pg[1] = st[NUP + c]; pv[0] = st[DFF + c]; pv[1] = st[NUP + DFF + c]; }
        const float cg0 = cur[c], cg1 = cur[NUP + c], cv0 = cur[DFF + c], cv1 = cur[NUP + DFF + c];
        const float wg0 = p.ffn_conv_w[c], wg1 = p.ffn_conv_w[NUP + c], wg2 = p.ffn_conv_w[2 * NUP + c], bg = p.ffn_conv_b[c];
        const float wv0 = p.ffn_conv_w[DFF + c], wv1 = p.ffn_conv_w[NUP + DFF + c], wv2 = p.ffn_conv_w[2 * NUP + DFF + c], bv = p.ffn_conv_b[DFF + c];
        float g, v;
        if (r == 0) { g = wg0 * pg[0] + wg1 * pg[1] + wg2 * cg0 + bg; v = wv0 * pv[0] + wv1 * pv[1] + wv2 * cv0 + bv; }
        else { g = wg0 * pg[1] + wg1 * cg0 + wg2 * cg1 + bg; v = wv0 * pv[1] + wv1 * cv0 + wv2 * cv1 + bv; }
        const size_t row = u < 128 ? (size_t)u * 256 + r : (size_t)MP + (size_t)(u - 128) * 32 + r;
        GT[row * DFF + c] = f2bf(silu(g) * v);
    }
}

#define MFMA16(a, b, c) __builtin_amdgcn_mfma_f32_16x16x32_bf16((a), (b), (c), 0, 0, 0)
#define MFMA32(a, b, c) __builtin_amdgcn_mfma_f32_32x32x16_bf16((a), (b), (c), 0, 0, 0)
DI bf16x8 pack8(const f32x4 a, const f32x4 b) { u32x4 o; o.x = pk2(a.x, a.y); o.y = pk2(a.z, a.w); o.z = pk2(b.x, b.y); o.w = pk2(b.z, b.w); return __builtin_bit_cast(bf16x8, o); }
constexpr float GSCALE = 0.08838834764831845f;
constexpr int QST = 132, AST = 68, NST = 136, QKST = 72;
constexpr int L_QKV = 0, L_AM = 3 * 64 * QST * 4, L_KN = L_AM + 64 * AST * 4, L_QN = L_KN + 64 * NST * 2, L_GC = L_QN + 64 * NST * 2;
constexpr int L_QKS = 0, L_WS = 64 * QKST * 2;
static_assert(L_GC + 1024 <= LDS_BYTES, "gdn prep LDS");

DI void gdn_conv_weights(const Params& p, const int h, float (&cw)[3][4]) {
#pragma unroll
    for (int k = 0; k < 3; ++k) {
        const int task = threadIdx.x + 512 * k, col = task % 384, part = col >> 7, cc = col & 127, gcol = part * 512 + h * 128 + cc;
#pragma unroll
        for (int j = 0; j < 4; ++j) cw[k][j] = p.gdn_conv_w[j * 1536 + gcol];
    }
}
DI void gdn_prep_item(const Params& p, const int item, const float (&cw)[3][4]) {
    unsigned char* ws = p.ws;
    float* QKVf = (float*)(dyn_smem + L_QKV); float* AM = (float*)(dyn_smem + L_AM);
    bf16_t* KN = (bf16_t*)(dyn_smem + L_KN); bf16_t* QN = (bf16_t*)(dyn_smem + L_QN);
    float* GC = (float*)(dyn_smem + L_GC); float* BETA = GC + 64; float* EG = GC + 128; float* ED = GC + 192;
    bf16_t* QKS = (bf16_t*)(dyn_smem + L_QKS); bf16_t* WSI = (bf16_t*)(dyn_smem + L_WS);
    const bf16_t* HQKV = (const bf16_t*)(ws + WS_R2);
    const float* AB = (const float*)(ws + WS_AB);
    float* DL = (float*)(ws + WS_DL);
        const int tid = opaque_tid(), lane = tid & 63, wave = __builtin_amdgcn_readfirstlane(tid >> 6), fr = lane & 15, fq = lane >> 4;
        int h, b, c, row0, valid; bool samp;
        if (item < 2048) { h = item & 3; c = (item >> 2) & 127; b = item >> 9; row0 = b * TP + c * 64; valid = 64; samp = false; }
        else { const int j = item - 2048; h = j & 3; b = j >> 2; c = 0; row0 = MP + b * TS; valid = TS; samp = true; }
        unsigned char* ip = ws + WS_R1 + (size_t)item * ITEM_B;
        lds_barrier();
        {
            bf16_t* RAW = (bf16_t*)(dyn_smem + L_AM);
#pragma unroll
            for (int i = 0; i < 7; ++i) {
                const int id = tid + 512 * i;
                if (id < 67 * 48) {
                    const int rw = id / 48, ch = id % 48, part = ch >> 4, c8 = (ch & 15) * 8, gcol = part * 512 + h * 128 + c8, t = rw - 3;
                    u32x4 v = (u32x4){0u, 0u, 0u, 0u};
                    if (t >= 0) {
                        if (t < valid) {
                            if (!samp) v = *(const u32x4*)(HQKV + (size_t)(row0 + t) * 1536 + gcol);
                            else { const float* sp = (const float*)(ws + WS_CS1) + (size_t)(row0 - MP + t) * NH1 + gcol; const f32x4 f0 = *(const f32x4*)sp, f1 = *(const f32x4*)(sp + 4);
                                   v.x = pk2(f0.x, f0.y); v.y = pk2(f0.z, f0.w); v.z = pk2(f1.x, f1.y); v.w = pk2(f1.z, f1.w); }
                        }
                    }
                    else if (samp) { const float* sp = p.state_cq + (size_t)(b * 3 + 3 + t) * 1536 + gcol; const f32x4 f0 = *(const f32x4*)sp, f1 = *(const f32x4*)(sp + 4);
                                     v.x = pk2(f0.x, f0.y); v.y = pk2(f0.z, f0.w); v.z = pk2(f1.x, f1.y); v.w = pk2(f1.z, f1.w); }
                    else if (c != 0) v = *(const u32x4*)(HQKV + (size_t)(row0 + t) * 1536 + gcol);
                    *(u32x4*)(RAW + rw * 384 + ch * 8) = v;
                }
            }
            lds_barrier();
#pragma unroll
            for (int k3 = 0; k3 < 3; ++k3) {
                const int task = tid + 512 * k3;
                const int col = task % 384, seg = task / 384, part = col >> 7, cc = col & 127, t0 = seg * 16;
                const float w0 = cw[k3][0], w1 = cw[k3][1], w2 = cw[k3][2], w3 = cw[k3][3];
                float x0 = bf2f(RAW[(t0) * 384 + col]), x1 = bf2f(RAW[(t0 + 1) * 384 + col]), x2 = bf2f(RAW[(t0 + 2) * 384 + col]);
#pragma unroll
                for (int t = t0; t < t0 + 16; ++t) {
                    const float xv = bf2f(RAW[(t + 3) * 384 + col]);
                    const float y = w0 * x0 + w1 * x1 + w2 * x2 + w3 * xv;
                    QKVf[(part * 64 + t) * QST + cc] = t < valid ? silu(y) : 0.f;
                    x0 = x1; x1 = x2; x2 = xv;
                }
            }
        }
        if (tid < 64) {
            float g = 0.f, be = 0.f;
            if (tid < valid) {
                const float a = AB[(size_t)(row0 + tid) * 8 + h] + p.dt_bias[h], bb = AB[(size_t)(row0 + tid) * 8 + 4 + h];
                const float sp = a > 20.f ? a : log1pf(expf(a));
                g = -expf(p.a_log[h]) * sp; be = 1.f / (1.f + expf(-bb));
            }
            float gc = g;
#pragma unroll
            for (int o = 1; o < 64; o <<= 1) { const float n = __shfl_up(gc, o); if (lane >= o) gc += n; }
            const float gl = __shfl(gc, 63);
            GC[tid] = gc; BETA[tid] = be; EG[tid] = expf(gc); ED[tid] = expf(gl - gc);
            if (tid == 0) DL[item] = expf(gl);
        }
        lds_barrier();
        {
            const int row = tid >> 3, pt = tid & 7;
            float q[16], k[16]; float sq = 0.f, sk = 0.f;
#pragma unroll
            for (int e4 = 0; e4 < 4; ++e4) {
                const f32x4 a = *(const f32x4*)(QKVf + row * QST + 16 * pt + 4 * e4), bq = *(const f32x4*)(QKVf + (64 + row) * QST + 16 * pt + 4 * e4);
#pragma unroll
                for (int e = 0; e < 4; ++e) { q[4 * e4 + e] = a[e]; k[4 * e4 + e] = bq[e]; sq += a[e] * a[e]; sk += bq[e] * bq[e]; }
            }
#pragma unroll
            for (int o = 1; o < 8; o <<= 1) { sq += __shfl_xor(sq, o); sk += __shfl_xor(sk, o); }
            const float rq = rsqrtf(sq + 1e-6f), rk = rsqrtf(sk + 1e-6f), qg = rq * GSCALE * EG[row];
            u32x4 o0, o1;
            o0.x = pk2(q[0] * rq, q[1] * rq); o0.y = pk2(q[2] * rq, q[3] * rq); o0.z = pk2(q[4] * rq, q[5] * rq); o0.w = pk2(q[6] * rq, q[7] * rq);
            o1.x = pk2(q[8] * rq, q[9] * rq); o1.y = pk2(q[10] * rq, q[11] * rq); o1.z = pk2(q[12] * rq, q[13] * rq); o1.w = pk2(q[14] * rq, q[15] * rq);
            *(u32x4*)(QN + row * NST + 16 * pt) = o0; *(u32x4*)(QN + row * NST + 16 * pt + 8) = o1;
            o0.x = pk2(k[0] * rk, k[1] * rk); o0.y = pk2(k[2] * rk, k[3] * rk); o0.z = pk2(k[4] * rk, k[5] * rk); o0.w = pk2(k[6] * rk, k[7] * rk);
            o1.x = pk2(k[8] * rk, k[9] * rk); o1.y = pk2(k[10] * rk, k[11] * rk); o1.z = pk2(k[12] * rk, k[13] * rk); o1.w = pk2(k[14] * rk, k[15] * rk);
            *(u32x4*)(KN + row * NST + 16 * pt) = o0; *(u32x4*)(KN + row * NST + 16 * pt + 8) = o1;
#pragma unroll
            for (int e4 = 0; e4 < 4; ++e4) *(f32x4*)(QKVf + (64 + row) * QST + 16 * pt + 4 * e4) = (f32x4){k[4 * e4] * rk, k[4 * e4 + 1] * rk, k[4 * e4 + 2] * rk, k[4 * e4 + 3] * rk};
            bf16_t* QGf = (bf16_t*)(ip + 16384);
            const int rt = row >> 4, frr = row & 15, ks = pt >> 1;
#pragma unroll
            for (int f = 0; f < 4; ++f) {
                u32x2 o; o.x = pk2(q[4 * f] * qg, q[4 * f + 1] * qg); o.y = pk2(q[4 * f + 2] * qg, q[4 * f + 3] * qg);
                *(u32x2*)(QGf + (size_t)(((rt * 4 + ks) * 64 + f * 16 + frr) * 8 + 4 * (pt & 1))) = o;
            }
        }
        lds_barrier();
        {
            const bool isq = wave >= 4; const int ti = wave & 3;
            const bf16_t* As = isq ? QN : KN;
#pragma unroll
            for (int tj = 0; tj < 4; ++tj) {
                f32x4 acc = (f32x4){0.f, 0.f, 0.f, 0.f};
#pragma unroll
                for (int ks = 0; ks < 4; ++ks) {
                    const bf16x8 a = *(const bf16x8*)(As + (16 * ti + fr) * NST + 32 * ks + 8 * fq), bb = *(const bf16x8*)(KN + (16 * tj + fr) * NST + 32 * ks + 8 * fq);
                    acc = MFMA16(a, bb, acc);
                }
                const int jj = 16 * tj + fr; const float gj = GC[jj];
#pragma unroll
                for (int j = 0; j < 4; ++j) {
                    const int i = 16 * ti + 4 * fq + j;
                    const float dec = i >= jj ? __expf(GC[i] - gj) : 0.f;
                    if (!isq) AM[i * AST + jj] = i > jj ? BETA[i] * acc[j] * dec : 0.f;
                    else QKS[i * QKST + jj] = f2bf(GSCALE * acc[j] * dec);
                }
            }
            bf16_t* KDTf = (bf16_t*)(ip + 32768);
#pragma unroll
            for (int i2 = 0; i2 < 2; ++i2) {
                const int f = tid + 512 * i2, ln = f & 63, ks2 = (f >> 6) & 1, dt = f >> 7, fq_ = ln >> 4, dk = 16 * dt + (ln & 15);
                float v[8];
#pragma unroll
                for (int e = 0; e < 8; ++e) { const int i = 32 * ks2 + 16 * (e >> 2) + 4 * fq_ + (e & 3); v[e] = bf2f(KN[i * NST + dk]) * ED[i]; }
                u32x4 o; o.x = pk2(v[0], v[1]); o.y = pk2(v[2], v[3]); o.z = pk2(v[4], v[5]); o.w = pk2(v[6], v[7]);
                *(u32x4*)(KDTf + (size_t)f * 8) = o;
            }
        }
        lds_barrier();
        {
            float* TM = (float*)(dyn_smem + L_QN);
            float* TMP = (float*)(dyn_smem + L_KN);
#pragma unroll
            for (int i = 0; i < 9; ++i) { const int id = tid + 512 * i; if (id < 64 * AST) TM[id] = 0.f; }
            lds_barrier();
            if (tid < 64) {
                const int d = tid >> 4, c = tid & 15;
                float y[16];
#pragma unroll
                for (int r = 0; r < 16; ++r) {
                    float sacc = r == c ? 1.f : 0.f;
                    const float* ar = AM + (16 * d + r) * AST + 16 * d;
                    float arow[16];
#pragma unroll
                    for (int j4 = 0; j4 < (r + 3) / 4; ++j4) { const f32x4 a = *(const f32x4*)(ar + 4 * j4); arow[4 * j4] = a.x; arow[4 * j4 + 1] = a.y; arow[4 * j4 + 2] = a.z; arow[4 * j4 + 3] = a.w; }
#pragma unroll
                    for (int j = 0; j < r; ++j) sacc -= arow[j] * y[j];
                    y[r] = sacc;
                    TM[(16 * d + r) * AST + 16 * d + c] = sacc;
                }
            }
            lds_barrier();
            {
                const int blk = tid >> 8, r = (tid >> 4) & 15, c = tid & 15, rb = blk ? 3 : 1, cb = rb - 1;
                float t = 0.f;
#pragma unroll
                for (int j = 0; j < 16; ++j) t += AM[(16 * rb + r) * AST + 16 * cb + j] * TM[(16 * cb + j) * AST + 16 * cb + c];
                TMP[blk * 272 + r * 17 + c] = t;
                lds_barrier();
                float o = 0.f;
#pragma unroll
                for (int k = 0; k < 16; ++k) o -= TM[(16 * rb + r) * AST + 16 * rb + k] * TMP[blk * 272 + k * 17 + c];
                lds_barrier();
                TM[(16 * rb + r) * AST + 16 * cb + c] = o;
            }
            lds_barrier();
            {
                float t[2];
#pragma unroll
                for (int i2 = 0; i2 < 2; ++i2) {
                    const int o = tid + 512 * i2, r = o >> 5, c = o & 31;
                    float acc = 0.f;
#pragma unroll
                    for (int j4 = 0; j4 < 8; ++j4) {
                        const f32x4 a = *(const f32x4*)(AM + (32 + r) * AST + 4 * j4);
                        acc += a.x * TM[(4 * j4) * AST + c] + a.y * TM[(4 * j4 + 1) * AST + c] + a.z * TM[(4 * j4 + 2) * AST + c] + a.w * TM[(4 * j4 + 3) * AST + c];
                    }
                    t[i2] = acc;
                }
#pragma unroll
                for (int i2 = 0; i2 < 2; ++i2) { const int o = tid + 512 * i2; TMP[(o >> 5) * 33 + (o & 31)] = t[i2]; }
                lds_barrier();
#pragma unroll
                for (int i2 = 0; i2 < 2; ++i2) {
                    const int o = tid + 512 * i2, r = o >> 5, c = o & 31;
                    float acc = 0.f;
#pragma unroll
                    for (int k4 = 0; k4 < 8; ++k4) {
                        const f32x4 a = *(const f32x4*)(TM + (32 + r) * AST + 32 + 4 * k4);
                        acc -= a.x * TMP[(4 * k4) * 33 + c] + a.y * TMP[(4 * k4 + 1) * 33 + c] + a.z * TMP[(4 * k4 + 2) * 33 + c] + a.w * TMP[(4 * k4 + 3) * 33 + c];
                    }
                    t[i2] = acc;
                }
#pragma unroll
                for (int i2 = 0; i2 < 2; ++i2) { const int o = tid + 512 * i2; TM[(32 + (o >> 5)) * AST + (o & 31)] = t[i2]; }
            }
            lds_barrier();
            {
                bf16x8 Ah[4][2], Al[4][2];
#pragma unroll
                for (int rt = 0; rt < 4; ++rt)
#pragma unroll
                    for (int ks = 0; ks < 2; ++ks) {
                        const f32x4 a0 = *(const f32x4*)(TM + (16 * rt + fr) * AST + 32 * ks + 8 * fq), a1 = *(const f32x4*)(TM + (16 * rt + fr) * AST + 32 * ks + 8 * fq + 4);
                        u32x4 hq; hq.x = pk2(a0.x, a0.y); hq.y = pk2(a0.z, a0.w); hq.z = pk2(a1.x, a1.y); hq.w = pk2(a1.z, a1.w);
                        u32x4 lq; lq.x = pk2(a0.x - bflo(hq.x), a0.y - bfhi(hq.x)); lq.y = pk2(a0.z - bflo(hq.y), a0.w - bfhi(hq.y));
                        lq.z = pk2(a1.x - bflo(hq.z), a1.y - bfhi(hq.z)); lq.w = pk2(a1.z - bflo(hq.w), a1.w - bfhi(hq.w));
                        Ah[rt][ks] = __builtin_bit_cast(bf16x8, hq); Al[rt][ks] = __builtin_bit_cast(bf16x8, lq);
                    }
                const bool isw = wave >= 4;
                f32x4 xacc[2][4];
#pragma unroll
                for (int q = 0; q < 2; ++q)
#pragma unroll
                    for (int rt = 0; rt < 4; ++rt) xacc[q][rt] = (f32x4){0.f, 0.f, 0.f, 0.f};
#pragma unroll
                for (int ks = 0; ks < 2; ++ks) {
                    float sc8[8];
                    {
                        const f32x4 b0 = *(const f32x4*)(BETA + 32 * ks + 8 * fq), b1 = *(const f32x4*)(BETA + 32 * ks + 8 * fq + 4);
                        const f32x4 e0 = *(const f32x4*)(EG + 32 * ks + 8 * fq), e1 = *(const f32x4*)(EG + 32 * ks + 8 * fq + 4);
#pragma unroll
                        for (int e = 0; e < 4; ++e) { sc8[e] = isw ? b0[e] * e0[e] : b0[e]; sc8[4 + e] = isw ? b1[e] * e1[e] : b1[e]; }
                    }
#pragma unroll
                    for (int q = 0; q < 2; ++q) {
                        const int cc = ((2 * wave + q) & 7) * 16 + fr;
                        const float* src = QKVf + ((isw ? 64 : 128) + 32 * ks + 8 * fq) * QST + cc;
                        float v[8];
#pragma unroll
                        for (int e = 0; e < 8; ++e) v[e] = src[e * QST] * sc8[e];
                        u32x4 hq; hq.x = pk2(v[0], v[1]); hq.y = pk2(v[2], v[3]); hq.z = pk2(v[4], v[5]); hq.w = pk2(v[6], v[7]);
                        u32x4 lq; lq.x = pk2(v[0] - bflo(hq.x), v[1] - bfhi(hq.x)); lq.y = pk2(v[2] - bflo(hq.y), v[3] - bfhi(hq.y));
                        lq.z = pk2(v[4] - bflo(hq.z), v[5] - bfhi(hq.z)); lq.w = pk2(v[6] - bflo(hq.w), v[7] - bfhi(hq.w));
                        const bf16x8 Bh = __builtin_bit_cast(bf16x8, hq), Bl = __builtin_bit_cast(bf16x8, lq);
#pragma unroll
                        for (int rt = 0; rt < 4; ++rt) {
                            xacc[q][rt] = MFMA16(Ah[rt][ks], Bh, xacc[q][rt]);
                            xacc[q][rt] = MFMA16(Al[rt][ks], Bh, xacc[q][rt]);
                            xacc[q][rt] = MFMA16(Ah[rt][ks], Bl, xacc[q][rt]);
                        }
                    }
                }
                if (!isw) {
                    float* Uc = (float*)(ip + 57344);
#pragma unroll
                    for (int q = 0; q < 2; ++q)
#pragma unroll
                        for (int rt = 0; rt < 4; ++rt) *(f32x4*)(Uc + (size_t)((((2 * wave + q) * 4 + rt) * 64 + lane) * 4)) = xacc[q][rt];
                } else {
#pragma unroll
                    for (int q = 0; q < 2; ++q)
#pragma unroll
                        for (int rt = 0; rt < 4; ++rt)
#pragma unroll
                            for (int j = 0; j < 4; ++j) WSI[(16 * rt + 4 * fq + j) * NST + ((2 * wave + q) & 7) * 16 + fr] = f2bf(xacc[q][rt][j]);
                }
            }
        }
        lds_barrier();
        {
            bf16_t* Wf = (bf16_t*)ip; bf16_t* QKf = (bf16_t*)(ip + 49152);
#pragma unroll
            for (int i2 = 0; i2 < 2; ++i2) {
                const int f = tid + 512 * i2, ln = f & 63, ks = (f >> 6) & 3, rt = f >> 8, i = 16 * rt + (ln & 15), fq_ = ln >> 4;
                const u32x2 lo = *(const u32x2*)(WSI + i * NST + 32 * ks + 4 * fq_), hi = *(const u32x2*)(WSI + i * NST + 32 * ks + 16 + 4 * fq_);
                *(u32x4*)(Wf + (size_t)f * 8) = (u32x4){lo.x, lo.y, hi.x, hi.y};
            }
            {
                const int f = tid, ln = f & 63, ks2 = (f >> 6) & 1, rt = f >> 7, i = 16 * rt + (ln & 15), fq_ = ln >> 4;
                const u32x2 lo = *(const u32x2*)(QKS + i * QKST + 32 * ks2 + 4 * fq_), hi = *(const u32x2*)(QKS + i * QKST + 32 * ks2 + 16 + 4 * fq_);
                *(u32x4*)(QKf + (size_t)f * 8) = (u32x4){lo.x, lo.y, hi.x, hi.y};
            }
        }
    lds_barrier();
}

DI void gdn_prep_phase(const Params& p) {
    unsigned char* ws = p.ws;
    for (int r = blockIdx.x; r < MS; r += gridDim.x) {
        const int tid = opaque_tid(), b = r >> 5, t = r & 31, pos = PAST + t;
        const float* cs = (const float*)(ws + WS_CS1) + (size_t)r * NH1;
        if (t >= TS - 3) { for (int c = tid; c < 1536; c += 512) p.out[O_CQS + (size_t)(b * 3 + t - (TS - 3)) * 1536 + c] = cs[c]; }
        {
            const int which = tid >> 8, pr = tid & 255, hd = pr >> 6, mp = (pr >> 5) & 1, d = pr & 31, col = hd * 128 + mp * 64 + d;
            const float2 csn = ((const float2*)(ws + WS_ROPE))[pos * 32 + d];
            const float x1 = cs[2048 + which * 512 + col], x2 = cs[2048 + which * 512 + col + 32];
            const float y1 = x1 * csn.x - x2 * csn.y, y2 = x2 * csn.x + x1 * csn.y;
            if (which == 0) { const float qs = 0.125f * 1.4426950408889634f; bf16_t* QB = (bf16_t*)(ws + WS_R4) + ((size_t)MP + r) * 512; QB[col] = f2bf(y1 * qs); QB[col + 32] = f2bf(y2 * qs); }
            else { float* ko = p.out + O_KS + (size_t)r * 512; ko[col] = y1; ko[col + 32] = y2;
                   bf16_t* kk = (bf16_t*)(ws + WS_R5) + ((size_t)MP + (size_t)b * TKS + pos) * 512; kk[col] = f2bf(y1); kk[col + 32] = f2bf(y2); }
        }
        {
            const float vv = cs[3072 + tid];
            p.out[O_VS + (size_t)r * 512 + tid] = vv;
            ((bf16_t*)(ws + WS_R6))[VT_S_OFF + ((size_t)((b * 4 + (tid >> 7)) * 128 + (tid & 127)) * TKS + pos)] = f2bf(vv);
        }
    }
    float cw[3][4];
    gdn_conv_weights(p, blockIdx.x & 3, cw);
    {
        const int when = blockIdx.x & 7; int k = 0;
#pragma unroll 1
        for (int item = blockIdx.x; item < 2048; item += gridDim.x, ++k) { if (k == when) prep_stream(p); gdn_prep_item(p, item, cw); }
    }
}

constexpr int OPB_B = 57344, L_OBUF = 2 * OPB_B, OST = 132;
static_assert(L_OBUF + 64 * OST * 4 <= LDS_BYTES, "scan LDS");
DI void gdn_scan(const Params& p, const bool samp, const int b, const int h) {
    unsigned char* ws = p.ws;
    const int tid = threadIdx.x, lane = tid & 63, w = __builtin_amdgcn_readfirstlane(tid >> 6), fr = lane & 15, fq = lane >> 4;
    const int nsteps = samp ? 1 : 128, valid = samp ? TS : 64;
    float* OBUF = (float*)(dyn_smem + L_OBUF);
    const bf16_t* HG = (const bf16_t*)(ws + WS_R3);
    bf16_t* OMIX = (bf16_t*)(ws + WS_R2);
    const float* DL = (const float*)(ws + WS_DL);
    f32x4 S[8];
#pragma unroll
    for (int dt = 0; dt < 8; ++dt) {
        if (samp) {
#pragma unroll
            for (int j = 0; j < 4; ++j) S[dt][j] = p.state_gdn[((size_t)(b * 4 + h) * 128 + 16 * dt + 4 * fq + j) * 128 + 16 * w + fr];
        } else S[dt] = (f32x4){0.f, 0.f, 0.f, 0.f};
    }
    const int item0 = samp ? 2048 + b * 4 + h : b * 512 + h;
    lds_barrier();
    {
        const unsigned char* ip = ws + WS_R1 + (size_t)item0 * ITEM_B;
#pragma unroll
        for (int i = 0; i < 7; ++i) *(u32x4*)(dyn_smem + (tid + 512 * i) * 16) = *(const u32x4*)(ip + (tid + 512 * i) * 16);
    }
    lds_barrier();
    const int erow = tid >> 3, ept = tid & 7;
    float nw[16];
#pragma unroll
    for (int e = 0; e < 16; ++e) nw[e] = p.gdn_norm_w[16 * ept + e];
    f32x4 U[4]; float dl; u32x4 g0, g1;
    auto side_load = [&](int c, f32x4 (&Uo)[4], float& dlo, u32x4& go0, u32x4& go1) {
        const int item = item0 + 4 * c;
        const float* Uc = (const float*)(ws + WS_R1 + (size_t)item * ITEM_B + 57344);
#pragma unroll
        for (int rt = 0; rt < 4; ++rt) Uo[rt] = *(const f32x4*)(Uc + ((w * 4 + rt) * 64 + lane) * 4);
        dlo = DL[item];
        const size_t grow = (samp ? (size_t)MP + b * TS : (size_t)b * TP + (size_t)c * 64) + erow;
        if (!samp) { go0 = *(const u32x4*)(HG + grow * 512 + h * 128 + 16 * ept); go1 = *(const u32x4*)(HG + grow * 512 + h * 128 + 16 * ept + 8); }
        else if (erow < TS) { const float* gp = (const float*)(ws + WS_CS1) + (grow - MP) * NH1 + 1536 + h * 128 + 16 * ept;
               const f32x4 f0 = *(const f32x4*)gp, f1 = *(const f32x4*)(gp + 4), f2 = *(const f32x4*)(gp + 8), f3 = *(const f32x4*)(gp + 12);
               go0 = (u32x4){pk2(f0.x, f0.y), pk2(f0.z, f0.w), pk2(f1.x, f1.y), pk2(f1.z, f1.w)}; go1 = (u32x4){pk2(f2.x, f2.y), pk2(f2.z, f2.w), pk2(f3.x, f3.y), pk2(f3.z, f3.w)}; }
        else { go0 = (u32x4){0u, 0u, 0u, 0u}; go1 = go0; }
    };
    side_load(0, U, dl, g0, g1);
#pragma unroll 1
    for (int c = 0; c < nsteps; ++c) {
        const int item = item0 + 4 * c;
        const unsigned char* ip = ws + WS_R1 + (size_t)item * ITEM_B;
        const bool nxt = c + 1 < nsteps;
        u32x4 pf[7];
        f32x4 Un[4]; float dln = 0.f; u32x4 gn0 = g0, gn1 = g1;
        if (nxt) {
#pragma unroll
            for (int i = 0; i < 7; ++i) pf[i] = *(const u32x4*)(ip + 4 * (size_t)ITEM_B + (tid + 512 * i) * 16);
            side_load(c + 1, Un, dln, gn0, gn1);
        }
        const unsigned char* buf = dyn_smem + (c & 1) * OPB_B;
        bf16x8 Sb[4];
#pragma unroll
        for (int ks = 0; ks < 4; ++ks) Sb[ks] = pack8(S[2 * ks], S[2 * ks + 1]);
        f32x4 vn[4];
#pragma unroll
        for (int rt = 0; rt < 4; ++rt) {
            f32x4 acc = (f32x4){0.f, 0.f, 0.f, 0.f};
#pragma unroll
            for (int ks = 0; ks < 4; ++ks) acc = MFMA16(*(const bf16x8*)(buf + ((rt * 4 + ks) * 64 + lane) * 16), Sb[ks], acc);
            vn[rt] = U[rt] - acc;
        }
        bf16x8 Vb[2];
        Vb[0] = pack8(vn[0], vn[1]); Vb[1] = pack8(vn[2], vn[3]);
#pragma unroll
        for (int rt = 0; rt < 4; ++rt) {
            f32x4 acc = (f32x4){0.f, 0.f, 0.f, 0.f};
#pragma unroll
            for (int ks = 0; ks < 4; ++ks) acc = MFMA16(*(const bf16x8*)(buf + 16384 + ((rt * 4 + ks) * 64 + lane) * 16), Sb[ks], acc);
#pragma unroll
            for (int ks2 = 0; ks2 < 2; ++ks2) acc = MFMA16(*(const bf16x8*)(buf + 49152 + ((rt * 2 + ks2) * 64 + lane) * 16), Vb[ks2], acc);
#pragma unroll
            for (int j = 0; j < 4; ++j) OBUF[(16 * rt + 4 * fq + j) * OST + 16 * w + fr] = acc[j];
        }
#pragma unroll
        for (int dt = 0; dt < 8; ++dt) {
            f32x4 acc = S[dt] * dl;
#pragma unroll
            for (int ks2 = 0; ks2 < 2; ++ks2) acc = MFMA16(*(const bf16x8*)(buf + 32768 + ((dt * 2 + ks2) * 64 + lane) * 16), Vb[ks2], acc);
            S[dt] = acc;
        }
        if (nxt) {
#pragma unroll
            for (int i = 0; i < 7; ++i) *(u32x4*)(dyn_smem + ((c + 1) & 1) * OPB_B + (tid + 512 * i) * 16) = pf[i];
        }
        lds_barrier();
        {
            float o[16]; float ss = 0.f;
#pragma unroll
            for (int e4 = 0; e4 < 4; ++e4) { const f32x4 a = *(const f32x4*)(OBUF + erow * OST + 16 * ept + 4 * e4);
#pragma unroll
                for (int e = 0; e < 4; ++e) { o[4 * e4 + e] = a[e]; ss += a[e] * a[e]; } }
#pragma unroll
            for (int of = 1; of < 8; of <<= 1) ss += __shfl_xor(ss, of);
            if (erow < valid) {
                const float r = rsqrtf(ss * (1.f / 128.f) + 1e-6f);
                const size_t grow = (samp ? (size_t)MP + b * TS : (size_t)b * TP + (size_t)c * 64) + erow;
                const unsigned gw[8] = {g0.x, g0.y, g0.z, g0.w, g1.x, g1.y, g1.z, g1.w};
                unsigned ow[8];
#pragma unroll
                for (int e = 0; e < 8; ++e) {
                    const float ga = bflo(gw[e]), gb = bfhi(gw[e]);
                    ow[e] = pk2(o[2 * e] * r * nw[2 * e] * silu(ga), o[2 * e + 1] * r * nw[2 * e + 1] * silu(gb));
                }
                *(u32x4*)(OMIX + grow * 1024 + h * 128 + 16 * ept) = (u32x4){ow[0], ow[1], ow[2], ow[3]};
                *(u32x4*)(OMIX + grow * 1024 + h * 128 + 16 * ept + 8) = (u32x4){ow[4], ow[5], ow[6], ow[7]};
            }
        }
        lds_barrier();
#pragma unroll
        for (int rt = 0; rt < 4; ++rt) U[rt] = Un[rt];
        dl = dln; g0 = gn0; g1 = gn1;
    }
    float* So = p.out + (samp ? O_GS : O_GP) + (size_t)(b * 4 + h) * 128 * 128;
#pragma unroll
    for (int dt = 0; dt < 8; ++dt)
#pragma unroll
        for (int j = 0; j < 4; ++j) So[(size_t)(16 * dt + 4 * fq + j) * 128 + 16 * w + fr] = S[dt][j];
}

constexpr int L_KT = 0, L_VT = 2 * 16384, L_ALX = L_VT + 3 * 16384, L_IDX = L_ALX + 8 * 2 * 32 * 4, L_QF = L_IDX + 256;
static_assert(L_QF + 8 * 8 * 1024 <= LDS_BYTES, "attn LDS");
DI int crow32(int i, int hh) { return (i & 3) + 8 * (i >> 2) + 4 * hh; }

DI void attn_item(const Params& p, const int idx, const float* lamp) {
    unsigned char* ws = p.ws;
    const int tid = opaque_tid(), lane = tid & 63, w = __builtin_amdgcn_readfirstlane(tid >> 6), r = lane & 31, hh = lane >> 5;
    bool samp; int b, h, qb = 0, ntiles, lastw; size_t qbase, kbase; const bf16_t* vtb; int vstride; bool active;
    if (idx < 32) { samp = true; b = idx >> 2; h = idx & 3; qbase = (size_t)MP + b * TS; kbase = (size_t)MP + (size_t)b * TKS; ntiles = 65; lastw = 64; active = w == 0;
                    vtb = (const bf16_t*)(ws + WS_R6) + VT_S_OFF + (size_t)((b * 4 + h) * 128) * TKS; vstride = TKS; }
    else { const int j = idx - 32; samp = false; qb = 31 - (j >> 4); b = (j & 15) >> 2; h = j & 3; qbase = (size_t)b * TP + qb * 256; kbase = (size_t)b * TP; ntiles = 4 * qb + 4; lastw = 4 * qb + (w >> 1); active = true;
           vtb = (const bf16_t*)(ws + WS_R6) + (size_t)((b * 4 + h) * 128) * TP; vstride = TP; }
    const bf16_t* KALL = (const bf16_t*)(ws + WS_R5) + kbase * 512 + h * 128;
    bf16_t* QF = (bf16_t*)(dyn_smem + L_QF) + w * 8 * 64 * 8;
    {
        const bf16_t* qp = (const bf16_t*)(ws + WS_R4) + (qbase + 32 * w + r) * 512 + h * 128 + 8 * hh;
        if (active) {
#pragma unroll
            for (int f = 0; f < 8; ++f) *(u32x4*)(QF + (f * 64 + lane) * 8) = *(const u32x4*)(qp + (f >> 2) * 64 + 16 * (f & 3));
        }
    }
    f32x16 O1[4], O2[4];
#pragma unroll
    for (int t = 0; t < 4; ++t)
#pragma unroll
        for (int i = 0; i < 16; ++i) { O1[t][i] = 0.f; O2[t][i] = 0.f; }
    float m1 = -1e30f, m2 = -1e30f, l1 = 0.f, l2 = 0.f;
    auto stage_tile = [&](int kt_, int buf_, int vbuf_) {
        int ln = lane; asm volatile("" : "+v"(ln));
        const int krow_ = ln >> 4, vrow_ = ln >> 3;
        const unsigned kx = (ln & 15) ^ krow_, vx = (ln & 7) ^ (vrow_ >> 1);
        const unsigned klane = krow_ * 512, vlane = vrow_ * vstride;
#pragma unroll
        for (int j = 0; j < 2; ++j) {
            const int i = 2 * w + j;
            const bf16_t* kbase = KALL + ((size_t)kt_ * 64 + (((4 * i) & ~12) | (((4 * i) & 4) << 1) | (((4 * i) & 8) >> 1))) * 512;
            const bf16_t* vbase = vtb + (size_t)(8 * i) * vstride + (size_t)kt_ * 64;
            const unsigned ko = klane + ((kx ^ ((4 * i) & 15)) * 8), vo = vlane + ((vx ^ ((4 * i) & 7)) * 8);
            __builtin_amdgcn_global_load_lds((const unsigned*)(kbase + ko), (unsigned*)(dyn_smem + L_KT + buf_ * 16384 + i * 1024 + ln * 16), 16, 0, 0);
            __builtin_amdgcn_global_load_lds((const unsigned*)(vbase + vo), (unsigned*)(dyn_smem + L_VT + vbuf_ * 16384 + i * 1024 + ln * 16), 16, 0, 0);
        }
    };
    const int ky = hh ^ (r & 15), vzh = ((r >> 1) & 7) ^ hh;
    __syncthreads();
    stage_tile(0, 0, 0);
    asm volatile("s_waitcnt vmcnt(0)" ::: "memory");
    __syncthreads();
    if (active) {
#pragma unroll
        for (int mp = 0; mp < 2; ++mp) {
            float mx = -1e30f;
#pragma unroll
            for (int sub = 0; sub < 2; ++sub) {
                f32x16 sc;
#pragma unroll
                for (int i = 0; i < 16; ++i) sc[i] = 0.f;
#pragma unroll
                for (int s = 0; s < 4; ++s) {
                    const bf16x8 ka = *(const bf16x8*)(dyn_smem + L_KT + (sub * 32 + r) * 256 + (((mp * 8 + 2 * s) ^ ky) * 16));
                    const bf16x8 qf = *(const bf16x8*)(QF + ((mp * 4 + s) * 64 + lane) * 8);
                    sc = MFMA32(ka, qf, sc);
                }
#pragma unroll
                for (int i = 0; i < 16; ++i) mx = fmaxf(mx, sc[i]);
            }
            const auto sw = __builtin_amdgcn_permlane32_swap(__float_as_uint(mx), __float_as_uint(mx), false, false);
            mx = fmaxf(__uint_as_float(sw[0]), __uint_as_float(sw[1]));
            if (mp == 0) m1 = mx; else m2 = mx;
        }
    }
    const bool roleY = w >= 4;
    bf16x8 PA[2], PB[2];
    float tm1 = -1e30f, tm2 = -1e30f;
    int vcur = 0, vprev = 2;
#define ATT_QK(SUB, MP, SC) do { \
        _Pragma("unroll") for (int s_ = 0; s_ < 4; ++s_) { \
            const bf16x8 ka_ = *(const bf16x8*)(Kb + (SUB) * 32 * 256 + ((((MP) * 8 + 2 * s_) ^ ky) * 16)); \
            const bf16x8 qf_ = *(const bf16x8*)(QF + (((MP) * 4 + s_) * 64 + lane) * 8); \
            SC = MFMA32(ka_, qf_, s_ == 0 ? zero16 : SC); } } while (0)
#define ATT_SM(SC, P, MM, LL, TM, MSK) do { \
        float ps_ = 0.f, tq_ = TM; const float mr_ = MM + MSK; \
        _Pragma("unroll") for (int i_ = 0; i_ < 16; ++i_) { tq_ = fmaxf(tq_, SC[i_]); SC[i_] = __builtin_amdgcn_exp2f(SC[i_] - mr_); ps_ += SC[i_]; } \
        TM = MSK != 0.f ? TM : tq_; \
        LL += ps_; \
        _Pragma("unroll") for (int sp_ = 0; sp_ < 2; ++sp_) { \
            u32x4 a_; a_.x = pk2(SC[8 * sp_], SC[8 * sp_ + 1]); a_.y = pk2(SC[8 * sp_ + 2], SC[8 * sp_ + 3]); a_.z = pk2(SC[8 * sp_ + 4], SC[8 * sp_ + 5]); a_.w = pk2(SC[8 * sp_ + 6], SC[8 * sp_ + 7]); \
            P[sp_] = __builtin_bit_cast(bf16x8, a_); } } while (0)
#define ATT_PV2(VB, SUB, P1, P2) do { \
        _Pragma("unroll") for (int sp_ = 0; sp_ < 2; ++sp_) \
            _Pragma("unroll") for (int t_ = 0; t_ < 4; ++t_) { \
                const bf16x8 vb_ = *(const bf16x8*)((VB) + t_ * 32 * 128 + (((4 * (SUB) + 2 * sp_) ^ vzh) * 16)); \
                O1[t_] = MFMA32(P1[sp_], vb_, O1[t_]); O2[t_] = MFMA32(P2[sp_], vb_, O2[t_]); } } while (0)
#define ATT_QS(SUB, MSK) do { \
        f32x16 scA, scB; \
        ATT_QK(SUB, 0, scA); \
        __builtin_amdgcn_sched_barrier(0); \
        ATT_QK(SUB, 1, scB); \
        ATT_SM(scA, PA, m1, l1, tm1, MSK); \
        __builtin_amdgcn_sched_barrier(0); \
        ATT_SM(scB, PB, m2, l2, tm2, MSK); \
        __builtin_amdgcn_sched_barrier(0); } while (0)
#define ATT_CHECK() do { \
        const auto s1_ = __builtin_amdgcn_permlane32_swap(__float_as_uint(tm1), __float_as_uint(tm1), false, false); tm1 = fmaxf(__uint_as_float(s1_[0]), __uint_as_float(s1_[1])); \
        const auto s2_ = __builtin_amdgcn_permlane32_swap(__float_as_uint(tm2), __float_as_uint(tm2), false, false); tm2 = fmaxf(__uint_as_float(s2_[0]), __uint_as_float(s2_[1])); \
        const float n1 = tm1 > m1 + 8.f ? tm1 : m1, n2 = tm2 > m2 + 8.f ? tm2 : m2; \
        if (__any((n1 != m1) || (n2 != m2))) { \
            const float al1 = __builtin_amdgcn_exp2f(m1 - n1), al2 = __builtin_amdgcn_exp2f(m2 - n2); \
            l1 *= al1; l2 *= al2; m1 = n1; m2 = n2; \
            const int ln_ = __builtin_amdgcn_mbcnt_hi(~0u, __builtin_amdgcn_mbcnt_lo(~0u, 0u)), r_ = ln_ & 31, hh_ = ln_ >> 5; \
            float* alx_ = (float*)(dyn_smem + L_ALX) + w * 64; \
            if (hh_ == 0) { alx_[r_] = al1; alx_[32 + r_] = al2; } \
            asm volatile("s_waitcnt lgkmcnt(0)" ::: "memory"); \
            _Pragma("unroll") for (int g = 0; g < 4; ++g) { \
                const f32x4 a1 = *(const f32x4*)(alx_ + 8 * g + 4 * hh_), a2 = *(const f32x4*)(alx_ + 32 + 8 * g + 4 * hh_); \
                _Pragma("unroll") for (int t = 0; t < 4; ++t) \
                    _Pragma("unroll") for (int j = 0; j < 4; ++j) { O1[t][4 * g + j] *= a1[j]; O2[t][4 * g + j] *= a2[j]; } } \
            asm volatile("s_waitcnt lgkmcnt(0)" ::: "memory"); } \
        tm1 = -1e30f; tm2 = -1e30f; } while (0)
    f32x16 zero16;
#pragma unroll
    for (int i = 0; i < 16; ++i) zero16[i] = 0.f;
    if (!roleY) {
#pragma unroll 1
        for (int kt = 0; kt < ntiles; ++kt) {
            const int vnext = vcur == 2 ? 0 : vcur + 1;
            if (kt + 1 < ntiles) stage_tile(kt + 1, (kt + 1) & 1, vnext);
            const unsigned char* Kb = dyn_smem + L_KT + (kt & 1) * 16384 + r * 256;
            const unsigned char* Vb = dyn_smem + L_VT + vcur * 16384 + r * 128;
            if (active && kt <= lastw) {
                const float msk1 = (samp && kt == 64) ? 1e30f : 0.f;
#pragma unroll 1
                for (int sub = 0; sub < 2; ++sub) {
                    const float msk = sub ? msk1 : 0.f;
                    ATT_QS(sub, msk);
                    ATT_PV2(Vb, sub, PA, PB);
                    __builtin_amdgcn_sched_barrier(0);
                }
                ATT_CHECK();
            }
            vcur = vnext;
            asm volatile("s_waitcnt vmcnt(0)" ::: "memory");
            __builtin_amdgcn_s_barrier();
        }
    } else {
#pragma unroll 1
        for (int kt = 0; kt < ntiles; ++kt) {
            const int vnext = vcur == 2 ? 0 : vcur + 1;
            if (kt + 1 < ntiles) stage_tile(kt + 1, (kt + 1) & 1, vnext);
            const unsigned char* Kb = dyn_smem + L_KT + (kt & 1) * 16384 + r * 256;
            const unsigned char* Vb = dyn_smem + L_VT + vcur * 16384 + r * 128;
            const unsigned char* Vp = dyn_smem + L_VT + vprev * 16384 + r * 128;
            if (kt <= lastw + 1) {
                if (kt > 0) { ATT_PV2(Vp, 1, PA, PB); __builtin_amdgcn_sched_barrier(0); }
                if (kt <= lastw) {
                    ATT_CHECK();
                    ATT_QS(0, 0.f);
                    ATT_PV2(Vb, 0, PA, PB);
                    __builtin_amdgcn_sched_barrier(0);
                    ATT_QS(1, 0.f);
                }
            }
            vprev = vcur; vcur = vnext;
            asm volatile("s_waitcnt vmcnt(0)" ::: "memory");
            __builtin_amdgcn_s_barrier();
        }
        if (lastw == ntiles - 1) {
            const unsigned char* Vp = dyn_smem + L_VT + vprev * 16384 + r * 128;
            ATT_PV2(Vp, 1, PA, PB);
        }
    }
    if (active) {
        const int lnf = __builtin_amdgcn_mbcnt_hi(~0u, __builtin_amdgcn_mbcnt_lo(~0u, 0u)), r = lnf & 31, hh = lnf >> 5;
        float* ALX = (float*)(dyn_smem + L_ALX) + w * 64;
        { const auto s1_ = __builtin_amdgcn_permlane32_swap(__float_as_uint(l1), __float_as_uint(l1), false, false); l1 = __uint_as_float(s1_[0]) + __uint_as_float(s1_[1]);
          const auto s2_ = __builtin_amdgcn_permlane32_swap(__float_as_uint(l2), __float_as_uint(l2), false, false); l2 = __uint_as_float(s2_[0]) + __uint_as_float(s2_[1]); }
        if (hh == 0) { ALX[r] = __builtin_amdgcn_rcpf(l1); ALX[32 + r] = *lamp * __builtin_amdgcn_rcpf(l2); }
        asm volatile("s_waitcnt lgkmcnt(0)" ::: "memory");
        float ss[16], a1[16], a2[16];
#pragma unroll
        for (int g = 0; g < 4; ++g) {
            const f32x4 x1 = *(const f32x4*)(ALX + 8 * g + 4 * hh), x2 = *(const f32x4*)(ALX + 32 + 8 * g + 4 * hh);
#pragma unroll
            for (int j = 0; j < 4; ++j) { a1[4 * g + j] = x1[j]; a2[4 * g + j] = x2[j]; ss[4 * g + j] = 0.f; }
        }
#pragma unroll
        for (int t = 0; t < 4; ++t) {
            __builtin_amdgcn_sched_barrier(0);
#pragma unroll
            for (int i = 0; i < 16; ++i) { const float o = O1[t][i] * a1[i] - O2[t][i] * a2[i]; O1[t][i] = o; ss[i] += o * o; }
        }
        __builtin_amdgcn_sched_barrier(0);
#pragma unroll
        for (int i = 0; i < 16; ++i) {
#pragma unroll
            for (int of = 1; of < 32; of <<= 1) ss[i] += __shfl_xor(ss[i], of);
            ss[i] = __builtin_amdgcn_rsqf(ss[i] * (1.f / 128.f) + 1e-6f) * (1.f - LAM_INIT);
        }
        int zo = 0; asm volatile("" : "+v"(zo));
        bf16_t* obase = (bf16_t*)(ws + WS_R2) + (qbase + 32 * w) * 1024 + 512 + h * 128;
        const unsigned ooff = (unsigned)((4 * hh + zo) * 1024 + r);
        const float* sw = p.subln_w + r + zo;
#pragma unroll
        for (int t = 0; t < 4; ++t) {
            const float wv = sw[32 * t];
#pragma unroll
            for (int i = 0; i < 16; ++i) obase[ooff + ((i & 3) + 8 * (i >> 2)) * 1024 + 32 * t] = f2bf(O1[t][i] * ss[i] * wv);
        }
    }
}

DI void mixer_phase(const Params& p) {
    const int bid = blockIdx.x;
#ifndef NO_SCAN
    if (bid >= 16 && bid < 48) {
        float cw[3][4];
        gdn_conv_weights(p, (bid - 16) & 3, cw);
        gdn_prep_item(p, 2048 + bid - 16, cw);
        asm volatile("s_waitcnt vmcnt(0)" ::: "memory");
        __builtin_amdgcn_fence(__ATOMIC_ACQUIRE, "agent");
        asm volatile("s_waitcnt vmcnt(0)" ::: "memory");
        __syncthreads();
    }
    if (bid < 48) { const bool sm = bid >= 16; const int j = sm ? bid - 16 : bid;
#pragma unroll 1
        for (int rep = 0; rep < SREP; ++rep) gdn_scan(p, sm, j >> 2, j & 3); }
#endif
    unsigned* ctl = (unsigned*)(p.ws + WS_CTL);
    int* sidx = (int*)(dyn_smem + L_IDX);
    for (;;) {
        __syncthreads();
        if (threadIdx.x == 0) *sidx = (int)atomicAdd(ctl, 1u);
        __syncthreads();
        const int idx0 = __builtin_amdgcn_readfirstlane(*sidx);
        if (idx0 >= (32 + 512) * AREP) break;
        const int idx = idx0 % (32 + 512);
#ifndef NO_ATTN
        attn_item(p, idx, (const float*)ctl + 1);
#endif
    }
}


#define XB_TMO      128
#define XB_XCNT(j)  (256  + 64 * (j))
#define XB_XSUB(j)  (1280 + 64 * (j))
#define XB_XGEN(j)  (2304 + 64 * (j))
#define XB_TOP      3328
#define XB_TOPGEN   3392
#define XCD_BAR_WORDS 3456
#define XB_SPIN_CAP (1u << 20)
#define LAS __attribute__((address_space(3)))
DI unsigned xb_ld(unsigned* p) { return __hip_atomic_load(p, __ATOMIC_RELAXED, __HIP_MEMORY_SCOPE_AGENT); }
DI unsigned xb_add(unsigned* p, unsigned v) { return __hip_atomic_fetch_add(p, v, __ATOMIC_RELAXED, __HIP_MEMORY_SCOPE_AGENT); }
DI unsigned xb_xcc_id() { return (unsigned)__builtin_amdgcn_s_getreg((3 << 11) | 20) & 0xFu; }
#define XB_SPIN(cond, bar) do { unsigned _sp = 0; while (cond) { __builtin_amdgcn_s_sleep(1); \
    if ((++_sp & 255u) == 0u) { if (xb_ld(&(bar)[XB_TMO])) break; if (_sp > XB_SPIN_CAP) { atomicAdd(&(bar)[XB_TMO], 1u); break; } } } } while (0)
struct XcdBarrier { unsigned* bar; unsigned x; volatile LAS unsigned* st; };
DI XcdBarrier xcd_barrier_post(unsigned* bar, volatile LAS unsigned* st) {
    XcdBarrier b; b.bar = bar; b.x = xb_xcc_id(); b.st = st;
    if (threadIdx.x == 0) (void)xb_add(&bar[XB_XCNT(b.x)], 1u);
    return b;
}
DI void xcd_barrier_complete(unsigned* bar, unsigned x, unsigned& nloc, unsigned& nx) {
    const unsigned G = gridDim.x * gridDim.y * gridDim.z;
    unsigned sum, cnt, mine, sp = 0u;
    for (;;) {
        sum = 0u; cnt = 0u; mine = 0u;
#pragma unroll
        for (unsigned j = 0; j < 16; ++j) { const unsigned c = xb_ld(&bar[XB_XCNT(j)]); sum += c; cnt += (c > 0u) ? 1u : 0u; mine = (j == x) ? c : mine; }
        if (sum == G) break;
        __builtin_amdgcn_s_sleep(1);
        if ((++sp & 255u) == 0u) { if (xb_ld(&bar[XB_TMO])) break; if (sp > XB_SPIN_CAP) { atomicAdd(&bar[XB_TMO], 1u); break; } }
    }
    nloc = mine > 0u ? mine : 1u; nx = cnt > 0u ? cnt : 1u;
}
DI void xcd_barrier(const XcdBarrier& b) {
    asm volatile("s_waitcnt vmcnt(0)" ::: "memory");
    __syncthreads();
    if (threadIdx.x == 0) {
        unsigned* bar = b.bar;
        __builtin_amdgcn_s_waitcnt(0);
        unsigned nloc = b.st[0], nx = b.st[1];
        if (nloc == 0u) { xcd_barrier_complete(bar, b.x, nloc, nx); b.st[0] = nloc; b.st[1] = nx; }
        const unsigned old = xb_add(&bar[XB_XSUB(b.x)], 1u);
        const unsigned gen = old / nloc;
        if (old + 1u == (gen + 1u) * nloc) {
            __builtin_amdgcn_fence(__ATOMIC_RELEASE, "agent");
            asm volatile("s_waitcnt vmcnt(0)" ::: "memory");
            const unsigned og = xb_add(&bar[XB_TOP], 1u);
            const unsigned tg = og / nx;
            if (og + 1u == (tg + 1u) * nx) xb_add(&bar[XB_TOPGEN], 1u);
            else XB_SPIN(xb_ld(&bar[XB_TOPGEN]) == tg, bar);
            __builtin_amdgcn_fence(__ATOMIC_ACQUIRE, "agent");
            xb_add(&bar[XB_XGEN(b.x)], 1u);
            asm volatile("s_waitcnt vmcnt(0)" ::: "memory");
        } else {
            XB_SPIN(xb_ld(&bar[XB_XGEN(b.x)]) == gen, bar);
            __builtin_amdgcn_fence(__ATOMIC_ACQUIRE, "agent");
            asm volatile("s_waitcnt vmcnt(0)" ::: "memory");
        }
    }
    __syncthreads();
}

__global__ void __launch_bounds__(512, 2) fwd_kernel(Params p) {
    cg::grid_group grid = cg::this_grid();
    volatile LAS unsigned* xst = (volatile LAS unsigned*)(dyn_smem + LDS_BYTES - 16);
    if (threadIdx.x == 0) { xst[0] = 0u; xst[1] = 0u; }
    __syncthreads();
    const XcdBarrier xb = xcd_barrier_post((unsigned*)(p.ws + WS_BAR), xst);
    if (p.phase_lo > 1000) grid.sync();
    const bool all = p.phase_hi - p.phase_lo > 1;
#define PHASE(i, body) if (p.phase_lo <= (i) && (i) < p.phase_hi) { body; if (all && (i) + 1 < p.phase_hi) xcd_barrier(xb); }
    PHASE(0, phase_prep(p))
    PHASE(1, gemm_phase<1>(p))
    PHASE(2, gdn_prep_phase(p))
    PHASE(3, mixer_phase(p))
    PHASE(4, gemm_phase<2>(p))
    PHASE(5, ln_phase<0>(p))
    PHASE(6, gemm_phase<3>(p))
    PHASE(7, fixup_phase(p))
    PHASE(8, gemm_phase<4>(p))
    PHASE(9, ln_phase<1>(p))
}

extern "C" void kernel_launch(void* const* d_in, const int* in_sizes, int n_in, void* d_out, int out_size, void* d_ws, size_t ws_size, hipStream_t stream) {
    static int grid = 0;
    if (grid == 0) {
        if (n_in != 23 || (size_t)out_size != O_END || ws_size < WS_END2) { fprintf(stderr, "kernel_launch: unexpected sizes n_in %d out %d ws %zu (need %zu)\n", n_in, out_size, ws_size, (size_t)WS_END2); grid = -1; return; }
        int dev = 0, cus = 0, per_cu = 0;
        hipGetDevice(&dev);
        hipDeviceGetAttribute(&cus, hipDeviceAttributeMultiprocessorCount, dev);
        if (hipFuncSetAttribute((const void*)fwd_kernel, hipFuncAttributeMaxDynamicSharedMemorySize, LDS_BYTES) != hipSuccess) { fprintf(stderr, "kernel_launch: hipFuncSetAttribute failed\n"); grid = -1; return; }
        hipOccupancyMaxActiveBlocksPerMultiprocessor(&per_cu, (const void*)fwd_kernel, 512, LDS_BYTES);
        if (per_cu < 1) { fprintf(stderr, "kernel_launch: occupancy query says %d\n", per_cu); per_cu = 1; }
        (void)hipGetLastError();
        grid = cus * 1;
    }
    if (grid < 0) return;
    Params p{};
    const float** f = (const float**)&p;
    for (int i = 0; i < 23; ++i) f[i] = (const float*)d_in[i];
    p.out = (float*)d_out; p.ws = (unsigned char*)d_ws; p.phase_lo = 0; p.phase_hi = 10;
    if (hipMemsetAsync((unsigned char*)d_ws + WS_BAR, 0, 16384, stream) != hipSuccess) { fprintf(stderr, "kernel_launch: memset failed\n"); return; }
    void* args[] = {&p};
    hipError_t e = hipLaunchCooperativeKernel((const void*)fwd_kernel, dim3(grid), dim3(512), args, LDS_BYTES, stream);
    if (e != hipSuccess) fprintf(stderr, "cooperative launch failed: %s (grid %d)\n", hipGetErrorString(e), grid);
}
```

```cpp
#include <hip/hip_runtime.h>
#include <hip/hip_cooperative_groups.h>
#include <cstdio>
namespace cg = cooperative_groups;
#ifndef GREP_WHICH
#define GREP_WHICH 0
#endif
#ifndef AREP
#define AREP 1
#endif
#ifndef SREP
#define SREP 1
#endif

typedef unsigned short bf16_t;
typedef short bf16x8 __attribute__((ext_vector_type(8)));
typedef short s16x4 __attribute__((ext_vector_type(4)));
typedef float f32x4 __attribute__((ext_vector_type(4)));
typedef float f32x16 __attribute__((ext_vector_type(16)));
typedef unsigned u32x4 __attribute__((ext_vector_type(4)));
typedef unsigned u32x2 __attribute__((ext_vector_type(2)));
#define DI __device__ __forceinline__

constexpr int D = 1024, TP = 8192, BP = 4, MP = BP * TP, BS = 8, TS = 32, MS = BS * TS, M = MP + MS, PAST = 4096;
constexpr int DIN = 3592, NH1 = 3584, DFF = 2816, NUP = 2 * DFF;
constexpr int TKS = 4160;
constexpr int NITEM = BP * 128 * 4 + BS * 4;
constexpr int ITEM_B = 90112;
constexpr int LDS_BYTES = 160 * 1024;
constexpr float ALPHA = 1.189207115002721f;
constexpr float LAM_INIT = 0.2f;

constexpr size_t O_Y = 0, O_KP = 33816576, O_VP = 50593792, O_GP = 67371008, O_CQP = 67633152, O_CFP = 67651584,
                 O_KS = 67696640, O_VS = 67827712, O_GS = 67958784, O_CQS = 68483072, O_CFS = 68519936, O_END = 68610048;

constexpr size_t al256(size_t x) { return (x + 255) & ~(size_t)255; }
constexpr size_t WS_CTL = 0;
constexpr size_t WS_ROPE = 4096;
constexpr size_t WS_AB = WS_ROPE + (size_t)8192 * 32 * 8;
constexpr size_t WS_DL = WS_AB + (size_t)M * 8 * 4;
constexpr size_t WS_WIN = al256(WS_DL + NITEM * 4);
constexpr size_t WS_WO = WS_WIN + (size_t)NH1 * D * 2;
constexpr size_t WS_WUP = WS_WO + (size_t)D * D * 2;
constexpr size_t WS_WDN = WS_WUP + (size_t)NUP * D * 2;
constexpr size_t WS_R1 = al256(WS_WDN + (size_t)D * DFF * 2);
constexpr size_t R1_SIZE = (size_t)NITEM * ITEM_B;
constexpr size_t WS_R2 = al256(WS_R1 + R1_SIZE);
constexpr size_t WS_R3 = al256(WS_R2 + (size_t)M * 1536 * 2);
constexpr size_t WS_R4 = WS_R3 + (size_t)M * 512 * 2;
constexpr size_t WS_R5 = al256(WS_R4 + (size_t)M * 512 * 2);
constexpr size_t KROWS = (size_t)MP + (size_t)BS * TKS;
constexpr size_t WS_R6 = al256(WS_R5 + KROWS * 512 * 2);
constexpr size_t VT_S_OFF = (size_t)BP * 4 * 128 * TP;
constexpr size_t WS_END = al256(WS_R6 + (VT_S_OFF + (size_t)BS * 4 * 128 * TKS) * 2);
constexpr size_t WS_CS1 = WS_END;
constexpr size_t WS_CS2 = WS_CS1 + (size_t)MS * NH1 * 4;
constexpr size_t WS_CS3 = WS_CS2 + (size_t)MS * D * 4;
constexpr size_t WS_CS4 = WS_CS3 + (size_t)MS * NUP * 4;
constexpr size_t WS_BAR = WS_CS4 + (size_t)MS * D * 4;
constexpr size_t WS_END2 = WS_BAR + 16384;
static_assert((size_t)M * DFF * 2 <= R1_SIZE, "GT must fit R1");
static_assert(WS_END2 <= (size_t)536870912, "workspace too large");

struct Params {
    const float *x_p, *x_s, *cache_k, *cache_v, *state_gdn, *state_cq, *state_cf;
    const float *w_in, *gdn_conv_w, *a_log, *dt_bias, *gdn_norm_w, *diff_lambda, *subln_w, *w_o, *ln1_g, *ln1_b, *w_up,
        *ffn_conv_w, *ffn_conv_b, *w_down, *ln2_g, *ln2_b;
    float* out; unsigned char* ws;
    int phase_lo, phase_hi;
};

extern __shared__ __attribute__((aligned(16))) unsigned char dyn_smem[];

typedef __bf16 bf16x2_t __attribute__((ext_vector_type(2)));
typedef float f32x2 __attribute__((ext_vector_type(2)));
DI unsigned pk2(float lo, float hi) { f32x2 v = {lo, hi}; bf16x2_t b = __builtin_convertvector(v, bf16x2_t); return __builtin_bit_cast(unsigned, b); }
DI bf16_t f2bf(float x) { return (bf16_t)(pk2(x, 0.f) & 0xffffu); }
DI float bf2f(bf16_t b) { return __uint_as_float(((unsigned)b) << 16); }
DI float bflo(unsigned u) { return __uint_as_float(u << 16); }
DI float bfhi(unsigned u) { return __uint_as_float(u & 0xffff0000u); }
DI float silu(float x) { return x * __builtin_amdgcn_rcpf(1.f + __expf(-x)); }
DI void lds_barrier() { asm volatile("s_waitcnt lgkmcnt(0)\n\ts_barrier" ::: "memory"); }
DI int opaque_tid() { int t = threadIdx.x; asm volatile("" : "+v"(t)); return t; }
DI float wave_sum(float v) {
#pragma unroll
    for (int o = 1; o < 64; o <<= 1) v += __shfl_xor(v, o);
    return v;
}
DI const float* xrow_ptr(const Params& p, int row) { return row < MP ? p.x_p + (size_t)row * D : p.x_s + (size_t)(row - MP) * D; }

template <int MODE> DI int srccol(int n) {
    if (MODE == 1) {
        if (n < 2048) return n;
        return n + 8;
    }
    if (MODE == 2) { const int pn = n >> 8, j = n & 255; return j < 128 ? 128 * pn + j : DFF + 128 * pn + (j - 128); }
    return n;
}
struct TrItem { const float* W; bf16_t* WT; int K, N, k0, n0, mode; };
DI TrItem tr_decode(const Params& p, int it) {
    constexpr int I_IN = 16 * 56, I_O = 16 * 16, I_UP = 16 * 88;
    unsigned char* ws = p.ws; TrItem t; int r = it;
    if (r < I_IN) { t.W = p.w_in; t.WT = (bf16_t*)(ws + WS_WIN); t.K = D; t.N = DIN; t.k0 = (r / 56) * 64; t.n0 = (r % 56) * 64; t.mode = 1; return t; } r -= I_IN;
    if (r < I_O) { t.W = p.w_o; t.WT = (bf16_t*)(ws + WS_WO); t.K = D; t.N = D; t.k0 = (r / 16) * 64; t.n0 = (r % 16) * 64; t.mode = 0; return t; } r -= I_O;
    if (r < I_UP) { t.W = p.w_up; t.WT = (bf16_t*)(ws + WS_WUP); t.K = D; t.N = NUP; t.k0 = (r / 88) * 64; t.n0 = (r % 88) * 64; t.mode = 2; return t; } r -= I_UP;
    t.W = p.w_down; t.WT = (bf16_t*)(ws + WS_WDN); t.K = DFF; t.N = D; t.k0 = (r / 16) * 64; t.n0 = (r % 16) * 64; t.mode = 0; return t;
}
DI void tr_load(const TrItem& t, float (&v)[8]) {
    const int tid = threadIdx.x, n = t.n0 + (tid & 63);
    const int sc = t.mode == 1 ? (n < 2048 ? n : n + 8) : (t.mode == 2 ? srccol<2>(n) : n);
#pragma unroll
    for (int i = 0; i < 8; ++i) v[i] = __builtin_nontemporal_load(t.W + (size_t)(t.k0 + (tid >> 6) + 8 * i) * t.N + sc);
}
DI void transpose_range(const Params& p, const int lo, const int hi) {
    const int tid = opaque_tid(), nb = gridDim.x, bid = blockIdx.x;
    float* lds = (float*)dyn_smem;
    float v[8];
    lds_barrier();
    TrItem cur = tr_decode(p, lo + bid < hi ? lo + bid : lo);
    if (lo + bid < hi) tr_load(cur, v);
    for (int it = lo + bid; it < hi; it += nb) {
        float nv[8]; TrItem nx = cur;
        if (it + nb < hi) { nx = tr_decode(p, it + nb); tr_load(nx, nv); }
#pragma unroll
        for (int i = 0; i < 8; ++i) lds[((tid >> 6) + 8 * i) * 65 + (tid & 63)] = v[i];
        lds_barrier();
#pragma unroll
        for (int i = 0; i < 8; ++i) { const int nn = (tid >> 6) + 8 * i, kk = tid & 63; cur.WT[(size_t)(cur.n0 + nn) * cur.K + cur.k0 + kk] = f2bf(lds[kk * 65 + nn]); }
        lds_barrier();
#pragma unroll
        for (int i = 0; i < 8; ++i) v[i] = nv[i];
        cur = nx;
    }
}
DI void phase_prep(const Params& p) {
    const int tid = threadIdx.x, lane = tid & 63, wave = tid >> 6, nb = gridDim.x, bid = blockIdx.x;
    unsigned char* ws = p.ws;
    if (bid == 0 && tid < 64) {
        unsigned* ctl = (unsigned*)(ws + WS_CTL);
        float a = p.diff_lambda[lane] * p.diff_lambda[64 + lane], b = p.diff_lambda[128 + lane] * p.diff_lambda[192 + lane];
        a = wave_sum(a); b = wave_sum(b);
        if (lane == 0) { ctl[0] = 0u; ((float*)ctl)[1] = expf(a) - expf(b) + LAM_INIT; }
    }
    transpose_range(p, 0, 16 * 56);
    {
        float2* rope = (float2*)(ws + WS_ROPE);
        for (int idx = bid * 512 + tid; idx < 8192 * 32; idx += nb * 512) {
            const int pos = idx >> 5, d = idx & 31;
            const double inv = exp(-(double)d * (9.210340371976184 / 32.0));
            double a = (double)pos * inv;
            a -= 6.283185307179586 * rint(a * 0.15915494309189535);
            const float af = (float)a;
            rope[idx] = make_float2(__cosf(af), __sinf(af));
        }
    }
    {
        float* w8 = (float*)dyn_smem;
        __syncthreads();
        for (int i = tid; i < 1024 * 8; i += 512) w8[i] = p.w_in[(size_t)(i >> 3) * DIN + 2048 + (i & 7)];
        __syncthreads();
        bf16_t* XB = (bf16_t*)(ws + WS_R1);
        float* AB = (float*)(ws + WS_AB);
        f32x4 cv[4];
        {
            const int row = bid * 8 + wave;
            if (row < M) { const float* xr = xrow_ptr(p, row);
#pragma unroll
                for (int j = 0; j < 4; ++j) cv[j] = __builtin_nontemporal_load((const f32x4*)(xr + lane * 4 + 256 * j)); }
        }
        for (int row = bid * 8 + wave; row < M; row += nb * 8) {
            f32x4 nvx[4];
            if (row + nb * 8 < M) { const float* xn = xrow_ptr(p, row + nb * 8);
#pragma unroll
                for (int j = 0; j < 4; ++j) nvx[j] = __builtin_nontemporal_load((const f32x4*)(xn + lane * 4 + 256 * j)); }
            float acc[8];
#pragma unroll
            for (int c = 0; c < 8; ++c) acc[c] = 0.f;
#pragma unroll
            for (int j = 0; j < 4; ++j) {
                const int k0 = lane * 4 + 256 * j;
                const f32x4 v = cv[j];
                u32x2 o; o.x = pk2(v.x, v.y); o.y = pk2(v.z, v.w);
                *(u32x2*)(XB + (size_t)row * D + k0) = o;
#pragma unroll
                for (int e = 0; e < 4; ++e) {
                    const f32x4 wa = *(const f32x4*)(w8 + (k0 + e) * 8), wb = *(const f32x4*)(w8 + (k0 + e) * 8 + 4);
                    const float xv = v[e];
                    acc[0] += xv * wa.x; acc[1] += xv * wa.y; acc[2] += xv * wa.z; acc[3] += xv * wa.w;
                    acc[4] += xv * wb.x; acc[5] += xv * wb.y; acc[6] += xv * wb.z; acc[7] += xv * wb.w;
                }
            }
#pragma unroll
            for (int c = 0; c < 8; ++c) acc[c] = wave_sum(acc[c]);
            if (lane == 0) { *(f32x4*)(AB + (size_t)row * 8) = (f32x4){acc[0], acc[1], acc[2], acc[3]}; *(f32x4*)(AB + (size_t)row * 8 + 4) = (f32x4){acc[4], acc[5], acc[6], acc[7]}; }
#pragma unroll
            for (int j = 0; j < 4; ++j) cv[j] = nvx[j];
        }
        __syncthreads();
    }
}

DI void prep_stream(const Params& p) {
    const int tid = opaque_tid(), nb = gridDim.x, bid = blockIdx.x;
    unsigned char* ws = p.ws;
    transpose_range(p, 16 * 56, 16 * 56 + 16 * 16 + 16 * 88 + 44 * 16);
    lds_barrier();
    {
        bf16_t* KALL = (bf16_t*)(ws + WS_R5);
        const int nchunk = BS * TKS * 64;
        for (int c0 = bid * 512 + tid; c0 < nchunk; c0 += nb * 512 * 4) {
            f32x4 v0[4], v1[4]; int st[4]; size_t dsto[4];
#pragma unroll
            for (int u = 0; u < 4; ++u) {
                const int c = c0 + u * nb * 512;
                st[u] = 0;
                if (c < nchunk) {
                    const int col8 = c & 63, r = c >> 6, b = r / TKS, pp = r % TKS;
                    dsto[u] = ((size_t)MP + (size_t)b * TKS + pp) * 512 + col8 * 8;
                    if (pp < PAST) { const float* sp = p.cache_k + ((size_t)(b * PAST + pp) * 512 + col8 * 8); v0[u] = __builtin_nontemporal_load((const f32x4*)sp); v1[u] = __builtin_nontemporal_load((const f32x4*)(sp + 4)); st[u] = 1; }
                    else if (pp >= PAST + TS) st[u] = 2;
                }
            }
#pragma unroll
            for (int u = 0; u < 4; ++u) {
                if (st[u] == 1) { u32x4 o; o.x = pk2(v0[u].x, v0[u].y); o.y = pk2(v0[u].z, v0[u].w); o.z = pk2(v1[u].x, v1[u].y); o.w = pk2(v1[u].z, v1[u].w); *(u32x4*)(KALL + dsto[u]) = o; }
                else if (st[u] == 2) *(u32x4*)(KALL + dsto[u]) = (u32x4){0u, 0u, 0u, 0u};
            }
        }
    }
    {
        bf16_t* VTS = (bf16_t*)(ws + WS_R6) + VT_S_OFF;
        bf16_t* t = (bf16_t*)dyn_smem;
        f32x4 cvv[4];
        auto ldv = [&](int it, f32x4 (&v)[4]) {
            const int blk = it % 65, bh = it / 65, b = bh >> 2, h = bh & 3;
            if (blk < 64) {
#pragma unroll
                for (int i = 0; i < 4; ++i) { const int id = tid + 512 * i, key = id >> 5, c4 = id & 31;
                    v[i] = __builtin_nontemporal_load((const f32x4*)(p.cache_v + ((size_t)(b * PAST + blk * 64 + key) * 512 + h * 128 + c4 * 4))); }
            }
        };
        if (bid < BS * 4 * 65) ldv(bid, cvv);
        for (int it = bid; it < BS * 4 * 65; it += nb) {
            const int blk = it % 65, bh = it / 65;
            f32x4 nvv[4];
            if (it + nb < BS * 4 * 65) ldv(it + nb, nvv);
            if (blk < 64) {
                lds_barrier();
#pragma unroll
                for (int i = 0; i < 4; ++i) {
                    const int id = tid + 512 * i, key = id >> 5, c4 = id & 31;
                    const f32x4 v = cvv[i];
                    bf16_t* d = t + key * 130 + c4 * 4;
                    *(unsigned*)d = pk2(v.x, v.y); *(unsigned*)(d + 2) = pk2(v.z, v.w);
                }
                lds_barrier();
                const int dv = tid >> 2, part = tid & 3;
                unsigned o[8];
#pragma unroll
                for (int i = 0; i < 8; ++i) { const int k0 = part * 16 + 2 * i; o[i] = (unsigned)t[k0 * 130 + dv] | ((unsigned)t[(k0 + 1) * 130 + dv] << 16); }
                bf16_t* dst = VTS + ((size_t)(bh * 128 + dv) * TKS + blk * 64 + part * 16);
                *(u32x4*)dst = (u32x4){o[0], o[1], o[2], o[3]}; *(u32x4*)(dst + 8) = (u32x4){o[4], o[5], o[6], o[7]};
            } else {
                if (tid < 128) { bf16_t* dst = VTS + ((size_t)(bh * 128 + tid) * TKS + PAST + TS);
#pragma unroll
                    for (int i = 0; i < 4; ++i) *(u32x4*)(dst + 8 * i) = (u32x4){0u, 0u, 0u, 0u}; }
            }
#pragma unroll
            for (int i = 0; i < 4; ++i) cvv[i] = nvv[i];
        }
        lds_barrier();
    }
}

constexpr int BM = 256, BK = 64, HALF = 128, NXCD = 8, WGM = 8, HT = HALF * BK;
DI void stage_rc(int b, int& R, int& C) {
    const int st = b / 1024, sb = b % 1024, swz = sb ^ (((sb >> 9) & 1) << 5);
    R = (st >> 1) * 16 + swz / 64; C = (st & 1) * 32 + (swz % 64) / 2;
}
DI int lds_byte(int r, int c) {
    const int st = (r >> 4) * 2 + (c >> 5), rr = r & 15, cc = c & 31, ob = rr * 64 + cc * 2;
    return st * 1024 + (ob ^ (((ob >> 9) & 1) << 5));
}

#define SHM ((bf16_t*)dyn_smem)
#define SA(b, h) (SHM + ((b) * 2 + (h)) * HT)
#define SB(b, h) (SHM + (4 + (b) * 2 + (h)) * HT)
#define STAGE(P, BASE, br, kt) do { const bf16_t* _gb = (BASE) + ((long)(br) * K + (long)(kt) * BK); \
      __builtin_amdgcn_global_load_lds((const unsigned*)(_gb + so0), (unsigned*)((char*)(P) + wlds), 16, 0, 0); \
      __builtin_amdgcn_global_load_lds((const unsigned*)(_gb + 64 * K + so0), (unsigned*)((char*)(P) + wlds + 8192), 16, 0, 0); } while (0)
#define LDA(dst, b, h) for (int m = 0; m < 4; ++m) for (int k = 0; k < 2; ++k) \
    dst[m][k] = *reinterpret_cast<const bf16x8*>((char*)SA(b, h) + lds_byte(wr * 64 + m * 16 + fr, k * 32 + fq * 8))
#define LDB(dst, b, h) for (int n = 0; n < 2; ++n) for (int k = 0; k < 2; ++k) \
    dst[n][k] = *reinterpret_cast<const bf16x8*>((char*)SB(b, h) + lds_byte(wc * 32 + n * 16 + fr, k * 32 + fq * 8))
#define MMA(ai, bj, At, Bt_) do { __builtin_amdgcn_s_setprio(1); \
    for (int m = 0; m < 4; ++m) for (int n = 0; n < 2; ++n) for (int k = 0; k < 2; ++k) \
      acc[ai][bj][m][n] = __builtin_amdgcn_mfma_f32_16x16x32_bf16(Bt_[n][k], At[m][k], acc[ai][bj][m][n], 0, 0, 0); \
    __builtin_amdgcn_s_setprio(0); } while (0)
#define WAIT_V(n) asm volatile("s_waitcnt vmcnt(" #n ")" ::: "memory")
#define WAIT_L(n) asm volatile("s_waitcnt lgkmcnt(" #n ")" ::: "memory")
#define BAR __builtin_amdgcn_s_barrier()
#define SCHED __builtin_amdgcn_sched_barrier(0)

template <int K> DI void gemm_tile(const bf16_t* __restrict__ A, const bf16_t* __restrict__ Bt, const int brow, const int bcol, f32x4 (&acc)[2][2][4][2]) {
    const int wid = threadIdx.x >> 6, lane = threadIdx.x & 63, wr = wid >> 2, wc = wid & 3, fr = lane & 15, fq = lane >> 4;
    unsigned so0;
    { int _r, _c; stage_rc(threadIdx.x * 16, _r, _c); so0 = (unsigned)(_r * K + _c); }
    const int wlds = __builtin_amdgcn_readfirstlane((int)(threadIdx.x >> 6) << 10);
#pragma unroll
    for (int a = 0; a < 2; ++a)
#pragma unroll
        for (int b = 0; b < 2; ++b)
#pragma unroll
            for (int m = 0; m < 4; ++m)
#pragma unroll
                for (int n = 0; n < 2; ++n) acc[a][b][m][n] = (f32x4){0.f, 0.f, 0.f, 0.f};
    bf16x8 At[4][2], B0[2][2], B1[2][2];
    constexpr int nt = K / BK;
    STAGE(SB(0, 0), Bt, bcol, 0); STAGE(SA(0, 0), A, brow, 0);
    STAGE(SB(0, 1), Bt, bcol + HALF, 0); STAGE(SA(0, 1), A, brow + HALF, 0);
    if (wr == 1) BAR;
    WAIT_V(4); BAR;
    STAGE(SB(1, 0), Bt, bcol, 1); STAGE(SA(1, 0), A, brow, 1); STAGE(SB(1, 1), Bt, bcol + HALF, 1);
    WAIT_V(6); BAR;
    for (int t = 0; t < nt - 2; t += 2) {
        LDB(B0, 0, 0); SCHED; LDA(At, 0, 0); STAGE(SA(1, 1), A, brow + HALF, t + 1);
        WAIT_L(8); BAR; WAIT_L(0); MMA(0, 0, At, B0); BAR; SCHED;
        LDB(B1, 0, 1); STAGE(SB(0, 0), Bt, bcol, t + 2);
        BAR; WAIT_L(0); MMA(0, 1, At, B1); BAR;
        LDA(At, 0, 1); STAGE(SA(0, 0), A, brow, t + 2);
        BAR; WAIT_L(0); MMA(1, 0, At, B0); BAR; SCHED;
        STAGE(SB(0, 1), Bt, bcol + HALF, t + 2);
        WAIT_V(6); BAR; MMA(1, 1, At, B1); BAR;
        LDB(B0, 1, 0); SCHED; LDA(At, 1, 0); STAGE(SA(0, 1), A, brow + HALF, t + 2);
        WAIT_L(8); BAR; WAIT_L(0); MMA(0, 0, At, B0); BAR; SCHED;
        LDB(B1, 1, 1); STAGE(SB(1, 0), Bt, bcol, t + 3);
        BAR; WAIT_L(0); MMA(0, 1, At, B1); BAR;
        LDA(At, 1, 1); STAGE(SA(1, 0), A, brow, t + 3);
        BAR; WAIT_L(0); MMA(1, 0, At, B0); BAR; SCHED;
        STAGE(SB(1, 1), Bt, bcol + HALF, t + 3);
        WAIT_V(6); BAR; MMA(1, 1, At, B1); BAR;
    }
    { LDB(B0, 0, 0); LDA(At, 0, 0); STAGE(SA(1, 1), A, brow + HALF, nt - 1);
      BAR; WAIT_L(0); MMA(0, 0, At, B0); BAR;
      LDB(B1, 0, 1); BAR; WAIT_L(0); MMA(0, 1, At, B1); BAR;
      LDA(At, 0, 1); WAIT_V(4); BAR; WAIT_L(0); MMA(1, 0, At, B0); MMA(1, 1, At, B1); BAR; }
    { LDB(B0, 1, 0); LDA(At, 1, 0); WAIT_V(2); BAR; WAIT_L(0); MMA(0, 0, At, B0); BAR;
      LDB(B1, 1, 1); WAIT_V(0); BAR; WAIT_L(0); MMA(0, 1, At, B1); BAR;
      LDA(At, 1, 1); BAR; WAIT_L(0); MMA(1, 0, At, B0); MMA(1, 1, At, B1); BAR; }
    if (wr == 0) BAR;
}

DI void tile_of(int L, int nM, int nN, int& pm, int& pn) {
    const int nwg = nM * nN; int wgid = L;
    { const int q = nwg / NXCD, r = nwg % NXCD, xcd = wgid % NXCD, off = wgid / NXCD; wgid = (xcd < r ? xcd * (q + 1) : r * (q + 1) + (xcd - r) * q) + off; }
    const int nig = WGM * nN, gid = wgid / nig, fm = gid * WGM, gsz = min(nM - fm, WGM);
    pm = fm + ((wgid % nig) % gsz); pn = (wgid % nig) / gsz;
}

constexpr int CST = 260;
DI void stage_half(const f32x4 (&acc)[2][2][4][2], const int ai) {
    const int tid_ = opaque_tid(), wid = tid_ >> 6, lane = tid_ & 63, wr = wid >> 2, wc = wid & 3, fr = lane & 15, fq = lane >> 4;
    float* base = (float*)dyn_smem + (wr * 64 + fr) * CST + wc * 32 + 4 * fq;
#pragma unroll
    for (int m = 0; m < 4; ++m)
#pragma unroll
        for (int bj = 0; bj < 2; ++bj)
#pragma unroll
            for (int n = 0; n < 2; ++n) *(f32x4*)(base + (m * 16) * CST + bj * 128 + n * 16) = ai == 0 ? acc[0][bj][m][n] : acc[1][bj][m][n];
}
#define CT ((const float*)dyn_smem)

DI void epi_in_half(const Params& p, int pm, int pn, int ai) {
    unsigned char* ws = p.ws;
    const int tid = opaque_tid(), brow = pm * BM + ai * 128, bcol = pn * BM;
    const bool samp = pm == 128;
    if (pn < 8) {
        bf16_t* dst = pn < 6 ? (bf16_t*)(ws + WS_R2) : (bf16_t*)(ws + WS_R3);
        const int ld = pn < 6 ? 1536 : 512, c0 = pn < 6 ? bcol : bcol - 1536;
#pragma unroll 4
        for (int i = 0; i < 8; ++i) {
            const int id = tid + 512 * i, r = id >> 5, c8 = (id & 31) * 8, row = brow + r;
            const f32x4 v = *(const f32x4*)(CT + r * CST + c8), w = *(const f32x4*)(CT + r * CST + c8 + 4);
            *(u32x4*)(dst + (size_t)row * ld + c0 + c8) = (u32x4){pk2(v.x, v.y), pk2(v.z, v.w), pk2(w.x, w.y), pk2(w.z, w.w)};
            if (pn < 6) {
                const int t = row & (TP - 1);
                if (t >= TP - 3) { float* cd = p.out + O_CQP + (size_t)((row >> 13) * 3 + t - (TP - 3)) * 1536 + c0 + c8; *(f32x4*)cd = v; *(f32x4*)(cd + 4) = w; }
            }
        }
        return;
    }
    if (pn < 12) {
        const bool isq = pn < 10;
        const float* rope = (const float*)(ws + WS_ROPE);
        bf16_t* QB = (bf16_t*)(ws + WS_R4); bf16_t* KALL = (bf16_t*)(ws + WS_R5);
        const float qs = 0.125f * 1.4426950408889634f;
        f32x4 rt0[8], rt1[8];
#pragma unroll
        for (int i = 0; i < 8; ++i) {
            const int id = tid + 512 * i, r = id >> 5, q = id & 31, d4 = (q & 7) * 4, row = brow + r;
            const int pos = samp ? PAST + ((row - MP) & 31) : (row & (TP - 1));
            rt0[i] = *(const f32x4*)(rope + (size_t)(pos * 32 + d4) * 2); rt1[i] = *(const f32x4*)(rope + (size_t)(pos * 32 + d4) * 2 + 4);
        }
#pragma unroll
        for (int i = 0; i < 8; ++i) {
            const int id = tid + 512 * i, r = id >> 5, q = id & 31, hl = q >> 4, map = (q >> 3) & 1, d4 = (q & 7) * 4, row = brow + r;
            const int cl = hl * 128 + map * 64 + d4, col = ((pn & 1) * 2 + hl) * 128 + map * 64 + d4;
            const f32x4 x1 = *(const f32x4*)(CT + r * CST + cl), x2 = *(const f32x4*)(CT + r * CST + cl + 32);
            int pos; size_t krow; float* kout;
            if (!samp) { pos = row & (TP - 1); krow = row; kout = p.out + O_KP + (size_t)row * 512; }
            else { const int rr = row - MP; pos = PAST + (rr & 31); krow = (size_t)MP + (size_t)(rr >> 5) * TKS + pos; kout = p.out + O_KS + (size_t)rr * 512; }
            const f32x4 t0 = rt0[i], t1 = rt1[i];
            const f32x4 cs = (f32x4){t0.x, t0.z, t1.x, t1.z}, sn = (f32x4){t0.y, t0.w, t1.y, t1.w};
            const f32x4 y1 = x1 * cs - x2 * sn, y2 = x2 * cs + x1 * sn;
            if (isq) {
                u32x2 o1, o2; o1.x = pk2(y1.x * qs, y1.y * qs); o1.y = pk2(y1.z * qs, y1.w * qs); o2.x = pk2(y2.x * qs, y2.y * qs); o2.y = pk2(y2.z * qs, y2.w * qs);
                *(u32x2*)(QB + (size_t)row * 512 + col) = o1; *(u32x2*)(QB + (size_t)row * 512 + col + 32) = o2;
            } else {
                *(f32x4*)(kout + col) = y1; *(f32x4*)(kout + col + 32) = y2;
                u32x2 o1, o2; o1.x = pk2(y1.x, y1.y); o1.y = pk2(y1.z, y1.w); o2.x = pk2(y2.x, y2.y); o2.y = pk2(y2.z, y2.w);
                *(u32x2*)(KALL + krow * 512 + col) = o1; *(u32x2*)(KALL + krow * 512 + col + 32) = o2;
            }
        }
        return;
    }
    {
        bf16_t* VT = (bf16_t*)(ws + WS_R6);
#pragma unroll 4
        for (int i = 0; i < 16; ++i) {
            const int id = tid + 512 * i, r = id >> 6, c4 = (id & 63) * 4, row = brow + r, col = (pn & 1) * 256 + c4;
            const f32x4 v = *(const f32x4*)(CT + r * CST + c4);
            float* vout = samp ? p.out + O_VS + (size_t)(row - MP) * 512 + col : p.out + O_VP + (size_t)row * 512 + col;
            *(f32x4*)vout = v;
        }
#pragma unroll 1
        for (int i = 0; i < 2; ++i) {
            const int id = tid + 512 * i, rg = id >> 6, c4 = (id & 63) * 4, row0 = brow + rg * 8;
            f32x4 v[8];
#pragma unroll
            for (int e = 0; e < 8; ++e) v[e] = *(const f32x4*)(CT + (rg * 8 + e) * CST + c4);
#pragma unroll
            for (int e = 0; e < 4; ++e) {
                const int colg = (pn & 1) * 256 + c4 + e, head = colg >> 7, dv = colg & 127;
                u32x4 o; o.x = pk2(v[0][e], v[1][e]); o.y = pk2(v[2][e], v[3][e]); o.z = pk2(v[4][e], v[5][e]); o.w = pk2(v[6][e], v[7][e]);
                bf16_t* d;
                if (samp) { const int rr = row0 - MP; d = VT + VT_S_OFF + ((size_t)(((rr >> 5) * 4 + head) * 128 + dv) * TKS + PAST + (rr & 31)); }
                else d = VT + ((size_t)(((row0 >> 13) * 4 + head) * 128 + dv) * TP + (row0 & (TP - 1)));
                *(u32x4*)d = o;
            }
        }
    }
}

template <int WHICH> DI void epi_res_half(const Params& p, int pm, int pn, int ai) {
    const int tid = opaque_tid(), brow = pm * BM + ai * 128, bcol = pn * BM;
    bf16_t* dst = (bf16_t*)(p.ws + (WHICH == 0 ? WS_R1 : WS_R2));
    const bf16_t* X1B = (const bf16_t*)(p.ws + WS_R3);
    f32x4 xa[8], xb[8];
#pragma unroll
    for (int i = 0; i < 8; ++i) {
        const int id = tid + 512 * i, r = id >> 5, c8 = (id & 31) * 8, row = brow + r;
        if (WHICH == 0) { const float* xp = xrow_ptr(p, row) + bcol + c8; xa[i] = __builtin_nontemporal_load((const f32x4*)xp); xb[i] = __builtin_nontemporal_load((const f32x4*)(xp + 4)); }
        else { const u32x4 q = *(const u32x4*)(X1B + (size_t)row * D + bcol + c8); xa[i] = (f32x4){bflo(q.x), bfhi(q.x), bflo(q.y), bfhi(q.y)}; xb[i] = (f32x4){bflo(q.z), bfhi(q.z), bflo(q.w), bfhi(q.w)}; }
    }
#pragma unroll
    for (int i = 0; i < 8; ++i) {
        const int id = tid + 512 * i, r = id >> 5, c8 = (id & 31) * 8, row = brow + r;
        const f32x4 v = *(const f32x4*)(CT + r * CST + c8), w = *(const f32x4*)(CT + r * CST + c8 + 4);
        const f32x4 o = xa[i] * ALPHA + v, o2 = xb[i] * ALPHA + w;
        *(u32x4*)(dst + (size_t)row * D + bcol + c8) = (u32x4){pk2(o.x, o.y), pk2(o.z, o.w), pk2(o2.x, o2.y), pk2(o2.z, o2.w)};
    }
}

constexpr int UST = 264;
DI void epi_up(const Params& p, const f32x4 (&acc)[2][2][4][2], int pm, int pn) {
    unsigned char* ws = p.ws;
    bf16_t* U = (bf16_t*)dyn_smem;
    float* BND = (float*)(ws + WS_R5);
    const bool samp = pm == 128;
    const int brow = pm * BM, tid = opaque_tid();
    {
        const int wid = tid >> 6, lane = tid & 63, wr = wid >> 2, wc = wid & 3, fr = lane & 15, fq = lane >> 4;
        bf16_t* base = U + (wr * 64 + fr) * UST + wc * 32 + 4 * fq;
#pragma unroll
        for (int ai = 0; ai < 2; ++ai)
#pragma unroll
            for (int m = 0; m < 4; ++m)
#pragma unroll
                for (int bj = 0; bj < 2; ++bj)
#pragma unroll
                    for (int n = 0; n < 2; ++n) {
                        const f32x4 v = acc[ai][bj][m][n];
                        u32x2 q; q.x = pk2(v.x, v.y); q.y = pk2(v.z, v.w);
                        *(u32x2*)(base + (ai * 128 + m * 16) * UST + bj * 128 + n * 16) = q;
                    }
    }
    lds_barrier();
    {
        const int nb = samp ? 32 * 256 : 4 * 256;
        for (int id = tid; id < nb; id += 512) {
            const int cl = id & 255, q = id >> 8;
            const int oc = (cl >> 7) * DFF + 128 * pn + (cl & 127);
            int rr, bslot, u;
            if (!samp) { bslot = q; rr = q < 2 ? q : 252 + q; u = pm; }
            else { bslot = q & 3; rr = (q >> 2) * 32 + (bslot < 2 ? bslot : 28 + bslot); u = 128 + (q >> 2); }
            const float v = bf2f(U[rr * UST + cl]);
            BND[((size_t)u * 4 + bslot) * NUP + oc] = v;
            if (bslot >= 2) {
                if (samp) p.out[O_CFS + (size_t)((q >> 2) * 2 + bslot - 2) * NUP + oc] = v;
                else if ((pm & 31) == 31) p.out[O_CFP + (size_t)((pm >> 5) * 2 + bslot - 2) * NUP + oc] = v;
            }
        }
    }
    {
        const int cq = tid & 31, rs = tid >> 5, c = 4 * cq, cg_ = 128 * pn + c, cv_ = DFF + 128 * pn + c;
        const f32x4 wg0 = *(const f32x4*)(p.ffn_conv_w + cg_), wg1 = *(const f32x4*)(p.ffn_conv_w + NUP + cg_), wg2 = *(const f32x4*)(p.ffn_conv_w + 2 * NUP + cg_), bg = *(const f32x4*)(p.ffn_conv_b + cg_);
        const f32x4 wv0 = *(const f32x4*)(p.ffn_conv_w + cv_), wv1 = *(const f32x4*)(p.ffn_conv_w + NUP + cv_), wv2 = *(const f32x4*)(p.ffn_conv_w + 2 * NUP + cv_), bv = *(const f32x4*)(p.ffn_conv_b + cv_);
        bf16_t* GT = (bf16_t*)(ws + WS_R1);
        const int r0 = rs * 16;
        auto ld4 = [&](int rr, int cc) { const u32x2 q = *(const u32x2*)(U + rr * UST + cc); return (f32x4){bflo(q.x), bfhi(q.x), bflo(q.y), bfhi(q.y)}; };
        const f32x4 z4 = {0.f, 0.f, 0.f, 0.f};
        f32x4 g1 = z4, g2 = z4, v1 = z4, v2 = z4;
        if (r0 >= 2) { g1 = ld4(r0 - 2, c); g2 = ld4(r0 - 1, c); v1 = ld4(r0 - 2, 128 + c); v2 = ld4(r0 - 1, 128 + c); }
#pragma unroll 4
        for (int r = r0; r < r0 + 16; ++r) {
            const f32x4 g3 = ld4(r, c), v3 = ld4(r, 128 + c);
            if (r >= 2) {
                const f32x4 cg2 = wg0 * g1 + wg1 * g2 + wg2 * g3 + bg, cv2 = wv0 * v1 + wv1 * v2 + wv2 * v3 + bv;
                u32x2 q; q.x = pk2(silu(cg2.x) * cv2.x, silu(cg2.y) * cv2.y); q.y = pk2(silu(cg2.z) * cv2.z, silu(cg2.w) * cv2.w);
                *(u32x2*)(GT + (size_t)(brow + r) * DFF + 128 * pn + c) = q;
            }
            g1 = g2; g2 = g3; v1 = v2; v2 = v3;
        }
    }
}

template <int K> DI void skinny_gemm(const bf16_t* __restrict__ A, const bf16_t* __restrict__ Bt, float* __restrict__ C, const int N) {
    const int tid = opaque_tid(), lane = tid & 63, w = __builtin_amdgcn_readfirstlane(tid >> 6), fr = lane & 15, fq = lane >> 4;
    float* red = (float*)dyn_smem;
    constexpr int KW = K / 8, NKS = KW / 32;
    const int ntile = 8 * (N / 32);
    for (int t = blockIdx.x; t < ntile; t += gridDim.x) {
        const int rm = t & 7, cn = t >> 3;
        const bf16_t* ap = A + (size_t)(32 * rm + fr) * K + w * KW + 8 * fq;
        const bf16_t* bp = Bt + (size_t)(32 * cn + fr) * K + w * KW + 8 * fq;
        f32x4 acc[2][2];
#pragma unroll
        for (int i = 0; i < 2; ++i)
#pragma unroll
            for (int j = 0; j < 2; ++j) acc[i][j] = (f32x4){0.f, 0.f, 0.f, 0.f};
#pragma unroll 4
        for (int ks = 0; ks < NKS; ++ks) {
            const bf16x8 a0 = *(const bf16x8*)(ap + ks * 32), a1 = *(const bf16x8*)(ap + (size_t)16 * K + ks * 32);
            const bf16x8 b0 = *(const bf16x8*)(bp + ks * 32), b1 = *(const bf16x8*)(bp + (size_t)16 * K + ks * 32);
            acc[0][0] = __builtin_amdgcn_mfma_f32_16x16x32_bf16(a0, b0, acc[0][0], 0, 0, 0);
            acc[0][1] = __builtin_amdgcn_mfma_f32_16x16x32_bf16(a0, b1, acc[0][1], 0, 0, 0);
            acc[1][0] = __builtin_amdgcn_mfma_f32_16x16x32_bf16(a1, b0, acc[1][0], 0, 0, 0);
            acc[1][1] = __builtin_amdgcn_mfma_f32_16x16x32_bf16(a1, b1, acc[1][1], 0, 0, 0);
        }
        lds_barrier();
#pragma unroll
        for (int i = 0; i < 2; ++i)
#pragma unroll
            for (int j = 0; j < 2; ++j)
#pragma unroll
                for (int e = 0; e < 4; ++e) red[(w * 32 + 16 * i + 4 * fq + e) * 33 + 16 * j + fr] = acc[i][j][e];
        lds_barrier();
#pragma unroll
        for (int o2 = 0; o2 < 2; ++o2) {
            const int o = tid + 512 * o2, r = o >> 5, c = o & 31;
            float sum = 0.f;
#pragma unroll
            for (int ww = 0; ww < 8; ++ww) sum += red[(ww * 32 + r) * 33 + c];
            C[(size_t)(32 * rm + r) * N + 32 * cn + c] = sum;
        }
    }
    lds_barrier();
}

template <int WHICH> DI void gemm_phase(const Params& p) {
    unsigned char* ws = p.ws;
    const bf16_t* A; const bf16_t* Bt; int N; constexpr int K = WHICH == 4 ? DFF : D; float* CS;
    if (WHICH == 1) { A = (const bf16_t*)(ws + WS_R1); Bt = (const bf16_t*)(ws + WS_WIN); N = NH1; CS = (float*)(ws + WS_CS1); }
    else if (WHICH == 2) { A = (const bf16_t*)(ws + WS_R2); Bt = (const bf16_t*)(ws + WS_WO); N = D; CS = (float*)(ws + WS_CS2); }
    else if (WHICH == 3) { A = (const bf16_t*)(ws + WS_R3); Bt = (const bf16_t*)(ws + WS_WUP); N = NUP; CS = (float*)(ws + WS_CS3); }
    else { A = (const bf16_t*)(ws + WS_R1); Bt = (const bf16_t*)(ws + WS_WDN); N = D; CS = (float*)(ws + WS_CS4); }
    skinny_gemm<K>(A + (size_t)MP * K, Bt, CS, N);
    const int nM = MP / BM, nN = N / BM, ntile = nM * nN;
    for (int L0 = blockIdx.x; L0 < ntile * (WHICH == GREP_WHICH ? 2 : 1); L0 += gridDim.x) {
        const int L = L0 % ntile;
        int pm, pn; tile_of(L, nM, nN, pm, pn);
        f32x4 acc[2][2][4][2];
        gemm_tile<K>(A, Bt, pm * BM, pn * BM, acc);
        if (WHICH == 3) epi_up(p, acc, pm, pn);
        else {
#pragma unroll
            for (int ai = 0; ai < 2; ++ai) {
                stage_half(acc, ai);
                lds_barrier();
                if (WHICH == 1) epi_in_half(p, pm, pn, ai);
                else if (WHICH == 2) epi_res_half<0>(p, pm, pn, ai);
                else epi_res_half<1>(p, pm, pn, ai);
                lds_barrier();
            }
        }
        lds_barrier();
    }
}

template <int WHICH> DI void ln_phase(const Params& p) {
    const int lane = threadIdx.x & 63, wave = threadIdx.x >> 6;
    const float* g = WHICH == 0 ? p.ln1_g : p.ln2_g; const float* b = WHICH == 0 ? p.ln1_b : p.ln2_b;
    bf16_t* X1B = (bf16_t*)(p.ws + WS_R3);
    const bf16_t* PRE = (const bf16_t*)(p.ws + (WHICH == 0 ? WS_R1 : WS_R2));
    f32x4 gv[4], bv[4];
#pragma unroll
    for (int j = 0; j < 4; ++j) { gv[j] = *(const f32x4*)(g + lane * 4 + 256 * j); bv[j] = *(const f32x4*)(b + lane * 4 + 256 * j); }
    auto ld_row = [&](int row, f32x4 (&v)[4]) {
        if (row < MP) {
#pragma unroll
            for (int j = 0; j < 4; ++j) { const u32x2 q = __builtin_nontemporal_load((const u32x2*)(PRE + (size_t)row * D + lane * 4 + 256 * j)); v[j] = (f32x4){bflo(q.x), bfhi(q.x), bflo(q.y), bfhi(q.y)}; }
        } else {
            const float* cs = (const float*)(p.ws + (WHICH == 0 ? WS_CS2 : WS_CS4)) + (size_t)(row - MP) * D;
#pragma unroll
            for (int j = 0; j < 4; ++j) {
                f32x4 rs;
                if (WHICH == 0) rs = *(const f32x4*)(p.x_s + (size_t)(row - MP) * D + lane * 4 + 256 * j);
                else { const u32x2 q = *(const u32x2*)(X1B + (size_t)row * D + lane * 4 + 256 * j); rs = (f32x4){bflo(q.x), bfhi(q.x), bflo(q.y), bfhi(q.y)}; }
                v[j] = rs * ALPHA + *(const f32x4*)(cs + lane * 4 + 256 * j);
            }
        }
    };
    f32x4 v[4];
    if (blockIdx.x * 8 + wave < M) ld_row(blockIdx.x * 8 + wave, v);
    for (int row = blockIdx.x * 8 + wave; row < M; row += gridDim.x * 8) {
        f32x4 vn[4];
        const bool more = row + (int)gridDim.x * 8 < M;
        if (more) ld_row(row + gridDim.x * 8, vn);
        float s = 0.f;
#pragma unroll
        for (int j = 0; j < 4; ++j) s += (v[j].x + v[j].y) + (v[j].z + v[j].w);
        const float mean = wave_sum(s) * (1.f / D); float s2 = 0.f;
#pragma unroll
        for (int j = 0; j < 4; ++j) { v[j] = v[j] - mean; s2 += (v[j].x * v[j].x + v[j].y * v[j].y) + (v[j].z * v[j].z + v[j].w * v[j].w); }
        const float rstd = rsqrtf(wave_sum(s2) * (1.f / D) + 1e-5f);
#pragma unroll
        for (int j = 0; j < 4; ++j) {
            const f32x4 o = v[j] * rstd * gv[j] + bv[j];
            if (WHICH == 0) { u32x2 q; q.x = pk2(o.x, o.y); q.y = pk2(o.z, o.w); *(u32x2*)(X1B + (size_t)row * D + lane * 4 + 256 * j) = q; }
            else *(f32x4*)(p.out + O_Y + (size_t)row * D + lane * 4 + 256 * j) = o;
        }
        if (more) {
#pragma unroll
            for (int j = 0; j < 4; ++j) v[j] = vn[j];
        }
    }
}

DI void fixup_phase(const Params& p) {
    const float* BND = (const float*)(p.ws + WS_R5);
    bf16_t* GT = (bf16_t*)(p.ws + WS_R1);
    {
        const float* CS3 = (const float*)(p.ws + WS_CS3);
        for (int idx = blockIdx.x * 512 + threadIdx.x; idx < MS * DFF; idx += gridDim.x * 512) {
            const int c = idx % DFF, r = idx / DFF, b = r >> 5, t = r & 31, ng = (c >> 7) * 256 + (c & 127), nv = ng + 128;
            float g[3], v[3];
#pragma unroll
            for (int k = 0; k < 3; ++k) {
                const int tt = t - 2 + k;
                if (tt >= 0) { g[k] = CS3[(size_t)(b * 32 + tt) * NUP + ng]; v[k] = CS3[(size_t)(b * 32 + tt) * NUP + nv]; }
                else { g[k] = p.state_cf[(size_t)(b * 2 + 2 + tt) * NUP + c]; v[k] = p.state_cf[(size_t)(b * 2 + 2 + tt) * NUP + DFF + c]; }
            }
            const float cg2 = p.ffn_conv_w[c] * g[0] + p.ffn_conv_w[NUP + c] * g[1] + p.ffn_conv_w[2 * NUP + c] * g[2] + p.ffn_conv_b[c];
            const float cv2 = p.ffn_conv_w[DFF + c] * v[0] + p.ffn_conv_w[NUP + DFF + c] * v[1] + p.ffn_conv_w[2 * NUP + DFF + c] * v[2] + p.ffn_conv_b[DFF + c];
            GT[((size_t)MP + r) * DFF + c] = f2bf(silu(cg2) * cv2);
            if (t >= 30) { p.out[O_CFS + (size_t)(b * 2 + t - 30) * NUP + c] = g[2]; p.out[O_CFS + (size_t)(b * 2 + t - 30) * NUP + DFF + c] = v[2]; }
        }
    }
    const int total = 128 * 2 * DFF;
    for (int idx = blockIdx.x * 512 + threadIdx.x; idx < total; idx += gridDim.x * 512) {
        const int c = idx % DFF, q = idx / DFF, r = q & 1, u = q >> 1;
        const float* cur = BND + (size_t)u * 4 * NUP;
        float pg[2], pv[2];
        if (u < 128) {
            if ((u & 31) == 0) { pg[0] = pg[1] = pv[0] = pv[1] = 0.f; }
            else { const float* pr = BND + (size_t)(u - 1) * 4 * NUP; pg[0] = pr[2 * NUP + c]; pg[1] = pr[3 * NUP + c]; pv[0] = pr[2 * NUP + DFF + c]; pv[1] = pr[3 * NUP + DFF + c]; }
        } else { const float* st = p.state_cf + (size_t)(u - 128) * 2 * NUP; pg[0] = st[c]; pg[1] = st[NUP + c]; pv[0] = st[DFF + c]; pv[1] = st[NUP + DFF + c]; }
        const float cg0 = cur[c], cg1 = cur[NUP + c], cv0 = cur[DFF + c], cv1 = cur[NUP + DFF + c];
        const float wg0 = p.ffn_conv_w[c], wg1 = p.ffn_conv_w[NUP + c], wg2 = p.ffn_conv_w[2 * NUP + c], bg = p.ffn_conv_b[c];
        const float wv0 = p.ffn_conv_w[DFF + c], wv1 = p.ffn_conv_w[NUP + DFF + c], wv2 = p.ffn_conv_w[2 * NUP + DFF + c], bv = p.ffn_conv_b[DFF + c];
        float g, v;
        if (r == 0) { g = wg0 * pg[0] + wg1 * pg[1] + wg2 * cg0 + bg; v = wv0 * pv[0] + wv1 * pv[1] + wv2 * cv0 + bv; }
        else { g = wg0 * pg[1] + wg1 * cg0 + wg2 * cg1 + bg; v = wv0 * pv[1] + wv1 * cv0 + wv2 * cv1 + bv; }
        const size_t row = u < 128 ? (size_t)u * 256 + r : (size_t)MP + (size_t)(u - 128) * 32 + r;
        GT[row * DFF + c] = f2bf(silu(g) * v);
    }
}

#define MFMA16(a, b, c) __builtin_amdgcn_mfma_f32_16x16x32_bf16((a), (b), (c), 0, 0, 0)
#define MFMA32(a, b, c) __builtin_amdgcn_mfma_f32_32x32x16_bf16((a), (b), (c), 0, 0, 0)
DI bf16x8 pack8(const f32x4 a, const f32x4 b) { u32x4 o; o.x = pk2(a.x, a.y); o.y = pk2(a.z, a.w); o.z = pk2(b.x, b.y); o.w = pk2(b.z, b.w); return __builtin_bit_cast(bf16x8, o); }
constexpr float GSCALE = 0.08838834764831845f;
constexpr int QST = 132, AST = 68, NST = 136, QKST = 72;
constexpr int L_QKV = 0, L_AM = 3 * 64 * QST * 4, L_KN = L_AM + 64 * AST * 4, L_QN = L_KN + 64 * NST * 2, L_GC = L_QN + 64 * NST * 2;
constexpr int L_QKS = 0, L_WS = 64 * QKST * 2;
static_assert(L_GC + 1024 <= LDS_BYTES, "gdn prep LDS");

DI void gdn_conv_weights(const Params& p, const int h, float (&cw)[3][4]) {
#pragma unroll
    for (int k = 0; k < 3; ++k) {
        const int task = threadIdx.x + 512 * k, col = task % 384, part = col >> 7, cc = col & 127, gcol = part * 512 + h * 128 + cc;
#pragma unroll
        for (int j = 0; j < 4; ++j) cw[k][j] = p.gdn_conv_w[j * 1536 + gcol];
    }
}
DI void gdn_prep_item(const Params& p, const int item, const float (&cw)[3][4]) {
    unsigned char* ws = p.ws;
    float* QKVf = (float*)(dyn_smem + L_QKV); float* AM = (float*)(dyn_smem + L_AM);
    bf16_t* KN = (bf16_t*)(dyn_smem + L_KN); bf16_t* QN = (bf16_t*)(dyn_smem + L_QN);
    float* GC = (float*)(dyn_smem + L_GC); float* BETA = GC + 64; float* EG = GC + 128; float* ED = GC + 192;
    bf16_t* QKS = (bf16_t*)(dyn_smem + L_QKS); bf16_t* WSI = (bf16_t*)(dyn_smem + L_WS);
    const bf16_t* HQKV = (const bf16_t*)(ws + WS_R2);
    const float* AB = (const float*)(ws + WS_AB);
    float* DL = (float*)(ws + WS_DL);
        const int tid = opaque_tid(), lane = tid & 63, wave = __builtin_amdgcn_readfirstlane(tid >> 6), fr = lane & 15, fq = lane >> 4;
        int h, b, c, row0, valid; bool samp;
        if (item < 2048) { h = item & 3; c = (item >> 2) & 127; b = item >> 9; row0 = b * TP + c * 64; valid = 64; samp = false; }
        else { const int j = item - 2048; h = j & 3; b = j >> 2; c = 0; row0 = MP + b * TS; valid = TS; samp = true; }
        unsigned char* ip = ws + WS_R1 + (size_t)item * ITEM_B;
        lds_barrier();
        {
            bf16_t* RAW = (bf16_t*)(dyn_smem + L_AM);
#pragma unroll
            for (int i = 0; i < 7; ++i) {
                const int id = tid + 512 * i;
                if (id < 67 * 48) {
                    const int rw = id / 48, ch = id % 48, part = ch >> 4, c8 = (ch & 15) * 8, gcol = part * 512 + h * 128 + c8, t = rw - 3;
                    u32x4 v = (u32x4){0u, 0u, 0u, 0u};
                    if (t >= 0) {
                        if (t < valid) {
                            if (!samp) v = __builtin_nontemporal_load((const u32x4*)(HQKV + (size_t)(row0 + t) * 1536 + gcol));
                            else { const float* sp = (const float*)(ws + WS_CS1) + (size_t)(row0 - MP + t) * NH1 + gcol; const f32x4 f0 = *(const f32x4*)sp, f1 = *(const f32x4*)(sp + 4);
                                   v.x = pk2(f0.x, f0.y); v.y = pk2(f0.z, f0.w); v.z = pk2(f1.x, f1.y); v.w = pk2(f1.z, f1.w); }
                        }
                    }
                    else if (samp) { const float* sp = p.state_cq + (size_t)(b * 3 + 3 + t) * 1536 + gcol; const f32x4 f0 = *(const f32x4*)sp, f1 = *(const f32x4*)(sp + 4);
                                     v.x = pk2(f0.x, f0.y); v.y = pk2(f0.z, f0.w); v.z = pk2(f1.x, f1.y); v.w = pk2(f1.z, f1.w); }
                    else if (c != 0) v = *(const u32x4*)(HQKV + (size_t)(row0 + t) * 1536 + gcol);
                    *(u32x4*)(RAW + rw * 384 + ch * 8) = v;
                }
            }
            lds_barrier();
#pragma unroll
            for (int k3 = 0; k3 < 3; ++k3) {
                const int task = tid + 512 * k3;
                const int col = task % 384, seg = task / 384, part = col >> 7, cc = col & 127, t0 = seg * 16;
                const float w0 = cw[k3][0], w1 = cw[k3][1], w2 = cw[k3][2], w3 = cw[k3][3];
                float x0 = bf2f(RAW[(t0) * 384 + col]), x1 = bf2f(RAW[(t0 + 1) * 384 + col]), x2 = bf2f(RAW[(t0 + 2) * 384 + col]);
#pragma unroll
                for (int t = t0; t < t0 + 16; ++t) {
                    const float xv = bf2f(RAW[(t + 3) * 384 + col]);
                    const float y = w0 * x0 + w1 * x1 + w2 * x2 + w3 * xv;
                    QKVf[(part * 64 + t) * QST + cc] = t < valid ? silu(y) : 0.f;
                    x0 = x1; x1 = x2; x2 = xv;
                }
            }
        }
        if (tid < 64) {
            float g = 0.f, be = 0.f;
            if (tid < valid) {
                const float a = AB[(size_t)(row0 + tid) * 8 + h] + p.dt_bias[h], bb = AB[(size_t)(row0 + tid) * 8 + 4 + h];
                const float sp = a > 20.f ? a : log1pf(expf(a));
                g = -expf(p.a_log[h]) * sp; be = 1.f / (1.f + expf(-bb));
            }
            float gc = g;
#pragma unroll
            for (int o = 1; o < 64; o <<= 1) { const float n = __shfl_up(gc, o); if (lane >= o) gc += n; }
            const float gl = __shfl(gc, 63);
            GC[tid] = gc; BETA[tid] = be; EG[tid] = expf(gc); ED[tid] = expf(gl - gc);
            if (tid == 0) DL[item] = expf(gl);
        }
        lds_barrier();
        {
            const int row = tid >> 3, pt = tid & 7;
            float q[16], k[16]; float sq = 0.f, sk = 0.f;
#pragma unroll
            for (int e4 = 0; e4 < 4; ++e4) {
                const f32x4 a = *(const f32x4*)(QKVf + row * QST + 16 * pt + 4 * e4), bq = *(const f32x4*)(QKVf + (64 + row) * QST + 16 * pt + 4 * e4);
#pragma unroll
                for (int e = 0; e < 4; ++e) { q[4 * e4 + e] = a[e]; k[4 * e4 + e] = bq[e]; sq += a[e] * a[e]; sk += bq[e] * bq[e]; }
            }
#pragma unroll
            for (int o = 1; o < 8; o <<= 1) { sq += __shfl_xor(sq, o); sk += __shfl_xor(sk, o); }
            const float rq = rsqrtf(sq + 1e-6f), rk = rsqrtf(sk + 1e-6f), qg = rq * GSCALE * EG[row];
            u32x4 o0, o1;
            o0.x = pk2(q[0] * rq, q[1] * rq); o0.y = pk2(q[2] * rq, q[3] * rq); o0.z = pk2(q[4] * rq, q[5] * rq); o0.w = pk2(q[6] * rq, q[7] * rq);
            o1.x = pk2(q[8] * rq, q[9] * rq); o1.y = pk2(q[10] * rq, q[11] * rq); o1.z = pk2(q[12] * rq, q[13] * rq); o1.w = pk2(q[14] * rq, q[15] * rq);
            *(u32x4*)(QN + row * NST + 16 * pt) = o0; *(u32x4*)(QN + row * NST + 16 * pt + 8) = o1;
            o0.x = pk2(k[0] * rk, k[1] * rk); o0.y = pk2(k[2] * rk, k[3] * rk); o0.z = pk2(k[4] * rk, k[5] * rk); o0.w = pk2(k[6] * rk, k[7] * rk);
            o1.x = pk2(k[8] * rk, k[9] * rk); o1.y = pk2(k[10] * rk, k[11] * rk); o1.z = pk2(k[12] * rk, k[13] * rk); o1.w = pk2(k[14] * rk, k[15] * rk);
            *(u32x4*)(KN + row * NST + 16 * pt) = o0; *(u32x4*)(KN + row * NST + 16 * pt + 8) = o1;
#pragma unroll
            for (int e4 = 0; e4 < 4; ++e4) *(f32x4*)(QKVf + (64 + row) * QST + 16 * pt + 4 * e4) = (f32x4){k[4 * e4] * rk, k[4 * e4 + 1] * rk, k[4 * e4 + 2] * rk, k[4 * e4 + 3] * rk};
            bf16_t* QGf = (bf16_t*)(ip + 16384);
            const int rt = row >> 4, frr = row & 15, ks = pt >> 1;
#pragma unroll
            for (int f = 0; f < 4; ++f) {
                u32x2 o; o.x = pk2(q[4 * f] * qg, q[4 * f + 1] * qg); o.y = pk2(q[4 * f + 2] * qg, q[4 * f + 3] * qg);
                *(u32x2*)(QGf + (size_t)(((rt * 4 + ks) * 64 + f * 16 + frr) * 8 + 4 * (pt & 1))) = o;
            }
        }
        lds_barrier();
        {
            const bool isq = wave >= 4; const int ti = wave & 3;
            const bf16_t* As = isq ? QN : KN;
#pragma unroll
            for (int tj = 0; tj < 4; ++tj) {
                f32x4 acc = (f32x4){0.f, 0.f, 0.f, 0.f};
#pragma unroll
                for (int ks = 0; ks < 4; ++ks) {
                    const bf16x8 a = *(const bf16x8*)(As + (16 * ti + fr) * NST + 32 * ks + 8 * fq), bb = *(const bf16x8*)(KN + (16 * tj + fr) * NST + 32 * ks + 8 * fq);
                    acc = MFMA16(a, bb, acc);
                }
                const int jj = 16 * tj + fr; const float gj = GC[jj];
#pragma unroll
                for (int j = 0; j < 4; ++j) {
                    const int i = 16 * ti + 4 * fq + j;
                    const float dec = i >= jj ? __expf(GC[i] - gj) : 0.f;
                    if (!isq) AM[i * AST + jj] = i > jj ? BETA[i] * acc[j] * dec : 0.f;
                    else QKS[i * QKST + jj] = f2bf(GSCALE * acc[j] * dec);
                }
            }
            bf16_t* KDTf = (bf16_t*)(ip + 32768);
#pragma unroll
            for (int i2 = 0; i2 < 2; ++i2) {
                const int f = tid + 512 * i2, ln = f & 63, ks2 = (f >> 6) & 1, dt = f >> 7, fq_ = ln >> 4, dk = 16 * dt + (ln & 15);
                float v[8];
#pragma unroll
                for (int e = 0; e < 8; ++e) { const int i = 32 * ks2 + 16 * (e >> 2) + 4 * fq_ + (e & 3); v[e] = bf2f(KN[i * NST + dk]) * ED[i]; }
                u32x4 o; o.x = pk2(v[0], v[1]); o.y = pk2(v[2], v[3]); o.z = pk2(v[4], v[5]); o.w = pk2(v[6], v[7]);
                *(u32x4*)(KDTf + (size_t)f * 8) = o;
            }
        }
        lds_barrier();
        {
            float* TM = (float*)(dyn_smem + L_QN);
            float* TMP = (float*)(dyn_smem + L_KN);
#pragma unroll
            for (int i = 0; i < 9; ++i) { const int id = tid + 512 * i; if (id < 64 * AST) TM[id] = 0.f; }
            lds_barrier();
            if (tid < 64) {
                const int d = tid >> 4, c = tid & 15;
                float y[16];
#pragma unroll
                for (int r = 0; r < 16; ++r) {
                    float sacc = r == c ? 1.f : 0.f;
                    const float* ar = AM + (16 * d + r) * AST + 16 * d;
                    float arow[16];
#pragma unroll
                    for (int j4 = 0; j4 < (r + 3) / 4; ++j4) { const f32x4 a = *(const f32x4*)(ar + 4 * j4); arow[4 * j4] = a.x; arow[4 * j4 + 1] = a.y; arow[4 * j4 + 2] = a.z; arow[4 * j4 + 3] = a.w; }
#pragma unroll
                    for (int j = 0; j < r; ++j) sacc -= arow[j] * y[j];
                    y[r] = sacc;
                    TM[(16 * d + r) * AST + 16 * d + c] = sacc;
                }
            }
            lds_barrier();
            {
                const int blk = tid >> 8, r = (tid >> 4) & 15, c = tid & 15, rb = blk ? 3 : 1, cb = rb - 1;
                float t = 0.f;
#pragma unroll
                for (int j = 0; j < 16; ++j) t += AM[(16 * rb + r) * AST + 16 * cb + j] * TM[(16 * cb + j) * AST + 16 * cb + c];
                TMP[blk * 272 + r * 17 + c] = t;
                lds_barrier();
                float o = 0.f;
#pragma unroll
                for (int k = 0; k < 16; ++k) o -= TM[(16 * rb + r) * AST + 16 * rb + k] * TMP[blk * 272 + k * 17 + c];
                lds_barrier();
                TM[(16 * rb + r) * AST + 16 * cb + c] = o;
            }
            lds_barrier();
            {
                float t[2];
#pragma unroll
                for (int i2 = 0; i2 < 2; ++i2) {
                    const int o = tid + 512 * i2, r = o >> 5, c = o & 31;
                    float acc = 0.f;
#pragma unroll
                    for (int j4 = 0; j4 < 8; ++j4) {
                        const f32x4 a = *(const f32x4*)(AM + (32 + r) * AST + 4 * j4);
                        acc += a.x * TM[(4 * j4) * AST + c] + a.y * TM[(4 * j4 + 1) * AST + c] + a.z * TM[(4 * j4 + 2) * AST + c] + a.w * TM[(4 * j4 + 3) * AST + c];
                    }
                    t[i2] = acc;
                }
#pragma unroll
                for (int i2 = 0; i2 < 2; ++i2) { const int o = tid + 512 * i2; TMP[(o >> 5) * 33 + (o & 31)] = t[i2]; }
                lds_barrier();
#pragma unroll
                for (int i2 = 0; i2 < 2; ++i2) {
                    const int o = tid + 512 * i2, r = o >> 5, c = o & 31;
                    float acc = 0.f;
#pragma unroll
                    for (int k4 = 0; k4 < 8; ++k4) {
                        const f32x4 a = *(const f32x4*)(TM + (32 + r) * AST + 32 + 4 * k4);
                        acc -= a.x * TMP[(4 * k4) * 33 + c] + a.y * TMP[(4 * k4 + 1) * 33 + c] + a.z * TMP[(4 * k4 + 2) * 33 + c] + a.w * TMP[(4 * k4 + 3) * 33 + c];
                    }
                    t[i2] = acc;
                }
#pragma unroll
                for (int i2 = 0; i2 < 2; ++i2) { const int o = tid + 512 * i2; TM[(32 + (o >> 5)) * AST + (o & 31)] = t[i2]; }
            }
            lds_barrier();
            {
                bf16x8 Ah[4][2], Al[4][2];
#pragma unroll
                for (int rt = 0; rt < 4; ++rt)
#pragma unroll
                    for (int ks = 0; ks < 2; ++ks) {
                        const f32x4 a0 = *(const f32x4*)(TM + (16 * rt + fr) * AST + 32 * ks + 8 * fq), a1 = *(const f32x4*)(TM + (16 * rt + fr) * AST + 32 * ks + 8 * fq + 4);
                        u32x4 hq; hq.x = pk2(a0.x, a0.y); hq.y = pk2(a0.z, a0.w); hq.z = pk2(a1.x, a1.y); hq.w = pk2(a1.z, a1.w);
                        u32x4 lq; lq.x = pk2(a0.x - bflo(hq.x), a0.y - bfhi(hq.x)); lq.y = pk2(a0.z - bflo(hq.y), a0.w - bfhi(hq.y));
                        lq.z = pk2(a1.x - bflo(hq.z), a1.y - bfhi(hq.z)); lq.w = pk2(a1.z - bflo(hq.w), a1.w - bfhi(hq.w));
                        Ah[rt][ks] = __builtin_bit_cast(bf16x8, hq); Al[rt][ks] = __builtin_bit_cast(bf16x8, lq);
                    }
                const bool isw = wave >= 4;
                f32x4 xacc[2][4];
#pragma unroll
                for (int q = 0; q < 2; ++q)
#pragma unroll
                    for (int rt = 0; rt < 4; ++rt) xacc[q][rt] = (f32x4){0.f, 0.f, 0.f, 0.f};
#pragma unroll
                for (int ks = 0; ks < 2; ++ks) {
                    float sc8[8];
                    {
                        const f32x4 b0 = *(const f32x4*)(BETA + 32 * ks + 8 * fq), b1 = *(const f32x4*)(BETA + 32 * ks + 8 * fq + 4);
                        const f32x4 e0 = *(const f32x4*)(EG + 32 * ks + 8 * fq), e1 = *(const f32x4*)(EG + 32 * ks + 8 * fq + 4);
#pragma unroll
                        for (int e = 0; e < 4; ++e) { sc8[e] = isw ? b0[e] * e0[e] : b0[e]; sc8[4 + e] = isw ? b1[e] * e1[e] : b1[e]; }
                    }
#pragma unroll
                    for (int q = 0; q < 2; ++q) {
                        const int cc = ((2 * wave + q) & 7) * 16 + fr;
                        const float* src = QKVf + ((isw ? 64 : 128) + 32 * ks + 8 * fq) * QST + cc;
                        float v[8];
#pragma unroll
                        for (int e = 0; e < 8; ++e) v[e] = src[e * QST] * sc8[e];
                        u32x4 hq; hq.x = pk2(v[0], v[1]); hq.y = pk2(v[2], v[3]); hq.z = pk2(v[4], v[5]); hq.w = pk2(v[6], v[7]);
                        u32x4 lq; lq.x = pk2(v[0] - bflo(hq.x), v[1] - bfhi(hq.x)); lq.y = pk2(v[2] - bflo(hq.y), v[3] - bfhi(hq.y));
                        lq.z = pk2(v[4] - bflo(hq.z), v[5] - bfhi(hq.z)); lq.w = pk2(v[6] - bflo(hq.w), v[7] - bfhi(hq.w));
                        const bf16x8 Bh = __builtin_bit_cast(bf16x8, hq), Bl = __builtin_bit_cast(bf16x8, lq);
#pragma unroll
                        for (int rt = 0; rt < 4; ++rt) {
                            xacc[q][rt] = MFMA16(Ah[rt][ks], Bh, xacc[q][rt]);
                            xacc[q][rt] = MFMA16(Al[rt][ks], Bh, xacc[q][rt]);
                            xacc[q][rt] = MFMA16(Ah[rt][ks], Bl, xacc[q][rt]);
                        }
                    }
                }
                if (!isw) {
                    float* Uc = (float*)(ip + 57344);
#pragma unroll
                    for (int q = 0; q < 2; ++q)
#pragma unroll
                        for (int rt = 0; rt < 4; ++rt) *(f32x4*)(Uc + (size_t)((((2 * wave + q) * 4 + rt) * 64 + lane) * 4)) = xacc[q][rt];
                } else {
#pragma unroll
                    for (int q = 0; q < 2; ++q)
#pragma unroll
                        for (int rt = 0; rt < 4; ++rt)
#pragma unroll
                            for (int j = 0; j < 4; ++j) WSI[(16 * rt + 4 * fq + j) * NST + ((2 * wave + q) & 7) * 16 + fr] = f2bf(xacc[q][rt][j]);
                }
            }
        }
        lds_barrier();
        {
            bf16_t* Wf = (bf16_t*)ip; bf16_t* QKf = (bf16_t*)(ip + 49152);
#pragma unroll
            for (int i2 = 0; i2 < 2; ++i2) {
                const int f = tid + 512 * i2, ln = f & 63, ks = (f >> 6) & 3, rt = f >> 8, i = 16 * rt + (ln & 15), fq_ = ln >> 4;
                const u32x2 lo = *(const u32x2*)(WSI + i * NST + 32 * ks + 4 * fq_), hi = *(const u32x2*)(WSI + i * NST + 32 * ks + 16 + 4 * fq_);
                *(u32x4*)(Wf + (size_t)f * 8) = (u32x4){lo.x, lo.y, hi.x, hi.y};
            }
            {
                const int f = tid, ln = f & 63, ks2 = (f >> 6) & 1, rt = f >> 7, i = 16 * rt + (ln & 15), fq_ = ln >> 4;
                const u32x2 lo = *(const u32x2*)(QKS + i * QKST + 32 * ks2 + 4 * fq_), hi = *(const u32x2*)(QKS + i * QKST + 32 * ks2 + 16 + 4 * fq_);
                *(u32x4*)(QKf + (size_t)f * 8) = (u32x4){lo.x, lo.y, hi.x, hi.y};
            }
        }
    lds_barrier();
}

DI void gdn_prep_phase(const Params& p) {
    unsigned char* ws = p.ws;
    for (int r = blockIdx.x; r < MS; r += gridDim.x) {
        const int tid = opaque_tid(), b = r >> 5, t = r & 31, pos = PAST + t;
        const float* cs = (const float*)(ws + WS_CS1) + (size_t)r * NH1;
        if (t >= TS - 3) { for (int c = tid; c < 1536; c += 512) p.out[O_CQS + (size_t)(b * 3 + t - (TS - 3)) * 1536 + c] = cs[c]; }
        {
            const int which = tid >> 8, pr = tid & 255, hd = pr >> 6, mp = (pr >> 5) & 1, d = pr & 31, col = hd * 128 + mp * 64 + d;
            const float2 csn = ((const float2*)(ws + WS_ROPE))[pos * 32 + d];
            const float x1 = cs[2048 + which * 512 + col], x2 = cs[2048 + which * 512 + col + 32];
            const float y1 = x1 * csn.x - x2 * csn.y, y2 = x2 * csn.x + x1 * csn.y;
            if (which == 0) { const float qs = 0.125f * 1.4426950408889634f; bf16_t* QB = (bf16_t*)(ws + WS_R4) + ((size_t)MP + r) * 512; QB[col] = f2bf(y1 * qs); QB[col + 32] = f2bf(y2 * qs); }
            else { float* ko = p.out + O_KS + (size_t)r * 512; ko[col] = y1; ko[col + 32] = y2;
                   bf16_t* kk = (bf16_t*)(ws + WS_R5) + ((size_t)MP + (size_t)b * TKS + pos) * 512; kk[col] = f2bf(y1); kk[col + 32] = f2bf(y2); }
        }
        {
            const float vv = cs[3072 + tid];
            p.out[O_VS + (size_t)r * 512 + tid] = vv;
            ((bf16_t*)(ws + WS_R6))[VT_S_OFF + ((size_t)((b * 4 + (tid >> 7)) * 128 + (tid & 127)) * TKS + pos)] = f2bf(vv);
        }
    }
    float cw[3][4];
    gdn_conv_weights(p, blockIdx.x & 3, cw);
    {
        const int when = blockIdx.x & 7; int k = 0;
#pragma unroll 1
        for (int item = blockIdx.x; item < 2048; item += gridDim.x, ++k) { if (k == when) prep_stream(p); gdn_prep_item(p, item, cw); }
    }
}

constexpr int OPB_B = 57344, L_OBUF = 2 * OPB_B, OST = 132;
static_assert(L_OBUF + 64 * OST * 4 <= LDS_BYTES, "scan LDS");
DI void gdn_scan(const Params& p, const bool samp, const int b, const int h) {
    unsigned char* ws = p.ws;
    const int tid = threadIdx.x, lane = tid & 63, w = __builtin_amdgcn_readfirstlane(tid >> 6), fr = lane & 15, fq = lane >> 4;
    const int nsteps = samp ? 1 : 128, valid = samp ? TS : 64;
    float* OBUF = (float*)(dyn_smem + L_OBUF);
    const bf16_t* HG = (const bf16_t*)(ws + WS_R3);
    bf16_t* OMIX = (bf16_t*)(ws + WS_R2);
    const float* DL = (const float*)(ws + WS_DL);
    f32x4 S[8];
#pragma unroll
    for (int dt = 0; dt < 8; ++dt) {
        if (samp) {
#pragma unroll
            for (int j = 0; j < 4; ++j) S[dt][j] = p.state_gdn[((size_t)(b * 4 + h) * 128 + 16 * dt + 4 * fq + j) * 128 + 16 * w + fr];
        } else S[dt] = (f32x4){0.f, 0.f, 0.f, 0.f};
    }
    const int item0 = samp ? 2048 + b * 4 + h : b * 512 + h;
    lds_barrier();
    {
        const unsigned char* ip = ws + WS_R1 + (size_t)item0 * ITEM_B;
#pragma unroll
        for (int i = 0; i < 7; ++i) *(u32x4*)(dyn_smem + (tid + 512 * i) * 16) = *(const u32x4*)(ip + (tid + 512 * i) * 16);
    }
    lds_barrier();
    const int erow = tid >> 3, ept = tid & 7;
    float nw[16];
#pragma unroll
    for (int e = 0; e < 16; ++e) nw[e] = p.gdn_norm_w[16 * ept + e];
    f32x4 U[4]; float dl; u32x4 g0, g1;
    auto side_load = [&](int c, f32x4 (&Uo)[4], float& dlo, u32x4& go0, u32x4& go1) {
        const int item = item0 + 4 * c;
        const float* Uc = (const float*)(ws + WS_R1 + (size_t)item * ITEM_B + 57344);
#pragma unroll
        for (int rt = 0; rt < 4; ++rt) Uo[rt] = __builtin_nontemporal_load((const f32x4*)(Uc + ((w * 4 + rt) * 64 + lane) * 4));
        dlo = DL[item];
        const size_t grow = (samp ? (size_t)MP + b * TS : (size_t)b * TP + (size_t)c * 64) + erow;
        if (!samp) { go0 = *(const u32x4*)(HG + grow * 512 + h * 128 + 16 * ept); go1 = *(const u32x4*)(HG + grow * 512 + h * 128 + 16 * ept + 8); }
        else if (erow < TS) { const float* gp = (const float*)(ws + WS_CS1) + (grow - MP) * NH1 + 1536 + h * 128 + 16 * ept;
               const f32x4 f0 = *(const f32x4*)gp, f1 = *(const f32x4*)(gp + 4), f2 = *(const f32x4*)(gp + 8), f3 = *(const f32x4*)(gp + 12);
               go0 = (u32x4){pk2(f0.x, f0.y), pk2(f0.z, f0.w), pk2(f1.x, f1.y), pk2(f1.z, f1.w)}; go1 = (u32x4){pk2(f2.x, f2.y), pk2(f2.z, f2.w), pk2(f3.x, f3.y), pk2(f3.z, f3.w)}; }
        else { go0 = (u32x4){0u, 0u, 0u, 0u}; go1 = go0; }
    };
    side_load(0, U, dl, g0, g1);
#pragma unroll 1
    for (int c = 0; c < nsteps; ++c) {
        const int item = item0 + 4 * c;
        const unsigned char* ip = ws + WS_R1 + (size_t)item * ITEM_B;
        const bool nxt = c + 1 < nsteps;
        u32x4 pf[7];
        f32x4 Un[4]; float dln = 0.f; u32x4 gn0 = g0, gn1 = g1;
        if (nxt) {
#pragma unroll
            for (int i = 0; i < 7; ++i) pf[i] = __builtin_nontemporal_load((const u32x4*)(ip + 4 * (size_t)ITEM_B + (tid + 512 * i) * 16));
            side_load(c + 1, Un, dln, gn0, gn1);
        }
        const unsigned char* buf = dyn_smem + (c & 1) * OPB_B;
        bf16x8 Sb[4];
#pragma unroll
        for (int ks = 0; ks < 4; ++ks) Sb[ks] = pack8(S[2 * ks], S[2 * ks + 1]);
        f32x4 vn[4];
#pragma unroll
        for (int rt = 0; rt < 4; ++rt) {
            f32x4 acc = (f32x4){0.f, 0.f, 0.f, 0.f};
#pragma unroll
            for (int ks = 0; ks < 4; ++ks) acc = MFMA16(*(const bf16x8*)(buf + ((rt * 4 + ks) * 64 + lane) * 16), Sb[ks], acc);
            vn[rt] = U[rt] - acc;
        }
        bf16x8 Vb[2];
        Vb[0] = pack8(vn[0], vn[1]); Vb[1] = pack8(vn[2], vn[3]);
#pragma unroll
        for (int rt = 0; rt < 4; ++rt) {
            f32x4 acc = (f32x4){0.f, 0.f, 0.f, 0.f};
#pragma unroll
            for (int ks = 0; ks < 4; ++ks) acc = MFMA16(*(const bf16x8*)(buf + 16384 + ((rt * 4 + ks) * 64 + lane) * 16), Sb[ks], acc);
#pragma unroll
            for (int ks2 = 0; ks2 < 2; ++ks2) acc = MFMA16(*(const bf16x8*)(buf + 49152 + ((rt * 2 + ks2) * 64 + lane) * 16), Vb[ks2], acc);
#pragma unroll
            for (int j = 0; j < 4; ++j) OBUF[(16 * rt + 4 * fq + j) * OST + 16 * w + fr] = acc[j];
        }
#pragma unroll
        for (int dt = 0; dt < 8; ++dt) {
            f32x4 acc = S[dt] * dl;
#pragma unroll
            for (int ks2 = 0; ks2 < 2; ++ks2) acc = MFMA16(*(const bf16x8*)(buf + 32768 + ((dt * 2 + ks2) * 64 + lane) * 16), Vb[ks2], acc);
            S[dt] = acc;
        }
        if (nxt) {
#pragma unroll
            for (int i = 0; i < 7; ++i) *(u32x4*)(dyn_smem + ((c + 1) & 1) * OPB_B + (tid + 512 * i) * 16) = pf[i];
        }
        lds_barrier();
        {
            float o[16]; float ss = 0.f;
#pragma unroll
            for (int e4 = 0; e4 < 4; ++e4) { const f32x4 a = *(const f32x4*)(OBUF + erow * OST + 16 * ept + 4 * e4);
#pragma unroll
                for (int e = 0; e < 4; ++e) { o[4 * e4 + e] = a[e]; ss += a[e] * a[e]; } }
#pragma unroll
            for (int of = 1; of < 8; of <<= 1) ss += __shfl_xor(ss, of);
            if (erow < valid) {
                const float r = rsqrtf(ss * (1.f / 128.f) + 1e-6f);
                const size_t grow = (samp ? (size_t)MP + b * TS : (size_t)b * TP + (size_t)c * 64) + erow;
                const unsigned gw[8] = {g0.x, g0.y, g0.z, g0.w, g1.x, g1.y, g1.z, g1.w};
                unsigned ow[8];
#pragma unroll
                for (int e = 0; e < 8; ++e) {
                    const float ga = bflo(gw[e]), gb = bfhi(gw[e]);
                    ow[e] = pk2(o[2 * e] * r * nw[2 * e] * silu(ga), o[2 * e + 1] * r * nw[2 * e + 1] * silu(gb));
                }
                *(u32x4*)(OMIX + grow * 1024 + h * 128 + 16 * ept) = (u32x4){ow[0], ow[1], ow[2], ow[3]};
                *(u32x4*)(OMIX + grow * 1024 + h * 128 + 16 * ept + 8) = (u32x4){ow[4], ow[5], ow[6], ow[7]};
            }
        }
        lds_barrier();
#pragma unroll
        for (int rt = 0; rt < 4; ++rt) U[rt] = Un[rt];
        dl = dln; g0 = gn0; g1 = gn1;
    }
    float* So = p.out + (samp ? O_GS : O_GP) + (size_t)(b * 4 + h) * 128 * 128;
#pragma unroll
    for (int dt = 0; dt < 8; ++dt)
#pragma unroll
        for (int j = 0; j < 4; ++j) So[(size_t)(16 * dt + 4 * fq + j) * 128 + 16 * w + fr] = S[dt][j];
}

constexpr int L_KT = 0, L_VT = 2 * 16384, L_ALX = L_VT + 3 * 16384, L_IDX = L_ALX + 8 * 2 * 32 * 4, L_QF = L_IDX + 256;
static_assert(L_QF + 8 * 8 * 1024 <= LDS_BYTES, "attn LDS");
DI int crow32(int i, int hh) { return (i & 3) + 8 * (i >> 2) + 4 * hh; }

DI void attn_item(const Params& p, const int idx, const float* lamp) {
    unsigned char* ws = p.ws;
    const int tid = opaque_tid(), lane = tid & 63, w = __builtin_amdgcn_readfirstlane(tid >> 6), r = lane & 31, hh = lane >> 5;
    bool samp; int b, h, qb = 0, ntiles, lastw; size_t qbase, kbase; const bf16_t* vtb; int vstride; bool active;
    if (idx < 32) { samp = true; b = idx >> 2; h = idx & 3; qbase = (size_t)MP + b * TS; kbase = (size_t)MP + (size_t)b * TKS; ntiles = 65; lastw = 64; active = w == 0;
                    vtb = (const bf16_t*)(ws + WS_R6) + VT_S_OFF + (size_t)((b * 4 + h) * 128) * TKS; vstride = TKS; }
    else { const int j = idx - 32; samp = false; qb = 31 - (j >> 4); b = (j & 15) >> 2; h = j & 3; qbase = (size_t)b * TP + qb * 256; kbase = (size_t)b * TP; ntiles = 4 * qb + 4; lastw = 4 * qb + (w >> 1); active = true;
           vtb = (const bf16_t*)(ws + WS_R6) + (size_t)((b * 4 + h) * 128) * TP; vstride = TP; }
    const bf16_t* KALL = (const bf16_t*)(ws + WS_R5) + kbase * 512 + h * 128;
    bf16_t* QF = (bf16_t*)(dyn_smem + L_QF) + w * 8 * 64 * 8;
    {
        const bf16_t* qp = (const bf16_t*)(ws + WS_R4) + (qbase + 32 * w + r) * 512 + h * 128 + 8 * hh;
        if (active) {
#pragma unroll
            for (int f = 0; f < 8; ++f) *(u32x4*)(QF + (f * 64 + lane) * 8) = *(const u32x4*)(qp + (f >> 2) * 64 + 16 * (f & 3));
        }
    }
    f32x16 O1[4], O2[4];
#pragma unroll
    for (int t = 0; t < 4; ++t)
#pragma unroll
        for (int i = 0; i < 16; ++i) { O1[t][i] = 0.f; O2[t][i] = 0.f; }
    float m1 = -1e30f, m2 = -1e30f, l1 = 0.f, l2 = 0.f;
    auto stage_tile = [&](int kt_, int buf_, int vbuf_) {
        int ln = lane; asm volatile("" : "+v"(ln));
        const int krow_ = ln >> 4, vrow_ = ln >> 3;
        const unsigned kx = (ln & 15) ^ krow_, vx = (ln & 7) ^ (vrow_ >> 1);
        const unsigned klane = krow_ * 512, vlane = vrow_ * vstride;
#pragma unroll
        for (int j = 0; j < 2; ++j) {
            const int i = 2 * w + j;
            const bf16_t* kbase = KALL + ((size_t)kt_ * 64 + (((4 * i) & ~12) | (((4 * i) & 4) << 1) | (((4 * i) & 8) >> 1))) * 512;
            const bf16_t* vbase = vtb + (size_t)(8 * i) * vstride + (size_t)kt_ * 64;
            const unsigned ko = klane + ((kx ^ ((4 * i) & 15)) * 8), vo = vlane + ((vx ^ ((4 * i) & 7)) * 8);
            __builtin_amdgcn_global_load_lds((const unsigned*)(kbase + ko), (unsigned*)(dyn_smem + L_KT + buf_ * 16384 + i * 1024 + ln * 16), 16, 0, 0);
            __builtin_amdgcn_global_load_lds((const unsigned*)(vbase + vo), (unsigned*)(dyn_smem + L_VT + vbuf_ * 16384 + i * 1024 + ln * 16), 16, 0, 0);
        }
    };
    const int ky = hh ^ (r & 15), vzh = ((r >> 1) & 7) ^ hh;
    __syncthreads();
    stage_tile(0, 0, 0);
    asm volatile("s_waitcnt vmcnt(0)" ::: "memory");
    __syncthreads();
    if (active) {
#pragma unroll
        for (int mp = 0; mp < 2; ++mp) {
            float mx = -1e30f;
#pragma unroll
            for (int sub = 0; sub < 2; ++sub) {
                f32x16 sc;
#pragma unroll
                for (int i = 0; i < 16; ++i) sc[i] = 0.f;
#pragma unroll
                for (int s = 0; s < 4; ++s) {
                    const bf16x8 ka = *(const bf16x8*)(dyn_smem + L_KT + (sub * 32 + r) * 256 + (((mp * 8 + 2 * s) ^ ky) * 16));
                    const bf16x8 qf = *(const bf16x8*)(QF + ((mp * 4 + s) * 64 + lane) * 8);
                    sc = MFMA32(ka, qf, sc);
                }
#pragma unroll
                for (int i = 0; i < 16; ++i) mx = fmaxf(mx, sc[i]);
            }
            const auto sw = __builtin_amdgcn_permlane32_swap(__float_as_uint(mx), __float_as_uint(mx), false, false);
            mx = fmaxf(__uint_as_float(sw[0]), __uint_as_float(sw[1]));
            if (mp == 0) m1 = mx; else m2 = mx;
        }
    }
    const bool roleY = w >= 4;
    bf16x8 PA[2], PB[2];
    float tm1 = -1e30f, tm2 = -1e30f;
    int vcur = 0, vprev = 2;
#define ATT_QK(SUB, MP, SC) do { \
        _Pragma("unroll") for (int s_ = 0; s_ < 4; ++s_) { \
            const bf16x8 ka_ = *(const bf16x8*)(Kb + (SUB) * 32 * 256 + ((((MP) * 8 + 2 * s_) ^ ky) * 16)); \
            const bf16x8 qf_ = *(const bf16x8*)(QF + (((MP) * 4 + s_) * 64 + lane) * 8); \
            SC = MFMA32(ka_, qf_, s_ == 0 ? zero16 : SC); } } while (0)
#define ATT_SM(SC, P, MM, LL, TM, MSK) do { \
        float ps_ = 0.f, tq_ = TM; const float mr_ = MM + MSK; \
        _Pragma("unroll") for (int i_ = 0; i_ < 16; ++i_) { tq_ = fmaxf(tq_, SC[i_]); SC[i_] = __builtin_amdgcn_exp2f(SC[i_] - mr_); ps_ += SC[i_]; } \
        TM = MSK != 0.f ? TM : tq_; \
        LL += ps_; \
        _Pragma("unroll") for (int sp_ = 0; sp_ < 2; ++sp_) { \
            u32x4 a_; a_.x = pk2(SC[8 * sp_], SC[8 * sp_ + 1]); a_.y = pk2(SC[8 * sp_ + 2], SC[8 * sp_ + 3]); a_.z = pk2(SC[8 * sp_ + 4], SC[8 * sp_ + 5]); a_.w = pk2(SC[8 * sp_ + 6], SC[8 * sp_ + 7]); \
            P[sp_] = __builtin_bit_cast(bf16x8, a_); } } while (0)
#define ATT_PV2(VB, SUB, P1, P2) do { \
        _Pragma("unroll") for (int sp_ = 0; sp_ < 2; ++sp_) \
            _Pragma("unroll") for (int t_ = 0; t_ < 4; ++t_) { \
                const bf16x8 vb_ = *(const bf16x8*)((VB) + t_ * 32 * 128 + (((4 * (SUB) + 2 * sp_) ^ vzh) * 16)); \
                O1[t_] = MFMA32(P1[sp_], vb_, O1[t_]); O2[t_] = MFMA32(P2[sp_], vb_, O2[t_]); } } while (0)
#define ATT_QS(SUB, MSK) do { \
        f32x16 scA, scB; \
        ATT_QK(SUB, 0, scA); \
        __builtin_amdgcn_sched_barrier(0); \
        ATT_QK(SUB, 1, scB); \
        ATT_SM(scA, PA, m1, l1, tm1, MSK); \
        __builtin_amdgcn_sched_barrier(0); \
        ATT_SM(scB, PB, m2, l2, tm2, MSK); \
        __builtin_amdgcn_sched_barrier(0); } while (0)
#define ATT_CHECK() do { \
        const auto s1_ = __builtin_amdgcn_permlane32_swap(__float_as_uint(tm1), __float_as_uint(tm1), false, false); tm1 = fmaxf(__uint_as_float(s1_[0]), __uint_as_float(s1_[1])); \
        const auto s2_ = __builtin_amdgcn_permlane32_swap(__float_as_uint(tm2), __float_as_uint(tm2), false, false); tm2 = fmaxf(__uint_as_float(s2_[0]), __uint_as_float(s2_[1])); \
        const float n1 = tm1 > m1 + 8.f ? tm1 : m1, n2 = tm2 > m2 + 8.f ? tm2 : m2; \
        if (__any((n1 != m1) || (n2 != m2))) { \
            const float al1 = __builtin_amdgcn_exp2f(m1 - n1), al2 = __builtin_amdgcn_exp2f(m2 - n2); \
            l1 *= al1; l2 *= al2; m1 = n1; m2 = n2; \
            const int ln_ = __builtin_amdgcn_mbcnt_hi(~0u, __builtin_amdgcn_mbcnt_lo(~0u, 0u)), r_ = ln_ & 31, hh_ = ln_ >> 5; \
            float* alx_ = (float*)(dyn_smem + L_ALX) + w * 64; \
            if (hh_ == 0) { alx_[r_] = al1; alx_[32 + r_] = al2; } \
            asm volatile("s_waitcnt lgkmcnt(0)" ::: "memory"); \
            _Pragma("unroll") for (int g = 0; g < 4; ++g) { \
                const f32x4 a1 = *(const f32x4*)(alx_ + 8 * g + 4 * hh_), a2 = *(const f32x4*)(alx_ + 32 + 8 * g + 4 * hh_); \
                _Pragma("unroll") for (int t = 0; t < 4; ++t) \
                    _Pragma("unroll") for (int j = 0; j < 4; ++j) { O1[t][4 * g + j] *= a1[j]; O2[t][4 * g + j] *= a2[j]; } } \
            asm volatile("s_waitcnt lgkmcnt(0)" ::: "memory"); } \
        tm1 = -1e30f; tm2 = -1e30f; } while (0)
    f32x16 zero16;
#pragma unroll
    for (int i = 0; i < 16; ++i) zero16[i] = 0.f;
    if (!roleY) {
#pragma unroll 1
        for (int kt = 0; kt < ntiles; ++kt) {
            const int vnext = vcur == 2 ? 0 : vcur + 1;
            if (kt + 1 < ntiles) stage_tile(kt + 1, (kt + 1) & 1, vnext);
            const unsigned char* Kb = dyn_smem + L_KT + (kt & 1) * 16384 + r * 256;
            const unsigned char* Vb = dyn_smem + L_VT + vcur * 16384 + r * 128;
            if (active && kt <= lastw) {
                const float msk1 = (samp && kt == 64) ? 1e30f : 0.f;
#pragma unroll 1
                for (int sub = 0; sub < 2; ++sub) {
                    const float msk = sub ? msk1 : 0.f;
                    ATT_QS(sub, msk);
                    ATT_PV2(Vb, sub, PA, PB);
                    __builtin_amdgcn_sched_barrier(0);
                }
                ATT_CHECK();
            }
            vcur = vnext;
            asm volatile("s_waitcnt vmcnt(0)" ::: "memory");
            __builtin_amdgcn_s_barrier();
        }
    } else {
#pragma unroll 1
        for (int kt = 0; kt < ntiles; ++kt) {
            const int vnext = vcur == 2 ? 0 : vcur + 1;
            if (kt + 1 < ntiles) stage_tile(kt + 1, (kt + 1) & 1, vnext);
            const unsigned char* Kb = dyn_smem + L_KT + (kt & 1) * 16384 + r * 256;
            const unsigned char* Vb = dyn_smem + L_VT + vcur * 16384 + r * 128;
            const unsigned char* Vp = dyn_smem + L_VT + vprev * 16384 + r * 128;
            if (kt <= lastw + 1) {
                if (kt > 0) { ATT_PV2(Vp, 1, PA, PB); __builtin_amdgcn_sched_barrier(0); }
                if (kt <= lastw) {
                    ATT_CHECK();
                    ATT_QS(0, 0.f);
                    ATT_PV2(Vb, 0, PA, PB);
                    __builtin_amdgcn_sched_barrier(0);
                    ATT_QS(1, 0.f);
                }
            }
            vprev = vcur; vcur = vnext;
            asm volatile("s_waitcnt vmcnt(0)" ::: "memory");
            __builtin_amdgcn_s_barrier();
        }
        if (lastw == ntiles - 1) {
            const unsigned char* Vp = dyn_smem + L_VT + vprev * 16384 + r * 128;
            ATT_PV2(Vp, 1, PA, PB);
        }
    }
    if (active) {
        const int lnf = __builtin_amdgcn_mbcnt_hi(~0u, __builtin_amdgcn_mbcnt_lo(~0u, 0u)), r = lnf & 31, hh = lnf >> 5;
        float* ALX = (float*)(dyn_smem + L_ALX) + w * 64;
        { const auto s1_ = __builtin_amdgcn_permlane32_swap(__float_as_uint(l1), __float_as_uint(l1), false, false); l1 = __uint_as_float(s1_[0]) + __uint_as_float(s1_[1]);
          const auto s2_ = __builtin_amdgcn_permlane32_swap(__float_as_uint(l2), __float_as_uint(l2), false, false); l2 = __uint_as_float(s2_[0]) + __uint_as_float(s2_[1]); }
        if (hh == 0) { ALX[r] = __builtin_amdgcn_rcpf(l1); ALX[32 + r] = *lamp * __builtin_amdgcn_rcpf(l2); }
        asm volatile("s_waitcnt lgkmcnt(0)" ::: "memory");
        float ss[16], a1[16], a2[16];
#pragma unroll
        for (int g = 0; g < 4; ++g) {
            const f32x4 x1 = *(const f32x4*)(ALX + 8 * g + 4 * hh), x2 = *(const f32x4*)(ALX + 32 + 8 * g + 4 * hh);
#pragma unroll
            for (int j = 0; j < 4; ++j) { a1[4 * g + j] = x1[j]; a2[4 * g + j] = x2[j]; ss[4 * g + j] = 0.f; }
        }
#pragma unroll
        for (int t = 0; t < 4; ++t) {
            __builtin_amdgcn_sched_barrier(0);
#pragma unroll
            for (int i = 0; i < 16; ++i) { const float o = O1[t][i] * a1[i] - O2[t][i] * a2[i]; O1[t][i] = o; ss[i] += o * o; }
        }
        __builtin_amdgcn_sched_barrier(0);
#pragma unroll
        for (int i = 0; i < 16; ++i) {
#pragma unroll
            for (int of = 1; of < 32; of <<= 1) ss[i] += __shfl_xor(ss[i], of);
            ss[i] = __builtin_amdgcn_rsqf(ss[i] * (1.f / 128.f) + 1e-6f) * (1.f - LAM_INIT);
        }
        int zo = 0; asm volatile("" : "+v"(zo));
        bf16_t* obase = (bf16_t*)(ws + WS_R2) + (qbase + 32 * w) * 1024 + 512 + h * 128;
        const unsigned ooff = (unsigned)((4 * hh + zo) * 1024 + r);
        const float* sw = p.subln_w + r + zo;
#pragma unroll
        for (int t = 0; t < 4; ++t) {
            const float wv = sw[32 * t];
#pragma unroll
            for (int i = 0; i < 16; ++i) obase[ooff + ((i & 3) + 8 * (i >> 2)) * 1024 + 32 * t] = f2bf(O1[t][i] * ss[i] * wv);
        }
    }
}

DI void mixer_phase(const Params& p) {
    const int bid = blockIdx.x;
#ifndef NO_SCAN
    if (bid >= 16 && bid < 48) {
        float cw[3][4];
        gdn_conv_weights(p, (bid - 16) & 3, cw);
        gdn_prep_item(p, 2048 + bid - 16, cw);
        asm volatile("s_waitcnt vmcnt(0)" ::: "memory");
        __builtin_amdgcn_fence(__ATOMIC_ACQUIRE, "agent");
        asm volatile("s_waitcnt vmcnt(0)" ::: "memory");
        __syncthreads();
    }
    if (bid < 48) { const bool sm = bid >= 16; const int j = sm ? bid - 16 : bid;
#pragma unroll 1
        for (int rep = 0; rep < SREP; ++rep) gdn_scan(p, sm, j >> 2, j & 3); }
#endif
    unsigned* ctl = (unsigned*)(p.ws + WS_CTL);
    int* sidx = (int*)(dyn_smem + L_IDX);
    for (;;) {
        __syncthreads();
        if (threadIdx.x == 0) *sidx = (int)atomicAdd(ctl, 1u);
        __syncthreads();
        const int idx0 = __builtin_amdgcn_readfirstlane(*sidx);
        if (idx0 >= (32 + 512) * AREP) break;
        const int idx = idx0 % (32 + 512);
#ifndef NO_ATTN
        attn_item(p, idx, (const float*)ctl + 1);
#endif
    }
}


#define XB_TMO      128
#define XB_XCNT(j)  (256  + 64 * (j))
#define XB_XSUB(j)  (1280 + 64 * (j))
#define XB_XGEN(j)  (2304 + 64 * (j))
#define XB_TOP      3328
#define XB_TOPGEN   3392
#define XCD_BAR_WORDS 3456
#define XB_SPIN_CAP (1u << 20)
#define LAS __attribute__((address_space(3)))
DI unsigned xb_ld(unsigned* p) { return __hip_atomic_load(p, __ATOMIC_RELAXED, __HIP_MEMORY_SCOPE_AGENT); }
DI unsigned xb_add(unsigned* p, unsigned v) { return __hip_atomic_fetch_add(p, v, __ATOMIC_RELAXED, __HIP_MEMORY_SCOPE_AGENT); }
DI unsigned xb_xcc_id() { return (unsigned)__builtin_amdgcn_s_getreg((3 << 11) | 20) & 0xFu; }
#define XB_SPIN(cond, bar) do { unsigned _sp = 0; while (cond) { __builtin_amdgcn_s_sleep(1); \
    if ((++_sp & 255u) == 0u) { if (xb_ld(&(bar)[XB_TMO])) break; if (_sp > XB_SPIN_CAP) { atomicAdd(&(bar)[XB_TMO], 1u); break; } } } } while (0)
struct XcdBarrier { unsigned* bar; unsigned x; volatile LAS unsigned* st; };
DI XcdBarrier xcd_barrier_post(unsigned* bar, volatile LAS unsigned* st) {
    XcdBarrier b; b.bar = bar; b.x = xb_xcc_id(); b.st = st;
    if (threadIdx.x == 0) (void)xb_add(&bar[XB_XCNT(b.x)], 1u);
    return b;
}
DI void xcd_barrier_complete(unsigned* bar, unsigned x, unsigned& nloc, unsigned& nx) {
    const unsigned G = gridDim.x * gridDim.y * gridDim.z;
    unsigned sum, cnt, mine, sp = 0u;
    for (;;) {
        sum = 0u; cnt = 0u; mine = 0u;
#pragma unroll
        for (unsigned j = 0; j < 16; ++j) { const unsigned c = xb_ld(&bar[XB_XCNT(j)]); sum += c; cnt += (c > 0u) ? 1u : 0u; mine = (j == x) ? c : mine; }
        if (sum == G) break;
        __builtin_amdgcn_s_sleep(1);
        if ((++sp & 255u) == 0u) { if (xb_ld(&bar[XB_TMO])) break; if (sp > XB_SPIN_CAP) { atomicAdd(&bar[XB_TMO], 1u); break; } }
    }
    nloc = mine > 0u ? mine : 1u; nx = cnt > 0u ? cnt : 1u;
}
DI void xcd_barrier(const XcdBarrier& b) {
    asm volatile("s_waitcnt vmcnt(0)" ::: "memory");
    __syncthreads();
    if (threadIdx.x == 0) {
        unsigned* bar = b.bar;
        __builtin_amdgcn_s_waitcnt(0);
        unsigned nloc = b.st[0], nx = b.st[1];
        if (nloc == 0u) { xcd_barrier_complete(bar, b.x, nloc, nx); b.st[0] = nloc; b.st[1] = nx; }
        const unsigned old = xb_add(&bar[XB_XSUB(b.x)], 1u);
        const unsigned gen = old / nloc;
        if (old + 1u == (gen + 1u) * nloc) {
            __builtin_amdgcn_fence(__ATOMIC_RELEASE, "agent");
            asm volatile("s_waitcnt vmcnt(0)" ::: "memory");
            const unsigned og = xb_add(&bar[XB_TOP], 1u);
            const unsigned tg = og / nx;
            if (og + 1u == (tg + 1u) * nx) xb_add(&bar[XB_TOPGEN], 1u);
            else XB_SPIN(xb_ld(&bar[XB_TOPGEN]) == tg, bar);
            __builtin_amdgcn_fence(__ATOMIC_ACQUIRE, "agent");
            xb_add(&bar[XB_XGEN(b.x)], 1u);
            asm volatile("s_waitcnt vmcnt(0)" ::: "memory");
        } else {
            XB_SPIN(xb_ld(&bar[XB_XGEN(b.x)]) == gen, bar);
            __builtin_amdgcn_fence(__ATOMIC_ACQUIRE, "agent");
            asm volatile("s_waitcnt vmcnt(0)" ::: "memory");
        }
    }
    __syncthreads();
}

__global__ void __launch_bounds__(512, 2) fwd_kernel(Params p) {
    cg::grid_group grid = cg::this_grid();
    volatile LAS unsigned* xst = (volatile LAS unsigned*)(dyn_smem + LDS_BYTES - 16);
    if (threadIdx.x == 0) { xst[0] = 0u; xst[1] = 0u; }
    __syncthreads();
    const XcdBarrier xb = xcd_barrier_post((unsigned*)(p.ws + WS_BAR), xst);
    if (p.phase_lo > 1000) grid.sync();
    const bool all = p.phase_hi - p.phase_lo > 1;
#define PHASE(i, body) if (p.phase_lo <= (i) && (i) < p.phase_hi) { body; if (all && (i) + 1 < p.phase_hi) xcd_barrier(xb); }
    PHASE(0, phase_prep(p))
    PHASE(1, gemm_phase<1>(p))
    PHASE(2, gdn_prep_phase(p))
    PHASE(3, mixer_phase(p))
    PHASE(4, gemm_phase<2>(p))
    PHASE(5, ln_phase<0>(p))
    PHASE(6, gemm_phase<3>(p))
    PHASE(7, fixup_phase(p))
    PHASE(8, gemm_phase<4>(p))
    PHASE(9, ln_phase<1>(p))
}

extern "C" void kernel_launch(void* const* d_in, const int* in_sizes, int n_in, void* d_out, int out_size, void* d_ws, size_t ws_size, hipStream_t stream) {
    static int grid = 0;
    if (grid == 0) {
        if (n_in != 23 || (size_t)out_size != O_END || ws_size < WS_END2) { fprintf(stderr, "kernel_launch: unexpected sizes n_in %d out %d ws %zu (need %zu)\n", n_in, out_size, ws_size, (size_t)WS_END2); grid = -1; return; }
        int dev = 0, cus = 0, per_cu = 0;
        hipGetDevice(&dev);
        hipDeviceGetAttribute(&cus, hipDeviceAttributeMultiprocessorCount, dev);
        if (hipFuncSetAttribute((const void*)fwd_kernel, hipFuncAttributeMaxDynamicSharedMemorySize, LDS_BYTES) != hipSuccess) { fprintf(stderr, "kernel_launch: hipFuncSetAttribute failed\n"); grid = -1; return; }
        hipOccupancyMaxActiveBlocksPerMultiprocessor(&per_cu, (const void*)fwd_kernel, 512, LDS_BYTES);
        if (per_cu < 1) { fprintf(stderr, "kernel_launch: occupancy query says %d\n", per_cu); per_cu = 1; }
        (void)hipGetLastError();
        grid = cus * 1;
    }
    if (grid < 0) return;
    Params p{};
    const float** f = (const float**)&p;
    for (int i = 0; i < 23; ++i) f[i] = (const float*)d_in[i];
    p.out = (float*)d_out; p.ws = (unsigned char*)d_ws; p.phase_lo = 0; p.phase_hi = 10;
    if (hipMemsetAsync((unsigned char*)d_ws + WS_BAR, 0, 16384, stream) != hipSuccess) { fprintf(stderr, "kernel_launch: memset failed\n"); return; }
    void* args[] = {&p};
    hipError_t e = hipLaunchCooperativeKernel((const void*)fwd_kernel, dim3(grid), dim3(512), args, LDS_BYTES, stream);
    if (e != hipSuccess) fprintf(stderr, "cooperative launch failed: %s (grid %d)\n", hipGetErrorString(e), grid);
}
```

```cpp
#include <hip/hip_runtime.h>
#include <hip/hip_cooperative_groups.h>
#include <cstdio>
namespace cg = cooperative_groups;
#ifndef GREP_WHICH
#define GREP_WHICH 0
#endif
#ifndef AREP
#define AREP 1
#endif
#ifndef SREP
#define SREP 1
#endif

typedef unsigned short bf16_t;
typedef short bf16x8 __attribute__((ext_vector_type(8)));
typedef short s16x4 __attribute__((ext_vector_type(4)));
typedef float f32x4 __attribute__((ext_vector_type(4)));
typedef float f32x16 __attribute__((ext_vector_type(16)));
typedef unsigned u32x4 __attribute__((ext_vector_type(4)));
typedef unsigned u32x2 __attribute__((ext_vector_type(2)));
#define DI __device__ __forceinline__

constexpr int D = 1024, TP = 8192, BP = 4, MP = BP * TP, BS = 8, TS = 32, MS = BS * TS, M = MP + MS, PAST = 4096;
constexpr int DIN = 3592, NH1 = 3584, DFF = 2816, NUP = 2 * DFF;
constexpr int TKS = 4160;
constexpr int NITEM = BP * 128 * 4 + BS * 4;
constexpr int ITEM_B = 90112;
constexpr int LDS_BYTES = 160 * 1024;
constexpr float ALPHA = 1.189207115002721f;
constexpr float LAM_INIT = 0.2f;

constexpr size_t O_Y = 0, O_KP = 33816576, O_VP = 50593792, O_GP = 67371008, O_CQP = 67633152, O_CFP = 67651584,
                 O_KS = 67696640, O_VS = 67827712, O_GS = 67958784, O_CQS = 68483072, O_CFS = 68519936, O_END = 68610048;

constexpr size_t al256(size_t x) { return (x + 255) & ~(size_t)255; }
constexpr size_t WS_CTL = 0;
constexpr size_t WS_ROPE = 4096;
constexpr size_t WS_AB = WS_ROPE + (size_t)8192 * 32 * 8;
constexpr size_t WS_DL = WS_AB + (size_t)M * 8 * 4;
constexpr size_t WS_WIN = al256(WS_DL + NITEM * 4);
constexpr size_t WS_WO = WS_WIN + (size_t)NH1 * D * 2;
constexpr size_t WS_WUP = WS_WO + (size_t)D * D * 2;
constexpr size_t WS_WDN = WS_WUP + (size_t)NUP * D * 2;
constexpr size_t WS_R1 = al256(WS_WDN + (size_t)D * DFF * 2);
constexpr size_t R1_SIZE = (size_t)NITEM * ITEM_B;
constexpr size_t WS_R2 = al256(WS_R1 + R1_SIZE);
constexpr size_t WS_R3 = al256(WS_R2 + (size_t)M * 1536 * 2);
constexpr size_t WS_R4 = WS_R3 + (size_t)M * 512 * 2;
constexpr size_t WS_R5 = al256(WS_R4 + (size_t)M * 512 * 2);
constexpr size_t KROWS = (size_t)MP + (size_t)BS * TKS;
constexpr size_t WS_R6 = al256(WS_R5 + KROWS * 512 * 2);
constexpr size_t VT_S_OFF = (size_t)BP * 4 * 128 * TP;
constexpr size_t WS_END = al256(WS_R6 + (VT_S_OFF + (size_t)BS * 4 * 128 * TKS) * 2);
constexpr size_t WS_CS1 = WS_END;
constexpr size_t WS_CS2 = WS_CS1 + (size_t)MS * NH1 * 4;
constexpr size_t WS_CS3 = WS_CS2 + (size_t)MS * D * 4;
constexpr size_t WS_CS4 = WS_CS3 + (size_t)MS * NUP * 4;
constexpr size_t WS_BAR = WS_CS4 + (size_t)MS * D * 4;
constexpr size_t WS_END2 = WS_BAR + 16384;
static_assert((size_t)M * DFF * 2 <= R1_SIZE, "GT must fit R1");
static_assert(WS_END2 <= (size_t)536870912, "workspace too large");

struct Params {
    const float *x_p, *x_s, *cache_k, *cache_v, *state_gdn, *state_cq, *state_cf;
    const float *w_in, *gdn_conv_w, *a_log, *dt_bias, *gdn_norm_w, *diff_lambda, *subln_w, *w_o, *ln1_g, *ln1_b, *w_up,
        *ffn_conv_w, *ffn_conv_b, *w_down, *ln2_g, *ln2_b;
    float* out; unsigned char* ws;
    int phase_lo, phase_hi;
};

extern __shared__ __attribute__((aligned(16))) unsigned char dyn_smem[];

typedef __bf16 bf16x2_t __attribute__((ext_vector_type(2)));
typedef float f32x2 __attribute__((ext_vector_type(2)));
DI unsigned pk2(float lo, float hi) { f32x2 v = {lo, hi}; bf16x2_t b = __builtin_convertvector(v, bf16x2_t); return __builtin_bit_cast(unsigned, b); }
DI bf16_t f2bf(float x) { return (bf16_t)(pk2(x, 0.f) & 0xffffu); }
DI float bf2f(bf16_t b) { return __uint_as_float(((unsigned)b) << 16); }
DI float bflo(unsigned u) { return __uint_as_float(u << 16); }
DI float bfhi(unsigned u) { return __uint_as_float(u & 0xffff0000u); }
DI float silu(float x) { return x * __builtin_amdgcn_rcpf(1.f + __expf(-x)); }
DI void lds_barrier() { asm volatile("s_waitcnt lgkmcnt(0)\n\ts_barrier" ::: "memory"); }
DI int opaque_tid() { int t = threadIdx.x; asm volatile("" : "+v"(t)); return t; }
DI float wave_sum(float v) {
#pragma unroll
    for (int o = 1; o < 64; o <<= 1) v += __shfl_xor(v, o);
    return v;
}
DI const float* xrow_ptr(const Params& p, int row) { return row < MP ? p.x_p + (size_t)row * D : p.x_s + (size_t)(row - MP) * D; }

template <int MODE> DI int srccol(int n) {
    if (MODE == 1) {
        if (n < 2048) return n;
        return n + 8;
    }
    if (MODE == 2) { const int pn = n >> 8, j = n & 255; return j < 128 ? 128 * pn + j : DFF + 128 * pn + (j - 128); }
    return n;
}
struct TrItem { const float* W; bf16_t* WT; int K, N, k0, n0, mode; };
DI TrItem tr_decode(const Params& p, int it) {
    constexpr int I_IN = 16 * 56, I_O = 16 * 16, I_UP = 16 * 88;
    unsigned char* ws = p.ws; TrItem t; int r = it;
    if (r < I_IN) { t.W = p.w_in; t.WT = (bf16_t*)(ws + WS_WIN); t.K = D; t.N = DIN; t.k0 = (r / 56) * 64; t.n0 = (r % 56) * 64; t.mode = 1; return t; } r -= I_IN;
    if (r < I_O) { t.W = p.w_o; t.WT = (bf16_t*)(ws + WS_WO); t.K = D; t.N = D; t.k0 = (r / 16) * 64; t.n0 = (r % 16) * 64; t.mode = 0; return t; } r -= I_O;
    if (r < I_UP) { t.W = p.w_up; t.WT = (bf16_t*)(ws + WS_WUP); t.K = D; t.N = NUP; t.k0 = (r / 88) * 64; t.n0 = (r % 88) * 64; t.mode = 2; return t; } r -= I_UP;
    t.W = p.w_down; t.WT = (bf16_t*)(ws + WS_WDN); t.K = DFF; t.N = D; t.k0 = (r / 16) * 64; t.n0 = (r % 16) * 64; t.mode = 0; return t;
}
DI void tr_load(const TrItem& t, float (&v)[8]) {
    const int tid = threadIdx.x, n = t.n0 + (tid & 63);
    const int sc = t.mode == 1 ? (n < 2048 ? n : n + 8) : (t.mode == 2 ? srccol<2>(n) : n);
#pragma unroll
    for (int i = 0; i < 8; ++i) v[i] = __builtin_nontemporal_load(t.W + (size_t)(t.k0 + (tid >> 6) + 8 * i) * t.N + sc);
}
DI void transpose_range(const Params& p, const int lo, const int hi) {
    const int tid = opaque_tid(), nb = gridDim.x, bid = blockIdx.x;
    float* lds = (float*)dyn_smem;
    float v[8];
    lds_barrier();
    TrItem cur = tr_decode(p, lo + bid < hi ? lo + bid : lo);
    if (lo + bid < hi) tr_load(cur, v);
    for (int it = lo + bid; it < hi; it += nb) {
        float nv[8]; TrItem nx = cur;
        if (it + nb < hi) { nx = tr_decode(p, it + nb); tr_load(nx, nv); }
#pragma unroll
        for (int i = 0; i < 8; ++i) lds[((tid >> 6) + 8 * i) * 65 + (tid & 63)] = v[i];
        lds_barrier();
#pragma unroll
        for (int i = 0; i < 8; ++i) { const int nn = (tid >> 6) + 8 * i, kk = tid & 63; cur.WT[(size_t)(cur.n0 + nn) * cur.K + cur.k0 + kk] = f2bf(lds[kk * 65 + nn]); }
        lds_barrier();
#pragma unroll
        for (int i = 0; i < 8; ++i) v[i] = nv[i];
        cur = nx;
    }
}
DI void phase_prep(const Params& p) {
    const int tid = threadIdx.x, lane = tid & 63, wave = tid >> 6, nb = gridDim.x, bid = blockIdx.x;
    unsigned char* ws = p.ws;
    if (bid == 0 && tid < 64) {
        unsigned* ctl = (unsigned*)(ws + WS_CTL);
        float a = p.diff_lambda[lane] * p.diff_lambda[64 + lane], b = p.diff_lambda[128 + lane] * p.diff_lambda[192 + lane];
        a = wave_sum(a); b = wave_sum(b);
        if (lane == 0) { ctl[0] = 0u; ((float*)ctl)[1] = expf(a) - expf(b) + LAM_INIT; }
    }
    transpose_range(p, 0, 16 * 56);
    {
        float2* rope = (float2*)(ws + WS_ROPE);
        for (int idx = bid * 512 + tid; idx < 8192 * 32; idx += nb * 512) {
            const int pos = idx >> 5, d = idx & 31;
            const double inv = exp(-(double)d * (9.210340371976184 / 32.0));
            double a = (double)pos * inv;
            a -= 6.283185307179586 * rint(a * 0.15915494309189535);
            const float af = (float)a;
            rope[idx] = make_float2(__cosf(af), __sinf(af));
        }
    }
    {
        float* w8 = (float*)dyn_smem;
        __syncthreads();
        for (int i = tid; i < 1024 * 8; i += 512) w8[i] = p.w_in[(size_t)(i >> 3) * DIN + 2048 + (i & 7)];
        __syncthreads();
        bf16_t* XB = (bf16_t*)(ws + WS_R1);
        float* AB = (float*)(ws + WS_AB);
        f32x4 cv[4];
        {
            const int row = bid * 8 + wave;
            if (row < M) { const float* xr = xrow_ptr(p, row);
#pragma unroll
                for (int j = 0; j < 4; ++j) cv[j] = __builtin_nontemporal_load((const f32x4*)(xr + lane * 4 + 256 * j)); }
        }
        for (int row = bid * 8 + wave; row < M; row += nb * 8) {
            f32x4 nvx[4];
            if (row + nb * 8 < M) { const float* xn = xrow_ptr(p, row + nb * 8);
#pragma unroll
                for (int j = 0; j < 4; ++j) nvx[j] = __builtin_nontemporal_load((const f32x4*)(xn + lane * 4 + 256 * j)); }
            float acc[8];
#pragma unroll
            for (int c = 0; c < 8; ++c) acc[c] = 0.f;
#pragma unroll
            for (int j = 0; j < 4; ++j) {
                const int k0 = lane * 4 + 256 * j;
                const f32x4 v = cv[j];
                u32x2 o; o.x = pk2(v.x, v.y); o.y = pk2(v.z, v.w);
                *(u32x2*)(XB + (size_t)row * D + k0) = o;
#pragma unroll
                for (int e = 0; e < 4; ++e) {
                    const f32x4 wa = *(const f32x4*)(w8 + (k0 + e) * 8), wb = *(const f32x4*)(w8 + (k0 + e) * 8 + 4);
                    const float xv = v[e];
                    acc[0] += xv * wa.x; acc[1] += xv * wa.y; acc[2] += xv * wa.z; acc[3] += xv * wa.w;
                    acc[4] += xv * wb.x; acc[5] += xv * wb.y; acc[6] += xv * wb.z; acc[7] += xv * wb.w;
                }
            }
#pragma unroll
            for (int c = 0; c < 8; ++c) acc[c] = wave_sum(acc[c]);
            if (lane == 0) { *(f32x4*)(AB + (size_t)row * 8) = (f32x4){acc[0], acc[1], acc[2], acc[3]}; *(f32x4*)(AB + (size_t)row * 8 + 4) = (f32x4){acc[4], acc[5], acc[6], acc[7]}; }
#pragma unroll
            for (int j = 0; j < 4; ++j) cv[j] = nvx[j];
        }
        __syncthreads();
    }
}

DI void prep_stream(const Params& p) {
    const int tid = opaque_tid(), nb = gridDim.x, bid = blockIdx.x;
    unsigned char* ws = p.ws;
    transpose_range(p, 16 * 56, 16 * 56 + 16 * 16 + 16 * 88 + 44 * 16);
    lds_barrier();
    {
        bf16_t* KALL = (bf16_t*)(ws + WS_R5);
        const int nchunk = BS * TKS * 64;
        for (int c0 = bid * 512 + tid; c0 < nchunk; c0 += nb * 512 * 4) {
            f32x4 v0[4], v1[4]; int st[4]; size_t dsto[4];
#pragma unroll
            for (int u = 0; u < 4; ++u) {
                const int c = c0 + u * nb * 512;
                st[u] = 0;
                if (c < nchunk) {
                    const int col8 = c & 63, r = c >> 6, b = r / TKS, pp = r % TKS;
                    dsto[u] = ((size_t)MP + (size_t)b * TKS + pp) * 512 + col8 * 8;
                    if (pp < PAST) { const float* sp = p.cache_k + ((size_t)(b * PAST + pp) * 512 + col8 * 8); v0[u] = __builtin_nontemporal_load((const f32x4*)sp); v1[u] = __builtin_nontemporal_load((const f32x4*)(sp + 4)); st[u] = 1; }
                    else if (pp >= PAST + TS) st[u] = 2;
                }
            }
#pragma unroll
            for (int u = 0; u < 4; ++u) {
                if (st[u] == 1) { u32x4 o; o.x = pk2(v0[u].x, v0[u].y); o.y = pk2(v0[u].z, v0[u].w); o.z = pk2(v1[u].x, v1[u].y); o.w = pk2(v1[u].z, v1[u].w); *(u32x4*)(KALL + dsto[u]) = o; }
                else if (st[u] == 2) *(u32x4*)(KALL + dsto[u]) = (u32x4){0u, 0u, 0u, 0u};
            }
        }
    }
    {
        bf16_t* VTS = (bf16_t*)(ws + WS_R6) + VT_S_OFF;
        bf16_t* t = (bf16_t*)dyn_smem;
        f32x4 cvv[4];
        auto ldv = [&](int it, f32x4 (&v)[4]) {
            const int blk = it % 65, bh = it / 65, b = bh >> 2, h = bh & 3;
            if (blk < 64) {
#pragma unroll
                for (int i = 0; i < 4; ++i) { const int id = tid + 512 * i, key = id >> 5, c4 = id & 31;
                    v[i] = __builtin_nontemporal_load((const f32x4*)(p.cache_v + ((size_t)(b * PAST + blk * 64 + key) * 512 + h * 128 + c4 * 4))); }
            }
        };
        if (bid < BS * 4 * 65) ldv(bid, cvv);
        for (int it = bid; it < BS * 4 * 65; it += nb) {
            const int blk = it % 65, bh = it / 65;
            f32x4 nvv[4];
            if (it + nb < BS * 4 * 65) ldv(it + nb, nvv);
            if (blk < 64) {
                lds_barrier();
#pragma unroll
                for (int i = 0; i < 4; ++i) {
                    const int id = tid + 512 * i, key = id >> 5, c4 = id & 31;
                    const f32x4 v = cvv[i];
                    bf16_t* d = t + key * 130 + c4 * 4;
                    *(unsigned*)d = pk2(v.x, v.y); *(unsigned*)(d + 2) = pk2(v.z, v.w);
                }
                lds_barrier();
                const int dv = tid >> 2, part = tid & 3;
                unsigned o[8];
#pragma unroll
                for (int i = 0; i < 8; ++i) { const int k0 = part * 16 + 2 * i; o[i] = (unsigned)t[k0 * 130 + dv] | ((unsigned)t[(k0 + 1) * 130 + dv] << 16); }
                bf16_t* dst = VTS + ((size_t)(bh * 128 + dv) * TKS + blk * 64 + part * 16);
                *(u32x4*)dst = (u32x4){o[0], o[1], o[2], o[3]}; *(u32x4*)(dst + 8) = (u32x4){o[4], o[5], o[6], o[7]};
            } else {
                if (tid < 128) { bf16_t* dst = VTS + ((size_t)(bh * 128 + tid) * TKS + PAST + TS);
#pragma unroll
                    for (int i = 0; i < 4; ++i) *(u32x4*)(dst + 8 * i) = (u32x4){0u, 0u, 0u, 0u}; }
            }
#pragma unroll
            for (int i = 0; i < 4; ++i) cvv[i] = nvv[i];
        }
        lds_barrier();
    }
}

constexpr int BM = 256, BK = 64, HALF = 128, NXCD = 8, WGM = 8, HT = HALF * BK;
DI void stage_rc(int b, int& R, int& C) {
    const int st = b / 1024, sb = b % 1024, swz = sb ^ (((sb >> 9) & 1) << 5);
    R = (st >> 1) * 16 + swz / 64; C = (st & 1) * 32 + (swz % 64) / 2;
}
DI int lds_byte(int r, int c) {
    const int st = (r >> 4) * 2 + (c >> 5), rr = r & 15, cc = c & 31, ob = rr * 64 + cc * 2;
    return st * 1024 + (ob ^ (((ob >> 9) & 1) << 5));
}

#define SHM ((bf16_t*)dyn_smem)
#define SA(b, h) (SHM + ((b) * 2 + (h)) * HT)
#define SB(b, h) (SHM + (4 + (b) * 2 + (h)) * HT)
#define STAGE(P, BASE, br, kt) do { const bf16_t* _gb = (BASE) + ((long)(br) * K + (long)(kt) * BK); \
      __builtin_amdgcn_global_load_lds((const unsigned*)(_gb + so0), (unsigned*)((char*)(P) + wlds), 16, 0, 0); \
      __builtin_amdgcn_global_load_lds((const unsigned*)(_gb + 64 * K + so0), (unsigned*)((char*)(P) + wlds + 8192), 16, 0, 0); } while (0)
#define LDA(dst, b, h) for (int m = 0; m < 4; ++m) for (int k = 0; k < 2; ++k) \
    dst[m][k] = *reinterpret_cast<const bf16x8*>((char*)SA(b, h) + lds_byte(wr * 64 + m * 16 + fr, k * 32 + fq * 8))
#define LDB(dst, b, h) for (int n = 0; n < 2; ++n) for (int k = 0; k < 2; ++k) \
    dst[n][k] = *reinterpret_cast<const bf16x8*>((char*)SB(b, h) + lds_byte(wc * 32 + n * 16 + fr, k * 32 + fq * 8))
#define MMA(ai, bj, At, Bt_) do { __builtin_amdgcn_s_setprio(1); \
    for (int m = 0; m < 4; ++m) for (int n = 0; n < 2; ++n) for (int k = 0; k < 2; ++k) \
      acc[ai][bj][m][n] = __builtin_amdgcn_mfma_f32_16x16x32_bf16(Bt_[n][k], At[m][k], acc[ai][bj][m][n], 0, 0, 0); \
    __builtin_amdgcn_s_setprio(0); } while (0)
#define WAIT_V(n) asm volatile("s_waitcnt vmcnt(" #n ")" ::: "memory")
#define WAIT_L(n) asm volatile("s_waitcnt lgkmcnt(" #n ")" ::: "memory")
#define BAR __builtin_amdgcn_s_barrier()
#define SCHED __builtin_amdgcn_sched_barrier(0)

template <int K> DI void gemm_tile(const bf16_t* __restrict__ A, const bf16_t* __restrict__ Bt, const int brow, const int bcol, f32x4 (&acc)[2][2][4][2]) {
    const int wid = threadIdx.x >> 6, lane = threadIdx.x & 63, wr = wid >> 2, wc = wid & 3, fr = lane & 15, fq = lane >> 4;
    unsigned so0;
    { int _r, _c; stage_rc(threadIdx.x * 16, _r, _c); so0 = (unsigned)(_r * K + _c); }
    const int wlds = __builtin_amdgcn_readfirstlane((int)(threadIdx.x >> 6) << 10);
#pragma unroll
    for (int a = 0; a < 2; ++a)
#pragma unroll
        for (int b = 0; b < 2; ++b)
#pragma unroll
            for (int m = 0; m < 4; ++m)
#pragma unroll
                for (int n = 0; n < 2; ++n) acc[a][b][m][n] = (f32x4){0.f, 0.f, 0.f, 0.f};
    bf16x8 At[4][2], B0[2][2], B1[2][2];
    constexpr int nt = K / BK;
    STAGE(SB(0, 0), Bt, bcol, 0); STAGE(SA(0, 0), A, brow, 0);
    STAGE(SB(0, 1), Bt, bcol + HALF, 0); STAGE(SA(0, 1), A, brow + HALF, 0);
    if (wr == 1) BAR;
    WAIT_V(4); BAR;
    STAGE(SB(1, 0), Bt, bcol, 1); STAGE(SA(1, 0), A, brow, 1); STAGE(SB(1, 1), Bt, bcol + HALF, 1);
    WAIT_V(6); BAR;
    for (int t = 0; t < nt - 2; t += 2) {
        LDB(B0, 0, 0); SCHED; LDA(At, 0, 0); STAGE(SA(1, 1), A, brow + HALF, t + 1);
        WAIT_L(8); BAR; WAIT_L(0); MMA(0, 0, At, B0); BAR; SCHED;
        LDB(B1, 0, 1); STAGE(SB(0, 0), Bt, bcol, t + 2);
        BAR; WAIT_L(0); MMA(0, 1, At, B1); BAR;
        LDA(At, 0, 1); STAGE(SA(0, 0), A, brow, t + 2);
        BAR; WAIT_L(0); MMA(1, 0, At, B0); BAR; SCHED;
        STAGE(SB(0, 1), Bt, bcol + HALF, t + 2);
        WAIT_V(6); BAR; MMA(1, 1, At, B1); BAR;
        LDB(B0, 1, 0); SCHED; LDA(At, 1, 0); STAGE(SA(0, 1), A, brow + HALF, t + 2);
        WAIT_L(8); BAR; WAIT_L(0); MMA(0, 0, At, B0); BAR; SCHED;
        LDB(B1, 1, 1); STAGE(SB(1, 0), Bt, bcol, t + 3);
        BAR; WAIT_L(0); MMA(0, 1, At, B1); BAR;
        LDA(At, 1, 1); STAGE(SA(1, 0), A, brow, t + 3);
        BAR; WAIT_L(0); MMA(1, 0, At, B0); BAR; SCHED;
        STAGE(SB(1, 1), Bt, bcol + HALF, t + 3);
        WAIT_V(6); BAR; MMA(1, 1, At, B1); BAR;
    }
    { LDB(B0, 0, 0); LDA(At, 0, 0); STAGE(SA(1, 1), A, brow + HALF, nt - 1);
      BAR; WAIT_L(0); MMA(0, 0, At, B0); BAR;
      LDB(B1, 0, 1); BAR; WAIT_L(0); MMA(0, 1, At, B1); BAR;
      LDA(At, 0, 1); WAIT_V(4); BAR; WAIT_L(0); MMA(1, 0, At, B0); MMA(1, 1, At, B1); BAR; }
    { LDB(B0, 1, 0); LDA(At, 1, 0); WAIT_V(2); BAR; WAIT_L(0); MMA(0, 0, At, B0); BAR;
      LDB(B1, 1, 1); WAIT_V(0); BAR; WAIT_L(0); MMA(0, 1, At, B1); BAR;
      LDA(At, 1, 1); BAR; WAIT_L(0); MMA(1, 0, At, B0); MMA(1, 1, At, B1); BAR; }
    if (wr == 0) BAR;
}

DI void tile_of(int L, int nM, int nN, int& pm, int& pn) {
    const int nwg = nM * nN; int wgid = L;
    { const int q = nwg / NXCD, r = nwg % NXCD, xcd = wgid % NXCD, off = wgid / NXCD; wgid = (xcd < r ? xcd * (q + 1) : r * (q + 1) + (xcd - r) * q) + off; }
    const int nig = WGM * nN, gid = wgid / nig, fm = gid * WGM, gsz = min(nM - fm, WGM);
    pm = fm + ((wgid % nig) % gsz); pn = (wgid % nig) / gsz;
}

constexpr int CST = 260;
DI void stage_half(const f32x4 (&acc)[2][2][4][2], const int ai) {
    const int tid_ = opaque_tid(), wid = tid_ >> 6, lane = tid_ & 63, wr = wid >> 2, wc = wid & 3, fr = lane & 15, fq = lane >> 4;
    float* base = (float*)dyn_smem + (wr * 64 + fr) * CST + wc * 32 + 4 * fq;
#pragma unroll
    for (int m = 0; m < 4; ++m)
#pragma unroll
        for (int bj = 0; bj < 2; ++bj)
#pragma unroll
            for (int n = 0; n < 2; ++n) *(f32x4*)(base + (m * 16) * CST + bj * 128 + n * 16) = ai == 0 ? acc[0][bj][m][n] : acc[1][bj][m][n];
}
#define CT ((const float*)dyn_smem)

DI void epi_in_half(const Params& p, int pm, int pn, int ai) {
    unsigned char* ws = p.ws;
    const int tid = opaque_tid(), brow = pm * BM + ai * 128, bcol = pn * BM;
    const bool samp = pm == 128;
    if (pn < 8) {
        bf16_t* dst = pn < 6 ? (bf16_t*)(ws + WS_R2) : (bf16_t*)(ws + WS_R3);
        const int ld = pn < 6 ? 1536 : 512, c0 = pn < 6 ? bcol : bcol - 1536;
#pragma unroll 4
        for (int i = 0; i < 8; ++i) {
            const int id = tid + 512 * i, r = id >> 5, c8 = (id & 31) * 8, row = brow + r;
            const f32x4 v = *(const f32x4*)(CT + r * CST + c8), w = *(const f32x4*)(CT + r * CST + c8 + 4);
            *(u32x4*)(dst + (size_t)row * ld + c0 + c8) = (u32x4){pk2(v.x, v.y), pk2(v.z, v.w), pk2(w.x, w.y), pk2(w.z, w.w)};
            if (pn < 6) {
                const int t = row & (TP - 1);
                if (t >= TP - 3) { float* cd = p.out + O_CQP + (size_t)((row >> 13) * 3 + t - (TP - 3)) * 1536 + c0 + c8; *(f32x4*)cd = v; *(f32x4*)(cd + 4) = w; }
            }
        }
        return;
    }
    if (pn < 12) {
        const bool isq = pn < 10;
        const float* rope = (const float*)(ws + WS_ROPE);
        bf16_t* QB = (bf16_t*)(ws + WS_R4); bf16_t* KALL = (bf16_t*)(ws + WS_R5);
        const float qs = 0.125f * 1.4426950408889634f;
        f32x4 rt0[8], rt1[8];
#pragma unroll
        for (int i = 0; i < 8; ++i) {
            const int id = tid + 512 * i, r = id >> 5, q = id & 31, d4 = (q & 7) * 4, row = brow + r;
            const int pos = samp ? PAST + ((row - MP) & 31) : (row & (TP - 1));
            rt0[i] = *(const f32x4*)(rope + (size_t)(pos * 32 + d4) * 2); rt1[i] = *(const f32x4*)(rope + (size_t)(pos * 32 + d4) * 2 + 4);
        }
#pragma unroll
        for (int i = 0; i < 8; ++i) {
            const int id = tid + 512 * i, r = id >> 5, q = id & 31, hl = q >> 4, map = (q >> 3) & 1, d4 = (q & 7) * 4, row = brow + r;
            const int cl = hl * 128 + map * 64 + d4, col = ((pn & 1) * 2 + hl) * 128 + map * 64 + d4;
            const f32x4 x1 = *(const f32x4*)(CT + r * CST + cl), x2 = *(const f32x4*)(CT + r * CST + cl + 32);
            int pos; size_t krow; float* kout;
            if (!samp) { pos = row & (TP - 1); krow = row; kout = p.out + O_KP + (size_t)row * 512; }
            else { const int rr = row - MP; pos = PAST + (rr & 31); krow = (size_t)MP + (size_t)(rr >> 5) * TKS + pos; kout = p.out + O_KS + (size_t)rr * 512; }
            const f32x4 t0 = rt0[i], t1 = rt1[i];
            const f32x4 cs = (f32x4){t0.x, t0.z, t1.x, t1.z}, sn = (f32x4){t0.y, t0.w, t1.y, t1.w};
            const f32x4 y1 = x1 * cs - x2 * sn, y2 = x2 * cs + x1 * sn;
            if (isq) {
                u32x2 o1, o2; o1.x = pk2(y1.x * qs, y1.y * qs); o1.y = pk2(y1.z * qs, y1.w * qs); o2.x = pk2(y2.x * qs, y2.y * qs); o2.y = pk2(y2.z * qs, y2.w * qs);
                *(u32x2*)(QB + (size_t)row * 512 + col) = o1; *(u32x2*)(QB + (size_t)row * 512 + col + 32) = o2;
            } else {
                *(f32x4*)(kout + col) = y1; *(f32x4*)(kout + col + 32) = y2;
                u32x2 o1, o2; o1.x = pk2(y1.x, y1.y); o1.y = pk2(y1.z, y1.w); o2.x = pk2(y2.x, y2.y); o2.y = pk2(y2.z, y2.w);
                *(u32x2*)(KALL + krow * 512 + col) = o1; *(u32x2*)(KALL + krow * 512 + col + 32) = o2;
            }
        }
        return;
    }
    {
        bf16_t* VT = (bf16_t*)(ws + WS_R6);
#pragma unroll 4
        for (int i = 0; i < 16; ++i) {
            const int id = tid + 512 * i, r = id >> 6, c4 = (id & 63) * 4, row = brow + r, col = (pn & 1) * 256 + c4;
            const f32x4 v = *(const f32x4*)(CT + r * CST + c4);
            float* vout = samp ? p.out + O_VS + (size_t)(row - MP) * 512 + col : p.out + O_VP + (size_t)row * 512 + col;
            *(f32x4*)vout = v;
        }
#pragma unroll 1
        for (int i = 0; i < 2; ++i) {
            const int id = tid + 512 * i, rg = id >> 6, c4 = (id & 63) * 4, row0 = brow + rg * 8;
            f32x4 v[8];
#pragma unroll
            for (int e = 0; e < 8; ++e) v[e] = *(const f32x4*)(CT + (rg * 8 + e) * CST + c4);
#pragma unroll
            for (int e = 0; e < 4; ++e) {
                const int colg = (pn & 1) * 256 + c4 + e, head = colg >> 7, dv = colg & 127;
                u32x4 o; o.x = pk2(v[0][e], v[1][e]); o.y = pk2(v[2][e], v[3][e]); o.z = pk2(v[4][e], v[5][e]); o.w = pk2(v[6][e], v[7][e]);
                bf16_t* d;
                if (samp) { const int rr = row0 - MP; d = VT + VT_S_OFF + ((size_t)(((rr >> 5) * 4 + head) * 128 + dv) * TKS + PAST + (rr & 31)); }
                else d = VT + ((size_t)(((row0 >> 13) * 4 + head) * 128 + dv) * TP + (row0 & (TP - 1)));
                *(u32x4*)d = o;
            }
        }
    }
}

template <int WHICH> DI void epi_res_half(const Params& p, int pm, int pn, int ai) {
    const int tid = opaque_tid(), brow = pm * BM + ai * 128, bcol = pn * BM;
    bf16_t* dst = (bf16_t*)(p.ws + (WHICH == 0 ? WS_R1 : WS_R2));
    const bf16_t* X1B = (const bf16_t*)(p.ws + WS_R3);
    f32x4 xa[8], xb[8];
#pragma unroll
    for (int i = 0; i < 8; ++i) {
        const int id = tid + 512 * i, r = id >> 5, c8 = (id & 31) * 8, row = brow + r;
        if (WHICH == 0) { const float* xp = xrow_ptr(p, row) + bcol + c8; xa[i] = __builtin_nontemporal_load((const f32x4*)xp); xb[i] = __builtin_nontemporal_load((const f32x4*)(xp + 4)); }
        else { const u32x4 q = *(const u32x4*)(X1B + (size_t)row * D + bcol + c8); xa[i] = (f32x4){bflo(q.x), bfhi(q.x), bflo(q.y), bfhi(q.y)}; xb[i] = (f32x4){bflo(q.z), bfhi(q.z), bflo(q.w), bfhi(q.w)}; }
    }
#pragma unroll
    for (int i = 0; i < 8; ++i) {
        const int id = tid + 512 * i, r = id >> 5, c8 = (id & 31) * 8, row = brow + r;
        const f32x4 v = *(const f32x4*)(CT + r * CST + c8), w = *(const f32x4*)(CT + r * CST + c8 + 4);
        const f32x4 o = xa[i] * ALPHA + v, o2 = xb[i] * ALPHA + w;
        *(u32x4*)(dst + (size_t)row * D + bcol + c8) = (u32x4){pk2(o.x, o.y), pk2(o.z, o.w), pk2(o2.x, o2.y), pk2(o2.z, o2.w)};
    }
}

constexpr int UST = 264;
DI void epi_up(const Params& p, const f32x4 (&acc)[2][2][4][2], int pm, int pn) {
    unsigned char* ws = p.ws;
    bf16_t* U = (bf16_t*)dyn_smem;
    float* BND = (float*)(ws + WS_R5);
    const bool samp = pm == 128;
    const int brow = pm * BM, tid = opaque_tid();
    {
        const int wid = tid >> 6, lane = tid & 63, wr = wid >> 2, wc = wid & 3, fr = lane & 15, fq = lane >> 4;
        bf16_t* base = U + (wr * 64 + fr) * UST + wc * 32 + 4 * fq;
#pragma unroll
        for (int ai = 0; ai < 2; ++ai)
#pragma unroll
            for (int m = 0; m < 4; ++m)
#pragma unroll
                for (int bj = 0; bj < 2; ++bj)
#pragma unroll
                    for (int n = 0; n < 2; ++n) {
                        const f32x4 v = acc[ai][bj][m][n];
                        u32x2 q; q.x = pk2(v.x, v.y); q.y = pk2(v.z, v.w);
                        *(u32x2*)(base + (ai * 128 + m * 16) * UST + bj * 128 + n * 16) = q;
                    }
    }
    lds_barrier();
    {
        const int nb = samp ? 32 * 256 : 4 * 256;
        for (int id = tid; id < nb; id += 512) {
            const int cl = id & 255, q = id >> 8;
            const int oc = (cl >> 7) * DFF + 128 * pn + (cl & 127);
            int rr, bslot, u;
            if (!samp) { bslot = q; rr = q < 2 ? q : 252 + q; u = pm; }
            else { bslot = q & 3; rr = (q >> 2) * 32 + (bslot < 2 ? bslot : 28 + bslot); u = 128 + (q >> 2); }
            const float v = bf2f(U[rr * UST + cl]);
            BND[((size_t)u * 4 + bslot) * NUP + oc] = v;
            if (bslot >= 2) {
                if (samp) p.out[O_CFS + (size_t)((q >> 2) * 2 + bslot - 2) * NUP + oc] = v;
                else if ((pm & 31) == 31) p.out[O_CFP + (size_t)((pm >> 5) * 2 + bslot - 2) * NUP + oc] = v;
            }
        }
    }
    {
        const int cq = tid & 31, rs = tid >> 5, c = 4 * cq, cg_ = 128 * pn + c, cv_ = DFF + 128 * pn + c;
        const f32x4 wg0 = *(const f32x4*)(p.ffn_conv_w + cg_), wg1 = *(const f32x4*)(p.ffn_conv_w + NUP + cg_), wg2 = *(const f32x4*)(p.ffn_conv_w + 2 * NUP + cg_), bg = *(const f32x4*)(p.ffn_conv_b + cg_);
        const f32x4 wv0 = *(const f32x4*)(p.ffn_conv_w + cv_), wv1 = *(const f32x4*)(p.ffn_conv_w + NUP + cv_), wv2 = *(const f32x4*)(p.ffn_conv_w + 2 * NUP + cv_), bv = *(const f32x4*)(p.ffn_conv_b + cv_);
        bf16_t* GT = (bf16_t*)(ws + WS_R1);
        const int r0 = rs * 16;
        auto ld4 = [&](int rr, int cc) { const u32x2 q = *(const u32x2*)(U + rr * UST + cc); return (f32x4){bflo(q.x), bfhi(q.x), bflo(q.y), bfhi(q.y)}; };
        const f32x4 z4 = {0.f, 0.f, 0.f, 0.f};
        f32x4 g1 = z4, g2 = z4, v1 = z4, v2 = z4;
        if (r0 >= 2) { g1 = ld4(r0 - 2, c); g2 = ld4(r0 - 1, c); v1 = ld4(r0 - 2, 128 + c); v2 = ld4(r0 - 1, 128 + c); }
#pragma unroll 4
        for (int r = r0; r < r0 + 16; ++r) {
            const f32x4 g3 = ld4(r, c), v3 = ld4(r, 128 + c);
            if (r >= 2) {
                const f32x4 cg2 = wg0 * g1 + wg1 * g2 + wg2 * g3 + bg, cv2 = wv0 * v1 + wv1 * v2 + wv2 * v3 + bv;
                u32x2 q; q.x = pk2(silu(cg2.x) * cv2.x, silu(cg2.y) * cv2.y); q.y = pk2(silu(cg2.z) * cv2.z, silu(cg2.w) * cv2.w);
                *(u32x2*)(GT + (size_t)(brow + r) * DFF + 128 * pn + c) = q;
            }
            g1 = g2; g2 = g3; v1 = v2; v2 = v3;
        }
    }
}

template <int K> DI void skinny_gemm(const bf16_t* __restrict__ A, const bf16_t* __restrict__ Bt, float* __restrict__ C, const int N) {
    const int tid = opaque_tid(), lane = tid & 63, w = __builtin_amdgcn_readfirstlane(tid >> 6), fr = lane & 15, fq = lane >> 4;
    float* red = (float*)dyn_smem;
    constexpr int KW = K / 8, NKS = KW / 32;
    const int ntile = 8 * (N / 32);
    for (int t = blockIdx.x; t < ntile; t += gridDim.x) {
        const int rm = t & 7, cn = t >> 3;
        const bf16_t* ap = A + (size_t)(32 * rm + fr) * K + w * KW + 8 * fq;
        const bf16_t* bp = Bt + (size_t)(32 * cn + fr) * K + w * KW + 8 * fq;
        f32x4 acc[2][2];
#pragma unroll
        for (int i = 0; i < 2; ++i)
#pragma unroll
            for (int j = 0; j < 2; ++j) acc[i][j] = (f32x4){0.f, 0.f, 0.f, 0.f};
#pragma unroll 4
        for (int ks = 0; ks < NKS; ++ks) {
            const bf16x8 a0 = *(const bf16x8*)(ap + ks * 32), a1 = *(const bf16x8*)(ap + (size_t)16 * K + ks * 32);
            const bf16x8 b0 = *(const bf16x8*)(bp + ks * 32), b1 = *(const bf16x8*)(bp + (size_t)16 * K + ks * 32);
            acc[0][0] = __builtin_amdgcn_mfma_f32_16x16x32_bf16(a0, b0, acc[0][0], 0, 0, 0);
            acc[0][1] = __builtin_amdgcn_mfma_f32_16x16x32_bf16(a0, b1, acc[0][1], 0, 0, 0);
            acc[1][0] = __builtin_amdgcn_mfma_f32_16x16x32_bf16(a1, b0, acc[1][0], 0, 0, 0);
            acc[1][1] = __builtin_amdgcn_mfma_f32_16x16x32_bf16(a1, b1, acc[1][1], 0, 0, 0);
        }
        lds_barrier();
#pragma unroll
        for (int i = 0; i < 2; ++i)
#pragma unroll
            for (int j = 0; j < 2; ++j)
#pragma unroll
                for (int e = 0; e < 4; ++e) red[(w * 32 + 16 * i + 4 * fq + e) * 33 + 16 * j + fr] = acc[i][j][e];
        lds_barrier();
#pragma unroll
        for (int o2 = 0; o2 < 2; ++o2) {
            const int o = tid + 512 * o2, r = o >> 5, c = o & 31;
            float sum = 0.f;
#pragma unroll
            for (int ww = 0; ww < 8; ++ww) sum += red[(ww * 32 + r) * 33 + c];
            C[(size_t)(32 * rm + r) * N + 32 * cn + c] = sum;
        }
    }
    lds_barrier();
}

template <int WHICH> DI void gemm_phase(const Params& p) {
    unsigned char* ws = p.ws;
    const bf16_t* A; const bf16_t* Bt; int N; constexpr int K = WHICH == 4 ? DFF : D; float* CS;
    if (WHICH == 1) { A = (const bf16_t*)(ws + WS_R1); Bt = (const bf16_t*)(ws + WS_WIN); N = NH1; CS = (float*)(ws + WS_CS1); }
    else if (WHICH == 2) { A = (const bf16_t*)(ws + WS_R2); Bt = (const bf16_t*)(ws + WS_WO); N = D; CS = (float*)(ws + WS_CS2); }
    else if (WHICH == 3) { A = (const bf16_t*)(ws + WS_R3); Bt = (const bf16_t*)(ws + WS_WUP); N = NUP; CS = (float*)(ws + WS_CS3); }
    else { A = (const bf16_t*)(ws + WS_R1); Bt = (const bf16_t*)(ws + WS_WDN); N = D; CS = (float*)(ws + WS_CS4); }
    skinny_gemm<K>(A + (size_t)MP * K, Bt, CS, N);
    const int nM = MP / BM, nN = N / BM, ntile = nM * nN;
    for (int L0 = blockIdx.x; L0 < ntile * (WHICH == GREP_WHICH ? 2 : 1); L0 += gridDim.x) {
        const int L = L0 % ntile;
        int pm, pn; tile_of(L, nM, nN, pm, pn);
        f32x4 acc[2][2][4][2];
        gemm_tile<K>(A, Bt, pm * BM, pn * BM, acc);
        if (WHICH == 3) epi_up(p, acc, pm, pn);
        else {
#pragma unroll
            for (int ai = 0; ai < 2; ++ai) {
                stage_half(acc, ai);
                lds_barrier();
                if (WHICH == 1) epi_in_half(p, pm, pn, ai);
                else if (WHICH == 2) epi_res_half<0>(p, pm, pn, ai);
                else epi_res_half<1>(p, pm, pn, ai);
                lds_barrier();
            }
        }
        lds_barrier();
    }
}

template <int WHICH> DI void ln_phase(const Params& p) {
    const int lane = threadIdx.x & 63, wave = threadIdx.x >> 6;
    const float* g = WHICH == 0 ? p.ln1_g : p.ln2_g; const float* b = WHICH == 0 ? p.ln1_b : p.ln2_b;
    bf16_t* X1B = (bf16_t*)(p.ws + WS_R3);
    const bf16_t* PRE = (const bf16_t*)(p.ws + (WHICH == 0 ? WS_R1 : WS_R2));
    f32x4 gv[4], bv[4];
#pragma unroll
    for (int j = 0; j < 4; ++j) { gv[j] = *(const f32x4*)(g + lane * 4 + 256 * j); bv[j] = *(const f32x4*)(b + lane * 4 + 256 * j); }
    auto ld_row = [&](int row, f32x4 (&v)[4]) {
        if (row < MP) {
#pragma unroll
            for (int j = 0; j < 4; ++j) { const u32x2 q = __builtin_nontemporal_load((const u32x2*)(PRE + (size_t)row * D + lane * 4 + 256 * j)); v[j] = (f32x4){bflo(q.x), bfhi(q.x), bflo(q.y), bfhi(q.y)}; }
        } else {
            const float* cs = (const float*)(p.ws + (WHICH == 0 ? WS_CS2 : WS_CS4)) + (size_t)(row - MP) * D;
#pragma unroll
            for (int j = 0; j < 4; ++j) {
                f32x4 rs;
                if (WHICH == 0) rs = *(const f32x4*)(p.x_s + (size_t)(row - MP) * D + lane * 4 + 256 * j);
                else { const u32x2 q = *(const u32x2*)(X1B + (size_t)row * D + lane * 4 + 256 * j); rs = (f32x4){bflo(q.x), bfhi(q.x), bflo(q.y), bfhi(q.y)}; }
                v[j] = rs * ALPHA + *(const f32x4*)(cs + lane * 4 + 256 * j);
            }
        }
    };
    f32x4 v[4];
    if (blockIdx.x * 8 + wave < M) ld_row(blockIdx.x * 8 + wave, v);
    for (int row = blockIdx.x * 8 + wave; row < M; row += gridDim.x * 8) {
        f32x4 vn[4];
        const bool more = row + (int)gridDim.x * 8 < M;
        if (more) ld_row(row + gridDim.x * 8, vn);
        float s = 0.f;
#pragma unroll
        for (int j = 0; j < 4; ++j) s += (v[j].x + v[j].y) + (v[j].z + v[j].w);
        const float mean = wave_sum(s) * (1.f / D); float s2 = 0.f;
#pragma unroll
        for (int j = 0; j < 4; ++j) { v[j] = v[j] - mean; s2 += (v[j].x * v[j].x + v[j].y * v[j].y) + (v[j].z * v[j].z + v[j].w * v[j].w); }
        const float rstd = rsqrtf(wave_sum(s2) * (1.f / D) + 1e-5f);
#pragma unroll
        for (int j = 0; j < 4; ++j) {
            const f32x4 o = v[j] * rstd * gv[j] + bv[j];
            if (WHICH == 0) { u32x2 q; q.x = pk2(o.x, o.y); q.y = pk2(o.z, o.w); *(u32x2*)(X1B + (size_t)row * D + lane * 4 + 256 * j) = q; }
            else *(f32x4*)(p.out + O_Y + (size_t)row * D + lane * 4 + 256 * j) = o;
        }
        if (more) {
#pragma unroll
            for (int j = 0; j < 4; ++j) v[j] = vn[j];
        }
    }
}

DI void fixup_phase(const Params& p) {
    const float* BND = (const float*)(p.ws + WS_R5);
    bf16_t* GT = (bf16_t*)(p.ws + WS_R1);
    {
        const float* CS3 = (const float*)(p.ws + WS_CS3);
        for (int idx = blockIdx.x * 512 + threadIdx.x; idx < MS * DFF; idx += gridDim.x * 512) {
            const int c = idx % DFF, r = idx / DFF, b = r >> 5, t = r & 31, ng = (c >> 7) * 256 + (c & 127), nv = ng + 128;
            float g[3], v[3];
#pragma unroll
            for (int k = 0; k < 3; ++k) {
                const int tt = t - 2 + k;
                if (tt >= 0) { g[k] = CS3[(size_t)(b * 32 + tt) * NUP + ng]; v[k] = CS3[(size_t)(b * 32 + tt) * NUP + nv]; }
                else { g[k] = p.state_cf[(size_t)(b * 2 + 2 + tt) * NUP + c]; v[k] = p.state_cf[(size_t)(b * 2 + 2 + tt) * NUP + DFF + c]; }
            }
            const float cg2 = p.ffn_conv_w[c] * g[0] + p.ffn_conv_w[NUP + c] * g[1] + p.ffn_conv_w[2 * NUP + c] * g[2] + p.ffn_conv_b[c];
            const float cv2 = p.ffn_conv_w[DFF + c] * v[0] + p.ffn_conv_w[NUP + DFF + c] * v[1] + p.ffn_conv_w[2 * NUP + DFF + c] * v[2] + p.ffn_conv_b[DFF + c];
            GT[((size_t)MP + r) * DFF + c] = f2bf(silu(cg2) * cv2);
            if (t >= 30) { p.out[O_CFS + (size_t)(b * 2 + t - 30) * NUP + c] = g[2]; p.out[O_CFS + (size_t)(b * 2 + t - 30) * NUP + DFF + c] = v[2]; }
        }
    }
    const int total = 128 * 2 * DFF;
    for (int idx = blockIdx.x * 512 + threadIdx.x; idx < total; idx += gridDim.x * 512) {
        const int c = idx % DFF, q = idx / DFF, r = q & 1, u = q >> 1;
        const float* cur = BND + (size_t)u * 4 * NUP;
        float pg[2], pv[2];
        if (u < 128) {
            if ((u & 31) == 0) { pg[0] = pg[1] = pv[0] = pv[1] = 0.f; }
            else { const float* pr = BND + (size_t)(u - 1) * 4 * NUP; pg[0] = pr[2 * NUP + c]; pg[1] = pr[3 * NUP + c]; pv[0] = pr[2 * NUP + DFF + c]; pv[1] = pr[3 * NUP + DFF + c]; }
        } else { const float* st = p.state_cf + (size_t)(u - 128) * 2 * NUP; pg[0] = st[c]; pg[1] = st[NUP + c]; pv[0] = st[DFF + c]; pv[1] = st[NUP + DFF + c]; }
        const float cg0 = cur[c], cg1 = cur[NUP + c], cv0 = cur[DFF + c], cv1 = cur[NUP + DFF + c];
        const float wg0 = p.ffn_conv_w[c], wg1 = p.ffn_conv_w[NUP + c], wg2 = p.ffn_conv_w[2 * NUP + c], bg = p.ffn_conv_b[c];
        const float wv0 = p.ffn_conv_w[DFF + c], wv1 = p.ffn_conv_w[NUP + DFF + c], wv2 = p.ffn_conv_w[2 * NUP + DFF + c], bv = p.ffn_conv_b[DFF + c];
        float g, v;
        if (r == 0) { g = wg0 * pg[0] + wg1 * pg[1] + wg2 * cg0 + bg; v = wv0 * pv[0] + wv1 * pv[1] + wv2 * cv0 + bv; }
        else { g = wg0 * pg[1] + wg1 * cg0 + wg2 * cg1 + bg; v = wv0 * pv[1] + wv1 * cv0 + wv2 * cv1 + bv; }
        const size_t row = u < 128 ? (size_t)u * 256 + r : (size_t)MP + (size_t)(u - 128) * 32 + r;
        GT[row * DFF + c] = f2bf(silu(g) * v);
    }
}

#define MFMA16(a, b, c) __builtin_amdgcn_mfma_f32_16x16x32_bf16((a), (b), (c), 0, 0, 0)
#define MFMA32(a, b, c) __builtin_amdgcn_mfma_f32_32x32x16_bf16((a), (b), (c), 0, 0, 0)
DI bf16x8 pack8(const f32x4 a, const f32x4 b) { u32x4 o; o.x = pk2(a.x, a.y); o.y = pk2(a.z, a.w); o.z = pk2(b.x, b.y); o.w = pk2(b.z, b.w); return __builtin_bit_cast(bf16x8, o); }
constexpr float GSCALE = 0.08838834764831845f;
constexpr int QST = 132, AST = 68, NST = 136, QKST = 72;
constexpr int L_QKV = 0, L_AM = 3 * 64 * QST * 4, L_KN = L_AM + 64 * AST * 4, L_QN = L_KN + 64 * NST * 2, L_GC = L_QN + 64 * NST * 2;
constexpr int L_QKS = 0, L_WS = 64 * QKST * 2;
static_assert(L_GC + 1024 <= LDS_BYTES, "gdn prep LDS");

DI void gdn_conv_weights(const Params& p, const int h, float (&cw)[3][4]) {
#pragma unroll
    for (int k = 0; k < 3; ++k) {
        const int task = threadIdx.x + 512 * k, col = task % 384, part = col >> 7, cc = col & 127, gcol = part * 512 + h * 128 + cc;
#pragma unroll
        for (int j = 0; j < 4; ++j) cw[k][j] = p.gdn_conv_w[j * 1536 + gcol];
    }
}
DI void gdn_prep_item(const Params& p, const int item, const float (&cw)[3][4]) {
    unsigned char* ws = p.ws;
    float* QKVf = (float*)(dyn_smem + L_QKV); float* AM = (float*)(dyn_smem + L_AM);
    bf16_t* KN = (bf16_t*)(dyn_smem + L_KN); bf16_t* QN = (bf16_t*)(dyn_smem + L_QN);
    float* GC = (float*)(dyn_smem + L_GC); float* BETA = GC + 64; float* EG = GC + 128; float* ED = GC + 192;
    bf16_t* QKS = (bf16_t*)(dyn_smem + L_QKS); bf16_t* WSI = (bf16_t*)(dyn_smem + L_WS);
    const bf16_t* HQKV = (const bf16_t*)(ws + WS_R2);
    const float* AB = (const float*)(ws + WS_AB);
    float* DL = (float*)(ws + WS_DL);
        const int tid = opaque_tid(), lane = tid & 63, wave = __builtin_amdgcn_readfirstlane(tid >> 6), fr = lane & 15, fq = lane >> 4;
        int h, b, c, row0, valid; bool samp;
        if (item < 2048) { h = item & 3; c = (item >> 2) & 127; b = item >> 9; row0 = b * TP + c * 64; valid = 64; samp = false; }
        else { const int j = item - 2048; h = j & 3; b = j >> 2; c = 0; row0 = MP + b * TS; valid = TS; samp = true; }
        unsigned char* ip = ws + WS_R1 + (size_t)item * ITEM_B;
        lds_barrier();
        {
            bf16_t* RAW = (bf16_t*)(dyn_smem + L_AM);
#pragma unroll
            for (int i = 0; i < 7; ++i) {
                const int id = tid + 512 * i;
                if (id < 67 * 48) {
                    const int rw = id / 48, ch = id % 48, part = ch >> 4, c8 = (ch & 15) * 8, gcol = part * 512 + h * 128 + c8, t = rw - 3;
                    u32x4 v = (u32x4){0u, 0u, 0u, 0u};
                    if (t >= 0) {
                        if (t < valid) {
                            if (!samp) v = __builtin_nontemporal_load((const u32x4*)(HQKV + (size_t)(row0 + t) * 1536 + gcol));
                            else { const float* sp = (const float*)(ws + WS_CS1) + (size_t)(row0 - MP + t) * NH1 + gcol; const f32x4 f0 = *(const f32x4*)sp, f1 = *(const f32x4*)(sp + 4);
                                   v.x = pk2(f0.x, f0.y); v.y = pk2(f0.z, f0.w); v.z = pk2(f1.x, f1.y); v.w = pk2(f1.z, f1.w); }
                        }
                    }
                    else if (samp) { const float* sp = p.state_cq + (size_t)(b * 3 + 3 + t) * 1536 + gcol; const f32x4 f0 = *(const f32x4*)sp, f1 = *(const f32x4*)(sp + 4);
                                     v.x = pk2(f0.x, f0.y); v.y = pk2(f0.z, f0.w); v.z = pk2(f1.x, f1.y); v.w = pk2(f1.z, f1.w); }
                    else if (c != 0) v = *(const u32x4*)(HQKV + (size_t)(row0 + t) * 1536 + gcol);
                    *(u32x4*)(RAW + rw * 384 + ch * 8) = v;
                }
            }
            lds_barrier();
#pragma unroll
            for (int k3 = 0; k3 < 3; ++k3) {
                const int task = tid + 512 * k3;
                const int col = task % 384, seg = task / 384, part = col >> 7, cc = col & 127, t0 = seg * 16;
                const float w0 = cw[k3][0], w1 = cw[k3][1], w2 = cw[k3][2], w3 = cw[k3][3];
                float x0 = bf2f(RAW[(t0) * 384 + col]), x1 = bf2f(RAW[(t0 + 1) * 384 + col]), x2 = bf2f(RAW[(t0 + 2) * 384 + col]);
#pragma unroll
                for (int t = t0; t < t0 + 16; ++t) {
                    const float xv = bf2f(RAW[(t + 3) * 384 + col]);
                    const float y = w0 * x0 + w1 * x1 + w2 * x2 + w3 * xv;
                    QKVf[(part * 64 + t) * QST + cc] = t < valid ? silu(y) : 0.f;
                    x0 = x1; x1 = x2; x2 = xv;
                }
            }
        }
        if (tid < 64) {
            float g = 0.f, be = 0.f;
            if (tid < valid) {
                const float a = AB[(size_t)(row0 + tid) * 8 + h] + p.dt_bias[h], bb = AB[(size_t)(row0 + tid) * 8 + 4 + h];
                const float sp = a > 20.f ? a : log1pf(expf(a));
                g = -expf(p.a_log[h]) * sp; be = 1.f / (1.f + expf(-bb));
            }
            float gc = g;
#pragma unroll
            for (int o = 1; o < 64; o <<= 1) { const float n = __shfl_up(gc, o); if (lane >= o) gc += n; }
            const float gl = __shfl(gc, 63);
            GC[tid] = gc; BETA[tid] = be; EG[tid] = expf(gc); ED[tid] = expf(gl - gc);
            if (tid == 0) DL[item] = expf(gl);
        }
        lds_barrier();
        {
            const int row = tid >> 3, pt = tid & 7;
            float q[16], k[16]; float sq = 0.f, sk = 0.f;
#pragma unroll
            for (int e4 = 0; e4 < 4; ++e4) {
                const f32x4 a = *(const f32x4*)(QKVf + row * QST + 16 * pt + 4 * e4), bq = *(const f32x4*)(QKVf + (64 + row) * QST + 16 * pt + 4 * e4);
#pragma unroll
                for (int e = 0; e < 4; ++e) { q[4 * e4 + e] = a[e]; k[4 * e4 + e] = bq[e]; sq += a[e] * a[e]; sk += bq[e] * bq[e]; }
            }
#pragma unroll
            for (int o = 1; o < 8; o <<= 1) { sq += __shfl_xor(sq, o); sk += __shfl_xor(sk, o); }
            const float rq = rsqrtf(sq + 1e-6f), rk = rsqrtf(sk + 1e-6f), qg = rq * GSCALE * EG[row];
            u32x4 o0, o1;
            o0.x = pk2(q[0] * rq, q[1] * rq); o0.y = pk2(q[2] * rq, q[3] * rq); o0.z = pk2(q[4] * rq, q[5] * rq); o0.w = pk2(q[6] * rq, q[7] * rq);
            o1.x = pk2(q[8] * rq, q[9] * rq); o1.y = pk2(q[10] * rq, q[11] * rq); o1.z = pk2(q[12] * rq, q[13] * rq); o1.w = pk2(q[14] * rq, q[15] * rq);
            *(u32x4*)(QN + row * NST + 16 * pt) = o0; *(u32x4*)(QN + row * NST + 16 * pt + 8) = o1;
            o0.x = pk2(k[0] * rk, k[1] * rk); o0.y = pk2(k[2] * rk, k[3] * rk); o0.z = pk2(k[4] * rk, k[5] * rk); o0.w = pk2(k[6] * rk, k[7] * rk);
            o1.x = pk2(k[8] * rk, k[9] * rk); o1.y = pk2(k[10] * rk, k[11] * rk); o1.z = pk2(k[12] * rk, k[13] * rk); o1.w = pk2(k[14] * rk, k[15] * rk);
            *(u32x4*)(KN + row * NST + 16 * pt) = o0; *(u32x4*)(KN + row * NST + 16 * pt + 8) = o1;
#pragma unroll
            for (int e4 = 0; e4 < 4; ++e4) *(f32x4*)(QKVf + (64 + row) * QST + 16 * pt + 4 * e4) = (f32x4){k[4 * e4] * rk, k[4 * e4 + 1] * rk, k[4 * e4 + 2] * rk, k[4 * e4 + 3] * rk};
            bf16_t* QGf = (bf16_t*)(ip + 16384);
            const int rt = row >> 4, frr = row & 15, ks = pt >> 1;
#pragma unroll
            for (int f = 0; f < 4; ++f) {
                u32x2 o; o.x = pk2(q[4 * f] * qg, q[4 * f + 1] * qg); o.y = pk2(q[4 * f + 2] * qg, q[4 * f + 3] * qg);
                *(u32x2*)(QGf + (size_t)(((rt * 4 + ks) * 64 + f * 16 + frr) * 8 + 4 * (pt & 1))) = o;
            }
        }
        lds_barrier();
        {
            const bool isq = wave >= 4; const int ti = wave & 3;
            const bf16_t* As = isq ? QN : KN;
#pragma unroll
            for (int tj = 0; tj < 4; ++tj) {
                f32x4 acc = (f32x4){0.f, 0.f, 0.f, 0.f};
#pragma unroll
                for (int ks = 0; ks < 4; ++ks) {
                    const bf16x8 a = *(const bf16x8*)(As + (16 * ti + fr) * NST + 32 * ks + 8 * fq), bb = *(const bf16x8*)(KN + (16 * tj + fr) * NST + 32 * ks + 8 * fq);
                    acc = MFMA16(a, bb, acc);
                }
                const int jj = 16 * tj + fr; const float gj = GC[jj];
#pragma unroll
                for (int j = 0; j < 4; ++j) {
                    const int i = 16 * ti + 4 * fq + j;
                    const float dec = i >= jj ? __expf(GC[i] - gj) : 0.f;
                    if (!isq) AM[i * AST + jj] = i > jj ? BETA[i] * acc[j] * dec : 0.f;
                    else QKS[i * QKST + jj] = f2bf(GSCALE * acc[j] * dec);
                }
            }
            bf16_t* KDTf = (bf16_t*)(ip + 32768);
#pragma unroll
            for (int i2 = 0; i2 < 2; ++i2) {
                const int f = tid + 512 * i2, ln = f & 63, ks2 = (f >> 6) & 1, dt = f >> 7, fq_ = ln >> 4, dk = 16 * dt + (ln & 15);
                float v[8];
#pragma unroll
                for (int e = 0; e < 8; ++e) { const int i = 32 * ks2 + 16 * (e >> 2) + 4 * fq_ + (e & 3); v[e] = bf2f(KN[i * NST + dk]) * ED[i]; }
                u32x4 o; o.x = pk2(v[0], v[1]); o.y = pk2(v[2], v[3]); o.z = pk2(v[4], v[5]); o.w = pk2(v[6], v[7]);
                *(u32x4*)(KDTf + (size_t)f * 8) = o;
            }
        }
        lds_barrier();
        {
            float* TM = (float*)(dyn_smem + L_QN);
            float* TMP = (float*)(dyn_smem + L_KN);
#pragma unroll
            for (int i = 0; i < 9; ++i) { const int id = tid + 512 * i; if (id < 64 * AST) TM[id] = 0.f; }
            lds_barrier();
            if (tid < 64) {
                const int d = tid >> 4, c = tid & 15;
                float y[16];
#pragma unroll
                for (int r = 0; r < 16; ++r) {
                    float sacc = r == c ? 1.f : 0.f;
                    const float* ar = AM + (16 * d + r) * AST + 16 * d;
                    float arow[16];
#pragma unroll
                    for (int j4 = 0; j4 < (r + 3) / 4; ++j4) { const f32x4 a = *(const f32x4*)(ar + 4 * j4); arow[4 * j4] = a.x; arow[4 * j4 + 1] = a.y; arow[4 * j4 + 2] = a.z; arow[4 * j4 + 3] = a.w; }
#pragma unroll
                    for (int j = 0; j < r; ++j) sacc -= arow[j] * y[j];
                    y[r] = sacc;
                    TM[(16 * d + r) * AST + 16 * d + c] = sacc;
                }
            }
            lds_barrier();
            {
                const int blk = tid >> 8, r = (tid >> 4) & 15, c = tid & 15, rb = blk ? 3 : 1, cb = rb - 1;
                float t = 0.f;
#pragma unroll
                for (int j = 0; j < 16; ++j) t += AM[(16 * rb + r) * AST + 16 * cb + j] * TM[(16 * cb + j) * AST + 16 * cb + c];
                TMP[blk * 272 + r * 17 + c] = t;
                lds_barrier();
                float o = 0.f;
#pragma unroll
                for (int k = 0; k < 16; ++k) o -= TM[(16 * rb + r) * AST + 16 * rb + k] * TMP[blk * 272 + k * 17 + c];
                lds_barrier();
                TM[(16 * rb + r) * AST + 16 * cb + c] = o;
            }
            lds_barrier();
            {
                float t[2];
#pragma unroll
                for (int i2 = 0; i2 < 2; ++i2) {
                    const int o = tid + 512 * i2, r = o >> 5, c = o & 31;
                    float acc = 0.f;
#pragma unroll
                    for (int j4 = 0; j4 < 8; ++j4) {
                        const f32x4 a = *(const f32x4*)(AM + (32 + r) * AST + 4 * j4);
                        acc += a.x * TM[(4 * j4) * AST + c] + a.y * TM[(4 * j4 + 1) * AST + c] + a.z * TM[(4 * j4 + 2) * AST + c] + a.w * TM[(4 * j4 + 3) * AST + c];
                    }
                    t[i2] = acc;
                }
#pragma unroll
                for (int i2 = 0; i2 < 2; ++i2) { const int o = tid + 512 * i2; TMP[(o >> 5) * 33 + (o & 31)] = t[i2]; }
                lds_barrier();
#pragma unroll
                for (int i2 = 0; i2 < 2; ++i2) {
                    const int o = tid + 512 * i2, r = o >> 5, c = o & 31;
                    float acc = 0.f;
#pragma unroll
                    for (int k4 = 0; k4 < 8; ++k4) {
                        const f32x4 a = *(const f32x4*)(TM + (32 + r) * AST + 32 + 4 * k4);
                        acc -= a.x * TMP[(4 * k4) * 33 + c] + a.y * TMP[(4 * k4 + 1) * 33 + c] + a.z * TMP[(4 * k4 + 2) * 33 + c] + a.w * TMP[(4 * k4 + 3) * 33 + c];
                    }
                    t[i2] = acc;
                }
#pragma unroll
                for (int i2 = 0; i2 < 2; ++i2) { const int o = tid + 512 * i2; TM[(32 + (o >> 5)) * AST + (o & 31)] = t[i2]; }
            }
            lds_barrier();
            {
                bf16x8 Ah[4][2], Al[4][2];
#pragma unroll
                for (int rt = 0; rt < 4; ++rt)
#pragma unroll
                    for (int ks = 0; ks < 2; ++ks) {
                        const f32x4 a0 = *(const f32x4*)(TM + (16 * rt + fr) * AST + 32 * ks + 8 * fq), a1 = *(const f32x4*)(TM + (16 * rt + fr) * AST + 32 * ks + 8 * fq + 4);
                        u32x4 hq; hq.x = pk2(a0.x, a0.y); hq.y = pk2(a0.z, a0.w); hq.z = pk2(a1.x, a1.y); hq.w = pk2(a1.z, a1.w);
                        u32x4 lq; lq.x = pk2(a0.x - bflo(hq.x), a0.y - bfhi(hq.x)); lq.y = pk2(a0.z - bflo(hq.y), a0.w - bfhi(hq.y));
                        lq.z = pk2(a1.x - bflo(hq.z), a1.y - bfhi(hq.z)); lq.w = pk2(a1.z - bflo(hq.w), a1.w - bfhi(hq.w));
                        Ah[rt][ks] = __builtin_bit_cast(bf16x8, hq); Al[rt][ks] = __builtin_bit_cast(bf16x8, lq);
                    }
                const bool isw = wave >= 4;
                f32x4 xacc[2][4];
#pragma unroll
                for (int q = 0; q < 2; ++q)
#pragma unroll
                    for (int rt = 0; rt < 4; ++rt) xacc[q][rt] = (f32x4){0.f, 0.f, 0.f, 0.f};
#pragma unroll
                for (int ks = 0; ks < 2; ++ks) {
                    float sc8[8];
                    {
                        const f32x4 b0 = *(const f32x4*)(BETA + 32 * ks + 8 * fq), b1 = *(const f32x4*)(BETA + 32 * ks + 8 * fq + 4);
                        const f32x4 e0 = *(const f32x4*)(EG + 32 * ks + 8 * fq), e1 = *(const f32x4*)(EG + 32 * ks + 8 * fq + 4);
#pragma unroll
                        for (int e = 0; e < 4; ++e) { sc8[e] = isw ? b0[e] * e0[e] : b0[e]; sc8[4 + e] = isw ? b1[e] * e1[e] : b1[e]; }
                    }
#pragma unroll
                    for (int q = 0; q < 2; ++q) {
                        const int cc = ((2 * wave + q) & 7) * 16 + fr;
                        const float* src = QKVf + ((isw ? 64 : 128) + 32 * ks + 8 * fq) * QST + cc;
                        float v[8];
#pragma unroll
                        for (int e = 0; e < 8; ++e) v[e] = src[e * QST] * sc8[e];
                        u32x4 hq; hq.x = pk2(v[0], v[1]); hq.y = pk2(v[2], v[3]); hq.z = pk2(v[4], v[5]); hq.w = pk2(v[6], v[7]);
                        u32x4 lq; lq.x = pk2(v[0] - bflo(hq.x), v[1] - bfhi(hq.x)); lq.y = pk2(v[2] - bflo(hq.y), v[3] - bfhi(hq.y));
                        lq.z = pk2(v[4] - bflo(hq.z), v[5] - bfhi(hq.z)); lq.w = pk2(v[6] - bflo(hq.w), v[7] - bfhi(hq.w));
                        const bf16x8 Bh = __builtin_bit_cast(bf16x8, hq), Bl = __builtin_bit_cast(bf16x8, lq);
#pragma unroll
                        for (int rt = 0; rt < 4; ++rt) {
                            xacc[q][rt] = MFMA16(Ah[rt][ks], Bh, xacc[q][rt]);
                            xacc[q][rt] = MFMA16(Al[rt][ks], Bh, xacc[q][rt]);
                            xacc[q][rt] = MFMA16(Ah[rt][ks], Bl, xacc[q][rt]);
                        }
                    }
                }
                if (!isw) {
                    float* Uc = (float*)(ip + 57344);
#pragma unroll
                    for (int q = 0; q < 2; ++q)
#pragma unroll
                        for (int rt = 0; rt < 4; ++rt) *(f32x4*)(Uc + (size_t)((((2 * wave + q) * 4 + rt) * 64 + lane) * 4)) = xacc[q][rt];
                } else {
#pragma unroll
                    for (int q = 0; q < 2; ++q)
#pragma unroll
                        for (int rt = 0; rt < 4; ++rt)
#pragma unroll
                            for (int j = 0; j < 4; ++j) WSI[(16 * rt + 4 * fq + j) * NST + ((2 * wave + q) & 7) * 16 + fr] = f2bf(xacc[q][rt][j]);
                }
            }
        }
        lds_barrier();
        {
            bf16_t* Wf = (bf16_t*)ip; bf16_t* QKf = (bf16_t*)(ip + 49152);
#pragma unroll
            for (int i2 = 0; i2 < 2; ++i2) {
                const int f = tid + 512 * i2, ln = f & 63, ks = (f >> 6) & 3, rt = f >> 8, i = 16 * rt + (ln & 15), fq_ = ln >> 4;
                const u32x2 lo = *(const u32x2*)(WSI + i * NST + 32 * ks + 4 * fq_), hi = *(const u32x2*)(WSI + i * NST + 32 * ks + 16 + 4 * fq_);
                *(u32x4*)(Wf + (size_t)f * 8) = (u32x4){lo.x, lo.y, hi.x, hi.y};
            }
            {
                const int f = tid, ln = f & 63, ks2 = (f >> 6) & 1, rt = f >> 7, i = 16 * rt + (ln & 15), fq_ = ln >> 4;
                const u32x2 lo = *(const u32x2*)(QKS + i * QKST + 32 * ks2 + 4 * fq_), hi = *(const u32x2*)(QKS + i * QKST + 32 * ks2 + 16 + 4 * fq_);
                *(u32x4*)(QKf + (size_t)f * 8) = (u32x4){lo.x, lo.y, hi.x, hi.y};
            }
        }
    lds_barrier();
}

DI void gdn_prep_phase(const Params& p) {
    unsigned char* ws = p.ws;
    for (int r = blockIdx.x; r < MS; r += gridDim.x) {
        const int tid = opaque_tid(), b = r >> 5, t = r & 31, pos = PAST + t;
        const float* cs = (const float*)(ws + WS_CS1) + (size_t)r * NH1;
        if (t >= TS - 3) { for (int c = tid; c < 1536; c += 512) p.out[O_CQS + (size_t)(b * 3 + t - (TS - 3)) * 1536 + c] = cs[c]; }
        {
            const int which = tid >> 8, pr = tid & 255, hd = pr >> 6, mp = (pr >> 5) & 1, d = pr & 31, col = hd * 128 + mp * 64 + d;
            const float2 csn = ((const float2*)(ws + WS_ROPE))[pos * 32 + d];
            const float x1 = cs[2048 + which * 512 + col], x2 = cs[2048 + which * 512 + col + 32];
            const float y1 = x1 * csn.x - x2 * csn.y, y2 = x2 * csn.x + x1 * csn.y;
            if (which == 0) { const float qs = 0.125f * 1.4426950408889634f; bf16_t* QB = (bf16_t*)(ws + WS_R4) + ((size_t)MP + r) * 512; QB[col] = f2bf(y1 * qs); QB[col + 32] = f2bf(y2 * qs); }
            else { float* ko = p.out + O_KS + (size_t)r * 512; ko[col] = y1; ko[col + 32] = y2;
                   bf16_t* kk = (bf16_t*)(ws + WS_R5) + ((size_t)MP + (size_t)b * TKS + pos) * 512; kk[col] = f2bf(y1); kk[col + 32] = f2bf(y2); }
        }
        {
            const float vv = cs[3072 + tid];
            p.out[O_VS + (size_t)r * 512 + tid] = vv;
            ((bf16_t*)(ws + WS_R6))[VT_S_OFF + ((size_t)((b * 4 + (tid >> 7)) * 128 + (tid & 127)) * TKS + pos)] = f2bf(vv);
        }
    }
    float cw[3][4];
    gdn_conv_weights(p, blockIdx.x & 3, cw);
    {
        const int when = blockIdx.x & 7; int k = 0;
#pragma unroll 1
        for (int item = blockIdx.x; item < 2048; item += gridDim.x, ++k) { if (k == when) prep_stream(p); gdn_prep_item(p, item, cw); }
    }
}

constexpr int OPB_B = 57344, L_OBUF = 2 * OPB_B, OST = 132;
static_assert(L_OBUF + 64 * OST * 4 <= LDS_BYTES, "scan LDS");
DI void gdn_scan(const Params& p, const bool samp, const int b, const int h) {
    unsigned char* ws = p.ws;
    const int tid = threadIdx.x, lane = tid & 63, w = __builtin_amdgcn_readfirstlane(tid >> 6), fr = lane & 15, fq = lane >> 4;
    const int nsteps = samp ? 1 : 128, valid = samp ? TS : 64;
    float* OBUF = (float*)(dyn_smem + L_OBUF);
    const bf16_t* HG = (const bf16_t*)(ws + WS_R3);
    bf16_t* OMIX = (bf16_t*)(ws + WS_R2);
    const float* DL = (const float*)(ws + WS_DL);
    f32x4 S[8];
#pragma unroll
    for (int dt = 0; dt < 8; ++dt) {
        if (samp) {
#pragma unroll
            for (int j = 0; j < 4; ++j) S[dt][j] = p.state_gdn[((size_t)(b * 4 + h) * 128 + 16 * dt + 4 * fq + j) * 128 + 16 * w + fr];
        } else S[dt] = (f32x4){0.f, 0.f, 0.f, 0.f};
    }
    const int item0 = samp ? 2048 + b * 4 + h : b * 512 + h;
    lds_barrier();
    {
        const unsigned char* ip = ws + WS_R1 + (size_t)item0 * ITEM_B;
#pragma unroll
        for (int i = 0; i < 7; ++i) *(u32x4*)(dyn_smem + (tid + 512 * i) * 16) = *(const u32x4*)(ip + (tid + 512 * i) * 16);
    }
    lds_barrier();
    const int erow = tid >> 3, ept = tid & 7;
    float nw[16];
#pragma unroll
    for (int e = 0; e < 16; ++e) nw[e] = p.gdn_norm_w[16 * ept + e];
    f32x4 U[4]; float dl; u32x4 g0, g1;
    auto side_load = [&](int c, f32x4 (&Uo)[4], float& dlo, u32x4& go0, u32x4& go1) {
        const int item = item0 + 4 * c;
        const float* Uc = (const float*)(ws + WS_R1 + (size_t)item * ITEM_B + 57344);
#pragma unroll
        for (int rt = 0; rt < 4; ++rt) Uo[rt] = __builtin_nontemporal_load((const f32x4*)(Uc + ((w * 4 + rt) * 64 + lane) * 4));
        dlo = DL[item];
        const size_t grow = (samp ? (size_t)MP + b * TS : (size_t)b * TP + (size_t)c * 64) + erow;
        if (!samp) { go0 = *(const u32x4*)(HG + grow * 512 + h * 128 + 16 * ept); go1 = *(const u32x4*)(HG + grow * 512 + h * 128 + 16 * ept + 8); }
        else if (erow < TS) { const float* gp = (const float*)(ws + WS_CS1) + (grow - MP) * NH1 + 1536 + h * 128 + 16 * ept;
               const f32x4 f0 = *(const f32x4*)gp, f1 = *(const f32x4*)(gp + 4), f2 = *(const f32x4*)(gp + 8), f3 = *(const f32x4*)(gp + 12);
               go0 = (u32x4){pk2(f0.x, f0.y), pk2(f0.z, f0.w), pk2(f1.x, f1.y), pk2(f1.z, f1.w)}; go1 = (u32x4){pk2(f2.x, f2.y), pk2(f2.z, f2.w), pk2(f3.x, f3.y), pk2(f3.z, f3.w)}; }
        else { go0 = (u32x4){0u, 0u, 0u, 0u}; go1 = go0; }
    };
    side_load(0, U, dl, g0, g1);
#pragma unroll 1
    for (int c = 0; c < nsteps; ++c) {
        const int item = item0 + 4 * c;
        const unsigned char* ip = ws + WS_R1 + (size_t)item * ITEM_B;
        const bool nxt = c + 1 < nsteps;
        u32x4 pf[7];
        f32x4 Un[4]; float dln = 0.f; u32x4 gn0 = g0, gn1 = g1;
        if (nxt) {
#pragma unroll
            for (int i = 0; i < 7; ++i) pf[i] = __builtin_nontemporal_load((const u32x4*)(ip + 4 * (size_t)ITEM_B + (tid + 512 * i) * 16));
            side_load(c + 1, Un, dln, gn0, gn1);
        }
        const unsigned char* buf = dyn_smem + (c & 1) * OPB_B;
        bf16x8 Sb[4];
#pragma unroll
        for (int ks = 0; ks < 4; ++ks) Sb[ks] = pack8(S[2 * ks], S[2 * ks + 1]);
        f32x4 vn[4];
#pragma unroll
        for (int rt = 0; rt < 4; ++rt) {
            f32x4 acc = (f32x4){0.f, 0.f, 0.f, 0.f};
#pragma unroll
            for (int ks = 0; ks < 4; ++ks) acc = MFMA16(*(const bf16x8*)(buf + ((rt * 4 + ks) * 64 + lane) * 16), Sb[ks], acc);
            vn[rt] = U[rt] - acc;
        }
        bf16x8 Vb[2];
        Vb[0] = pack8(vn[0], vn[1]); Vb[1] = pack8(vn[2], vn[3]);
#pragma unroll
        for (int rt = 0; rt < 4; ++rt) {
            f32x4 acc = (f32x4){0.f, 0.f, 0.f, 0.f};
#pragma unroll
            for (int ks = 0; ks < 4; ++ks) acc = MFMA16(*(const bf16x8*)(buf + 16384 + ((rt * 4 + ks) * 64 + lane) * 16), Sb[ks], acc);
#pragma unroll
            for (int ks2 = 0; ks2 < 2; ++ks2) acc = MFMA16(*(const bf16x8*)(buf + 49152 + ((rt * 2 + ks2) * 64 + lane) * 16), Vb[ks2], acc);
#pragma unroll
            for (int j = 0; j < 4; ++j) OBUF[(16 * rt + 4 * fq + j) * OST + 16 * w + fr] = acc[j];
        }
#pragma unroll
        for (int dt = 0; dt < 8; ++dt) {
            f32x4 acc = S[dt] * dl;
#pragma unroll
            for (int ks2 = 0; ks2 < 2; ++ks2) acc = MFMA16(*(const bf16x8*)(buf + 32768 + ((dt * 2 + ks2) * 64 + lane) * 16), Vb[ks2], acc);
            S[dt] = acc;
        }
        if (nxt) {
#pragma unroll
            for (int i = 0; i < 7; ++i) *(u32x4*)(dyn_smem + ((c + 1) & 1) * OPB_B + (tid + 512 * i) * 16) = pf[i];
        }
        lds_barrier();
        {
            float o[16]; float ss = 0.f;
#pragma unroll
            for (int e4 = 0; e4 < 4; ++e4) { const f32x4 a = *(const f32x4*)(OBUF + erow * OST + 16 * ept + 4 * e4);
#pragma unroll
                for (int e = 0; e < 4; ++e) { o[4 * e4 + e] = a[e]; ss += a[e] * a[e]; } }
#pragma unroll
            for (int of = 1; of < 8; of <<= 1) ss += __shfl_xor(ss, of);
            if (erow < valid) {
                const float r = rsqrtf(ss * (1.f / 128.f) + 1e-6f);
                const size_t grow = (samp ? (size_t)MP + b * TS : (size_t)b * TP + (size_t)c * 64) + erow;
                const unsigned gw[8] = {g0.x, g0.y, g0.z, g0.w, g1.x, g1.y, g1.z, g1.w};
                unsigned ow[8];
#pragma unroll
                for (int e = 0; e < 8; ++e) {
                    const float ga = bflo(gw[e]), gb = bfhi(gw[e]);
                    ow[e] = pk2(o[2 * e] * r * nw[2 * e] * silu(ga), o[2 * e + 1] * r * nw[2 * e + 1] * silu(gb));
                }
                *(u32x4*)(OMIX + grow * 1024 + h * 128 + 16 * ept) = (u32x4){ow[0], ow[1], ow[2], ow[3]};
                *(u32x4*)(OMIX + grow * 1024 + h * 128 + 16 * ept + 8) = (u32x4){ow[4], ow[5], ow[6], ow[7]};
            }
        }
        lds_barrier();
#pragma unroll
        for (int rt = 0; rt < 4; ++rt) U[rt] = Un[rt];
        dl = dln; g0 = gn0; g1 = gn1;
    }
    float* So = p.out + (samp ? O_GS : O_GP) + (size_t)(b * 4 + h) * 128 * 128;
#pragma unroll
    for (int dt = 0; dt < 8; ++dt)
#pragma unroll
        for (int j = 0; j < 4; ++j) So[(size_t)(16 * dt + 4 * fq + j) * 128 + 16 * w + fr] = S[dt][j];
}

constexpr int L_KT = 0, L_VT = 2 * 16384, L_ALX = L_VT + 3 * 16384, L_IDX = L_ALX + 8 * 2 * 32 * 4, L_QF = L_IDX + 256;
static_assert(L_QF + 8 * 8 * 1024 <= LDS_BYTES, "attn LDS");
DI int crow32(int i, int hh) { return (i & 3) + 8 * (i >> 2) + 4 * hh; }

DI void attn_item(const Params& p, const int idx, const float* lamp) {
    unsigned char* ws = p.ws;
    const int tid = opaque_tid(), lane = tid & 63, w = __builtin_amdgcn_readfirstlane(tid >> 6), r = lane & 31, hh = lane >> 5;
    bool samp; int b, h, qb = 0, ntiles, lastw; size_t qbase, kbase; const bf16_t* vtb; int vstride; bool active;
    if (idx < 32) { samp = true; b = idx >> 2; h = idx & 3; qbase = (size_t)MP + b * TS; kbase = (size_t)MP + (size_t)b * TKS; ntiles = 65; lastw = 64; active = w == 0;
                    vtb = (const bf16_t*)(ws + WS_R6) + VT_S_OFF + (size_t)((b * 4 + h) * 128) * TKS; vstride = TKS; }
    else { const int j = idx - 32; samp = false; qb = 31 - (j >> 4); b = (j & 15) >> 2; h = j & 3; qbase = (size_t)b * TP + qb * 256; kbase = (size_t)b * TP; ntiles = 4 * qb + 4; lastw = 4 * qb + (w >> 1); active = true;
           vtb = (const bf16_t*)(ws + WS_R6) + (size_t)((b * 4 + h) * 128) * TP; vstride = TP; }
    const bf16_t* KALL = (const bf16_t*)(ws + WS_R5) + kbase * 512 + h * 128;
    bf16_t* QF = (bf16_t*)(dyn_smem + L_QF) + w * 8 * 64 * 8;
    {
        const bf16_t* qp = (const bf16_t*)(ws + WS_R4) + (qbase + 32 * w + r) * 512 + h * 128 + 8 * hh;
        if (active) {
#pragma unroll
            for (int f = 0; f < 8; ++f) *(u32x4*)(QF + (f * 64 + lane) * 8) = *(const u32x4*)(qp + (f >> 2) * 64 + 16 * (f & 3));
        }
    }
    f32x16 O1[4], O2[4];
#pragma unroll
    for (int t = 0; t < 4; ++t)
#pragma unroll
        for (int i = 0; i < 16; ++i) { O1[t][i] = 0.f; O2[t][i] = 0.f; }
    float m1 = -1e30f, m2 = -1e30f, l1 = 0.f, l2 = 0.f;
    auto stage_tile = [&](int kt_, int buf_, int vbuf_) {
        int ln = lane; asm volatile("" : "+v"(ln));
        const int krow_ = ln >> 4, vrow_ = ln >> 3;
        const unsigned kx = (ln & 15) ^ krow_, vx = (ln & 7) ^ (vrow_ >> 1);
        const unsigned klane = krow_ * 512, vlane = vrow_ * vstride;
#pragma unroll
        for (int j = 0; j < 2; ++j) {
            const int i = 2 * w + j;
            const bf16_t* kbase = KALL + ((size_t)kt_ * 64 + (((4 * i) & ~12) | (((4 * i) & 4) << 1) | (((4 * i) & 8) >> 1))) * 512;
            const bf16_t* vbase = vtb + (size_t)(8 * i) * vstride + (size_t)kt_ * 64;
            const unsigned ko = klane + ((kx ^ ((4 * i) & 15)) * 8), vo = vlane + ((vx ^ ((4 * i) & 7)) * 8);
            __builtin_amdgcn_global_load_lds((const unsigned*)(kbase + ko), (unsigned*)(dyn_smem + L_KT + buf_ * 16384 + i * 1024 + ln * 16), 16, 0, 0);
            __builtin_amdgcn_global_load_lds((const unsigned*)(vbase + vo), (unsigned*)(dyn_smem + L_VT + vbuf_ * 16384 + i * 1024 + ln * 16), 16, 0, 0);
        }
    };
    const int ky = hh ^ (r & 15), vzh = ((r >> 1) & 7) ^ hh;
    __syncthreads();
    stage_tile(0, 0, 0);
    asm volatile("s_waitcnt vmcnt(0)" ::: "memory");
    __syncthreads();
    if (active) {
#pragma unroll
        for (int mp = 0; mp < 2; ++mp) {
            float mx = -1e30f;
#pragma unroll
            for (int sub = 0; sub < 2; ++sub) {
                f32x16 sc;
#pragma unroll
                for (int i = 0; i < 16; ++i) sc[i] = 0.f;
#pragma unroll
                for (int s = 0; s < 4; ++s) {
                    const bf16x8 ka = *(const bf16x8*)(dyn_smem + L_KT + (sub * 32 + r) * 256 + (((mp * 8 + 2 * s) ^ ky) * 16));
                    const bf16x8 qf = *(const bf16x8*)(QF + ((mp * 4 + s) * 64 + lane) * 8);
                    sc = MFMA32(ka, qf, sc);
                }
#pragma unroll
                for (int i = 0; i < 16; ++i) mx = fmaxf(mx, sc[i]);
            }
            const auto sw = __builtin_amdgcn_permlane32_swap(__float_as_uint(mx), __float_as_uint(mx), false, false);
            mx = fmaxf(__uint_as_float(sw[0]), __uint_as_float(sw[1]));
            if (mp == 0) m1 = mx; else m2 = mx;
        }
    }
    const bool roleY = w >= 4;
    bf16x8 PA[2], PB[2];
    float tm1 = -1e30f, tm2 = -1e30f;
    int vcur = 0, vprev = 2;
#define ATT_QK(SUB, MP, SC) do { \
        _Pragma("unroll") for (int s_ = 0; s_ < 4; ++s_) { \
            const bf16x8 ka_ = *(const bf16x8*)(Kb + (SUB) * 32 * 256 + ((((MP) * 8 + 2 * s_) ^ ky) * 16)); \
            const bf16x8 qf_ = *(const bf16x8*)(QF + (((MP) * 4 + s_) * 64 + lane) * 8); \
            SC = MFMA32(ka_, qf_, s_ == 0 ? zero16 : SC); } } while (0)
#define ATT_SM(SC, P, MM, LL, TM, MSK) do { \
        float ps_ = 0.f, tq_ = TM; const float mr_ = MM + MSK; \
        _Pragma("unroll") for (int i_ = 0; i_ < 16; ++i_) { tq_ = fmaxf(tq_, SC[i_]); SC[i_] = __builtin_amdgcn_exp2f(SC[i_] - mr_); ps_ += SC[i_]; } \
        TM = MSK != 0.f ? TM : tq_; \
        LL += ps_; \
        _Pragma("unroll") for (int sp_ = 0; sp_ < 2; ++sp_) { \
            u32x4 a_; a_.x = pk2(SC[8 * sp_], SC[8 * sp_ + 1]); a_.y = pk2(SC[8 * sp_ + 2], SC[8 * sp_ + 3]); a_.z = pk2(SC[8 * sp_ + 4], SC[8 * sp_ + 5]); a_.w = pk2(SC[8 * sp_ + 6], SC[8 * sp_ + 7]); \
            P[sp_] = __builtin_bit_cast(bf16x8, a_); } } while (0)
#define ATT_PV2(VB, SUB, P1, P2) do { \
        _Pragma("unroll") for (int sp_ = 0; sp_ < 2; ++sp_) \
            _Pragma("unroll") for (int t_ = 0; t_ < 4; ++t_) { \
                const bf16x8 vb_ = *(const bf16x8*)((VB) + t_ * 32 * 128 + (((4 * (SUB) + 2 * sp_) ^ vzh) * 16)); \
                O1[t_] = MFMA32(P1[sp_], vb_, O1[t_]); O2[t_] = MFMA32(P2[sp_], vb_, O2[t_]); } } while (0)
#define ATT_QS(SUB, MSK) do { \
        f32x16 scA, scB; \
        ATT_QK(SUB, 0, scA); \
        ATT_QK(SUB, 1, scB); \
        __builtin_amdgcn_sched_barrier(0); \
        ATT_SM(scA, PA, m1, l1, tm1, MSK); \
        ATT_SM(scB, PB, m2, l2, tm2, MSK); \
        __builtin_amdgcn_sched_barrier(0); } while (0)
#define ATT_CHECK() do { \
        const auto s1_ = __builtin_amdgcn_permlane32_swap(__float_as_uint(tm1), __float_as_uint(tm1), false, false); tm1 = fmaxf(__uint_as_float(s1_[0]), __uint_as_float(s1_[1])); \
        const auto s2_ = __builtin_amdgcn_permlane32_swap(__float_as_uint(tm2), __float_as_uint(tm2), false, false); tm2 = fmaxf(__uint_as_float(s2_[0]), __uint_as_float(s2_[1])); \
        const float n1 = tm1 > m1 + 8.f ? tm1 : m1, n2 = tm2 > m2 + 8.f ? tm2 : m2; \
        if (__any((n1 != m1) || (n2 != m2))) { \
            const float al1 = __builtin_amdgcn_exp2f(m1 - n1), al2 = __builtin_amdgcn_exp2f(m2 - n2); \
            l1 *= al1; l2 *= al2; m1 = n1; m2 = n2; \
            const int ln_ = __builtin_amdgcn_mbcnt_hi(~0u, __builtin_amdgcn_mbcnt_lo(~0u, 0u)), r_ = ln_ & 31, hh_ = ln_ >> 5; \
            float* alx_ = (float*)(dyn_smem + L_ALX) + w * 64; \
            if (hh_ == 0) { alx_[r_] = al1; alx_[32 + r_] = al2; } \
            asm volatile("s_waitcnt lgkmcnt(0)" ::: "memory"); \
            _Pragma("unroll") for (int g = 0; g < 4; ++g) { \
                const f32x4 a1 = *(const f32x4*)(alx_ + 8 * g + 4 * hh_), a2 = *(const f32x4*)(alx_ + 32 + 8 * g + 4 * hh_); \
                _Pragma("unroll") for (int t = 0; t < 4; ++t) \
                    _Pragma("unroll") for (int j = 0; j < 4; ++j) { O1[t][4 * g + j] *= a1[j]; O2[t][4 * g + j] *= a2[j]; } } \
            asm volatile("s_waitcnt lgkmcnt(0)" ::: "memory"); } \
        tm1 = -1e30f; tm2 = -1e30f; } while (0)
    f32x16 zero16;
#pragma unroll
    for (int i = 0; i < 16; ++i) zero16[i] = 0.f;
    if (!roleY) {
#pragma unroll 1
        for (int kt = 0; kt < ntiles; ++kt) {
            const int vnext = vcur == 2 ? 0 : vcur + 1;
            if (kt + 1 < ntiles) stage_tile(kt + 1, (kt + 1) & 1, vnext);
            const unsigned char* Kb = dyn_smem + L_KT + (kt & 1) * 16384 + r * 256;
            const unsigned char* Vb = dyn_smem + L_VT + vcur * 16384 + r * 128;
            if (active && kt <= lastw) {
                const float msk1 = (samp && kt == 64) ? 1e30f : 0.f;
#pragma unroll 1
                for (int sub = 0; sub < 2; ++sub) {
                    const float msk = sub ? msk1 : 0.f;
                    ATT_QS(sub, msk);
                    ATT_PV2(Vb, sub, PA, PB);
                    __builtin_amdgcn_sched_barrier(0);
                }
                ATT_CHECK();
            }
            vcur = vnext;
            asm volatile("s_waitcnt vmcnt(0)" ::: "memory");
            __builtin_amdgcn_s_barrier();
        }
    } else {
#pragma unroll 1
        for (int kt = 0; kt < ntiles; ++kt) {
            const int vnext = vcur == 2 ? 0 : vcur + 1;
            if (kt + 1 < ntiles) stage_tile(kt + 1, (kt + 1) & 1, vnext);
            const unsigned char* Kb = dyn_smem + L_KT + (kt & 1) * 16384 + r * 256;
            const unsigned char* Vb = dyn_smem + L_VT + vcur * 16384 + r * 128;
            const unsigned char* Vp = dyn_smem + L_VT + vprev * 16384 + r * 128;
            if (kt <= lastw + 1) {
                if (kt > 0) { ATT_PV2(Vp, 1, PA, PB); __builtin_amdgcn_sched_barrier(0); }
                if (kt <= lastw) {
                    ATT_CHECK();
                    ATT_QS(0, 0.f);
                    ATT_PV2(Vb, 0, PA, PB);
                    __builtin_amdgcn_sched_barrier(0);
                    ATT_QS(1, 0.f);
                }
            }
            vprev = vcur; vcur = vnext;
            asm volatile("s_waitcnt vmcnt(0)" ::: "memory");
            __builtin_amdgcn_s_barrier();
        }
        if (lastw == ntiles - 1) {
            const unsigned char* Vp = dyn_smem + L_VT + vprev * 16384 + r * 128;
            ATT_PV2(Vp, 1, PA, PB);
        }
    }
    if (active) {
        const int lnf = __builtin_amdgcn_mbcnt_hi(~0u, __builtin_amdgcn_mbcnt_lo(~0u, 0u)), r = lnf & 31, hh = lnf >> 5;
        float* ALX = (float*)(dyn_smem + L_ALX) + w * 64;
        { const auto s1_ = __builtin_amdgcn_permlane32_swap(__float_as_uint(l1), __float_as_uint(l1), false, false); l1 = __uint_as_float(s1_[0]) + __uint_as_float(s1_[1]);
          const auto s2_ = __builtin_amdgcn_permlane32_swap(__float_as_uint(l2), __float_as_uint(l2), false, false); l2 = __uint_as_float(s2_[0]) + __uint_as_float(s2_[1]); }
        if (hh == 0) { ALX[r] = __builtin_amdgcn_rcpf(l1); ALX[32 + r] = *lamp * __builtin_amdgcn_rcpf(l2); }
        asm volatile("s_waitcnt lgkmcnt(0)" ::: "memory");
        float ss[16], a1[16], a2[16];
#pragma unroll
        for (int g = 0; g < 4; ++g) {
            const f32x4 x1 = *(const f32x4*)(ALX + 8 * g + 4 * hh), x2 = *(const f32x4*)(ALX + 32 + 8 * g + 4 * hh);
#pragma unroll
            for (int j = 0; j < 4; ++j) { a1[4 * g + j] = x1[j]; a2[4 * g + j] = x2[j]; ss[4 * g + j] = 0.f; }
        }
#pragma unroll
        for (int t = 0; t < 4; ++t) {
            __builtin_amdgcn_sched_barrier(0);
#pragma unroll
            for (int i = 0; i < 16; ++i) { const float o = O1[t][i] * a1[i] - O2[t][i] * a2[i]; O1[t][i] = o; ss[i] += o * o; }
        }
        __builtin_amdgcn_sched_barrier(0);
#pragma unroll
        for (int i = 0; i < 16; ++i) {
#pragma unroll
            for (int of = 1; of < 32; of <<= 1) ss[i] += __shfl_xor(ss[i], of);
            ss[i] = __builtin_amdgcn_rsqf(ss[i] * (1.f / 128.f) + 1e-6f) * (1.f - LAM_INIT);
        }
        int zo = 0; asm volatile("" : "+v"(zo));
        bf16_t* obase = (bf16_t*)(ws + WS_R2) + (qbase + 32 * w) * 1024 + 512 + h * 128;
        const unsigned ooff = (unsigned)((4 * hh + zo) * 1024 + r);
        const float* sw = p.subln_w + r + zo;
#pragma unroll
        for (int t = 0; t < 4; ++t) {
            const float wv = sw[32 * t];
#pragma unroll
            for (int i = 0; i < 16; ++i) obase[ooff + ((i & 3) + 8 * (i >> 2)) * 1024 + 32 * t] = f2bf(O1[t][i] * ss[i] * wv);
        }
    }
}

DI void mixer_phase(const Params& p) {
    const int bid = blockIdx.x;
#ifndef NO_SCAN
    if (bid >= 16 && bid < 48) {
        float cw[3][4];
        gdn_conv_weights(p, (bid - 16) & 3, cw);
        gdn_prep_item(p, 2048 + bid - 16, cw);
        asm volatile("s_waitcnt vmcnt(0)" ::: "memory");
        __builtin_amdgcn_fence(__ATOMIC_ACQUIRE, "agent");
        asm volatile("s_waitcnt vmcnt(0)" ::: "memory");
        __syncthreads();
    }
    if (bid < 48) { const bool sm = bid >= 16; const int j = sm ? bid - 16 : bid;
#pragma unroll 1
        for (int rep = 0; rep < SREP; ++rep) gdn_scan(p, sm, j >> 2, j & 3); }
#endif
    unsigned* ctl = (unsigned*)(p.ws + WS_CTL);
    int* sidx = (int*)(dyn_smem + L_IDX);
    for (;;) {
        __syncthreads();
        if (threadIdx.x == 0) *sidx = (int)atomicAdd(ctl, 1u);
        __syncthreads();
        const int idx0 = __builtin_amdgcn_readfirstlane(*sidx);
        if (idx0 >= (32 + 512) * AREP) break;
        const int idx = idx0 % (32 + 512);
#ifndef NO_ATTN
        attn_item(p, idx, (const float*)ctl + 1);
#endif
    }
}


#define XB_TMO      128
#define XB_XCNT(j)  (256  + 64 * (j))
#define XB_XSUB(j)  (1280 + 64 * (j))
#define XB_XGEN(j)  (2304 + 64 * (j))
#define XB_TOP      3328
#define XB_TOPGEN   3392
#define XCD_BAR_WORDS 3456
#define XB_SPIN_CAP (1u << 20)
#define LAS __attribute__((address_space(3)))
DI unsigned xb_ld(unsigned* p) { return __hip_atomic_load(p, __ATOMIC_RELAXED, __HIP_MEMORY_SCOPE_AGENT); }
DI unsigned xb_add(unsigned* p, unsigned v) { return __hip_atomic_fetch_add(p, v, __ATOMIC_RELAXED, __HIP_MEMORY_SCOPE_AGENT); }
DI unsigned xb_xcc_id() { return (unsigned)__builtin_amdgcn_s_getreg((3 << 11) | 20) & 0xFu; }
#define XB_SPIN(cond, bar) do { unsigned _sp = 0; while (cond) { __builtin_amdgcn_s_sleep(1); \
    if ((++_sp & 255u) == 0u) { if (xb_ld(&(bar)[XB_TMO])) break; if (_sp > XB_SPIN_CAP) { atomicAdd(&(bar)[XB_TMO], 1u); break; } } } } while (0)
struct XcdBarrier { unsigned* bar; unsigned x; volatile LAS unsigned* st; };
DI XcdBarrier xcd_barrier_post(unsigned* bar, volatile LAS unsigned* st) {
    XcdBarrier b; b.bar = bar; b.x = xb_xcc_id(); b.st = st;
    if (threadIdx.x == 0) (void)xb_add(&bar[XB_XCNT(b.x)], 1u);
    return b;
}
DI void xcd_barrier_complete(unsigned* bar, unsigned x, unsigned& nloc, unsigned& nx) {
    const unsigned G = gridDim.x * gridDim.y * gridDim.z;
    unsigned sum, cnt, mine, sp = 0u;
    for (;;) {
        sum = 0u; cnt = 0u; mine = 0u;
#pragma unroll
        for (unsigned j = 0; j < 16; ++j) { const unsigned c = xb_ld(&bar[XB_XCNT(j)]); sum += c; cnt += (c > 0u) ? 1u : 0u; mine = (j == x) ? c : mine; }
        if (sum == G) break;
        __builtin_amdgcn_s_sleep(1);
        if ((++sp & 255u) == 0u) { if (xb_ld(&bar[XB_TMO])) break; if (sp > XB_SPIN_CAP) { atomicAdd(&bar[XB_TMO], 1u); break; } }
    }
    nloc = mine > 0u ? mine : 1u; nx = cnt > 0u ? cnt : 1u;
}
DI void xcd_barrier(const XcdBarrier& b) {
    asm volatile("s_waitcnt vmcnt(0)" ::: "memory");
    __syncthreads();
    if (threadIdx.x == 0) {
        unsigned* bar = b.bar;
        __builtin_amdgcn_s_waitcnt(0);
        unsigned nloc = b.st[0], nx = b.st[1];
        if (nloc == 0u) { xcd_barrier_complete(bar, b.x, nloc, nx); b.st[0] = nloc; b.st[1] = nx; }
        const unsigned old = xb_add(&bar[XB_XSUB(b.x)], 1u);
        const unsigned gen = old / nloc;
        if (old + 1u == (gen + 1u) * nloc) {
            __builtin_amdgcn_fence(__ATOMIC_RELEASE, "agent");
            asm volatile("s_waitcnt vmcnt(0)" ::: "memory");
            const unsigned og = xb_add(&bar[XB_TOP], 1u);
            const unsigned tg = og / nx;
            if (og + 1u == (tg + 1u) * nx) xb_add(&bar[XB_TOPGEN], 1u);
            else XB_SPIN(xb_ld(&bar[XB_TOPGEN]) == tg, bar);
            __builtin_amdgcn_fence(__ATOMIC_ACQUIRE, "agent");
            xb_add(&bar[XB_XGEN(b.x)], 1u);
            asm volatile("s_waitcnt vmcnt(0)" ::: "memory");
        } else {
            XB_SPIN(xb_ld(&bar[XB_XGEN(b.x)]) == gen, bar);
            __builtin_amdgcn_fence(__ATOMIC_ACQUIRE, "agent");
            asm volatile("s_waitcnt vmcnt(0)" ::: "memory");
        }
    }
    __syncthreads();
}

__global__ void __launch_bounds__(512, 2) fwd_kernel(Params p) {
    cg::grid_group grid = cg::this_grid();
    volatile LAS unsigned* xst = (volatile LAS unsigned*)(dyn_smem + LDS_BYTES - 16);
    if (threadIdx.x == 0) { xst[0] = 0u; xst[1] = 0u; }
    __syncthreads();
    const XcdBarrier xb = xcd_barrier_post((unsigned*)(p.ws + WS_BAR), xst);
    if (p.phase_lo > 1000) grid.sync();
    const bool all = p.phase_hi - p.phase_lo > 1;
#define PHASE(i, body) if (p.phase_lo <= (i) && (i) < p.phase_hi) { body; if (all && (i) + 1 < p.phase_hi) xcd_barrier(xb); }
    PHASE(0, phase_prep(p))
    PHASE(1, gemm_phase<1>(p))
    PHASE(2, gdn_prep_phase(p))
    PHASE(3, mixer_phase(p))
    PHASE(4, gemm_phase<2>(p))
    PHASE(5, ln_phase<0>(p))
    PHASE(6, gemm_phase<3>(p))
    PHASE(7, fixup_phase(p))
    PHASE(8, gemm_phase<4>(p))
    PHASE(9, ln_phase<1>(p))
}

extern "C" void kernel_launch(void* const* d_in, const int* in_sizes, int n_in, void* d_out, int out_size, void* d_ws, size_t ws_size, hipStream_t stream) {
    static int grid = 0;
    if (grid == 0) {
        if (n_in != 23 || (size_t)out_size != O_END || ws_size < WS_END2) { fprintf(stderr, "kernel_launch: unexpected sizes n_in %d out %d ws %zu (need %zu)\n", n_in, out_size, ws_size, (size_t)WS_END2); grid = -1; return; }
        int dev = 0, cus = 0, per_cu = 0;
        hipGetDevice(&dev);
        hipDeviceGetAttribute(&cus, hipDeviceAttributeMultiprocessorCount, dev);
        if (hipFuncSetAttribute((const void*)fwd_kernel, hipFuncAttributeMaxDynamicSharedMemorySize, LDS_BYTES) != hipSuccess) { fprintf(stderr, "kernel_launch: hipFuncSetAttribute failed\n"); grid = -1; return; }
        hipOccupancyMaxActiveBlocksPerMultiprocessor(&per_cu, (const void*)fwd_kernel, 512, LDS_BYTES);
        if (per_cu < 1) { fprintf(stderr, "kernel_launch: occupancy query says %d\n", per_cu); per_cu = 1; }
        (void)hipGetLastError();
        grid = cus * 1;
    }
    if (grid < 0) return;
    Params p{};
    const float** f = (const float**)&p;
    for (int i = 0; i < 23; ++i) f[i] = (const float*)d_in[i];
    p.out = (float*)d_out; p.ws = (unsigned char*)d_ws; p.phase_lo = 0; p.phase_hi = 10;
    if (hipMemsetAsync((unsigned char*)d_ws + WS_BAR, 0, 16384, stream) != hipSuccess) { fprintf(stderr, "kernel_launch: memset failed\n"); return; }
    void* args[] = {&p};
    hipError_t e = hipLaunchCooperativeKernel((const void*)fwd_kernel, dim3(grid), dim3(512), args, LDS_BYTES, stream);
    if (e != hipSuccess) fprintf(stderr, "cooperative launch failed: %s (grid %d)\n", hipGetErrorString(e), grid);
}
```

```cpp
#include <hip/hip_runtime.h>
#include <hip/hip_cooperative_groups.h>
#include <cstdio>
namespace cg = cooperative_groups;
#ifndef GREP_WHICH
#define GREP_WHICH 0
#endif
#ifndef AREP
#define AREP 1
#endif
#ifndef SREP
#define SREP 1
#endif

typedef unsigned short bf16_t;
typedef short bf16x8 __attribute__((ext_vector_type(8)));
typedef short s16x4 __attribute__((ext_vector_type(4)));
typedef float f32x4 __attribute__((ext_vector_type(4)));
typedef float f32x16 __attribute__((ext_vector_type(16)));
typedef unsigned u32x4 __attribute__((ext_vector_type(4)));
typedef unsigned u32x2 __attribute__((ext_vector_type(2)));
#define DI __device__ __forceinline__

constexpr int D = 1024, TP = 8192, BP = 4, MP = BP * TP, BS = 8, TS = 32, MS = BS * TS, M = MP + MS, PAST = 4096;
constexpr int DIN = 3592, NH1 = 3584, DFF = 2816, NUP = 2 * DFF;
constexpr int TKS = 4160;
constexpr int NITEM = BP * 128 * 4 + BS * 4;
constexpr int ITEM_B = 90112;
constexpr int LDS_BYTES = 160 * 1024;
constexpr float ALPHA = 1.189207115002721f;
constexpr float LAM_INIT = 0.2f;

constexpr size_t O_Y = 0, O_KP = 33816576, O_VP = 50593792, O_GP = 67371008, O_CQP = 67633152, O_CFP = 67651584,
                 O_KS = 67696640, O_VS = 67827712, O_GS = 67958784, O_CQS = 68483072, O_CFS = 68519936, O_END = 68610048;

constexpr size_t al256(size_t x) { return (x + 255) & ~(size_t)255; }
constexpr size_t WS_CTL = 0;
constexpr size_t WS_ROPE = 4096;
constexpr size_t WS_AB = WS_ROPE + (size_t)8192 * 32 * 8;
constexpr size_t WS_DL = WS_AB + (size_t)M * 8 * 4;
constexpr size_t WS_WIN = al256(WS_DL + NITEM * 4);
constexpr size_t WS_WO = WS_WIN + (size_t)NH1 * D * 2;
constexpr size_t WS_WUP = WS_WO + (size_t)D * D * 2;
constexpr size_t WS_WDN = WS_WUP + (size_t)NUP * D * 2;
constexpr size_t WS_R1 = al256(WS_WDN + (size_t)D * DFF * 2);
constexpr size_t R1_SIZE = (size_t)NITEM * ITEM_B;
constexpr size_t WS_R2 = al256(WS_R1 + R1_SIZE);
constexpr size_t WS_R3 = al256(WS_R2 + (size_t)M * 1536 * 2);
constexpr size_t WS_R4 = WS_R3 + (size_t)M * 512 * 2;
constexpr size_t WS_R5 = al256(WS_R4 + (size_t)M * 512 * 2);
constexpr size_t KROWS = (size_t)MP + (size_t)BS * TKS;
constexpr size_t WS_R6 = al256(WS_R5 + KROWS * 512 * 2);
constexpr size_t VT_S_OFF = (size_t)BP * 4 * 128 * TP;
constexpr size_t WS_END = al256(WS_R6 + (VT_S_OFF + (size_t)BS * 4 * 128 * TKS) * 2);
constexpr size_t WS_CS1 = WS_END;
constexpr size_t WS_CS2 = WS_CS1 + (size_t)MS * NH1 * 4;
constexpr size_t WS_CS3 = WS_CS2 + (size_t)MS * D * 4;
constexpr size_t WS_CS4 = WS_CS3 + (size_t)MS * NUP * 4;
constexpr size_t WS_BAR = WS_CS4 + (size_t)MS * D * 4;
constexpr size_t WS_END2 = WS_BAR + 16384;
static_assert((size_t)M * DFF * 2 <= R1_SIZE, "GT must fit R1");
static_assert(WS_END2 <= (size_t)536870912, "workspace too large");

struct Params {
    const float *x_p, *x_s, *cache_k, *cache_v, *state_gdn, *state_cq, *state_cf;
    const float *w_in, *gdn_conv_w, *a_log, *dt_bias, *gdn_norm_w, *diff_lambda, *subln_w, *w_o, *ln1_g, *ln1_b, *w_up,
        *ffn_conv_w, *ffn_conv_b, *w_down, *ln2_g, *ln2_b;
    float* out; unsigned char* ws;
    int phase_lo, phase_hi;
};

extern __shared__ __attribute__((aligned(16))) unsigned char dyn_smem[];

typedef __bf16 bf16x2_t __attribute__((ext_vector_type(2)));
typedef float f32x2 __attribute__((ext_vector_type(2)));
DI unsigned pk2(float lo, float hi) { f32x2 v = {lo, hi}; bf16x2_t b = __builtin_convertvector(v, bf16x2_t); return __builtin_bit_cast(unsigned, b); }
DI bf16_t f2bf(float x) { return (bf16_t)(pk2(x, 0.f) & 0xffffu); }
DI float bf2f(bf16_t b) { return __uint_as_float(((unsigned)b) << 16); }
DI float bflo(unsigned u) { return __uint_as_float(u << 16); }
DI float bfhi(unsigned u) { return __uint_as_float(u & 0xffff0000u); }
DI float silu(float x) { return x * __builtin_amdgcn_rcpf(1.f + __expf(-x)); }
DI void lds_barrier() { asm volatile("s_waitcnt lgkmcnt(0)\n\ts_barrier" ::: "memory"); }
DI int opaque_tid() { int t = threadIdx.x; asm volatile("" : "+v"(t)); return t; }
template <int CTRL> DI float dppf(float v) { return __int_as_float(__builtin_amdgcn_mov_dpp(__float_as_int(v), CTRL, 0xF, 0xF, true)); }
DI float xsum8(float v) { v += dppf<0xB1>(v); v += dppf<0x4E>(v); v += dppf<0x141>(v); return v; }
DI float xsum16(float v) { v = xsum8(v); v += dppf<0x140>(v); return v; }
DI float xsum32(float v) { v = xsum16(v); const auto r = __builtin_amdgcn_permlane16_swap(__float_as_uint(v), __float_as_uint(v), false, false); return __uint_as_float(r[0]) + __uint_as_float(r[1]); }
DI float wave_sum(float v) { v = xsum32(v); const auto r = __builtin_amdgcn_permlane32_swap(__float_as_uint(v), __float_as_uint(v), false, false); return __uint_as_float(r[0]) + __uint_as_float(r[1]); }
DI const float* xrow_ptr(const Params& p, int row) { return row < MP ? p.x_p + (size_t)row * D : p.x_s + (size_t)(row - MP) * D; }

template <int MODE> DI int srccol(int n) {
    if (MODE == 1) {
        if (n < 2048) return n;
        return n + 8;
    }
    if (MODE == 2) { const int pn = n >> 8, j = n & 255; return j < 128 ? 128 * pn + j : DFF + 128 * pn + (j - 128); }
    return n;
}
struct TrItem { const float* W; bf16_t* WT; int K, N, k0, n0, mode; };
DI TrItem tr_decode(const Params& p, int it) {
    constexpr int I_IN = 16 * 56, I_O = 16 * 16, I_UP = 16 * 88;
    unsigned char* ws = p.ws; TrItem t; int r = it;
    if (r < I_IN) { t.W = p.w_in; t.WT = (bf16_t*)(ws + WS_WIN); t.K = D; t.N = DIN; t.k0 = (r / 56) * 64; t.n0 = (r % 56) * 64; t.mode = 1; return t; } r -= I_IN;
    if (r < I_O) { t.W = p.w_o; t.WT = (bf16_t*)(ws + WS_WO); t.K = D; t.N = D; t.k0 = (r / 16) * 64; t.n0 = (r % 16) * 64; t.mode = 0; return t; } r -= I_O;
    if (r < I_UP) { t.W = p.w_up; t.WT = (bf16_t*)(ws + WS_WUP); t.K = D; t.N = NUP; t.k0 = (r / 88) * 64; t.n0 = (r % 88) * 64; t.mode = 2; return t; } r -= I_UP;
    t.W = p.w_down; t.WT = (bf16_t*)(ws + WS_WDN); t.K = DFF; t.N = D; t.k0 = (r / 16) * 64; t.n0 = (r % 16) * 64; t.mode = 0; return t;
}
DI void tr_load(const TrItem& t, float (&v)[8]) {
    const int tid = threadIdx.x, n = t.n0 + (tid & 63);
    const int sc = t.mode == 1 ? (n < 2048 ? n : n + 8) : (t.mode == 2 ? srccol<2>(n) : n);
#pragma unroll
    for (int i = 0; i < 8; ++i) v[i] = __builtin_nontemporal_load(t.W + (size_t)(t.k0 + (tid >> 6) + 8 * i) * t.N + sc);
}
DI void transpose_range(const Params& p, const int lo, const int hi) {
    const int tid = opaque_tid(), nb = gridDim.x, bid = blockIdx.x;
    float* lds = (float*)dyn_smem;
    float v[8];
    lds_barrier();
    TrItem cur = tr_decode(p, lo + bid < hi ? lo + bid : lo);
    if (lo + bid < hi) tr_load(cur, v);
    for (int it = lo + bid; it < hi; it += nb) {
        float nv[8]; TrItem nx = cur;
        if (it + nb < hi) { nx = tr_decode(p, it + nb); tr_load(nx, nv); }
#pragma unroll
        for (int i = 0; i < 8; ++i) lds[((tid >> 6) + 8 * i) * 65 + (tid & 63)] = v[i];
        lds_barrier();
#pragma unroll
        for (int i = 0; i < 8; ++i) { const int nn = (tid >> 6) + 8 * i, kk = tid & 63; cur.WT[(size_t)(cur.n0 + nn) * cur.K + cur.k0 + kk] = f2bf(lds[kk * 65 + nn]); }
        lds_barrier();
#pragma unroll
        for (int i = 0; i < 8; ++i) v[i] = nv[i];
        cur = nx;
    }
}
DI void phase_prep(const Params& p) {
    const int tid = threadIdx.x, lane = tid & 63, wave = tid >> 6, nb = gridDim.x, bid = blockIdx.x;
    unsigned char* ws = p.ws;
    if (bid == 0 && tid < 64) {
        unsigned* ctl = (unsigned*)(ws + WS_CTL);
        float a = p.diff_lambda[lane] * p.diff_lambda[64 + lane], b = p.diff_lambda[128 + lane] * p.diff_lambda[192 + lane];
        a = wave_sum(a); b = wave_sum(b);
        if (lane == 0) { ctl[0] = 0u; ((float*)ctl)[1] = expf(a) - expf(b) + LAM_INIT; }
    }
    transpose_range(p, 0, 16 * 56);
    {
        float2* rope = (float2*)(ws + WS_ROPE);
        for (int idx = bid * 512 + tid; idx < 8192 * 32; idx += nb * 512) {
            const int pos = idx >> 5, d = idx & 31;
            const double inv = exp(-(double)d * (9.210340371976184 / 32.0));
            double a = (double)pos * inv;
            a -= 6.283185307179586 * rint(a * 0.15915494309189535);
            const float af = (float)a;
            rope[idx] = make_float2(__cosf(af), __sinf(af));
        }
    }
    {
        float* w8 = (float*)dyn_smem;
        __syncthreads();
        for (int i = tid; i < 1024 * 8; i += 512) w8[i] = p.w_in[(size_t)(i >> 3) * DIN + 2048 + (i & 7)];
        __syncthreads();
        bf16_t* XB = (bf16_t*)(ws + WS_R1);
        float* AB = (float*)(ws + WS_AB);
        f32x4 cv[4];
        {
            const int row = bid * 8 + wave;
            if (row < M) { const float* xr = xrow_ptr(p, row);
#pragma unroll
                for (int j = 0; j < 4; ++j) cv[j] = __builtin_nontemporal_load((const f32x4*)(xr + lane * 4 + 256 * j)); }
        }
        for (int row = bid * 8 + wave; row < M; row += nb * 8) {
            f32x4 nvx[4];
            if (row + nb * 8 < M) { const float* xn = xrow_ptr(p, row + nb * 8);
#pragma unroll
                for (int j = 0; j < 4; ++j) nvx[j] = __builtin_nontemporal_load((const f32x4*)(xn + lane * 4 + 256 * j)); }
            float acc[8];
#pragma unroll
            for (int c = 0; c < 8; ++c) acc[c] = 0.f;
#pragma unroll
            for (int j = 0; j < 4; ++j) {
                const int k0 = lane * 4 + 256 * j;
                const f32x4 v = cv[j];
                u32x2 o; o.x = pk2(v.x, v.y); o.y = pk2(v.z, v.w);
                *(u32x2*)(XB + (size_t)row * D + k0) = o;
#pragma unroll
                for (int e = 0; e < 4; ++e) {
                    const f32x4 wa = *(const f32x4*)(w8 + (k0 + e) * 8), wb = *(const f32x4*)(w8 + (k0 + e) * 8 + 4);
                    const float xv = v[e];
                    acc[0] += xv * wa.x; acc[1] += xv * wa.y; acc[2] += xv * wa.z; acc[3] += xv * wa.w;
                    acc[4] += xv * wb.x; acc[5] += xv * wb.y; acc[6] += xv * wb.z; acc[7] += xv * wb.w;
                }
            }
#pragma unroll
            for (int c = 0; c < 8; ++c) acc[c] = wave_sum(acc[c]);
            if (lane == 0) { *(f32x4*)(AB + (size_t)row * 8) = (f32x4){acc[0], acc[1], acc[2], acc[3]}; *(f32x4*)(AB + (size_t)row * 8 + 4) = (f32x4){acc[4], acc[5], acc[6], acc[7]}; }
#pragma unroll
            for (int j = 0; j < 4; ++j) cv[j] = nvx[j];
        }
        __syncthreads();
    }
}

DI void prep_stream(const Params& p) {
    const int tid = opaque_tid(), nb = gridDim.x, bid = blockIdx.x;
    unsigned char* ws = p.ws;
    transpose_range(p, 16 * 56, 16 * 56 + 16 * 16 + 16 * 88 + 44 * 16);
    lds_barrier();
    {
        bf16_t* KALL = (bf16_t*)(ws + WS_R5);
        const int nchunk = BS * TKS * 64;
        for (int c0 = bid * 512 + tid; c0 < nchunk; c0 += nb * 512 * 4) {
            f32x4 v0[4], v1[4]; int st[4]; size_t dsto[4];
#pragma unroll
            for (int u = 0; u < 4; ++u) {
                const int c = c0 + u * nb * 512;
                st[u] = 0;
                if (c < nchunk) {
                    const int col8 = c & 63, r = c >> 6, b = r / TKS, pp = r % TKS;
                    dsto[u] = ((size_t)MP + (size_t)b * TKS + pp) * 512 + col8 * 8;
                    if (pp < PAST) { const float* sp = p.cache_k + ((size_t)(b * PAST + pp) * 512 + col8 * 8); v0[u] = __builtin_nontemporal_load((const f32x4*)sp); v1[u] = __builtin_nontemporal_load((const f32x4*)(sp + 4)); st[u] = 1; }
                    else if (pp >= PAST + TS) st[u] = 2;
                }
            }
#pragma unroll
            for (int u = 0; u < 4; ++u) {
                if (st[u] == 1) { u32x4 o; o.x = pk2(v0[u].x, v0[u].y); o.y = pk2(v0[u].z, v0[u].w); o.z = pk2(v1[u].x, v1[u].y); o.w = pk2(v1[u].z, v1[u].w); *(u32x4*)(KALL + dsto[u]) = o; }
                else if (st[u] == 2) *(u32x4*)(KALL + dsto[u]) = (u32x4){0u, 0u, 0u, 0u};
            }
        }
    }
    {
        bf16_t* VTS = (bf16_t*)(ws + WS_R6) + VT_S_OFF;
        bf16_t* t = (bf16_t*)dyn_smem;
        f32x4 cvv[4];
        auto ldv = [&](int it, f32x4 (&v)[4]) {
            const int blk = it % 65, bh = it / 65, b = bh >> 2, h = bh & 3;
            if (blk < 64) {
#pragma unroll
                for (int i = 0; i < 4; ++i) { const int id = tid + 512 * i, key = id >> 5, c4 = id & 31;
                    v[i] = __builtin_nontemporal_load((const f32x4*)(p.cache_v + ((size_t)(b * PAST + blk * 64 + key) * 512 + h * 128 + c4 * 4))); }
            }
        };
        if (bid < BS * 4 * 65) ldv(bid, cvv);
        for (int it = bid; it < BS * 4 * 65; it += nb) {
            const int blk = it % 65, bh = it / 65;
            f32x4 nvv[4];
            if (it + nb < BS * 4 * 65) ldv(it + nb, nvv);
            if (blk < 64) {
                lds_barrier();
#pragma unroll
                for (int i = 0; i < 4; ++i) {
                    const int id = tid + 512 * i, key = id >> 5, c4 = id & 31;
                    const f32x4 v = cvv[i];
                    bf16_t* d = t + key * 130 + c4 * 4;
                    *(unsigned*)d = pk2(v.x, v.y); *(unsigned*)(d + 2) = pk2(v.z, v.w);
                }
                lds_barrier();
                const int dv = tid >> 2, part = tid & 3;
                unsigned o[8];
#pragma unroll
                for (int i = 0; i < 8; ++i) { const int k0 = part * 16 + 2 * i; o[i] = (unsigned)t[k0 * 130 + dv] | ((unsigned)t[(k0 + 1) * 130 + dv] << 16); }
                bf16_t* dst = VTS + ((size_t)(bh * 128 + dv) * TKS + blk * 64 + part * 16);
                *(u32x4*)dst = (u32x4){o[0], o[1], o[2], o[3]}; *(u32x4*)(dst + 8) = (u32x4){o[4], o[5], o[6], o[7]};
            } else {
                if (tid < 128) { bf16_t* dst = VTS + ((size_t)(bh * 128 + tid) * TKS + PAST + TS);
#pragma unroll
                    for (int i = 0; i < 4; ++i) *(u32x4*)(dst + 8 * i) = (u32x4){0u, 0u, 0u, 0u}; }
            }
#pragma unroll
            for (int i = 0; i < 4; ++i) cvv[i] = nvv[i];
        }
        lds_barrier();
    }
}

constexpr int BM = 256, BK = 64, HALF = 128, NXCD = 8, WGM = 8, HT = HALF * BK;
DI void stage_rc(int b, int& R, int& C) {
    const int st = b / 1024, sb = b % 1024, swz = sb ^ (((sb >> 9) & 1) << 5);
    R = (st >> 1) * 16 + swz / 64; C = (st & 1) * 32 + (swz % 64) / 2;
}
DI int lds_byte(int r, int c) {
    const int st = (r >> 4) * 2 + (c >> 5), rr = r & 15, cc = c & 31, ob = rr * 64 + cc * 2;
    return st * 1024 + (ob ^ (((ob >> 9) & 1) << 5));
}

#define SHM ((bf16_t*)dyn_smem)
#define SA(b, h) (SHM + ((b) * 2 + (h)) * HT)
#define SB(b, h) (SHM + (4 + (b) * 2 + (h)) * HT)
#define STAGE(P, BASE, br, kt) do { const bf16_t* _gb = (BASE) + ((long)(br) * K + (long)(kt) * BK); \
      __builtin_amdgcn_global_load_lds((const unsigned*)(_gb + so0), (unsigned*)((char*)(P) + wlds), 16, 0, 0); \
      __builtin_amdgcn_global_load_lds((const unsigned*)(_gb + 64 * K + so0), (unsigned*)((char*)(P) + wlds + 8192), 16, 0, 0); } while (0)
#define LDA(dst, b, h) for (int m = 0; m < 4; ++m) for (int k = 0; k < 2; ++k) \
    dst[m][k] = *reinterpret_cast<const bf16x8*>((char*)SA(b, h) + lds_byte(wr * 64 + m * 16 + fr, k * 32 + fq * 8))
#define LDB(dst, b, h) for (int n = 0; n < 2; ++n) for (int k = 0; k < 2; ++k) \
    dst[n][k] = *reinterpret_cast<const bf16x8*>((char*)SB(b, h) + lds_byte(wc * 32 + n * 16 + fr, k * 32 + fq * 8))
#define MMA(ai, bj, At, Bt_) do { __builtin_amdgcn_s_setprio(1); \
    for (int m = 0; m < 4; ++m) for (int n = 0; n < 2; ++n) for (int k = 0; k < 2; ++k) \
      acc[ai][bj][m][n] = __builtin_amdgcn_mfma_f32_16x16x32_bf16(Bt_[n][k], At[m][k], acc[ai][bj][m][n], 0, 0, 0); \
    __builtin_amdgcn_s_setprio(0); } while (0)
#define WAIT_V(n) asm volatile("s_waitcnt vmcnt(" #n ")" ::: "memory")
#define WAIT_L(n) asm volatile("s_waitcnt lgkmcnt(" #n ")" ::: "memory")
#define BAR __builtin_amdgcn_s_barrier()
#define SCHED __builtin_amdgcn_sched_barrier(0)

template <int K> DI void gemm_tile(const bf16_t* __restrict__ A, const bf16_t* __restrict__ Bt, const int brow, const int bcol, f32x4 (&acc)[2][2][4][2]) {
    const int wid = threadIdx.x >> 6, lane = threadIdx.x & 63, wr = wid >> 2, wc = wid & 3, fr = lane & 15, fq = lane >> 4;
    unsigned so0;
    { int _r, _c; stage_rc(threadIdx.x * 16, _r, _c); so0 = (unsigned)(_r * K + _c); }
    const int wlds = __builtin_amdgcn_readfirstlane((int)(threadIdx.x >> 6) << 10);
#pragma unroll
    for (int a = 0; a < 2; ++a)
#pragma unroll
        for (int b = 0; b < 2; ++b)
#pragma unroll
            for (int m = 0; m < 4; ++m)
#pragma unroll
                for (int n = 0; n < 2; ++n) acc[a][b][m][n] = (f32x4){0.f, 0.f, 0.f, 0.f};
    bf16x8 At[4][2], B0[2][2], B1[2][2];
    constexpr int nt = K / BK;
    STAGE(SB(0, 0), Bt, bcol, 0); STAGE(SA(0, 0), A, brow, 0);
    STAGE(SB(0, 1), Bt, bcol + HALF, 0); STAGE(SA(0, 1), A, brow + HALF, 0);
    if (wr == 1) BAR;
    WAIT_V(4); BAR;
    STAGE(SB(1, 0), Bt, bcol, 1); STAGE(SA(1, 0), A, brow, 1); STAGE(SB(1, 1), Bt, bcol + HALF, 1);
    WAIT_V(6); BAR;
    for (int t = 0; t < nt - 2; t += 2) {
        LDB(B0, 0, 0); SCHED; LDA(At, 0, 0); STAGE(SA(1, 1), A, brow + HALF, t + 1);
        WAIT_L(8); BAR; WAIT_L(0); MMA(0, 0, At, B0); BAR; SCHED;
        LDB(B1, 0, 1); STAGE(SB(0, 0), Bt, bcol, t + 2);
        BAR; WAIT_L(0); MMA(0, 1, At, B1); BAR;
        LDA(At, 0, 1); STAGE(SA(0, 0), A, brow, t + 2);
        BAR; WAIT_L(0); MMA(1, 0, At, B0); BAR; SCHED;
        STAGE(SB(0, 1), Bt, bcol + HALF, t + 2);
        WAIT_V(6); BAR; MMA(1, 1, At, B1); BAR;
        LDB(B0, 1, 0); SCHED; LDA(At, 1, 0); STAGE(SA(0, 1), A, brow + HALF, t + 2);
        WAIT_L(8); BAR; WAIT_L(0); MMA(0, 0, At, B0); BAR; SCHED;
        LDB(B1, 1, 1); STAGE(SB(1, 0), Bt, bcol, t + 3);
        BAR; WAIT_L(0); MMA(0, 1, At, B1); BAR;
        LDA(At, 1, 1); STAGE(SA(1, 0), A, brow, t + 3);
        BAR; WAIT_L(0); MMA(1, 0, At, B0); BAR; SCHED;
        STAGE(SB(1, 1), Bt, bcol + HALF, t + 3);
        WAIT_V(6); BAR; MMA(1, 1, At, B1); BAR;
    }
    { LDB(B0, 0, 0); LDA(At, 0, 0); STAGE(SA(1, 1), A, brow + HALF, nt - 1);
      BAR; WAIT_L(0); MMA(0, 0, At, B0); BAR;
      LDB(B1, 0, 1); BAR; WAIT_L(0); MMA(0, 1, At, B1); BAR;
      LDA(At, 0, 1); WAIT_V(4); BAR; WAIT_L(0); MMA(1, 0, At, B0); MMA(1, 1, At, B1); BAR; }
    { LDB(B0, 1, 0); LDA(At, 1, 0); WAIT_V(2); BAR; WAIT_L(0); MMA(0, 0, At, B0); BAR;
      LDB(B1, 1, 1); WAIT_V(0); BAR; WAIT_L(0); MMA(0, 1, At, B1); BAR;
      LDA(At, 1, 1); BAR; WAIT_L(0); MMA(1, 0, At, B0); MMA(1, 1, At, B1); BAR; }
    if (wr == 0) BAR;
}

DI void tile_of(int L, int nM, int nN, int& pm, int& pn) {
    const int nwg = nM * nN; int wgid = L;
    { const int q = nwg / NXCD, r = nwg % NXCD, xcd = wgid % NXCD, off = wgid / NXCD; wgid = (xcd < r ? xcd * (q + 1) : r * (q + 1) + (xcd - r) * q) + off; }
    const int nig = WGM * nN, gid = wgid / nig, fm = gid * WGM, gsz = min(nM - fm, WGM);
    pm = fm + ((wgid % nig) % gsz); pn = (wgid % nig) / gsz;
}

constexpr int CST = 260;
DI void stage_half(const f32x4 (&acc)[2][2][4][2], const int ai) {
    const int tid_ = opaque_tid(), wid = tid_ >> 6, lane = tid_ & 63, wr = wid >> 2, wc = wid & 3, fr = lane & 15, fq = lane >> 4;
    float* base = (float*)dyn_smem + (wr * 64 + fr) * CST + wc * 32 + 4 * fq;
#pragma unroll
    for (int m = 0; m < 4; ++m)
#pragma unroll
        for (int bj = 0; bj < 2; ++bj)
#pragma unroll
            for (int n = 0; n < 2; ++n) *(f32x4*)(base + (m * 16) * CST + bj * 128 + n * 16) = ai == 0 ? acc[0][bj][m][n] : acc[1][bj][m][n];
}
#define CT ((const float*)dyn_smem)

DI void epi_in_half(const Params& p, int pm, int pn, int ai) {
    unsigned char* ws = p.ws;
    const int tid = opaque_tid(), brow = pm * BM + ai * 128, bcol = pn * BM;
    const bool samp = pm == 128;
    if (pn < 8) {
        bf16_t* dst = pn < 6 ? (bf16_t*)(ws + WS_R2) : (bf16_t*)(ws + WS_R3);
        const int ld = pn < 6 ? 1536 : 512, c0 = pn < 6 ? bcol : bcol - 1536;
#pragma unroll 4
        for (int i = 0; i < 8; ++i) {
            const int id = tid + 512 * i, r = id >> 5, c8 = (id & 31) * 8, row = brow + r;
            const f32x4 v = *(const f32x4*)(CT + r * CST + c8), w = *(const f32x4*)(CT + r * CST + c8 + 4);
            *(u32x4*)(dst + (size_t)row * ld + c0 + c8) = (u32x4){pk2(v.x, v.y), pk2(v.z, v.w), pk2(w.x, w.y), pk2(w.z, w.w)};
            if (pn < 6) {
                const int t = row & (TP - 1);
                if (t >= TP - 3) { float* cd = p.out + O_CQP + (size_t)((row >> 13) * 3 + t - (TP - 3)) * 1536 + c0 + c8; *(f32x4*)cd = v; *(f32x4*)(cd + 4) = w; }
            }
        }
        return;
    }
    if (pn < 12) {
        const bool isq = pn < 10;
        const float* rope = (const float*)(ws + WS_ROPE);
        bf16_t* QB = (bf16_t*)(ws + WS_R4); bf16_t* KALL = (bf16_t*)(ws + WS_R5);
        const float qs = 0.125f * 1.4426950408889634f;
        f32x4 rt0[8], rt1[8];
#pragma unroll
        for (int i = 0; i < 8; ++i) {
            const int id = tid + 512 * i, r = id >> 5, q = id & 31, d4 = (q & 7) * 4, row = brow + r;
            const int pos = samp ? PAST + ((row - MP) & 31) : (row & (TP - 1));
            rt0[i] = *(const f32x4*)(rope + (size_t)(pos * 32 + d4) * 2); rt1[i] = *(const f32x4*)(rope + (size_t)(pos * 32 + d4) * 2 + 4);
        }
#pragma unroll
        for (int i = 0; i < 8; ++i) {
            const int id = tid + 512 * i, r = id >> 5, q = id & 31, hl = q >> 4, map = (q >> 3) & 1, d4 = (q & 7) * 4, row = brow + r;
            const int cl = hl * 128 + map * 64 + d4, col = ((pn & 1) * 2 + hl) * 128 + map * 64 + d4;
            const f32x4 x1 = *(const f32x4*)(CT + r * CST + cl), x2 = *(const f32x4*)(CT + r * CST + cl + 32);
            int pos; size_t krow; float* kout;
            if (!samp) { pos = row & (TP - 1); krow = row; kout = p.out + O_KP + (size_t)row * 512; }
            else { const int rr = row - MP; pos = PAST + (rr & 31); krow = (size_t)MP + (size_t)(rr >> 5) * TKS + pos; kout = p.out + O_KS + (size_t)rr * 512; }
            const f32x4 t0 = rt0[i], t1 = rt1[i];
            const f32x4 cs = (f32x4){t0.x, t0.z, t1.x, t1.z}, sn = (f32x4){t0.y, t0.w, t1.y, t1.w};
            const f32x4 y1 = x1 * cs - x2 * sn, y2 = x2 * cs + x1 * sn;
            if (isq) {
                u32x2 o1, o2; o1.x = pk2(y1.x * qs, y1.y * qs); o1.y = pk2(y1.z * qs, y1.w * qs); o2.x = pk2(y2.x * qs, y2.y * qs); o2.y = pk2(y2.z * qs, y2.w * qs);
                *(u32x2*)(QB + (size_t)row * 512 + col) = o1; *(u32x2*)(QB + (size_t)row * 512 + col + 32) = o2;
            } else {
                *(f32x4*)(kout + col) = y1; *(f32x4*)(kout + col + 32) = y2;
                u32x2 o1, o2; o1.x = pk2(y1.x, y1.y); o1.y = pk2(y1.z, y1.w); o2.x = pk2(y2.x, y2.y); o2.y = pk2(y2.z, y2.w);
                *(u32x2*)(KALL + krow * 512 + col) = o1; *(u32x2*)(KALL + krow * 512 + col + 32) = o2;
            }
        }
        return;
    }
    {
        bf16_t* VT = (bf16_t*)(ws + WS_R6);
#pragma unroll 4
        for (int i = 0; i < 16; ++i) {
            const int id = tid + 512 * i, r = id >> 6, c4 = (id & 63) * 4, row = brow + r, col = (pn & 1) * 256 + c4;
            const f32x4 v = *(const f32x4*)(CT + r * CST + c4);
            float* vout = samp ? p.out + O_VS + (size_t)(row - MP) * 512 + col : p.out + O_VP + (size_t)row * 512 + col;
            *(f32x4*)vout = v;
        }
#pragma unroll 1
        for (int i = 0; i < 2; ++i) {
            const int id = tid + 512 * i, rg = id >> 6, c4 = (id & 63) * 4, row0 = brow + rg * 8;
            f32x4 v[8];
#pragma unroll
            for (int e = 0; e < 8; ++e) v[e] = *(const f32x4*)(CT + (rg * 8 + e) * CST + c4);
#pragma unroll
            for (int e = 0; e < 4; ++e) {
                const int colg = (pn & 1) * 256 + c4 + e, head = colg >> 7, dv = colg & 127;
                u32x4 o; o.x = pk2(v[0][e], v[1][e]); o.y = pk2(v[2][e], v[3][e]); o.z = pk2(v[4][e], v[5][e]); o.w = pk2(v[6][e], v[7][e]);
                bf16_t* d;
                if (samp) { const int rr = row0 - MP; d = VT + VT_S_OFF + ((size_t)(((rr >> 5) * 4 + head) * 128 + dv) * TKS + PAST + (rr & 31)); }
                else d = VT + ((size_t)(((row0 >> 13) * 4 + head) * 128 + dv) * TP + (row0 & (TP - 1)));
                *(u32x4*)d = o;
            }
        }
    }
}

template <int WHICH> DI void epi_res_half(const Params& p, int pm, int pn, int ai) {
    const int tid = opaque_tid(), brow = pm * BM + ai * 128, bcol = pn * BM;
    bf16_t* dst = (bf16_t*)(p.ws + (WHICH == 0 ? WS_R1 : WS_R2));
    const bf16_t* X1B = (const bf16_t*)(p.ws + WS_R3);
    f32x4 xa[8], xb[8];
#pragma unroll
    for (int i = 0; i < 8; ++i) {
        const int id = tid + 512 * i, r = id >> 5, c8 = (id & 31) * 8, row = brow + r;
        if (WHICH == 0) { const float* xp = xrow_ptr(p, row) + bcol + c8; xa[i] = __builtin_nontemporal_load((const f32x4*)xp); xb[i] = __builtin_nontemporal_load((const f32x4*)(xp + 4)); }
        else { const u32x4 q = *(const u32x4*)(X1B + (size_t)row * D + bcol + c8); xa[i] = (f32x4){bflo(q.x), bfhi(q.x), bflo(q.y), bfhi(q.y)}; xb[i] = (f32x4){bflo(q.z), bfhi(q.z), bflo(q.w), bfhi(q.w)}; }
    }
#pragma unroll
    for (int i = 0; i < 8; ++i) {
        const int id = tid + 512 * i, r = id >> 5, c8 = (id & 31) * 8, row = brow + r;
        const f32x4 v = *(const f32x4*)(CT + r * CST + c8), w = *(const f32x4*)(CT + r * CST + c8 + 4);
        const f32x4 o = xa[i] * ALPHA + v, o2 = xb[i] * ALPHA + w;
        *(u32x4*)(dst + (size_t)row * D + bcol + c8) = (u32x4){pk2(o.x, o.y), pk2(o.z, o.w), pk2(o2.x, o2.y), pk2(o2.z, o2.w)};
    }
}

constexpr int UST = 264;
DI void epi_up(const Params& p, const f32x4 (&acc)[2][2][4][2], int pm, int pn) {
    unsigned char* ws = p.ws;
    bf16_t* U = (bf16_t*)dyn_smem;
    float* BND = (float*)(ws + WS_R5);
    const bool samp = pm == 128;
    const int brow = pm * BM, tid = opaque_tid();
    {
        const int wid = tid >> 6, lane = tid & 63, wr = wid >> 2, wc = wid & 3, fr = lane & 15, fq = lane >> 4;
        bf16_t* base = U + (wr * 64 + fr) * UST + wc * 32 + 4 * fq;
#pragma unroll
        for (int ai = 0; ai < 2; ++ai)
#pragma unroll
            for (int m = 0; m < 4; ++m)
#pragma unroll
                for (int bj = 0; bj < 2; ++bj)
#pragma unroll
                    for (int n = 0; n < 2; ++n) {
                        const f32x4 v = acc[ai][bj][m][n];
                        u32x2 q; q.x = pk2(v.x, v.y); q.y = pk2(v.z, v.w);
                        *(u32x2*)(base + (ai * 128 + m * 16) * UST + bj * 128 + n * 16) = q;
                    }
    }
    lds_barrier();
    {
        const int nb = samp ? 32 * 256 : 4 * 256;
        for (int id = tid; id < nb; id += 512) {
            const int cl = id & 255, q = id >> 8;
            const int oc = (cl >> 7) * DFF + 128 * pn + (cl & 127);
            int rr, bslot, u;
            if (!samp) { bslot = q; rr = q < 2 ? q : 252 + q; u = pm; }
            else { bslot = q & 3; rr = (q >> 2) * 32 + (bslot < 2 ? bslot : 28 + bslot); u = 128 + (q >> 2); }
            const float v = bf2f(U[rr * UST + cl]);
            BND[((size_t)u * 4 + bslot) * NUP + oc] = v;
            if (bslot >= 2) {
                if (samp) p.out[O_CFS + (size_t)((q >> 2) * 2 + bslot - 2) * NUP + oc] = v;
                else if ((pm & 31) == 31) p.out[O_CFP + (size_t)((pm >> 5) * 2 + bslot - 2) * NUP + oc] = v;
            }
        }
    }
    {
        const int cq = tid & 31, rs = tid >> 5, c = 4 * cq, cg_ = 128 * pn + c, cv_ = DFF + 128 * pn + c;
        const f32x4 wg0 = *(const f32x4*)(p.ffn_conv_w + cg_), wg1 = *(const f32x4*)(p.ffn_conv_w + NUP + cg_), wg2 = *(const f32x4*)(p.ffn_conv_w + 2 * NUP + cg_), bg = *(const f32x4*)(p.ffn_conv_b + cg_);
        const f32x4 wv0 = *(const f32x4*)(p.ffn_conv_w + cv_), wv1 = *(const f32x4*)(p.ffn_conv_w + NUP + cv_), wv2 = *(const f32x4*)(p.ffn_conv_w + 2 * NUP + cv_), bv = *(const f32x4*)(p.ffn_conv_b + cv_);
        bf16_t* GT = (bf16_t*)(ws + WS_R1);
        const int r0 = rs * 16;
        auto ld4 = [&](int rr, int cc) { const u32x2 q = *(const u32x2*)(U + rr * UST + cc); return (f32x4){bflo(q.x), bfhi(q.x), bflo(q.y), bfhi(q.y)}; };
        const f32x4 z4 = {0.f, 0.f, 0.f, 0.f};
        f32x4 g1 = z4, g2 = z4, v1 = z4, v2 = z4;
        if (r0 >= 2) { g1 = ld4(r0 - 2, c); g2 = ld4(r0 - 1, c); v1 = ld4(r0 - 2, 128 + c); v2 = ld4(r0 - 1, 128 + c); }
#pragma unroll 4
        for (int r = r0; r < r0 + 16; ++r) {
            const f32x4 g3 = ld4(r, c), v3 = ld4(r, 128 + c);
            if (r >= 2) {
                const f32x4 cg2 = wg0 * g1 + wg1 * g2 + wg2 * g3 + bg, cv2 = wv0 * v1 + wv1 * v2 + wv2 * v3 + bv;
                u32x2 q; q.x = pk2(silu(cg2.x) * cv2.x, silu(cg2.y) * cv2.y); q.y = pk2(silu(cg2.z) * cv2.z, silu(cg2.w) * cv2.w);
                *(u32x2*)(GT + (size_t)(brow + r) * DFF + 128 * pn + c) = q;
            }
            g1 = g2; g2 = g3; v1 = v2; v2 = v3;
        }
    }
}

template <int K> DI void skinny_gemm(const bf16_t* __restrict__ A, const bf16_t* __restrict__ Bt, float* __restrict__ C, const int N) {
    const int tid = opaque_tid(), lane = tid & 63, w = __builtin_amdgcn_readfirstlane(tid >> 6), fr = lane & 15, fq = lane >> 4;
    float* red = (float*)dyn_smem;
    constexpr int KW = K / 8, NKS = KW / 32;
    const int ntile = 8 * (N / 32);
    for (int t = blockIdx.x; t < ntile; t += gridDim.x) {
        const int rm = t & 7, cn = t >> 3;
        const bf16_t* ap = A + (size_t)(32 * rm + fr) * K + w * KW + 8 * fq;
        const bf16_t* bp = Bt + (size_t)(32 * cn + fr) * K + w * KW + 8 * fq;
        f32x4 acc[2][2];
#pragma unroll
        for (int i = 0; i < 2; ++i)
#pragma unroll
            for (int j = 0; j < 2; ++j) acc[i][j] = (f32x4){0.f, 0.f, 0.f, 0.f};
#pragma unroll 4
        for (int ks = 0; ks < NKS; ++ks) {
            const bf16x8 a0 = *(const bf16x8*)(ap + ks * 32), a1 = *(const bf16x8*)(ap + (size_t)16 * K + ks * 32);
            const bf16x8 b0 = *(const bf16x8*)(bp + ks * 32), b1 = *(const bf16x8*)(bp + (size_t)16 * K + ks * 32);
            acc[0][0] = __builtin_amdgcn_mfma_f32_16x16x32_bf16(a0, b0, acc[0][0], 0, 0, 0);
            acc[0][1] = __builtin_amdgcn_mfma_f32_16x16x32_bf16(a0, b1, acc[0][1], 0, 0, 0);
            acc[1][0] = __builtin_amdgcn_mfma_f32_16x16x32_bf16(a1, b0, acc[1][0], 0, 0, 0);
            acc[1][1] = __builtin_amdgcn_mfma_f32_16x16x32_bf16(a1, b1, acc[1][1], 0, 0, 0);
        }
        lds_barrier();
#pragma unroll
        for (int i = 0; i < 2; ++i)
#pragma unroll
            for (int j = 0; j < 2; ++j)
#pragma unroll
                for (int e = 0; e < 4; ++e) red[(w * 32 + 16 * i + 4 * fq + e) * 33 + 16 * j + fr] = acc[i][j][e];
        lds_barrier();
#pragma unroll
        for (int o2 = 0; o2 < 2; ++o2) {
            const int o = tid + 512 * o2, r = o >> 5, c = o & 31;
            float sum = 0.f;
#pragma unroll
            for (int ww = 0; ww < 8; ++ww) sum += red[(ww * 32 + r) * 33 + c];
            C[(size_t)(32 * rm + r) * N + 32 * cn + c] = sum;
        }
    }
    lds_barrier();
}

template <int WHICH> DI void gemm_phase(const Params& p) {
    unsigned char* ws = p.ws;
    const bf16_t* A; const bf16_t* Bt; int N; constexpr int K = WHICH == 4 ? DFF : D; float* CS;
    if (WHICH == 1) { A = (const bf16_t*)(ws + WS_R1); Bt = (const bf16_t*)(ws + WS_WIN); N = NH1; CS = (float*)(ws + WS_CS1); }
    else if (WHICH == 2) { A = (const bf16_t*)(ws + WS_R2); Bt = (const bf16_t*)(ws + WS_WO); N = D; CS = (float*)(ws + WS_CS2); }
    else if (WHICH == 3) { A = (const bf16_t*)(ws + WS_R3); Bt = (const bf16_t*)(ws + WS_WUP); N = NUP; CS = (float*)(ws + WS_CS3); }
    else { A = (const bf16_t*)(ws + WS_R1); Bt = (const bf16_t*)(ws + WS_WDN); N = D; CS = (float*)(ws + WS_CS4); }
    skinny_gemm<K>(A + (size_t)MP * K, Bt, CS, N);
    const int nM = MP / BM, nN = N / BM, ntile = nM * nN;
    for (int L0 = blockIdx.x; L0 < ntile * (WHICH == GREP_WHICH ? 2 : 1); L0 += gridDim.x) {
        const int L = L0 % ntile;
        int pm, pn; tile_of(L, nM, nN, pm, pn);
        f32x4 acc[2][2][4][2];
        gemm_tile<K>(A, Bt, pm * BM, pn * BM, acc);
        if (WHICH == 3) epi_up(p, acc, pm, pn);
        else {
#pragma unroll
            for (int ai = 0; ai < 2; ++ai) {
                stage_half(acc, ai);
                lds_barrier();
                if (WHICH == 1) epi_in_half(p, pm, pn, ai);
                else if (WHICH == 2) epi_res_half<0>(p, pm, pn, ai);
                else epi_res_half<1>(p, pm, pn, ai);
                lds_barrier();
            }
        }
        lds_barrier();
    }
}

template <int WHICH> DI void ln_phase(const Params& p) {
    const int lane = threadIdx.x & 63, wave = threadIdx.x >> 6;
    const float* g = WHICH == 0 ? p.ln1_g : p.ln2_g; const float* b = WHICH == 0 ? p.ln1_b : p.ln2_b;
    bf16_t* X1B = (bf16_t*)(p.ws + WS_R3);
    const bf16_t* PRE = (const bf16_t*)(p.ws + (WHICH == 0 ? WS_R1 : WS_R2));
    f32x4 gv[4], bv[4];
#pragma unroll
    for (int j = 0; j < 4; ++j) { gv[j] = *(const f32x4*)(g + lane * 4 + 256 * j); bv[j] = *(const f32x4*)(b + lane * 4 + 256 * j); }
    auto ld_row = [&](int row, f32x4 (&v)[4]) {
        if (row < MP) {
#pragma unroll
            for (int j = 0; j < 4; ++j) { const u32x2 q = __builtin_nontemporal_load((const u32x2*)(PRE + (size_t)row * D + lane * 4 + 256 * j)); v[j] = (f32x4){bflo(q.x), bfhi(q.x), bflo(q.y), bfhi(q.y)}; }
        } else {
            const float* cs = (const float*)(p.ws + (WHICH == 0 ? WS_CS2 : WS_CS4)) + (size_t)(row - MP) * D;
#pragma unroll
            for (int j = 0; j < 4; ++j) {
                f32x4 rs;
                if (WHICH == 0) rs = *(const f32x4*)(p.x_s + (size_t)(row - MP) * D + lane * 4 + 256 * j);
                else { const u32x2 q = *(const u32x2*)(X1B + (size_t)row * D + lane * 4 + 256 * j); rs = (f32x4){bflo(q.x), bfhi(q.x), bflo(q.y), bfhi(q.y)}; }
                v[j] = rs * ALPHA + *(const f32x4*)(cs + lane * 4 + 256 * j);
            }
        }
    };
    f32x4 v[4];
    if (blockIdx.x * 8 + wave < M) ld_row(blockIdx.x * 8 + wave, v);
    for (int row = blockIdx.x * 8 + wave; row < M; row += gridDim.x * 8) {
        f32x4 vn[4];
        const bool more = row + (int)gridDim.x * 8 < M;
        if (more) ld_row(row + gridDim.x * 8, vn);
        float s = 0.f;
#pragma unroll
        for (int j = 0; j < 4; ++j) s += (v[j].x + v[j].y) + (v[j].z + v[j].w);
        const float mean = wave_sum(s) * (1.f / D); float s2 = 0.f;
#pragma unroll
        for (int j = 0; j < 4; ++j) { v[j] = v[j] - mean; s2 += (v[j].x * v[j].x + v[j].y * v[j].y) + (v[j].z * v[j].z + v[j].w * v[j].w); }
        const float rstd = rsqrtf(wave_sum(s2) * (1.f / D) + 1e-5f);
#pragma unroll
        for (int j = 0; j < 4; ++j) {
            const f32x4 o = v[j] * rstd * gv[j] + bv[j];
            if (WHICH == 0) { u32x2 q; q.x = pk2(o.x, o.y); q.y = pk2(o.z, o.w); *(u32x2*)(X1B + (size_t)row * D + lane * 4 + 256 * j) = q; }
            else *(f32x4*)(p.out + O_Y + (size_t)row * D + lane * 4 + 256 * j) = o;
        }
        if (more) {
#pragma unroll
            for (int j = 0; j < 4; ++j) v[j] = vn[j];
        }
    }
}

DI void fixup_phase(const Params& p) {
    const float* BND = (const float*)(p.ws + WS_R5);
    bf16_t* GT = (bf16_t*)(p.ws + WS_R1);
    {
        const float* CS3 = (const float*)(p.ws + WS_CS3);
        for (int idx = blockIdx.x * 512 + threadIdx.x; idx < MS * DFF; idx += gridDim.x * 512) {
            const int c = idx % DFF, r = idx / DFF, b = r >> 5, t = r & 31, ng = (c >> 7) * 256 + (c & 127), nv = ng + 128;
            float g[3], v[3];
#pragma unroll
            for (int k = 0; k < 3; ++k) {
                const int tt = t - 2 + k;
                if (tt >= 0) { g[k] = CS3[(size_t)(b * 32 + tt) * NUP + ng]; v[k] = CS3[(size_t)(b * 32 + tt) * NUP + nv]; }
                else { g[k] = p.state_cf[(size_t)(b * 2 + 2 + tt) * NUP + c]; v[k] = p.state_cf[(size_t)(b * 2 + 2 + tt) * NUP + DFF + c]; }
            }
            const float cg2 = p.ffn_conv_w[c] * g[0] + p.ffn_conv_w[NUP + c] * g[1] + p.ffn_conv_w[2 * NUP + c] * g[2] + p.ffn_conv_b[c];
            const float cv2 = p.ffn_conv_w[DFF + c] * v[0] + p.ffn_conv_w[NUP + DFF + c] * v[1] + p.ffn_conv_w[2 * NUP + DFF + c] * v[2] + p.ffn_conv_b[DFF + c];
            GT[((size_t)MP + r) * DFF + c] = f2bf(silu(cg2) * cv2);
            if (t >= 30) { p.out[O_CFS + (size_t)(b * 2 + t - 30) * NUP + c] = g[2]; p.out[O_CFS + (size_t)(b * 2 + t - 30) * NUP + DFF + c] = v[2]; }
        }
    }
    const int total = 128 * 2 * DFF;
    for (int idx = blockIdx.x * 512 + threadIdx.x; idx < total; idx += gridDim.x * 512) {
        const int c = idx % DFF, q = idx / DFF, r = q & 1, u = q >> 1;
        const float* cur = BND + (size_t)u * 4 * NUP;
        float pg[2], pv[2];
        if (u < 128) {
            if ((u & 31) == 0) { pg[0] = pg[1] = pv[0] = pv[1] = 0.f; }
            else { const float* pr = BND + (size_t)(u - 1) * 4 * NUP; pg[0] = pr[2 * NUP + c]; pg[1] = pr[3 * NUP + c]; pv[0] = pr[2 * NUP + DFF + c]; pv[1] = pr[3 * NUP + DFF + c]; }
        } else { const float* st = p.state_cf + (size_t)(u - 128) * 2 * NUP; pg[0] = st[c]; pg[1] = st[NUP + c]; pv[0] = st[DFF + c]; pv[1] = st[NUP + DFF + c]; }
        const float cg0 = cur[c], cg1 = cur[NUP + c], cv0 = cur[DFF + c], cv1 = cur[NUP + DFF + c];
        const float wg0 = p.ffn_conv_w[c], wg1 = p.ffn_conv_w[NUP + c], wg2 = p.ffn_conv_w[2 * NUP + c], bg = p.ffn_conv_b[c];
        const float wv0 = p.ffn_conv_w[DFF + c], wv1 = p.ffn_conv_w[NUP + DFF + c], wv2 = p.ffn_conv_w[2 * NUP + DFF + c], bv = p.ffn_conv_b[DFF + c];
        float g, v;
        if (r == 0) { g = wg0 * pg[0] + wg1 * pg[1] + wg2 * cg0 + bg; v = wv0 * pv[0] + wv1 * pv[1] + wv2 * cv0 + bv; }
        else { g = wg0 * pg[1] + wg1 * cg0 + wg2 * cg1 + bg; v = wv0 * pv[1] + wv1 * cv0 + wv2 * cv1 + bv; }
        const size_t row = u < 128 ? (size_t)u * 256 + r : (size_t)MP + (size_t)(u - 128) * 32 + r;
        GT[row * DFF + c] = f2bf(silu(g) * v);
    }
}

#define MFMA16(a, b, c) __builtin_amdgcn_mfma_f32_16x16x32_bf16((a), (b), (c), 0, 0, 0)
#define MFMA32(a, b, c) __builtin_amdgcn_mfma_f32_32x32x16_bf16((a), (b), (c), 0, 0, 0)
DI bf16x8 pack8(const f32x4 a, const f32x4 b) { u32x4 o; o.x = pk2(a.x, a.y); o.y = pk2(a.z, a.w); o.z = pk2(b.x, b.y); o.w = pk2(b.z, b.w); return __builtin_bit_cast(bf16x8, o); }
constexpr float GSCALE = 0.08838834764831845f;
constexpr int QST = 132, AST = 68, NST = 136, QKST = 72;
constexpr int L_QKV = 0, L_AM = 3 * 64 * QST * 4, L_KN = L_AM + 64 * AST * 4, L_QN = L_KN + 64 * NST * 2, L_GC = L_QN + 64 * NST * 2;
constexpr int L_QKS = 0, L_WS = 64 * QKST * 2;
static_assert(L_GC + 1024 <= LDS_BYTES, "gdn prep LDS");

DI void gdn_conv_weights(const Params& p, const int h, float (&cw)[3][4]) {
#pragma unroll
    for (int k = 0; k < 3; ++k) {
        const int task = threadIdx.x + 512 * k, col = task % 384, part = col >> 7, cc = col & 127, gcol = part * 512 + h * 128 + cc;
#pragma unroll
        for (int j = 0; j < 4; ++j) cw[k][j] = p.gdn_conv_w[j * 1536 + gcol];
    }
}
DI void gdn_prep_item(const Params& p, const int item, const float (&cw)[3][4]) {
    unsigned char* ws = p.ws;
    float* QKVf = (float*)(dyn_smem + L_QKV); float* AM = (float*)(dyn_smem + L_AM);
    bf16_t* KN = (bf16_t*)(dyn_smem + L_KN); bf16_t* QN = (bf16_t*)(dyn_smem + L_QN);
    float* GC = (float*)(dyn_smem + L_GC); float* BETA = GC + 64; float* EG = GC + 128; float* ED = GC + 192;
    bf16_t* QKS = (bf16_t*)(dyn_smem + L_QKS); bf16_t* WSI = (bf16_t*)(dyn_smem + L_WS);
    const bf16_t* HQKV = (const bf16_t*)(ws + WS_R2);
    const float* AB = (const float*)(ws + WS_AB);
    float* DL = (float*)(ws + WS_DL);
        const int tid = opaque_tid(), lane = tid & 63, wave = __builtin_amdgcn_readfirstlane(tid >> 6), fr = lane & 15, fq = lane >> 4;
        int h, b, c, row0, valid; bool samp;
        if (item < 2048) { h = item & 3; c = (item >> 2) & 127; b = item >> 9; row0 = b * TP + c * 64; valid = 64; samp = false; }
        else { const int j = item - 2048; h = j & 3; b = j >> 2; c = 0; row0 = MP + b * TS; valid = TS; samp = true; }
        unsigned char* ip = ws + WS_R1 + (size_t)item * ITEM_B;
        lds_barrier();
        {
            bf16_t* RAW = (bf16_t*)(dyn_smem + L_AM);
#pragma unroll
            for (int i = 0; i < 7; ++i) {
                const int id = tid + 512 * i;
                if (id < 67 * 48) {
                    const int rw = id / 48, ch = id % 48, part = ch >> 4, c8 = (ch & 15) * 8, gcol = part * 512 + h * 128 + c8, t = rw - 3;
                    u32x4 v = (u32x4){0u, 0u, 0u, 0u};
                    if (t >= 0) {
                        if (t < valid) {
                            if (!samp) v = __builtin_nontemporal_load((const u32x4*)(HQKV + (size_t)(row0 + t) * 1536 + gcol));
                            else { const float* sp = (const float*)(ws + WS_CS1) + (size_t)(row0 - MP + t) * NH1 + gcol; const f32x4 f0 = *(const f32x4*)sp, f1 = *(const f32x4*)(sp + 4);
                                   v.x = pk2(f0.x, f0.y); v.y = pk2(f0.z, f0.w); v.z = pk2(f1.x, f1.y); v.w = pk2(f1.z, f1.w); }
                        }
                    }
                    else if (samp) { const float* sp = p.state_cq + (size_t)(b * 3 + 3 + t) * 1536 + gcol; const f32x4 f0 = *(const f32x4*)sp, f1 = *(const f32x4*)(sp + 4);
                                     v.x = pk2(f0.x, f0.y); v.y = pk2(f0.z, f0.w); v.z = pk2(f1.x, f1.y); v.w = pk2(f1.z, f1.w); }
                    else if (c != 0) v = *(const u32x4*)(HQKV + (size_t)(row0 + t) * 1536 + gcol);
                    *(u32x4*)(RAW + rw * 384 + ch * 8) = v;
                }
            }
            lds_barrier();
#pragma unroll
            for (int k3 = 0; k3 < 3; ++k3) {
                const int task = tid + 512 * k3;
                const int col = task % 384, seg = task / 384, part = col >> 7, cc = col & 127, t0 = seg * 16;
                const float w0 = cw[k3][0], w1 = cw[k3][1], w2 = cw[k3][2], w3 = cw[k3][3];
                float x0 = bf2f(RAW[(t0) * 384 + col]), x1 = bf2f(RAW[(t0 + 1) * 384 + col]), x2 = bf2f(RAW[(t0 + 2) * 384 + col]);
#pragma unroll
                for (int t = t0; t < t0 + 16; ++t) {
                    const float xv = bf2f(RAW[(t + 3) * 384 + col]);
                    const float y = w0 * x0 + w1 * x1 + w2 * x2 + w3 * xv;
                    QKVf[(part * 64 + t) * QST + cc] = t < valid ? silu(y) : 0.f;
                    x0 = x1; x1 = x2; x2 = xv;
                }
            }
        }
        if (tid < 64) {
            float g = 0.f, be = 0.f;
            if (tid < valid) {
                const float a = AB[(size_t)(row0 + tid) * 8 + h] + p.dt_bias[h], bb = AB[(size_t)(row0 + tid) * 8 + 4 + h];
                const float sp = a > 20.f ? a : log1pf(expf(a));
                g = -expf(p.a_log[h]) * sp; be = 1.f / (1.f + expf(-bb));
            }
            float gc = g;
#pragma unroll
            for (int o = 1; o < 64; o <<= 1) { const float n = __shfl_up(gc, o); if (lane >= o) gc += n; }
            const float gl = __shfl(gc, 63);
            GC[tid] = gc; BETA[tid] = be; EG[tid] = expf(gc); ED[tid] = expf(gl - gc);
            if (tid == 0) DL[item] = expf(gl);
        }
        lds_barrier();
        {
            const int row = tid >> 3, pt = tid & 7;
            float q[16], k[16]; float sq = 0.f, sk = 0.f;
#pragma unroll
            for (int e4 = 0; e4 < 4; ++e4) {
                const f32x4 a = *(const f32x4*)(QKVf + row * QST + 16 * pt + 4 * e4), bq = *(const f32x4*)(QKVf + (64 + row) * QST + 16 * pt + 4 * e4);
#pragma unroll
                for (int e = 0; e < 4; ++e) { q[4 * e4 + e] = a[e]; k[4 * e4 + e] = bq[e]; sq += a[e] * a[e]; sk += bq[e] * bq[e]; }
            }
            { sq = xsum8(sq); sk = xsum8(sk); }
            const float rq = rsqrtf(sq + 1e-6f), rk = rsqrtf(sk + 1e-6f), qg = rq * GSCALE * EG[row];
            u32x4 o0, o1;
            o0.x = pk2(q[0] * rq, q[1] * rq); o0.y = pk2(q[2] * rq, q[3] * rq); o0.z = pk2(q[4] * rq, q[5] * rq); o0.w = pk2(q[6] * rq, q[7] * rq);
            o1.x = pk2(q[8] * rq, q[9] * rq); o1.y = pk2(q[10] * rq, q[11] * rq); o1.z = pk2(q[12] * rq, q[13] * rq); o1.w = pk2(q[14] * rq, q[15] * rq);
            *(u32x4*)(QN + row * NST + 16 * pt) = o0; *(u32x4*)(QN + row * NST + 16 * pt + 8) = o1;
            o0.x = pk2(k[0] * rk, k[1] * rk); o0.y = pk2(k[2] * rk, k[3] * rk); o0.z = pk2(k[4] * rk, k[5] * rk); o0.w = pk2(k[6] * rk, k[7] * rk);
            o1.x = pk2(k[8] * rk, k[9] * rk); o1.y = pk2(k[10] * rk, k[11] * rk); o1.z = pk2(k[12] * rk, k[13] * rk); o1.w = pk2(k[14] * rk, k[15] * rk);
            *(u32x4*)(KN + row * NST + 16 * pt) = o0; *(u32x4*)(KN + row * NST + 16 * pt + 8) = o1;
#pragma unroll
            for (int e4 = 0; e4 < 4; ++e4) *(f32x4*)(QKVf + (64 + row) * QST + 16 * pt + 4 * e4) = (f32x4){k[4 * e4] * rk, k[4 * e4 + 1] * rk, k[4 * e4 + 2] * rk, k[4 * e4 + 3] * rk};
            bf16_t* QGf = (bf16_t*)(ip + 16384);
            const int rt = row >> 4, frr = row & 15, ks = pt >> 1;
#pragma unroll
            for (int f = 0; f < 4; ++f) {
                u32x2 o; o.x = pk2(q[4 * f] * qg, q[4 * f + 1] * qg); o.y = pk2(q[4 * f + 2] * qg, q[4 * f + 3] * qg);
                *(u32x2*)(QGf + (size_t)(((rt * 4 + ks) * 64 + f * 16 + frr) * 8 + 4 * (pt & 1))) = o;
            }
        }
        lds_barrier();
        {
            const bool isq = wave >= 4; const int ti = wave & 3;
            const bf16_t* As = isq ? QN : KN;
#pragma unroll
            for (int tj = 0; tj < 4; ++tj) {
                f32x4 acc = (f32x4){0.f, 0.f, 0.f, 0.f};
#pragma unroll
                for (int ks = 0; ks < 4; ++ks) {
                    const bf16x8 a = *(const bf16x8*)(As + (16 * ti + fr) * NST + 32 * ks + 8 * fq), bb = *(const bf16x8*)(KN + (16 * tj + fr) * NST + 32 * ks + 8 * fq);
                    acc = MFMA16(a, bb, acc);
                }
                const int jj = 16 * tj + fr; const float gj = GC[jj];
#pragma unroll
                for (int j = 0; j < 4; ++j) {
                    const int i = 16 * ti + 4 * fq + j;
                    const float dec = i >= jj ? __expf(GC[i] - gj) : 0.f;
                    if (!isq) AM[i * AST + jj] = i > jj ? BETA[i] * acc[j] * dec : 0.f;
                    else QKS[i * QKST + jj] = f2bf(GSCALE * acc[j] * dec);
                }
            }
            bf16_t* KDTf = (bf16_t*)(ip + 32768);
#pragma unroll
            for (int i2 = 0; i2 < 2; ++i2) {
                const int f = tid + 512 * i2, ln = f & 63, ks2 = (f >> 6) & 1, dt = f >> 7, fq_ = ln >> 4, dk = 16 * dt + (ln & 15);
                float v[8];
#pragma unroll
                for (int e = 0; e < 8; ++e) { const int i = 32 * ks2 + 16 * (e >> 2) + 4 * fq_ + (e & 3); v[e] = bf2f(KN[i * NST + dk]) * ED[i]; }
                u32x4 o; o.x = pk2(v[0], v[1]); o.y = pk2(v[2], v[3]); o.z = pk2(v[4], v[5]); o.w = pk2(v[6], v[7]);
                *(u32x4*)(KDTf + (size_t)f * 8) = o;
            }
        }
        lds_barrier();
        {
            float* TM = (float*)(dyn_smem + L_QN);
            float* TMP = (float*)(dyn_smem + L_KN);
#pragma unroll
            for (int i = 0; i < 9; ++i) { const int id = tid + 512 * i; if (id < 64 * AST) TM[id] = 0.f; }
            lds_barrier();
            if (tid < 64) {
                const int d = tid >> 4, c = tid & 15;
                float y[16];
#pragma unroll
                for (int r = 0; r < 16; ++r) {
                    float sacc = r == c ? 1.f : 0.f;
                    const float* ar = AM + (16 * d + r) * AST + 16 * d;
                    float arow[16];
#pragma unroll
                    for (int j4 = 0; j4 < (r + 3) / 4; ++j4) { const f32x4 a = *(const f32x4*)(ar + 4 * j4); arow[4 * j4] = a.x; arow[4 * j4 + 1] = a.y; arow[4 * j4 + 2] = a.z; arow[4 * j4 + 3] = a.w; }
#pragma unroll
                    for (int j = 0; j < r; ++j) sacc -= arow[j] * y[j];
                    y[r] = sacc;
                    TM[(16 * d + r) * AST + 16 * d + c] = sacc;
                }
            }
            lds_barrier();
            {
                const int blk = tid >> 8, r = (tid >> 4) & 15, c = tid & 15, rb = blk ? 3 : 1, cb = rb - 1;
                float t = 0.f;
#pragma unroll
                for (int j = 0; j < 16; ++j) t += AM[(16 * rb + r) * AST + 16 * cb + j] * TM[(16 * cb + j) * AST + 16 * cb + c];
                TMP[blk * 272 + r * 17 + c] = t;
                lds_barrier();
                float o = 0.f;
#pragma unroll
                for (int k = 0; k < 16; ++k) o -= TM[(16 * rb + r) * AST + 16 * rb + k] * TMP[blk * 272 + k * 17 + c];
                lds_barrier();
                TM[(16 * rb + r) * AST + 16 * cb + c] = o;
            }
            lds_barrier();
            {
                float t[2];
#pragma unroll
                for (int i2 = 0; i2 < 2; ++i2) {
                    const int o = tid + 512 * i2, r = o >> 5, c = o & 31;
                    float acc = 0.f;
#pragma unroll
                    for (int j4 = 0; j4 < 8; ++j4) {
                        const f32x4 a = *(const f32x4*)(AM + (32 + r) * AST + 4 * j4);
                        acc += a.x * TM[(4 * j4) * AST + c] + a.y * TM[(4 * j4 + 1) * AST + c] + a.z * TM[(4 * j4 + 2) * AST + c] + a.w * TM[(4 * j4 + 3) * AST + c];
                    }
                    t[i2] = acc;
                }
#pragma unroll
                for (int i2 = 0; i2 < 2; ++i2) { const int o = tid + 512 * i2; TMP[(o >> 5) * 33 + (o & 31)] = t[i2]; }
                lds_barrier();
#pragma unroll
                for (int i2 = 0; i2 < 2; ++i2) {
                    const int o = tid + 512 * i2, r = o >> 5, c = o & 31;
                    float acc = 0.f;
#pragma unroll
                    for (int k4 = 0; k4 < 8; ++k4) {
                        const f32x4 a = *(const f32x4*)(TM + (32 + r) * AST + 32 + 4 * k4);
                        acc -= a.x * TMP[(4 * k4) * 33 + c] + a.y * TMP[(4 * k4 + 1) * 33 + c] + a.z * TMP[(4 * k4 + 2) * 33 + c] + a.w * TMP[(4 * k4 + 3) * 33 + c];
                    }
                    t[i2] = acc;
                }
#pragma unroll
                for (int i2 = 0; i2 < 2; ++i2) { const int o = tid + 512 * i2; TM[(32 + (o >> 5)) * AST + (o & 31)] = t[i2]; }
            }
            lds_barrier();
            {
                bf16x8 Ah[4][2], Al[4][2];
#pragma unroll
                for (int rt = 0; rt < 4; ++rt)
#pragma unroll
                    for (int ks = 0; ks < 2; ++ks) {
                        const f32x4 a0 = *(const f32x4*)(TM + (16 * rt + fr) * AST + 32 * ks + 8 * fq), a1 = *(const f32x4*)(TM + (16 * rt + fr) * AST + 32 * ks + 8 * fq + 4);
                        u32x4 hq; hq.x = pk2(a0.x, a0.y); hq.y = pk2(a0.z, a0.w); hq.z = pk2(a1.x, a1.y); hq.w = pk2(a1.z, a1.w);
                        u32x4 lq; lq.x = pk2(a0.x - bflo(hq.x), a0.y - bfhi(hq.x)); lq.y = pk2(a0.z - bflo(hq.y), a0.w - bfhi(hq.y));
                        lq.z = pk2(a1.x - bflo(hq.z), a1.y - bfhi(hq.z)); lq.w = pk2(a1.z - bflo(hq.w), a1.w - bfhi(hq.w));
                        Ah[rt][ks] = __builtin_bit_cast(bf16x8, hq); Al[rt][ks] = __builtin_bit_cast(bf16x8, lq);
                    }
                const bool isw = wave >= 4;
                f32x4 xacc[2][4];
#pragma unroll
                for (int q = 0; q < 2; ++q)
#pragma unroll
                    for (int rt = 0; rt < 4; ++rt) xacc[q][rt] = (f32x4){0.f, 0.f, 0.f, 0.f};
#pragma unroll
                for (int ks = 0; ks < 2; ++ks) {
                    float sc8[8];
                    {
                        const f32x4 b0 = *(const f32x4*)(BETA + 32 * ks + 8 * fq), b1 = *(const f32x4*)(BETA + 32 * ks + 8 * fq + 4);
                        const f32x4 e0 = *(const f32x4*)(EG + 32 * ks + 8 * fq), e1 = *(const f32x4*)(EG + 32 * ks + 8 * fq + 4);
#pragma unroll
                        for (int e = 0; e < 4; ++e) { sc8[e] = isw ? b0[e] * e0[e] : b0[e]; sc8[4 + e] = isw ? b1[e] * e1[e] : b1[e]; }
                    }
#pragma unroll
                    for (int q = 0; q < 2; ++q) {
                        const int cc = ((2 * wave + q) & 7) * 16 + fr;
                        const float* src = QKVf + ((isw ? 64 : 128) + 32 * ks + 8 * fq) * QST + cc;
                        float v[8];
#pragma unroll
                        for (int e = 0; e < 8; ++e) v[e] = src[e * QST] * sc8[e];
                        u32x4 hq; hq.x = pk2(v[0], v[1]); hq.y = pk2(v[2], v[3]); hq.z = pk2(v[4], v[5]); hq.w = pk2(v[6], v[7]);
                        u32x4 lq; lq.x = pk2(v[0] - bflo(hq.x), v[1] - bfhi(hq.x)); lq.y = pk2(v[2] - bflo(hq.y), v[3] - bfhi(hq.y));
                        lq.z = pk2(v[4] - bflo(hq.z), v[5] - bfhi(hq.z)); lq.w = pk2(v[6] - bflo(hq.w), v[7] - bfhi(hq.w));
                        const bf16x8 Bh = __builtin_bit_cast(bf16x8, hq), Bl = __builtin_bit_cast(bf16x8, lq);
#pragma unroll
                        for (int rt = 0; rt < 4; ++rt) {
                            xacc[q][rt] = MFMA16(Ah[rt][ks], Bh, xacc[q][rt]);
                            xacc[q][rt] = MFMA16(Al[rt][ks], Bh, xacc[q][rt]);
                            xacc[q][rt] = MFMA16(Ah[rt][ks], Bl, xacc[q][rt]);
                        }
                    }
                }
                if (!isw) {
                    float* Uc = (float*)(ip + 57344);
#pragma unroll
                    for (int q = 0; q < 2; ++q)
#pragma unroll
                        for (int rt = 0; rt < 4; ++rt) *(f32x4*)(Uc + (size_t)((((2 * wave + q) * 4 + rt) * 64 + lane) * 4)) = xacc[q][rt];
                } else {
#pragma unroll
                    for (int q = 0; q < 2; ++q)
#pragma unroll
                        for (int rt = 0; rt < 4; ++rt)
#pragma unroll
                            for (int j = 0; j < 4; ++j) WSI[(16 * rt + 4 * fq + j) * NST + ((2 * wave + q) & 7) * 16 + fr] = f2bf(xacc[q][rt][j]);
                }
            }
        }
        lds_barrier();
        {
            bf16_t* Wf = (bf16_t*)ip; bf16_t* QKf = (bf16_t*)(ip + 49152);
#pragma unroll
            for (int i2 = 0; i2 < 2; ++i2) {
                const int f = tid + 512 * i2, ln = f & 63, ks = (f >> 6) & 3, rt = f >> 8, i = 16 * rt + (ln & 15), fq_ = ln >> 4;
                const u32x2 lo = *(const u32x2*)(WSI + i * NST + 32 * ks + 4 * fq_), hi = *(const u32x2*)(WSI + i * NST + 32 * ks + 16 + 4 * fq_);
                *(u32x4*)(Wf + (size_t)f * 8) = (u32x4){lo.x, lo.y, hi.x, hi.y};
            }
            {
                const int f = tid, ln = f & 63, ks2 = (f >> 6) & 1, rt = f >> 7, i = 16 * rt + (ln & 15), fq_ = ln >> 4;
                const u32x2 lo = *(const u32x2*)(QKS + i * QKST + 32 * ks2 + 4 * fq_), hi = *(const u32x2*)(QKS + i * QKST + 32 * ks2 + 16 + 4 * fq_);
                *(u32x4*)(QKf + (size_t)f * 8) = (u32x4){lo.x, lo.y, hi.x, hi.y};
            }
        }
    lds_barrier();
}

DI void gdn_prep_phase(const Params& p) {
    unsigned char* ws = p.ws;
    for (int r = blockIdx.x; r < MS; r += gridDim.x) {
        const int tid = opaque_tid(), b = r >> 5, t = r & 31, pos = PAST + t;
        const float* cs = (const float*)(ws + WS_CS1) + (size_t)r * NH1;
        if (t >= TS - 3) { for (int c = tid; c < 1536; c += 512) p.out[O_CQS + (size_t)(b * 3 + t - (TS - 3)) * 1536 + c] = cs[c]; }
        {
            const int which = tid >> 8, pr = tid & 255, hd = pr >> 6, mp = (pr >> 5) & 1, d = pr & 31, col = hd * 128 + mp * 64 + d;
            const float2 csn = ((const float2*)(ws + WS_ROPE))[pos * 32 + d];
            const float x1 = cs[2048 + which * 512 + col], x2 = cs[2048 + which * 512 + col + 32];
            const float y1 = x1 * csn.x - x2 * csn.y, y2 = x2 * csn.x + x1 * csn.y;
            if (which == 0) { const float qs = 0.125f * 1.4426950408889634f; bf16_t* QB = (bf16_t*)(ws + WS_R4) + ((size_t)MP + r) * 512; QB[col] = f2bf(y1 * qs); QB[col + 32] = f2bf(y2 * qs); }
            else { float* ko = p.out + O_KS + (size_t)r * 512; ko[col] = y1; ko[col + 32] = y2;
                   bf16_t* kk = (bf16_t*)(ws + WS_R5) + ((size_t)MP + (size_t)b * TKS + pos) * 512; kk[col] = f2bf(y1); kk[col + 32] = f2bf(y2); }
        }
        {
            const float vv = cs[3072 + tid];
            p.out[O_VS + (size_t)r * 512 + tid] = vv;
            ((bf16_t*)(ws + WS_R6))[VT_S_OFF + ((size_t)((b * 4 + (tid >> 7)) * 128 + (tid & 127)) * TKS + pos)] = f2bf(vv);
        }
    }
    float cw[3][4];
    gdn_conv_weights(p, blockIdx.x & 3, cw);
    {
        const int when = blockIdx.x & 7; int k = 0;
#pragma unroll 1
        for (int item = blockIdx.x; item < 2048; item += gridDim.x, ++k) { if (k == when) prep_stream(p); gdn_prep_item(p, item, cw); }
    }
}

constexpr int OPB_B = 57344, L_OBUF = 2 * OPB_B, OST = 132;
static_assert(L_OBUF + 64 * OST * 4 <= LDS_BYTES, "scan LDS");
DI void gdn_scan(const Params& p, const bool samp, const int b, const int h) {
    unsigned char* ws = p.ws;
    const int tid = threadIdx.x, lane = tid & 63, w = __builtin_amdgcn_readfirstlane(tid >> 6), fr = lane & 15, fq = lane >> 4;
    const int nsteps = samp ? 1 : 128, valid = samp ? TS : 64;
    float* OBUF = (float*)(dyn_smem + L_OBUF);
    const bf16_t* HG = (const bf16_t*)(ws + WS_R3);
    bf16_t* OMIX = (bf16_t*)(ws + WS_R2);
    const float* DL = (const float*)(ws + WS_DL);
    f32x4 S[8];
#pragma unroll
    for (int dt = 0; dt < 8; ++dt) {
        if (samp) {
#pragma unroll
            for (int j = 0; j < 4; ++j) S[dt][j] = p.state_gdn[((size_t)(b * 4 + h) * 128 + 16 * dt + 4 * fq + j) * 128 + 16 * w + fr];
        } else S[dt] = (f32x4){0.f, 0.f, 0.f, 0.f};
    }
    const int item0 = samp ? 2048 + b * 4 + h : b * 512 + h;
    lds_barrier();
    {
        const unsigned char* ip = ws + WS_R1 + (size_t)item0 * ITEM_B;
#pragma unroll
        for (int i = 0; i < 7; ++i) *(u32x4*)(dyn_smem + (tid + 512 * i) * 16) = *(const u32x4*)(ip + (tid + 512 * i) * 16);
    }
    lds_barrier();
    const int erow = tid >> 3, ept = tid & 7;
    float nw[16];
#pragma unroll
    for (int e = 0; e < 16; ++e) nw[e] = p.gdn_norm_w[16 * ept + e];
    f32x4 U[4]; float dl; u32x4 g0, g1;
    auto side_load = [&](int c, f32x4 (&Uo)[4], float& dlo, u32x4& go0, u32x4& go1) {
        const int item = item0 + 4 * c;
        const float* Uc = (const float*)(ws + WS_R1 + (size_t)item * ITEM_B + 57344);
#pragma unroll
        for (int rt = 0; rt < 4; ++rt) Uo[rt] = __builtin_nontemporal_load((const f32x4*)(Uc + ((w * 4 + rt) * 64 + lane) * 4));
        dlo = DL[item];
        const size_t grow = (samp ? (size_t)MP + b * TS : (size_t)b * TP + (size_t)c * 64) + erow;
        if (!samp) { go0 = *(const u32x4*)(HG + grow * 512 + h * 128 + 16 * ept); go1 = *(const u32x4*)(HG + grow * 512 + h * 128 + 16 * ept + 8); }
        else if (erow < TS) { const float* gp = (const float*)(ws + WS_CS1) + (grow - MP) * NH1 + 1536 + h * 128 + 16 * ept;
               const f32x4 f0 = *(const f32x4*)gp, f1 = *(const f32x4*)(gp + 4), f2 = *(const f32x4*)(gp + 8), f3 = *(const f32x4*)(gp + 12);
               go0 = (u32x4){pk2(f0.x, f0.y), pk2(f0.z, f0.w), pk2(f1.x, f1.y), pk2(f1.z, f1.w)}; go1 = (u32x4){pk2(f2.x, f2.y), pk2(f2.z, f2.w), pk2(f3.x, f3.y), pk2(f3.z, f3.w)}; }
        else { go0 = (u32x4){0u, 0u, 0u, 0u}; go1 = go0; }
    };
    side_load(0, U, dl, g0, g1);
#pragma unroll 1
    for (int c = 0; c < nsteps; ++c) {
        const int item = item0 + 4 * c;
        const unsigned char* ip = ws + WS_R1 + (size_t)item * ITEM_B;
        const bool nxt = c + 1 < nsteps;
        u32x4 pf[7];
        f32x4 Un[4]; float dln = 0.f; u32x4 gn0 = g0, gn1 = g1;
        if (nxt) {
#pragma unroll
            for (int i = 0; i < 7; ++i) pf[i] = __builtin_nontemporal_load((const u32x4*)(ip + 4 * (size_t)ITEM_B + (tid + 512 * i) * 16));
            side_load(c + 1, Un, dln, gn0, gn1);
        }
        const unsigned char* buf = dyn_smem + (c & 1) * OPB_B;
        bf16x8 Sb[4];
#pragma unroll
        for (int ks = 0; ks < 4; ++ks) Sb[ks] = pack8(S[2 * ks], S[2 * ks + 1]);
        f32x4 vn[4];
#pragma unroll
        for (int rt = 0; rt < 4; ++rt) {
            f32x4 acc = (f32x4){0.f, 0.f, 0.f, 0.f};
#pragma unroll
            for (int ks = 0; ks < 4; ++ks) acc = MFMA16(*(const bf16x8*)(buf + ((rt * 4 + ks) * 64 + lane) * 16), Sb[ks], acc);
            vn[rt] = U[rt] - acc;
        }
        bf16x8 Vb[2];
        Vb[0] = pack8(vn[0], vn[1]); Vb[1] = pack8(vn[2], vn[3]);
#pragma unroll
        for (int rt = 0; rt < 4; ++rt) {
            f32x4 acc = (f32x4){0.f, 0.f, 0.f, 0.f};
#pragma unroll
            for (int ks = 0; ks < 4; ++ks) acc = MFMA16(*(const bf16x8*)(buf + 16384 + ((rt * 4 + ks) * 64 + lane) * 16), Sb[ks], acc);
#pragma unroll
            for (int ks2 = 0; ks2 < 2; ++ks2) acc = MFMA16(*(const bf16x8*)(buf + 49152 + ((rt * 2 + ks2) * 64 + lane) * 16), Vb[ks2], acc);
#pragma unroll
            for (int j = 0; j < 4; ++j) OBUF[(16 * rt + 4 * fq + j) * OST + 16 * w + fr] = acc[j];
        }
#pragma unroll
        for (int dt = 0; dt < 8; ++dt) {
            f32x4 acc = S[dt] * dl;
#pragma unroll
            for (int ks2 = 0; ks2 < 2; ++ks2) acc = MFMA16(*(const bf16x8*)(buf + 32768 + ((dt * 2 + ks2) * 64 + lane) * 16), Vb[ks2], acc);
            S[dt] = acc;
        }
        if (nxt) {
#pragma unroll
            for (int i = 0; i < 7; ++i) *(u32x4*)(dyn_smem + ((c + 1) & 1) * OPB_B + (tid + 512 * i) * 16) = pf[i];
        }
        lds_barrier();
        {
            float o[16]; float ss = 0.f;
#pragma unroll
            for (int e4 = 0; e4 < 4; ++e4) { const f32x4 a = *(const f32x4*)(OBUF + erow * OST + 16 * ept + 4 * e4);
#pragma unroll
                for (int e = 0; e < 4; ++e) { o[4 * e4 + e] = a[e]; ss += a[e] * a[e]; } }
            ss = xsum8(ss);
            if (erow < valid) {
                const float r = rsqrtf(ss * (1.f / 128.f) + 1e-6f);
                const size_t grow = (samp ? (size_t)MP + b * TS : (size_t)b * TP + (size_t)c * 64) + erow;
                const unsigned gw[8] = {g0.x, g0.y, g0.z, g0.w, g1.x, g1.y, g1.z, g1.w};
                unsigned ow[8];
#pragma unroll
                for (int e = 0; e < 8; ++e) {
                    const float ga = bflo(gw[e]), gb = bfhi(gw[e]);
                    ow[e] = pk2(o[2 * e] * r * nw[2 * e] * silu(ga), o[2 * e + 1] * r * nw[2 * e + 1] * silu(gb));
                }
                *(u32x4*)(OMIX + grow * 1024 + h * 128 + 16 * ept) = (u32x4){ow[0], ow[1], ow[2], ow[3]};
                *(u32x4*)(OMIX + grow * 1024 + h * 128 + 16 * ept + 8) = (u32x4){ow[4], ow[5], ow[6], ow[7]};
            }
        }
        lds_barrier();
#pragma unroll
        for (int rt = 0; rt < 4; ++rt) U[rt] = Un[rt];
        dl = dln; g0 = gn0; g1 = gn1;
    }
    float* So = p.out + (samp ? O_GS : O_GP) + (size_t)(b * 4 + h) * 128 * 128;
#pragma unroll
    for (int dt = 0; dt < 8; ++dt)
#pragma unroll
        for (int j = 0; j < 4; ++j) So[(size_t)(16 * dt + 4 * fq + j) * 128 + 16 * w + fr] = S[dt][j];
}

constexpr int L_KT = 0, L_VT = 2 * 16384, L_ALX = L_VT + 3 * 16384, L_IDX = L_ALX + 8 * 2 * 32 * 4, L_QF = L_IDX + 256;
static_assert(L_QF + 8 * 8 * 1024 <= LDS_BYTES, "attn LDS");
DI int crow32(int i, int hh) { return (i & 3) + 8 * (i >> 2) + 4 * hh; }

DI void attn_item(const Params& p, const int idx, const float* lamp) {
    unsigned char* ws = p.ws;
    const int tid = opaque_tid(), lane = tid & 63, w = __builtin_amdgcn_readfirstlane(tid >> 6), r = lane & 31, hh = lane >> 5;
    bool samp; int b, h, qb = 0, ntiles, lastw; size_t qbase, kbase; const bf16_t* vtb; int vstride; bool active;
    if (idx < 32) { samp = true; b = idx >> 2; h = idx & 3; qbase = (size_t)MP + b * TS; kbase = (size_t)MP + (size_t)b * TKS; ntiles = 65; lastw = 64; active = w == 0;
                    vtb = (const bf16_t*)(ws + WS_R6) + VT_S_OFF + (size_t)((b * 4 + h) * 128) * TKS; vstride = TKS; }
    else { const int j = idx - 32; samp = false; qb = 31 - (j >> 4); b = (j & 15) >> 2; h = j & 3; qbase = (size_t)b * TP + qb * 256; kbase = (size_t)b * TP; ntiles = 4 * qb + 4; lastw = 4 * qb + (w >> 1); active = true;
           vtb = (const bf16_t*)(ws + WS_R6) + (size_t)((b * 4 + h) * 128) * TP; vstride = TP; }
    const bf16_t* KALL = (const bf16_t*)(ws + WS_R5) + kbase * 512 + h * 128;
    bf16_t* QF = (bf16_t*)(dyn_smem + L_QF) + w * 8 * 64 * 8;
    {
        const bf16_t* qp = (const bf16_t*)(ws + WS_R4) + (qbase + 32 * w + r) * 512 + h * 128 + 8 * hh;
        if (active) {
#pragma unroll
            for (int f = 0; f < 8; ++f) *(u32x4*)(QF + (f * 64 + lane) * 8) = *(const u32x4*)(qp + (f >> 2) * 64 + 16 * (f & 3));
        }
    }
    f32x16 O1[4], O2[4];
#pragma unroll
    for (int t = 0; t < 4; ++t)
#pragma unroll
        for (int i = 0; i < 16; ++i) { O1[t][i] = 0.f; O2[t][i] = 0.f; }
    float m1 = -1e30f, m2 = -1e30f, l1 = 0.f, l2 = 0.f;
    auto stage_tile = [&](int kt_, int buf_, int vbuf_) {
        int ln = lane; asm volatile("" : "+v"(ln));
        const int krow_ = ln >> 4, vrow_ = ln >> 3;
        const unsigned kx = (ln & 15) ^ krow_, vx = (ln & 7) ^ (vrow_ >> 1);
        const unsigned klane = krow_ * 512, vlane = vrow_ * vstride;
#pragma unroll
        for (int j = 0; j < 2; ++j) {
            const int i = 2 * w + j;
            const bf16_t* kbase = KALL + ((size_t)kt_ * 64 + (((4 * i) & ~12) | (((4 * i) & 4) << 1) | (((4 * i) & 8) >> 1))) * 512;
            const bf16_t* vbase = vtb + (size_t)(8 * i) * vstride + (size_t)kt_ * 64;
            const unsigned ko = klane + ((kx ^ ((4 * i) & 15)) * 8), vo = vlane + ((vx ^ ((4 * i) & 7)) * 8);
            __builtin_amdgcn_global_load_lds((const unsigned*)(kbase + ko), (unsigned*)(dyn_smem + L_KT + buf_ * 16384 + i * 1024 + ln * 16), 16, 0, 0);
            __builtin_amdgcn_global_load_lds((const unsigned*)(vbase + vo), (unsigned*)(dyn_smem + L_VT + vbuf_ * 16384 + i * 1024 + ln * 16), 16, 0, 0);
        }
    };
    const int ky = hh ^ (r & 15), vzh = ((r >> 1) & 7) ^ hh;
    __syncthreads();
    stage_tile(0, 0, 0);
    asm volatile("s_waitcnt vmcnt(0)" ::: "memory");
    __syncthreads();
    if (active) {
#pragma unroll
        for (int mp = 0; mp < 2; ++mp) {
            float mx = -1e30f;
#pragma unroll
            for (int sub = 0; sub < 2; ++sub) {
                f32x16 sc;
#pragma unroll
                for (int i = 0; i < 16; ++i) sc[i] = 0.f;
#pragma unroll
                for (int s = 0; s < 4; ++s) {
                    const bf16x8 ka = *(const bf16x8*)(dyn_smem + L_KT + (sub * 32 + r) * 256 + (((mp * 8 + 2 * s) ^ ky) * 16));
                    const bf16x8 qf = *(const bf16x8*)(QF + ((mp * 4 + s) * 64 + lane) * 8);
                    sc = MFMA32(ka, qf, sc);
                }
#pragma unroll
                for (int i = 0; i < 16; ++i) mx = fmaxf(mx, sc[i]);
            }
            const auto sw = __builtin_amdgcn_permlane32_swap(__float_as_uint(mx), __float_as_uint(mx), false, false);
            mx = fmaxf(__uint_as_float(sw[0]), __uint_as_float(sw[1]));
            if (mp == 0) m1 = mx; else m2 = mx;
        }
    }
    const bool roleY = w >= 4;
    bf16x8 PA[2], PB[2];
    float tm1 = -1e30f, tm2 = -1e30f;
    int vcur = 0, vprev = 2;
#define ATT_QK(SUB, MP, SC) do { \
        _Pragma("unroll") for (int s_ = 0; s_ < 4; ++s_) { \
            const bf16x8 ka_ = *(const bf16x8*)(Kb + (SUB) * 32 * 256 + ((((MP) * 8 + 2 * s_) ^ ky) * 16)); \
            const bf16x8 qf_ = *(const bf16x8*)(QF + (((MP) * 4 + s_) * 64 + lane) * 8); \
            SC = MFMA32(ka_, qf_, s_ == 0 ? zero16 : SC); } } while (0)
#define ATT_SM(SC, P, MM, LL, TM, MSK) do { \
        float ps_ = 0.f, tq_ = TM; const float mr_ = MM + MSK; \
        _Pragma("unroll") for (int i_ = 0; i_ < 16; ++i_) { tq_ = fmaxf(tq_, SC[i_]); SC[i_] = __builtin_amdgcn_exp2f(SC[i_] - mr_); ps_ += SC[i_]; } \
        TM = MSK != 0.f ? TM : tq_; \
        LL += ps_; \
        _Pragma("unroll") for (int sp_ = 0; sp_ < 2; ++sp_) { \
            u32x4 a_; a_.x = pk2(SC[8 * sp_], SC[8 * sp_ + 1]); a_.y = pk2(SC[8 * sp_ + 2], SC[8 * sp_ + 3]); a_.z = pk2(SC[8 * sp_ + 4], SC[8 * sp_ + 5]); a_.w = pk2(SC[8 * sp_ + 6], SC[8 * sp_ + 7]); \
            P[sp_] = __builtin_bit_cast(bf16x8, a_); } } while (0)
#define ATT_PV2(VB, SUB, P1, P2) do { \
        _Pragma("unroll") for (int sp_ = 0; sp_ < 2; ++sp_) \
            _Pragma("unroll") for (int t_ = 0; t_ < 4; ++t_) { \
                const bf16x8 vb_ = *(const bf16x8*)((VB) + t_ * 32 * 128 + (((4 * (SUB) + 2 * sp_) ^ vzh) * 16)); \
                O1[t_] = MFMA32(P1[sp_], vb_, O1[t_]); O2[t_] = MFMA32(P2[sp_], vb_, O2[t_]); } } while (0)
#define ATT_QS(SUB, MSK) do { \
        f32x16 scA, scB; \
        ATT_QK(SUB, 0, scA); \
        ATT_QK(SUB, 1, scB); \
        __builtin_amdgcn_sched_barrier(0); \
        ATT_SM(scA, PA, m1, l1, tm1, MSK); \
        ATT_SM(scB, PB, m2, l2, tm2, MSK); \
        __builtin_amdgcn_sched_barrier(0); } while (0)
#define ATT_CHECK() do { \
        const auto s1_ = __builtin_amdgcn_permlane32_swap(__float_as_uint(tm1), __float_as_uint(tm1), false, false); tm1 = fmaxf(__uint_as_float(s1_[0]), __uint_as_float(s1_[1])); \
        const auto s2_ = __builtin_amdgcn_permlane32_swap(__float_as_uint(tm2), __float_as_uint(tm2), false, false); tm2 = fmaxf(__uint_as_float(s2_[0]), __uint_as_float(s2_[1])); \
        const float n1 = tm1 > m1 + 8.f ? tm1 : m1, n2 = tm2 > m2 + 8.f ? tm2 : m2; \
        if (__any((n1 != m1) || (n2 != m2))) { \
            const float al1 = __builtin_amdgcn_exp2f(m1 - n1), al2 = __builtin_amdgcn_exp2f(m2 - n2); \
            l1 *= al1; l2 *= al2; m1 = n1; m2 = n2; \
            const int ln_ = __builtin_amdgcn_mbcnt_hi(~0u, __builtin_amdgcn_mbcnt_lo(~0u, 0u)), r_ = ln_ & 31, hh_ = ln_ >> 5; \
            float* alx_ = (float*)(dyn_smem + L_ALX) + w * 64; \
            if (hh_ == 0) { alx_[r_] = al1; alx_[32 + r_] = al2; } \
            asm volatile("s_waitcnt lgkmcnt(0)" ::: "memory"); \
            _Pragma("unroll") for (int g = 0; g < 4; ++g) { \
                const f32x4 a1 = *(const f32x4*)(alx_ + 8 * g + 4 * hh_), a2 = *(const f32x4*)(alx_ + 32 + 8 * g + 4 * hh_); \
                _Pragma("unroll") for (int t = 0; t < 4; ++t) \
                    _Pragma("unroll") for (int j = 0; j < 4; ++j) { O1[t][4 * g + j] *= a1[j]; O2[t][4 * g + j] *= a2[j]; } } \
            asm volatile("s_waitcnt lgkmcnt(0)" ::: "memory"); } \
        tm1 = -1e30f; tm2 = -1e30f; } while (0)
    f32x16 zero16;
#pragma unroll
    for (int i = 0; i < 16; ++i) zero16[i] = 0.f;
    if (!roleY) {
#pragma unroll 1
        for (int kt = 0; kt < ntiles; ++kt) {
            const int vnext = vcur == 2 ? 0 : vcur + 1;
            if (kt + 1 < ntiles) stage_tile(kt + 1, (kt + 1) & 1, vnext);
            const unsigned char* Kb = dyn_smem + L_KT + (kt & 1) * 16384 + r * 256;
            const unsigned char* Vb = dyn_smem + L_VT + vcur * 16384 + r * 128;
            if (active && kt <= lastw) {
                const float msk1 = (samp && kt == 64) ? 1e30f : 0.f;
#pragma unroll 1
                for (int sub = 0; sub < 2; ++sub) {
                    const float msk = sub ? msk1 : 0.f;
                    ATT_QS(sub, msk);
                    ATT_PV2(Vb, sub, PA, PB);
                    __builtin_amdgcn_sched_barrier(0);
                }
                ATT_CHECK();
            }
            vcur = vnext;
            asm volatile("s_waitcnt vmcnt(0)" ::: "memory");
            __builtin_amdgcn_s_barrier();
        }
    } else {
#pragma unroll 1
        for (int kt = 0; kt < ntiles; ++kt) {
            const int vnext = vcur == 2 ? 0 : vcur + 1;
            if (kt + 1 < ntiles) stage_tile(kt + 1, (kt + 1) & 1, vnext);
            const unsigned char* Kb = dyn_smem + L_KT + (kt & 1) * 16384 + r * 256;
            const unsigned char* Vb = dyn_smem + L_VT + vcur * 16384 + r * 128;
            const unsigned char* Vp = dyn_smem + L_VT + vprev * 16384 + r * 128;
            if (kt <= lastw + 1) {
                if (kt > 0) { ATT_PV2(Vp, 1, PA, PB); __builtin_amdgcn_sched_barrier(0); }
                if (kt <= lastw) {
                    ATT_CHECK();
                    ATT_QS(0, 0.f);
                    ATT_PV2(Vb, 0, PA, PB);
                    __builtin_amdgcn_sched_barrier(0);
                    ATT_QS(1, 0.f);
                }
            }
            vprev = vcur; vcur = vnext;
            asm volatile("s_waitcnt vmcnt(0)" ::: "memory");
            __builtin_amdgcn_s_barrier();
        }
        if (lastw == ntiles - 1) {
            const unsigned char* Vp = dyn_smem + L_VT + vprev * 16384 + r * 128;
            ATT_PV2(Vp, 1, PA, PB);
        }
    }
    if (active) {
        const int lnf = __builtin_amdgcn_mbcnt_hi(~0u, __builtin_amdgcn_mbcnt_lo(~0u, 0u)), r = lnf & 31, hh = lnf >> 5;
        float* ALX = (float*)(dyn_smem + L_ALX) + w * 64;
        { const auto s1_ = __builtin_amdgcn_permlane32_swap(__float_as_uint(l1), __float_as_uint(l1), false, false); l1 = __uint_as_float(s1_[0]) + __uint_as_float(s1_[1]);
          const auto s2_ = __builtin_amdgcn_permlane32_swap(__float_as_uint(l2), __float_as_uint(l2), false, false); l2 = __uint_as_float(s2_[0]) + __uint_as_float(s2_[1]); }
        if (hh == 0) { ALX[r] = __builtin_amdgcn_rcpf(l1); ALX[32 + r] = *lamp * __builtin_amdgcn_rcpf(l2); }
        asm volatile("s_waitcnt lgkmcnt(0)" ::: "memory");
        float ss[16], a1[16], a2[16];
#pragma unroll
        for (int g = 0; g < 4; ++g) {
            const f32x4 x1 = *(const f32x4*)(ALX + 8 * g + 4 * hh), x2 = *(const f32x4*)(ALX + 32 + 8 * g + 4 * hh);
#pragma unroll
            for (int j = 0; j < 4; ++j) { a1[4 * g + j] = x1[j]; a2[4 * g + j] = x2[j]; ss[4 * g + j] = 0.f; }
        }
#pragma unroll
        for (int t = 0; t < 4; ++t) {
            __builtin_amdgcn_sched_barrier(0);
#pragma unroll
            for (int i = 0; i < 16; ++i) { const float o = O1[t][i] * a1[i] - O2[t][i] * a2[i]; O1[t][i] = o; ss[i] += o * o; }
        }
        __builtin_amdgcn_sched_barrier(0);
#pragma unroll
        for (int i = 0; i < 16; ++i) {
            ss[i] = xsum32(ss[i]);
            ss[i] = __builtin_amdgcn_rsqf(ss[i] * (1.f / 128.f) + 1e-6f) * (1.f - LAM_INIT);
        }
        int zo = 0; asm volatile("" : "+v"(zo));
        bf16_t* obase = (bf16_t*)(ws + WS_R2) + (qbase + 32 * w) * 1024 + 512 + h * 128;
        const unsigned ooff = (unsigned)((4 * hh + zo) * 1024 + r);
        const float* sw = p.subln_w + r + zo;
#pragma unroll
        for (int t = 0; t < 4; ++t) {
            const float wv = sw[32 * t];
#pragma unroll
            for (int i = 0; i < 16; ++i) obase[ooff + ((i & 3) + 8 * (i >> 2)) * 1024 + 32 * t] = f2bf(O1[t][i] * ss[i] * wv);
        }
    }
}

DI void mixer_phase(const Params& p) {
    const int bid = blockIdx.x;
#ifndef NO_SCAN
    if (bid >= 16 && bid < 48) {
        float cw[3][4];
        gdn_conv_weights(p, (bid - 16) & 3, cw);
        gdn_prep_item(p, 2048 + bid - 16, cw);
        asm volatile("s_waitcnt vmcnt(0)" ::: "memory");
        __builtin_amdgcn_fence(__ATOMIC_ACQUIRE, "agent");
        asm volatile("s_waitcnt vmcnt(0)" ::: "memory");
        __syncthreads();
    }
    if (bid < 48) { const bool sm = bid >= 16; const int j = sm ? bid - 16 : bid;
#pragma unroll 1
        for (int rep = 0; rep < SREP; ++rep) gdn_scan(p, sm, j >> 2, j & 3); }
#endif
    unsigned* ctl = (unsigned*)(p.ws + WS_CTL);
    int* sidx = (int*)(dyn_smem + L_IDX);
    for (;;) {
        __syncthreads();
        if (threadIdx.x == 0) *sidx = (int)atomicAdd(ctl, 1u);
        __syncthreads();
        const int idx0 = __builtin_amdgcn_readfirstlane(*sidx);
        if (idx0 >= (32 + 512) * AREP) break;
        const int idx = idx0 % (32 + 512);
#ifndef NO_ATTN
        attn_item(p, idx, (const float*)ctl + 1);
#endif
    }
}


#define XB_TMO      128
#define XB_XCNT(j)  (256  + 64 * (j))
#define XB_XSUB(j)  (1280 + 64 * (j))
#define XB_XGEN(j)  (2304 + 64 * (j))
#define XB_TOP      3328
#define XB_TOPGEN   3392
#define XCD_BAR_WORDS 3456
#define XB_SPIN_CAP (1u << 20)
#define LAS __attribute__((address_space(3)))
DI unsigned xb_ld(unsigned* p) { return __hip_atomic_load(p, __ATOMIC_RELAXED, __HIP_MEMORY_SCOPE_AGENT); }
DI unsigned xb_add(unsigned* p, unsigned v) { return __hip_atomic_fetch_add(p, v, __ATOMIC_RELAXED, __HIP_MEMORY_SCOPE_AGENT); }
DI unsigned xb_xcc_id() { return (unsigned)__builtin_amdgcn_s_getreg((3 << 11) | 20) & 0xFu; }
#define XB_SPIN(cond, bar) do { unsigned _sp = 0; while (cond) { __builtin_amdgcn_s_sleep(1); \
    if ((++_sp & 255u) == 0u) { if (xb_ld(&(bar)[XB_TMO])) break; if (_sp > XB_SPIN_CAP) { atomicAdd(&(bar)[XB_TMO], 1u); break; } } } } while (0)
struct XcdBarrier { unsigned* bar; unsigned x; volatile LAS unsigned* st; };
DI XcdBarrier xcd_barrier_post(unsigned* bar, volatile LAS unsigned* st) {
    XcdBarrier b; b.bar = bar; b.x = xb_xcc_id(); b.st = st;
    if (threadIdx.x == 0) (void)xb_add(&bar[XB_XCNT(b.x)], 1u);
    return b;
}
DI void xcd_barrier_complete(unsigned* bar, unsigned x, unsigned& nloc, unsigned& nx) {
    const unsigned G = gridDim.x * gridDim.y * gridDim.z;
    unsigned sum, cnt, mine, sp = 0u;
    for (;;) {
        sum = 0u; cnt = 0u; mine = 0u;
#pragma unroll
        for (unsigned j = 0; j < 16; ++j) { const unsigned c = xb_ld(&bar[XB_XCNT(j)]); sum += c; cnt += (c > 0u) ? 1u : 0u; mine = (j == x) ? c : mine; }
        if (sum == G) break;
        __builtin_amdgcn_s_sleep(1);
        if ((++sp & 255u) == 0u) { if (xb_ld(&bar[XB_TMO])) break; if (sp > XB_SPIN_CAP) { atomicAdd(&bar[XB_TMO], 1u); break; } }
    }
    nloc = mine > 0u ? mine : 1u; nx = cnt > 0u ? cnt : 1u;
}
DI void xcd_barrier(const XcdBarrier& b) {
    asm volatile("s_waitcnt vmcnt(0)" ::: "memory");
    __syncthreads();
    if (threadIdx.x == 0) {
        unsigned* bar = b.bar;
        __builtin_amdgcn_s_waitcnt(0);
        unsigned nloc = b.st[0], nx = b.st[1];
        if (nloc == 0u) { xcd_barrier_complete(bar, b.x, nloc, nx); b.st[0] = nloc; b.st[1] = nx; }
        const unsigned old = xb_add(&bar[XB_XSUB(b.x)], 1u);
        const unsigned gen = old / nloc;
        if (old + 1u == (gen + 1u) * nloc) {
            __builtin_amdgcn_fence(__ATOMIC_RELEASE, "agent");
            asm volatile("s_waitcnt vmcnt(0)" ::: "memory");
            const unsigned og = xb_add(&bar[XB_TOP], 1u);
            const unsigned tg = og / nx;
            if (og + 1u == (tg + 1u) * nx) xb_add(&bar[XB_TOPGEN], 1u);
            else XB_SPIN(xb_ld(&bar[XB_TOPGEN]) == tg, bar);
            __builtin_amdgcn_fence(__ATOMIC_ACQUIRE, "agent");
            xb_add(&bar[XB_XGEN(b.x)], 1u);
            asm volatile("s_waitcnt vmcnt(0)" ::: "memory");
        } else {
            XB_SPIN(xb_ld(&bar[XB_XGEN(b.x)]) == gen, bar);
            __builtin_amdgcn_fence(__ATOMIC_ACQUIRE, "agent");
            asm volatile("s_waitcnt vmcnt(0)" ::: "memory");
        }
    }
    __syncthreads();
}

__global__ void __launch_bounds__(512, 2) fwd_kernel(Params p) {
    cg::grid_group grid = cg::this_grid();
    volatile LAS unsigned* xst = (volatile LAS unsigned*)(dyn_smem + LDS_BYTES - 16);
    if (threadIdx.x == 0) { xst[0] = 0u; xst[1] = 0u; }
    __syncthreads();
    const XcdBarrier xb = xcd_barrier_post((unsigned*)(p.ws + WS_BAR), xst);
    if (p.phase_lo > 1000) grid.sync();
    const bool all = p.phase_hi - p.phase_lo > 1;
#define PHASE(i, body) if (p.phase_lo <= (i) && (i) < p.phase_hi) { body; if (all && (i) + 1 < p.phase_hi) xcd_barrier(xb); }
    PHASE(0, phase_prep(p))
    PHASE(1, gemm_phase<1>(p))
    PHASE(2, gdn_prep_phase(p))
    PHASE(3, mixer_phase(p))
    PHASE(4, gemm_phase<2>(p))
    PHASE(5, ln_phase<0>(p))
    PHASE(6, gemm_phase<3>(p))
    PHASE(7, fixup_phase(p))
    PHASE(8, gemm_phase<4>(p))
    PHASE(9, ln_phase<1>(p))
}

extern "C" void kernel_launch(void* const* d_in, const int* in_sizes, int n_in, void* d_out, int out_size, void* d_ws, size_t ws_size, hipStream_t stream) {
    static int grid = 0;
    if (grid == 0) {
        if (n_in != 23 || (size_t)out_size != O_END || ws_size < WS_END2) { fprintf(stderr, "kernel_launch: unexpected sizes n_in %d out %d ws %zu (need %zu)\n", n_in, out_size, ws_size, (size_t)WS_END2); grid = -1; return; }
        int dev = 0, cus = 0, per_cu = 0;
        hipGetDevice(&dev);
        hipDeviceGetAttribute(&cus, hipDeviceAttributeMultiprocessorCount, dev);
        if (hipFuncSetAttribute((const void*)fwd_kernel, hipFuncAttributeMaxDynamicSharedMemorySize, LDS_BYTES) != hipSuccess) { fprintf(stderr, "kernel_launch: hipFuncSetAttribute failed\n"); grid = -1; return; }
        hipOccupancyMaxActiveBlocksPerMultiprocessor(&per_cu, (const void*)fwd_kernel, 512, LDS_BYTES);
        if (per_cu < 1) { fprintf(stderr, "kernel_launch: occupancy query says %d\n", per_cu); per_cu = 1; }
        (void)hipGetLastError();
        grid = cus * 1;
    }
    if (grid < 0) return;
    Params p{};
    const float** f = (const float**)&p;
    for (int i = 0; i < 23; ++i) f[i] = (const float*)d_in[i];
    p.out = (float*)d_out; p.ws = (unsigned char*)d_ws; p.phase_lo = 0; p.phase_hi = 10;
    if (hipMemsetAsync((unsigned char*)d_ws + WS_BAR, 0, 16384, stream) != hipSuccess) { fprintf(stderr, "kernel_launch: memset failed\n"); return; }
    void* args[] = {&p};
    hipError_t e = hipLaunchCooperativeKernel((const void*)fwd_kernel, dim3(grid), dim3(512), args, LDS_BYTES, stream);
    if (e != hipSuccess) fprintf(stderr, "cooperative launch failed: %s (grid %d)\n", hipGetErrorString(e), grid);
}
```
